# Optimizing an MI355X kernel written in HIP

```python
import math
import jax, jax.numpy as jnp
from jax import lax
import numpy as np

D_MODEL = 1024
BATCH = 4
SEQ = 4096
DEPTH = 2

MEM_LEN = 256
N_BRANCH = 4
BRANCH_WIDTH = D_MODEL // 4
ROPE_THETA = 10000.0
NORM_EPS = 1e-6
QUERY_BLOCK = 128
DIFF_HEADS = 4
DIFF_HEAD_DIM = BRANCH_WIDTH // (2 * DIFF_HEADS)
HGRN_HEADS = 4
HGRN_KEY_DIM = BRANCH_WIDTH // HGRN_HEADS
HGRN_VAL_DIM = BRANCH_WIDTH // HGRN_HEADS
HGRN_CHUNK = 64
HGRN_MIN_FORGET = 1e-30
SGU_GROUPS = 4
SGU_GROUP_DIM = BRANCH_WIDTH // SGU_GROUPS
SGU_CHUNK = 128
DSA_HEADS = 4
DSA_HEAD_DIM = BRANCH_WIDTH // DSA_HEADS
DSA_IDX_HEADS = 4
DSA_IDX_DIM = 32
DSA_TOPK = 256
MEM_HEADS = 4
MEM_HEAD_DIM = 64
MOE_GROUPS = 4
MOE_EXPERTS_PER_GROUP = 8
MOE_N_EXPERTS = MOE_GROUPS * MOE_EXPERTS_PER_GROUP
MOE_HIDDEN = 256
MOE_TOPK = 2
MOE_BLOCK = 128

IN_SPLITS = (
    2 * DIFF_HEADS * DIFF_HEAD_DIM,
    2 * DIFF_HEADS * DIFF_HEAD_DIM,
    2 * DIFF_HEADS * DIFF_HEAD_DIM,
    HGRN_HEADS * HGRN_KEY_DIM,
    HGRN_HEADS * HGRN_KEY_DIM,
    HGRN_HEADS * HGRN_VAL_DIM,
    HGRN_HEADS * HGRN_VAL_DIM,
    2 * BRANCH_WIDTH,
    DSA_HEADS * DSA_HEAD_DIM,
    DSA_HEAD_DIM,
    DSA_HEAD_DIM,
    DSA_IDX_HEADS * DSA_IDX_DIM,
    DSA_IDX_DIM,
    DSA_IDX_HEADS,
    N_BRANCH * D_MODEL,
)
IN_WIDTH = sum(IN_SPLITS)

kernel_name = "hybrid_gated_four_mixer_hmoe"


def _rmsnorm(x, gain=None):
    xf = x.astype(jnp.float32)
    y = xf * lax.rsqrt(jnp.mean(xf * xf, axis=-1, keepdims=True) + NORM_EPS)
    if gain is not None:
        y = y * gain.astype(jnp.float32)
    return y.astype(x.dtype)


def _layernorm(x):
    xf = x.astype(jnp.float32)
    mu = jnp.mean(xf, axis=-1, keepdims=True)
    xc = xf - mu
    y = xc * lax.rsqrt(jnp.mean(xc * xc, axis=-1, keepdims=True) + NORM_EPS)
    return y.astype(x.dtype)


def _rope(x, positions):
    d = x.shape[-1]
    half = d // 2
    inv = ROPE_THETA ** (-jnp.arange(half, dtype=jnp.float32) * (2.0 / d))
    ang = positions.astype(jnp.float32)[..., None] * inv
    ang = ang.reshape(ang.shape[:2] + (1,) * (x.ndim - 3) + (half,))
    cos, sin = jnp.cos(ang), jnp.sin(ang)
    xf = x.astype(jnp.float32)
    x1, x2 = xf[..., :half], xf[..., half:]
    return jnp.concatenate([x1 * cos - x2 * sin, x2 * cos + x1 * sin], axis=-1).astype(x.dtype)


def _to_blocks(t, blk):
    b, s = t.shape[:2]
    return jnp.moveaxis(t.reshape((b, s // blk, blk) + t.shape[2:]), 1, 0)


def _from_blocks(t):
    t = jnp.moveaxis(t, 0, 1)
    return t.reshape((t.shape[0], t.shape[1] * t.shape[2]) + t.shape[3:])


def _diff_attention(q, k, v, lam, lam_init):
    s_len = q.shape[1]
    scale = DIFF_HEAD_DIM ** -0.5
    key_pos = jnp.arange(s_len)
    starts = jnp.arange(s_len // QUERY_BLOCK) * QUERY_BLOCK

    def block(args):
        qb, start = args
        s = jnp.einsum('bqhmd,bkhmd->bhmqk', qb, k).astype(jnp.float32) * scale
        qpos = start + jnp.arange(QUERY_BLOCK)
        causal = key_pos[None, :] <= qpos[:, None]
        p = jax.nn.softmax(jnp.where(causal, s, -jnp.inf), axis=-1)
        a = p[:, :, 0] - lam * p[:, :, 1]
        return jnp.einsum('bhqk,bkhe->bqhe', a.astype(v.dtype), v)

    o = _from_blocks(lax.map(block, (_to_blocks(q, QUERY_BLOCK), starts)))
    return _rmsnorm(o) * (1.0 - lam_init)


def _hgrn2(q, f_pre, inp, g, lb):
    b, s_len = q.shape[:2]
    H, DK, DV, C = HGRN_HEADS, HGRN_KEY_DIM, HGRN_VAL_DIM, HGRN_CHUNK
    qf = jax.nn.silu(q.astype(jnp.float32)).reshape(b, s_len, H, DK)
    fp = f_pre.astype(jnp.float32).reshape(b, s_len, H, DK)
    lbh = lb.astype(jnp.float32).reshape(H, DK)
    f = lbh + (1.0 - lbh) * jax.nn.sigmoid(fp)
    log_f = jnp.log(jnp.maximum(f, HGRN_MIN_FORGET))
    kf = (1.0 - lbh) * jax.nn.sigmoid(-fp)
    vf = inp.astype(jnp.float32).reshape(b, s_len, H, DV)

    def chunks(t):
        return t.reshape(b, s_len // C, C, H, t.shape[-1]).transpose(1, 0, 3, 2, 4)

    qc, kc, vc = chunks(qf), chunks(kf), chunks(vf)
    bc = jnp.cumsum(chunks(log_f), axis=3)
    tril = jnp.tril(jnp.ones((C, C), dtype=bool))

    def step(state, xs):
        qt, kt, vt, bt = xs
        o_inter = jnp.einsum('bhtk,bhkv->bhtv', qt * jnp.exp(bt), state)
        rel = jnp.where(tril[:, :, None], bt[:, :, :, None, :] - bt[:, :, None, :, :], -jnp.inf)
        att = jnp.einsum('bhtk,bhsk,bhtsk->bhts', qt, kt, jnp.exp(rel))
        o = o_inter + jnp.einsum('bhts,bhsv->bhtv', att, vt)
        b_end = bt[:, :, -1:, :]
        state = (jnp.exp(b_end[:, :, 0, :, None]) * state
                 + jnp.einsum('bhsk,bhsv->bhkv', kt * jnp.exp(b_end - bt), vt))
        return state, o

    state0 = jnp.zeros((b, H, DK, DV), jnp.float32)
    _, o = lax.scan(step, state0, (qc, kc, vc, bc))
    o = o.transpose(1, 0, 3, 2, 4).reshape(b, s_len, H, DV)
    o = _rmsnorm(o).reshape(b, s_len, H * DV)
    return (o * jax.nn.silu(g.astype(jnp.float32))).astype(g.dtype)


def _spatial_gating(uv, w_s, b_s):
    b, s_len = uv.shape[:2]
    u, v = jnp.split(jax.nn.gelu(uv), 2, axis=-1)
    v = _layernorm(v).reshape(b, s_len // SGU_CHUNK, SGU_CHUNK, SGU_GROUPS, SGU_GROUP_DIM)
    w = w_s * jnp.tril(jnp.ones((SGU_CHUNK, SGU_CHUNK), w_s.dtype))
    mixed = jnp.einsum('gts,bcsgd->bctgd', w, v) + b_s.T[:, :, None]
    return u * mixed.reshape(b, s_len, BRANCH_WIDTH)


def _dsa_attention(q, k, v, iq, ik, iw):
    b, s_len = q.shape[:2]
    n_sel = min(DSA_TOPK, s_len // 4)
    scale = DSA_HEAD_DIM ** -0.5
    iw = iw.astype(jnp.float32) * (DSA_IDX_HEADS ** -0.5 * DSA_IDX_DIM ** -0.5)
    key_pos = jnp.arange(s_len)
    starts = jnp.arange(s_len // QUERY_BLOCK) * QUERY_BLOCK

    def block(args):
        qb, iqb, iwb, start = args
        qpos = start + jnp.arange(QUERY_BLOCK)
        sc = jax.nn.relu(jnp.einsum('bqhd,bsd->bqhs', iqb, ik).astype(jnp.float32))
        sc = jnp.einsum('bqhs,bqh->bqs', sc, iwb)
        sc = jnp.where(key_pos[None, None, :] <= qpos[None, :, None], sc, -jnp.inf)
        _, idx = lax.top_k(sc, n_sel)
        valid = idx <= qpos[None, :, None]
        kg = jax.vmap(lambda kk, ii: kk[ii])(k, idx)
        vg = jax.vmap(lambda vv, ii: vv[ii])(v, idx)
        logits = jnp.einsum('bqhd,bqnd->bqhn', qb, kg).astype(jnp.float32) * scale
        p = jax.nn.softmax(jnp.where(valid[:, :, None, :], logits, -jnp.inf), axis=-1)
        return jnp.einsum('bqhn,bqnd->bqhd', p.astype(v.dtype), vg)

    o = _from_blocks(lax.map(block, (_to_blocks(q, QUERY_BLOCK), _to_blocks(iq, QUERY_BLOCK),
                                     _to_blocks(iw, QUERY_BLOCK), starts)))
    return o.reshape(b, s_len, DSA_HEADS * DSA_HEAD_DIM)


def _hybrid_mixer(h, positions, w_in, lam_vec, lam_init, lb, sgu_w, sgu_b, w_branch, w_out):
    b, s_len, _ = h.shape
    offsets = np.cumsum(IN_SPLITS)[:-1].tolist()
    (a_q, a_k, a_v, b_q, b_f, b_i, b_g, c_uv, d_q, d_k, d_v, d_iq, d_ik, d_iw,
     gate_pre) = jnp.split(h @ w_in, offsets, axis=-1)
    lv = lam_vec.astype(jnp.float32)
    lam = jnp.exp(jnp.sum(lv[0] * lv[1])) - jnp.exp(jnp.sum(lv[2] * lv[3])) + lam_init
    aq = _rope(a_q.reshape(b, s_len, DIFF_HEADS, 2, DIFF_HEAD_DIM), positions)
    ak = _rope(a_k.reshape(b, s_len, DIFF_HEADS, 2, DIFF_HEAD_DIM), positions)
    av = a_v.reshape(b, s_len, DIFF_HEADS, 2 * DIFF_HEAD_DIM)
    y_a = _diff_attention(aq, ak, av, lam, lam_init).reshape(b, s_len, BRANCH_WIDTH)
    y_b = _hgrn2(b_q, b_f, b_i, b_g, lb)
    y_c = _spatial_gating(c_uv, sgu_w, sgu_b)
    dq = _rope(d_q.reshape(b, s_len, DSA_HEADS, DSA_HEAD_DIM), positions)
    dk = _rope(d_k, positions)
    diq = _rope(d_iq.reshape(b, s_len, DSA_IDX_HEADS, DSA_IDX_DIM), positions)
    dik = _rope(d_ik, positions)
    y_d = _dsa_attention(dq, dk, d_v, diq, dik, d_iw)
    y = jnp.stack([y_a, y_b, y_c, y_d], axis=2)
    branch = jnp.einsum('bsnc,ncd->bsnd', y, w_branch)
    gates = jax.nn.sigmoid(gate_pre.reshape(b, s_len, N_BRANCH, D_MODEL))
    merged = jnp.sum(gates * branch, axis=2)
    return merged @ w_out


def _memory_attention(h, mem_n, w_q, w_kv, w_o):
    b, s_len, _ = h.shape
    m = mem_n.shape[1]
    q = (h @ w_q).reshape(b, s_len, MEM_HEADS, MEM_HEAD_DIM)
    kv = (mem_n @ w_kv).reshape(b, m, 2, MEM_HEADS, MEM_HEAD_DIM)
    s = jnp.einsum('bqhd,bmhd->bhqm', q, kv[:, :, 0]).astype(jnp.float32) * MEM_HEAD_DIM ** -0.5
    p = jax.nn.softmax(s, axis=-1)
    o = jnp.einsum('bhqm,bmhd->bqhd', p.astype(h.dtype), kv[:, :, 1])
    return o.reshape(b, s_len, MEM_HEADS * MEM_HEAD_DIM) @ w_o


def _hier_moe(h, w_rg, b_rg, w_re, b_re, w_gate, w_up, w_down):
    b, s_len, d = h.shape
    x = h.reshape(-1, d)
    n = x.shape[0]
    rows = jnp.arange(n)
    gl = (x @ w_rg).astype(jnp.float32) + b_rg.astype(jnp.float32)
    pg = jax.nn.softmax(gl, axis=-1)
    gsel = jnp.argmax(gl, axis=-1)
    pg_sel = pg[rows, gsel]
    el = ((x @ w_re).astype(jnp.float32) + b_re.astype(jnp.float32)).reshape(n, MOE_GROUPS, MOE_EXPERTS_PER_GROUP)
    pe = jax.nn.softmax(el[rows, gsel], axis=-1)
    top_p, top_i = lax.top_k(pe, MOE_TOPK)
    comb = pg_sel[:, None] * top_p / jnp.sum(top_p, axis=-1, keepdims=True)
    eid = gsel[:, None] * MOE_EXPERTS_PER_GROUP + top_i
    m = n * MOE_TOPK
    flat_e = eid.reshape(-1)
    flat_t = jnp.repeat(rows, MOE_TOPK)
    flat_w = comb.reshape(-1)
    order = jnp.argsort(flat_e)
    se = flat_e[order]
    counts = jnp.bincount(flat_e, length=MOE_N_EXPERTS)
    padded = (counts + MOE_BLOCK - 1) // MOE_BLOCK * MOE_BLOCK
    start = jnp.cumsum(counts) - counts
    pend = jnp.cumsum(padded)
    pstart = pend - padded
    dest = pstart[se] + jnp.arange(m) - start[se]
    n_blocks = -(-m // MOE_BLOCK) + MOE_N_EXPERTS
    p_rows = n_blocks * MOE_BLOCK
    buf_t = jnp.zeros((p_rows,), jnp.int32).at[dest].set(flat_t[order].astype(jnp.int32))
    buf_w = jnp.zeros((p_rows,), jnp.float32).at[dest].set(flat_w[order])
    block_e = jnp.clip(jnp.searchsorted(pend, jnp.arange(n_blocks) * MOE_BLOCK, side='right'),
                       0, MOE_N_EXPERTS - 1)
    xb = x[buf_t].reshape(n_blocks, MOE_BLOCK, d)

    def expert_block(args):
        xe, e = args
        hid = jax.nn.silu(xe @ w_gate[e]) * (xe @ w_up[e])
        return hid @ w_down[e]

    yb = lax.map(expert_block, (xb, block_e)).reshape(p_rows, d)
    y = jnp.zeros((n, d), x.dtype).at[buf_t].add(yb * buf_w[:, None].astype(x.dtype))
    return y.reshape(b, s_len, d)


def setup_inputs(seed: int = 0) -> dict:
    key = jax.random.key(seed)
    ks = jax.random.split(key, 26)
    f32 = jnp.float32
    nrm = lambda k, shape, scale: jax.random.normal(k, shape, f32) * scale
    gain = lambda k, shape: 1.0 + 0.01 * jax.random.normal(k, shape, f32)
    offs = jax.random.randint(ks[2], (BATCH, 1), 0, 1024)
    positions = (offs + jnp.arange(SEQ)[None, :]).astype(jnp.int32)
    return {
        "x": nrm(ks[0], (BATCH, SEQ, D_MODEL), 1.0),
        "mem": nrm(ks[1], (BATCH, MEM_LEN, D_MODEL), 1.0),
        "positions": positions,
        "norm_mix": gain(ks[3], (DEPTH, D_MODEL)),
        "w_in": nrm(ks[4], (DEPTH, D_MODEL, IN_WIDTH), D_MODEL ** -0.5),
        "diff_lambda": nrm(ks[5], (DEPTH, 4, DIFF_HEAD_DIM), 0.1),
        "hgrn_lb_logits": nrm(ks[6], (DEPTH, HGRN_HEADS * HGRN_KEY_DIM), 0.5),
        "spatial_w": nrm(ks[7], (DEPTH, SGU_GROUPS, SGU_CHUNK, SGU_CHUNK), 0.05),
        "spatial_b": gain(ks[8], (DEPTH, SGU_GROUPS, SGU_CHUNK)),
        "w_branch": nrm(ks[9], (DEPTH, N_BRANCH, BRANCH_WIDTH, D_MODEL), BRANCH_WIDTH ** -0.5),
        "w_out": nrm(ks[10], (DEPTH, D_MODEL, D_MODEL), D_MODEL ** -0.5),
        "norm_mem_q": gain(ks[11], (DEPTH, D_MODEL)),
        "norm_mem_kv": gain(ks[12], (DEPTH, D_MODEL)),
        "w_mem_q": nrm(ks[13], (DEPTH, D_MODEL, MEM_HEADS * MEM_HEAD_DIM), D_MODEL ** -0.5),
        "w_mem_kv": nrm(ks[14], (DEPTH, D_MODEL, 2 * MEM_HEADS * MEM_HEAD_DIM), D_MODEL ** -0.5),
        "w_mem_o": nrm(ks[15], (DEPTH, MEM_HEADS * MEM_HEAD_DIM, D_MODEL), (MEM_HEADS * MEM_HEAD_DIM) ** -0.5),
        "norm_ffn": gain(ks[16], (DEPTH, D_MODEL)),
        "w_router_group": nrm(ks[17], (DEPTH, D_MODEL, MOE_GROUPS), D_MODEL ** -0.5),
        "b_router_group": nrm(ks[18], (DEPTH, MOE_GROUPS), 0.01),
        "w_router_expert": nrm(ks[19], (DEPTH, D_MODEL, MOE_N_EXPERTS), D_MODEL ** -0.5),
        "b_router_expert": nrm(ks[20], (DEPTH, MOE_N_EXPERTS), 0.01),
        "w_exp_gate": nrm(ks[21], (DEPTH, MOE_N_EXPERTS, D_MODEL, MOE_HIDDEN), D_MODEL ** -0.5),
        "w_exp_up": nrm(ks[22], (DEPTH, MOE_N_EXPERTS, D_MODEL, MOE_HIDDEN), D_MODEL ** -0.5),
        "w_exp_down": nrm(ks[23], (DEPTH, MOE_N_EXPERTS, MOE_HIDDEN, D_MODEL), MOE_HIDDEN ** -0.5),
        "norm_final": gain(ks[24], (D_MODEL,)),
    }


def reference(x, mem, positions, norm_mix, w_in, diff_lambda, hgrn_lb_logits, spatial_w, spatial_b,
              w_branch, w_out, norm_mem_q, norm_mem_kv, w_mem_q, w_mem_kv, w_mem_o, norm_ffn,
              w_router_group, b_router_group, w_router_expert, b_router_expert,
              w_exp_gate, w_exp_up, w_exp_down, norm_final):
    lb_w = jax.nn.softmax(hgrn_lb_logits.astype(jnp.float32), axis=0)
    lower_bounds = jnp.cumsum(lb_w, axis=0) - lb_w[0]
    for l in range(DEPTH):
        lam_init = 0.8 - 0.6 * math.exp(-0.3 * l)
        x = x + _hybrid_mixer(_rmsnorm(x, norm_mix[l]), positions, w_in[l], diff_lambda[l], lam_init,
                              lower_bounds[l], spatial_w[l], spatial_b[l], w_branch[l], w_out[l])
        x = x + _memory_attention(_rmsnorm(x, norm_mem_q[l]), _rmsnorm(mem, norm_mem_kv[l]),
                                  w_mem_q[l], w_mem_kv[l], w_mem_o[l])
        x = x + _hier_moe(_rmsnorm(x, norm_ffn[l]), w_router_group[l], b_router_group[l],
                          w_router_expert[l], b_router_expert[l],
                          w_exp_gate[l], w_exp_up[l], w_exp_down[l])
    return _rmsnorm(x, norm_final)
```

```cpp
#include <hip/hip_runtime.h>
#include <stdint.h>
#include <stdio.h>

#ifndef PROBE_DUP
#define PROBE_DUP 0
#endif
#define DI __device__ __forceinline__
#define LAS __attribute__((address_space(3)))
typedef unsigned short bf16_t;
typedef short bf16x8 __attribute__((ext_vector_type(8)));
typedef short s16x4 __attribute__((ext_vector_type(4)));
typedef float f32x2 __attribute__((ext_vector_type(2)));
typedef float f32x4 __attribute__((ext_vector_type(4)));
typedef float f32x16 __attribute__((ext_vector_type(16)));
typedef unsigned u32x2 __attribute__((ext_vector_type(2)));
typedef unsigned u32x4 __attribute__((ext_vector_type(4)));
typedef __bf16 hbf2 __attribute__((ext_vector_type(2)));

constexpr int NB = 4, SEQ = 4096, NTOK = NB * SEQ, DM = 1024, DEPTH = 2, MEMLEN = 256;
constexpr int NTHREADS = 512, NWAVES = 8;
constexpr int LDS_BYTES = 147456;
constexpr int LDS_MISC = 133120;
constexpr int IN_WIDTH = 6948;
constexpr int PROJ_LD = 2560;
constexpr int PC_AQ = 0, PC_AK = 256, PC_BQ = 512, PC_BF = 768, PC_BI = 1024, PC_BG = 1280, PC_CU = 1536, PC_CV = 1792,
              PC_DQ = 2048, PC_DK = 2304, PC_DIQ = 2368, PC_DIK = 2496, PC_DIW = 2528;
constexpr int MOE_CAP = 16384;

constexpr size_t AL(size_t x) { return (x + 255) & ~(size_t)255; }
constexpr size_t WS_CTL = 0, CTL_BYTES = 65536;
constexpr size_t W_IN = AL(WS_CTL + CTL_BYTES);
constexpr size_t W_V = W_IN + (size_t)2560 * 1024 * 2;
constexpr size_t W_G = W_V + (size_t)512 * 1024 * 2;
constexpr size_t W_BR = W_G + (size_t)4096 * 1024 * 2;
constexpr size_t W_OUT = W_BR + (size_t)4 * 1024 * 256 * 2;
constexpr size_t W_Q = W_OUT + (size_t)1024 * 1024 * 2;
constexpr size_t W_O = W_Q + (size_t)256 * 1024 * 2;
constexpr size_t W_GU = W_O + (size_t)1024 * 256 * 2;
constexpr size_t W_D = W_GU + (size_t)32 * 512 * 1024 * 2;
constexpr size_t W_SGU = W_D + (size_t)32 * 1024 * 256 * 2;
constexpr size_t W_RT = W_SGU + (size_t)4 * 128 * 128 * 2;
constexpr size_t W_RH = W_RT + (size_t)36 * 1024 * 4;
constexpr size_t W_KV = W_RH + (size_t)2 * 64 * 1024 * 2;
constexpr size_t WS_H = W_KV + (size_t)DEPTH * 512 * 1024 * 2;
constexpr size_t WS_R1 = WS_H + (size_t)NTOK * 1024 * 2;
constexpr size_t R1_BYTES = (size_t)NTOK * 4096 * 2;
constexpr size_t WS_Y = WS_R1 + R1_BYTES;
constexpr size_t WS_HS = WS_Y + (size_t)NTOK * 1024 * 2;
constexpr size_t WS_HD = WS_HS + (size_t)NB * 64 * 4 * 4096 * 4;
constexpr size_t WS_THETA = WS_HD + (size_t)NB * 64 * 256 * 4;
constexpr size_t WS_MEMN = WS_THETA + (size_t)NTOK * 8;
constexpr size_t WS_MK = WS_MEMN + (size_t)DEPTH * 1024 * 1024 * 2;
constexpr size_t WS_MVT = WS_MK + (size_t)DEPTH * 1024 * 256 * 2;
constexpr size_t WS_TOKE = WS_MVT + (size_t)DEPTH * 256 * 1024 * 2;
constexpr size_t WS_TOKW = WS_TOKE + (size_t)NTOK * 2 * 4;
constexpr size_t WS_RANK = WS_TOKW + (size_t)NTOK * 2 * 4;
constexpr size_t WS_ROWTOK = WS_RANK + (size_t)NTOK * 2 * 4;
constexpr size_t WS_MASK = WS_ROWTOK + (size_t)32 * MOE_CAP * 4;
constexpr size_t WS_RSS = WS_MASK + (size_t)NB * 128 * 128 * 64 * 2;
constexpr size_t WS_DUMMY_BASE = WS_RSS + (size_t)NTOK * 16 * 4;
constexpr size_t WS_DUMMY_OLD = WS_MASK + (size_t)NB * 128 * 128 * 64 * 2;
constexpr size_t WS_DUMMY = WS_DUMMY_BASE;
constexpr size_t WS_END = WS_DUMMY + (size_t)32 * MOE_CAP * 4;
constexpr size_t R1_PROJ = 0, R1_VT = (size_t)NTOK * PROJ_LD * 2;
constexpr size_t R1_GS = 0, R1_MG = (size_t)256 * 65536 * 2;
constexpr size_t R1_MQ = 0, R1_MO = (size_t)NTOK * 256 * 2, R1_HID = 2 * R1_MO, R1_YB = R1_HID + (size_t)40960 * 256 * 2;
constexpr size_t R1_HIDS = R1_YB + (size_t)NTOK * 2 * 1024 * 2;
static_assert(R1_HIDS + (size_t)32 * 64 * 256 * 2 <= R1_BYTES, "R1 map");
static_assert(R1_YB + (size_t)NTOK * 2 * 1024 * 2 <= R1_BYTES, "R1 map");
static_assert(R1_VT + (size_t)512 * NTOK * 2 <= R1_BYTES, "R1 map");
constexpr int CW_BAR = 0;
constexpr int CW_KMAX = 4032;
constexpr int CW_CNT = 4096;

DI bf16_t f2bf(float f) { __bf16 b = (__bf16)f; return __builtin_bit_cast(bf16_t, b); }
DI float bf2f(bf16_t b) { return __uint_as_float(((unsigned)b) << 16); }
DI unsigned pk2(float a, float b) { f32x2 v = {a, b}; hbf2 r = __builtin_convertvector(v, hbf2); return __builtin_bit_cast(unsigned, r); }
DI float bflo(unsigned w) { return __uint_as_float(w << 16); }
DI float bfhi(unsigned w) { return __uint_as_float(w & 0xffff0000u); }
DI float sigmoidf_(float x) { return __builtin_amdgcn_rcpf(1.0f + __builtin_amdgcn_exp2f(-1.4426950408889634f * x)); }
DI float siluf_(float x) { return x * __builtin_amdgcn_rcpf(1.0f + __builtin_amdgcn_exp2f(-1.4426950408889634f * x)); }
DI float fexp(float x) { return __builtin_amdgcn_exp2f(1.4426950408889634f * x); }
DI float frcp(float x) { return __builtin_amdgcn_rcpf(x); }
DI float flog(float x) { return 0.6931471805599453f * __builtin_amdgcn_logf(x); }
DI float gelu_tanh(float x) { const float u = 0.7978845608028654f * (x + 0.044715f * x * x * x); return x * frcp(1.0f + fexp(-2.0f * u)); }
DI float wave_sum(float v) { for (int o = 32; o > 0; o >>= 1) v += __shfl_xor(v, o); return v; }
DI float xhalf_max(float x) { const u32x2 r = __builtin_amdgcn_permlane32_swap(__float_as_uint(x), __float_as_uint(x), false, false); return fmaxf(__uint_as_float(r.x), __uint_as_float(r.y)); }
DI float xhalf_sum(float x) { const u32x2 r = __builtin_amdgcn_permlane32_swap(__float_as_uint(x), __float_as_uint(x), false, false); return __uint_as_float(r.x) + __uint_as_float(r.y); }
DI f32x16 mfma32(bf16x8 a, bf16x8 b, f32x16 c) { return __builtin_amdgcn_mfma_f32_32x32x16_bf16(a, b, c, 0, 0, 0); }
DI int crow(int reg, int h) { return (reg & 3) + 8 * (reg >> 2) + 4 * h; }
DI f32x16 zero16() { f32x16 z; for (int i = 0; i < 16; ++i) z[i] = 0.f; return z; }

#define XB_TMO      128
#define XB_XCNT(j)  (256  + 64 * (j))
#define XB_XSUB(j)  (1280 + 64 * (j))
#define XB_XGEN(j)  (2304 + 64 * (j))
#define XB_TOP      3328
#define XB_TOPGEN   3392
#define XCD_BAR_WORDS 3456
#define XB_SPIN_CAP (1u << 22)

DI unsigned xb_ld(unsigned* p)              { return __hip_atomic_load(p, __ATOMIC_RELAXED, __HIP_MEMORY_SCOPE_AGENT); }
DI unsigned xb_add(unsigned* p, unsigned v) { return __hip_atomic_fetch_add(p, v, __ATOMIC_RELAXED, __HIP_MEMORY_SCOPE_AGENT); }
DI unsigned xb_xcc_id() { return (unsigned)__builtin_amdgcn_s_getreg((3 << 11) | 20) & 0xFu; }
#define XB_SPIN(cond, bar) do { unsigned _sp = 0; while (cond) { __builtin_amdgcn_s_sleep(1); \
    if ((++_sp & 255u) == 0u) { if (xb_ld(&(bar)[XB_TMO])) break; if (_sp > XB_SPIN_CAP) { atomicAdd(&(bar)[XB_TMO], 1u); break; } } } } while (0)

struct XcdBarrier { unsigned* bar; unsigned x; volatile LAS unsigned* st; };

DI XcdBarrier xcd_barrier_post(unsigned* bar, volatile LAS unsigned* st) {
    XcdBarrier b; b.bar = bar; b.x = xb_xcc_id(); b.st = st;
    if (threadIdx.x == 0) (void)xb_add(&bar[XB_XCNT(b.x)], 1u);
    return b;
}
DI void xcd_barrier_complete(unsigned* bar, unsigned x, unsigned& nloc, unsigned& nx) {
    const unsigned G = gridDim.x * gridDim.y * gridDim.z;
    unsigned sum, cnt, mine, sp = 0u;
    for (;;) {
        sum = 0u; cnt = 0u; mine = 0u;
#pragma unroll
        for (unsigned j = 0; j < 16; ++j) { const unsigned c = xb_ld(&bar[XB_XCNT(j)]); sum += c; cnt += (c > 0u) ? 1u : 0u; mine = (j == x) ? c : mine; }
        if (sum == G) break;
        __builtin_amdgcn_s_sleep(1);
        if ((++sp & 255u) == 0u) { if (xb_ld(&bar[XB_TMO])) break; if (sp > XB_SPIN_CAP) { atomicAdd(&bar[XB_TMO], 1u); break; } }
    }
    nloc = mine > 0u ? mine : 1u; nx = cnt > 0u ? cnt : 1u;
}
DI void xcd_barrier(const XcdBarrier& b) {
    asm volatile("s_waitcnt vmcnt(0)" ::: "memory");
    __syncthreads();
    if (threadIdx.x == 0) {
        unsigned* bar = b.bar;
        __builtin_amdgcn_s_waitcnt(0);
        unsigned nloc = b.st[0], nx = b.st[1];
        if (nloc == 0u) { xcd_barrier_complete(bar, b.x, nloc, nx); b.st[0] = nloc; b.st[1] = nx; }
        const unsigned old = xb_add(&bar[XB_XSUB(b.x)], 1u);
        const unsigned gen = old / nloc;
        if (old + 1u == (gen + 1u) * nloc) {
            __builtin_amdgcn_fence(__ATOMIC_RELEASE, "agent");
            asm volatile("s_waitcnt vmcnt(0)" ::: "memory");
            const unsigned og = xb_add(&bar[XB_TOP], 1u);
            const unsigned tg = og / nx;
            if (og + 1u == (tg + 1u) * nx) xb_add(&bar[XB_TOPGEN], 1u);
            else XB_SPIN(xb_ld(&bar[XB_TOPGEN]) == tg, bar);
            __builtin_amdgcn_fence(__ATOMIC_ACQUIRE, "agent");
            xb_add(&bar[XB_XGEN(b.x)], 1u);
            asm volatile("s_waitcnt vmcnt(0)" ::: "memory");
        } else {
            XB_SPIN(xb_ld(&bar[XB_XGEN(b.x)]) == gen, bar);
            __builtin_amdgcn_fence(__ATOMIC_ACQUIRE, "agent");
            asm volatile("s_waitcnt vmcnt(0)" ::: "memory");
        }
    }
    __syncthreads();
}
namespace pg8 {
constexpr int BM = 256, BK = 64, HALF = 128, HTB = HALF * BK * 2, STAGE_BYTES = 8 * HTB, NXCD = 8, WGM = 8;
DI int lds_byte(int r, int c) { const int st = (r >> 4) * 2 + (c >> 5), rr = r & 15, cc = c & 31, ob = rr * 64 + cc * 2; return st * 1024 + (ob ^ (((ob >> 9) & 1) << 5)); }
DI void stage_rc(int b, int& R, int& C) { const int st = b / 1024, sb = b % 1024, swz = sb ^ (((sb >> 9) & 1) << 5); R = (st >> 1) * 16 + swz / 64; C = (st & 1) * 32 + (swz % 64) / 2; }
DI int perm32(int rho) { const int n = rho >> 4, i = rho & 15; return 8 * (i >> 2) + 4 * n + (i & 3); }

struct Unit { const char* a; const char* b; int pm, pn, x, y, nt; };

DI void tile_map(int L, int nM, int nN, int& pm, int& pn) {
    const int nwg = nM * nN; int wgid = L;
    { const int q = nwg / NXCD, r = nwg % NXCD, xcd = wgid % NXCD, off = wgid / NXCD; wgid = (xcd < r ? xcd * (q + 1) : r * (q + 1) + (xcd - r) * q) + off; }
    const int nig = WGM * nN, gid = wgid / nig, fm = gid * WGM, gsz = (nM - fm) < WGM ? (nM - fm) : WGM;
    pm = fm + ((wgid % nig) % gsz); pn = (wgid % nig) / gsz;
}
struct DenseOrder {
    const char* A; const char* B; size_t at, bt; int nM, nN, nwg, G, c;
    DI void init(const void* A_, const void* B_, int M, int N, int lda, int ldb, int G_, int c_) {
        A = (const char*)A_; B = (const char*)B_; at = (size_t)BM * lda * 2; bt = (size_t)BM * ldb * 2; nM = M / BM; nN = N / BM; nwg = nM * nN; G = G_; c = c_; }
    DI bool next(int i, Unit& u) const {
        const long L = (long)i * G + c; if (L >= nwg) return false;
        tile_map((int)L, nM, nN, u.pm, u.pn); u.a = A + (size_t)u.pm * at; u.b = B + (size_t)u.pn * bt; u.x = 0; u.y = 0; u.nt = 0; return true; }
    DI unsigned row_off(const Unit&, int) const { return 0u; }
};

#define PG8_WAIT_V(n) asm volatile("s_waitcnt vmcnt(" #n ")" ::: "memory")
#define PG8_WAIT_L(n) asm volatile("s_waitcnt lgkmcnt(" #n ")" ::: "memory")
#define PG8_BAR __builtin_amdgcn_s_barrier()
#define PG8_SCHED __builtin_amdgcn_sched_barrier(0)

template <class Epi, class Sched, bool GATHER>
DI void gemm_phase(const int tid, LAS unsigned char* lds, const int lda, const int ldb, const int K, const Sched& S, const Epi& E) {
    const int wid = __builtin_amdgcn_readfirstlane(tid >> 6), lane = tid & 63, wr = wid >> 2, wc = wid & 3, fr = lane & 15, fq = lane >> 4;
    const int nt_phase = K / BK;
    unsigned voffA[2], voffB[2]; int RA[2], CA[2];
#pragma unroll
    for (int i = 0; i < 2; ++i) { int R, C; stage_rc(tid * 16 + i * 8192, R, C); const int Rb = (R & ~31) + perm32(R & 31);
        RA[i] = R; CA[i] = C; voffA[i] = (unsigned)(R * lda + C) * 2u; voffB[i] = (unsigned)(Rb * ldb + C) * 2u; }
    const size_t kstep = (size_t)(BK * 2);
    const size_t hstepA = (size_t)HALF * lda * 2, hstepB = (size_t)HALF * ldb * 2;
    const unsigned ldsw = (unsigned)wid * 1024u;
    const int aoff = lds_byte(wr * 64 + fr, fq * 8), boff = lds_byte(wc * 32 + fr, fq * 8);
    unsigned vc[2][2], vn[2][2];
#define PG8_SA(b, h) (((b) * 2 + (h)) * HTB)
#define PG8_SB(b, h) ((4 + (b) * 2 + (h)) * HTB)
#define PG8_GL(bufoff, gptr, vo, _i) __builtin_amdgcn_global_load_lds((const unsigned*)((const char*)(gptr) + (vo)), (LAS unsigned*)(lds + (bufoff) + ldsw + (_i) * 8192), 16, 0, 0)
#define PG8_STAGE_B(bufoff, gbase) do { PG8_GL(bufoff, gbase, voffB[0], 0); PG8_GL(bufoff, gbase, voffB[1], 1); } while (0)
#define PG8_STAGE_A(bufoff, kptr, h, isnext) do { if constexpr (GATHER) { const unsigned _o0 = (isnext) ? vn[h][0] : vc[h][0], _o1 = (isnext) ? vn[h][1] : vc[h][1]; PG8_GL(bufoff, kptr, _o0, 0); PG8_GL(bufoff, kptr, _o1, 1); } \
        else { PG8_GL(bufoff, (kptr) + (h) * hstepA, voffA[0], 0); PG8_GL(bufoff, (kptr) + (h) * hstepA, voffA[1], 1); } } while (0)
#define PG8_LDA(dst, b, h) do { _Pragma("unroll") for (int m = 0; m < 4; ++m) _Pragma("unroll") for (int k = 0; k < 2; ++k) dst[m][k] = *(const LAS bf16x8*)(lds + PG8_SA(b, h) + aoff + m * 2048 + k * 1024); } while (0)
#define PG8_LDB(dst, b, h) do { _Pragma("unroll") for (int n = 0; n < 2; ++n) _Pragma("unroll") for (int k = 0; k < 2; ++k) dst[n][k] = *(const LAS bf16x8*)(lds + PG8_SB(b, h) + boff + n * 2048 + k * 1024); } while (0)
#define PG8_MMA(ai, bj, At, Bt) do { __builtin_amdgcn_s_setprio(1); _Pragma("unroll") for (int m = 0; m < 4; ++m) _Pragma("unroll") for (int n = 0; n < 2; ++n) _Pragma("unroll") for (int k = 0; k < 2; ++k) \
        acc[ai][bj][m][n] = __builtin_amdgcn_mfma_f32_16x16x32_bf16(Bt[n][k], At[m][k], acc[ai][bj][m][n], 0, 0, 0); __builtin_amdgcn_s_setprio(0); } while (0)
    Unit cur, nxt; int ui = 0;
    if (!S.next(0, cur)) return;
    f32x4 acc[2][2][4][2];
#pragma unroll
    for (int a = 0; a < 2; ++a)
#pragma unroll
        for (int b = 0; b < 2; ++b)
#pragma unroll
            for (int m = 0; m < 4; ++m)
#pragma unroll
                for (int n = 0; n < 2; ++n) acc[a][b][m][n] = (f32x4){0.f, 0.f, 0.f, 0.f};
    bf16x8 At[4][2], B0[2][2], B1[2][2];
    const char* cA = cur.a; const char* cB = cur.b;
    if constexpr (GATHER) {
#pragma unroll
        for (int h = 0; h < 2; ++h)
#pragma unroll
            for (int i = 0; i < 2; ++i) { vc[h][i] = S.row_off(cur, RA[i] + h * HALF) + (unsigned)CA[i] * 2u; vn[h][i] = vc[h][i]; }
    }
    PG8_STAGE_B(PG8_SB(0, 0), cB); PG8_STAGE_A(PG8_SA(0, 0), cA, 0, false); PG8_STAGE_B(PG8_SB(0, 1), cB + hstepB); PG8_STAGE_A(PG8_SA(0, 1), cA, 1, false);
    if (wr == 1) PG8_BAR;
    PG8_WAIT_V(4); PG8_BAR;
    PG8_STAGE_B(PG8_SB(1, 0), cB + kstep); PG8_STAGE_A(PG8_SA(1, 0), cA + kstep, 0, false); PG8_STAGE_B(PG8_SB(1, 1), cB + hstepB + kstep);
    PG8_WAIT_V(6); PG8_BAR;
    for (;;) {
        const bool has_next = S.next(ui + 1, nxt);
        const char* nA = has_next ? nxt.a : cA; const char* nB = has_next ? nxt.b : cB;
        if constexpr (GATHER) {
            if (has_next) {
#pragma unroll
                for (int h = 0; h < 2; ++h)
#pragma unroll
                    for (int i = 0; i < 2; ++i) vn[h][i] = S.row_off(nxt, RA[i] + h * HALF) + (unsigned)CA[i] * 2u;
            }
        }
        const int nt = cur.nt ? cur.nt : nt_phase;
        for (int t = 0; t < nt; t += 2) {
            const bool last = (t == nt - 2);
            int tq = t; asm volatile("" : "+s"(tq));
            const char* a1 = cA + (size_t)(tq + 1) * kstep;
            const char* a2 = last ? nA : cA + (size_t)(tq + 2) * kstep; const char* b2 = last ? nB : cB + (size_t)(tq + 2) * kstep;
            const char* a3 = a2 + kstep; const char* b3 = b2 + kstep;
            PG8_LDB(B0, 0, 0); PG8_SCHED; PG8_LDA(At, 0, 0); PG8_STAGE_A(PG8_SA(1, 1), a1, 1, false);
            PG8_WAIT_L(8); PG8_BAR; PG8_WAIT_L(0); PG8_MMA(0, 0, At, B0); PG8_BAR; PG8_SCHED;
            PG8_LDB(B1, 0, 1); PG8_STAGE_B(PG8_SB(0, 0), b2);
            PG8_BAR; PG8_WAIT_L(0); PG8_MMA(0, 1, At, B1); PG8_BAR;
            PG8_LDA(At, 0, 1); PG8_STAGE_A(PG8_SA(0, 0), a2, 0, last);
            PG8_BAR; PG8_WAIT_L(0); PG8_MMA(1, 0, At, B0); PG8_BAR; PG8_SCHED;
            PG8_STAGE_B(PG8_SB(0, 1), b2 + hstepB);
            PG8_WAIT_V(6); PG8_BAR; PG8_MMA(1, 1, At, B1); PG8_BAR;
            PG8_LDB(B0, 1, 0); PG8_SCHED; PG8_LDA(At, 1, 0); PG8_STAGE_A(PG8_SA(0, 1), a2, 1, last);
            PG8_WAIT_L(8); PG8_BAR; PG8_WAIT_L(0); PG8_MMA(0, 0, At, B0); PG8_BAR; PG8_SCHED;
            PG8_LDB(B1, 1, 1); PG8_STAGE_B(PG8_SB(1, 0), b3);
            PG8_BAR; PG8_WAIT_L(0); PG8_MMA(0, 1, At, B1); PG8_BAR;
            PG8_LDA(At, 1, 1); PG8_STAGE_A(PG8_SA(1, 0), a3, 0, last);
            PG8_BAR; PG8_WAIT_L(0); PG8_MMA(1, 0, At, B0); PG8_BAR; PG8_SCHED;
            PG8_STAGE_B(PG8_SB(1, 1), b3 + hstepB);
            PG8_WAIT_V(6); PG8_BAR; PG8_MMA(1, 1, At, B1); PG8_BAR;
        }
        { int ln2 = lane; asm volatile("" : "+v"(ln2)); E(acc, cur, wr, wc, ln2 & 15, ln2 >> 4); }
        if (!has_next) break;
#pragma unroll
        for (int a = 0; a < 2; ++a)
#pragma unroll
            for (int b = 0; b < 2; ++b)
#pragma unroll
                for (int m = 0; m < 4; ++m)
#pragma unroll
                    for (int n = 0; n < 2; ++n) acc[a][b][m][n] = (f32x4){0.f, 0.f, 0.f, 0.f};
        cur = nxt; cA = nA; cB = nB; ++ui;
        if constexpr (GATHER) {
#pragma unroll
            for (int h = 0; h < 2; ++h)
#pragma unroll
                for (int i = 0; i < 2; ++i) vc[h][i] = vn[h][i];
        }
    }
    PG8_WAIT_V(0);
    if (wr == 0) PG8_BAR;
    PG8_BAR;
#undef PG8_SA
#undef PG8_SB
#undef PG8_GL
#undef PG8_STAGE_A
#undef PG8_STAGE_B
#undef PG8_LDA
#undef PG8_LDB
#undef PG8_MMA
}
}
struct Params {
    const float* x; const float* mem; const int* positions;
    const float* norm_mix; const float* w_in; const float* diff_lambda; const float* hgrn_lb; const float* spatial_w; const float* spatial_b;
    const float* w_branch; const float* w_out; const float* norm_mem_q; const float* norm_mem_kv; const float* w_mem_q; const float* w_mem_kv; const float* w_mem_o;
    const float* norm_ffn; const float* w_rg; const float* b_rg; const float* w_re; const float* b_re; const float* w_eg; const float* w_eu; const float* w_ed; const float* norm_final;
    float* out; unsigned char* ws; int ph_lo, ph_hi;
};
struct Ctx {
    LAS unsigned char* lds; int tid, lane, wave, G, bid;
};
DI Ctx relaunder(const Ctx& C) { Ctx D = C; int w = C.wave, g = C.G, bi = C.bid; asm volatile("" : "+s"(w), "+s"(g), "+s"(bi)); D.wave = w; D.G = g; D.bid = bi; int ln; asm volatile("v_mbcnt_lo_u32_b32 %0, -1, 0\n\tv_mbcnt_hi_u32_b32 %0, -1, %0" : "=v"(ln)); D.lane = ln; D.tid = w * 64 + ln; return D; }
template <class T> DI T* wsp(const Params& P, size_t off) { return (T*)(P.ws + off); }

struct CvtJob { const float* src; bf16_t* dst; int ld_src, ncols, K, ld_dst, nb1, nb2; long ss1, ds1, ss2, ds2; const float* kscale; };
DI void cvt_transpose(const Ctx& C, const CvtJob& J) {
    LAS float* T = (LAS float*)C.lds;
    const int tn = (J.ncols + 63) >> 6, tk = J.K >> 6, per = tn * tk, total = per * J.nb1 * J.nb2;
    for (int t = C.bid; t < total; t += C.G) {
        const int bb = t / per, r = t % per, b1 = bb / J.nb2, b2 = bb % J.nb2, in_ = r / tk, ik = r % tk;
        const float* src = J.src + (size_t)b1 * J.ss1 + (size_t)b2 * J.ss2; bf16_t* dst = J.dst + (size_t)b1 * J.ds1 + (size_t)b2 * J.ds2;
        const int n0 = in_ * 64, k0 = ik * 64;
        { const int k = C.tid >> 3, c8 = (C.tid & 7) * 8;
#pragma unroll
          for (int v = 0; v < 2; ++v) { const int n = n0 + c8 + v * 4;
              f32x4 x = (f32x4){0.f, 0.f, 0.f, 0.f};
              if (n < J.ncols) x = *(const f32x4*)(src + (size_t)(k0 + k) * J.ld_src + n);
              if (J.kscale) { const float g = J.kscale[k0 + k]; x[0] *= g; x[1] *= g; x[2] *= g; x[3] *= g; }
#pragma unroll
              for (int j = 0; j < 4; ++j) T[(c8 + v * 4 + j) * 65 + k] = x[j]; } }
        __syncthreads();
        { const int n = C.tid >> 3, k8 = (C.tid & 7) * 8;
          if (n0 + n < J.ncols) { u32x4 w;
#pragma unroll
              for (int j = 0; j < 4; ++j) w[j] = pk2(T[n * 65 + k8 + 2 * j], T[n * 65 + k8 + 2 * j + 1]);
              *(u32x4*)(dst + (size_t)(n0 + n) * J.ld_dst + k0 + k8) = w; } }
        __syncthreads();
    }
}
DI CvtJob mkjob(const float* src, bf16_t* dst, int ld_src, int ncols, int K, int ld_dst, int nb1 = 1, long ss1 = 0, long ds1 = 0, int nb2 = 1, long ss2 = 0, long ds2 = 0) {
    CvtJob J; J.src = src; J.dst = dst; J.ld_src = ld_src; J.ncols = ncols; J.K = K; J.ld_dst = ld_dst; J.nb1 = nb1; J.nb2 = nb2; J.ss1 = ss1; J.ds1 = ds1; J.ss2 = ss2; J.ds2 = ds2; J.kscale = nullptr; return J; }

DI void phase_convert_layer(const Ctx& C, const Params& P, int l) {
    const float* win = P.w_in + (size_t)l * 1024 * IN_WIDTH;
    bf16_t* WIN = wsp<bf16_t>(P, W_IN); bf16_t* WV = wsp<bf16_t>(P, W_V);
    cvt_transpose(C, mkjob(win + 0, WIN, IN_WIDTH, 512, 1024, 1024));
    cvt_transpose(C, mkjob(win + 768, WIN + (size_t)512 * 1024, IN_WIDTH, 1856, 1024, 1024));
    cvt_transpose(C, mkjob(win + 2688, WIN + (size_t)2368 * 1024, IN_WIDTH, 164, 1024, 1024));
    cvt_transpose(C, mkjob(win + 512, WV, IN_WIDTH, 256, 1024, 1024));
    cvt_transpose(C, mkjob(win + 2624, WV + (size_t)256 * 1024, IN_WIDTH, 64, 1024, 1024));
    cvt_transpose(C, mkjob(win + 2852, wsp<bf16_t>(P, W_G), IN_WIDTH, 4096, 1024, 1024));
    cvt_transpose(C, mkjob(P.w_branch + (size_t)l * 4 * 256 * 1024, wsp<bf16_t>(P, W_BR), 1024, 1024, 256, 1024, 4, 256 * 1024, 256));
    cvt_transpose(C, mkjob(P.w_out + (size_t)l * 1024 * 1024, wsp<bf16_t>(P, W_OUT), 1024, 1024, 1024, 1024));
    { CvtJob J = mkjob(P.w_mem_q + (size_t)l * 1024 * 256, wsp<bf16_t>(P, W_Q), 256, 256, 1024, 1024); J.kscale = P.norm_mem_q + l * DM; cvt_transpose(C, J); }
    cvt_transpose(C, mkjob(P.w_mem_o + (size_t)l * 256 * 1024, wsp<bf16_t>(P, W_O), 1024, 1024, 256, 256));
    cvt_transpose(C, mkjob(P.w_eg + (size_t)l * 32 * 1024 * 256, wsp<bf16_t>(P, W_GU), 256, 128, 1024, 1024, 32, 1024 * 256, 512 * 1024, 2, 128, 256 * 1024));
    cvt_transpose(C, mkjob(P.w_eu + (size_t)l * 32 * 1024 * 256, wsp<bf16_t>(P, W_GU) + (size_t)128 * 1024, 256, 128, 1024, 1024, 32, 1024 * 256, 512 * 1024, 2, 128, 256 * 1024));
    cvt_transpose(C, mkjob(P.w_ed + (size_t)l * 32 * 256 * 1024, wsp<bf16_t>(P, W_D), 1024, 1024, 256, 256, 32, 256 * 1024, 1024 * 256));
    { bf16_t* z0 = WIN + (size_t)2532 * 1024; for (int i = C.bid * NTHREADS + C.tid; i < 28 * 1024; i += C.G * NTHREADS) z0[i] = 0;
      bf16_t* z1 = WV + (size_t)320 * 1024; for (int i = C.bid * NTHREADS + C.tid; i < 192 * 1024; i += C.G * NTHREADS) z1[i] = 0; }
    { bf16_t* rh = wsp<bf16_t>(P, W_RH); const float* wre = P.w_re + (size_t)l * 1024 * 32; const float* wrg = P.w_rg + (size_t)l * 1024 * 4;
      for (int i = C.bid * NTHREADS + C.tid; i < 64 * 1024; i += C.G * NTHREADS) { const int j = i >> 10, k = i & 1023;
          const float w = (j < 32) ? wre[k * 32 + j] : (j < 36 ? wrg[k * 4 + (j - 32)] : 0.f);
          const bf16_t hi = f2bf(w); rh[i] = hi; rh[64 * 1024 + i] = f2bf(w - bf2f(hi)); } }
    { const float* sw = P.spatial_w + (size_t)l * 4 * 128 * 128; bf16_t* d = wsp<bf16_t>(P, W_SGU);
      for (int i = C.bid * NTHREADS + C.tid; i < 4 * 128 * 128; i += C.G * NTHREADS) { const int s = i & 127, t = (i >> 7) & 127; d[i] = (s <= t) ? f2bf(sw[i]) : (bf16_t)0; } }
}

DI void phase_prologue(const Ctx& C, const Params& P) {
    for (int r = C.bid * NWAVES + C.wave; r < NB * MEMLEN; r += C.G * NWAVES) {
        const float* src = P.mem + (size_t)r * DM; f32x4 v[4]; float ss = 0.f;
#pragma unroll
        for (int j = 0; j < 4; ++j) { v[j] = *(const f32x4*)(src + j * 256 + C.lane * 4); ss += v[j][0] * v[j][0] + v[j][1] * v[j][1] + v[j][2] * v[j][2] + v[j][3] * v[j][3]; }
        ss = wave_sum(ss); const float rs = 1.0f / sqrtf(ss * (1.0f / DM) + 1e-6f);
        for (int l = 0; l < DEPTH; ++l) { bf16_t* dst = wsp<bf16_t>(P, WS_MEMN) + ((size_t)l * 1024 + r) * DM;
#pragma unroll
            for (int j = 0; j < 4; ++j) { const f32x4 g = *(const f32x4*)(P.norm_mem_kv + l * DM + j * 256 + C.lane * 4);
                u32x2 w; w.x = pk2(v[j][0] * rs * g[0], v[j][1] * rs * g[1]); w.y = pk2(v[j][2] * rs * g[2], v[j][3] * rs * g[3]);
                *(u32x2*)(dst + j * 256 + C.lane * 4) = w; } }
    }
    for (int l = 0; l < DEPTH; ++l)
        cvt_transpose(C, mkjob(P.w_mem_kv + (size_t)l * 1024 * 512, wsp<bf16_t>(P, W_KV) + (size_t)l * 512 * 1024, 512, 512, 1024, 1024));
}

template <bool ADD_YB, bool WRITE_H, bool FINAL, bool FROM_X = false>
DI void phase_rownorm(const Ctx& C, const Params& P, const float* gain) {
    float* XR = P.out; bf16_t* H = wsp<bf16_t>(P, WS_H); const bf16_t* YB = (const bf16_t*)(P.ws + WS_R1 + R1_YB);
    const int stride = C.G * NWAVES; int t = C.bid * NWAVES + C.wave;
    f32x4 v[4], vn[4]; u32x2 ya[4], yb[4], yan[4], ybn[4];
#define RN_LOAD(dst, da, db, tt) do { const float* src_ = (FROM_X ? P.x : (const float*)XR) + (size_t)(tt) * DM; _Pragma("unroll") for (int j = 0; j < 4; ++j) { const int c = j * 256 + C.lane * 4; dst[j] = *(const f32x4*)(src_ + c); \
        if constexpr (ADD_YB) { da[j] = *(const u32x2*)(YB + (size_t)(2 * (tt)) * DM + c); db[j] = *(const u32x2*)(YB + (size_t)(2 * (tt) + 1) * DM + c); } } } while (0)
    if (t < NTOK) RN_LOAD(v, ya, yb, t);
    for (; t < NTOK; t += stride) {
        const int tn = (t + stride < NTOK) ? t + stride : t;
        RN_LOAD(vn, yan, ybn, tn);
        float* xr = XR + (size_t)t * DM; float ss = 0.f;
#pragma unroll
        for (int j = 0; j < 4; ++j) { const int c = j * 256 + C.lane * 4;
            if constexpr (ADD_YB) { const u32x2 a = ya[j], b = yb[j];
                v[j][0] += bflo(a.x) + bflo(b.x); v[j][1] += bfhi(a.x) + bfhi(b.x); v[j][2] += bflo(a.y) + bflo(b.y); v[j][3] += bfhi(a.y) + bfhi(b.y); }
            if constexpr ((ADD_YB && !FINAL) || FROM_X) *(f32x4*)(xr + c) = v[j];
            ss += v[j][0] * v[j][0] + v[j][1] * v[j][1] + v[j][2] * v[j][2] + v[j][3] * v[j][3]; }
        ss = wave_sum(ss); const float rs = 1.0f / sqrtf(ss * (1.0f / DM) + 1e-6f);
#pragma unroll
        for (int j = 0; j < 4; ++j) { const int c = j * 256 + C.lane * 4; const f32x4 g = *(const f32x4*)(gain + c);
            const f32x4 o = (f32x4){v[j][0] * rs * g[0], v[j][1] * rs * g[1], v[j][2] * rs * g[2], v[j][3] * rs * g[3]};
            if constexpr (FINAL) *(f32x4*)(xr + c) = o;
            if constexpr (WRITE_H) { u32x2 w; w.x = pk2(o[0], o[1]); w.y = pk2(o[2], o[3]); *(u32x2*)(H + (size_t)t * DM + c) = w; } }
#pragma unroll
        for (int j = 0; j < 4; ++j) { v[j] = vn[j]; if constexpr (ADD_YB) { ya[j] = yan[j]; yb[j] = ybn[j]; } }
    }
#undef RN_LOAD
}

DI void phase_rope(const Ctx& C, const Params& P, const int l, const bool dry = false) {
    bf16_t* PROJ = (bf16_t*)(P.ws + WS_R1 + R1_PROJ);
    LAS f32x2* tab = (LAS f32x2*)(C.lds) + C.wave * 64;
    float kmx[4] = {0.f, 0.f, 0.f, 0.f};
    for (int t = C.bid * NWAVES + C.wave; t < NTOK; t += C.G * NWAVES) {
        const float pos = (float)P.positions[t];
        if (C.lane < 48) { const int i = C.lane < 16 ? C.lane : C.lane - 16; const float d = C.lane < 16 ? 32.f : 64.f;
            const float inv = powf(10000.0f, -(float)i * (2.0f / d)); const float ang = pos * inv; float s, c; sincosf(ang, &s, &c); tab[C.lane] = (f32x2){c, s}; }
        __builtin_amdgcn_wave_barrier();
        asm volatile("s_waitcnt lgkmcnt(0)" ::: "memory");
        bf16_t* row = PROJ + (size_t)t * PROJ_LD;
        { const float kv = (C.lane < 32) ? bf2f(row[PC_DIK + C.lane]) : 0.f; const float k2 = wave_sum(kv * kv); const int bb = t >> 12;
#pragma unroll
          for (int q = 0; q < 4; ++q) kmx[q] = (bb == q) ? fmaxf(kmx[q], k2) : kmx[q]; }
        for (int p = C.lane; p < 496; p += 64) {
            int col, half, ti;
            if (p < 256) { col = (p >> 4) * 32 + (p & 15); half = 16; ti = p & 15; }
            else if (p < 416) { const int q = p - 256; col = PC_DQ + (q >> 5) * 64 + (q & 31); half = 32; ti = 16 + (q & 31); }
            else { const int q = p - 416; col = PC_DIQ + (q >> 4) * 32 + (q & 15); half = 16; ti = q & 15; }
            const f32x2 cs = tab[ti]; const float x1 = bf2f(row[col]), x2 = bf2f(row[col + half]);
            if (!dry || pos < -1.0f) { row[col] = f2bf(x1 * cs.x - x2 * cs.y); row[col + half] = f2bf(x2 * cs.x + x1 * cs.y); }
        }
        __builtin_amdgcn_wave_barrier();
    }
    { LAS unsigned* km = (LAS unsigned*)(C.lds + 8192);
      __syncthreads();
      if (C.tid < 4) km[C.tid] = 0u;
      __syncthreads();
      if (C.lane < 4) { float v = 0.f;
#pragma unroll
          for (int q = 0; q < 4; ++q) v = (C.lane == q) ? kmx[q] : v;
          __hip_atomic_fetch_max(km + C.lane, __float_as_uint(v), __ATOMIC_RELAXED, __HIP_MEMORY_SCOPE_WORKGROUP); }
      __syncthreads();
      if (C.tid < 4 && !dry) atomicMax(wsp<unsigned>(P, WS_CTL) + CW_KMAX + 8 * l + C.tid, (unsigned)km[C.tid]);
      __syncthreads(); }
}
DI void sm_step(f32x16& st, const float c, float& m, float& l, f32x16& O0, f32x16& O1, bf16x8& p0, bf16x8& p1) {
    float mx = st[0];
#pragma unroll
    for (int i = 1; i < 16; ++i) mx = fmaxf(mx, st[i]);
    mx = fmaxf(mx, __shfl_xor(mx, 32));
    if (__any(mx > m)) { const float mn = fmaxf(m, mx); const float a = __builtin_amdgcn_exp2f((m - mn) * c); l *= a;
#pragma unroll
        for (int i = 0; i < 16; ++i) { O0[i] *= a; O1[i] *= a; }
        m = mn; }
    const f32x2 cc = {c, c}, mcv = {-(m * c), -(m * c)}; f32x2 rs2 = {0.f, 0.f};
#pragma unroll
    for (int i = 0; i < 8; ++i) { f32x2 x = {st[2 * i], st[2 * i + 1]}; x = x * cc + mcv;
        f32x2 p; p.x = __builtin_amdgcn_exp2f(x.x); p.y = __builtin_amdgcn_exp2f(x.y); st[2 * i] = p.x; st[2 * i + 1] = p.y; rs2 += p; }
    l += rs2.x + rs2.y;
    u32x4 a, b;
    a.x = pk2(st[0], st[1]); a.y = pk2(st[2], st[3]); a.z = pk2(st[4], st[5]); a.w = pk2(st[6], st[7]);
    b.x = pk2(st[8], st[9]); b.y = pk2(st[10], st[11]); b.z = pk2(st[12], st[13]); b.w = pk2(st[14], st[15]);
    p0 = __builtin_bit_cast(bf16x8, a); p1 = __builtin_bit_cast(bf16x8, b);
}
DI void apply_mask(f32x16& st, unsigned vmask) {
#pragma unroll
    for (int i = 0; i < 16; ++i) { const unsigned sel = (unsigned)__builtin_amdgcn_sbfe((int)vmask, i, 1);
        st[i] = __uint_as_float((__float_as_uint(st[i]) & sel) | (__float_as_uint(-3.0e38f) & ~sel)); }
}
DI bf16x8 vt_frag(const bf16_t* vt_row, int k0, int s2, int h) {
    const bf16_t* p = vt_row + k0 + 16 * s2 + 4 * h; const u32x2 lo = *(const u32x2*)p, hi = *(const u32x2*)(p + 8);
    u32x4 w; w.x = lo.x; w.y = lo.y; w.z = hi.x; w.w = hi.y; return __builtin_bit_cast(bf16x8, w);
}
DI unsigned causal_mask(int r, int h) { unsigned m = 0;
#pragma unroll
    for (int i = 0; i < 16; ++i) m |= (crow(i, h) <= r) ? (1u << i) : 0u;
    return m; }
DI void causal_wave_unit(int c, int w, int& bh, int& qs) { const int pi = c * 4 + (w & 3); bh = (pi >> 6) & 15; const int j = pi & 63; qs = (w < 4) ? 127 - j : j; }

struct DiffKV { bf16x8 kf[2][2]; bf16x8 vf[2][2]; };
DI void diff_load(DiffKV& t, const bf16_t* kbase, const bf16_t* vrow0, const bf16_t* vrow1, int k0, int r, int h) {
    const bf16_t* kp = kbase + (size_t)(k0 + r) * PROJ_LD + 8 * h;
#pragma unroll
    for (int m = 0; m < 2; ++m)
#pragma unroll
        for (int s = 0; s < 2; ++s) t.kf[m][s] = *(const bf16x8*)(kp + m * 32 + 16 * s);
#pragma unroll
    for (int s2 = 0; s2 < 2; ++s2) { t.vf[0][s2] = vt_frag(vrow0, k0, s2, h); t.vf[1][s2] = vt_frag(vrow1, k0, s2, h); }
}
DI void diff_step(const DiffKV& t, const bf16x8 (&qf)[2][2], bool diag, unsigned dmask, const float c, float (&mm)[2], float (&ll)[2], f32x16 (&O)[2][2]) {
#pragma unroll
    for (int m = 0; m < 2; ++m) {
        f32x16 st = mfma32(t.kf[m][0], qf[m][0], zero16()); st = mfma32(t.kf[m][1], qf[m][1], st);
        if (diag) apply_mask(st, dmask);
        bf16x8 p0, p1; sm_step(st, c, mm[m], ll[m], O[m][0], O[m][1], p0, p1);
        O[m][0] = mfma32(t.vf[0][0], p0, O[m][0]); O[m][0] = mfma32(t.vf[0][1], p1, O[m][0]);
        O[m][1] = mfma32(t.vf[1][0], p0, O[m][1]); O[m][1] = mfma32(t.vf[1][1], p1, O[m][1]);
    }
}
DI void diff_attn_wave(const Ctx& C, const Params& P, int l) {
    const bf16_t* PROJ = (const bf16_t*)(P.ws + WS_R1 + R1_PROJ); const bf16_t* VT = (const bf16_t*)(P.ws + WS_R1 + R1_VT); bf16_t* Y = wsp<bf16_t>(P, WS_Y);
    int bh, qs; causal_wave_unit(C.bid, C.wave, bh, qs);
    const int b = bh >> 2, hd = bh & 3, r = C.lane & 31, h = C.lane >> 5, tokb = b * SEQ, q0 = qs * 32, t = q0 + r;
    const float* lv = P.diff_lambda + l * 128;
    const float d1 = wave_sum(C.lane < 32 ? lv[C.lane] * lv[32 + C.lane] : 0.f), d2 = wave_sum(C.lane < 32 ? lv[64 + C.lane] * lv[96 + C.lane] : 0.f);
    const float lam_init = 0.8f - 0.6f * expf(-0.3f * (float)l), lam = expf(d1) - expf(d2) + lam_init;
    bf16x8 qf[2][2];
#pragma unroll
    for (int m = 0; m < 2; ++m)
#pragma unroll
        for (int s = 0; s < 2; ++s) qf[m][s] = *(const bf16x8*)(PROJ + (size_t)(tokb + t) * PROJ_LD + PC_AQ + hd * 64 + m * 32 + 16 * s + 8 * h);
    f32x16 O[2][2]; float mm[2] = {-1e30f, -1e30f}, ll[2] = {0.f, 0.f};
#pragma unroll
    for (int m = 0; m < 2; ++m) { O[m][0] = zero16(); O[m][1] = zero16(); }
    const float c = 0.17677669529663687f * 1.4426950408889634f;
    const int nkt = qs + 1; const unsigned dmask = causal_mask(r, h);
    const bf16_t* kbase = PROJ + (size_t)tokb * PROJ_LD + PC_AK + hd * 64;
    const bf16_t* vrow0 = VT + (size_t)(hd * 64 + r) * NTOK + tokb; const bf16_t* vrow1 = vrow0 + (size_t)32 * NTOK;
    DiffKV ta, tb; diff_load(ta, kbase, vrow0, vrow1, 0, r, h);
    for (int kt = 0; kt < nkt; kt += 2) {
        if (kt + 1 < nkt) diff_load(tb, kbase, vrow0, vrow1, (kt + 1) * 32, r, h);
        diff_step(ta, qf, kt == nkt - 1, dmask, c, mm, ll, O);
        if (kt + 1 < nkt) { if (kt + 2 < nkt) diff_load(ta, kbase, vrow0, vrow1, (kt + 2) * 32, r, h);
            diff_step(tb, qf, kt + 1 == nkt - 1, dmask, c, mm, ll, O); }
    }
    ll[0] += __shfl_xor(ll[0], 32); ll[1] += __shfl_xor(ll[1], 32);
    const float i0 = 1.0f / ll[0], i1 = lam / ll[1]; float ss = 0.f;
#pragma unroll
    for (int et = 0; et < 2; ++et)
#pragma unroll
        for (int i = 0; i < 16; ++i) { const float o = O[0][et][i] * i0 - O[1][et][i] * i1; O[0][et][i] = o; ss += o * o; }
    ss += __shfl_xor(ss, 32);
    const float rn = (1.0f - lam_init) / sqrtf(ss * (1.0f / 64.0f) + 1e-6f);
    bf16_t* yrow = Y + (size_t)(tokb + t) * DM + hd * 64;
#pragma unroll
    for (int et = 0; et < 2; ++et)
#pragma unroll
        for (int g = 0; g < 4; ++g) { u32x2 w; w.x = pk2(O[0][et][4 * g] * rn, O[0][et][4 * g + 1] * rn); w.y = pk2(O[0][et][4 * g + 2] * rn, O[0][et][4 * g + 3] * rn);
            *(u32x2*)(yrow + et * 32 + 8 * g + 4 * h) = w; }
}

struct KV64 { bf16x8 kf[4]; bf16x8 vf[2][2]; };
DI void kv64_load(KV64& t, const bf16_t* kbase, int kld, const bf16_t* vrow0, const bf16_t* vrow1, int k0, int r, int h) {
    const bf16_t* kp = kbase + (size_t)(k0 + r) * kld + 8 * h;
#pragma unroll
    for (int s = 0; s < 4; ++s) t.kf[s] = *(const bf16x8*)(kp + 16 * s);
#pragma unroll
    for (int s2 = 0; s2 < 2; ++s2) { t.vf[0][s2] = vt_frag(vrow0, k0, s2, h); t.vf[1][s2] = vt_frag(vrow1, k0, s2, h); }
}
DI void kv64_step(const KV64& t, const bf16x8 (&qf)[4], bool masked, unsigned vmask, const float c, float& mm, float& ll, f32x16 (&O)[2]) {
    f32x16 st = zero16();
#pragma unroll
    for (int s = 0; s < 4; ++s) st = mfma32(t.kf[s], qf[s], st);
    if (masked) apply_mask(st, vmask);
    bf16x8 p0, p1; sm_step(st, c, mm, ll, O[0], O[1], p0, p1);
    O[0] = mfma32(t.vf[0][0], p0, O[0]); O[0] = mfma32(t.vf[0][1], p1, O[0]);
    O[1] = mfma32(t.vf[1][0], p0, O[1]); O[1] = mfma32(t.vf[1][1], p1, O[1]);
}
DI void mem_attn_wave(const Ctx& C, const Params& P, int l) {
    const bf16_t* MQ = (const bf16_t*)(P.ws + WS_R1 + R1_MQ); bf16_t* MO = (bf16_t*)(P.ws + WS_R1 + R1_MO);
    const bf16_t* MK = wsp<bf16_t>(P, WS_MK) + (size_t)l * 1024 * 256; const bf16_t* MVT = wsp<bf16_t>(P, WS_MVT) + (size_t)l * 256 * 1024;
    const int r = C.lane & 31, h = C.lane >> 5;
    for (int wu = C.bid * NWAVES + C.wave; wu < 2048; wu += C.G * NWAVES) {
        const int bh = wu >> 7, qs = wu & 127, b = bh >> 2, hd = bh & 3, t = b * SEQ + qs * 32 + r;
        bf16x8 qf[4];
#pragma unroll
        for (int s = 0; s < 4; ++s) qf[s] = *(const bf16x8*)(MQ + (size_t)t * 256 + hd * 64 + 16 * s + 8 * h);
        f32x16 O[2] = {zero16(), zero16()}; float mm = -1e30f, ll = 0.f;
        const float c = 0.125f * 1.4426950408889634f;
        const bf16_t* kbase = MK + (size_t)(b * 256) * 256 + hd * 64;
        const bf16_t* vrow0 = MVT + (size_t)(hd * 64 + r) * 1024 + b * 256; const bf16_t* vrow1 = vrow0 + (size_t)32 * 1024;
        KV64 ta, tb; kv64_load(ta, kbase, 256, vrow0, vrow1, 0, r, h);
#pragma unroll 1
        for (int kt = 0; kt < 8; kt += 2) {
            kv64_load(tb, kbase, 256, vrow0, vrow1, (kt + 1) * 32, r, h);
            kv64_step(ta, qf, false, 0u, c, mm, ll, O);
            if (kt + 2 < 8) kv64_load(ta, kbase, 256, vrow0, vrow1, (kt + 2) * 32, r, h);
            kv64_step(tb, qf, false, 0u, c, mm, ll, O);
        }
        ll += __shfl_xor(ll, 32);
        const float il = 1.0f / ll; bf16_t* orow = MO + (size_t)t * 256 + hd * 64;
#pragma unroll
        for (int et = 0; et < 2; ++et)
#pragma unroll
            for (int g = 0; g < 4; ++g) { u32x2 w; w.x = pk2(O[et][4 * g] * il, O[et][4 * g + 1] * il); w.y = pk2(O[et][4 * g + 2] * il, O[et][4 * g + 3] * il);
                *(u32x2*)(orow + et * 32 + 8 * g + 4 * h) = w; }
    }
}

DI f32x16 idx_score(const bf16x8 (&ikf)[2], const bf16x8 (&iqf)[4][2], const float (&iw)[4]) {
    f32x16 a[4];
#pragma unroll
    for (int hh = 0; hh < 4; ++hh) a[hh] = mfma32(ikf[0], iqf[hh][0], zero16());
#pragma unroll
    for (int hh = 0; hh < 4; ++hh) a[hh] = mfma32(ikf[1], iqf[hh][1], a[hh]);
    f32x16 sc = zero16();
#pragma unroll
    for (int hh = 0; hh < 4; ++hh) {
#pragma unroll
        for (int i = 0; i < 16; ++i) sc[i] = fmaf(iw[hh], __builtin_amdgcn_fmed3f(a[hh][i], 0.f, __builtin_inff()), sc[i]); }
    return sc;
}
DI unsigned okey_of(float f) { const unsigned u = __float_as_uint(f); return u ^ ((unsigned)((int)u >> 31) | 0x80000000u); }
DI void load_idx_q(const bf16_t* PROJ, size_t tok, int h, bf16x8 (&iqf)[4][2], float (&iw)[4]) {
    const bf16_t* row = PROJ + tok * PROJ_LD;
#pragma unroll
    for (int hh = 0; hh < 4; ++hh) {
#pragma unroll
        for (int s = 0; s < 2; ++s) iqf[hh][s] = *(const bf16x8*)(row + PC_DIQ + hh * 32 + 16 * s + 8 * h);
        iw[hh] = bf2f(row[PC_DIW + hh]) * 0.08838834764831845f; }
}

template <int PASS> DI void d1_digit(unsigned ok, unsigned sinv, unsigned mv, unsigned mb, bool& match, unsigned& dg) {
    if constexpr (PASS == 0) { match = true; dg = ok >> 21; }
    else if constexpr (PASS == 1) { match = (ok >> 21) == mv; dg = (ok >> 10) & 2047u; }
    else if constexpr (PASS == 2) { match = (ok >> 10) == mv; dg = ((ok & 1023u) << 1) | (sinv >> 11); }
    else { match = (ok == mv) && ((sinv >> 11) == mb); dg = sinv & 2047u; }
}
constexpr int D1_HSTRIDE = 1025;
DI unsigned lin_bin(float sc, float lin_a, float lin_b) { return (unsigned)__builtin_amdgcn_fmed3f(fmaf(sc, lin_a, lin_b), 0.f, 2047.f); }
template <int PASS> DI void d1_pass(const Ctx& C, const bf16_t* PROJ, int tokb, int q0, int nkt, const bf16x8 (&iqf)[4][2], const float (&iw)[4], LAS unsigned* hist, volatile LAS unsigned* QS, const float lin_a = 0.f, const float lin_b = 0.f) {
    const int r = C.lane & 31, h = C.lane >> 5;
    const unsigned mv = QS[r * 4 + 0], mb = QS[r * 4 + 1];
    LAS unsigned* hrow = hist + r * D1_HSTRIDE;
    const bf16_t* kp0 = PROJ + (size_t)(tokb + r) * PROJ_LD + PC_DIK + 8 * h;
    bf16x8 ikf[2], ikn[2];
    if (C.wave < nkt) { const bf16_t* kp = kp0 + (size_t)(C.wave * 32) * PROJ_LD; ikf[0] = *(const bf16x8*)kp; ikf[1] = *(const bf16x8*)(kp + 16); }
    for (int kt = C.wave; kt < nkt; kt += NWAVES) {
        const int k0 = kt * 32;
        { const int ktn = (kt + NWAVES < nkt) ? kt + NWAVES : kt;
          const bf16_t* kp = kp0 + (size_t)(ktn * 32) * PROJ_LD; ikn[0] = *(const bf16x8*)kp; ikn[1] = *(const bf16x8*)(kp + 16); }
        const f32x16 sc = idx_score(ikf, iqf, iw);
        const bool diag = (kt == nkt - 1);
        unsigned wadr[16], wval[16]; bool any_m = false;
#pragma unroll
        for (int i = 0; i < 16; ++i) { const unsigned ok = okey_of(sc[i]), sinv = 4095u - (unsigned)(k0 + crow(i, h));
            bool match; unsigned dg;
            if constexpr (PASS == 4) { match = true; dg = lin_bin(sc[i], lin_a, lin_b); } else d1_digit<PASS>(ok, sinv, mv, mb, match, dg);
            if (diag) match = match && (crow(i, h) <= r);
            wadr[i] = match ? (dg >> 1) : 1024u;
            wval[i] = match ? (1u << ((dg & 1u) * 16u)) : 0u; any_m = any_m || match; }
        if (PASS == 0 || PASS == 4 || __any(any_m)) {
#pragma unroll
            for (int i = 0; i < 16; ++i) __hip_atomic_fetch_add(hrow + wadr[i], wval[i], __ATOMIC_RELAXED, __HIP_MEMORY_SCOPE_WORKGROUP);
        }
        ikf[0] = ikn[0]; ikf[1] = ikn[1];
    }
    __syncthreads();
    for (int srep = ((PROBE_DUP & 32768) ? 0 : 1); srep < 2; ++srep)
    for (int qq = 0; qq < 4; ++qq) {
        const int q = C.wave * 4 + qq; const unsigned rk = QS[q * 4 + 2];
        unsigned lsum = 0;
#pragma unroll
        for (int j = 0; j < 16; ++j) { const unsigned wj = hist[q * D1_HSTRIDE + C.lane * 16 + j]; lsum += (wj & 0xffffu) + (wj >> 16); }
        unsigned x = lsum;
#pragma unroll
        for (int o = 1; o < 64; o <<= 1) { const unsigned y = __shfl_down(x, o); if (C.lane + o < 64) x += y; }
        const unsigned above = x - lsum;
        const bool hit = (above < rk) && (rk <= x);
        const unsigned long long bal = __ballot(hit); const int L = bal ? (__ffsll((long long)bal) - 1) : 0;
        const unsigned aboveL = __shfl(above, L);
        const unsigned bk = (C.lane < 32) ? (unsigned)((const LAS unsigned short*)hist)[q * (2 * D1_HSTRIDE) + L * 32 + C.lane] : 0u;
        unsigned y2 = bk;
#pragma unroll
        for (int o = 1; o < 32; o <<= 1) { const unsigned z = __shfl_down(y2, o); if (C.lane + o < 32) y2 += z; }
        const unsigned ab2 = aboveL + y2 - bk;
        const bool hit2 = (C.lane < 32) && (ab2 < rk) && (rk <= ab2 + bk);
        const unsigned long long bal2 = __ballot(hit2); const int K2 = bal2 ? (__ffsll((long long)bal2) - 1) : 0;
        unsigned bin = (unsigned)(L * 32 + K2), rnew = rk - __shfl(ab2, K2);
        if (C.lane == 0 && srep == 1) {
            const unsigned omv = QS[q * 4 + 0];
            if constexpr (PASS == 0 || PASS == 4) { QS[q * 4 + 0] = bin; }
            else if constexpr (PASS == 1) { QS[q * 4 + 0] = (omv << 11) | bin; }
            else if constexpr (PASS == 2) { QS[q * 4 + 0] = (omv << 10) | (bin >> 1); QS[q * 4 + 1] = bin & 1u; }
            else { QS[q * 4 + 3] = bin; }
            QS[q * 4 + 2] = rnew;
        }
    }
    __syncthreads();
    if constexpr (PASS == 1 || PASS == 2) { for (int crep = 0; crep < ((PROBE_DUP & 65536) ? 2 : 1); ++crep) { for (int i = C.tid; i < 32 * D1_HSTRIDE; i += NTHREADS) hist[i] = 0u; __syncthreads(); } }
}
DI void dsa_select_unit(const Ctx& C, const Params& P, int l, int u) {
    const bf16_t* PROJ = (const bf16_t*)(P.ws + WS_R1 + R1_PROJ); unsigned short* MASK = wsp<unsigned short>(P, WS_MASK);
    const int qt = 127 - (u >> 2), b = u & 3, tokb = b * SEQ, q0 = qt * 32;
    unsigned short* mrow = MASK + ((size_t)(b * 128 + qt) * 128) * 64 + C.lane;
    if (q0 + 31 < 256) {
        for (int kt = C.wave; kt <= qt; kt += NWAVES) mrow[(size_t)kt * 64] = (unsigned short)((kt == qt) ? causal_mask(C.lane & 31, C.lane >> 5) : 0xffffu);
        return; }
    LAS unsigned* hist = (LAS unsigned*)C.lds; volatile LAS unsigned* QS = (volatile LAS unsigned*)(C.lds + 32 * D1_HSTRIDE * 4);
    for (int i = C.tid; i < 32 * D1_HSTRIDE; i += NTHREADS) hist[i] = 0u;
    if (C.tid < 32) { QS[C.tid * 4 + 0] = 0u; QS[C.tid * 4 + 1] = 0u; QS[C.tid * 4 + 2] = 256u; QS[C.tid * 4 + 3] = 0u; }
    __syncthreads();
    const int r = C.lane & 31, h = C.lane >> 5;
    bf16x8 iqf[4][2]; float iw[4]; load_idx_q(PROJ, (size_t)(tokb + q0 + r), h, iqf, iw);
    const int nkt = qt + 1;
    float lin_a, lin_b;
    { const float kmax = sqrtf(__uint_as_float(wsp<unsigned>(P, WS_CTL)[CW_KMAX + 8 * l + b]));
      float hi = 0.f, lo = 0.f;
#pragma unroll
      for (int hh = 0; hh < 4; ++hh) { float n2 = 0.f;
#pragma unroll
          for (int s2 = 0; s2 < 2; ++s2) { const u32x4 w = __builtin_bit_cast(u32x4, iqf[hh][s2]);
#pragma unroll
              for (int j = 0; j < 4; ++j) { const float x0 = bflo(w[j]), x1 = bfhi(w[j]); n2 += x0 * x0 + x1 * x1; } }
          n2 += __shfl_xor(n2, 32); const float bnd = 0.5f * kmax * fabsf(iw[hh]) * sqrtf(n2);
          if (iw[hh] > 0.f) hi += bnd; else lo -= bnd; }
      const float span = hi - lo; lin_a = span > 0.f ? 2047.0f / span : 0.f; lin_b = -lo * lin_a; }
    d1_pass<4>(C, PROJ, tokb, q0, nkt, iqf, iw, hist, QS, lin_a, lin_b);
    constexpr int CCAP = 384;
    LAS unsigned long long* CAND = (LAS unsigned long long*)C.lds;
    LAS unsigned short* LM = (LAS unsigned short*)(C.lds + 98304);
    LAS unsigned* ZBM = (LAS unsigned*)(C.lds + 114688);
    LAS unsigned* ccnt = (LAS unsigned*)(C.lds + 32 * D1_HSTRIDE * 4 + 512);
    if (C.tid < 33) ccnt[C.tid] = 0u;
    __syncthreads();
    {
        const unsigned b0 = QS[r * 4 + 0];
        const bf16_t* kp0 = PROJ + (size_t)(tokb + r) * PROJ_LD + PC_DIK + 8 * h;
        bf16x8 ikf[2], ikn[2];
        if (C.wave < nkt) { const bf16_t* kp = kp0 + (size_t)(C.wave * 32) * PROJ_LD; ikf[0] = *(const bf16x8*)kp; ikf[1] = *(const bf16x8*)(kp + 16); }
        for (int kt = C.wave; kt < nkt; kt += NWAVES) {
            const int k0 = kt * 32;
            { const int ktn = (kt + NWAVES < nkt) ? kt + NWAVES : kt;
              const bf16_t* kp = kp0 + (size_t)(ktn * 32) * PROJ_LD; ikn[0] = *(const bf16x8*)kp; ikn[1] = *(const bf16x8*)(kp + 16); }
            const f32x16 sc = idx_score(ikf, iqf, iw);
            const bool diag = (kt == nkt - 1);
            unsigned above = 0, cand = 0, zer = 0;
#pragma unroll
            for (int i = 0; i < 16; ++i) { const unsigned d0 = lin_bin(sc[i], lin_a, lin_b); const bool ok_c = !diag || (crow(i, h) <= r);
                const bool inb = ok_c && d0 == b0, isz = sc[i] == 0.0f;
                above |= (ok_c && d0 > b0) ? (1u << i) : 0u; cand |= (inb && !isz) ? (1u << i) : 0u; zer |= (inb && isz) ? (1u << i) : 0u; }
            LM[kt * 64 + C.lane] = (unsigned short)above;
            { unsigned kw = 0;
#pragma unroll
              for (int g = 0; g < 4; ++g) kw |= ((zer >> (4 * g)) & 0xfu) << (8 * g + 4 * h);
              kw |= __shfl_xor(kw, 32);
              if (h == 0) ZBM[r * 128 + kt] = kw; }
            if (__any(cand != 0u)) {
                const unsigned nc = (unsigned)__popc(cand);
                unsigned pos = nc ? __hip_atomic_fetch_add(ccnt + r, nc, __ATOMIC_RELAXED, __HIP_MEMORY_SCOPE_WORKGROUP) : 0u;
#pragma unroll
                for (int i = 0; i < 16; ++i) { const bool on = (cand >> i) & 1u;
                    if (on && pos < (unsigned)CCAP) CAND[r * CCAP + pos] = ((unsigned long long)okey_of(sc[i]) << 12) | (unsigned long long)(4095 - (k0 + crow(i, h)));
                    pos += on ? 1u : 0u; }
            }
            ikf[0] = ikn[0]; ikf[1] = ikn[1];
        }
    }
    __syncthreads();
    if (C.tid < 32 && ccnt[C.tid] > (unsigned)CCAP) ccnt[32] = 1u;
    __syncthreads();
    if (ccnt[32] == 0u || (PROBE_DUP & 16384)) {
        const unsigned long long ZK = 0x80000000ull << 12;
        for (int qq = 0; qq < 4; ++qq) {
            const int q = C.wave * 4 + qq; const unsigned n = ccnt[q]; unsigned rk = QS[q * 4 + 2];
            unsigned long long cv[6];
#pragma unroll
            for (int j = 0; j < 6; ++j) { const unsigned idx = (unsigned)C.lane + 64u * j; cv[j] = (idx < n) ? CAND[q * CCAP + idx] : 0ull; }
            unsigned z0 = (2 * C.lane < nkt) ? ZBM[q * 128 + 2 * C.lane] : 0u, z1 = (2 * C.lane + 1 < nkt) ? ZBM[q * 128 + 2 * C.lane + 1] : 0u;
            unsigned Pc = 0, Zc;
#pragma unroll
            for (int j = 0; j < 6; ++j) Pc += (unsigned)__popcll(__ballot(cv[j] >= ZK + 4096ull));
            { unsigned zc = (unsigned)(__popc(z0) + __popc(z1)); Zc = zc;
#pragma unroll
              for (int o = 32; o > 0; o >>= 1) Zc += __shfl_xor(Zc, o); }
            unsigned long long thr;
            unsigned mz = 0;
            if (rk <= Pc || rk > Pc + Zc) {
                if (rk > Pc + Zc) { mz = Zc; }
                const bool neg = rk > Pc + Zc; const unsigned rk2 = neg ? rk - Zc : rk;
                unsigned long long cur = 0ull;
                if (n <= 64u) {
                    for (int bit = 43; bit >= 0; --bit) { const unsigned long long T = cur | (1ull << bit); if ((unsigned)__popcll(__ballot(cv[0] != 0ull && cv[0] >= T)) >= rk2) cur = T; }
                } else {
                    for (int bit = 43; bit >= 0; --bit) { const unsigned long long T = cur | (1ull << bit); unsigned cnt = 0;
#pragma unroll
                        for (int j = 0; j < 6; ++j) cnt += (unsigned)__popcll(__ballot(cv[j] != 0ull && cv[j] >= T));
                        if (cnt >= rk2) cur = T; }
                }
                thr = cur;
            } else { thr = ZK + 4096ull; mz = rk - Pc; }
#pragma unroll
            for (int j = 0; j < 6; ++j) {
                if (cv[j] != 0ull && cv[j] >= thr) { const int key = 4095 - (int)(cv[j] & 4095ull), kt = key >> 5, kk = key & 31, hh = (kk >> 2) & 1, ii = (kk & 3) + 4 * (kk >> 3);
                    const int w16 = kt * 64 + q + 32 * hh;
                    __hip_atomic_fetch_or((LAS unsigned*)LM + (w16 >> 1), 1u << (16 * (w16 & 1) + ii), __ATOMIC_RELAXED, __HIP_MEMORY_SCOPE_WORKGROUP); } }
            if (mz > 0u) {
                const unsigned c0 = (unsigned)__popc(z0), c1 = (unsigned)__popc(z1); unsigned incl = c0 + c1;
#pragma unroll
                for (int o = 1; o < 64; o <<= 1) { const unsigned y = __shfl_up(incl, o); if (C.lane >= o) incl += y; }
                unsigned before = incl - (c0 + c1);
                unsigned need0 = (before >= mz) ? 0u : ((mz - before) < c0 ? (mz - before) : c0);
                while ((unsigned)__popc(z0) > need0) z0 &= ~(0x80000000u >> __clz(z0));
                before += c0;
                unsigned need1 = (before >= mz) ? 0u : ((mz - before) < c1 ? (mz - before) : c1);
                while ((unsigned)__popc(z1) > need1) z1 &= ~(0x80000000u >> __clz(z1));
#pragma unroll
                for (int tz = 0; tz < 2; ++tz) { const unsigned zw = tz ? z1 : z0; const int kt = 2 * C.lane + tz;
                    if (zw) {
#pragma unroll
                        for (int hh = 0; hh < 2; ++hh) { unsigned m16 = 0;
#pragma unroll
                            for (int g = 0; g < 4; ++g) m16 |= ((zw >> (8 * g + 4 * hh)) & 0xfu) << (4 * g);
                            const int w16 = kt * 64 + q + 32 * hh;
                            if (m16) __hip_atomic_fetch_or((LAS unsigned*)LM + (w16 >> 1), m16 << (16 * (w16 & 1)), __ATOMIC_RELAXED, __HIP_MEMORY_SCOPE_WORKGROUP); } } }
            }
        }
        __syncthreads();
        { const LAS unsigned* src = (const LAS unsigned*)LM; unsigned* dst = (unsigned*)(MASK + ((size_t)(b * 128 + qt) * 128) * 64);
          for (int i = C.tid; i < nkt * 32; i += NTHREADS) dst[i] = src[i]; }
        __syncthreads();
        return;
    }
    for (int i = C.tid; i < 32 * D1_HSTRIDE; i += NTHREADS) hist[i] = 0u;
    if (C.tid < 32) { QS[C.tid * 4 + 0] = 0u; QS[C.tid * 4 + 1] = 0u; QS[C.tid * 4 + 2] = 256u; QS[C.tid * 4 + 3] = 0u; }
    __syncthreads();
    d1_pass<0>(C, PROJ, tokb, q0, nkt, iqf, iw, hist, QS);
    for (int i = C.tid; i < 32 * D1_HSTRIDE; i += NTHREADS) hist[i] = 0u;
    __syncthreads();
    d1_pass<1>(C, PROJ, tokb, q0, nkt, iqf, iw, hist, QS);
    d1_pass<2>(C, PROJ, tokb, q0, nkt, iqf, iw, hist, QS);
    d1_pass<3>(C, PROJ, tokb, q0, nkt, iqf, iw, hist, QS);
    {
      const unsigned long long theta = ((unsigned long long)QS[r * 4 + 0] << 12) | ((unsigned long long)QS[r * 4 + 1] << 11) | QS[r * 4 + 3];
      for (int rep = 0; rep < ((PROBE_DUP & 4096) ? 2 : 1); ++rep)
      for (int kt = C.wave; kt < nkt; kt += NWAVES) {
          const int k0 = kt * 32; bf16x8 ikf[2];
          const bf16_t* kp = PROJ + (size_t)(tokb + k0 + r) * PROJ_LD + PC_DIK + 8 * h;
          ikf[0] = *(const bf16x8*)kp; ikf[1] = *(const bf16x8*)(kp + 16);
          const f32x16 sc = idx_score(ikf, iqf, iw);
          unsigned vmask = 0;
#pragma unroll
          for (int i = 0; i < 16; ++i) { const int key = k0 + crow(i, h); const unsigned long long comp = ((unsigned long long)okey_of(sc[i]) << 12) | (unsigned long long)(4095 - key);
              vmask |= (key <= q0 + r && comp >= theta) ? (1u << i) : 0u; }
          mrow[(size_t)kt * 64] = (unsigned short)vmask; } }
    __syncthreads();
}

DI void dsa_attn_wave(const Ctx& C, const Params& P) {
    const bf16_t* PROJ = (const bf16_t*)(P.ws + WS_R1 + R1_PROJ); const bf16_t* VT = (const bf16_t*)(P.ws + WS_R1 + R1_VT); bf16_t* Y = wsp<bf16_t>(P, WS_Y);
    const unsigned short* MASK = wsp<unsigned short>(P, WS_MASK);
    int bh, qs; causal_wave_unit(C.bid, C.wave, bh, qs);
    const int b = bh >> 2, hd = bh & 3, r = C.lane & 31, h = C.lane >> 5, tokb = b * SEQ, q0 = qs * 32, t = q0 + r;
    bf16x8 qf[4];
#pragma unroll
    for (int s = 0; s < 4; ++s) qf[s] = *(const bf16x8*)(PROJ + (size_t)(tokb + t) * PROJ_LD + PC_DQ + hd * 64 + 16 * s + 8 * h);
    f32x16 O[2] = {zero16(), zero16()}; float mm = -1e30f, ll = 0.f;
    const float c = 0.125f * 1.4426950408889634f;
    const int nkt = qs + 1;
    const bf16_t* kbase = PROJ + (size_t)tokb * PROJ_LD + PC_DK;
    const bf16_t* vrow0 = VT + (size_t)(256 + r) * NTOK + tokb; const bf16_t* vrow1 = vrow0 + (size_t)32 * NTOK;
    const unsigned short* mrow = MASK + ((size_t)(b * 128 + qs) * 128) * 64 + C.lane;
    KV64 ta, tb; unsigned ma, mb;
    kv64_load(ta, kbase, PROJ_LD, vrow0, vrow1, 0, r, h); ma = mrow[0];
    for (int kt = 0; kt < nkt; kt += 2) {
        if (kt + 1 < nkt) { kv64_load(tb, kbase, PROJ_LD, vrow0, vrow1, (kt + 1) * 32, r, h); mb = mrow[(size_t)(kt + 1) * 64]; }
        kv64_step(ta, qf, true, ma, c, mm, ll, O);
        if (kt + 1 < nkt) { if (kt + 2 < nkt) { kv64_load(ta, kbase, PROJ_LD, vrow0, vrow1, (kt + 2) * 32, r, h); ma = mrow[(size_t)(kt + 2) * 64]; }
            kv64_step(tb, qf, true, mb, c, mm, ll, O); }
    }
    ll += __shfl_xor(ll, 32);
    const float il = 1.0f / ll; bf16_t* yrow = Y + (size_t)(tokb + t) * DM + 768 + hd * 64;
#pragma unroll
    for (int et = 0; et < 2; ++et)
#pragma unroll
        for (int g = 0; g < 4; ++g) { u32x2 w; w.x = pk2(O[et][4 * g] * il, O[et][4 * g + 1] * il); w.y = pk2(O[et][4 * g + 2] * il, O[et][4 * g + 3] * il);
            *(u32x2*)(yrow + et * 32 + 8 * g + 4 * h) = w; }
}

constexpr int CA_KB = 64 * 144, CA_VB = 64 * 136, CA_BUF = CA_KB + CA_VB;
template <bool DIFF>
DI void causal_attn_block(const Ctx& C, const Params& P, int l) {
    const bf16_t* PROJ = (const bf16_t*)(P.ws + WS_R1 + R1_PROJ); const bf16_t* VT = (const bf16_t*)(P.ws + WS_R1 + R1_VT); bf16_t* Y = wsp<bf16_t>(P, WS_Y);
    const unsigned short* MASK = wsp<unsigned short>(P, WS_MASK);
    const int bh = (C.bid >> 4) & 15, g = C.bid & 15, j0 = 4 * g, b = bh >> 2, hd = bh & 3, tokb = b * SEQ;
#if (PROBE_DUP & 262144)
    const int qs = ((C.wave & 1) == 0) ? 127 - (j0 + (C.wave >> 1)) : j0 + (C.wave >> 1);
#else
    const int qs = (C.wave < 4) ? 127 - (j0 + C.wave) : j0 + (C.wave - 4);
#endif
    const int r = C.lane & 31, h = C.lane >> 5, q0 = qs * 32, t = q0 + r;
    const int nsub = qs + 1, NT = (128 - j0 + 1) >> 1;
    const int kcol = DIFF ? PC_AK + hd * 64 : PC_DK, vrb = DIFF ? hd * 64 : 256;
    const int srow = C.tid >> 3, sch = C.tid & 7;
    const bf16_t* kg = PROJ + (size_t)(tokb + srow) * PROJ_LD + kcol + sch * 8;
    const bf16_t* vg = VT + (size_t)(vrb + srow) * NTOK + tokb + sch * 8;
    LAS unsigned char* kdst = C.lds + srow * 144 + sch * 16; LAS unsigned char* vdst = C.lds + CA_KB + srow * 136 + sch * 16;
    bf16x8 qfd[2][2], qf4[4];
    if constexpr (DIFF) {
#pragma unroll
        for (int m = 0; m < 2; ++m)
#pragma unroll
            for (int s = 0; s < 2; ++s) qfd[m][s] = *(const bf16x8*)(PROJ + (size_t)(tokb + t) * PROJ_LD + PC_AQ + hd * 64 + m * 32 + 16 * s + 8 * h);
    } else {
#pragma unroll
        for (int s = 0; s < 4; ++s) qf4[s] = *(const bf16x8*)(PROJ + (size_t)(tokb + t) * PROJ_LD + PC_DQ + hd * 64 + 16 * s + 8 * h);
    }
    f32x16 O[2][2]; float mm[2] = {-1e30f, -1e30f}, ll[2] = {0.f, 0.f};
#pragma unroll
    for (int m = 0; m < 2; ++m) { O[m][0] = zero16(); O[m][1] = zero16(); }
    const float c = (DIFF ? 0.17677669529663687f : 0.125f) * 1.4426950408889634f;
    const unsigned dmask = causal_mask(r, h);
    const unsigned short* mrow = MASK + ((size_t)(b * 128 + qs) * 128) * 64 + C.lane;
    u32x4 kreg = *(const u32x4*)kg, vreg = *(const u32x4*)vg, kr2, vr2;
    unsigned mcur[2] = {0u, 0u}, mnxt[2] = {0u, 0u}, mn2[2] = {0u, 0u};
    if constexpr (!DIFF) { mcur[0] = mrow[0]; if (1 < nsub) mcur[1] = mrow[64]; if (2 < nsub) mnxt[0] = mrow[128]; if (3 < nsub) mnxt[1] = mrow[192]; }
    *(LAS u32x4*)kdst = kreg; *(LAS u32x2*)vdst = (u32x2){vreg.x, vreg.y}; *(LAS u32x2*)(vdst + 8) = (u32x2){vreg.z, vreg.w};
    if (1 < NT) { kreg = *(const u32x4*)(kg + (size_t)64 * PROJ_LD); vreg = *(const u32x4*)(vg + 64); }
    __syncthreads();
    for (int T = 0; T < NT; ++T) {
        const int cur = T & 1;
        if (T + 2 < NT) { kr2 = *(const u32x4*)(kg + (size_t)(T + 2) * 64 * PROJ_LD); vr2 = *(const u32x4*)(vg + (T + 2) * 64);
            if constexpr (!DIFF) { if (2 * T + 4 < nsub) mn2[0] = mrow[(size_t)(2 * T + 4) * 64]; if (2 * T + 5 < nsub) mn2[1] = mrow[(size_t)(2 * T + 5) * 64]; } }
        const LAS unsigned char* KB = C.lds + cur * CA_BUF; const LAS unsigned char* VB = KB + CA_KB;
#pragma unroll
        for (int sub = 0; sub < 2; ++sub) {
            const int st = 2 * T + sub;
            if (st < nsub) {
                const LAS unsigned char* krow = KB + (sub * 32 + r) * 144 + h * 16;
                const LAS unsigned char* v0 = VB + r * 136 + (sub * 32 + 4 * h) * 2; const LAS unsigned char* v1 = v0 + 32 * 136;
                if constexpr (DIFF) {
                    DiffKV tl;
#pragma unroll
                    for (int m = 0; m < 2; ++m)
#pragma unroll
                        for (int s = 0; s < 2; ++s) tl.kf[m][s] = *(const LAS bf16x8*)(krow + m * 64 + s * 32);
#pragma unroll
                    for (int s2 = 0; s2 < 2; ++s2) {
                        { const u32x2 lo = *(const LAS u32x2*)(v0 + s2 * 32), hi = *(const LAS u32x2*)(v0 + s2 * 32 + 16); u32x4 w; w.x = lo.x; w.y = lo.y; w.z = hi.x; w.w = hi.y; tl.vf[0][s2] = __builtin_bit_cast(bf16x8, w); }
                        { const u32x2 lo = *(const LAS u32x2*)(v1 + s2 * 32), hi = *(const LAS u32x2*)(v1 + s2 * 32 + 16); u32x4 w; w.x = lo.x; w.y = lo.y; w.z = hi.x; w.w = hi.y; tl.vf[1][s2] = __builtin_bit_cast(bf16x8, w); } }
                    diff_step(tl, qfd, st == nsub - 1, dmask, c, mm, ll, O);
                } else {
                    KV64 tl; const unsigned vm = mcur[sub];
#pragma unroll
                    for (int s = 0; s < 4; ++s) tl.kf[s] = *(const LAS bf16x8*)(krow + s * 32);
#pragma unroll
                    for (int s2 = 0; s2 < 2; ++s2) {
                        { const u32x2 lo = *(const LAS u32x2*)(v0 + s2 * 32), hi = *(const LAS u32x2*)(v0 + s2 * 32 + 16); u32x4 w; w.x = lo.x; w.y = lo.y; w.z = hi.x; w.w = hi.y; tl.vf[0][s2] = __builtin_bit_cast(bf16x8, w); }
                        { const u32x2 lo = *(const LAS u32x2*)(v1 + s2 * 32), hi = *(const LAS u32x2*)(v1 + s2 * 32 + 16); u32x4 w; w.x = lo.x; w.y = lo.y; w.z = hi.x; w.w = hi.y; tl.vf[1][s2] = __builtin_bit_cast(bf16x8, w); } }
                    kv64_step(tl, qf4, true, vm, c, mm[0], ll[0], O[0]);
                }
            }
        }
        if (T + 1 < NT) { LAS unsigned char* kd = kdst + (cur ^ 1) * CA_BUF; LAS unsigned char* vd = vdst + (cur ^ 1) * CA_BUF;
            *(LAS u32x4*)kd = kreg; *(LAS u32x2*)vd = (u32x2){vreg.x, vreg.y}; *(LAS u32x2*)(vd + 8) = (u32x2){vreg.z, vreg.w}; }
        kreg = kr2; vreg = vr2; mcur[0] = mnxt[0]; mcur[1] = mnxt[1]; mnxt[0] = mn2[0]; mnxt[1] = mn2[1];
        __syncthreads();
    }
    if constexpr (DIFF) {
        const float* lv = P.diff_lambda + l * 128;
        const float d1 = wave_sum(C.lane < 32 ? lv[C.lane] * lv[32 + C.lane] : 0.f), d2 = wave_sum(C.lane < 32 ? lv[64 + C.lane] * lv[96 + C.lane] : 0.f);
        const float lam_init = 0.8f - 0.6f * expf(-0.3f * (float)l), lam = expf(d1) - expf(d2) + lam_init;
        ll[0] += __shfl_xor(ll[0], 32); ll[1] += __shfl_xor(ll[1], 32);
        const float i0 = 1.0f / ll[0], i1 = lam / ll[1]; float ss = 0.f;
#pragma unroll
        for (int et = 0; et < 2; ++et)
#pragma unroll
            for (int i = 0; i < 16; ++i) { const float o = O[0][et][i] * i0 - O[1][et][i] * i1; O[0][et][i] = o; ss += o * o; }
        ss += __shfl_xor(ss, 32);
        const float rn = (1.0f - lam_init) / sqrtf(ss * (1.0f / 64.0f) + 1e-6f);
        bf16_t* yrow = Y + (size_t)(tokb + t) * DM + hd * 64;
#pragma unroll
        for (int et = 0; et < 2; ++et)
#pragma unroll
            for (int gq = 0; gq < 4; ++gq) { u32x2 w; w.x = pk2(O[0][et][4 * gq] * rn, O[0][et][4 * gq + 1] * rn); w.y = pk2(O[0][et][4 * gq + 2] * rn, O[0][et][4 * gq + 3] * rn);
                *(u32x2*)(yrow + et * 32 + 8 * gq + 4 * h) = w; }
    } else {
        ll[0] += __shfl_xor(ll[0], 32);
        const float il = 1.0f / ll[0]; bf16_t* yrow = Y + (size_t)(tokb + t) * DM + 768 + hd * 64;
#pragma unroll
        for (int et = 0; et < 2; ++et)
#pragma unroll
            for (int gq = 0; gq < 4; ++gq) { u32x2 w; w.x = pk2(O[0][et][4 * gq] * il, O[0][et][4 * gq + 1] * il); w.y = pk2(O[0][et][4 * gq + 2] * il, O[0][et][4 * gq + 3] * il);
                *(u32x2*)(yrow + et * 32 + 8 * gq + 4 * h) = w; }
    }
    __syncthreads();
}

constexpr int CB_KB = 128 * 144, CB_VB = 64 * 264, CB_BUF = CB_KB + CB_VB;
template <bool DIFF>
DI void causal_attn_unit2(const Ctx& C, const Params& P, int l, int bh, int G) {
    const bf16_t* PROJ = (const bf16_t*)(P.ws + WS_R1 + R1_PROJ); const bf16_t* VT = (const bf16_t*)(P.ws + WS_R1 + R1_VT); bf16_t* Y = wsp<bf16_t>(P, WS_Y);
    const unsigned short* MASK = wsp<unsigned short>(P, WS_MASK);
    const int b = bh >> 2, hd = bh & 3, tokb = b * SEQ;
    const int qs = 4 * G + (C.wave & 3), par = C.wave >> 2;
    const int r = C.lane & 31, h = C.lane >> 5, q0 = qs * 32, t = q0 + r;
    const int NT = G + 1;
    const int kcol = DIFF ? PC_AK + hd * 64 : PC_DK, vrb = DIFF ? hd * 64 : 256;
    const int srow = C.tid >> 3, sch = C.tid & 7;
    const bf16_t* kg = PROJ + (size_t)(tokb + srow) * PROJ_LD + kcol + sch * 8;
    const bf16_t* vg = VT + (size_t)(vrb + srow) * NTOK + tokb + sch * 8;
    LAS unsigned char* kdst = C.lds + srow * 144 + sch * 16; LAS unsigned char* vdst = C.lds + CB_KB + srow * 264 + sch * 16;
    bf16x8 qfd[2][2], qf4[4];
    if constexpr (DIFF) {
#pragma unroll
        for (int m = 0; m < 2; ++m)
#pragma unroll
            for (int s = 0; s < 2; ++s) qfd[m][s] = *(const bf16x8*)(PROJ + (size_t)(tokb + t) * PROJ_LD + PC_AQ + hd * 64 + m * 32 + 16 * s + 8 * h);
    } else {
#pragma unroll
        for (int s = 0; s < 4; ++s) qf4[s] = *(const bf16x8*)(PROJ + (size_t)(tokb + t) * PROJ_LD + PC_DQ + hd * 64 + 16 * s + 8 * h);
    }
    f32x16 O[2][2]; float mm[2] = {-1e30f, -1e30f}, ll[2] = {0.f, 0.f};
#pragma unroll
    for (int m = 0; m < 2; ++m) { O[m][0] = zero16(); O[m][1] = zero16(); }
    const float c = (DIFF ? 0.17677669529663687f : 0.125f) * 1.4426950408889634f;
    const unsigned dmask = causal_mask(r, h);
    const unsigned short* mrow = MASK + ((size_t)(b * 128 + qs) * 128) * 64 + C.lane;
    u32x4 kr[2], vr[2];
#define CB_GLOAD(T_) do { kr[0] = *(const u32x4*)(kg + (size_t)((T_) * 128) * PROJ_LD); kr[1] = *(const u32x4*)(kg + (size_t)((T_) * 128 + 64) * PROJ_LD); \
        vr[0] = *(const u32x4*)(vg + (T_) * 128); vr[1] = *(const u32x4*)(vg + (T_) * 128 + 64); } while (0)
#define CB_LSTORE(buf_) do { LAS unsigned char* kd_ = kdst + (buf_) * CB_BUF; LAS unsigned char* vd_ = vdst + (buf_) * CB_BUF; \
        *(LAS u32x4*)kd_ = kr[0]; *(LAS u32x4*)(kd_ + 64 * 144) = kr[1]; \
        *(LAS u32x2*)vd_ = (u32x2){vr[0].x, vr[0].y}; *(LAS u32x2*)(vd_ + 8) = (u32x2){vr[0].z, vr[0].w}; \
        *(LAS u32x2*)(vd_ + 128) = (u32x2){vr[1].x, vr[1].y}; *(LAS u32x2*)(vd_ + 136) = (u32x2){vr[1].z, vr[1].w}; } while (0)
    unsigned mcur[2] = {0u, 0u}, mnxt[2] = {0u, 0u};
    if constexpr (!DIFF) { if (par <= qs) mcur[0] = mrow[(size_t)par * 64]; if (par + 2 <= qs) mcur[1] = mrow[(size_t)(par + 2) * 64]; }
    CB_GLOAD(0); CB_LSTORE(0);
    __syncthreads();
    int cur = 0;
    for (int T = 0; T < NT; ++T) {
        const int nxb = (cur == 2) ? 0 : cur + 1;
        if (T + 1 < NT) { CB_GLOAD(T + 1);
            if constexpr (!DIFF) { const int s0 = 4 * (T + 1) + par; if (s0 <= qs) mnxt[0] = mrow[(size_t)s0 * 64]; if (s0 + 2 <= qs) mnxt[1] = mrow[(size_t)(s0 + 2) * 64]; } }
        const LAS unsigned char* KB = C.lds + cur * CB_BUF; const LAS unsigned char* VB = KB + CB_KB;
#pragma unroll
        for (int k2 = 0; k2 < 2; ++k2) {
            if (k2 == 1 && par == 1) { if (T + 1 < NT) CB_LSTORE(nxb); __syncthreads(); }
            const int sub = par + 2 * k2, st = 4 * T + sub;
            if (st <= qs) {
                const LAS unsigned char* krow = KB + (sub * 32 + r) * 144 + h * 16;
                const LAS unsigned char* v0 = VB + r * 264 + (sub * 32 + 4 * h) * 2; const LAS unsigned char* v1 = v0 + 32 * 264;
                if constexpr (DIFF) {
                    DiffKV tl;
#pragma unroll
                    for (int m = 0; m < 2; ++m)
#pragma unroll
                        for (int s = 0; s < 2; ++s) tl.kf[m][s] = *(const LAS bf16x8*)(krow + m * 64 + s * 32);
#pragma unroll
                    for (int s2 = 0; s2 < 2; ++s2) {
                        { const u32x2 lo = *(const LAS u32x2*)(v0 + s2 * 32), hi = *(const LAS u32x2*)(v0 + s2 * 32 + 16); u32x4 w; w.x = lo.x; w.y = lo.y; w.z = hi.x; w.w = hi.y; tl.vf[0][s2] = __builtin_bit_cast(bf16x8, w); }
                        { const u32x2 lo = *(const LAS u32x2*)(v1 + s2 * 32), hi = *(const LAS u32x2*)(v1 + s2 * 32 + 16); u32x4 w; w.x = lo.x; w.y = lo.y; w.z = hi.x; w.w = hi.y; tl.vf[1][s2] = __builtin_bit_cast(bf16x8, w); } }
                    diff_step(tl, qfd, st == qs, dmask, c, mm, ll, O);
                } else {
                    KV64 tl; const unsigned vm = mcur[k2];
#pragma unroll
                    for (int s = 0; s < 4; ++s) tl.kf[s] = *(const LAS bf16x8*)(krow + s * 32);
#pragma unroll
                    for (int s2 = 0; s2 < 2; ++s2) {
                        { const u32x2 lo = *(const LAS u32x2*)(v0 + s2 * 32), hi = *(const LAS u32x2*)(v0 + s2 * 32 + 16); u32x4 w; w.x = lo.x; w.y = lo.y; w.z = hi.x; w.w = hi.y; tl.vf[0][s2] = __builtin_bit_cast(bf16x8, w); }
                        { const u32x2 lo = *(const LAS u32x2*)(v1 + s2 * 32), hi = *(const LAS u32x2*)(v1 + s2 * 32 + 16); u32x4 w; w.x = lo.x; w.y = lo.y; w.z = hi.x; w.w = hi.y; tl.vf[1][s2] = __builtin_bit_cast(bf16x8, w); } }
                    kv64_step(tl, qf4, true, vm, c, mm[0], ll[0], O[0]);
                }
            }
        }
        if (par == 0) { if (T + 1 < NT) CB_LSTORE(nxb); __syncthreads(); }
        mcur[0] = mnxt[0]; mcur[1] = mnxt[1]; cur = nxb;
    }
#undef CB_GLOAD
#undef CB_LSTORE
    constexpr int NM = DIFF ? 2 : 1, NV = NM * 34;
    LAS float* MA = (LAS float*)C.lds + (size_t)(C.wave & 3) * 64 * NV + C.lane;
    __syncthreads();
    if (par == 1) {
#pragma unroll
        for (int m = 0; m < NM; ++m) { MA[(m * 34 + 0) * 64] = mm[m]; MA[(m * 34 + 1) * 64] = ll[m];
#pragma unroll
            for (int et = 0; et < 2; ++et)
#pragma unroll
                for (int i = 0; i < 16; ++i) MA[(m * 34 + 2 + et * 16 + i) * 64] = O[m][et][i]; }
    }
    __syncthreads();
    if (par == 0) {
#pragma unroll
        for (int m = 0; m < NM; ++m) { const float mB = MA[(m * 34 + 0) * 64], lB = MA[(m * 34 + 1) * 64];
            const float mn = fmaxf(mm[m], mB), aA = __builtin_amdgcn_exp2f((mm[m] - mn) * c), aB = __builtin_amdgcn_exp2f((mB - mn) * c);
            ll[m] = ll[m] * aA + lB * aB;
#pragma unroll
            for (int et = 0; et < 2; ++et)
#pragma unroll
                for (int i = 0; i < 16; ++i) O[m][et][i] = O[m][et][i] * aA + MA[(m * 34 + 2 + et * 16 + i) * 64] * aB; }
        if constexpr (DIFF) {
            const float* lv = P.diff_lambda + l * 128;
            const float d1 = wave_sum(C.lane < 32 ? lv[C.lane] * lv[32 + C.lane] : 0.f), d2 = wave_sum(C.lane < 32 ? lv[64 + C.lane] * lv[96 + C.lane] : 0.f);
            const float lam_init = 0.8f - 0.6f * expf(-0.3f * (float)l), lam = expf(d1) - expf(d2) + lam_init;
            ll[0] += __shfl_xor(ll[0], 32); ll[1] += __shfl_xor(ll[1], 32);
            const float i0 = 1.0f / ll[0], i1 = lam / ll[1]; float ss = 0.f;
#pragma unroll
            for (int et = 0; et < 2; ++et)
#pragma unroll
                for (int i = 0; i < 16; ++i) { const float o = O[0][et][i] * i0 - O[1][et][i] * i1; O[0][et][i] = o; ss += o * o; }
            ss += __shfl_xor(ss, 32);
            const float rn = (1.0f - lam_init) / sqrtf(ss * (1.0f / 64.0f) + 1e-6f);
            bf16_t* yrow = Y + (size_t)(tokb + t) * DM + hd * 64;
#pragma unroll
            for (int et = 0; et < 2; ++et)
#pragma unroll
                for (int gq = 0; gq < 4; ++gq) { u32x2 w; w.x = pk2(O[0][et][4 * gq] * rn, O[0][et][4 * gq + 1] * rn); w.y = pk2(O[0][et][4 * gq + 2] * rn, O[0][et][4 * gq + 3] * rn);
                    *(u32x2*)(yrow + et * 32 + 8 * gq + 4 * h) = w; }
        } else {
            ll[0] += __shfl_xor(ll[0], 32);
            const float il = 1.0f / ll[0]; bf16_t* yrow = Y + (size_t)(tokb + t) * DM + 768 + hd * 64;
#pragma unroll
            for (int et = 0; et < 2; ++et)
#pragma unroll
                for (int gq = 0; gq < 4; ++gq) { u32x2 w; w.x = pk2(O[0][et][4 * gq] * il, O[0][et][4 * gq + 1] * il); w.y = pk2(O[0][et][4 * gq + 2] * il, O[0][et][4 * gq + 3] * il);
                    *(u32x2*)(yrow + et * 32 + 8 * gq + 4 * h) = w; }
        }
    }
    __syncthreads();
}
template <bool DIFF>
DI void causal_attn_block2(const Ctx& C, const Params& P, int l) {
    const int bh = (C.bid >> 4) & 15, gi = C.bid & 15;
    causal_attn_unit2<DIFF>(C, P, l, bh, 31 - gi);
    causal_attn_unit2<DIFF>(C, P, l, bh, gi);
}

DI void mem_attn_block(const Ctx& C, const Params& P, int l) {
    const bf16_t* MQ = (const bf16_t*)(P.ws + WS_R1 + R1_MQ); bf16_t* MO = (bf16_t*)(P.ws + WS_R1 + R1_MO);
    const bf16_t* MK = wsp<bf16_t>(P, WS_MK) + (size_t)l * 1024 * 256; const bf16_t* MVT = wsp<bf16_t>(P, WS_MVT) + (size_t)l * 256 * 1024;
    const int bh = (C.bid >> 4) & 15, grp = C.bid & 15, b = bh >> 2, hd = bh & 3, r = C.lane & 31, h = C.lane >> 5;
    const int t = b * SEQ + (grp * 8 + C.wave) * 32 + r;
    bf16x8 qf[4];
#pragma unroll
    for (int s = 0; s < 4; ++s) qf[s] = *(const bf16x8*)(MQ + (size_t)t * 256 + hd * 64 + 16 * s + 8 * h);
    { u32x4 kr[4], vr[4];
#pragma unroll
      for (int j = 0; j < 4; ++j) { const int ci = C.tid + 512 * j;
          kr[j] = *(const u32x4*)(MK + (size_t)(b * 256 + (ci >> 3)) * 256 + hd * 64 + (ci & 7) * 8);
          vr[j] = *(const u32x4*)(MVT + (size_t)(hd * 64 + (ci >> 5)) * 1024 + b * 256 + (ci & 31) * 8); }
#pragma unroll
      for (int j = 0; j < 4; ++j) { const int ci = C.tid + 512 * j;
          *(LAS u32x4*)(C.lds + (ci >> 3) * 144 + (ci & 7) * 16) = kr[j];
          LAS unsigned char* vd = C.lds + 36864 + (ci >> 5) * 520 + (ci & 31) * 16;
          *(LAS u32x2*)vd = (u32x2){vr[j].x, vr[j].y}; *(LAS u32x2*)(vd + 8) = (u32x2){vr[j].z, vr[j].w}; } }
    __syncthreads();
    f32x16 O[2] = {zero16(), zero16()}; float mm = -1e30f, ll = 0.f;
    const float c = 0.125f * 1.4426950408889634f;
#pragma unroll 2
    for (int kt = 0; kt < 8; ++kt) {
        KV64 tl; const LAS unsigned char* krow = C.lds + (kt * 32 + r) * 144 + h * 16;
        const LAS unsigned char* v0 = C.lds + 36864 + r * 520 + (kt * 32 + 4 * h) * 2; const LAS unsigned char* v1 = v0 + 32 * 520;
#pragma unroll
        for (int s = 0; s < 4; ++s) tl.kf[s] = *(const LAS bf16x8*)(krow + s * 32);
#pragma unroll
        for (int s2 = 0; s2 < 2; ++s2) {
            { const u32x2 lo = *(const LAS u32x2*)(v0 + s2 * 32), hi = *(const LAS u32x2*)(v0 + s2 * 32 + 16); u32x4 w; w.x = lo.x; w.y = lo.y; w.z = hi.x; w.w = hi.y; tl.vf[0][s2] = __builtin_bit_cast(bf16x8, w); }
            { const u32x2 lo = *(const LAS u32x2*)(v1 + s2 * 32), hi = *(const LAS u32x2*)(v1 + s2 * 32 + 16); u32x4 w; w.x = lo.x; w.y = lo.y; w.z = hi.x; w.w = hi.y; tl.vf[1][s2] = __builtin_bit_cast(bf16x8, w); } }
        kv64_step(tl, qf, false, 0u, c, mm, ll, O);
    }
    ll += __shfl_xor(ll, 32);
    const float il = 1.0f / ll; bf16_t* orow = MO + (size_t)t * 256 + hd * 64;
#pragma unroll
    for (int et = 0; et < 2; ++et)
#pragma unroll
        for (int g = 0; g < 4; ++g) { u32x2 w; w.x = pk2(O[et][4 * g] * il, O[et][4 * g + 1] * il); w.y = pk2(O[et][4 * g + 2] * il, O[et][4 * g + 3] * il);
            *(u32x2*)(orow + et * 32 + 8 * g + 4 * h) = w; }
    __syncthreads();
}
DI void mma_lds(f32x16& acc, const LAS bf16_t* A, int lda, const LAS bf16_t* Bt, int ldb, int K, int lane) {
    const int r = lane & 31, h = lane >> 5;
    for (int k0 = 0; k0 < K; k0 += 16) {
        const bf16x8 a = *(const LAS bf16x8*)(A + r * lda + k0 + 8 * h);
        const bf16x8 b = *(const LAS bf16x8*)(Bt + r * ldb + k0 + 8 * h);
        acc = mfma32(a, b, acc);
    }
}

constexpr int HG_BC = 0, HG_QT = 32768, HG_KT = 50176, HG_VT = 67584, HG_ST = 86016, HG_AT = 104448;
DI float hgrn_lb(const Params& P, int l, int ch) { if (l == 0) return 0.f; const float z0 = P.hgrn_lb[ch], z1 = P.hgrn_lb[256 + ch]; return 1.0f / (1.0f + expf(z0 - z1)); }
DI void hgrn_cumsum(const Ctx& C, const Params& P, int l, const float (&fpv)[16], int ch0) {
    LAS float* BC = (LAS float*)(C.lds + HG_BC);
    const float lb = hgrn_lb(P, l, ch0 + (C.tid & 127));
#pragma unroll
    for (int j = 0; j < 16; ++j) { const float f = lb + (1.0f - lb) * frcp(1.0f + fexp(fminf(-fpv[j], 80.f))); BC[C.tid + 512 * j] = flog(fmaxf(f, 1e-30f)); }
    __syncthreads();
    if (C.tid < 128) { float cum = 0.f;
#pragma unroll 8
        for (int s = 0; s < 64; ++s) { cum += BC[s * 128 + C.tid]; BC[s * 128 + C.tid] = cum; } }
    __syncthreads();
}
DI void hgrn_local_unit(const Ctx& C, const Params& P, int l, int u) {
    const bf16_t* PROJ = (const bf16_t*)(P.ws + WS_R1 + R1_PROJ); float* HS = wsp<float>(P, WS_HS); float* HD = wsp<float>(P, WS_HD);
    const int hp = u & 1, bc = u >> 1, b = bc >> 6, c = bc & 63, tok0 = b * SEQ + c * 64, ch0 = hp * 128;
    LAS float* BC = (LAS float*)(C.lds + HG_BC); LAS bf16_t* KT = (LAS bf16_t*)(C.lds + HG_QT);   LAS bf16_t* VT = (LAS bf16_t*)(C.lds + HG_VT);
    const int cl = C.tid & 127, ch = ch0 + cl; const float lb = hgrn_lb(P, l, ch);
    float fpv[16]; bf16_t vv[16];
#pragma unroll
    for (int j = 0; j < 16; ++j) { const bf16_t* row = PROJ + (size_t)(tok0 + (C.tid >> 7) + 4 * j) * PROJ_LD; fpv[j] = bf2f(row[PC_BF + ch]); vv[j] = row[PC_BI + ch]; }
    hgrn_cumsum(C, P, l, fpv, ch0);
#pragma unroll
    for (int j = 0; j < 16; ++j) { const int s = (C.tid >> 7) + 4 * j; const float kk = (1.0f - lb) * frcp(1.0f + fexp(fminf(fpv[j], 80.f)));
        KT[cl * 72 + s] = f2bf(kk * fexp(BC[63 * 128 + cl] - BC[s * 128 + cl])); VT[cl * 72 + s] = vv[j]; }
    if (C.tid < 128) HD[(size_t)bc * 256 + ch0 + C.tid] = fexp(BC[63 * 128 + C.tid]);
    __syncthreads();
    { const int h2 = C.wave >> 2, dkt = (C.wave >> 1) & 1, dvt = C.wave & 1, r = C.lane & 31, h = C.lane >> 5;
      f32x16 acc = zero16();
      mma_lds(acc, KT + (h2 * 64 + dkt * 32) * 72, 72, VT + (h2 * 64 + dvt * 32) * 72, 72, 64, C.lane);
      float* dst = HS + ((size_t)(bc * 4 + hp * 2 + h2) * 64) * 64;
#pragma unroll
      for (int i = 0; i < 16; ++i) dst[(dkt * 32 + crow(i, h)) * 64 + dvt * 32 + r] = acc[i]; }
    __syncthreads();
}
DI void hgrn_scan_unit(const Ctx& C, const Params& P, int u) {
    float* HS = wsp<float>(P, WS_HS); const float* HD = wsp<float>(P, WS_HD);
    const int id = u * NTHREADS + C.tid;
    const int bh = id >> 12, e = id & 4095, b = bh >> 2, hh = bh & 3, dk = e >> 6;
    float Lv[64], Dv[64];
#pragma unroll
    for (int c = 0; c < 64; ++c) { const size_t bc = (size_t)b * 64 + c; Lv[c] = HS[((bc * 4 + hh) << 12) + e]; Dv[c] = HD[bc * 256 + hh * 64 + dk]; }
    float S = 0.f;
#pragma unroll
    for (int c = 0; c < 64; ++c) { const size_t bc = (size_t)b * 64 + c; HS[((bc * 4 + hh) << 12) + e] = S; S = Dv[c] * S + Lv[c]; }
}
DI void hgrn_out_unit(const Ctx& C, const Params& P, int l, int u) {
    const bf16_t* PROJ = (const bf16_t*)(P.ws + WS_R1 + R1_PROJ); const float* HS = wsp<float>(P, WS_HS); bf16_t* Y = wsp<bf16_t>(P, WS_Y);
    const int hp = u & 1, bc = u >> 1, b = bc >> 6, c = bc & 63, tok0 = b * SEQ + c * 64, ch0 = hp * 128;
    LAS float* BC = (LAS float*)(C.lds + HG_BC); LAS bf16_t* QT = (LAS bf16_t*)(C.lds + HG_QT); LAS bf16_t* KT = (LAS bf16_t*)(C.lds + HG_KT);
    LAS bf16_t* VT = (LAS bf16_t*)(C.lds + HG_VT); LAS bf16_t* ST = (LAS bf16_t*)(C.lds + HG_ST); LAS bf16_t* AT = (LAS bf16_t*)(C.lds + HG_AT);
    const int cl = C.tid & 127, ch = ch0 + cl; const float lb = hgrn_lb(P, l, ch);
    float fpv[16], qv16[16], sp16[16]; bf16_t vv[16];
#pragma unroll
    for (int j = 0; j < 16; ++j) { const bf16_t* row = PROJ + (size_t)(tok0 + (C.tid >> 7) + 4 * j) * PROJ_LD; fpv[j] = bf2f(row[PC_BF + ch]); qv16[j] = bf2f(row[PC_BQ + ch]); vv[j] = row[PC_BI + ch];
        sp16[j] = HS[(((size_t)bc * 4 + hp * 2) << 12) + C.tid + 512 * j]; }
    hgrn_cumsum(C, P, l, fpv, ch0);
#pragma unroll
    for (int j = 0; j < 16; ++j) { const int s = (C.tid >> 7) + 4 * j; const float kk = (1.0f - lb) * frcp(1.0f + fexp(fminf(fpv[j], 80.f)));
        const float q = qv16[j] * frcp(1.0f + fexp(fminf(-qv16[j], 80.f)));
        const float bs = BC[s * 128 + cl], br = BC[31 * 128 + cl];
        QT[s * 136 + cl] = f2bf(q * fexp(fminf(bs - br, 80.f)));
        KT[s * 136 + cl] = f2bf(kk * fexp(fminf(br - bs, 80.f)));
        VT[cl * 72 + s] = vv[j]; }
#pragma unroll
    for (int j = 0; j < 16; ++j) { const int i = C.tid + 512 * j, h2 = i >> 12, e = i & 4095, dk = e >> 6, dv = e & 63;
        ST[(h2 * 64 + dv) * 72 + dk] = f2bf(sp16[j] * fexp(BC[31 * 128 + h2 * 64 + dk])); }
    __syncthreads();
    {
      const int h2 = C.wave >> 2, tt = (C.wave >> 1) & 1, st = C.wave & 1, r = C.lane & 31, h = C.lane >> 5;
      if (st <= tt) { f32x16 acc = zero16();
          mma_lds(acc, QT + (tt * 32) * 136 + h2 * 64, 136, KT + (st * 32) * 136 + h2 * 64, 136, 64, C.lane);
#pragma unroll
          for (int i = 0; i < 16; ++i) { const int t = tt * 32 + crow(i, h), s = st * 32 + r; AT[(h2 * 64 + t) * 72 + s] = (s <= t) ? f2bf(acc[i]) : (bf16_t)0; } } }
    __syncthreads();
    if (C.wave < 4) {
      const int h2 = C.wave >> 1, tt = C.wave & 1, r = C.lane & 31, h = C.lane >> 5;
      f32x16 o[2] = {zero16(), zero16()};
#pragma unroll
      for (int dvt = 0; dvt < 2; ++dvt) {
          mma_lds(o[dvt], VT + (h2 * 64 + dvt * 32) * 72, 72, AT + (h2 * 64 + tt * 32) * 72, 72, (tt + 1) * 32, C.lane);
          mma_lds(o[dvt], ST + (h2 * 64 + dvt * 32) * 72, 72, QT + (tt * 32) * 136 + h2 * 64, 136, 64, C.lane); }
      float ss = 0.f;
#pragma unroll
      for (int dvt = 0; dvt < 2; ++dvt)
#pragma unroll
          for (int i = 0; i < 16; ++i) ss += o[dvt][i] * o[dvt][i];
      ss += __shfl_xor(ss, 32);
      const float rn = 1.0f / sqrtf(ss * (1.0f / 64.0f) + 1e-6f);
      const int t = tok0 + tt * 32 + r, chb = ch0 + h2 * 64;
      const bf16_t* grow = PROJ + (size_t)t * PROJ_LD + PC_BG + chb; bf16_t* yrow = Y + (size_t)t * DM + 256 + chb;
#pragma unroll
      for (int dvt = 0; dvt < 2; ++dvt)
#pragma unroll
          for (int g = 0; g < 4; ++g) { const int dv = dvt * 32 + 8 * g + 4 * h; const u32x2 gw = *(const u32x2*)(grow + dv);
              const float g0 = siluf_(bflo(gw.x)), g1 = siluf_(bfhi(gw.x)), g2 = siluf_(bflo(gw.y)), g3 = siluf_(bfhi(gw.y));
              u32x2 w; w.x = pk2(o[dvt][4 * g] * rn * g0, o[dvt][4 * g + 1] * rn * g1); w.y = pk2(o[dvt][4 * g + 2] * rn * g2, o[dvt][4 * g + 3] * rn * g3);
              *(u32x2*)(yrow + dv) = w; } }
    __syncthreads();
}

DI void sgu_unit(const Ctx& C, const Params& P, int l, int u) {
    const bf16_t* PROJ = (const bf16_t*)(P.ws + WS_R1 + R1_PROJ); bf16_t* Y = wsp<bf16_t>(P, WS_Y); const bf16_t* SW = wsp<bf16_t>(P, W_SGU);
    const float* sb = P.spatial_b + l * 512;
    LAS bf16_t* VT = (LAS bf16_t*)C.lds; const int tok0 = (u >> 1) * 128, half = u & 1;
    u32x2 wv[16];
#pragma unroll
    for (int j = 0; j < 16; ++j) wv[j] = *(const u32x2*)(PROJ + (size_t)(tok0 + C.wave + NWAVES * j) * PROJ_LD + PC_CV + C.lane * 4);
#pragma unroll
    for (int j = 0; j < 16; ++j) {
        const int s = C.wave + NWAVES * j; const u32x2 w = wv[j];
        float v[4] = {gelu_tanh(bflo(w.x)), gelu_tanh(bfhi(w.x)), gelu_tanh(bflo(w.y)), gelu_tanh(bfhi(w.y))};
        const float mu = wave_sum(v[0] + v[1] + v[2] + v[3]) * (1.0f / 256.0f);
        float q = 0.f;
#pragma unroll
        for (int jj = 0; jj < 4; ++jj) { v[jj] -= mu; q += v[jj] * v[jj]; }
        const float rs = 1.0f / sqrtf(wave_sum(q) * (1.0f / 256.0f) + 1e-6f);
#pragma unroll
        for (int jj = 0; jj < 4; ++jj) VT[(C.lane * 4 + jj) * 136 + s] = f2bf(v[jj] * rs);
    }
    __syncthreads();
    { const int g = C.wave >> 1, dt = C.wave & 1, r = C.lane & 31, h = C.lane >> 5;
      for (int ti = 0; ti < 2; ++ti) { const int tt = half ? (1 + ti) : (ti * 3);
          f32x16 acc = zero16();
          const bf16_t* wrow = SW + ((size_t)g * 128 + tt * 32 + r) * 128 + 8 * h;
          const LAS bf16_t* vrow = VT + (g * 64 + dt * 32 + r) * 136 + 8 * h;
          for (int k0 = 0; k0 < (tt + 1) * 32; k0 += 16) { const bf16x8 a = *(const bf16x8*)(wrow + k0); const bf16x8 bb = *(const LAS bf16x8*)(vrow + k0); acc = mfma32(a, bb, acc); }
          const int ch = g * 64 + dt * 32 + r;
#pragma unroll
          for (int i = 0; i < 16; ++i) { const int t = tt * 32 + crow(i, h); const size_t tok = (size_t)(tok0 + t);
              const float uu = gelu_tanh(bf2f(PROJ[tok * PROJ_LD + PC_CU + ch]));
              Y[tok * DM + 512 + ch] = f2bf(uu * (acc[i] + sb[g * 128 + t])); } } }
    __syncthreads();
}

DI void phase_router(const Ctx& C, const Params& P, int l, const bool dry = false) {
    float* XR = P.out; bf16_t* H = wsp<bf16_t>(P, WS_H);
    int* TOKE = wsp<int>(P, WS_TOKE); float* TOKW = wsp<float>(P, WS_TOKW); int* RANK = wsp<int>(P, WS_RANK); int* ROWTOK = dry ? wsp<int>(P, WS_DUMMY) : wsp<int>(P, WS_ROWTOK);
    unsigned* CNT = wsp<unsigned>(P, WS_CTL) + CW_CNT + 64 * l + (dry ? 256 : 0);
    const float* gain = P.norm_ffn + l * DM;
    const float* brg = P.b_rg + l * 4; const float* bre = P.b_re + l * 32;
    LAS bf16_t* XHL = (LAS bf16_t*)C.lds; LAS float* PART = (LAS float*)C.lds; LAS float* LOG = (LAS float*)(C.lds + 32768);
    LAS unsigned* lcnt = (LAS unsigned*)(C.lds + LDS_MISC + 1024); LAS unsigned* lbase = lcnt + 32;
    if (C.tid < 32) lcnt[C.tid] = 0u;
    __syncthreads();
    const int per = NTOK / C.G;
    const int r = C.lane & 31, h = C.lane >> 5;
    for (int it = 0; it < per; it += 32) {
        const int tok0 = C.bid * per + it;
        { f32x4 v[4][4];
#pragma unroll
          for (int j = 0; j < 4; ++j) { const float* xr = XR + (size_t)(tok0 + C.wave * 4 + j) * DM;
#pragma unroll
              for (int q = 0; q < 4; ++q) v[j][q] = *(const f32x4*)(xr + q * 256 + C.lane * 4); }
#pragma unroll
          for (int j = 0; j < 4; ++j) { const int tl = C.wave * 4 + j, t = tok0 + tl; float ss = 0.f;
#pragma unroll
              for (int q = 0; q < 4; ++q) ss += v[j][q][0] * v[j][q][0] + v[j][q][1] * v[j][q][1] + v[j][q][2] * v[j][q][2] + v[j][q][3] * v[j][q][3];
              ss = wave_sum(ss); const float rs = 1.0f / sqrtf(ss * (1.0f / DM) + 1e-6f);
#pragma unroll
              for (int q = 0; q < 4; ++q) { const int c = q * 256 + C.lane * 4; const f32x4 g = *(const f32x4*)(gain + c);
                  const f32x4 o = (f32x4){v[j][q][0] * rs * g[0], v[j][q][1] * rs * g[1], v[j][q][2] * rs * g[2], v[j][q][3] * rs * g[3]};
                  u32x2 w; w.x = pk2(o[0], o[1]); w.y = pk2(o[2], o[3]); *(u32x2*)(H + (size_t)t * DM + c) = w;
                  { u32x2 wl; wl.x = pk2(o[0] - bflo(w.x), o[1] - bfhi(w.x)); wl.y = pk2(o[2] - bflo(w.y), o[3] - bfhi(w.y));
                    *(LAS u32x2*)(XHL + tl * 1032 + c) = w; *(LAS u32x2*)(XHL + 33024 + tl * 1032 + c) = wl; } } } }
        __syncthreads();
        f32x16 acc = zero16();
        { const int ct = C.wave & 1, kq = C.wave >> 1;
          const LAS bf16_t* ah = XHL + r * 1032 + kq * 256 + 8 * h; const LAS bf16_t* al = ah + 33024;
          const bf16_t* bh_ = wsp<bf16_t>(P, W_RH) + (size_t)(ct * 32 + r) * 1024 + kq * 256 + 8 * h; const bf16_t* bl_ = bh_ + (size_t)64 * 1024;
#pragma unroll 4
          for (int k0 = 0; k0 < 256; k0 += 16) { const bf16x8 xh = *(const LAS bf16x8*)(ah + k0), xl = *(const LAS bf16x8*)(al + k0);
              const bf16x8 wh = *(const bf16x8*)(bh_ + k0), wl = *(const bf16x8*)(bl_ + k0);
              acc = mfma32(xh, wh, acc); acc = mfma32(xh, wl, acc); acc = mfma32(xl, wh, acc); } }
        __syncthreads();
#pragma unroll
        for (int i = 0; i < 16; ++i) PART[(C.wave * 16 + i) * 64 + C.lane] = acc[i];
        __syncthreads();
        for (int idx = C.tid; idx < 32 * 36; idx += NTHREADS) { const int tok = idx / 36, col = idx % 36, ct = col < 32 ? 0 : 1, cc = col < 32 ? col : col - 32;
            const int hh = (tok >> 2) & 1, reg = (tok & 3) + 4 * (tok >> 3); float s = 0.f;
#pragma unroll
            for (int kq = 0; kq < 4; ++kq) s += PART[((kq * 2 + ct) * 16 + reg) * 64 + cc + 32 * hh];
            LOG[tok * 36 + col] = s; }
        __syncthreads();
        if (C.tid < 32) { const int t = tok0 + C.tid; const LAS float* lg = LOG + C.tid * 36;
            float gl[4]; int gsel = 0;
#pragma unroll
            for (int k = 0; k < 4; ++k) gl[k] = lg[32 + k] + brg[k];
            float gmax = gl[0];
#pragma unroll
            for (int k = 1; k < 4; ++k) if (gl[k] > gmax) { gmax = gl[k]; gsel = k; }
            float gsum = 0.f;
#pragma unroll
            for (int k = 0; k < 4; ++k) gsum += expf(gl[k] - gmax);
            const float pg = 1.0f / gsum;
            float pe[8]; float emax = -1e30f;
#pragma unroll
            for (int k = 0; k < 8; ++k) { pe[k] = lg[gsel * 8 + k] + bre[gsel * 8 + k]; emax = fmaxf(emax, pe[k]); }
#pragma unroll
            for (int k = 0; k < 8; ++k) pe[k] = expf(pe[k] - emax);
            int i1 = 0; float p1 = pe[0];
#pragma unroll
            for (int k = 1; k < 8; ++k) if (pe[k] > p1) { p1 = pe[k]; i1 = k; }
            int i2 = (i1 == 0) ? 1 : 0; float p2 = pe[i2];
#pragma unroll
            for (int k = 0; k < 8; ++k) if (k != i1 && pe[k] > p2) { p2 = pe[k]; i2 = k; }
            const float inv = pg / (p1 + p2);
            const int e1 = gsel * 8 + i1, e2 = gsel * 8 + i2;
            TOKE[t * 2] = e1; TOKE[t * 2 + 1] = e2; TOKW[t * 2] = p1 * inv; TOKW[t * 2 + 1] = p2 * inv;
            RANK[t * 2] = (int)__hip_atomic_fetch_add(lcnt + e1, 1u, __ATOMIC_RELAXED, __HIP_MEMORY_SCOPE_WORKGROUP);
            RANK[t * 2 + 1] = (int)__hip_atomic_fetch_add(lcnt + e2, 1u, __ATOMIC_RELAXED, __HIP_MEMORY_SCOPE_WORKGROUP); }
        __syncthreads();
    }
    if (C.tid < 32) { const unsigned n = lcnt[C.tid]; lbase[C.tid] = n ? __hip_atomic_fetch_add(CNT + C.tid, n, __ATOMIC_RELAXED, __HIP_MEMORY_SCOPE_AGENT) : 0u; }
    __syncthreads();
    asm volatile("s_waitcnt vmcnt(0)" ::: "memory");
    for (int a = C.tid; a < per * 2; a += NTHREADS) { const int ga = C.bid * per * 2 + a; const int e = TOKE[ga]; const unsigned rk = lbase[e] + (unsigned)RANK[ga];
        ROWTOK[(size_t)e * MOE_CAP + rk] = ga; }
    __syncthreads();
}
typedef f32x4 AccT[2][2][4][2];
DI u32x4 pack8(const f32x4& a, const f32x4& b) { u32x4 w; w.x = pk2(a[0], a[1]); w.y = pk2(a[2], a[3]); w.z = pk2(b[0], b[1]); w.w = pk2(b[2], b[3]); return w; }
template <int ACT> struct EpiStore {
    bf16_t* O; int ldc;
    DI void operator()(const AccT& acc, const pg8::Unit& u, int wr, int wc, int fr, int fq) const {
#pragma unroll
        for (int ai = 0; ai < 2; ++ai)
#pragma unroll
            for (int m = 0; m < 4; ++m) { const size_t row = (size_t)(u.pm * 256 + ai * 128 + wr * 64 + m * 16 + fr);
#pragma unroll
                for (int bj = 0; bj < 2; ++bj) { const int col = u.pn * 256 + bj * 128 + wc * 32 + 8 * fq; f32x4 a = acc[ai][bj][m][0], b = acc[ai][bj][m][1];
                    if (ACT == 1) {
#pragma unroll
                        for (int j = 0; j < 4; ++j) { a[j] = sigmoidf_(a[j]); b[j] = sigmoidf_(b[j]); } }
                    *(u32x4*)(O + row * ldc + col) = pack8(a, b); } }
    }
};
struct EpiMerge {
    const bf16_t* GATE; bf16_t* MG;
    DI void operator()(const AccT& acc, const pg8::Unit& u, int wr, int wc, int fr, int fq) const {
#pragma unroll
        for (int ai = 0; ai < 2; ++ai)
#pragma unroll
            for (int m = 0; m < 4; ++m) { const size_t row = (size_t)(u.pm * 256 + ai * 128 + wr * 64 + m * 16 + fr);
#pragma unroll
                for (int bj = 0; bj < 2; ++bj) { const int col = u.pn * 256 + bj * 128 + wc * 32 + 8 * fq;
                    const u32x4 g = *(const u32x4*)(GATE + row * 4096 + u.x * 1024 + col);
                    f32x4 a = acc[ai][bj][m][0], b = acc[ai][bj][m][1];
                    a[0] *= bflo(g.x); a[1] *= bfhi(g.x); a[2] *= bflo(g.y); a[3] *= bfhi(g.y); b[0] *= bflo(g.z); b[1] *= bfhi(g.z); b[2] *= bflo(g.w); b[3] *= bfhi(g.w);
                    bf16_t* dst = MG + row * 1024 + col;
                    if (u.x > 0) { const u32x4 p = *(const u32x4*)dst;
                        a[0] += bflo(p.x); a[1] += bfhi(p.x); a[2] += bflo(p.y); a[3] += bfhi(p.y); b[0] += bflo(p.z); b[1] += bfhi(p.z); b[2] += bflo(p.w); b[3] += bfhi(p.w); }
                    *(u32x4*)dst = pack8(a, b); }
                asm volatile("" ::: "memory"); }
    }
};
struct EpiResid {
    float* XR;
    DI void operator()(const AccT& acc, const pg8::Unit& u, int wr, int wc, int fr, int fq) const {
#pragma unroll
        for (int ai = 0; ai < 2; ++ai)
#pragma unroll
            for (int m = 0; m < 4; ++m) { const size_t row = (size_t)(u.pm * 256 + ai * 128 + wr * 64 + m * 16 + fr);
#pragma unroll
                for (int bj = 0; bj < 2; ++bj) { float* p = XR + row * 1024 + u.pn * 256 + bj * 128 + wc * 32 + 8 * fq;
                    const f32x4 x0 = *(const f32x4*)p, x1 = *(const f32x4*)(p + 4);
                    *(f32x4*)p = x0 + acc[ai][bj][m][0]; *(f32x4*)(p + 4) = x1 + acc[ai][bj][m][1]; }
                if (m == 3) asm volatile("" ::: "memory"); }
    }
};
struct EpiResidNorm {
    float* XR; bf16_t* XB; float* RSS;
    DI void operator()(const AccT& acc, const pg8::Unit& u, int wr, int wc, int fr, int fq) const {
#pragma unroll
        for (int ai = 0; ai < 2; ++ai)
#pragma unroll
            for (int m = 0; m < 4; ++m) { const size_t row = (size_t)(u.pm * 256 + ai * 128 + wr * 64 + m * 16 + fr); float ss = 0.f;
#pragma unroll
                for (int bj = 0; bj < 2; ++bj) { const size_t off = row * 1024 + u.pn * 256 + bj * 128 + wc * 32 + 8 * fq; float* p = XR + off;
                    const f32x4 x0 = *(const f32x4*)p + acc[ai][bj][m][0], x1 = *(const f32x4*)(p + 4) + acc[ai][bj][m][1];
                    *(f32x4*)p = x0; *(f32x4*)(p + 4) = x1; *(u32x4*)(XB + off) = pack8(x0, x1);
                    ss += (x0[0] * x0[0] + x0[1] * x0[1]) + (x0[2] * x0[2] + x0[3] * x0[3]) + (x1[0] * x1[0] + x1[1] * x1[1]) + (x1[2] * x1[2] + x1[3] * x1[3]); }
                ss += __shfl_xor(ss, 16); ss += __shfl_xor(ss, 32);
                if (fq == 0) RSS[row * 16 + u.pn * 4 + wc] = ss;
                if (m == 3) asm volatile("" ::: "memory"); }
    }
};
struct EpiStoreRstd {
    bf16_t* O; int ldc; const float* RSS;
    DI void operator()(const AccT& acc, const pg8::Unit& u, int wr, int wc, int fr, int fq) const {
#pragma unroll
        for (int ai = 0; ai < 2; ++ai)
#pragma unroll
            for (int m = 0; m < 4; ++m) { const size_t row = (size_t)(u.pm * 256 + ai * 128 + wr * 64 + m * 16 + fr);
                const f32x4* rp = (const f32x4*)(RSS + row * 16); const f32x4 r0 = rp[0], r1 = rp[1], r2 = rp[2], r3 = rp[3];
                const float rsum = ((r0[0] + r0[1]) + (r0[2] + r0[3])) + ((r1[0] + r1[1]) + (r1[2] + r1[3])) + ((r2[0] + r2[1]) + (r2[2] + r2[3])) + ((r3[0] + r3[1]) + (r3[2] + r3[3]));
                const float rs = 1.0f / sqrtf(rsum * (1.0f / 1024.0f) + 1e-6f);
#pragma unroll
                for (int bj = 0; bj < 2; ++bj) { const int col = u.pn * 256 + bj * 128 + wc * 32 + 8 * fq;
                    *(u32x4*)(O + row * ldc + col) = pack8(acc[ai][bj][m][0] * rs, acc[ai][bj][m][1] * rs); } }
    }
};
struct EpiGU {
    bf16_t* HID;
    DI void operator()(const AccT& acc, const pg8::Unit& u, int wr, int wc, int fr, int fq) const {
#pragma unroll
        for (int ai = 0; ai < 2; ++ai)
#pragma unroll
            for (int m = 0; m < 4; ++m) { const size_t row = (size_t)(u.pm * 256 + ai * 128 + wr * 64 + m * 16 + fr);
                f32x4 a, b;
#pragma unroll
                for (int j = 0; j < 4; ++j) { a[j] = siluf_(acc[ai][0][m][0][j]) * acc[ai][1][m][0][j]; b[j] = siluf_(acc[ai][0][m][1][j]) * acc[ai][1][m][1][j]; }
                *(u32x4*)(HID + row * 256 + u.pn * 128 + wc * 32 + 8 * fq) = pack8(a, b); }
    }
};
struct EpiDown {
    bf16_t* YB; const int* ROWTOK; const float* TOKW; const LAS int* cnt;
    DI void operator()(const AccT& acc, const pg8::Unit& u, int wr, int wc, int fr, int fq) const {
        const int ce = cnt[u.x];
#pragma unroll
        for (int ai = 0; ai < 2; ++ai)
#pragma unroll
            for (int m = 0; m < 4; ++m) { const int idx = u.y * 256 + ai * 128 + wr * 64 + m * 16 + fr;
                if (idx < ce) { const int a = ROWTOK[(size_t)u.x * MOE_CAP + idx]; const float w = TOKW[a];
#pragma unroll
                    for (int bj = 0; bj < 2; ++bj) { const int col = u.pn * 256 + bj * 128 + wc * 32 + 8 * fq;
                        *(u32x4*)(YB + (size_t)a * 1024 + col) = pack8(acc[ai][bj][m][0] * w, acc[ai][bj][m][1] * w); } } }
    }
};

struct FusedMergeOrder {
    const char* Hb; const char* Yb; const char* Wg; const char* Wb; int G, c;
    DI bool next(int i, pg8::Unit& u) const {
        const int ti = i >> 3, x = i & 7, n = x >> 1; const long L = (long)ti * G + c; if (L >= 256) return false;
        pg8::tile_map((int)L, 64, 4, u.pm, u.pn); u.x = x; u.y = 0;
        if (x & 1) { u.a = Yb + (size_t)u.pm * 256 * 1024 * 2 + (size_t)n * 256 * 2; u.b = Wb + (size_t)u.pn * 256 * 1024 * 2 + (size_t)n * 256 * 2; u.nt = 4; }
        else { u.a = Hb + (size_t)u.pm * 256 * 1024 * 2; u.b = Wg + ((size_t)n * 1024 + (size_t)u.pn * 256) * 1024 * 2; u.nt = 16; }
        return true; }
    DI unsigned row_off(const pg8::Unit&, int) const { return 0u; }
};
struct EpiFusedMerge {
    bf16_t* GS; bf16_t* MG; int tid;
    DI void operator()(const AccT& acc, const pg8::Unit& u, int wr, int wc, int fr, int fq) const {
        u32x4* gs = (u32x4*)GS + tid;
        if ((u.x & 1) == 0) {
#pragma unroll
            for (int ai = 0; ai < 2; ++ai)
#pragma unroll
                for (int m = 0; m < 4; ++m)
#pragma unroll
                    for (int bj = 0; bj < 2; ++bj) { f32x4 a = acc[ai][bj][m][0], b = acc[ai][bj][m][1];
#pragma unroll
                        for (int j = 0; j < 4; ++j) { a[j] = sigmoidf_(a[j]); b[j] = sigmoidf_(b[j]); }
                        gs[((ai * 4 + m) * 2 + bj) * 512] = pack8(a, b); }
        } else {
#pragma unroll
            for (int ai = 0; ai < 2; ++ai)
#pragma unroll
                for (int m = 0; m < 4; ++m) { const size_t row = (size_t)(u.pm * 256 + ai * 128 + wr * 64 + m * 16 + fr);
#pragma unroll
                    for (int bj = 0; bj < 2; ++bj) { const int col = u.pn * 256 + bj * 128 + wc * 32 + 8 * fq;
                        const u32x4 g = gs[((ai * 4 + m) * 2 + bj) * 512];
                        f32x4 a = acc[ai][bj][m][0], b = acc[ai][bj][m][1];
                        a[0] *= bflo(g.x); a[1] *= bfhi(g.x); a[2] *= bflo(g.y); a[3] *= bfhi(g.y); b[0] *= bflo(g.z); b[1] *= bfhi(g.z); b[2] *= bflo(g.w); b[3] *= bfhi(g.w);
                        bf16_t* dst = MG + row * 1024 + col;
                        if (u.x > 1) { const u32x4 p = *(const u32x4*)dst;
                            a[0] += bflo(p.x); a[1] += bfhi(p.x); a[2] += bflo(p.y); a[3] += bfhi(p.y); b[0] += bflo(p.z); b[1] += bfhi(p.z); b[2] += bflo(p.w); b[3] += bfhi(p.w); }
                        *(u32x4*)dst = pack8(a, b); }
                    if (m == 3) asm volatile("" ::: "memory"); }
        }
    }
};
constexpr int MOE_TAB = LDS_MISC + 256;
DI void moe_build_table(const Ctx& C, const unsigned* CNT) {
    volatile LAS int* T = (volatile LAS int*)(C.lds + MOE_TAB);
    if (C.tid == 0) { int acc = 0; for (int e = 0; e < 32; ++e) { const int n = (int)CNT[e]; T[e] = acc; T[40 + e] = n; const int nt = (n + 255) >> 8;
            for (int j = 0; j < nt; ++j) T[80 + acc + j] = (e << 8) | j;
            acc += nt; } T[32] = acc; }
    __syncthreads();
}
template <int NPN, bool GU> struct MoeOrder {
    const LAS int* T; const char* Ab; const char* Wb; const int* ROWTOK; int G, c;
    DI bool next(int i, pg8::Unit& u) const {
        const long L = (long)i * G + c; const int tile = (int)(L / NPN), pn = (int)(L % NPN);
        if (tile >= __builtin_amdgcn_readfirstlane(T[32])) return false;
        const int ej = __builtin_amdgcn_readfirstlane(T[80 + tile]); const int e = ej >> 8;
        u.x = e; u.y = ej & 255; u.pm = tile; u.pn = pn; u.nt = 0;
        if (GU) { u.a = Ab; u.b = Wb + ((size_t)e * 512 + (size_t)pn * 256) * 1024 * 2; }
        else { u.a = Ab + (size_t)tile * 256 * 256 * 2; u.b = Wb + ((size_t)e * 1024 + (size_t)pn * 256) * 256 * 2; }
        return true; }
    DI unsigned row_off(const pg8::Unit& u, int row) const {
        const int idx = u.y * 256 + row; int tok = 0;
        if (idx < T[40 + u.x]) tok = ROWTOK[(size_t)u.x * MOE_CAP + idx] >> 1;
        return (unsigned)tok * 2048u; }
};

constexpr int PH_PER_LAYER = 16, PH_L0 = 1, N_PHASES = PH_L0 + DEPTH * PH_PER_LAYER + 1;
#ifndef ENABLE_MASK
#define ENABLE_MASK 0xFF
#endif
#ifndef PROBE_DUP
#define PROBE_DUP 0
#endif
#define NREP(bit) ((PROBE_DUP & (bit)) ? 2 : 1)
#define ZIGZAG(n, call) do { for (int _rd = 0; _rd * C.G < (n); ++_rd) { const int u = _rd * C.G + ((_rd & 1) ? (C.G - 1 - C.bid) : C.bid); if (u < (n)) { call; } } } while (0)

typedef const Params __attribute__((address_space(4))) KParams;
#if defined(__HIP_DEVICE_COMPILE__)
#define PHASE_LOADP() KParams* _pp = (KParams*)__builtin_amdgcn_kernarg_segment_ptr(); asm volatile("" : "+s"(_pp)); const Params P = *_pp
#else
#define PHASE_LOADP() const Params P = Parg
#endif
#define PHASE_ENV() PHASE_LOADP(); const Ctx C = relaunder(C0); LAS unsigned char* lds = C.lds; bf16_t* H = wsp<bf16_t>(P, WS_H); bf16_t* Y = wsp<bf16_t>(P, WS_Y); unsigned char* R1 = P.ws + WS_R1
#define IN(k) (lo <= (k) && (k) < hi)
#define SEAM(k) do { if (IN(k) && IN((k) + 1)) { xcd_barrier(bar); if (PROBE_DUP & 1048576) xcd_barrier(bar); } } while (0)
template <int l> DI void layer_phases(const Ctx& C0, const Params& Parg, const int lo, const int hi, const XcdBarrier& bar) {
    constexpr int pb = PH_L0 + l * PH_PER_LAYER;
        if (IN(pb + 0)) { PHASE_ENV(); for (int rep = 0; rep < NREP(8); ++rep) phase_convert_layer(C, P, l);
            if (l == 0) phase_rownorm<false, true, false, true>(C, P, P.norm_mix + l * DM); else if (!(ENABLE_MASK & 32)) phase_rownorm<false, true, false>(C, P, P.norm_mix + l * DM); else phase_rownorm<true, true, false>(C, P, P.norm_mix + l * DM); } SEAM(pb + 0);
        if (IN(pb + 1)) for (int rep = 0; rep < NREP(16); ++rep) { PHASE_ENV();
            { pg8::DenseOrder S; S.init(H, wsp<bf16_t>(P, W_IN), NTOK, 2560, 1024, 1024, C.G, C.bid);
              EpiStore<0> E{(bf16_t*)(R1 + R1_PROJ), PROJ_LD}; pg8::gemm_phase<EpiStore<0>, pg8::DenseOrder, false>(C.tid, lds, 1024, 1024, 1024, S, E); }
            { pg8::DenseOrder S; S.init(wsp<bf16_t>(P, W_V), H, 512, NTOK, 1024, 1024, C.G, (C.bid + 128) % C.G);
              EpiStore<0> E{(bf16_t*)(R1 + R1_VT), NTOK}; pg8::gemm_phase<EpiStore<0>, pg8::DenseOrder, false>(C.tid, lds, 1024, 1024, 1024, S, E); }
            if (l == 0) {
        for (int lm = 0; lm < DEPTH; ++lm) {
            const bf16_t* MEMN = wsp<bf16_t>(P, WS_MEMN) + (size_t)lm * 1024 * 1024; const bf16_t* WKV = wsp<bf16_t>(P, W_KV) + (size_t)lm * 512 * 1024;
            { pg8::DenseOrder S; S.init(MEMN, WKV, 1024, 256, 1024, 1024, C.G, (C.bid + 8 * lm) % C.G);
              EpiStore<0> E{wsp<bf16_t>(P, WS_MK) + (size_t)lm * 1024 * 256, 256}; pg8::gemm_phase<EpiStore<0>, pg8::DenseOrder, false>(C.tid, lds, 1024, 1024, 1024, S, E); }
            { pg8::DenseOrder S; S.init(WKV + (size_t)256 * 1024, MEMN, 256, 1024, 1024, 1024, C.G, (C.bid + 8 * lm + 4) % C.G);
              EpiStore<0> E{wsp<bf16_t>(P, WS_MVT) + (size_t)lm * 256 * 1024, 1024}; pg8::gemm_phase<EpiStore<0>, pg8::DenseOrder, false>(C.tid, lds, 1024, 1024, 1024, S, E); }
        }
            }
        } SEAM(pb + 1);
        if (IN(pb + 2)) { PHASE_ENV(); phase_rope(C, P, l); } SEAM(pb + 2);
        if (IN(pb + 3)) { PHASE_ENV();
            for (int rep = 0; rep < NREP(1); ++rep) { if (ENABLE_MASK & 8) ZIGZAG(512, dsa_select_unit(C, P, l, u);); }
            for (int rep = 0; rep < NREP(1024); ++rep) { if (ENABLE_MASK & 2) ZIGZAG(512, hgrn_local_unit(C, P, l, u);); }
            for (int rep = 0; rep < NREP(2048); ++rep) { if (ENABLE_MASK & 4) ZIGZAG(256, sgu_unit(C, P, l, u);); }
        } SEAM(pb + 3);
        if (IN(pb + 4)) { PHASE_ENV();
            for (int rep = 0; rep < NREP(2); ++rep) { if (ENABLE_MASK & 1) causal_attn_block2<true>(C, P, l); }
            if (ENABLE_MASK & 2) { for (int u = C.G - 1 - C.bid; u < 128; u += C.G) hgrn_scan_unit(C, P, u); }
        } SEAM(pb + 4);
        if (IN(pb + 5)) {
            for (int rep = 0; rep < NREP(4); ++rep) { PHASE_ENV();
            for (int r2 = 0; r2 < NREP(2097152); ++r2) { if (ENABLE_MASK & 8) causal_attn_block2<false>(C, P, l); }
            for (int r3 = 0; r3 < NREP(4194304); ++r3) { if (ENABLE_MASK & 2) ZIGZAG(512, hgrn_out_unit(C, P, l, u);); } }
        } SEAM(pb + 5);
        if (IN(pb + 7)) for (int rep = 0; rep < NREP(128); ++rep) { PHASE_ENV();
            FusedMergeOrder S{(const char*)H, (const char*)Y, (const char*)wsp<bf16_t>(P, W_G), (const char*)wsp<bf16_t>(P, W_BR), C.G, C.bid};
            EpiFusedMerge E{(bf16_t*)(R1 + R1_GS) + (size_t)C.bid * 65536, (bf16_t*)(R1 + R1_MG), C.tid};
            pg8::gemm_phase<EpiFusedMerge, FusedMergeOrder, false>(C.tid, lds, 1024, 1024, 1024, S, E);
        } SEAM(pb + 7);
        if (IN(pb + 8)) { PHASE_ENV();
            pg8::DenseOrder S; S.init(R1 + R1_MG, wsp<bf16_t>(P, W_OUT), NTOK, 1024, 1024, 1024, C.G, C.bid);
            EpiResidNorm E{P.out, H, wsp<float>(P, WS_RSS)}; pg8::gemm_phase<EpiResidNorm, pg8::DenseOrder, false>(C.tid, lds, 1024, 1024, 1024, S, E);
        } SEAM(pb + 8);
        if (IN(pb + 10)) for (int rep = 0; rep < NREP(64); ++rep) { PHASE_ENV();
            pg8::DenseOrder S; S.init(H, wsp<bf16_t>(P, W_Q), NTOK, 256, 1024, 1024, C.G, C.bid);
            EpiStoreRstd E{(bf16_t*)(R1 + R1_MQ), 256, wsp<float>(P, WS_RSS)}; pg8::gemm_phase<EpiStoreRstd, pg8::DenseOrder, false>(C.tid, lds, 1024, 1024, 1024, S, E);
        } SEAM(pb + 10);
        if (IN(pb + 11)) for (int rep = 0; rep < NREP(64); ++rep) { PHASE_ENV(); mem_attn_block(C, P, l); } SEAM(pb + 11);
        if (IN(pb + 12)) { PHASE_ENV();
            if (ENABLE_MASK & 16) { pg8::DenseOrder S; S.init(R1 + R1_MO, wsp<bf16_t>(P, W_O), NTOK, 1024, 256, 256, C.G, C.bid);
              EpiResid E{P.out}; pg8::gemm_phase<EpiResid, pg8::DenseOrder, false>(C.tid, lds, 256, 256, 256, S, E); }
        } SEAM(pb + 12);
        if (IN(pb + 13)) { PHASE_ENV(); phase_router(C, P, l); if (PROBE_DUP & 512) { __syncthreads(); phase_router(C, P, l, true); } } SEAM(pb + 13);
        if (IN(pb + 14)) for (int rep = 0; rep < NREP(32); ++rep) { PHASE_ENV();
            moe_build_table(C, wsp<unsigned>(P, WS_CTL) + CW_CNT + 64 * l);
            MoeOrder<2, true> S{(const LAS int*)(lds + MOE_TAB), (const char*)H, (const char*)wsp<bf16_t>(P, W_GU), wsp<int>(P, WS_ROWTOK), C.G, C.bid};
            EpiGU E{(bf16_t*)(R1 + R1_HID)}; pg8::gemm_phase<EpiGU, MoeOrder<2, true>, true>(C.tid, lds, 1024, 1024, 1024, S, E);
        } SEAM(pb + 14);
        if (IN(pb + 15)) for (int rep = 0; rep < NREP(32); ++rep) { PHASE_ENV();
            moe_build_table(C, wsp<unsigned>(P, WS_CTL) + CW_CNT + 64 * l);
            MoeOrder<4, false> S{(const LAS int*)(lds + MOE_TAB), (const char*)(R1 + R1_HID), (const char*)wsp<bf16_t>(P, W_D), wsp<int>(P, WS_ROWTOK), C.G, C.bid};
            EpiDown E{(bf16_t*)(R1 + R1_YB), wsp<int>(P, WS_ROWTOK), wsp<float>(P, WS_TOKW), (const LAS int*)(lds + MOE_TAB) + 40};
            pg8::gemm_phase<EpiDown, MoeOrder<4, false>, false>(C.tid, lds, 256, 256, 256, S, E);
        } SEAM(pb + 15);
    }
__global__ void __launch_bounds__(NTHREADS, 2) mega_fwd(Params Parg) {
    extern __shared__ __attribute__((aligned(16))) unsigned char lds_raw[];
    Ctx C0; C0.lds = (LAS unsigned char*)lds_raw; C0.tid = threadIdx.x; C0.lane = C0.tid & 63; C0.wave = __builtin_amdgcn_readfirstlane((int)threadIdx.x >> 6); C0.G = gridDim.x; C0.bid = blockIdx.x;
    volatile LAS unsigned* misc = (volatile LAS unsigned*)(C0.lds + LDS_MISC);
    if (C0.tid < 4) misc[C0.tid] = 0u;
    __syncthreads();
    const int lo = Parg.ph_lo, hi = Parg.ph_hi;
    const bool use_bar = (hi - lo) > 1;
    XcdBarrier bar; bar.bar = (unsigned*)(Parg.ws + WS_CTL) + CW_BAR; bar.x = 0; bar.st = misc;
    if (use_bar) bar = xcd_barrier_post((unsigned*)(Parg.ws + WS_CTL) + CW_BAR, misc);
#define IN(k) (lo <= (k) && (k) < hi)
#define SEAM(k) do { if (IN(k) && IN((k) + 1)) { xcd_barrier(bar); if (PROBE_DUP & 1048576) xcd_barrier(bar); } } while (0)

    if (IN(0)) { PHASE_ENV(); phase_prologue(C, P); } SEAM(0);
    layer_phases<0>(C0, Parg, lo, hi, bar);
    layer_phases<1>(C0, Parg, lo, hi, bar);
    if (IN(N_PHASES - 1)) { PHASE_ENV(); if (ENABLE_MASK & 32) phase_rownorm<true, false, true>(C, P, P.norm_final); else phase_rownorm<false, false, true>(C, P, P.norm_final); }
#undef IN
#undef SEAM
}

#ifndef N_LAUNCH_MODE
#define N_LAUNCH_MODE 0
#endif
extern "C" void kernel_launch(void* const* d_in, const int* in_sizes, int n_in, void* d_out, int out_size, void* d_ws, size_t ws_size, hipStream_t stream) {
    static int grid = 0;
    if (grid == 0) {
        if (n_in != 25 || out_size != NTOK * DM || ws_size < WS_END) { fprintf(stderr, "kernel_launch: unexpected shapes (n_in %d out %d ws %zu need %zu)\n", n_in, out_size, ws_size, (size_t)WS_END); grid = -1; return; }
        int dev = 0, cus = 0;
        if (hipGetDevice(&dev) != hipSuccess || hipDeviceGetAttribute(&cus, hipDeviceAttributeMultiprocessorCount, dev) != hipSuccess) { grid = -1; return; }
        if (hipFuncSetAttribute((const void*)mega_fwd, hipFuncAttributeMaxDynamicSharedMemorySize, LDS_BYTES) != hipSuccess) { fprintf(stderr, "kernel_launch: hipFuncSetAttribute failed\n"); grid = -1; return; }
        int per_cu = 0;
        if (hipOccupancyMaxActiveBlocksPerMultiprocessor(&per_cu, (const void*)mega_fwd, NTHREADS, LDS_BYTES) != hipSuccess || per_cu < 1) { fprintf(stderr, "kernel_launch: occupancy query says %d\n", per_cu); }
        (void)hipGetLastError();
        if (cus != 256) fprintf(stderr, "kernel_launch: built for 256 CUs (one workgroup per CU); device reports %d\n", cus);
        grid = 256;
    }
    if (grid < 0) return;
    (void)hipMemsetAsync((char*)d_ws + WS_CTL, 0, CTL_BYTES, stream);
    Params p{};
    p.x = (const float*)d_in[0]; p.mem = (const float*)d_in[1]; p.positions = (const int*)d_in[2];
    p.norm_mix = (const float*)d_in[3]; p.w_in = (const float*)d_in[4]; p.diff_lambda = (const float*)d_in[5]; p.hgrn_lb = (const float*)d_in[6];
    p.spatial_w = (const float*)d_in[7]; p.spatial_b = (const float*)d_in[8]; p.w_branch = (const float*)d_in[9]; p.w_out = (const float*)d_in[10];
    p.norm_mem_q = (const float*)d_in[11]; p.norm_mem_kv = (const float*)d_in[12]; p.w_mem_q = (const float*)d_in[13]; p.w_mem_kv = (const float*)d_in[14]; p.w_mem_o = (const float*)d_in[15];
    p.norm_ffn = (const float*)d_in[16]; p.w_rg = (const float*)d_in[17]; p.b_rg = (const float*)d_in[18]; p.w_re = (const float*)d_in[19]; p.b_re = (const float*)d_in[20];
    p.w_eg = (const float*)d_in[21]; p.w_eu = (const float*)d_in[22]; p.w_ed = (const float*)d_in[23]; p.norm_final = (const float*)d_in[24];
    p.out = (float*)d_out; p.ws = (unsigned char*)d_ws;
#if N_LAUNCH_MODE == 0
    p.ph_lo = 0; p.ph_hi = N_PHASES;
    hipLaunchKernelGGL(mega_fwd, dim3(grid), dim3(NTHREADS), LDS_BYTES, stream, p);
#else
    for (int k = 0; k < N_PHASES; ++k) { p.ph_lo = k; p.ph_hi = k + 1; hipLaunchKernelGGL(mega_fwd, dim3(grid), dim3(NTHREADS), LDS_BYTES, stream, p); }
#endif
}
```

```cpp
#include <hip/hip_runtime.h>
#include <stdint.h>
#include <stdio.h>

#ifndef PROBE_DUP
#define PROBE_DUP 0
#endif
#define DI __device__ __forceinline__
#define LAS __attribute__((address_space(3)))
typedef unsigned short bf16_t;
typedef short bf16x8 __attribute__((ext_vector_type(8)));
typedef short s16x4 __attribute__((ext_vector_type(4)));
typedef float f32x2 __attribute__((ext_vector_type(2)));
typedef float f32x4 __attribute__((ext_vector_type(4)));
typedef float f32x16 __attribute__((ext_vector_type(16)));
typedef unsigned u32x2 __attribute__((ext_vector_type(2)));
typedef unsigned u32x4 __attribute__((ext_vector_type(4)));
typedef __bf16 hbf2 __attribute__((ext_vector_type(2)));

constexpr int NB = 4, SEQ = 4096, NTOK = NB * SEQ, DM = 1024, DEPTH = 2, MEMLEN = 256;
constexpr int NTHREADS = 512, NWAVES = 8;
constexpr int LDS_BYTES = 147456;
constexpr int LDS_MISC = 133120;
constexpr int IN_WIDTH = 6948;
constexpr int PROJ_LD = 2560;
constexpr int PC_AQ = 0, PC_AK = 256, PC_BQ = 512, PC_BF = 768, PC_BI = 1024, PC_BG = 1280, PC_CU = 1536, PC_CV = 1792,
              PC_DQ = 2048, PC_DK = 2304, PC_DIQ = 2368, PC_DIK = 2496, PC_DIW = 2528;
constexpr int MOE_CAP = 16384;

constexpr size_t AL(size_t x) { return (x + 255) & ~(size_t)255; }
constexpr size_t WS_CTL = 0, CTL_BYTES = 65536;
constexpr size_t W_IN = AL(WS_CTL + CTL_BYTES);
constexpr size_t W_V = W_IN + (size_t)2560 * 1024 * 2;
constexpr size_t W_G = W_V + (size_t)512 * 1024 * 2;
constexpr size_t W_BR = W_G + (size_t)4096 * 1024 * 2;
constexpr size_t W_OUT = W_BR + (size_t)4 * 1024 * 256 * 2;
constexpr size_t W_Q = W_OUT + (size_t)1024 * 1024 * 2;
constexpr size_t W_O = W_Q + (size_t)256 * 1024 * 2;
constexpr size_t W_GU = W_O + (size_t)1024 * 256 * 2;
constexpr size_t W_D = W_GU + (size_t)32 * 512 * 1024 * 2;
constexpr size_t W_SGU = W_D + (size_t)32 * 1024 * 256 * 2;
constexpr size_t W_RT = W_SGU + (size_t)4 * 128 * 128 * 2;
constexpr size_t W_RH = W_RT + (size_t)36 * 1024 * 4;
constexpr size_t W_KV = W_RH + (size_t)2 * 64 * 1024 * 2;
constexpr size_t WS_H = W_KV + (size_t)DEPTH * 512 * 1024 * 2;
constexpr size_t WS_R1 = WS_H + (size_t)NTOK * 1024 * 2;
constexpr size_t R1_BYTES = (size_t)NTOK * 4096 * 2;
constexpr size_t WS_Y = WS_R1 + R1_BYTES;
constexpr size_t WS_HS = WS_Y + (size_t)NTOK * 1024 * 2;
constexpr size_t WS_HD = WS_HS + (size_t)NB * 64 * 4 * 4096 * 4;
constexpr size_t WS_THETA = WS_HD + (size_t)NB * 64 * 256 * 4;
constexpr size_t WS_MEMN = WS_THETA + (size_t)NTOK * 8;
constexpr size_t WS_MK = WS_MEMN + (size_t)DEPTH * 1024 * 1024 * 2;
constexpr size_t WS_MVT = WS_MK + (size_t)DEPTH * 1024 * 256 * 2;
constexpr size_t WS_TOKE = WS_MVT + (size_t)DEPTH * 256 * 1024 * 2;
constexpr size_t WS_TOKW = WS_TOKE + (size_t)NTOK * 2 * 4;
constexpr size_t WS_RANK = WS_TOKW + (size_t)NTOK * 2 * 4;
constexpr size_t WS_ROWTOK = WS_RANK + (size_t)NTOK * 2 * 4;
constexpr size_t WS_MASK = WS_ROWTOK + (size_t)32 * MOE_CAP * 4;
constexpr size_t WS_RSS = WS_MASK + (size_t)NB * 128 * 128 * 64 * 2;
constexpr size_t WS_DUMMY_BASE = WS_RSS + (size_t)NTOK * 16 * 4;
constexpr size_t WS_DUMMY_OLD = WS_MASK + (size_t)NB * 128 * 128 * 64 * 2;
constexpr size_t WS_DUMMY = WS_DUMMY_BASE;
constexpr size_t WS_END = WS_DUMMY + (size_t)32 * MOE_CAP * 4;
constexpr size_t R1_PROJ = 0, R1_VT = (size_t)NTOK * PROJ_LD * 2;
constexpr size_t R1_GS = 0, R1_MG = (size_t)256 * 65536 * 2;
constexpr size_t R1_MQ = 0, R1_MO = (size_t)NTOK * 256 * 2, R1_HID = 2 * R1_MO, R1_YB = R1_HID + (size_t)40960 * 256 * 2;
constexpr size_t R1_HIDS = R1_YB + (size_t)NTOK * 2 * 1024 * 2;
static_assert(R1_HIDS + (size_t)32 * 64 * 256 * 2 <= R1_BYTES, "R1 map");
static_assert(R1_YB + (size_t)NTOK * 2 * 1024 * 2 <= R1_BYTES, "R1 map");
static_assert(R1_VT + (size_t)512 * NTOK * 2 <= R1_BYTES, "R1 map");
constexpr int CW_BAR = 0;
constexpr int CW_KMAX = 4032;
constexpr int CW_CNT = 4096;

DI bf16_t f2bf(float f) { __bf16 b = (__bf16)f; return __builtin_bit_cast(bf16_t, b); }
DI float bf2f(bf16_t b) { return __uint_as_float(((unsigned)b) << 16); }
DI unsigned pk2(float a, float b) { f32x2 v = {a, b}; hbf2 r = __builtin_convertvector(v, hbf2); return __builtin_bit_cast(unsigned, r); }
DI float bflo(unsigned w) { return __uint_as_float(w << 16); }
DI float bfhi(unsigned w) { return __uint_as_float(w & 0xffff0000u); }
DI float sigmoidf_(float x) { return __builtin_amdgcn_rcpf(1.0f + __builtin_amdgcn_exp2f(-1.4426950408889634f * x)); }
DI float siluf_(float x) { return x * __builtin_amdgcn_rcpf(1.0f + __builtin_amdgcn_exp2f(-1.4426950408889634f * x)); }
DI float fexp(float x) { return __builtin_amdgcn_exp2f(1.4426950408889634f * x); }
DI float frcp(float x) { return __builtin_amdgcn_rcpf(x); }
DI float flog(float x) { return 0.6931471805599453f * __builtin_amdgcn_logf(x); }
DI float gelu_tanh(float x) { const float u = 0.7978845608028654f * (x + 0.044715f * x * x * x); return x * frcp(1.0f + fexp(-2.0f * u)); }
DI float wave_sum(float v) { for (int o = 32; o > 0; o >>= 1) v += __shfl_xor(v, o); return v; }
DI float xhalf_max(float x) { const u32x2 r = __builtin_amdgcn_permlane32_swap(__float_as_uint(x), __float_as_uint(x), false, false); return fmaxf(__uint_as_float(r.x), __uint_as_float(r.y)); }
DI float xhalf_sum(float x) { const u32x2 r = __builtin_amdgcn_permlane32_swap(__float_as_uint(x), __float_as_uint(x), false, false); return __uint_as_float(r.x) + __uint_as_float(r.y); }
DI f32x16 mfma32(bf16x8 a, bf16x8 b, f32x16 c) { return __builtin_amdgcn_mfma_f32_32x32x16_bf16(a, b, c, 0, 0, 0); }
DI int crow(int reg, int h) { return (reg & 3) + 8 * (reg >> 2) + 4 * h; }
DI f32x16 zero16() { f32x16 z; for (int i = 0; i < 16; ++i) z[i] = 0.f; return z; }

#define XB_TMO      128
#define XB_XCNT(j)  (256  + 64 * (j))
#define XB_XSUB(j)  (1280 + 64 * (j))
#define XB_XGEN(j)  (2304 + 64 * (j))
#define XB_TOP      3328
#define XB_TOPGEN   3392
#define XCD_BAR_WORDS 3456
#define XB_SPIN_CAP (1u << 22)

DI unsigned xb_ld(unsigned* p)              { return __hip_atomic_load(p, __ATOMIC_RELAXED, __HIP_MEMORY_SCOPE_AGENT); }
DI unsigned xb_add(unsigned* p, unsigned v) { return __hip_atomic_fetch_add(p, v, __ATOMIC_RELAXED, __HIP_MEMORY_SCOPE_AGENT); }
DI unsigned xb_xcc_id() { return (unsigned)__builtin_amdgcn_s_getreg((3 << 11) | 20) & 0xFu; }
#define XB_SPIN(cond, bar) do { unsigned _sp = 0; while (cond) { __builtin_amdgcn_s_sleep(1); \
    if ((++_sp & 255u) == 0u) { if (xb_ld(&(bar)[XB_TMO])) break; if (_sp > XB_SPIN_CAP) { atomicAdd(&(bar)[XB_TMO], 1u); break; } } } } while (0)

struct XcdBarrier { unsigned* bar; unsigned x; volatile LAS unsigned* st; };

DI XcdBarrier xcd_barrier_post(unsigned* bar, volatile LAS unsigned* st) {
    XcdBarrier b; b.bar = bar; b.x = xb_xcc_id(); b.st = st;
    if (threadIdx.x == 0) (void)xb_add(&bar[XB_XCNT(b.x)], 1u);
    return b;
}
DI void xcd_barrier_complete(unsigned* bar, unsigned x, unsigned& nloc, unsigned& nx) {
    const unsigned G = gridDim.x * gridDim.y * gridDim.z;
    unsigned sum, cnt, mine, sp = 0u;
    for (;;) {
        sum = 0u; cnt = 0u; mine = 0u;
#pragma unroll
        for (unsigned j = 0; j < 16; ++j) { const unsigned c = xb_ld(&bar[XB_XCNT(j)]); sum += c; cnt += (c > 0u) ? 1u : 0u; mine = (j == x) ? c : mine; }
        if (sum == G) break;
        __builtin_amdgcn_s_sleep(1);
        if ((++sp & 255u) == 0u) { if (xb_ld(&bar[XB_TMO])) break; if (sp > XB_SPIN_CAP) { atomicAdd(&bar[XB_TMO], 1u); break; } }
    }
    nloc = mine > 0u ? mine : 1u; nx = cnt > 0u ? cnt : 1u;
}
DI void xcd_barrier(const XcdBarrier& b) {
    asm volatile("s_waitcnt vmcnt(0)" ::: "memory");
    __syncthreads();
    if (threadIdx.x == 0) {
        unsigned* bar = b.bar;
        __builtin_amdgcn_s_waitcnt(0);
        unsigned nloc = b.st[0], nx = b.st[1];
        if (nloc == 0u) { xcd_barrier_complete(bar, b.x, nloc, nx); b.st[0] = nloc; b.st[1] = nx; }
        const unsigned old = xb_add(&bar[XB_XSUB(b.x)], 1u);
        const unsigned gen = old / nloc;
        if (old + 1u == (gen + 1u) * nloc) {
            __builtin_amdgcn_fence(__ATOMIC_RELEASE, "agent");
            asm volatile("s_waitcnt vmcnt(0)" ::: "memory");
            const unsigned og = xb_add(&bar[XB_TOP], 1u);
            const unsigned tg = og / nx;
            if (og + 1u == (tg + 1u) * nx) xb_add(&bar[XB_TOPGEN], 1u);
            else XB_SPIN(xb_ld(&bar[XB_TOPGEN]) == tg, bar);
            __builtin_amdgcn_fence(__ATOMIC_ACQUIRE, "agent");
            xb_add(&bar[XB_XGEN(b.x)], 1u);
            asm volatile("s_waitcnt vmcnt(0)" ::: "memory");
        } else {
            XB_SPIN(xb_ld(&bar[XB_XGEN(b.x)]) == gen, bar);
            __builtin_amdgcn_fence(__ATOMIC_ACQUIRE, "agent");
            asm volatile("s_waitcnt vmcnt(0)" ::: "memory");
        }
    }
    __syncthreads();
}
namespace pg8 {
constexpr int BM = 256, BK = 64, HALF = 128, HTB = HALF * BK * 2, STAGE_BYTES = 8 * HTB, NXCD = 8, WGM = 8;
DI int lds_byte(int r, int c) { const int st = (r >> 4) * 2 + (c >> 5), rr = r & 15, cc = c & 31, ob = rr * 64 + cc * 2; return st * 1024 + (ob ^ (((ob >> 9) & 1) << 5)); }
DI void stage_rc(int b, int& R, int& C) { const int st = b / 1024, sb = b % 1024, swz = sb ^ (((sb >> 9) & 1) << 5); R = (st >> 1) * 16 + swz / 64; C = (st & 1) * 32 + (swz % 64) / 2; }
DI int perm32(int rho) { const int n = rho >> 4, i = rho & 15; return 8 * (i >> 2) + 4 * n + (i & 3); }

struct Unit { const char* a; const char* b; int pm, pn, x, y, nt; };

DI void tile_map(int L, int nM, int nN, int& pm, int& pn) {
    const int nwg = nM * nN; int wgid = L;
    { const int q = nwg / NXCD, r = nwg % NXCD, xcd = wgid % NXCD, off = wgid / NXCD; wgid = (xcd < r ? xcd * (q + 1) : r * (q + 1) + (xcd - r) * q) + off; }
    const int nig = WGM * nN, gid = wgid / nig, fm = gid * WGM, gsz = (nM - fm) < WGM ? (nM - fm) : WGM;
    pm = fm + ((wgid % nig) % gsz); pn = (wgid % nig) / gsz;
}
struct DenseOrder {
    const char* A; const char* B; size_t at, bt; int nM, nN, nwg, G, c;
    DI void init(const void* A_, const void* B_, int M, int N, int lda, int ldb, int G_, int c_) {
        A = (const char*)A_; B = (const char*)B_; at = (size_t)BM * lda * 2; bt = (size_t)BM * ldb * 2; nM = M / BM; nN = N / BM; nwg = nM * nN; G = G_; c = c_; }
    DI bool next(int i, Unit& u) const {
        const long L = (long)i * G + c; if (L >= nwg) return false;
        tile_map((int)L, nM, nN, u.pm, u.pn); u.a = A + (size_t)u.pm * at; u.b = B + (size_t)u.pn * bt; u.x = 0; u.y = 0; u.nt = 0; return true; }
    DI unsigned row_off(const Unit&, int) const { return 0u; }
};

#define PG8_WAIT_V(n) asm volatile("s_waitcnt vmcnt(" #n ")" ::: "memory")
#define PG8_WAIT_L(n) asm volatile("s_waitcnt lgkmcnt(" #n ")" ::: "memory")
#define PG8_BAR __builtin_amdgcn_s_barrier()
#define PG8_SCHED __builtin_amdgcn_sched_barrier(0)

template <class Epi, class Sched, bool GATHER>
DI void gemm_phase(const int tid, LAS unsigned char* lds, const int lda, const int ldb, const int K, const Sched& S, const Epi& E) {
    const int wid = __builtin_amdgcn_readfirstlane(tid >> 6), lane = tid & 63, wr = wid >> 2, wc = wid & 3, fr = lane & 15, fq = lane >> 4;
    const int nt_phase = K / BK;
    unsigned voffA[2], voffB[2]; int RA[2], CA[2];
#pragma unroll
    for (int i = 0; i < 2; ++i) { int R, C; stage_rc(tid * 16 + i * 8192, R, C); const int Rb = (R & ~31) + perm32(R & 31);
        RA[i] = R; CA[i] = C; voffA[i] = (unsigned)(R * lda + C) * 2u; voffB[i] = (unsigned)(Rb * ldb + C) * 2u; }
    const size_t kstep = (size_t)(BK * 2);
    const size_t hstepA = (size_t)HALF * lda * 2, hstepB = (size_t)HALF * ldb * 2;
    const unsigned ldsw = (unsigned)wid * 1024u;
    const int aoff = lds_byte(wr * 64 + fr, fq * 8), boff = lds_byte(wc * 32 + fr, fq * 8);
    unsigned vc[2][2], vn[2][2];
#define PG8_SA(b, h) (((b) * 2 + (h)) * HTB)
#define PG8_SB(b, h) ((4 + (b) * 2 + (h)) * HTB)
#define PG8_GL(bufoff, gptr, vo, _i) __builtin_amdgcn_global_load_lds((const unsigned*)((const char*)(gptr) + (vo)), (LAS unsigned*)(lds + (bufoff) + ldsw + (_i) * 8192), 16, 0, 0)
#define PG8_STAGE_B(bufoff, gbase) do { PG8_GL(bufoff, gbase, voffB[0], 0); PG8_GL(bufoff, gbase, voffB[1], 1); } while (0)
#define PG8_STAGE_A(bufoff, kptr, h, isnext) do { if constexpr (GATHER) { const unsigned _o0 = (isnext) ? vn[h][0] : vc[h][0], _o1 = (isnext) ? vn[h][1] : vc[h][1]; PG8_GL(bufoff, kptr, _o0, 0); PG8_GL(bufoff, kptr, _o1, 1); } \
        else { PG8_GL(bufoff, (kptr) + (h) * hstepA, voffA[0], 0); PG8_GL(bufoff, (kptr) + (h) * hstepA, voffA[1], 1); } } while (0)
#define PG8_LDA(dst, b, h) do { _Pragma("unroll") for (int m = 0; m < 4; ++m) _Pragma("unroll") for (int k = 0; k < 2; ++k) dst[m][k] = *(const LAS bf16x8*)(lds + PG8_SA(b, h) + aoff + m * 2048 + k * 1024); } while (0)
#define PG8_LDB(dst, b, h) do { _Pragma("unroll") for (int n = 0; n < 2; ++n) _Pragma("unroll") for (int k = 0; k < 2; ++k) dst[n][k] = *(const LAS bf16x8*)(lds + PG8_SB(b, h) + boff + n * 2048 + k * 1024); } while (0)
#define PG8_MMA(ai, bj, At, Bt) do { __builtin_amdgcn_s_setprio(1); _Pragma("unroll") for (int m = 0; m < 4; ++m) _Pragma("unroll") for (int n = 0; n < 2; ++n) _Pragma("unroll") for (int k = 0; k < 2; ++k) \
        acc[ai][bj][m][n] = __builtin_amdgcn_mfma_f32_16x16x32_bf16(Bt[n][k], At[m][k], acc[ai][bj][m][n], 0, 0, 0); __builtin_amdgcn_s_setprio(0); } while (0)
    Unit cur, nxt; int ui = 0;
    if (!S.next(0, cur)) return;
    f32x4 acc[2][2][4][2];
#pragma unroll
    for (int a = 0; a < 2; ++a)
#pragma unroll
        for (int b = 0; b < 2; ++b)
#pragma unroll
            for (int m = 0; m < 4; ++m)
#pragma unroll
                for (int n = 0; n < 2; ++n) acc[a][b][m][n] = (f32x4){0.f, 0.f, 0.f, 0.f};
    bf16x8 At[4][2], B0[2][2], B1[2][2];
    const char* cA = cur.a; const char* cB = cur.b;
    if constexpr (GATHER) {
#pragma unroll
        for (int h = 0; h < 2; ++h)
#pragma unroll
            for (int i = 0; i < 2; ++i) { vc[h][i] = S.row_off(cur, RA[i] + h * HALF) + (unsigned)CA[i] * 2u; vn[h][i] = vc[h][i]; }
    }
    PG8_STAGE_B(PG8_SB(0, 0), cB); PG8_STAGE_A(PG8_SA(0, 0), cA, 0, false); PG8_STAGE_B(PG8_SB(0, 1), cB + hstepB); PG8_STAGE_A(PG8_SA(0, 1), cA, 1, false);
    if (wr == 1) PG8_BAR;
    PG8_WAIT_V(4); PG8_BAR;
    PG8_STAGE_B(PG8_SB(1, 0), cB + kstep); PG8_STAGE_A(PG8_SA(1, 0), cA + kstep, 0, false); PG8_STAGE_B(PG8_SB(1, 1), cB + hstepB + kstep);
    PG8_WAIT_V(6); PG8_BAR;
    for (;;) {
        const bool has_next = S.next(ui + 1, nxt);
        const char* nA = has_next ? nxt.a : cA; const char* nB = has_next ? nxt.b : cB;
        if constexpr (GATHER) {
            if (has_next) {
#pragma unroll
                for (int h = 0; h < 2; ++h)
#pragma unroll
                    for (int i = 0; i < 2; ++i) vn[h][i] = S.row_off(nxt, RA[i] + h * HALF) + (unsigned)CA[i] * 2u;
            }
        }
        const int nt = cur.nt ? cur.nt : nt_phase;
        for (int t = 0; t < nt; t += 2) {
            const bool last = (t == nt - 2);
            int tq = t; asm volatile("" : "+s"(tq));
            const char* a1 = cA + (size_t)(tq + 1) * kstep;
            const char* a2 = last ? nA : cA + (size_t)(tq + 2) * kstep; const char* b2 = last ? nB : cB + (size_t)(tq + 2) * kstep;
            const char* a3 = a2 + kstep; const char* b3 = b2 + kstep;
            PG8_LDB(B0, 0, 0); PG8_SCHED; PG8_LDA(At, 0, 0); PG8_STAGE_A(PG8_SA(1, 1), a1, 1, false);
            PG8_WAIT_L(8); PG8_BAR; PG8_WAIT_L(0); PG8_MMA(0, 0, At, B0); PG8_BAR; PG8_SCHED;
            PG8_LDB(B1, 0, 1); PG8_STAGE_B(PG8_SB(0, 0), b2);
            PG8_BAR; PG8_WAIT_L(0); PG8_MMA(0, 1, At, B1); PG8_BAR;
            PG8_LDA(At, 0, 1); PG8_STAGE_A(PG8_SA(0, 0), a2, 0, last);
            PG8_BAR; PG8_WAIT_L(0); PG8_MMA(1, 0, At, B0); PG8_BAR; PG8_SCHED;
            PG8_STAGE_B(PG8_SB(0, 1), b2 + hstepB);
            PG8_WAIT_V(6); PG8_BAR; PG8_MMA(1, 1, At, B1); PG8_BAR;
            PG8_LDB(B0, 1, 0); PG8_SCHED; PG8_LDA(At, 1, 0); PG8_STAGE_A(PG8_SA(0, 1), a2, 1, last);
            PG8_WAIT_L(8); PG8_BAR; PG8_WAIT_L(0); PG8_MMA(0, 0, At, B0); PG8_BAR; PG8_SCHED;
            PG8_LDB(B1, 1, 1); PG8_STAGE_B(PG8_SB(1, 0), b3);
            PG8_BAR; PG8_WAIT_L(0); PG8_MMA(0, 1, At, B1); PG8_BAR;
            PG8_LDA(At, 1, 1); PG8_STAGE_A(PG8_SA(1, 0), a3, 0, last);
            PG8_BAR; PG8_WAIT_L(0); PG8_MMA(1, 0, At, B0); PG8_BAR; PG8_SCHED;
            PG8_STAGE_B(PG8_SB(1, 1), b3 + hstepB);
            PG8_WAIT_V(6); PG8_BAR; PG8_MMA(1, 1, At, B1); PG8_BAR;
        }
        { int ln2 = lane; asm volatile("" : "+v"(ln2)); E(acc, cur, wr, wc, ln2 & 15, ln2 >> 4); }
        if (!has_next) break;
#pragma unroll
        for (int a = 0; a < 2; ++a)
#pragma unroll
            for (int b = 0; b < 2; ++b)
#pragma unroll
                for (int m = 0; m < 4; ++m)
#pragma unroll
                    for (int n = 0; n < 2; ++n) acc[a][b][m][n] = (f32x4){0.f, 0.f, 0.f, 0.f};
        cur = nxt; cA = nA; cB = nB; ++ui;
        if constexpr (GATHER) {
#pragma unroll
            for (int h = 0; h < 2; ++h)
#pragma unroll
                for (int i = 0; i < 2; ++i) vc[h][i] = vn[h][i];
        }
    }
    PG8_WAIT_V(0);
    if (wr == 0) PG8_BAR;
    PG8_BAR;
#undef PG8_SA
#undef PG8_SB
#undef PG8_GL
#undef PG8_STAGE_A
#undef PG8_STAGE_B
#undef PG8_LDA
#undef PG8_LDB
#undef PG8_MMA
}
}
struct Params {
    const float* x; const float* mem; const int* positions;
    const float* norm_mix; const float* w_in; const float* diff_lambda; const float* hgrn_lb; const float* spatial_w; const float* spatial_b;
    const float* w_branch; const float* w_out; const float* norm_mem_q; const float* norm_mem_kv; const float* w_mem_q; const float* w_mem_kv; const float* w_mem_o;
    const float* norm_ffn; const float* w_rg; const float* b_rg; const float* w_re; const float* b_re; const float* w_eg; const float* w_eu; const float* w_ed; const float* norm_final;
    float* out; unsigned char* ws; int ph_lo, ph_hi;
};
struct Ctx {
    LAS unsigned char* lds; int tid, lane, wave, G, bid;
};
DI Ctx relaunder(const Ctx& C) { Ctx D = C; int w = C.wave, g = C.G, bi = C.bid; asm volatile("" : "+s"(w), "+s"(g), "+s"(bi)); D.wave = w; D.G = g; D.bid = bi; int ln; asm volatile("v_mbcnt_lo_u32_b32 %0, -1, 0\n\tv_mbcnt_hi_u32_b32 %0, -1, %0" : "=v"(ln)); D.lane = ln; D.tid = w * 64 + ln; return D; }
template <class T> DI T* wsp(const Params& P, size_t off) { return (T*)(P.ws + off); }

struct CvtJob { const float* src; bf16_t* dst; int ld_src, ncols, K, ld_dst, nb1, nb2; long ss1, ds1, ss2, ds2; const float* kscale; };
DI void cvt_transpose(const Ctx& C, const CvtJob& J) {
    LAS float* T = (LAS float*)C.lds;
    const int tn = (J.ncols + 63) >> 6, tk = J.K >> 6, per = tn * tk, total = per * J.nb1 * J.nb2;
    for (int t = C.bid; t < total; t += C.G) {
        const int bb = t / per, r = t % per, b1 = bb / J.nb2, b2 = bb % J.nb2, in_ = r / tk, ik = r % tk;
        const float* src = J.src + (size_t)b1 * J.ss1 + (size_t)b2 * J.ss2; bf16_t* dst = J.dst + (size_t)b1 * J.ds1 + (size_t)b2 * J.ds2;
        const int n0 = in_ * 64, k0 = ik * 64;
        { const int k = C.tid >> 3, c8 = (C.tid & 7) * 8;
#pragma unroll
          for (int v = 0; v < 2; ++v) { const int n = n0 + c8 + v * 4;
              f32x4 x = (f32x4){0.f, 0.f, 0.f, 0.f};
              if (n < J.ncols) x = *(const f32x4*)(src + (size_t)(k0 + k) * J.ld_src + n);
              if (J.kscale) { const float g = J.kscale[k0 + k]; x[0] *= g; x[1] *= g; x[2] *= g; x[3] *= g; }
#pragma unroll
              for (int j = 0; j < 4; ++j) T[(c8 + v * 4 + j) * 65 + k] = x[j]; } }
        __syncthreads();
        { const int n = C.tid >> 3, k8 = (C.tid & 7) * 8;
          if (n0 + n < J.ncols) { u32x4 w;
#pragma unroll
              for (int j = 0; j < 4; ++j) w[j] = pk2(T[n * 65 + k8 + 2 * j], T[n * 65 + k8 + 2 * j + 1]);
              *(u32x4*)(dst + (size_t)(n0 + n) * J.ld_dst + k0 + k8) = w; } }
        __syncthreads();
    }
}
DI CvtJob mkjob(const float* src, bf16_t* dst, int ld_src, int ncols, int K, int ld_dst, int nb1 = 1, long ss1 = 0, long ds1 = 0, int nb2 = 1, long ss2 = 0, long ds2 = 0) {
    CvtJob J; J.src = src; J.dst = dst; J.ld_src = ld_src; J.ncols = ncols; J.K = K; J.ld_dst = ld_dst; J.nb1 = nb1; J.nb2 = nb2; J.ss1 = ss1; J.ds1 = ds1; J.ss2 = ss2; J.ds2 = ds2; J.kscale = nullptr; return J; }

DI void phase_convert_layer(const Ctx& C, const Params& P, int l) {
    const float* win = P.w_in + (size_t)l * 1024 * IN_WIDTH;
    bf16_t* WIN = wsp<bf16_t>(P, W_IN); bf16_t* WV = wsp<bf16_t>(P, W_V);
    cvt_transpose(C, mkjob(win + 0, WIN, IN_WIDTH, 512, 1024, 1024));
    cvt_transpose(C, mkjob(win + 768, WIN + (size_t)512 * 1024, IN_WIDTH, 1856, 1024, 1024));
    cvt_transpose(C, mkjob(win + 2688, WIN + (size_t)2368 * 1024, IN_WIDTH, 164, 1024, 1024));
    cvt_transpose(C, mkjob(win + 512, WV, IN_WIDTH, 256, 1024, 1024));
    cvt_transpose(C, mkjob(win + 2624, WV + (size_t)256 * 1024, IN_WIDTH, 64, 1024, 1024));
    cvt_transpose(C, mkjob(win + 2852, wsp<bf16_t>(P, W_G), IN_WIDTH, 4096, 1024, 1024));
    cvt_transpose(C, mkjob(P.w_branch + (size_t)l * 4 * 256 * 1024, wsp<bf16_t>(P, W_BR), 1024, 1024, 256, 1024, 4, 256 * 1024, 256));
    cvt_transpose(C, mkjob(P.w_out + (size_t)l * 1024 * 1024, wsp<bf16_t>(P, W_OUT), 1024, 1024, 1024, 1024));
    { CvtJob J = mkjob(P.w_mem_q + (size_t)l * 1024 * 256, wsp<bf16_t>(P, W_Q), 256, 256, 1024, 1024); J.kscale = P.norm_mem_q + l * DM; cvt_transpose(C, J); }
    cvt_transpose(C, mkjob(P.w_mem_o + (size_t)l * 256 * 1024, wsp<bf16_t>(P, W_O), 1024, 1024, 256, 256));
    cvt_transpose(C, mkjob(P.w_eg + (size_t)l * 32 * 1024 * 256, wsp<bf16_t>(P, W_GU), 256, 128, 1024, 1024, 32, 1024 * 256, 512 * 1024, 2, 128, 256 * 1024));
    cvt_transpose(C, mkjob(P.w_eu + (size_t)l * 32 * 1024 * 256, wsp<bf16_t>(P, W_GU) + (size_t)128 * 1024, 256, 128, 1024, 1024, 32, 1024 * 256, 512 * 1024, 2, 128, 256 * 1024));
    cvt_transpose(C, mkjob(P.w_ed + (size_t)l * 32 * 256 * 1024, wsp<bf16_t>(P, W_D), 1024, 1024, 256, 256, 32, 256 * 1024, 1024 * 256));
    { bf16_t* z0 = WIN + (size_t)2532 * 1024; for (int i = C.bid * NTHREADS + C.tid; i < 28 * 1024; i += C.G * NTHREADS) z0[i] = 0;
      bf16_t* z1 = WV + (size_t)320 * 1024; for (int i = C.bid * NTHREADS + C.tid; i < 192 * 1024; i += C.G * NTHREADS) z1[i] = 0; }
    { bf16_t* rh = wsp<bf16_t>(P, W_RH); const float* wre = P.w_re + (size_t)l * 1024 * 32; const float* wrg = P.w_rg + (size_t)l * 1024 * 4;
      for (int i = C.bid * NTHREADS + C.tid; i < 64 * 1024; i += C.G * NTHREADS) { const int j = i >> 10, k = i & 1023;
          const float w = (j < 32) ? wre[k * 32 + j] : (j < 36 ? wrg[k * 4 + (j - 32)] : 0.f);
          const bf16_t hi = f2bf(w); rh[i] = hi; rh[64 * 1024 + i] = f2bf(w - bf2f(hi)); } }
    { const float* sw = P.spatial_w + (size_t)l * 4 * 128 * 128; bf16_t* d = wsp<bf16_t>(P, W_SGU);
      for (int i = C.bid * NTHREADS + C.tid; i < 4 * 128 * 128; i += C.G * NTHREADS) { const int s = i & 127, t = (i >> 7) & 127; d[i] = (s <= t) ? f2bf(sw[i]) : (bf16_t)0; } }
}

DI void phase_prologue(const Ctx& C, const Params& P) {
    for (int r = C.bid * NWAVES + C.wave; r < NB * MEMLEN; r += C.G * NWAVES) {
        const float* src = P.mem + (size_t)r * DM; f32x4 v[4]; float ss = 0.f;
#pragma unroll
        for (int j = 0; j < 4; ++j) { v[j] = *(const f32x4*)(src + j * 256 + C.lane * 4); ss += v[j][0] * v[j][0] + v[j][1] * v[j][1] + v[j][2] * v[j][2] + v[j][3] * v[j][3]; }
        ss = wave_sum(ss); const float rs = 1.0f / sqrtf(ss * (1.0f / DM) + 1e-6f);
        for (int l = 0; l < DEPTH; ++l) { bf16_t* dst = wsp<bf16_t>(P, WS_MEMN) + ((size_t)l * 1024 + r) * DM;
#pragma unroll
            for (int j = 0; j < 4; ++j) { const f32x4 g = *(const f32x4*)(P.norm_mem_kv + l * DM + j * 256 + C.lane * 4);
                u32x2 w; w.x = pk2(v[j][0] * rs * g[0], v[j][1] * rs * g[1]); w.y = pk2(v[j][2] * rs * g[2], v[j][3] * rs * g[3]);
                *(u32x2*)(dst + j * 256 + C.lane * 4) = w; } }
    }
    for (int l = 0; l < DEPTH; ++l)
        cvt_transpose(C, mkjob(P.w_mem_kv + (size_t)l * 1024 * 512, wsp<bf16_t>(P, W_KV) + (size_t)l * 512 * 1024, 512, 512, 1024, 1024));
}

template <bool ADD_YB, bool WRITE_H, bool FINAL, bool FROM_X = false>
DI void phase_rownorm(const Ctx& C, const Params& P, const float* gain) {
    float* XR = P.out; bf16_t* H = wsp<bf16_t>(P, WS_H); const bf16_t* YB = (const bf16_t*)(P.ws + WS_R1 + R1_YB);
    const int stride = C.G * NWAVES; int t = C.bid * NWAVES + C.wave;
    f32x4 v[4], vn[4]; u32x2 ya[4], yb[4], yan[4], ybn[4];
#define RN_LOAD(dst, da, db, tt) do { const float* src_ = (FROM_X ? P.x : (const float*)XR) + (size_t)(tt) * DM; _Pragma("unroll") for (int j = 0; j < 4; ++j) { const int c = j * 256 + C.lane * 4; dst[j] = *(const f32x4*)(src_ + c); \
        if constexpr (ADD_YB) { da[j] = *(const u32x2*)(YB + (size_t)(2 * (tt)) * DM + c); db[j] = *(const u32x2*)(YB + (size_t)(2 * (tt) + 1) * DM + c); } } } while (0)
    if (t < NTOK) RN_LOAD(v, ya, yb, t);
    for (; t < NTOK; t += stride) {
        const int tn = (t + stride < NTOK) ? t + stride : t;
        RN_LOAD(vn, yan, ybn, tn);
        float* xr = XR + (size_t)t * DM; float ss = 0.f;
#pragma unroll
        for (int j = 0; j < 4; ++j) { const int c = j * 256 + C.lane * 4;
            if constexpr (ADD_YB) { const u32x2 a = ya[j], b = yb[j];
                v[j][0] += bflo(a.x) + bflo(b.x); v[j][1] += bfhi(a.x) + bfhi(b.x); v[j][2] += bflo(a.y) + bflo(b.y); v[j][3] += bfhi(a.y) + bfhi(b.y); }
            if constexpr ((ADD_YB && !FINAL) || FROM_X) *(f32x4*)(xr + c) = v[j];
            ss += v[j][0] * v[j][0] + v[j][1] * v[j][1] + v[j][2] * v[j][2] + v[j][3] * v[j][3]; }
        ss = wave_sum(ss); const float rs = 1.0f / sqrtf(ss * (1.0f / DM) + 1e-6f);
#pragma unroll
        for (int j = 0; j < 4; ++j) { const int c = j * 256 + C.lane * 4; const f32x4 g = *(const f32x4*)(gain + c);
            const f32x4 o = (f32x4){v[j][0] * rs * g[0], v[j][1] * rs * g[1], v[j][2] * rs * g[2], v[j][3] * rs * g[3]};
            if constexpr (FINAL) *(f32x4*)(xr + c) = o;
            if constexpr (WRITE_H) { u32x2 w; w.x = pk2(o[0], o[1]); w.y = pk2(o[2], o[3]); *(u32x2*)(H + (size_t)t * DM + c) = w; } }
#pragma unroll
        for (int j = 0; j < 4; ++j) { v[j] = vn[j]; if constexpr (ADD_YB) { ya[j] = yan[j]; yb[j] = ybn[j]; } }
    }
#undef RN_LOAD
}

DI void phase_rope(const Ctx& C, const Params& P, const int l, const bool dry = false) {
    bf16_t* PROJ = (bf16_t*)(P.ws + WS_R1 + R1_PROJ);
    LAS f32x2* tab = (LAS f32x2*)(C.lds) + C.wave * 64;
    float kmx[4] = {0.f, 0.f, 0.f, 0.f};
    for (int t = C.bid * NWAVES + C.wave; t < NTOK; t += C.G * NWAVES) {
        const float pos = (float)P.positions[t];
        if (C.lane < 48) { const int i = C.lane < 16 ? C.lane : C.lane - 16; const float d = C.lane < 16 ? 32.f : 64.f;
            const float inv = powf(10000.0f, -(float)i * (2.0f / d)); const float ang = pos * inv; float s, c; sincosf(ang, &s, &c); tab[C.lane] = (f32x2){c, s}; }
        __builtin_amdgcn_wave_barrier();
        asm volatile("s_waitcnt lgkmcnt(0)" ::: "memory");
        bf16_t* row = PROJ + (size_t)t * PROJ_LD;
        { const float kv = (C.lane < 32) ? bf2f(row[PC_DIK + C.lane]) : 0.f; const float k2 = wave_sum(kv * kv); const int bb = t >> 12;
#pragma unroll
          for (int q = 0; q < 4; ++q) kmx[q] = (bb == q) ? fmaxf(kmx[q], k2) : kmx[q]; }
        for (int p = C.lane; p < 496; p += 64) {
            int col, half, ti;
            if (p < 256) { col = (p >> 4) * 32 + (p & 15); half = 16; ti = p & 15; }
            else if (p < 416) { const int q = p - 256; col = PC_DQ + (q >> 5) * 64 + (q & 31); half = 32; ti = 16 + (q & 31); }
            else { const int q = p - 416; col = PC_DIQ + (q >> 4) * 32 + (q & 15); half = 16; ti = q & 15; }
            const f32x2 cs = tab[ti]; const float x1 = bf2f(row[col]), x2 = bf2f(row[col + half]);
            if (!dry || pos < -1.0f) { row[col] = f2bf(x1 * cs.x - x2 * cs.y); row[col + half] = f2bf(x2 * cs.x + x1 * cs.y); }
        }
        __builtin_amdgcn_wave_barrier();
    }
    { LAS unsigned* km = (LAS unsigned*)(C.lds + 8192);
      __syncthreads();
      if (C.tid < 4) km[C.tid] = 0u;
      __syncthreads();
      if (C.lane < 4) { float v = 0.f;
#pragma unroll
          for (int q = 0; q < 4; ++q) v = (C.lane == q) ? kmx[q] : v;
          __hip_atomic_fetch_max(km + C.lane, __float_as_uint(v), __ATOMIC_RELAXED, __HIP_MEMORY_SCOPE_WORKGROUP); }
      __syncthreads();
      if (C.tid < 4 && !dry) atomicMax(wsp<unsigned>(P, WS_CTL) + CW_KMAX + 8 * l + C.tid, (unsigned)km[C.tid]);
      __syncthreads(); }
}
DI void sm_step(f32x16& st, const float c, float& m, float& l, f32x16& O0, f32x16& O1, bf16x8& p0, bf16x8& p1) {
    float mx = st[0];
#pragma unroll
    for (int i = 1; i < 16; ++i) mx = fmaxf(mx, st[i]);
    mx = fmaxf(mx, __shfl_xor(mx, 32));
    if (__any(mx > m)) { const float mn = fmaxf(m, mx); const float a = __builtin_amdgcn_exp2f((m - mn) * c); l *= a;
#pragma unroll
        for (int i = 0; i < 16; ++i) { O0[i] *= a; O1[i] *= a; }
        m = mn; }
    const f32x2 cc = {c, c}, mcv = {-(m * c), -(m * c)}; f32x2 rs2 = {0.f, 0.f};
#pragma unroll
    for (int i = 0; i < 8; ++i) { f32x2 x = {st[2 * i], st[2 * i + 1]}; x = x * cc + mcv;
        f32x2 p; p.x = __builtin_amdgcn_exp2f(x.x); p.y = __builtin_amdgcn_exp2f(x.y); st[2 * i] = p.x; st[2 * i + 1] = p.y; rs2 += p; }
    l += rs2.x + rs2.y;
    u32x4 a, b;
    a.x = pk2(st[0], st[1]); a.y = pk2(st[2], st[3]); a.z = pk2(st[4], st[5]); a.w = pk2(st[6], st[7]);
    b.x = pk2(st[8], st[9]); b.y = pk2(st[10], st[11]); b.z = pk2(st[12], st[13]); b.w = pk2(st[14], st[15]);
    p0 = __builtin_bit_cast(bf16x8, a); p1 = __builtin_bit_cast(bf16x8, b);
}
DI void apply_mask(f32x16& st, unsigned vmask) {
#pragma unroll
    for (int i = 0; i < 16; ++i) { const unsigned sel = (unsigned)__builtin_amdgcn_sbfe((int)vmask, i, 1);
        st[i] = __uint_as_float((__float_as_uint(st[i]) & sel) | (__float_as_uint(-3.0e38f) & ~sel)); }
}
DI bf16x8 vt_frag(const bf16_t* vt_row, int k0, int s2, int h) {
    const bf16_t* p = vt_row + k0 + 16 * s2 + 4 * h; const u32x2 lo = *(const u32x2*)p, hi = *(const u32x2*)(p + 8);
    u32x4 w; w.x = lo.x; w.y = lo.y; w.z = hi.x; w.w = hi.y; return __builtin_bit_cast(bf16x8, w);
}
DI unsigned causal_mask(int r, int h) { unsigned m = 0;
#pragma unroll
    for (int i = 0; i < 16; ++i) m |= (crow(i, h) <= r) ? (1u << i) : 0u;
    return m; }
DI void causal_wave_unit(int c, int w, int& bh, int& qs) { const int pi = c * 4 + (w & 3); bh = (pi >> 6) & 15; const int j = pi & 63; qs = (w < 4) ? 127 - j : j; }

struct DiffKV { bf16x8 kf[2][2]; bf16x8 vf[2][2]; };
DI void diff_load(DiffKV& t, const bf16_t* kbase, const bf16_t* vrow0, const bf16_t* vrow1, int k0, int r, int h) {
    const bf16_t* kp = kbase + (size_t)(k0 + r) * PROJ_LD + 8 * h;
#pragma unroll
    for (int m = 0; m < 2; ++m)
#pragma unroll
        for (int s = 0; s < 2; ++s) t.kf[m][s] = *(const bf16x8*)(kp + m * 32 + 16 * s);
#pragma unroll
    for (int s2 = 0; s2 < 2; ++s2) { t.vf[0][s2] = vt_frag(vrow0, k0, s2, h); t.vf[1][s2] = vt_frag(vrow1, k0, s2, h); }
}
DI void diff_step(const DiffKV& t, const bf16x8 (&qf)[2][2], bool diag, unsigned dmask, const float c, float (&mm)[2], float (&ll)[2], f32x16 (&O)[2][2]) {
#pragma unroll
    for (int m = 0; m < 2; ++m) {
        f32x16 st = mfma32(t.kf[m][0], qf[m][0], zero16()); st = mfma32(t.kf[m][1], qf[m][1], st);
        if (diag) apply_mask(st, dmask);
        bf16x8 p0, p1; sm_step(st, c, mm[m], ll[m], O[m][0], O[m][1], p0, p1);
        O[m][0] = mfma32(t.vf[0][0], p0, O[m][0]); O[m][0] = mfma32(t.vf[0][1], p1, O[m][0]);
        O[m][1] = mfma32(t.vf[1][0], p0, O[m][1]); O[m][1] = mfma32(t.vf[1][1], p1, O[m][1]);
    }
}
DI void diff_attn_wave(const Ctx& C, const Params& P, int l) {
    const bf16_t* PROJ = (const bf16_t*)(P.ws + WS_R1 + R1_PROJ); const bf16_t* VT = (const bf16_t*)(P.ws + WS_R1 + R1_VT); bf16_t* Y = wsp<bf16_t>(P, WS_Y);
    int bh, qs; causal_wave_unit(C.bid, C.wave, bh, qs);
    const int b = bh >> 2, hd = bh & 3, r = C.lane & 31, h = C.lane >> 5, tokb = b * SEQ, q0 = qs * 32, t = q0 + r;
    const float* lv = P.diff_lambda + l * 128;
    const float d1 = wave_sum(C.lane < 32 ? lv[C.lane] * lv[32 + C.lane] : 0.f), d2 = wave_sum(C.lane < 32 ? lv[64 + C.lane] * lv[96 + C.lane] : 0.f);
    const float lam_init = 0.8f - 0.6f * expf(-0.3f * (float)l), lam = expf(d1) - expf(d2) + lam_init;
    bf16x8 qf[2][2];
#pragma unroll
    for (int m = 0; m < 2; ++m)
#pragma unroll
        for (int s = 0; s < 2; ++s) qf[m][s] = *(const bf16x8*)(PROJ + (size_t)(tokb + t) * PROJ_LD + PC_AQ + hd * 64 + m * 32 + 16 * s + 8 * h);
    f32x16 O[2][2]; float mm[2] = {-1e30f, -1e30f}, ll[2] = {0.f, 0.f};
#pragma unroll
    for (int m = 0; m < 2; ++m) { O[m][0] = zero16(); O[m][1] = zero16(); }
    const float c = 0.17677669529663687f * 1.4426950408889634f;
    const int nkt = qs + 1; const unsigned dmask = causal_mask(r, h);
    const bf16_t* kbase = PROJ + (size_t)tokb * PROJ_LD + PC_AK + hd * 64;
    const bf16_t* vrow0 = VT + (size_t)(hd * 64 + r) * NTOK + tokb; const bf16_t* vrow1 = vrow0 + (size_t)32 * NTOK;
    DiffKV ta, tb; diff_load(ta, kbase, vrow0, vrow1, 0, r, h);
    for (int kt = 0; kt < nkt; kt += 2) {
        if (kt + 1 < nkt) diff_load(tb, kbase, vrow0, vrow1, (kt + 1) * 32, r, h);
        diff_step(ta, qf, kt == nkt - 1, dmask, c, mm, ll, O);
        if (kt + 1 < nkt) { if (kt + 2 < nkt) diff_load(ta, kbase, vrow0, vrow1, (kt + 2) * 32, r, h);
            diff_step(tb, qf, kt + 1 == nkt - 1, dmask, c, mm, ll, O); }
    }
    ll[0] += __shfl_xor(ll[0], 32); ll[1] += __shfl_xor(ll[1], 32);
    const float i0 = 1.0f / ll[0], i1 = lam / ll[1]; float ss = 0.f;
#pragma unroll
    for (int et = 0; et < 2; ++et)
#pragma unroll
        for (int i = 0; i < 16; ++i) { const float o = O[0][et][i] * i0 - O[1][et][i] * i1; O[0][et][i] = o; ss += o * o; }
    ss += __shfl_xor(ss, 32);
    const float rn = (1.0f - lam_init) / sqrtf(ss * (1.0f / 64.0f) + 1e-6f);
    bf16_t* yrow = Y + (size_t)(tokb + t) * DM + hd * 64;
#pragma unroll
    for (int et = 0; et < 2; ++et)
#pragma unroll
        for (int g = 0; g < 4; ++g) { u32x2 w; w.x = pk2(O[0][et][4 * g] * rn, O[0][et][4 * g + 1] * rn); w.y = pk2(O[0][et][4 * g + 2] * rn, O[0][et][4 * g + 3] * rn);
            *(u32x2*)(yrow + et * 32 + 8 * g + 4 * h) = w; }
}

struct KV64 { bf16x8 kf[4]; bf16x8 vf[2][2]; };
DI void kv64_load(KV64& t, const bf16_t* kbase, int kld, const bf16_t* vrow0, const bf16_t* vrow1, int k0, int r, int h) {
    const bf16_t* kp = kbase + (size_t)(k0 + r) * kld + 8 * h;
#pragma unroll
    for (int s = 0; s < 4; ++s) t.kf[s] = *(const bf16x8*)(kp + 16 * s);
#pragma unroll
    for (int s2 = 0; s2 < 2; ++s2) { t.vf[0][s2] = vt_frag(vrow0, k0, s2, h); t.vf[1][s2] = vt_frag(vrow1, k0, s2, h); }
}
DI void kv64_step(const KV64& t, const bf16x8 (&qf)[4], bool masked, unsigned vmask, const float c, float& mm, float& ll, f32x16 (&O)[2]) {
    f32x16 st = zero16();
#pragma unroll
    for (int s = 0; s < 4; ++s) st = mfma32(t.kf[s], qf[s], st);
    if (masked) apply_mask(st, vmask);
    bf16x8 p0, p1; sm_step(st, c, mm, ll, O[0], O[1], p0, p1);
    O[0] = mfma32(t.vf[0][0], p0, O[0]); O[0] = mfma32(t.vf[0][1], p1, O[0]);
    O[1] = mfma32(t.vf[1][0], p0, O[1]); O[1] = mfma32(t.vf[1][1], p1, O[1]);
}
DI void mem_attn_wave(const Ctx& C, const Params& P, int l) {
    const bf16_t* MQ = (const bf16_t*)(P.ws + WS_R1 + R1_MQ); bf16_t* MO = (bf16_t*)(P.ws + WS_R1 + R1_MO);
    const bf16_t* MK = wsp<bf16_t>(P, WS_MK) + (size_t)l * 1024 * 256; const bf16_t* MVT = wsp<bf16_t>(P, WS_MVT) + (size_t)l * 256 * 1024;
    const int r = C.lane & 31, h = C.lane >> 5;
    for (int wu = C.bid * NWAVES + C.wave; wu < 2048; wu += C.G * NWAVES) {
        const int bh = wu >> 7, qs = wu & 127, b = bh >> 2, hd = bh & 3, t = b * SEQ + qs * 32 + r;
        bf16x8 qf[4];
#pragma unroll
        for (int s = 0; s < 4; ++s) qf[s] = *(const bf16x8*)(MQ + (size_t)t * 256 + hd * 64 + 16 * s + 8 * h);
        f32x16 O[2] = {zero16(), zero16()}; float mm = -1e30f, ll = 0.f;
        const float c = 0.125f * 1.4426950408889634f;
        const bf16_t* kbase = MK + (size_t)(b * 256) * 256 + hd * 64;
        const bf16_t* vrow0 = MVT + (size_t)(hd * 64 + r) * 1024 + b * 256; const bf16_t* vrow1 = vrow0 + (size_t)32 * 1024;
        KV64 ta, tb; kv64_load(ta, kbase, 256, vrow0, vrow1, 0, r, h);
#pragma unroll 1
        for (int kt = 0; kt < 8; kt += 2) {
            kv64_load(tb, kbase, 256, vrow0, vrow1, (kt + 1) * 32, r, h);
            kv64_step(ta, qf, false, 0u, c, mm, ll, O);
            if (kt + 2 < 8) kv64_load(ta, kbase, 256, vrow0, vrow1, (kt + 2) * 32, r, h);
            kv64_step(tb, qf, false, 0u, c, mm, ll, O);
        }
        ll += __shfl_xor(ll, 32);
        const float il = 1.0f / ll; bf16_t* orow = MO + (size_t)t * 256 + hd * 64;
#pragma unroll
        for (int et = 0; et < 2; ++et)
#pragma unroll
            for (int g = 0; g < 4; ++g) { u32x2 w; w.x = pk2(O[et][4 * g] * il, O[et][4 * g + 1] * il); w.y = pk2(O[et][4 * g + 2] * il, O[et][4 * g + 3] * il);
                *(u32x2*)(orow + et * 32 + 8 * g + 4 * h) = w; }
    }
}

DI f32x16 idx_score(const bf16x8 (&ikf)[2], const bf16x8 (&iqf)[4][2], const float (&iw)[4]) {
    f32x16 a[4];
#pragma unroll
    for (int hh = 0; hh < 4; ++hh) a[hh] = mfma32(ikf[0], iqf[hh][0], zero16());
#pragma unroll
    for (int hh = 0; hh < 4; ++hh) a[hh] = mfma32(ikf[1], iqf[hh][1], a[hh]);
    f32x16 sc = zero16();
#pragma unroll
    for (int hh = 0; hh < 4; ++hh) {
#pragma unroll
        for (int i = 0; i < 16; ++i) sc[i] = fmaf(iw[hh], __builtin_amdgcn_fmed3f(a[hh][i], 0.f, __builtin_inff()), sc[i]); }
    return sc;
}
DI unsigned okey_of(float f) { const unsigned u = __float_as_uint(f); return u ^ ((unsigned)((int)u >> 31) | 0x80000000u); }
DI void load_idx_q(const bf16_t* PROJ, size_t tok, int h, bf16x8 (&iqf)[4][2], float (&iw)[4]) {
    const bf16_t* row = PROJ + tok * PROJ_LD;
#pragma unroll
    for (int hh = 0; hh < 4; ++hh) {
#pragma unroll
        for (int s = 0; s < 2; ++s) iqf[hh][s] = *(const bf16x8*)(row + PC_DIQ + hh * 32 + 16 * s + 8 * h);
        iw[hh] = bf2f(row[PC_DIW + hh]) * 0.08838834764831845f; }
}

template <int PASS> DI void d1_digit(unsigned ok, unsigned sinv, unsigned mv, unsigned mb, bool& match, unsigned& dg) {
    if constexpr (PASS == 0) { match = true; dg = ok >> 21; }
    else if constexpr (PASS == 1) { match = (ok >> 21) == mv; dg = (ok >> 10) & 2047u; }
    else if constexpr (PASS == 2) { match = (ok >> 10) == mv; dg = ((ok & 1023u) << 1) | (sinv >> 11); }
    else { match = (ok == mv) && ((sinv >> 11) == mb); dg = sinv & 2047u; }
}
constexpr int D1_HSTRIDE = 1025;
DI unsigned lin_bin(float sc, float lin_a, float lin_b) { return (unsigned)__builtin_amdgcn_fmed3f(fmaf(sc, lin_a, lin_b), 0.f, 2047.f); }
template <int PASS> DI void d1_pass(const Ctx& C, const bf16_t* PROJ, int tokb, int q0, int nkt, const bf16x8 (&iqf)[4][2], const float (&iw)[4], LAS unsigned* hist, volatile LAS unsigned* QS, const float lin_a = 0.f, const float lin_b = 0.f) {
    const int r = C.lane & 31, h = C.lane >> 5;
    const unsigned mv = QS[r * 4 + 0], mb = QS[r * 4 + 1];
    LAS unsigned* hrow = hist + r * D1_HSTRIDE;
    const bf16_t* kp0 = PROJ + (size_t)(tokb + r) * PROJ_LD + PC_DIK + 8 * h;
    bf16x8 ikf[2], ikn[2];
    if (C.wave < nkt) { const bf16_t* kp = kp0 + (size_t)(C.wave * 32) * PROJ_LD; ikf[0] = *(const bf16x8*)kp; ikf[1] = *(const bf16x8*)(kp + 16); }
    for (int kt = C.wave; kt < nkt; kt += NWAVES) {
        const int k0 = kt * 32;
        { const int ktn = (kt + NWAVES < nkt) ? kt + NWAVES : kt;
          const bf16_t* kp = kp0 + (size_t)(ktn * 32) * PROJ_LD; ikn[0] = *(const bf16x8*)kp; ikn[1] = *(const bf16x8*)(kp + 16); }
        const f32x16 sc = idx_score(ikf, iqf, iw);
        const bool diag = (kt == nkt - 1);
        unsigned wadr[16], wval[16]; bool any_m = false;
#pragma unroll
        for (int i = 0; i < 16; ++i) { const unsigned ok = okey_of(sc[i]), sinv = 4095u - (unsigned)(k0 + crow(i, h));
            bool match; unsigned dg;
            if constexpr (PASS == 4) { match = true; dg = lin_bin(sc[i], lin_a, lin_b); } else d1_digit<PASS>(ok, sinv, mv, mb, match, dg);
            if (diag) match = match && (crow(i, h) <= r);
            wadr[i] = match ? (dg >> 1) : 1024u;
            wval[i] = match ? (1u << ((dg & 1u) * 16u)) : 0u; any_m = any_m || match; }
        if (PASS == 0 || PASS == 4 || __any(any_m)) {
#pragma unroll
            for (int i = 0; i < 16; ++i) __hip_atomic_fetch_add(hrow + wadr[i], wval[i], __ATOMIC_RELAXED, __HIP_MEMORY_SCOPE_WORKGROUP);
        }
        ikf[0] = ikn[0]; ikf[1] = ikn[1];
    }
    __syncthreads();
    for (int srep = ((PROBE_DUP & 32768) ? 0 : 1); srep < 2; ++srep)
    for (int qq = 0; qq < 4; ++qq) {
        const int q = C.wave * 4 + qq; const unsigned rk = QS[q * 4 + 2];
        unsigned lsum = 0;
#pragma unroll
        for (int j = 0; j < 16; ++j) { const unsigned wj = hist[q * D1_HSTRIDE + C.lane * 16 + j]; lsum += (wj & 0xffffu) + (wj >> 16); }
        unsigned x = lsum;
#pragma unroll
        for (int o = 1; o < 64; o <<= 1) { const unsigned y = __shfl_down(x, o); if (C.lane + o < 64) x += y; }
        const unsigned above = x - lsum;
        const bool hit = (above < rk) && (rk <= x);
        const unsigned long long bal = __ballot(hit); const int L = bal ? (__ffsll((long long)bal) - 1) : 0;
        const unsigned aboveL = __shfl(above, L);
        const unsigned bk = (C.lane < 32) ? (unsigned)((const LAS unsigned short*)hist)[q * (2 * D1_HSTRIDE) + L * 32 + C.lane] : 0u;
        unsigned y2 = bk;
#pragma unroll
        for (int o = 1; o < 32; o <<= 1) { const unsigned z = __shfl_down(y2, o); if (C.lane + o < 32) y2 += z; }
        const unsigned ab2 = aboveL + y2 - bk;
        const bool hit2 = (C.lane < 32) && (ab2 < rk) && (rk <= ab2 + bk);
        const unsigned long long bal2 = __ballot(hit2); const int K2 = bal2 ? (__ffsll((long long)bal2) - 1) : 0;
        unsigned bin = (unsigned)(L * 32 + K2), rnew = rk - __shfl(ab2, K2);
        if (C.lane == 0 && srep == 1) {
            const unsigned omv = QS[q * 4 + 0];
            if constexpr (PASS == 0 || PASS == 4) { QS[q * 4 + 0] = bin; }
            else if constexpr (PASS == 1) { QS[q * 4 + 0] = (omv << 11) | bin; }
            else if constexpr (PASS == 2) { QS[q * 4 + 0] = (omv << 10) | (bin >> 1); QS[q * 4 + 1] = bin & 1u; }
            else { QS[q * 4 + 3] = bin; }
            QS[q * 4 + 2] = rnew;
        }
    }
    __syncthreads();
    if constexpr (PASS == 1 || PASS == 2) { for (int crep = 0; crep < ((PROBE_DUP & 65536) ? 2 : 1); ++crep) { for (int i = C.tid; i < 32 * D1_HSTRIDE; i += NTHREADS) hist[i] = 0u; __syncthreads(); } }
}
DI void dsa_select_unit(const Ctx& C, const Params& P, int l, int u) {
    const bf16_t* PROJ = (const bf16_t*)(P.ws + WS_R1 + R1_PROJ); unsigned short* MASK = wsp<unsigned short>(P, WS_MASK);
    const int qt = 127 - (u >> 2), b = u & 3, tokb = b * SEQ, q0 = qt * 32;
    unsigned short* mrow = MASK + ((size_t)(b * 128 + qt) * 128) * 64 + C.lane;
    if (q0 + 31 < 256) {
        for (int kt = C.wave; kt <= qt; kt += NWAVES) mrow[(size_t)kt * 64] = (unsigned short)((kt == qt) ? causal_mask(C.lane & 31, C.lane >> 5) : 0xffffu);
        return; }
    LAS unsigned* hist = (LAS unsigned*)C.lds; volatile LAS unsigned* QS = (volatile LAS unsigned*)(C.lds + 32 * D1_HSTRIDE * 4);
    for (int i = C.tid; i < 32 * D1_HSTRIDE; i += NTHREADS) hist[i] = 0u;
    if (C.tid < 32) { QS[C.tid * 4 + 0] = 0u; QS[C.tid * 4 + 1] = 0u; QS[C.tid * 4 + 2] = 256u; QS[C.tid * 4 + 3] = 0u; }
    __syncthreads();
    const int r = C.lane & 31, h = C.lane >> 5;
    bf16x8 iqf[4][2]; float iw[4]; load_idx_q(PROJ, (size_t)(tokb + q0 + r), h, iqf, iw);
    const int nkt = qt + 1;
    float lin_a, lin_b;
    { const float kmax = sqrtf(__uint_as_float(wsp<unsigned>(P, WS_CTL)[CW_KMAX + 8 * l + b]));
      float hi = 0.f, lo = 0.f;
#pragma unroll
      for (int hh = 0; hh < 4; ++hh) { float n2 = 0.f;
#pragma unroll
          for (int s2 = 0; s2 < 2; ++s2) { const u32x4 w = __builtin_bit_cast(u32x4, iqf[hh][s2]);
#pragma unroll
              for (int j = 0; j < 4; ++j) { const float x0 = bflo(w[j]), x1 = bfhi(w[j]); n2 += x0 * x0 + x1 * x1; } }
          n2 += __shfl_xor(n2, 32); const float bnd = 0.5f * kmax * fabsf(iw[hh]) * sqrtf(n2);
          if (iw[hh] > 0.f) hi += bnd; else lo -= bnd; }
      const float span = hi - lo; lin_a = span > 0.f ? 2047.0f / span : 0.f; lin_b = -lo * lin_a; }
    d1_pass<4>(C, PROJ, tokb, q0, nkt, iqf, iw, hist, QS, lin_a, lin_b);
    constexpr int CCAP = 384;
    LAS unsigned long long* CAND = (LAS unsigned long long*)C.lds;
    LAS unsigned short* LM = (LAS unsigned short*)(C.lds + 98304);
    LAS unsigned* ZBM = (LAS unsigned*)(C.lds + 114688);
    LAS unsigned* ccnt = (LAS unsigned*)(C.lds + 32 * D1_HSTRIDE * 4 + 512);
    if (C.tid < 33) ccnt[C.tid] = 0u;
    __syncthreads();
    {
        const unsigned b0 = QS[r * 4 + 0];
        const bf16_t* kp0 = PROJ + (size_t)(tokb + r) * PROJ_LD + PC_DIK + 8 * h;
        bf16x8 ikf[2], ikn[2];
        if (C.wave < nkt) { const bf16_t* kp = kp0 + (size_t)(C.wave * 32) * PROJ_LD; ikf[0] = *(const bf16x8*)kp; ikf[1] = *(const bf16x8*)(kp + 16); }
        for (int kt = C.wave; kt < nkt; kt += NWAVES) {
            const int k0 = kt * 32;
            { const int ktn = (kt + NWAVES < nkt) ? kt + NWAVES : kt;
              const bf16_t* kp = kp0 + (size_t)(ktn * 32) * PROJ_LD; ikn[0] = *(const bf16x8*)kp; ikn[1] = *(const bf16x8*)(kp + 16); }
            const f32x16 sc = idx_score(ikf, iqf, iw);
            const bool diag = (kt == nkt - 1);
            unsigned above = 0, cand = 0, zer = 0;
#pragma unroll
            for (int i = 0; i < 16; ++i) { const unsigned d0 = lin_bin(sc[i], lin_a, lin_b); const bool ok_c = !diag || (crow(i, h) <= r);
                const bool inb = ok_c && d0 == b0, isz = sc[i] == 0.0f;
                above |= (ok_c && d0 > b0) ? (1u << i) : 0u; cand |= (inb && !isz) ? (1u << i) : 0u; zer |= (inb && isz) ? (1u << i) : 0u; }
            LM[kt * 64 + C.lane] = (unsigned short)above;
            { unsigned kw = 0;
#pragma unroll
              for (int g = 0; g < 4; ++g) kw |= ((zer >> (4 * g)) & 0xfu) << (8 * g + 4 * h);
              kw |= __shfl_xor(kw, 32);
              if (h == 0) ZBM[r * 128 + kt] = kw; }
            if (__any(cand != 0u)) {
                const unsigned nc = (unsigned)__popc(cand);
                unsigned pos = nc ? __hip_atomic_fetch_add(ccnt + r, nc, __ATOMIC_RELAXED, __HIP_MEMORY_SCOPE_WORKGROUP) : 0u;
#pragma unroll
                for (int i = 0; i < 16; ++i) { const bool on = (cand >> i) & 1u;
                    if (on && pos < (unsigned)CCAP) CAND[r * CCAP + pos] = ((unsigned long long)okey_of(sc[i]) << 12) | (unsigned long long)(4095 - (k0 + crow(i, h)));
                    pos += on ? 1u : 0u; }
            }
            ikf[0] = ikn[0]; ikf[1] = ikn[1];
        }
    }
    __syncthreads();
    if (C.tid < 32 && ccnt[C.tid] > (unsigned)CCAP) ccnt[32] = 1u;
    __syncthreads();
    if (ccnt[32] == 0u || (PROBE_DUP & 16384)) {
        const unsigned long long ZK = 0x80000000ull << 12;
        for (int qq = 0; qq < 4; ++qq) {
            const int q = C.wave * 4 + qq; const unsigned n = ccnt[q]; unsigned rk = QS[q * 4 + 2];
            unsigned long long cv[6];
#pragma unroll
            for (int j = 0; j < 6; ++j) { const unsigned idx = (unsigned)C.lane + 64u * j; cv[j] = (idx < n) ? CAND[q * CCAP + idx] : 0ull; }
            unsigned z0 = (2 * C.lane < nkt) ? ZBM[q * 128 + 2 * C.lane] : 0u, z1 = (2 * C.lane + 1 < nkt) ? ZBM[q * 128 + 2 * C.lane + 1] : 0u;
            unsigned Pc = 0, Zc;
#pragma unroll
            for (int j = 0; j < 6; ++j) Pc += (unsigned)__popcll(__ballot(cv[j] >= ZK + 4096ull));
            { unsigned zc = (unsigned)(__popc(z0) + __popc(z1)); Zc = zc;
#pragma unroll
              for (int o = 32; o > 0; o >>= 1) Zc += __shfl_xor(Zc, o); }
            unsigned long long thr;
            unsigned mz = 0;
            if (rk <= Pc || rk > Pc + Zc) {
                if (rk > Pc + Zc) { mz = Zc; }
                const bool neg = rk > Pc + Zc; const unsigned rk2 = neg ? rk - Zc : rk;
                unsigned long long cur = 0ull;
                if (n <= 64u) {
                    for (int bit = 43; bit >= 0; --bit) { const unsigned long long T = cur | (1ull << bit); if ((unsigned)__popcll(__ballot(cv[0] != 0ull && cv[0] >= T)) >= rk2) cur = T; }
                } else {
                    for (int bit = 43; bit >= 0; --bit) { const unsigned long long T = cur | (1ull << bit); unsigned cnt = 0;
#pragma unroll
                        for (int j = 0; j < 6; ++j) cnt += (unsigned)__popcll(__ballot(cv[j] != 0ull && cv[j] >= T));
                        if (cnt >= rk2) cur = T; }
                }
                thr = cur;
            } else { thr = ZK + 4096ull; mz = rk - Pc; }
#pragma unroll
            for (int j = 0; j < 6; ++j) {
                if (cv[j] != 0ull && cv[j] >= thr) { const int key = 4095 - (int)(cv[j] & 4095ull), kt = key >> 5, kk = key & 31, hh = (kk >> 2) & 1, ii = (kk & 3) + 4 * (kk >> 3);
                    const int w16 = kt * 64 + q + 32 * hh;
                    __hip_atomic_fetch_or((LAS unsigned*)LM + (w16 >> 1), 1u << (16 * (w16 & 1) + ii), __ATOMIC_RELAXED, __HIP_MEMORY_SCOPE_WORKGROUP); } }
            if (mz > 0u) {
                const unsigned c0 = (unsigned)__popc(z0), c1 = (unsigned)__popc(z1); unsigned incl = c0 + c1;
#pragma unroll
                for (int o = 1; o < 64; o <<= 1) { const unsigned y = __shfl_up(incl, o); if (C.lane >= o) incl += y; }
                unsigned before = incl - (c0 + c1);
                unsigned need0 = (before >= mz) ? 0u : ((mz - before) < c0 ? (mz - before) : c0);
                while ((unsigned)__popc(z0) > need0) z0 &= ~(0x80000000u >> __clz(z0));
                before += c0;
                unsigned need1 = (before >= mz) ? 0u : ((mz - before) < c1 ? (mz - before) : c1);
                while ((unsigned)__popc(z1) > need1) z1 &= ~(0x80000000u >> __clz(z1));
#pragma unroll
                for (int tz = 0; tz < 2; ++tz) { const unsigned zw = tz ? z1 : z0; const int kt = 2 * C.lane + tz;
                    if (zw) {
#pragma unroll
                        for (int hh = 0; hh < 2; ++hh) { unsigned m16 = 0;
#pragma unroll
                            for (int g = 0; g < 4; ++g) m16 |= ((zw >> (8 * g + 4 * hh)) & 0xfu) << (4 * g);
                            const int w16 = kt * 64 + q + 32 * hh;
                            if (m16) __hip_atomic_fetch_or((LAS unsigned*)LM + (w16 >> 1), m16 << (16 * (w16 & 1)), __ATOMIC_RELAXED, __HIP_MEMORY_SCOPE_WORKGROUP); } } }
            }
        }
        __syncthreads();
        { const LAS unsigned* src = (const LAS unsigned*)LM; unsigned* dst = (unsigned*)(MASK + ((size_t)(b * 128 + qt) * 128) * 64);
          for (int i = C.tid; i < nkt * 32; i += NTHREADS) dst[i] = src[i]; }
        __syncthreads();
        return;
    }
    for (int i = C.tid; i < 32 * D1_HSTRIDE; i += NTHREADS) hist[i] = 0u;
    if (C.tid < 32) { QS[C.tid * 4 + 0] = 0u; QS[C.tid * 4 + 1] = 0u; QS[C.tid * 4 + 2] = 256u; QS[C.tid * 4 + 3] = 0u; }
    __syncthreads();
    d1_pass<0>(C, PROJ, tokb, q0, nkt, iqf, iw, hist, QS);
    for (int i = C.tid; i < 32 * D1_HSTRIDE; i += NTHREADS) hist[i] = 0u;
    __syncthreads();
    d1_pass<1>(C, PROJ, tokb, q0, nkt, iqf, iw, hist, QS);
    d1_pass<2>(C, PROJ, tokb, q0, nkt, iqf, iw, hist, QS);
    d1_pass<3>(C, PROJ, tokb, q0, nkt, iqf, iw, hist, QS);
    {
      const unsigned long long theta = ((unsigned long long)QS[r * 4 + 0] << 12) | ((unsigned long long)QS[r * 4 + 1] << 11) | QS[r * 4 + 3];
      for (int rep = 0; rep < ((PROBE_DUP & 4096) ? 2 : 1); ++rep)
      for (int kt = C.wave; kt < nkt; kt += NWAVES) {
          const int k0 = kt * 32; bf16x8 ikf[2];
          const bf16_t* kp = PROJ + (size_t)(tokb + k0 + r) * PROJ_LD + PC_DIK + 8 * h;
          ikf[0] = *(const bf16x8*)kp; ikf[1] = *(const bf16x8*)(kp + 16);
          const f32x16 sc = idx_score(ikf, iqf, iw);
          unsigned vmask = 0;
#pragma unroll
          for (int i = 0; i < 16; ++i) { const int key = k0 + crow(i, h); const unsigned long long comp = ((unsigned long long)okey_of(sc[i]) << 12) | (unsigned long long)(4095 - key);
              vmask |= (key <= q0 + r && comp >= theta) ? (1u << i) : 0u; }
          mrow[(size_t)kt * 64] = (unsigned short)vmask; } }
    __syncthreads();
}

DI void dsa_attn_wave(const Ctx& C, const Params& P) {
    const bf16_t* PROJ = (const bf16_t*)(P.ws + WS_R1 + R1_PROJ); const bf16_t* VT = (const bf16_t*)(P.ws + WS_R1 + R1_VT); bf16_t* Y = wsp<bf16_t>(P, WS_Y);
    const unsigned short* MASK = wsp<unsigned short>(P, WS_MASK);
    int bh, qs; causal_wave_unit(C.bid, C.wave, bh, qs);
    const int b = bh >> 2, hd = bh & 3, r = C.lane & 31, h = C.lane >> 5, tokb = b * SEQ, q0 = qs * 32, t = q0 + r;
    bf16x8 qf[4];
#pragma unroll
    for (int s = 0; s < 4; ++s) qf[s] = *(const bf16x8*)(PROJ + (size_t)(tokb + t) * PROJ_LD + PC_DQ + hd * 64 + 16 * s + 8 * h);
    f32x16 O[2] = {zero16(), zero16()}; float mm = -1e30f, ll = 0.f;
    const float c = 0.125f * 1.4426950408889634f;
    const int nkt = qs + 1;
    const bf16_t* kbase = PROJ + (size_t)tokb * PROJ_LD + PC_DK;
    const bf16_t* vrow0 = VT + (size_t)(256 + r) * NTOK + tokb; const bf16_t* vrow1 = vrow0 + (size_t)32 * NTOK;
    const unsigned short* mrow = MASK + ((size_t)(b * 128 + qs) * 128) * 64 + C.lane;
    KV64 ta, tb; unsigned ma, mb;
    kv64_load(ta, kbase, PROJ_LD, vrow0, vrow1, 0, r, h); ma = mrow[0];
    for (int kt = 0; kt < nkt; kt += 2) {
        if (kt + 1 < nkt) { kv64_load(tb, kbase, PROJ_LD, vrow0, vrow1, (kt + 1) * 32, r, h); mb = mrow[(size_t)(kt + 1) * 64]; }
        kv64_step(ta, qf, true, ma, c, mm, ll, O);
        if (kt + 1 < nkt) { if (kt + 2 < nkt) { kv64_load(ta, kbase, PROJ_LD, vrow0, vrow1, (kt + 2) * 32, r, h); ma = mrow[(size_t)(kt + 2) * 64]; }
            kv64_step(tb, qf, true, mb, c, mm, ll, O); }
    }
    ll += __shfl_xor(ll, 32);
    const float il = 1.0f / ll; bf16_t* yrow = Y + (size_t)(tokb + t) * DM + 768 + hd * 64;
#pragma unroll
    for (int et = 0; et < 2; ++et)
#pragma unroll
        for (int g = 0; g < 4; ++g) { u32x2 w; w.x = pk2(O[et][4 * g] * il, O[et][4 * g + 1] * il); w.y = pk2(O[et][4 * g + 2] * il, O[et][4 * g + 3] * il);
            *(u32x2*)(yrow + et * 32 + 8 * g + 4 * h) = w; }
}

constexpr int CA_KB = 64 * 144, CA_VB = 64 * 136, CA_BUF = CA_KB + CA_VB;
template <bool DIFF>
DI void causal_attn_block(const Ctx& C, const Params& P, int l) {
    const bf16_t* PROJ = (const bf16_t*)(P.ws + WS_R1 + R1_PROJ); const bf16_t* VT = (const bf16_t*)(P.ws + WS_R1 + R1_VT); bf16_t* Y = wsp<bf16_t>(P, WS_Y);
    const unsigned short* MASK = wsp<unsigned short>(P, WS_MASK);
    const int bh = (C.bid >> 4) & 15, g = C.bid & 15, j0 = 4 * g, b = bh >> 2, hd = bh & 3, tokb = b * SEQ;
#if (PROBE_DUP & 262144)
    const int qs = ((C.wave & 1) == 0) ? 127 - (j0 + (C.wave >> 1)) : j0 + (C.wave >> 1);
#else
    const int qs = (C.wave < 4) ? 127 - (j0 + C.wave) : j0 + (C.wave - 4);
#endif
    const int r = C.lane & 31, h = C.lane >> 5, q0 = qs * 32, t = q0 + r;
    const int nsub = qs + 1, NT = (128 - j0 + 1) >> 1;
    const int kcol = DIFF ? PC_AK + hd * 64 : PC_DK, vrb = DIFF ? hd * 64 : 256;
    const int srow = C.tid >> 3, sch = C.tid & 7;
    const bf16_t* kg = PROJ + (size_t)(tokb + srow) * PROJ_LD + kcol + sch * 8;
    const bf16_t* vg = VT + (size_t)(vrb + srow) * NTOK + tokb + sch * 8;
    LAS unsigned char* kdst = C.lds + srow * 144 + sch * 16; LAS unsigned char* vdst = C.lds + CA_KB + srow * 136 + sch * 16;
    bf16x8 qfd[2][2], qf4[4];
    if constexpr (DIFF) {
#pragma unroll
        for (int m = 0; m < 2; ++m)
#pragma unroll
            for (int s = 0; s < 2; ++s) qfd[m][s] = *(const bf16x8*)(PROJ + (size_t)(tokb + t) * PROJ_LD + PC_AQ + hd * 64 + m * 32 + 16 * s + 8 * h);
    } else {
#pragma unroll
        for (int s = 0; s < 4; ++s) qf4[s] = *(const bf16x8*)(PROJ + (size_t)(tokb + t) * PROJ_LD + PC_DQ + hd * 64 + 16 * s + 8 * h);
    }
    f32x16 O[2][2]; float mm[2] = {-1e30f, -1e30f}, ll[2] = {0.f, 0.f};
#pragma unroll
    for (int m = 0; m < 2; ++m) { O[m][0] = zero16(); O[m][1] = zero16(); }
    const float c = (DIFF ? 0.17677669529663687f : 0.125f) * 1.4426950408889634f;
    const unsigned dmask = causal_mask(r, h);
    const unsigned short* mrow = MASK + ((size_t)(b * 128 + qs) * 128) * 64 + C.lane;
    u32x4 kreg = *(const u32x4*)kg, vreg = *(const u32x4*)vg, kr2, vr2;
    unsigned mcur[2] = {0u, 0u}, mnxt[2] = {0u, 0u}, mn2[2] = {0u, 0u};
    if constexpr (!DIFF) { mcur[0] = mrow[0]; if (1 < nsub) mcur[1] = mrow[64]; if (2 < nsub) mnxt[0] = mrow[128]; if (3 < nsub) mnxt[1] = mrow[192]; }
    *(LAS u32x4*)kdst = kreg; *(LAS u32x2*)vdst = (u32x2){vreg.x, vreg.y}; *(LAS u32x2*)(vdst + 8) = (u32x2){vreg.z, vreg.w};
    if (1 < NT) { kreg = *(const u32x4*)(kg + (size_t)64 * PROJ_LD); vreg = *(const u32x4*)(vg + 64); }
    __syncthreads();
    for (int T = 0; T < NT; ++T) {
        const int cur = T & 1;
        if (T + 2 < NT) { kr2 = *(const u32x4*)(kg + (size_t)(T + 2) * 64 * PROJ_LD); vr2 = *(const u32x4*)(vg + (T + 2) * 64);
            if constexpr (!DIFF) { if (2 * T + 4 < nsub) mn2[0] = mrow[(size_t)(2 * T + 4) * 64]; if (2 * T + 5 < nsub) mn2[1] = mrow[(size_t)(2 * T + 5) * 64]; } }
        const LAS unsigned char* KB = C.lds + cur * CA_BUF; const LAS unsigned char* VB = KB + CA_KB;
#pragma unroll
        for (int sub = 0; sub < 2; ++sub) {
            const int st = 2 * T + sub;
            if (st < nsub) {
                const LAS unsigned char* krow = KB + (sub * 32 + r) * 144 + h * 16;
                const LAS unsigned char* v0 = VB + r * 136 + (sub * 32 + 4 * h) * 2; const LAS unsigned char* v1 = v0 + 32 * 136;
                if constexpr (DIFF) {
                    DiffKV tl;
#pragma unroll
                    for (int m = 0; m < 2; ++m)
#pragma unroll
                        for (int s = 0; s < 2; ++s) tl.kf[m][s] = *(const LAS bf16x8*)(krow + m * 64 + s * 32);
#pragma unroll
                    for (int s2 = 0; s2 < 2; ++s2) {
                        { const u32x2 lo = *(const LAS u32x2*)(v0 + s2 * 32), hi = *(const LAS u32x2*)(v0 + s2 * 32 + 16); u32x4 w; w.x = lo.x; w.y = lo.y; w.z = hi.x; w.w = hi.y; tl.vf[0][s2] = __builtin_bit_cast(bf16x8, w); }
                        { const u32x2 lo = *(const LAS u32x2*)(v1 + s2 * 32), hi = *(const LAS u32x2*)(v1 + s2 * 32 + 16); u32x4 w; w.x = lo.x; w.y = lo.y; w.z = hi.x; w.w = hi.y; tl.vf[1][s2] = __builtin_bit_cast(bf16x8, w); } }
                    diff_step(tl, qfd, st == nsub - 1, dmask, c, mm, ll, O);
                } else {
                    KV64 tl; const unsigned vm = mcur[sub];
#pragma unroll
                    for (int s = 0; s < 4; ++s) tl.kf[s] = *(const LAS bf16x8*)(krow + s * 32);
#pragma unroll
                    for (int s2 = 0; s2 < 2; ++s2) {
                        { const u32x2 lo = *(const LAS u32x2*)(v0 + s2 * 32), hi = *(const LAS u32x2*)(v0 + s2 * 32 + 16); u32x4 w; w.x = lo.x; w.y = lo.y; w.z = hi.x; w.w = hi.y; tl.vf[0][s2] = __builtin_bit_cast(bf16x8, w); }
                        { const u32x2 lo = *(const LAS u32x2*)(v1 + s2 * 32), hi = *(const LAS u32x2*)(v1 + s2 * 32 + 16); u32x4 w; w.x = lo.x; w.y = lo.y; w.z = hi.x; w.w = hi.y; tl.vf[1][s2] = __builtin_bit_cast(bf16x8, w); } }
                    kv64_step(tl, qf4, true, vm, c, mm[0], ll[0], O[0]);
                }
            }
        }
        if (T + 1 < NT) { LAS unsigned char* kd = kdst + (cur ^ 1) * CA_BUF; LAS unsigned char* vd = vdst + (cur ^ 1) * CA_BUF;
            *(LAS u32x4*)kd = kreg; *(LAS u32x2*)vd = (u32x2){vreg.x, vreg.y}; *(LAS u32x2*)(vd + 8) = (u32x2){vreg.z, vreg.w}; }
        kreg = kr2; vreg = vr2; mcur[0] = mnxt[0]; mcur[1] = mnxt[1]; mnxt[0] = mn2[0]; mnxt[1] = mn2[1];
        __syncthreads();
    }
    if constexpr (DIFF) {
        const float* lv = P.diff_lambda + l * 128;
        const float d1 = wave_sum(C.lane < 32 ? lv[C.lane] * lv[32 + C.lane] : 0.f), d2 = wave_sum(C.lane < 32 ? lv[64 + C.lane] * lv[96 + C.lane] : 0.f);
        const float lam_init = 0.8f - 0.6f * expf(-0.3f * (float)l), lam = expf(d1) - expf(d2) + lam_init;
        ll[0] += __shfl_xor(ll[0], 32); ll[1] += __shfl_xor(ll[1], 32);
        const float i0 = 1.0f / ll[0], i1 = lam / ll[1]; float ss = 0.f;
#pragma unroll
        for (int et = 0; et < 2; ++et)
#pragma unroll
            for (int i = 0; i < 16; ++i) { const float o = O[0][et][i] * i0 - O[1][et][i] * i1; O[0][et][i] = o; ss += o * o; }
        ss += __shfl_xor(ss, 32);
        const float rn = (1.0f - lam_init) / sqrtf(ss * (1.0f / 64.0f) + 1e-6f);
        bf16_t* yrow = Y + (size_t)(tokb + t) * DM + hd * 64;
#pragma unroll
        for (int et = 0; et < 2; ++et)
#pragma unroll
            for (int gq = 0; gq < 4; ++gq) { u32x2 w; w.x = pk2(O[0][et][4 * gq] * rn, O[0][et][4 * gq + 1] * rn); w.y = pk2(O[0][et][4 * gq + 2] * rn, O[0][et][4 * gq + 3] * rn);
                *(u32x2*)(yrow + et * 32 + 8 * gq + 4 * h) = w; }
    } else {
        ll[0] += __shfl_xor(ll[0], 32);
        const float il = 1.0f / ll[0]; bf16_t* yrow = Y + (size_t)(tokb + t) * DM + 768 + hd * 64;
#pragma unroll
        for (int et = 0; et < 2; ++et)
#pragma unroll
            for (int gq = 0; gq < 4; ++gq) { u32x2 w; w.x = pk2(O[0][et][4 * gq] * il, O[0][et][4 * gq + 1] * il); w.y = pk2(O[0][et][4 * gq + 2] * il, O[0][et][4 * gq + 3] * il);
                *(u32x2*)(yrow + et * 32 + 8 * gq + 4 * h) = w; }
    }
    __syncthreads();
}

constexpr int CB_KB = 128 * 144, CB_VB = 64 * 264, CB_BUF = CB_KB + CB_VB;
template <bool DIFF>
DI void causal_attn_unit2(const Ctx& C, const Params& P, int l, int bh, int G) {
    const bf16_t* PROJ = (const bf16_t*)(P.ws + WS_R1 + R1_PROJ); const bf16_t* VT = (const bf16_t*)(P.ws + WS_R1 + R1_VT); bf16_t* Y = wsp<bf16_t>(P, WS_Y);
    const unsigned short* MASK = wsp<unsigned short>(P, WS_MASK);
    const int b = bh >> 2, hd = bh & 3, tokb = b * SEQ;
    const int qs = 4 * G + (C.wave & 3), par = C.wave >> 2;
    const int r = C.lane & 31, h = C.lane >> 5, q0 = qs * 32, t = q0 + r;
    const int NT = G + 1;
    const int kcol = DIFF ? PC_AK + hd * 64 : PC_DK, vrb = DIFF ? hd * 64 : 256;
    const int srow = C.tid >> 3, sch = C.tid & 7;
    const bf16_t* kg = PROJ + (size_t)(tokb + srow) * PROJ_LD + kcol + sch * 8;
    const bf16_t* vg = VT + (size_t)(vrb + srow) * NTOK + tokb + sch * 8;
    LAS unsigned char* kdst = C.lds + srow * 144 + sch * 16; LAS unsigned char* vdst = C.lds + CB_KB + srow * 264 + sch * 16;
    bf16x8 qfd[2][2], qf4[4];
    if constexpr (DIFF) {
#pragma unroll
        for (int m = 0; m < 2; ++m)
#pragma unroll
            for (int s = 0; s < 2; ++s) qfd[m][s] = *(const bf16x8*)(PROJ + (size_t)(tokb + t) * PROJ_LD + PC_AQ + hd * 64 + m * 32 + 16 * s + 8 * h);
    } else {
#pragma unroll
        for (int s = 0; s < 4; ++s) qf4[s] = *(const bf16x8*)(PROJ + (size_t)(tokb + t) * PROJ_LD + PC_DQ + hd * 64 + 16 * s + 8 * h);
    }
    f32x16 O[2][2]; float mm[2] = {-1e30f, -1e30f}, ll[2] = {0.f, 0.f};
#pragma unroll
    for (int m = 0; m < 2; ++m) { O[m][0] = zero16(); O[m][1] = zero16(); }
    const float c = (DIFF ? 0.17677669529663687f : 0.125f) * 1.4426950408889634f;
    const unsigned dmask = causal_mask(r, h);
    const unsigned short* mrow = MASK + ((size_t)(b * 128 + qs) * 128) * 64 + C.lane;
    u32x4 kr[2], vr[2];
#define CB_GLOAD(T_) do { kr[0] = *(const u32x4*)(kg + (size_t)((T_) * 128) * PROJ_LD); kr[1] = *(const u32x4*)(kg + (size_t)((T_) * 128 + 64) * PROJ_LD); \
        vr[0] = *(const u32x4*)(vg + (T_) * 128); vr[1] = *(const u32x4*)(vg + (T_) * 128 + 64); } while (0)
#define CB_LSTORE(buf_) do { LAS unsigned char* kd_ = kdst + (buf_) * CB_BUF; LAS unsigned char* vd_ = vdst + (buf_) * CB_BUF; \
        *(LAS u32x4*)kd_ = kr[0]; *(LAS u32x4*)(kd_ + 64 * 144) = kr[1]; \
        *(LAS u32x2*)vd_ = (u32x2){vr[0].x, vr[0].y}; *(LAS u32x2*)(vd_ + 8) = (u32x2){vr[0].z, vr[0].w}; \
        *(LAS u32x2*)(vd_ + 128) = (u32x2){vr[1].x, vr[1].y}; *(LAS u32x2*)(vd_ + 136) = (u32x2){vr[1].z, vr[1].w}; } while (0)
    unsigned mcur[2] = {0u, 0u}, mnxt[2] = {0u, 0u};
    if constexpr (!DIFF) { if (par <= qs) mcur[0] = mrow[(size_t)par * 64]; if (par + 2 <= qs) mcur[1] = mrow[(size_t)(par + 2) * 64]; }
    CB_GLOAD(0); CB_LSTORE(0);
    __syncthreads();
    int cur = 0;
    for (int T = 0; T < NT; ++T) {
        const int nxb = (cur == 2) ? 0 : cur + 1;
        if (T + 1 < NT) { CB_GLOAD(T + 1);
            if constexpr (!DIFF) { const int s0 = 4 * (T + 1) + par; if (s0 <= qs) mnxt[0] = mrow[(size_t)s0 * 64]; if (s0 + 2 <= qs) mnxt[1] = mrow[(size_t)(s0 + 2) * 64]; } }
        const LAS unsigned char* KB = C.lds + cur * CB_BUF; const LAS unsigned char* VB = KB + CB_KB;
#pragma unroll
        for (int k2 = 0; k2 < 2; ++k2) {
            if (k2 == 1 && par == 1) { if (T + 1 < NT) CB_LSTORE(nxb); __syncthreads(); }
            const int sub = par + 2 * k2, st = 4 * T + sub;
            if (st <= qs) {
                const LAS unsigned char* krow = KB + (sub * 32 + r) * 144 + h * 16;
                const LAS unsigned char* v0 = VB + r * 264 + (sub * 32 + 4 * h) * 2; const LAS unsigned char* v1 = v0 + 32 * 264;
                if constexpr (DIFF) {
                    DiffKV tl;
#pragma unroll
                    for (int m = 0; m < 2; ++m)
#pragma unroll
                        for (int s = 0; s < 2; ++s) tl.kf[m][s] = *(const LAS bf16x8*)(krow + m * 64 + s * 32);
#pragma unroll
                    for (int s2 = 0; s2 < 2; ++s2) {
                        { const u32x2 lo = *(const LAS u32x2*)(v0 + s2 * 32), hi = *(const LAS u32x2*)(v0 + s2 * 32 + 16); u32x4 w; w.x = lo.x; w.y = lo.y; w.z = hi.x; w.w = hi.y; tl.vf[0][s2] = __builtin_bit_cast(bf16x8, w); }
                        { const u32x2 lo = *(const LAS u32x2*)(v1 + s2 * 32), hi = *(const LAS u32x2*)(v1 + s2 * 32 + 16); u32x4 w; w.x = lo.x; w.y = lo.y; w.z = hi.x; w.w = hi.y; tl.vf[1][s2] = __builtin_bit_cast(bf16x8, w); } }
                    diff_step(tl, qfd, st == qs, dmask, c, mm, ll, O);
                } else {
                    KV64 tl; const unsigned vm = mcur[k2];
#pragma unroll
                    for (int s = 0; s < 4; ++s) tl.kf[s] = *(const LAS bf16x8*)(krow + s * 32);
#pragma unroll
                    for (int s2 = 0; s2 < 2; ++s2) {
                        { const u32x2 lo = *(const LAS u32x2*)(v0 + s2 * 32), hi = *(const LAS u32x2*)(v0 + s2 * 32 + 16); u32x4 w; w.x = lo.x; w.y = lo.y; w.z = hi.x; w.w = hi.y; tl.vf[0][s2] = __builtin_bit_cast(bf16x8, w); }
                        { const u32x2 lo = *(const LAS u32x2*)(v1 + s2 * 32), hi = *(const LAS u32x2*)(v1 + s2 * 32 + 16); u32x4 w; w.x = lo.x; w.y = lo.y; w.z = hi.x; w.w = hi.y; tl.vf[1][s2] = __builtin_bit_cast(bf16x8, w); } }
                    kv64_step(tl, qf4, true, vm, c, mm[0], ll[0], O[0]);
                }
            }
        }
        if (par == 0) { if (T + 1 < NT) CB_LSTORE(nxb); __syncthreads(); }
        mcur[0] = mnxt[0]; mcur[1] = mnxt[1]; cur = nxb;
    }
#undef CB_GLOAD
#undef CB_LSTORE
    constexpr int NM = DIFF ? 2 : 1, NV = NM * 34;
    LAS float* MA = (LAS float*)C.lds + (size_t)(C.wave & 3) * 64 * NV + C.lane;
    __syncthreads();
    if (par == 1) {
#pragma unroll
        for (int m = 0; m < NM; ++m) { MA[(m * 34 + 0) * 64] = mm[m]; MA[(m * 34 + 1) * 64] = ll[m];
#pragma unroll
            for (int et = 0; et < 2; ++et)
#pragma unroll
                for (int i = 0; i < 16; ++i) MA[(m * 34 + 2 + et * 16 + i) * 64] = O[m][et][i]; }
    }
    __syncthreads();
    if (par == 0) {
#pragma unroll
        for (int m = 0; m < NM; ++m) { const float mB = MA[(m * 34 + 0) * 64], lB = MA[(m * 34 + 1) * 64];
            const float mn = fmaxf(mm[m], mB), aA = __builtin_amdgcn_exp2f((mm[m] - mn) * c), aB = __builtin_amdgcn_exp2f((mB - mn) * c);
            ll[m] = ll[m] * aA + lB * aB;
#pragma unroll
            for (int et = 0; et < 2; ++et)
#pragma unroll
                for (int i = 0; i < 16; ++i) O[m][et][i] = O[m][et][i] * aA + MA[(m * 34 + 2 + et * 16 + i) * 64] * aB; }
        if constexpr (DIFF) {
            const float* lv = P.diff_lambda + l * 128;
            const float d1 = wave_sum(C.lane < 32 ? lv[C.lane] * lv[32 + C.lane] : 0.f), d2 = wave_sum(C.lane < 32 ? lv[64 + C.lane] * lv[96 + C.lane] : 0.f);
            const float lam_init = 0.8f - 0.6f * expf(-0.3f * (float)l), lam = expf(d1) - expf(d2) + lam_init;
            ll[0] += __shfl_xor(ll[0], 32); ll[1] += __shfl_xor(ll[1], 32);
            const float i0 = 1.0f / ll[0], i1 = lam / ll[1]; float ss = 0.f;
#pragma unroll
            for (int et = 0; et < 2; ++et)
#pragma unroll
                for (int i = 0; i < 16; ++i) { const float o = O[0][et][i] * i0 - O[1][et][i] * i1; O[0][et][i] = o; ss += o * o; }
            ss += __shfl_xor(ss, 32);
            const float rn = (1.0f - lam_init) / sqrtf(ss * (1.0f / 64.0f) + 1e-6f);
            bf16_t* yrow = Y + (size_t)(tokb + t) * DM + hd * 64;
#pragma unroll
            for (int et = 0; et < 2; ++et)
#pragma unroll
                for (int gq = 0; gq < 4; ++gq) { u32x2 w; w.x = pk2(O[0][et][4 * gq] * rn, O[0][et][4 * gq + 1] * rn); w.y = pk2(O[0][et][4 * gq + 2] * rn, O[0][et][4 * gq + 3] * rn);
                    *(u32x2*)(yrow + et * 32 + 8 * gq + 4 * h) = w; }
        } else {
            ll[0] += __shfl_xor(ll[0], 32);
            const float il = 1.0f / ll[0]; bf16_t* yrow = Y + (size_t)(tokb + t) * DM + 768 + hd * 64;
#pragma unroll
            for (int et = 0; et < 2; ++et)
#pragma unroll
                for (int gq = 0; gq < 4; ++gq) { u32x2 w; w.x = pk2(O[0][et][4 * gq] * il, O[0][et][4 * gq + 1] * il); w.y = pk2(O[0][et][4 * gq + 2] * il, O[0][et][4 * gq + 3] * il);
                    *(u32x2*)(yrow + et * 32 + 8 * gq + 4 * h) = w; }
        }
    }
    __syncthreads();
}
template <bool DIFF>
DI void causal_attn_block2(const Ctx& C, const Params& P, int l) {
    const int bh = (C.bid >> 4) & 15, gi = C.bid & 15;
    causal_attn_unit2<DIFF>(C, P, l, bh, 31 - gi);
    causal_attn_unit2<DIFF>(C, P, l, bh, gi);
}

DI void mem_attn_block(const Ctx& C, const Params& P, int l) {
    const bf16_t* MQ = (const bf16_t*)(P.ws + WS_R1 + R1_MQ); bf16_t* MO = (bf16_t*)(P.ws + WS_R1 + R1_MO);
    const bf16_t* MK = wsp<bf16_t>(P, WS_MK) + (size_t)l * 1024 * 256; const bf16_t* MVT = wsp<bf16_t>(P, WS_MVT) + (size_t)l * 256 * 1024;
    const int bh = (C.bid >> 4) & 15, grp = C.bid & 15, b = bh >> 2, hd = bh & 3, r = C.lane & 31, h = C.lane >> 5;
    const int t = b * SEQ + (grp * 8 + C.wave) * 32 + r;
    bf16x8 qf[4];
#pragma unroll
    for (int s = 0; s < 4; ++s) qf[s] = *(const bf16x8*)(MQ + (size_t)t * 256 + hd * 64 + 16 * s + 8 * h);
    { u32x4 kr[4], vr[4];
#pragma unroll
      for (int j = 0; j < 4; ++j) { const int ci = C.tid + 512 * j;
          kr[j] = *(const u32x4*)(MK + (size_t)(b * 256 + (ci >> 3)) * 256 + hd * 64 + (ci & 7) * 8);
          vr[j] = *(const u32x4*)(MVT + (size_t)(hd * 64 + (ci >> 5)) * 1024 + b * 256 + (ci & 31) * 8); }
#pragma unroll
      for (int j = 0; j < 4; ++j) { const int ci = C.tid + 512 * j;
          *(LAS u32x4*)(C.lds + (ci >> 3) * 144 + (ci & 7) * 16) = kr[j];
          LAS unsigned char* vd = C.lds + 36864 + (ci >> 5) * 520 + (ci & 31) * 16;
          *(LAS u32x2*)vd = (u32x2){vr[j].x, vr[j].y}; *(LAS u32x2*)(vd + 8) = (u32x2){vr[j].z, vr[j].w}; } }
    __syncthreads();
    f32x16 O[2] = {zero16(), zero16()}; float mm = -1e30f, ll = 0.f;
    const float c = 0.125f * 1.4426950408889634f;
#pragma unroll 2
    for (int kt = 0; kt < 8; ++kt) {
        KV64 tl; const LAS unsigned char* krow = C.lds + (kt * 32 + r) * 144 + h * 16;
        const LAS unsigned char* v0 = C.lds + 36864 + r * 520 + (kt * 32 + 4 * h) * 2; const LAS unsigned char* v1 = v0 + 32 * 520;
#pragma unroll
        for (int s = 0; s < 4; ++s) tl.kf[s] = *(const LAS bf16x8*)(krow + s * 32);
#pragma unroll
        for (int s2 = 0; s2 < 2; ++s2) {
            { const u32x2 lo = *(const LAS u32x2*)(v0 + s2 * 32), hi = *(const LAS u32x2*)(v0 + s2 * 32 + 16); u32x4 w; w.x = lo.x; w.y = lo.y; w.z = hi.x; w.w = hi.y; tl.vf[0][s2] = __builtin_bit_cast(bf16x8, w); }
            { const u32x2 lo = *(const LAS u32x2*)(v1 + s2 * 32), hi = *(const LAS u32x2*)(v1 + s2 * 32 + 16); u32x4 w; w.x = lo.x; w.y = lo.y; w.z = hi.x; w.w = hi.y; tl.vf[1][s2] = __builtin_bit_cast(bf16x8, w); } }
        kv64_step(tl, qf, false, 0u, c, mm, ll, O);
    }
    ll += __shfl_xor(ll, 32);
    const float il = 1.0f / ll; bf16_t* orow = MO + (size_t)t * 256 + hd * 64;
#pragma unroll
    for (int et = 0; et < 2; ++et)
#pragma unroll
        for (int g = 0; g < 4; ++g) { u32x2 w; w.x = pk2(O[et][4 * g] * il, O[et][4 * g + 1] * il); w.y = pk2(O[et][4 * g + 2] * il, O[et][4 * g + 3] * il);
            *(u32x2*)(orow + et * 32 + 8 * g + 4 * h) = w; }
    __syncthreads();
}
DI void mma_lds(f32x16& acc, const LAS bf16_t* A, int lda, const LAS bf16_t* Bt, int ldb, int K, int lane) {
    const int r = lane & 31, h = lane >> 5;
    for (int k0 = 0; k0 < K; k0 += 16) {
        const bf16x8 a = *(const LAS bf16x8*)(A + r * lda + k0 + 8 * h);
        const bf16x8 b = *(const LAS bf16x8*)(Bt + r * ldb + k0 + 8 * h);
        acc = mfma32(a, b, acc);
    }
}

constexpr int HG_BC = 0, HG_QT = 32768, HG_KT = 50176, HG_VT = 67584, HG_ST = 86016, HG_AT = 104448;
DI float hgrn_lb(const Params& P, int l, int ch) { if (l == 0) return 0.f; const float z0 = P.hgrn_lb[ch], z1 = P.hgrn_lb[256 + ch]; return 1.0f / (1.0f + expf(z0 - z1)); }
DI void hgrn_cumsum(const Ctx& C, const Params& P, int l, const float (&fpv)[16], int ch0) {
    LAS float* BC = (LAS float*)(C.lds + HG_BC);
    const float lb = hgrn_lb(P, l, ch0 + (C.tid & 127));
#pragma unroll
    for (int j = 0; j < 16; ++j) { const float f = lb + (1.0f - lb) * frcp(1.0f + fexp(fminf(-fpv[j], 80.f))); BC[C.tid + 512 * j] = flog(fmaxf(f, 1e-30f)); }
    __syncthreads();
    if (C.tid < 128) { float cum = 0.f;
#pragma unroll 8
        for (int s = 0; s < 64; ++s) { cum += BC[s * 128 + C.tid]; BC[s * 128 + C.tid] = cum; } }
    __syncthreads();
}
DI void hgrn_local_unit(const Ctx& C, const Params& P, int l, int u) {
    const bf16_t* PROJ = (const bf16_t*)(P.ws + WS_R1 + R1_PROJ); float* HS = wsp<float>(P, WS_HS); float* HD = wsp<float>(P, WS_HD);
    const int hp = u & 1, bc = u >> 1, b = bc >> 6, c = bc & 63, tok0 = b * SEQ + c * 64, ch0 = hp * 128;
    LAS float* BC = (LAS float*)(C.lds + HG_BC); LAS bf16_t* KT = (LAS bf16_t*)(C.lds + HG_QT);   LAS bf16_t* VT = (LAS bf16_t*)(C.lds + HG_VT);
    const int cl = C.tid & 127, ch = ch0 + cl; const float lb = hgrn_lb(P, l, ch);
    float fpv[16]; bf16_t vv[16];
#pragma unroll
    for (int j = 0; j < 16; ++j) { const bf16_t* row = PROJ + (size_t)(tok0 + (C.tid >> 7) + 4 * j) * PROJ_LD; fpv[j] = bf2f(row[PC_BF + ch]); vv[j] = row[PC_BI + ch]; }
    hgrn_cumsum(C, P, l, fpv, ch0);
#pragma unroll
    for (int j = 0; j < 16; ++j) { const int s = (C.tid >> 7) + 4 * j; const float kk = (1.0f - lb) * frcp(1.0f + fexp(fminf(fpv[j], 80.f)));
        KT[cl * 72 + s] = f2bf(kk * fexp(BC[63 * 128 + cl] - BC[s * 128 + cl])); VT[cl * 72 + s] = vv[j]; }
    if (C.tid < 128) HD[(size_t)bc * 256 + ch0 + C.tid] = fexp(BC[63 * 128 + C.tid]);
    __syncthreads();
    { const int h2 = C.wave >> 2, dkt = (C.wave >> 1) & 1, dvt = C.wave & 1, r = C.lane & 31, h = C.lane >> 5;
      f32x16 acc = zero16();
      mma_lds(acc, KT + (h2 * 64 + dkt * 32) * 72, 72, VT + (h2 * 64 + dvt * 32) * 72, 72, 64, C.lane);
      float* dst = HS + ((size_t)(bc * 4 + hp * 2 + h2) * 64) * 64;
#pragma unroll
      for (int i = 0; i < 16; ++i) dst[(dkt * 32 + crow(i, h)) * 64 + dvt * 32 + r] = acc[i]; }
    __syncthreads();
}
DI void hgrn_scan_unit(const Ctx& C, const Params& P, int u) {
    float* HS = wsp<float>(P, WS_HS); const float* HD = wsp<float>(P, WS_HD);
    const int id = u * NTHREADS + C.tid;
    const int bh = id >> 12, e = id & 4095, b = bh >> 2, hh = bh & 3, dk = e >> 6;
    float Lv[64], Dv[64];
#pragma unroll
    for (int c = 0; c < 64; ++c) { const size_t bc = (size_t)b * 64 + c; Lv[c] = HS[((bc * 4 + hh) << 12) + e]; Dv[c] = HD[bc * 256 + hh * 64 + dk]; }
    float S = 0.f;
#pragma unroll
    for (int c = 0; c < 64; ++c) { const size_t bc = (size_t)b * 64 + c; HS[((bc * 4 + hh) << 12) + e] = S; S = Dv[c] * S + Lv[c]; }
}
DI void hgrn_out_unit(const Ctx& C, const Params& P, int l, int u) {
    const bf16_t* PROJ = (const bf16_t*)(P.ws + WS_R1 + R1_PROJ); const float* HS = wsp<float>(P, WS_HS); bf16_t* Y = wsp<bf16_t>(P, WS_Y);
    const int hp = u & 1, bc = u >> 1, b = bc >> 6, c = bc & 63, tok0 = b * SEQ + c * 64, ch0 = hp * 128;
    LAS float* BC = (LAS float*)(C.lds + HG_BC); LAS bf16_t* QT = (LAS bf16_t*)(C.lds + HG_QT); LAS bf16_t* KT = (LAS bf16_t*)(C.lds + HG_KT);
    LAS bf16_t* VT = (LAS bf16_t*)(C.lds + HG_VT); LAS bf16_t* ST = (LAS bf16_t*)(C.lds + HG_ST); LAS bf16_t* AT = (LAS bf16_t*)(C.lds + HG_AT);
    const int cl = C.tid & 127, ch = ch0 + cl; const float lb = hgrn_lb(P, l, ch);
    float fpv[16], qv16[16], sp16[16]; bf16_t vv[16];
#pragma unroll
    for (int j = 0; j < 16; ++j) { const bf16_t* row = PROJ + (size_t)(tok0 + (C.tid >> 7) + 4 * j) * PROJ_LD; fpv[j] = bf2f(row[PC_BF + ch]); qv16[j] = bf2f(row[PC_BQ + ch]); vv[j] = row[PC_BI + ch];
        sp16[j] = HS[(((size_t)bc * 4 + hp * 2) << 12) + C.tid + 512 * j]; }
    hgrn_cumsum(C, P, l, fpv, ch0);
#pragma unroll
    for (int j = 0; j < 16; ++j) { const int s = (C.tid >> 7) + 4 * j; const float kk = (1.0f - lb) * frcp(1.0f + fexp(fminf(fpv[j], 80.f)));
        const float q = qv16[j] * frcp(1.0f + fexp(fminf(-qv16[j], 80.f)));
        const float bs = BC[s * 128 + cl], br = BC[31 * 128 + cl];
        QT[s * 136 + cl] = f2bf(q * fexp(fminf(bs - br, 80.f)));
        KT[s * 136 + cl] = f2bf(kk * fexp(fminf(br - bs, 80.f)));
        VT[cl * 72 + s] = vv[j]; }
#pragma unroll
    for (int j = 0; j < 16; ++j) { const int i = C.tid + 512 * j, h2 = i >> 12, e = i & 4095, dk = e >> 6, dv = e & 63;
        ST[(h2 * 64 + dv) * 72 + dk] = f2bf(sp16[j] * fexp(BC[31 * 128 + h2 * 64 + dk])); }
    __syncthreads();
    {
      const int h2 = C.wave >> 2, tt = (C.wave >> 1) & 1, st = C.wave & 1, r = C.lane & 31, h = C.lane >> 5;
      if (st <= tt) { f32x16 acc = zero16();
          mma_lds(acc, QT + (tt * 32) * 136 + h2 * 64, 136, KT + (st * 32) * 136 + h2 * 64, 136, 64, C.lane);
#pragma unroll
          for (int i = 0; i < 16; ++i) { const int t = tt * 32 + crow(i, h), s = st * 32 + r; AT[(h2 * 64 + t) * 72 + s] = (s <= t) ? f2bf(acc[i]) : (bf16_t)0; } } }
    __syncthreads();
    if (C.wave < 4) {
      const int h2 = C.wave >> 1, tt = C.wave & 1, r = C.lane & 31, h = C.lane >> 5;
      f32x16 o[2] = {zero16(), zero16()};
#pragma unroll
      for (int dvt = 0; dvt < 2; ++dvt) {
          mma_lds(o[dvt], VT + (h2 * 64 + dvt * 32) * 72, 72, AT + (h2 * 64 + tt * 32) * 72, 72, (tt + 1) * 32, C.lane);
          mma_lds(o[dvt], ST + (h2 * 64 + dvt * 32) * 72, 72, QT + (tt * 32) * 136 + h2 * 64, 136, 64, C.lane); }
      float ss = 0.f;
#pragma unroll
      for (int dvt = 0; dvt < 2; ++dvt)
#pragma unroll
          for (int i = 0; i < 16; ++i) ss += o[dvt][i] * o[dvt][i];
      ss += __shfl_xor(ss, 32);
      const float rn = 1.0f / sqrtf(ss * (1.0f / 64.0f) + 1e-6f);
      const int t = tok0 + tt * 32 + r, chb = ch0 + h2 * 64;
      const bf16_t* grow = PROJ + (size_t)t * PROJ_LD + PC_BG + chb; bf16_t* yrow = Y + (size_t)t * DM + 256 + chb;
#pragma unroll
      for (int dvt = 0; dvt < 2; ++dvt)
#pragma unroll
          for (int g = 0; g < 4; ++g) { const int dv = dvt * 32 + 8 * g + 4 * h; const u32x2 gw = *(const u32x2*)(grow + dv);
              const float g0 = siluf_(bflo(gw.x)), g1 = siluf_(bfhi(gw.x)), g2 = siluf_(bflo(gw.y)), g3 = siluf_(bfhi(gw.y));
              u32x2 w; w.x = pk2(o[dvt][4 * g] * rn * g0, o[dvt][4 * g + 1] * rn * g1); w.y = pk2(o[dvt][4 * g + 2] * rn * g2, o[dvt][4 * g + 3] * rn * g3);
              *(u32x2*)(yrow + dv) = w; } }
    __syncthreads();
}

DI void sgu_unit(const Ctx& C, const Params& P, int l, int u) {
    const bf16_t* PROJ = (const bf16_t*)(P.ws + WS_R1 + R1_PROJ); bf16_t* Y = wsp<bf16_t>(P, WS_Y); const bf16_t* SW = wsp<bf16_t>(P, W_SGU);
    const float* sb = P.spatial_b + l * 512;
    LAS bf16_t* VT = (LAS bf16_t*)C.lds; const int tok0 = (u >> 1) * 128, half = u & 1;
    u32x2 wv[16];
#pragma unroll
    for (int j = 0; j < 16; ++j) wv[j] = *(const u32x2*)(PROJ + (size_t)(tok0 + C.wave + NWAVES * j) * PROJ_LD + PC_CV + C.lane * 4);
#pragma unroll
    for (int j = 0; j < 16; ++j) {
        const int s = C.wave + NWAVES * j; const u32x2 w = wv[j];
        float v[4] = {gelu_tanh(bflo(w.x)), gelu_tanh(bfhi(w.x)), gelu_tanh(bflo(w.y)), gelu_tanh(bfhi(w.y))};
        const float mu = wave_sum(v[0] + v[1] + v[2] + v[3]) * (1.0f / 256.0f);
        float q = 0.f;
#pragma unroll
        for (int jj = 0; jj < 4; ++jj) { v[jj] -= mu; q += v[jj] * v[jj]; }
        const float rs = 1.0f / sqrtf(wave_sum(q) * (1.0f / 256.0f) + 1e-6f);
#pragma unroll
        for (int jj = 0; jj < 4; ++jj) VT[(C.lane * 4 + jj) * 136 + s] = f2bf(v[jj] * rs);
    }
    __syncthreads();
    { const int g = C.wave >> 1, dt = C.wave & 1, r = C.lane & 31, h = C.lane >> 5;
      for (int ti = 0; ti < 2; ++ti) { const int tt = half ? (1 + ti) : (ti * 3);
          f32x16 acc = zero16();
          const bf16_t* wrow = SW + ((size_t)g * 128 + tt * 32 + r) * 128 + 8 * h;
          const LAS bf16_t* vrow = VT + (g * 64 + dt * 32 + r) * 136 + 8 * h;
          bf16x8 af[8];
#pragma unroll
          for (int kk = 0; kk < 8; ++kk) af[kk] = *(const bf16x8*)(wrow + (kk < 2 * (tt + 1) ? kk * 16 : 0));
#pragma unroll
          for (int kk = 0; kk < 8; ++kk) if (kk < 2 * (tt + 1)) { const bf16x8 bb = *(const LAS bf16x8*)(vrow + kk * 16); acc = mfma32(af[kk], bb, acc); }
          const int ch = g * 64 + dt * 32 + r;
#pragma unroll
          for (int i = 0; i < 16; ++i) { const int t = tt * 32 + crow(i, h); const size_t tok = (size_t)(tok0 + t);
              const float uu = gelu_tanh(bf2f(PROJ[tok * PROJ_LD + PC_CU + ch]));
              Y[tok * DM + 512 + ch] = f2bf(uu * (acc[i] + sb[g * 128 + t])); } } }
    __syncthreads();
}

DI void phase_router(const Ctx& C, const Params& P, int l, const bool dry = false) {
    float* XR = P.out; bf16_t* H = wsp<bf16_t>(P, WS_H);
    int* TOKE = wsp<int>(P, WS_TOKE); float* TOKW = wsp<float>(P, WS_TOKW); int* RANK = wsp<int>(P, WS_RANK); int* ROWTOK = dry ? wsp<int>(P, WS_DUMMY) : wsp<int>(P, WS_ROWTOK);
    unsigned* CNT = wsp<unsigned>(P, WS_CTL) + CW_CNT + 64 * l + (dry ? 256 : 0);
    const float* gain = P.norm_ffn + l * DM;
    const float* brg = P.b_rg + l * 4; const float* bre = P.b_re + l * 32;
    LAS bf16_t* XHL = (LAS bf16_t*)C.lds; LAS float* PART = (LAS float*)C.lds; LAS float* LOG = (LAS float*)(C.lds + 32768);
    LAS unsigned* lcnt = (LAS unsigned*)(C.lds + LDS_MISC + 1024); LAS unsigned* lbase = lcnt + 32;
    if (C.tid < 32) lcnt[C.tid] = 0u;
    __syncthreads();
    const int per = NTOK / C.G;
    const int r = C.lane & 31, h = C.lane >> 5;
    for (int it = 0; it < per; it += 32) {
        const int tok0 = C.bid * per + it;
        { f32x4 v[4][4];
#pragma unroll
          for (int j = 0; j < 4; ++j) { const float* xr = XR + (size_t)(tok0 + C.wave * 4 + j) * DM;
#pragma unroll
              for (int q = 0; q < 4; ++q) v[j][q] = *(const f32x4*)(xr + q * 256 + C.lane * 4); }
#pragma unroll
          for (int j = 0; j < 4; ++j) { const int tl = C.wave * 4 + j, t = tok0 + tl; float ss = 0.f;
#pragma unroll
              for (int q = 0; q < 4; ++q) ss += v[j][q][0] * v[j][q][0] + v[j][q][1] * v[j][q][1] + v[j][q][2] * v[j][q][2] + v[j][q][3] * v[j][q][3];
              ss = wave_sum(ss); const float rs = 1.0f / sqrtf(ss * (1.0f / DM) + 1e-6f);
#pragma unroll
              for (int q = 0; q < 4; ++q) { const int c = q * 256 + C.lane * 4; const f32x4 g = *(const f32x4*)(gain + c);
                  const f32x4 o = (f32x4){v[j][q][0] * rs * g[0], v[j][q][1] * rs * g[1], v[j][q][2] * rs * g[2], v[j][q][3] * rs * g[3]};
                  u32x2 w; w.x = pk2(o[0], o[1]); w.y = pk2(o[2], o[3]); *(u32x2*)(H + (size_t)t * DM + c) = w;
                  { u32x2 wl; wl.x = pk2(o[0] - bflo(w.x), o[1] - bfhi(w.x)); wl.y = pk2(o[2] - bflo(w.y), o[3] - bfhi(w.y));
                    *(LAS u32x2*)(XHL + tl * 1032 + c) = w; *(LAS u32x2*)(XHL + 33024 + tl * 1032 + c) = wl; } } } }
        __syncthreads();
        f32x16 acc = zero16();
        { const int ct = C.wave & 1, kq = C.wave >> 1;
          const LAS bf16_t* ah = XHL + r * 1032 + kq * 256 + 8 * h; const LAS bf16_t* al = ah + 33024;
          const bf16_t* bh_ = wsp<bf16_t>(P, W_RH) + (size_t)(ct * 32 + r) * 1024 + kq * 256 + 8 * h; const bf16_t* bl_ = bh_ + (size_t)64 * 1024;
#pragma unroll 4
          for (int k0 = 0; k0 < 256; k0 += 16) { const bf16x8 xh = *(const LAS bf16x8*)(ah + k0), xl = *(const LAS bf16x8*)(al + k0);
              const bf16x8 wh = *(const bf16x8*)(bh_ + k0), wl = *(const bf16x8*)(bl_ + k0);
              acc = mfma32(xh, wh, acc); acc = mfma32(xh, wl, acc); acc = mfma32(xl, wh, acc); } }
        __syncthreads();
#pragma unroll
        for (int i = 0; i < 16; ++i) PART[(C.wave * 16 + i) * 64 + C.lane] = acc[i];
        __syncthreads();
        for (int idx = C.tid; idx < 32 * 36; idx += NTHREADS) { const int tok = idx / 36, col = idx % 36, ct = col < 32 ? 0 : 1, cc = col < 32 ? col : col - 32;
            const int hh = (tok >> 2) & 1, reg = (tok & 3) + 4 * (tok >> 3); float s = 0.f;
#pragma unroll
            for (int kq = 0; kq < 4; ++kq) s += PART[((kq * 2 + ct) * 16 + reg) * 64 + cc + 32 * hh];
            LOG[tok * 36 + col] = s; }
        __syncthreads();
        if (C.tid < 32) { const int t = tok0 + C.tid; const LAS float* lg = LOG + C.tid * 36;
            float gl[4]; int gsel = 0;
#pragma unroll
            for (int k = 0; k < 4; ++k) gl[k] = lg[32 + k] + brg[k];
            float gmax = gl[0];
#pragma unroll
            for (int k = 1; k < 4; ++k) if (gl[k] > gmax) { gmax = gl[k]; gsel = k; }
            float gsum = 0.f;
#pragma unroll
            for (int k = 0; k < 4; ++k) gsum += expf(gl[k] - gmax);
            const float pg = 1.0f / gsum;
            float pe[8]; float emax = -1e30f;
#pragma unroll
            for (int k = 0; k < 8; ++k) { pe[k] = lg[gsel * 8 + k] + bre[gsel * 8 + k]; emax = fmaxf(emax, pe[k]); }
#pragma unroll
            for (int k = 0; k < 8; ++k) pe[k] = expf(pe[k] - emax);
            int i1 = 0; float p1 = pe[0];
#pragma unroll
            for (int k = 1; k < 8; ++k) if (pe[k] > p1) { p1 = pe[k]; i1 = k; }
            int i2 = (i1 == 0) ? 1 : 0; float p2 = pe[i2];
#pragma unroll
            for (int k = 0; k < 8; ++k) if (k != i1 && pe[k] > p2) { p2 = pe[k]; i2 = k; }
            const float inv = pg / (p1 + p2);
            const int e1 = gsel * 8 + i1, e2 = gsel * 8 + i2;
            TOKE[t * 2] = e1; TOKE[t * 2 + 1] = e2; TOKW[t * 2] = p1 * inv; TOKW[t * 2 + 1] = p2 * inv;
            RANK[t * 2] = (int)__hip_atomic_fetch_add(lcnt + e1, 1u, __ATOMIC_RELAXED, __HIP_MEMORY_SCOPE_WORKGROUP);
            RANK[t * 2 + 1] = (int)__hip_atomic_fetch_add(lcnt + e2, 1u, __ATOMIC_RELAXED, __HIP_MEMORY_SCOPE_WORKGROUP); }
        __syncthreads();
    }
    if (C.tid < 32) { const unsigned n = lcnt[C.tid]; lbase[C.tid] = n ? __hip_atomic_fetch_add(CNT + C.tid, n, __ATOMIC_RELAXED, __HIP_MEMORY_SCOPE_AGENT) : 0u; }
    __syncthreads();
    asm volatile("s_waitcnt vmcnt(0)" ::: "memory");
    for (int a = C.tid; a < per * 2; a += NTHREADS) { const int ga = C.bid * per * 2 + a; const int e = TOKE[ga]; const unsigned rk = lbase[e] + (unsigned)RANK[ga];
        ROWTOK[(size_t)e * MOE_CAP + rk] = ga; }
    __syncthreads();
}
typedef f32x4 AccT[2][2][4][2];
DI u32x4 pack8(const f32x4& a, const f32x4& b) { u32x4 w; w.x = pk2(a[0], a[1]); w.y = pk2(a[2], a[3]); w.z = pk2(b[0], b[1]); w.w = pk2(b[2], b[3]); return w; }
template <int ACT> struct EpiStore {
    bf16_t* O; int ldc;
    DI void operator()(const AccT& acc, const pg8::Unit& u, int wr, int wc, int fr, int fq) const {
#pragma unroll
        for (int ai = 0; ai < 2; ++ai)
#pragma unroll
            for (int m = 0; m < 4; ++m) { const size_t row = (size_t)(u.pm * 256 + ai * 128 + wr * 64 + m * 16 + fr);
#pragma unroll
                for (int bj = 0; bj < 2; ++bj) { const int col = u.pn * 256 + bj * 128 + wc * 32 + 8 * fq; f32x4 a = acc[ai][bj][m][0], b = acc[ai][bj][m][1];
                    if (ACT == 1) {
#pragma unroll
                        for (int j = 0; j < 4; ++j) { a[j] = sigmoidf_(a[j]); b[j] = sigmoidf_(b[j]); } }
                    *(u32x4*)(O + row * ldc + col) = pack8(a, b); } }
    }
};
struct EpiMerge {
    const bf16_t* GATE; bf16_t* MG;
    DI void operator()(const AccT& acc, const pg8::Unit& u, int wr, int wc, int fr, int fq) const {
#pragma unroll
        for (int ai = 0; ai < 2; ++ai)
#pragma unroll
            for (int m = 0; m < 4; ++m) { const size_t row = (size_t)(u.pm * 256 + ai * 128 + wr * 64 + m * 16 + fr);
#pragma unroll
                for (int bj = 0; bj < 2; ++bj) { const int col = u.pn * 256 + bj * 128 + wc * 32 + 8 * fq;
                    const u32x4 g = *(const u32x4*)(GATE + row * 4096 + u.x * 1024 + col);
                    f32x4 a = acc[ai][bj][m][0], b = acc[ai][bj][m][1];
                    a[0] *= bflo(g.x); a[1] *= bfhi(g.x); a[2] *= bflo(g.y); a[3] *= bfhi(g.y); b[0] *= bflo(g.z); b[1] *= bfhi(g.z); b[2] *= bflo(g.w); b[3] *= bfhi(g.w);
                    bf16_t* dst = MG + row * 1024 + col;
                    if (u.x > 0) { const u32x4 p = *(const u32x4*)dst;
                        a[0] += bflo(p.x); a[1] += bfhi(p.x); a[2] += bflo(p.y); a[3] += bfhi(p.y); b[0] += bflo(p.z); b[1] += bfhi(p.z); b[2] += bflo(p.w); b[3] += bfhi(p.w); }
                    *(u32x4*)dst = pack8(a, b); }
                asm volatile("" ::: "memory"); }
    }
};
struct EpiResid {
    float* XR;
    DI void operator()(const AccT& acc, const pg8::Unit& u, int wr, int wc, int fr, int fq) const {
#pragma unroll
        for (int ai = 0; ai < 2; ++ai)
#pragma unroll
            for (int m = 0; m < 4; ++m) { const size_t row = (size_t)(u.pm * 256 + ai * 128 + wr * 64 + m * 16 + fr);
#pragma unroll
                for (int bj = 0; bj < 2; ++bj) { float* p = XR + row * 1024 + u.pn * 256 + bj * 128 + wc * 32 + 8 * fq;
                    const f32x4 x0 = *(const f32x4*)p, x1 = *(const f32x4*)(p + 4);
                    *(f32x4*)p = x0 + acc[ai][bj][m][0]; *(f32x4*)(p + 4) = x1 + acc[ai][bj][m][1]; }
                if (m == 3) asm volatile("" ::: "memory"); }
    }
};
struct EpiResidNorm {
    float* XR; bf16_t* XB; float* RSS;
    DI void operator()(const AccT& acc, const pg8::Unit& u, int wr, int wc, int fr, int fq) const {
#pragma unroll
        for (int ai = 0; ai < 2; ++ai)
#pragma unroll
            for (int m = 0; m < 4; ++m) { const size_t row = (size_t)(u.pm * 256 + ai * 128 + wr * 64 + m * 16 + fr); float ss = 0.f;
#pragma unroll
                for (int bj = 0; bj < 2; ++bj) { const size_t off = row * 1024 + u.pn * 256 + bj * 128 + wc * 32 + 8 * fq; float* p = XR + off;
                    const f32x4 x0 = *(const f32x4*)p + acc[ai][bj][m][0], x1 = *(const f32x4*)(p + 4) + acc[ai][bj][m][1];
                    *(f32x4*)p = x0; *(f32x4*)(p + 4) = x1; *(u32x4*)(XB + off) = pack8(x0, x1);
                    ss += (x0[0] * x0[0] + x0[1] * x0[1]) + (x0[2] * x0[2] + x0[3] * x0[3]) + (x1[0] * x1[0] + x1[1] * x1[1]) + (x1[2] * x1[2] + x1[3] * x1[3]); }
                ss += __shfl_xor(ss, 16); ss += __shfl_xor(ss, 32);
                if (fq == 0) RSS[row * 16 + u.pn * 4 + wc] = ss;
                if (m == 3) asm volatile("" ::: "memory"); }
    }
};
struct EpiStoreRstd {
    bf16_t* O; int ldc; const float* RSS;
    DI void operator()(const AccT& acc, const pg8::Unit& u, int wr, int wc, int fr, int fq) const {
#pragma unroll
        for (int ai = 0; ai < 2; ++ai)
#pragma unroll
            for (int m = 0; m < 4; ++m) { const size_t row = (size_t)(u.pm * 256 + ai * 128 + wr * 64 + m * 16 + fr);
                const f32x4* rp = (const f32x4*)(RSS + row * 16); const f32x4 r0 = rp[0], r1 = rp[1], r2 = rp[2], r3 = rp[3];
                const float rsum = ((r0[0] + r0[1]) + (r0[2] + r0[3])) + ((r1[0] + r1[1]) + (r1[2] + r1[3])) + ((r2[0] + r2[1]) + (r2[2] + r2[3])) + ((r3[0] + r3[1]) + (r3[2] + r3[3]));
                const float rs = 1.0f / sqrtf(rsum * (1.0f / 1024.0f) + 1e-6f);
#pragma unroll
                for (int bj = 0; bj < 2; ++bj) { const int col = u.pn * 256 + bj * 128 + wc * 32 + 8 * fq;
                    *(u32x4*)(O + row * ldc + col) = pack8(acc[ai][bj][m][0] * rs, acc[ai][bj][m][1] * rs); } }
    }
};
struct EpiGU {
    bf16_t* HID;
    DI void operator()(const AccT& acc, const pg8::Unit& u, int wr, int wc, int fr, int fq) const {
#pragma unroll
        for (int ai = 0; ai < 2; ++ai)
#pragma unroll
            for (int m = 0; m < 4; ++m) { const size_t row = (size_t)(u.pm * 256 + ai * 128 + wr * 64 + m * 16 + fr);
                f32x4 a, b;
#pragma unroll
                for (int j = 0; j < 4; ++j) { a[j] = siluf_(acc[ai][0][m][0][j]) * acc[ai][1][m][0][j]; b[j] = siluf_(acc[ai][0][m][1][j]) * acc[ai][1][m][1][j]; }
                *(u32x4*)(HID + row * 256 + u.pn * 128 + wc * 32 + 8 * fq) = pack8(a, b); }
    }
};
struct EpiDown {
    bf16_t* YB; const int* ROWTOK; const float* TOKW; const LAS int* cnt;
    DI void operator()(const AccT& acc, const pg8::Unit& u, int wr, int wc, int fr, int fq) const {
        const int ce = cnt[u.x];
#pragma unroll
        for (int ai = 0; ai < 2; ++ai)
#pragma unroll
            for (int m = 0; m < 4; ++m) { const int idx = u.y * 256 + ai * 128 + wr * 64 + m * 16 + fr;
                if (idx < ce) { const int a = ROWTOK[(size_t)u.x * MOE_CAP + idx]; const float w = TOKW[a];
#pragma unroll
                    for (int bj = 0; bj < 2; ++bj) { const int col = u.pn * 256 + bj * 128 + wc * 32 + 8 * fq;
                        *(u32x4*)(YB + (size_t)a * 1024 + col) = pack8(acc[ai][bj][m][0] * w, acc[ai][bj][m][1] * w); } } }
    }
};

struct FusedMergeOrder {
    const char* Hb; const char* Yb; const char* Wg; const char* Wb; int G, c;
    DI bool next(int i, pg8::Unit& u) const {
        const int ti = i >> 3, x = i & 7, n = x >> 1; const long L = (long)ti * G + c; if (L >= 256) return false;
        pg8::tile_map((int)L, 64, 4, u.pm, u.pn); u.x = x; u.y = 0;
        if (x & 1) { u.a = Yb + (size_t)u.pm * 256 * 1024 * 2 + (size_t)n * 256 * 2; u.b = Wb + (size_t)u.pn * 256 * 1024 * 2 + (size_t)n * 256 * 2; u.nt = 4; }
        else { u.a = Hb + (size_t)u.pm * 256 * 1024 * 2; u.b = Wg + ((size_t)n * 1024 + (size_t)u.pn * 256) * 1024 * 2; u.nt = 16; }
        return true; }
    DI unsigned row_off(const pg8::Unit&, int) const { return 0u; }
};
struct EpiFusedMerge {
    bf16_t* GS; bf16_t* MG; int tid;
    DI void operator()(const AccT& acc, const pg8::Unit& u, int wr, int wc, int fr, int fq) const {
        u32x4* gs = (u32x4*)GS + tid;
        if ((u.x & 1) == 0) {
#pragma unroll
            for (int ai = 0; ai < 2; ++ai)
#pragma unroll
                for (int m = 0; m < 4; ++m)
#pragma unroll
                    for (int bj = 0; bj < 2; ++bj) { f32x4 a = acc[ai][bj][m][0], b = acc[ai][bj][m][1];
#pragma unroll
                        for (int j = 0; j < 4; ++j) { a[j] = sigmoidf_(a[j]); b[j] = sigmoidf_(b[j]); }
                        gs[((ai * 4 + m) * 2 + bj) * 512] = pack8(a, b); }
        } else {
#pragma unroll
            for (int ai = 0; ai < 2; ++ai)
#pragma unroll
                for (int m = 0; m < 4; ++m) { const size_t row = (size_t)(u.pm * 256 + ai * 128 + wr * 64 + m * 16 + fr);
#pragma unroll
                    for (int bj = 0; bj < 2; ++bj) { const int col = u.pn * 256 + bj * 128 + wc * 32 + 8 * fq;
                        const u32x4 g = gs[((ai * 4 + m) * 2 + bj) * 512];
                        f32x4 a = acc[ai][bj][m][0], b = acc[ai][bj][m][1];
                        a[0] *= bflo(g.x); a[1] *= bfhi(g.x); a[2] *= bflo(g.y); a[3] *= bfhi(g.y); b[0] *= bflo(g.z); b[1] *= bfhi(g.z); b[2] *= bflo(g.w); b[3] *= bfhi(g.w);
                        bf16_t* dst = MG + row * 1024 + col;
                        if (u.x > 1) { const u32x4 p = *(const u32x4*)dst;
                            a[0] += bflo(p.x); a[1] += bfhi(p.x); a[2] += bflo(p.y); a[3] += bfhi(p.y); b[0] += bflo(p.z); b[1] += bfhi(p.z); b[2] += bflo(p.w); b[3] += bfhi(p.w); }
                        *(u32x4*)dst = pack8(a, b); }
                    if (m == 3) asm volatile("" ::: "memory"); }
        }
    }
};
constexpr int MOE_TAB = LDS_MISC + 256;
DI void moe_build_table(const Ctx& C, const unsigned* CNT) {
    volatile LAS int* T = (volatile LAS int*)(C.lds + MOE_TAB);
    if (C.tid == 0) { int acc = 0; for (int e = 0; e < 32; ++e) { const int n = (int)CNT[e]; T[e] = acc; T[40 + e] = n; const int nt = (n + 255) >> 8;
            for (int j = 0; j < nt; ++j) T[80 + acc + j] = (e << 8) | j;
            acc += nt; } T[32] = acc; }
    __syncthreads();
}
template <int NPN, bool GU> struct MoeOrder {
    const LAS int* T; const char* Ab; const char* Wb; const int* ROWTOK; int G, c;
    DI bool next(int i, pg8::Unit& u) const {
        const long L = (long)i * G + c; const int tile = (int)(L / NPN), pn = (int)(L % NPN);
        if (tile >= __builtin_amdgcn_readfirstlane(T[32])) return false;
        const int ej = __builtin_amdgcn_readfirstlane(T[80 + tile]); const int e = ej >> 8;
        u.x = e; u.y = ej & 255; u.pm = tile; u.pn = pn; u.nt = 0;
        if (GU) { u.a = Ab; u.b = Wb + ((size_t)e * 512 + (size_t)pn * 256) * 1024 * 2; }
        else { u.a = Ab + (size_t)tile * 256 * 256 * 2; u.b = Wb + ((size_t)e * 1024 + (size_t)pn * 256) * 256 * 2; }
        return true; }
    DI unsigned row_off(const pg8::Unit& u, int row) const {
        const int idx = u.y * 256 + row; int tok = 0;
        if (idx < T[40 + u.x]) tok = ROWTOK[(size_t)u.x * MOE_CAP + idx] >> 1;
        return (unsigned)tok * 2048u; }
};

constexpr int PH_PER_LAYER = 16, PH_L0 = 1, N_PHASES = PH_L0 + DEPTH * PH_PER_LAYER + 1;
#ifndef ENABLE_MASK
#define ENABLE_MASK 0xFF
#endif
#ifndef PROBE_DUP
#define PROBE_DUP 0
#endif
#define NREP(bit) ((PROBE_DUP & (bit)) ? 2 : 1)
#define ZIGZAG(n, call) do { for (int _rd = 0; _rd * C.G < (n); ++_rd) { const int u = _rd * C.G + ((_rd & 1) ? (C.G - 1 - C.bid) : C.bid); if (u < (n)) { call; } } } while (0)

typedef const Params __attribute__((address_space(4))) KParams;
#if defined(__HIP_DEVICE_COMPILE__)
#define PHASE_LOADP() KParams* _pp = (KParams*)__builtin_amdgcn_kernarg_segment_ptr(); asm volatile("" : "+s"(_pp)); const Params P = *_pp
#else
#define PHASE_LOADP() const Params P = Parg
#endif
#define PHASE_ENV() PHASE_LOADP(); const Ctx C = relaunder(C0); LAS unsigned char* lds = C.lds; bf16_t* H = wsp<bf16_t>(P, WS_H); bf16_t* Y = wsp<bf16_t>(P, WS_Y); unsigned char* R1 = P.ws + WS_R1
#define IN(k) (lo <= (k) && (k) < hi)
#define SEAM(k) do { if (IN(k) && IN((k) + 1)) { xcd_barrier(bar); if (PROBE_DUP & 1048576) xcd_barrier(bar); } } while (0)
template <int l> DI void layer_phases(const Ctx& C0, const Params& Parg, const int lo, const int hi, const XcdBarrier& bar) {
    constexpr int pb = PH_L0 + l * PH_PER_LAYER;
        if (IN(pb + 0)) { PHASE_ENV(); for (int rep = 0; rep < NREP(8); ++rep) phase_convert_layer(C, P, l);
            if (l == 0) phase_rownorm<false, true, false, true>(C, P, P.norm_mix + l * DM); else if (!(ENABLE_MASK & 32)) phase_rownorm<false, true, false>(C, P, P.norm_mix + l * DM); else phase_rownorm<true, true, false>(C, P, P.norm_mix + l * DM); } SEAM(pb + 0);
        if (IN(pb + 1)) for (int rep = 0; rep < NREP(16); ++rep) { PHASE_ENV();
            { pg8::DenseOrder S; S.init(H, wsp<bf16_t>(P, W_IN), NTOK, 2560, 1024, 1024, C.G, C.bid);
              EpiStore<0> E{(bf16_t*)(R1 + R1_PROJ), PROJ_LD}; pg8::gemm_phase<EpiStore<0>, pg8::DenseOrder, false>(C.tid, lds, 1024, 1024, 1024, S, E); }
            { pg8::DenseOrder S; S.init(wsp<bf16_t>(P, W_V), H, 512, NTOK, 1024, 1024, C.G, (C.bid + 128) % C.G);
              EpiStore<0> E{(bf16_t*)(R1 + R1_VT), NTOK}; pg8::gemm_phase<EpiStore<0>, pg8::DenseOrder, false>(C.tid, lds, 1024, 1024, 1024, S, E); }
            if (l == 0) {
        for (int lm = 0; lm < DEPTH; ++lm) {
            const bf16_t* MEMN = wsp<bf16_t>(P, WS_MEMN) + (size_t)lm * 1024 * 1024; const bf16_t* WKV = wsp<bf16_t>(P, W_KV) + (size_t)lm * 512 * 1024;
            { pg8::DenseOrder S; S.init(MEMN, WKV, 1024, 256, 1024, 1024, C.G, (C.bid + 8 * lm) % C.G);
              EpiStore<0> E{wsp<bf16_t>(P, WS_MK) + (size_t)lm * 1024 * 256, 256}; pg8::gemm_phase<EpiStore<0>, pg8::DenseOrder, false>(C.tid, lds, 1024, 1024, 1024, S, E); }
            { pg8::DenseOrder S; S.init(WKV + (size_t)256 * 1024, MEMN, 256, 1024, 1024, 1024, C.G, (C.bid + 8 * lm + 4) % C.G);
              EpiStore<0> E{wsp<bf16_t>(P, WS_MVT) + (size_t)lm * 256 * 1024, 1024}; pg8::gemm_phase<EpiStore<0>, pg8::DenseOrder, false>(C.tid, lds, 1024, 1024, 1024, S, E); }
        }
            }
        } SEAM(pb + 1);
        if (IN(pb + 2)) { PHASE_ENV(); phase_rope(C, P, l); } SEAM(pb + 2);
        if (IN(pb + 3)) { PHASE_ENV();
            for (int rep = 0; rep < NREP(1); ++rep) { if (ENABLE_MASK & 8) ZIGZAG(512, dsa_select_unit(C, P, l, u);); }
            for (int rep = 0; rep < NREP(1024); ++rep) { if (ENABLE_MASK & 2) ZIGZAG(512, hgrn_local_unit(C, P, l, u);); }
            for (int rep = 0; rep < NREP(2048); ++rep) { if (ENABLE_MASK & 4) ZIGZAG(256, sgu_unit(C, P, l, u);); }
        } SEAM(pb + 3);
        if (IN(pb + 4)) { PHASE_ENV();
            for (int rep = 0; rep < NREP(2); ++rep) { if (ENABLE_MASK & 1) causal_attn_block2<true>(C, P, l); }
            if (ENABLE_MASK & 2) { for (int u = C.G - 1 - C.bid; u < 128; u += C.G) hgrn_scan_unit(C, P, u); }
        } SEAM(pb + 4);
        if (IN(pb + 5)) {
            for (int rep = 0; rep < NREP(4); ++rep) { PHASE_ENV();
            for (int r2 = 0; r2 < NREP(2097152); ++r2) { if (ENABLE_MASK & 8) causal_attn_block2<false>(C, P, l); }
            for (int r3 = 0; r3 < NREP(4194304); ++r3) { if (ENABLE_MASK & 2) ZIGZAG(512, hgrn_out_unit(C, P, l, u);); } }
        } SEAM(pb + 5);
        if (IN(pb + 7)) for (int rep = 0; rep < NREP(128); ++rep) { PHASE_ENV();
            FusedMergeOrder S{(const char*)H, (const char*)Y, (const char*)wsp<bf16_t>(P, W_G), (const char*)wsp<bf16_t>(P, W_BR), C.G, C.bid};
            EpiFusedMerge E{(bf16_t*)(R1 + R1_GS) + (size_t)C.bid * 65536, (bf16_t*)(R1 + R1_MG), C.tid};
            pg8::gemm_phase<EpiFusedMerge, FusedMergeOrder, false>(C.tid, lds, 1024, 1024, 1024, S, E);
        } SEAM(pb + 7);
        if (IN(pb + 8)) { PHASE_ENV();
            pg8::DenseOrder S; S.init(R1 + R1_MG, wsp<bf16_t>(P, W_OUT), NTOK, 1024, 1024, 1024, C.G, C.bid);
            EpiResidNorm E{P.out, H, wsp<float>(P, WS_RSS)}; pg8::gemm_phase<EpiResidNorm, pg8::DenseOrder, false>(C.tid, lds, 1024, 1024, 1024, S, E);
        } SEAM(pb + 8);
        if (IN(pb + 10)) for (int rep = 0; rep < NREP(64); ++rep) { PHASE_ENV();
            pg8::DenseOrder S; S.init(H, wsp<bf16_t>(P, W_Q), NTOK, 256, 1024, 1024, C.G, C.bid);
            EpiStoreRstd E{(bf16_t*)(R1 + R1_MQ), 256, wsp<float>(P, WS_RSS)}; pg8::gemm_phase<EpiStoreRstd, pg8::DenseOrder, false>(C.tid, lds, 1024, 1024, 1024, S, E);
        } SEAM(pb + 10);
        if (IN(pb + 11)) for (int rep = 0; rep < NREP(64); ++rep) { PHASE_ENV(); mem_attn_block(C, P, l); } SEAM(pb + 11);
        if (IN(pb + 12)) { PHASE_ENV();
            if (ENABLE_MASK & 16) { pg8::DenseOrder S; S.init(R1 + R1_MO, wsp<bf16_t>(P, W_O), NTOK, 1024, 256, 256, C.G, C.bid);
              EpiResid E{P.out}; pg8::gemm_phase<EpiResid, pg8::DenseOrder, false>(C.tid, lds, 256, 256, 256, S, E); }
        } SEAM(pb + 12);
        if (IN(pb + 13)) { PHASE_ENV(); phase_router(C, P, l); if (PROBE_DUP & 512) { __syncthreads(); phase_router(C, P, l, true); } } SEAM(pb + 13);
        if (IN(pb + 14)) for (int rep = 0; rep < NREP(32); ++rep) { PHASE_ENV();
            moe_build_table(C, wsp<unsigned>(P, WS_CTL) + CW_CNT + 64 * l);
            MoeOrder<2, true> S{(const LAS int*)(lds + MOE_TAB), (const char*)H, (const char*)wsp<bf16_t>(P, W_GU), wsp<int>(P, WS_ROWTOK), C.G, C.bid};
            EpiGU E{(bf16_t*)(R1 + R1_HID)}; pg8::gemm_phase<EpiGU, MoeOrder<2, true>, true>(C.tid, lds, 1024, 1024, 1024, S, E);
        } SEAM(pb + 14);
        if (IN(pb + 15)) for (int rep = 0; rep < NREP(32); ++rep) { PHASE_ENV();
            moe_build_table(C, wsp<unsigned>(P, WS_CTL) + CW_CNT + 64 * l);
            MoeOrder<4, false> S{(const LAS int*)(lds + MOE_TAB), (const char*)(R1 + R1_HID), (const char*)wsp<bf16_t>(P, W_D), wsp<int>(P, WS_ROWTOK), C.G, C.bid};
            EpiDown E{(bf16_t*)(R1 + R1_YB), wsp<int>(P, WS_ROWTOK), wsp<float>(P, WS_TOKW), (const LAS int*)(lds + MOE_TAB) + 40};
            pg8::gemm_phase<EpiDown, MoeOrder<4, false>, false>(C.tid, lds, 256, 256, 256, S, E);
        } SEAM(pb + 15);
    }
__global__ void __launch_bounds__(NTHREADS, 2) mega_fwd(Params Parg) {
    extern __shared__ __attribute__((aligned(16))) unsigned char lds_raw[];
    Ctx C0; C0.lds = (LAS unsigned char*)lds_raw; C0.tid = threadIdx.x; C0.lane = C0.tid & 63; C0.wave = __builtin_amdgcn_readfirstlane((int)threadIdx.x >> 6); C0.G = gridDim.x; C0.bid = blockIdx.x;
    volatile LAS unsigned* misc = (volatile LAS unsigned*)(C0.lds + LDS_MISC);
    if (C0.tid < 4) misc[C0.tid] = 0u;
    __syncthreads();
    const int lo = Parg.ph_lo, hi = Parg.ph_hi;
    const bool use_bar = (hi - lo) > 1;
    XcdBarrier bar; bar.bar = (unsigned*)(Parg.ws + WS_CTL) + CW_BAR; bar.x = 0; bar.st = misc;
    if (use_bar) bar = xcd_barrier_post((unsigned*)(Parg.ws + WS_CTL) + CW_BAR, misc);
#define IN(k) (lo <= (k) && (k) < hi)
#define SEAM(k) do { if (IN(k) && IN((k) + 1)) { xcd_barrier(bar); if (PROBE_DUP & 1048576) xcd_barrier(bar); } } while (0)

    if (IN(0)) { PHASE_ENV(); phase_prologue(C, P); } SEAM(0);
    layer_phases<0>(C0, Parg, lo, hi, bar);
    layer_phases<1>(C0, Parg, lo, hi, bar);
    if (IN(N_PHASES - 1)) { PHASE_ENV(); if (ENABLE_MASK & 32) phase_rownorm<true, false, true>(C, P, P.norm_final); else phase_rownorm<false, false, true>(C, P, P.norm_final); }
#undef IN
#undef SEAM
}

#ifndef N_LAUNCH_MODE
#define N_LAUNCH_MODE 0
#endif
extern "C" void kernel_launch(void* const* d_in, const int* in_sizes, int n_in, void* d_out, int out_size, void* d_ws, size_t ws_size, hipStream_t stream) {
    static int grid = 0;
    if (grid == 0) {
        if (n_in != 25 || out_size != NTOK * DM || ws_size < WS_END) { fprintf(stderr, "kernel_launch: unexpected shapes (n_in %d out %d ws %zu need %zu)\n", n_in, out_size, ws_size, (size_t)WS_END); grid = -1; return; }
        int dev = 0, cus = 0;
        if (hipGetDevice(&dev) != hipSuccess || hipDeviceGetAttribute(&cus, hipDeviceAttributeMultiprocessorCount, dev) != hipSuccess) { grid = -1; return; }
        if (hipFuncSetAttribute((const void*)mega_fwd, hipFuncAttributeMaxDynamicSharedMemorySize, LDS_BYTES) != hipSuccess) { fprintf(stderr, "kernel_launch: hipFuncSetAttribute failed\n"); grid = -1; return; }
        int per_cu = 0;
        if (hipOccupancyMaxActiveBlocksPerMultiprocessor(&per_cu, (const void*)mega_fwd, NTHREADS, LDS_BYTES) != hipSuccess || per_cu < 1) { fprintf(stderr, "kernel_launch: occupancy query says %d\n", per_cu); }
        (void)hipGetLastError();
        if (cus != 256) fprintf(stderr, "kernel_launch: built for 256 CUs (one workgroup per CU); device reports %d\n", cus);
        grid = 256;
    }
    if (grid < 0) return;
    (void)hipMemsetAsync((char*)d_ws + WS_CTL, 0, CTL_BYTES, stream);
    Params p{};
    p.x = (const float*)d_in[0]; p.mem = (const float*)d_in[1]; p.positions = (const int*)d_in[2];
    p.norm_mix = (const float*)d_in[3]; p.w_in = (const float*)d_in[4]; p.diff_lambda = (const float*)d_in[5]; p.hgrn_lb = (const float*)d_in[6];
    p.spatial_w = (const float*)d_in[7]; p.spatial_b = (const float*)d_in[8]; p.w_branch = (const float*)d_in[9]; p.w_out = (const float*)d_in[10];
    p.norm_mem_q = (const float*)d_in[11]; p.norm_mem_kv = (const float*)d_in[12]; p.w_mem_q = (const float*)d_in[13]; p.w_mem_kv = (const float*)d_in[14]; p.w_mem_o = (const float*)d_in[15];
    p.norm_ffn = (const float*)d_in[16]; p.w_rg = (const float*)d_in[17]; p.b_rg = (const float*)d_in[18]; p.w_re = (const float*)d_in[19]; p.b_re = (const float*)d_in[20];
    p.w_eg = (const float*)d_in[21]; p.w_eu = (const float*)d_in[22]; p.w_ed = (const float*)d_in[23]; p.norm_final = (const float*)d_in[24];
    p.out = (float*)d_out; p.ws = (unsigned char*)d_ws;
#if N_LAUNCH_MODE == 0
    p.ph_lo = 0; p.ph_hi = N_PHASES;
    hipLaunchKernelGGL(mega_fwd, dim3(grid), dim3(NTHREADS), LDS_BYTES, stream, p);
#else
    for (int k = 0; k < N_PHASES; ++k) { p.ph_lo = k; p.ph_hi = k + 1; hipLaunchKernelGGL(mega_fwd, dim3(grid), dim3(NTHREADS), LDS_BYTES, stream, p); }
#endif
}
```

```cpp
#include <hip/hip_runtime.h>
#include <stdint.h>
#include <stdio.h>

#ifndef PROBE_DUP
#define PROBE_DUP 0
#endif
#define DI __device__ __forceinline__
#define LAS __attribute__((address_space(3)))
typedef unsigned short bf16_t;
typedef short bf16x8 __attribute__((ext_vector_type(8)));
typedef short s16x4 __attribute__((ext_vector_type(4)));
typedef float f32x2 __attribute__((ext_vector_type(2)));
typedef float f32x4 __attribute__((ext_vector_type(4)));
typedef float f32x16 __attribute__((ext_vector_type(16)));
typedef unsigned u32x2 __attribute__((ext_vector_type(2)));
typedef unsigned u32x4 __attribute__((ext_vector_type(4)));
typedef __bf16 hbf2 __attribute__((ext_vector_type(2)));

constexpr int NB = 4, SEQ = 4096, NTOK = NB * SEQ, DM = 1024, DEPTH = 2, MEMLEN = 256;
constexpr int NTHREADS = 512, NWAVES = 8;
constexpr int LDS_BYTES = 147456;
constexpr int LDS_MISC = 133120;
constexpr int IN_WIDTH = 6948;
constexpr int PROJ_LD = 2560;
constexpr int PC_AQ = 0, PC_AK = 256, PC_BQ = 512, PC_BF = 768, PC_BI = 1024, PC_BG = 1280, PC_CU = 1536, PC_CV = 1792,
              PC_DQ = 2048, PC_DK = 2304, PC_DIQ = 2368, PC_DIK = 2496, PC_DIW = 2528;
constexpr int MOE_CAP = 16384;

constexpr size_t AL(size_t x) { return (x + 255) & ~(size_t)255; }
constexpr size_t WS_CTL = 0, CTL_BYTES = 65536;
constexpr size_t W_IN = AL(WS_CTL + CTL_BYTES);
constexpr size_t W_V = W_IN + (size_t)2560 * 1024 * 2;
constexpr size_t W_G = W_V + (size_t)512 * 1024 * 2;
constexpr size_t W_BR = W_G + (size_t)4096 * 1024 * 2;
constexpr size_t W_OUT = W_BR + (size_t)4 * 1024 * 256 * 2;
constexpr size_t W_Q = W_OUT + (size_t)1024 * 1024 * 2;
constexpr size_t W_O = W_Q + (size_t)256 * 1024 * 2;
constexpr size_t W_GU = W_O + (size_t)1024 * 256 * 2;
constexpr size_t W_D = W_GU + (size_t)32 * 512 * 1024 * 2;
constexpr size_t W_SGU = W_D + (size_t)32 * 1024 * 256 * 2;
constexpr size_t W_RT = W_SGU + (size_t)4 * 128 * 128 * 2;
constexpr size_t W_RH = W_RT + (size_t)36 * 1024 * 4;
constexpr size_t W_KV = W_RH + (size_t)2 * 64 * 1024 * 2;
constexpr size_t WS_H = W_KV + (size_t)DEPTH * 512 * 1024 * 2;
constexpr size_t WS_R1 = WS_H + (size_t)NTOK * 1024 * 2;
constexpr size_t R1_BYTES = (size_t)NTOK * 4096 * 2;
constexpr size_t WS_Y = WS_R1 + R1_BYTES;
constexpr size_t WS_HS = WS_Y + (size_t)NTOK * 1024 * 2;
constexpr size_t WS_HD = WS_HS + (size_t)NB * 64 * 4 * 4096 * 4;
constexpr size_t WS_THETA = WS_HD + (size_t)NB * 64 * 256 * 4;
constexpr size_t WS_MEMN = WS_THETA + (size_t)NTOK * 8;
constexpr size_t WS_MK = WS_MEMN + (size_t)DEPTH * 1024 * 1024 * 2;
constexpr size_t WS_MVT = WS_MK + (size_t)DEPTH * 1024 * 256 * 2;
constexpr size_t WS_TOKE = WS_MVT + (size_t)DEPTH * 256 * 1024 * 2;
constexpr size_t WS_TOKW = WS_TOKE + (size_t)NTOK * 2 * 4;
constexpr size_t WS_RANK = WS_TOKW + (size_t)NTOK * 2 * 4;
constexpr size_t WS_ROWTOK = WS_RANK + (size_t)NTOK * 2 * 4;
constexpr size_t WS_MASK = WS_ROWTOK + (size_t)32 * MOE_CAP * 4;
constexpr size_t WS_RSS = WS_MASK + (size_t)NB * 128 * 128 * 64 * 2;
constexpr size_t WS_DUMMY_BASE = WS_RSS + (size_t)NTOK * 16 * 4;
constexpr size_t WS_DUMMY_OLD = WS_MASK + (size_t)NB * 128 * 128 * 64 * 2;
constexpr size_t WS_DUMMY = WS_DUMMY_BASE;
constexpr size_t WS_END = WS_DUMMY + (size_t)32 * MOE_CAP * 4;
constexpr size_t R1_PROJ = 0, R1_VT = (size_t)NTOK * PROJ_LD * 2;
constexpr size_t R1_GS = 0, R1_MG = (size_t)256 * 65536 * 2;
constexpr size_t R1_MQ = 0, R1_MO = (size_t)NTOK * 256 * 2, R1_HID = 2 * R1_MO, R1_YB = R1_HID + (size_t)40960 * 256 * 2;
constexpr size_t R1_HIDS = R1_YB + (size_t)NTOK * 2 * 1024 * 2;
static_assert(R1_HIDS + (size_t)32 * 64 * 256 * 2 <= R1_BYTES, "R1 map");
static_assert(R1_YB + (size_t)NTOK * 2 * 1024 * 2 <= R1_BYTES, "R1 map");
static_assert(R1_VT + (size_t)512 * NTOK * 2 <= R1_BYTES, "R1 map");
constexpr int CW_BAR = 0;
constexpr int CW_KMAX = 4032;
constexpr int CW_CNT = 4096;

DI bf16_t f2bf(float f) { __bf16 b = (__bf16)f; return __builtin_bit_cast(bf16_t, b); }
DI float bf2f(bf16_t b) { return __uint_as_float(((unsigned)b) << 16); }
DI unsigned pk2(float a, float b) { f32x2 v = {a, b}; hbf2 r = __builtin_convertvector(v, hbf2); return __builtin_bit_cast(unsigned, r); }
DI float bflo(unsigned w) { return __uint_as_float(w << 16); }
DI float bfhi(unsigned w) { return __uint_as_float(w & 0xffff0000u); }
DI float sigmoidf_(float x) { return __builtin_amdgcn_rcpf(1.0f + __builtin_amdgcn_exp2f(-1.4426950408889634f * x)); }
DI float siluf_(float x) { return x * __builtin_amdgcn_rcpf(1.0f + __builtin_amdgcn_exp2f(-1.4426950408889634f * x)); }
DI float fexp(float x) { return __builtin_amdgcn_exp2f(1.4426950408889634f * x); }
DI float frcp(float x) { return __builtin_amdgcn_rcpf(x); }
DI float flog(float x) { return 0.6931471805599453f * __builtin_amdgcn_logf(x); }
DI float gelu_tanh(float x) { const float u = 0.7978845608028654f * (x + 0.044715f * x * x * x); return x * frcp(1.0f + fexp(-2.0f * u)); }
DI float wave_sum(float v) { for (int o = 32; o > 0; o >>= 1) v += __shfl_xor(v, o); return v; }
DI float xhalf_max(float x) { const u32x2 r = __builtin_amdgcn_permlane32_swap(__float_as_uint(x), __float_as_uint(x), false, false); return fmaxf(__uint_as_float(r.x), __uint_as_float(r.y)); }
DI float xhalf_sum(float x) { const u32x2 r = __builtin_amdgcn_permlane32_swap(__float_as_uint(x), __float_as_uint(x), false, false); return __uint_as_float(r.x) + __uint_as_float(r.y); }
DI f32x16 mfma32(bf16x8 a, bf16x8 b, f32x16 c) { return __builtin_amdgcn_mfma_f32_32x32x16_bf16(a, b, c, 0, 0, 0); }
DI int crow(int reg, int h) { return (reg & 3) + 8 * (reg >> 2) + 4 * h; }
DI f32x16 zero16() { f32x16 z; for (int i = 0; i < 16; ++i) z[i] = 0.f; return z; }

#define XB_TMO      128
#define XB_XCNT(j)  (256  + 64 * (j))
#define XB_XSUB(j)  (1280 + 64 * (j))
#define XB_XGEN(j)  (2304 + 64 * (j))
#define XB_TOP      3328
#define XB_TOPGEN   3392
#define XCD_BAR_WORDS 3456
#define XB_SPIN_CAP (1u << 22)

DI unsigned xb_ld(unsigned* p)              { return __hip_atomic_load(p, __ATOMIC_RELAXED, __HIP_MEMORY_SCOPE_AGENT); }
DI unsigned xb_add(unsigned* p, unsigned v) { return __hip_atomic_fetch_add(p, v, __ATOMIC_RELAXED, __HIP_MEMORY_SCOPE_AGENT); }
DI unsigned xb_xcc_id() { return (unsigned)__builtin_amdgcn_s_getreg((3 << 11) | 20) & 0xFu; }
#define XB_SPIN(cond, bar) do { unsigned _sp = 0; while (cond) { __builtin_amdgcn_s_sleep(1); \
    if ((++_sp & 255u) == 0u) { if (xb_ld(&(bar)[XB_TMO])) break; if (_sp > XB_SPIN_CAP) { atomicAdd(&(bar)[XB_TMO], 1u); break; } } } } while (0)

struct XcdBarrier { unsigned* bar; unsigned x; volatile LAS unsigned* st; };

DI XcdBarrier xcd_barrier_post(unsigned* bar, volatile LAS unsigned* st) {
    XcdBarrier b; b.bar = bar; b.x = xb_xcc_id(); b.st = st;
    if (threadIdx.x == 0) (void)xb_add(&bar[XB_XCNT(b.x)], 1u);
    return b;
}
DI void xcd_barrier_complete(unsigned* bar, unsigned x, unsigned& nloc, unsigned& nx) {
    const unsigned G = gridDim.x * gridDim.y * gridDim.z;
    unsigned sum, cnt, mine, sp = 0u;
    for (;;) {
        sum = 0u; cnt = 0u; mine = 0u;
#pragma unroll
        for (unsigned j = 0; j < 16; ++j) { const unsigned c = xb_ld(&bar[XB_XCNT(j)]); sum += c; cnt += (c > 0u) ? 1u : 0u; mine = (j == x) ? c : mine; }
        if (sum == G) break;
        __builtin_amdgcn_s_sleep(1);
        if ((++sp & 255u) == 0u) { if (xb_ld(&bar[XB_TMO])) break; if (sp > XB_SPIN_CAP) { atomicAdd(&bar[XB_TMO], 1u); break; } }
    }
    nloc = mine > 0u ? mine : 1u; nx = cnt > 0u ? cnt : 1u;
}
DI void xcd_barrier(const XcdBarrier& b) {
    asm volatile("s_waitcnt vmcnt(0)" ::: "memory");
    __syncthreads();
    if (threadIdx.x == 0) {
        unsigned* bar = b.bar;
        __builtin_amdgcn_s_waitcnt(0);
        unsigned nloc = b.st[0], nx = b.st[1];
        if (nloc == 0u) { xcd_barrier_complete(bar, b.x, nloc, nx); b.st[0] = nloc; b.st[1] = nx; }
        const unsigned old = xb_add(&bar[XB_XSUB(b.x)], 1u);
        const unsigned gen = old / nloc;
        if (old + 1u == (gen + 1u) * nloc) {
            __builtin_amdgcn_fence(__ATOMIC_RELEASE, "agent");
            asm volatile("s_waitcnt vmcnt(0)" ::: "memory");
            const unsigned og = xb_add(&bar[XB_TOP], 1u);
            const unsigned tg = og / nx;
            if (og + 1u == (tg + 1u) * nx) xb_add(&bar[XB_TOPGEN], 1u);
            else XB_SPIN(xb_ld(&bar[XB_TOPGEN]) == tg, bar);
            __builtin_amdgcn_fence(__ATOMIC_ACQUIRE, "agent");
            xb_add(&bar[XB_XGEN(b.x)], 1u);
            asm volatile("s_waitcnt vmcnt(0)" ::: "memory");
        } else {
            XB_SPIN(xb_ld(&bar[XB_XGEN(b.x)]) == gen, bar);
            __builtin_amdgcn_fence(__ATOMIC_ACQUIRE, "agent");
            asm volatile("s_waitcnt vmcnt(0)" ::: "memory");
        }
    }
    __syncthreads();
}
namespace pg8 {
constexpr int BM = 256, BK = 64, HALF = 128, HTB = HALF * BK * 2, STAGE_BYTES = 8 * HTB, NXCD = 8, WGM = 8;
DI int lds_byte(int r, int c) { const int st = (r >> 4) * 2 + (c >> 5), rr = r & 15, cc = c & 31, ob = rr * 64 + cc * 2; return st * 1024 + (ob ^ (((ob >> 9) & 1) << 5)); }
DI void stage_rc(int b, int& R, int& C) { const int st = b / 1024, sb = b % 1024, swz = sb ^ (((sb >> 9) & 1) << 5); R = (st >> 1) * 16 + swz / 64; C = (st & 1) * 32 + (swz % 64) / 2; }
DI int perm32(int rho) { const int n = rho >> 4, i = rho & 15; return 8 * (i >> 2) + 4 * n + (i & 3); }

struct Unit { const char* a; const char* b; int pm, pn, x, y, nt; };

DI void tile_map(int L, int nM, int nN, int& pm, int& pn) {
    const int nwg = nM * nN; int wgid = L;
    { const int q = nwg / NXCD, r = nwg % NXCD, xcd = wgid % NXCD, off = wgid / NXCD; wgid = (xcd < r ? xcd * (q + 1) : r * (q + 1) + (xcd - r) * q) + off; }
    const int nig = WGM * nN, gid = wgid / nig, fm = gid * WGM, gsz = (nM - fm) < WGM ? (nM - fm) : WGM;
    pm = fm + ((wgid % nig) % gsz); pn = (wgid % nig) / gsz;
}
struct DenseOrder {
    const char* A; const char* B; size_t at, bt; int nM, nN, nwg, G, c;
    DI void init(const void* A_, const void* B_, int M, int N, int lda, int ldb, int G_, int c_) {
        A = (const char*)A_; B = (const char*)B_; at = (size_t)BM * lda * 2; bt = (size_t)BM * ldb * 2; nM = M / BM; nN = N / BM; nwg = nM * nN; G = G_; c = c_; }
    DI bool next(int i, Unit& u) const {
        const long L = (long)i * G + c; if (L >= nwg) return false;
        tile_map((int)L, nM, nN, u.pm, u.pn); u.a = A + (size_t)u.pm * at; u.b = B + (size_t)u.pn * bt; u.x = 0; u.y = 0; u.nt = 0; return true; }
    DI unsigned row_off(const Unit&, int) const { return 0u; }
};

#define PG8_WAIT_V(n) asm volatile("s_waitcnt vmcnt(" #n ")" ::: "memory")
#define PG8_WAIT_L(n) asm volatile("s_waitcnt lgkmcnt(" #n ")" ::: "memory")
#define PG8_BAR __builtin_amdgcn_s_barrier()
#define PG8_SCHED __builtin_amdgcn_sched_barrier(0)

template <class Epi, class Sched, bool GATHER>
DI void gemm_phase(const int tid, LAS unsigned char* lds, const int lda, const int ldb, const int K, const Sched& S, const Epi& E) {
    const int wid = __builtin_amdgcn_readfirstlane(tid >> 6), lane = tid & 63, wr = wid >> 2, wc = wid & 3, fr = lane & 15, fq = lane >> 4;
    const int nt_phase = K / BK;
    unsigned voffA[2], voffB[2]; int RA[2], CA[2];
#pragma unroll
    for (int i = 0; i < 2; ++i) { int R, C; stage_rc(tid * 16 + i * 8192, R, C); const int Rb = (R & ~31) + perm32(R & 31);
        RA[i] = R; CA[i] = C; voffA[i] = (unsigned)(R * lda + C) * 2u; voffB[i] = (unsigned)(Rb * ldb + C) * 2u; }
    const size_t kstep = (size_t)(BK * 2);
    const size_t hstepA = (size_t)HALF * lda * 2, hstepB = (size_t)HALF * ldb * 2;
    const unsigned ldsw = (unsigned)wid * 1024u;
    const int aoff = lds_byte(wr * 64 + fr, fq * 8), boff = lds_byte(wc * 32 + fr, fq * 8);
    unsigned vc[2][2], vn[2][2];
#define PG8_SA(b, h) (((b) * 2 + (h)) * HTB)
#define PG8_SB(b, h) ((4 + (b) * 2 + (h)) * HTB)
#define PG8_GL(bufoff, gptr, vo, _i) __builtin_amdgcn_global_load_lds((const unsigned*)((const char*)(gptr) + (vo)), (LAS unsigned*)(lds + (bufoff) + ldsw + (_i) * 8192), 16, 0, 0)
#define PG8_STAGE_B(bufoff, gbase) do { PG8_GL(bufoff, gbase, voffB[0], 0); PG8_GL(bufoff, gbase, voffB[1], 1); } while (0)
#define PG8_STAGE_A(bufoff, kptr, h, isnext) do { if constexpr (GATHER) { const unsigned _o0 = (isnext) ? vn[h][0] : vc[h][0], _o1 = (isnext) ? vn[h][1] : vc[h][1]; PG8_GL(bufoff, kptr, _o0, 0); PG8_GL(bufoff, kptr, _o1, 1); } \
        else { PG8_GL(bufoff, (kptr) + (h) * hstepA, voffA[0], 0); PG8_GL(bufoff, (kptr) + (h) * hstepA, voffA[1], 1); } } while (0)
#define PG8_LDA(dst, b, h) do { _Pragma("unroll") for (int m = 0; m < 4; ++m) _Pragma("unroll") for (int k = 0; k < 2; ++k) dst[m][k] = *(const LAS bf16x8*)(lds + PG8_SA(b, h) + aoff + m * 2048 + k * 1024); } while (0)
#define PG8_LDB(dst, b, h) do { _Pragma("unroll") for (int n = 0; n < 2; ++n) _Pragma("unroll") for (int k = 0; k < 2; ++k) dst[n][k] = *(const LAS bf16x8*)(lds + PG8_SB(b, h) + boff + n * 2048 + k * 1024); } while (0)
#define PG8_MMA(ai, bj, At, Bt) do { __builtin_amdgcn_s_setprio(1); _Pragma("unroll") for (int m = 0; m < 4; ++m) _Pragma("unroll") for (int n = 0; n < 2; ++n) _Pragma("unroll") for (int k = 0; k < 2; ++k) \
        acc[ai][bj][m][n] = __builtin_amdgcn_mfma_f32_16x16x32_bf16(Bt[n][k], At[m][k], acc[ai][bj][m][n], 0, 0, 0); __builtin_amdgcn_s_setprio(0); } while (0)
    Unit cur, nxt; int ui = 0;
    if (!S.next(0, cur)) return;
    f32x4 acc[2][2][4][2];
#pragma unroll
    for (int a = 0; a < 2; ++a)
#pragma unroll
        for (int b = 0; b < 2; ++b)
#pragma unroll
            for (int m = 0; m < 4; ++m)
#pragma unroll
                for (int n = 0; n < 2; ++n) acc[a][b][m][n] = (f32x4){0.f, 0.f, 0.f, 0.f};
    bf16x8 At[4][2], B0[2][2], B1[2][2];
    const char* cA = cur.a; const char* cB = cur.b;
    if constexpr (GATHER) {
#pragma unroll
        for (int h = 0; h < 2; ++h)
#pragma unroll
            for (int i = 0; i < 2; ++i) { vc[h][i] = S.row_off(cur, RA[i] + h * HALF) + (unsigned)CA[i] * 2u; vn[h][i] = vc[h][i]; }
    }
    PG8_STAGE_B(PG8_SB(0, 0), cB); PG8_STAGE_A(PG8_SA(0, 0), cA, 0, false); PG8_STAGE_B(PG8_SB(0, 1), cB + hstepB); PG8_STAGE_A(PG8_SA(0, 1), cA, 1, false);
    if (wr == 1) PG8_BAR;
    PG8_WAIT_V(4); PG8_BAR;
    PG8_STAGE_B(PG8_SB(1, 0), cB + kstep); PG8_STAGE_A(PG8_SA(1, 0), cA + kstep, 0, false); PG8_STAGE_B(PG8_SB(1, 1), cB + hstepB + kstep);
    PG8_WAIT_V(6); PG8_BAR;
    for (;;) {
        const bool has_next = S.next(ui + 1, nxt);
        const char* nA = has_next ? nxt.a : cA; const char* nB = has_next ? nxt.b : cB;
        if constexpr (GATHER) {
            if (has_next) {
#pragma unroll
                for (int h = 0; h < 2; ++h)
#pragma unroll
                    for (int i = 0; i < 2; ++i) vn[h][i] = S.row_off(nxt, RA[i] + h * HALF) + (unsigned)CA[i] * 2u;
            }
        }
        const int nt = cur.nt ? cur.nt : nt_phase;
        for (int t = 0; t < nt; t += 2) {
            const bool last = (t == nt - 2);
            int tq = t; asm volatile("" : "+s"(tq));
            const char* a1 = cA + (size_t)(tq + 1) * kstep;
            const char* a2 = last ? nA : cA + (size_t)(tq + 2) * kstep; const char* b2 = last ? nB : cB + (size_t)(tq + 2) * kstep;
            const char* a3 = a2 + kstep; const char* b3 = b2 + kstep;
            PG8_LDB(B0, 0, 0); PG8_SCHED; PG8_LDA(At, 0, 0); PG8_STAGE_A(PG8_SA(1, 1), a1, 1, false);
            PG8_WAIT_L(8); PG8_BAR; PG8_WAIT_L(0); PG8_MMA(0, 0, At, B0); PG8_BAR; PG8_SCHED;
            PG8_LDB(B1, 0, 1); PG8_STAGE_B(PG8_SB(0, 0), b2);
            PG8_BAR; PG8_WAIT_L(0); PG8_MMA(0, 1, At, B1); PG8_BAR;
            PG8_LDA(At, 0, 1); PG8_STAGE_A(PG8_SA(0, 0), a2, 0, last);
            PG8_BAR; PG8_WAIT_L(0); PG8_MMA(1, 0, At, B0); PG8_BAR; PG8_SCHED;
            PG8_STAGE_B(PG8_SB(0, 1), b2 + hstepB);
            PG8_WAIT_V(6); PG8_BAR; PG8_MMA(1, 1, At, B1); PG8_BAR;
            PG8_LDB(B0, 1, 0); PG8_SCHED; PG8_LDA(At, 1, 0); PG8_STAGE_A(PG8_SA(0, 1), a2, 1, last);
            PG8_WAIT_L(8); PG8_BAR; PG8_WAIT_L(0); PG8_MMA(0, 0, At, B0); PG8_BAR; PG8_SCHED;
            PG8_LDB(B1, 1, 1); PG8_STAGE_B(PG8_SB(1, 0), b3);
            PG8_BAR; PG8_WAIT_L(0); PG8_MMA(0, 1, At, B1); PG8_BAR;
            PG8_LDA(At, 1, 1); PG8_STAGE_A(PG8_SA(1, 0), a3, 0, last);
            PG8_BAR; PG8_WAIT_L(0); PG8_MMA(1, 0, At, B0); PG8_BAR; PG8_SCHED;
            PG8_STAGE_B(PG8_SB(1, 1), b3 + hstepB);
            PG8_WAIT_V(6); PG8_BAR; PG8_MMA(1, 1, At, B1); PG8_BAR;
        }
        { int ln2 = lane; asm volatile("" : "+v"(ln2)); E(acc, cur, wr, wc, ln2 & 15, ln2 >> 4); }
        if (!has_next) break;
#pragma unroll
        for (int a = 0; a < 2; ++a)
#pragma unroll
            for (int b = 0; b < 2; ++b)
#pragma unroll
                for (int m = 0; m < 4; ++m)
#pragma unroll
                    for (int n = 0; n < 2; ++n) acc[a][b][m][n] = (f32x4){0.f, 0.f, 0.f, 0.f};
        cur = nxt; cA = nA; cB = nB; ++ui;
        if constexpr (GATHER) {
#pragma unroll
            for (int h = 0; h < 2; ++h)
#pragma unroll
                for (int i = 0; i < 2; ++i) vc[h][i] = vn[h][i];
        }
    }
    PG8_WAIT_V(0);
    if (wr == 0) PG8_BAR;
    PG8_BAR;
#undef PG8_SA
#undef PG8_SB
#undef PG8_GL
#undef PG8_STAGE_A
#undef PG8_STAGE_B
#undef PG8_LDA
#undef PG8_LDB
#undef PG8_MMA
}
}
struct Params {
    const float* x; const float* mem; const int* positions;
    const float* norm_mix; const float* w_in; const float* diff_lambda; const float* hgrn_lb; const float* spatial_w; const float* spatial_b;
    const float* w_branch; const float* w_out; const float* norm_mem_q; const float* norm_mem_kv; const float* w_mem_q; const float* w_mem_kv; const float* w_mem_o;
    const float* norm_ffn; const float* w_rg; const float* b_rg; const float* w_re; const float* b_re; const float* w_eg; const float* w_eu; const float* w_ed; const float* norm_final;
    float* out; unsigned char* ws; int ph_lo, ph_hi;
};
struct Ctx {
    LAS unsigned char* lds; int tid, lane, wave, G, bid;
};
DI Ctx relaunder(const Ctx& C) { Ctx D = C; int w = C.wave, g = C.G, bi = C.bid; asm volatile("" : "+s"(w), "+s"(g), "+s"(bi)); D.wave = w; D.G = g; D.bid = bi; int ln; asm volatile("v_mbcnt_lo_u32_b32 %0, -1, 0\n\tv_mbcnt_hi_u32_b32 %0, -1, %0" : "=v"(ln)); D.lane = ln; D.tid = w * 64 + ln; return D; }
template <class T> DI T* wsp(const Params& P, size_t off) { return (T*)(P.ws + off); }

struct CvtJob { const float* src; bf16_t* dst; int ld_src, ncols, K, ld_dst, nb1, nb2; long ss1, ds1, ss2, ds2; const float* kscale; };
DI void cvt_transpose(const Ctx& C, const CvtJob& J) {
    LAS float* T = (LAS float*)C.lds;
    const int tn = (J.ncols + 63) >> 6, tk = J.K >> 6, per = tn * tk, total = per * J.nb1 * J.nb2;
    for (int t = C.bid; t < total; t += C.G) {
        const int bb = t / per, r = t % per, b1 = bb / J.nb2, b2 = bb % J.nb2, in_ = r / tk, ik = r % tk;
        const float* src = J.src + (size_t)b1 * J.ss1 + (size_t)b2 * J.ss2; bf16_t* dst = J.dst + (size_t)b1 * J.ds1 + (size_t)b2 * J.ds2;
        const int n0 = in_ * 64, k0 = ik * 64;
        { const int k = C.tid >> 3, c8 = (C.tid & 7) * 8;
#pragma unroll
          for (int v = 0; v < 2; ++v) { const int n = n0 + c8 + v * 4;
              f32x4 x = (f32x4){0.f, 0.f, 0.f, 0.f};
              if (n < J.ncols) x = *(const f32x4*)(src + (size_t)(k0 + k) * J.ld_src + n);
              if (J.kscale) { const float g = J.kscale[k0 + k]; x[0] *= g; x[1] *= g; x[2] *= g; x[3] *= g; }
#pragma unroll
              for (int j = 0; j < 4; ++j) T[(c8 + v * 4 + j) * 65 + k] = x[j]; } }
        __syncthreads();
        { const int n = C.tid >> 3, k8 = (C.tid & 7) * 8;
          if (n0 + n < J.ncols) { u32x4 w;
#pragma unroll
              for (int j = 0; j < 4; ++j) w[j] = pk2(T[n * 65 + k8 + 2 * j], T[n * 65 + k8 + 2 * j + 1]);
              *(u32x4*)(dst + (size_t)(n0 + n) * J.ld_dst + k0 + k8) = w; } }
        __syncthreads();
    }
}
DI CvtJob mkjob(const float* src, bf16_t* dst, int ld_src, int ncols, int K, int ld_dst, int nb1 = 1, long ss1 = 0, long ds1 = 0, int nb2 = 1, long ss2 = 0, long ds2 = 0) {
    CvtJob J; J.src = src; J.dst = dst; J.ld_src = ld_src; J.ncols = ncols; J.K = K; J.ld_dst = ld_dst; J.nb1 = nb1; J.nb2 = nb2; J.ss1 = ss1; J.ds1 = ds1; J.ss2 = ss2; J.ds2 = ds2; J.kscale = nullptr; return J; }

DI void phase_convert_layer(const Ctx& C, const Params& P, int l) {
    const float* win = P.w_in + (size_t)l * 1024 * IN_WIDTH;
    bf16_t* WIN = wsp<bf16_t>(P, W_IN); bf16_t* WV = wsp<bf16_t>(P, W_V);
    cvt_transpose(C, mkjob(win + 0, WIN, IN_WIDTH, 512, 1024, 1024));
    cvt_transpose(C, mkjob(win + 768, WIN + (size_t)512 * 1024, IN_WIDTH, 1856, 1024, 1024));
    cvt_transpose(C, mkjob(win + 2688, WIN + (size_t)2368 * 1024, IN_WIDTH, 164, 1024, 1024));
    cvt_transpose(C, mkjob(win + 512, WV, IN_WIDTH, 256, 1024, 1024));
    cvt_transpose(C, mkjob(win + 2624, WV + (size_t)256 * 1024, IN_WIDTH, 64, 1024, 1024));
    cvt_transpose(C, mkjob(win + 2852, wsp<bf16_t>(P, W_G), IN_WIDTH, 4096, 1024, 1024));
    cvt_transpose(C, mkjob(P.w_branch + (size_t)l * 4 * 256 * 1024, wsp<bf16_t>(P, W_BR), 1024, 1024, 256, 1024, 4, 256 * 1024, 256));
    cvt_transpose(C, mkjob(P.w_out + (size_t)l * 1024 * 1024, wsp<bf16_t>(P, W_OUT), 1024, 1024, 1024, 1024));
    { CvtJob J = mkjob(P.w_mem_q + (size_t)l * 1024 * 256, wsp<bf16_t>(P, W_Q), 256, 256, 1024, 1024); J.kscale = P.norm_mem_q + l * DM; cvt_transpose(C, J); }
    cvt_transpose(C, mkjob(P.w_mem_o + (size_t)l * 256 * 1024, wsp<bf16_t>(P, W_O), 1024, 1024, 256, 256));
    cvt_transpose(C, mkjob(P.w_eg + (size_t)l * 32 * 1024 * 256, wsp<bf16_t>(P, W_GU), 256, 128, 1024, 1024, 32, 1024 * 256, 512 * 1024, 2, 128, 256 * 1024));
    cvt_transpose(C, mkjob(P.w_eu + (size_t)l * 32 * 1024 * 256, wsp<bf16_t>(P, W_GU) + (size_t)128 * 1024, 256, 128, 1024, 1024, 32, 1024 * 256, 512 * 1024, 2, 128, 256 * 1024));
    cvt_transpose(C, mkjob(P.w_ed + (size_t)l * 32 * 256 * 1024, wsp<bf16_t>(P, W_D), 1024, 1024, 256, 256, 32, 256 * 1024, 1024 * 256));
    { bf16_t* z0 = WIN + (size_t)2532 * 1024; for (int i = C.bid * NTHREADS + C.tid; i < 28 * 1024; i += C.G * NTHREADS) z0[i] = 0;
      bf16_t* z1 = WV + (size_t)320 * 1024; for (int i = C.bid * NTHREADS + C.tid; i < 192 * 1024; i += C.G * NTHREADS) z1[i] = 0; }
    { bf16_t* rh = wsp<bf16_t>(P, W_RH); const float* wre = P.w_re + (size_t)l * 1024 * 32; const float* wrg = P.w_rg + (size_t)l * 1024 * 4;
      for (int i = C.bid * NTHREADS + C.tid; i < 64 * 1024; i += C.G * NTHREADS) { const int j = i >> 10, k = i & 1023;
          const float w = (j < 32) ? wre[k * 32 + j] : (j < 36 ? wrg[k * 4 + (j - 32)] : 0.f);
          const bf16_t hi = f2bf(w); rh[i] = hi; rh[64 * 1024 + i] = f2bf(w - bf2f(hi)); } }
    { const float* sw = P.spatial_w + (size_t)l * 4 * 128 * 128; bf16_t* d = wsp<bf16_t>(P, W_SGU);
      for (int i = C.bid * NTHREADS + C.tid; i < 4 * 128 * 128; i += C.G * NTHREADS) { const int s = i & 127, t = (i >> 7) & 127; d[i] = (s <= t) ? f2bf(sw[i]) : (bf16_t)0; } }
}

DI void phase_prologue(const Ctx& C, const Params& P) {
    for (int r = C.bid * NWAVES + C.wave; r < NB * MEMLEN; r += C.G * NWAVES) {
        const float* src = P.mem + (size_t)r * DM; f32x4 v[4]; float ss = 0.f;
#pragma unroll
        for (int j = 0; j < 4; ++j) { v[j] = *(const f32x4*)(src + j * 256 + C.lane * 4); ss += v[j][0] * v[j][0] + v[j][1] * v[j][1] + v[j][2] * v[j][2] + v[j][3] * v[j][3]; }
        ss = wave_sum(ss); const float rs = 1.0f / sqrtf(ss * (1.0f / DM) + 1e-6f);
        for (int l = 0; l < DEPTH; ++l) { bf16_t* dst = wsp<bf16_t>(P, WS_MEMN) + ((size_t)l * 1024 + r) * DM;
#pragma unroll
            for (int j = 0; j < 4; ++j) { const f32x4 g = *(const f32x4*)(P.norm_mem_kv + l * DM + j * 256 + C.lane * 4);
                u32x2 w; w.x = pk2(v[j][0] * rs * g[0], v[j][1] * rs * g[1]); w.y = pk2(v[j][2] * rs * g[2], v[j][3] * rs * g[3]);
                *(u32x2*)(dst + j * 256 + C.lane * 4) = w; } }
    }
    for (int l = 0; l < DEPTH; ++l)
        cvt_transpose(C, mkjob(P.w_mem_kv + (size_t)l * 1024 * 512, wsp<bf16_t>(P, W_KV) + (size_t)l * 512 * 1024, 512, 512, 1024, 1024));
}

template <bool ADD_YB, bool WRITE_H, bool FINAL, bool FROM_X = false>
DI void phase_rownorm(const Ctx& C, const Params& P, const float* gain) {
    float* XR = P.out; bf16_t* H = wsp<bf16_t>(P, WS_H); const bf16_t* YB = (const bf16_t*)(P.ws + WS_R1 + R1_YB);
    const int stride = C.G * NWAVES; int t = C.bid * NWAVES + C.wave;
    f32x4 v[4], vn[4]; u32x2 ya[4], yb[4], yan[4], ybn[4];
#define RN_LOAD(dst, da, db, tt) do { const float* src_ = (FROM_X ? P.x : (const float*)XR) + (size_t)(tt) * DM; _Pragma("unroll") for (int j = 0; j < 4; ++j) { const int c = j * 256 + C.lane * 4; dst[j] = *(const f32x4*)(src_ + c); \
        if constexpr (ADD_YB) { da[j] = *(const u32x2*)(YB + (size_t)(2 * (tt)) * DM + c); db[j] = *(const u32x2*)(YB + (size_t)(2 * (tt) + 1) * DM + c); } } } while (0)
    if (t < NTOK) RN_LOAD(v, ya, yb, t);
    for (; t < NTOK; t += stride) {
        const int tn = (t + stride < NTOK) ? t + stride : t;
        RN_LOAD(vn, yan, ybn, tn);
        float* xr = XR + (size_t)t * DM; float ss = 0.f;
#pragma unroll
        for (int j = 0; j < 4; ++j) { const int c = j * 256 + C.lane * 4;
            if constexpr (ADD_YB) { const u32x2 a = ya[j], b = yb[j];
                v[j][0] += bflo(a.x) + bflo(b.x); v[j][1] += bfhi(a.x) + bfhi(b.x); v[j][2] += bflo(a.y) + bflo(b.y); v[j][3] += bfhi(a.y) + bfhi(b.y); }
            if constexpr ((ADD_YB && !FINAL) || FROM_X) *(f32x4*)(xr + c) = v[j];
            ss += v[j][0] * v[j][0] + v[j][1] * v[j][1] + v[j][2] * v[j][2] + v[j][3] * v[j][3]; }
        ss = wave_sum(ss); const float rs = 1.0f / sqrtf(ss * (1.0f / DM) + 1e-6f);
#pragma unroll
        for (int j = 0; j < 4; ++j) { const int c = j * 256 + C.lane * 4; const f32x4 g = *(const f32x4*)(gain + c);
            const f32x4 o = (f32x4){v[j][0] * rs * g[0], v[j][1] * rs * g[1], v[j][2] * rs * g[2], v[j][3] * rs * g[3]};
            if constexpr (FINAL) *(f32x4*)(xr + c) = o;
            if constexpr (WRITE_H) { u32x2 w; w.x = pk2(o[0], o[1]); w.y = pk2(o[2], o[3]); *(u32x2*)(H + (size_t)t * DM + c) = w; } }
#pragma unroll
        for (int j = 0; j < 4; ++j) { v[j] = vn[j]; if constexpr (ADD_YB) { ya[j] = yan[j]; yb[j] = ybn[j]; } }
    }
#undef RN_LOAD
}

DI void phase_rope(const Ctx& C, const Params& P, const int l, const bool dry = false) {
    bf16_t* PROJ = (bf16_t*)(P.ws + WS_R1 + R1_PROJ);
    LAS f32x2* tab = (LAS f32x2*)(C.lds) + C.wave * 64;
    float kmx[4] = {0.f, 0.f, 0.f, 0.f};
    for (int t = C.bid * NWAVES + C.wave; t < NTOK; t += C.G * NWAVES) {
        const float pos = (float)P.positions[t];
        if (C.lane < 48) { const int i = C.lane < 16 ? C.lane : C.lane - 16; const float d = C.lane < 16 ? 32.f : 64.f;
            const float inv = powf(10000.0f, -(float)i * (2.0f / d)); const float ang = pos * inv; float s, c; sincosf(ang, &s, &c); tab[C.lane] = (f32x2){c, s}; }
        __builtin_amdgcn_wave_barrier();
        asm volatile("s_waitcnt lgkmcnt(0)" ::: "memory");
        bf16_t* row = PROJ + (size_t)t * PROJ_LD;
        { const float kv = (C.lane < 32) ? bf2f(row[PC_DIK + C.lane]) : 0.f; const float k2 = wave_sum(kv * kv); const int bb = t >> 12;
#pragma unroll
          for (int q = 0; q < 4; ++q) kmx[q] = (bb == q) ? fmaxf(kmx[q], k2) : kmx[q]; }
        for (int p = C.lane; p < 496; p += 64) {
            int col, half, ti;
            if (p < 256) { col = (p >> 4) * 32 + (p & 15); half = 16; ti = p & 15; }
            else if (p < 416) { const int q = p - 256; col = PC_DQ + (q >> 5) * 64 + (q & 31); half = 32; ti = 16 + (q & 31); }
            else { const int q = p - 416; col = PC_DIQ + (q >> 4) * 32 + (q & 15); half = 16; ti = q & 15; }
            const f32x2 cs = tab[ti]; const float x1 = bf2f(row[col]), x2 = bf2f(row[col + half]);
            if (!dry || pos < -1.0f) { row[col] = f2bf(x1 * cs.x - x2 * cs.y); row[col + half] = f2bf(x2 * cs.x + x1 * cs.y); }
        }
        __builtin_amdgcn_wave_barrier();
    }
    { LAS unsigned* km = (LAS unsigned*)(C.lds + 8192);
      __syncthreads();
      if (C.tid < 4) km[C.tid] = 0u;
      __syncthreads();
      if (C.lane < 4) { float v = 0.f;
#pragma unroll
          for (int q = 0; q < 4; ++q) v = (C.lane == q) ? kmx[q] : v;
          __hip_atomic_fetch_max(km + C.lane, __float_as_uint(v), __ATOMIC_RELAXED, __HIP_MEMORY_SCOPE_WORKGROUP); }
      __syncthreads();
      if (C.tid < 4 && !dry) atomicMax(wsp<unsigned>(P, WS_CTL) + CW_KMAX + 8 * l + C.tid, (unsigned)km[C.tid]);
      __syncthreads(); }
}
DI void sm_step(f32x16& st, const float c, float& m, float& l, f32x16& O0, f32x16& O1, bf16x8& p0, bf16x8& p1) {
    float mx = st[0];
#pragma unroll
    for (int i = 1; i < 16; ++i) mx = fmaxf(mx, st[i]);
    mx = fmaxf(mx, __shfl_xor(mx, 32));
    if (__any(mx > m)) { const float mn = fmaxf(m, mx); const float a = __builtin_amdgcn_exp2f((m - mn) * c); l *= a;
#pragma unroll
        for (int i = 0; i < 16; ++i) { O0[i] *= a; O1[i] *= a; }
        m = mn; }
    const float mc = m * c; float rs = 0.f;
#pragma unroll
    for (int i = 0; i < 16; ++i) { const float p = __builtin_amdgcn_exp2f(fmaf(st[i], c, -mc)); st[i] = p; rs += p; }
    l += rs;
    u32x4 a, b;
    a.x = pk2(st[0], st[1]); a.y = pk2(st[2], st[3]); a.z = pk2(st[4], st[5]); a.w = pk2(st[6], st[7]);
    b.x = pk2(st[8], st[9]); b.y = pk2(st[10], st[11]); b.z = pk2(st[12], st[13]); b.w = pk2(st[14], st[15]);
    p0 = __builtin_bit_cast(bf16x8, a); p1 = __builtin_bit_cast(bf16x8, b);
}
DI void apply_mask(f32x16& st, unsigned vmask) {
#pragma unroll
    for (int i = 0; i < 16; ++i) { const unsigned sel = (unsigned)__builtin_amdgcn_sbfe((int)vmask, i, 1);
        st[i] = __uint_as_float((__float_as_uint(st[i]) & sel) | (__float_as_uint(-3.0e38f) & ~sel)); }
}
DI bf16x8 vt_frag(const bf16_t* vt_row, int k0, int s2, int h) {
    const bf16_t* p = vt_row + k0 + 16 * s2 + 4 * h; const u32x2 lo = *(const u32x2*)p, hi = *(const u32x2*)(p + 8);
    u32x4 w; w.x = lo.x; w.y = lo.y; w.z = hi.x; w.w = hi.y; return __builtin_bit_cast(bf16x8, w);
}
DI unsigned causal_mask(int r, int h) { unsigned m = 0;
#pragma unroll
    for (int i = 0; i < 16; ++i) m |= (crow(i, h) <= r) ? (1u << i) : 0u;
    return m; }
DI void causal_wave_unit(int c, int w, int& bh, int& qs) { const int pi = c * 4 + (w & 3); bh = (pi >> 6) & 15; const int j = pi & 63; qs = (w < 4) ? 127 - j : j; }

struct DiffKV { bf16x8 kf[2][2]; bf16x8 vf[2][2]; };
DI void diff_load(DiffKV& t, const bf16_t* kbase, const bf16_t* vrow0, const bf16_t* vrow1, int k0, int r, int h) {
    const bf16_t* kp = kbase + (size_t)(k0 + r) * PROJ_LD + 8 * h;
#pragma unroll
    for (int m = 0; m < 2; ++m)
#pragma unroll
        for (int s = 0; s < 2; ++s) t.kf[m][s] = *(const bf16x8*)(kp + m * 32 + 16 * s);
#pragma unroll
    for (int s2 = 0; s2 < 2; ++s2) { t.vf[0][s2] = vt_frag(vrow0, k0, s2, h); t.vf[1][s2] = vt_frag(vrow1, k0, s2, h); }
}
DI void diff_step(const DiffKV& t, const bf16x8 (&qf)[2][2], bool diag, unsigned dmask, const float c, float (&mm)[2], float (&ll)[2], f32x16 (&O)[2][2]) {
#pragma unroll
    for (int m = 0; m < 2; ++m) {
        f32x16 st = mfma32(t.kf[m][0], qf[m][0], zero16()); st = mfma32(t.kf[m][1], qf[m][1], st);
        if (diag) apply_mask(st, dmask);
        bf16x8 p0, p1; sm_step(st, c, mm[m], ll[m], O[m][0], O[m][1], p0, p1);
        O[m][0] = mfma32(t.vf[0][0], p0, O[m][0]); O[m][0] = mfma32(t.vf[0][1], p1, O[m][0]);
        O[m][1] = mfma32(t.vf[1][0], p0, O[m][1]); O[m][1] = mfma32(t.vf[1][1], p1, O[m][1]);
    }
}
DI void diff_attn_wave(const Ctx& C, const Params& P, int l) {
    const bf16_t* PROJ = (const bf16_t*)(P.ws + WS_R1 + R1_PROJ); const bf16_t* VT = (const bf16_t*)(P.ws + WS_R1 + R1_VT); bf16_t* Y = wsp<bf16_t>(P, WS_Y);
    int bh, qs; causal_wave_unit(C.bid, C.wave, bh, qs);
    const int b = bh >> 2, hd = bh & 3, r = C.lane & 31, h = C.lane >> 5, tokb = b * SEQ, q0 = qs * 32, t = q0 + r;
    const float* lv = P.diff_lambda + l * 128;
    const float d1 = wave_sum(C.lane < 32 ? lv[C.lane] * lv[32 + C.lane] : 0.f), d2 = wave_sum(C.lane < 32 ? lv[64 + C.lane] * lv[96 + C.lane] : 0.f);
    const float lam_init = 0.8f - 0.6f * expf(-0.3f * (float)l), lam = expf(d1) - expf(d2) + lam_init;
    bf16x8 qf[2][2];
#pragma unroll
    for (int m = 0; m < 2; ++m)
#pragma unroll
        for (int s = 0; s < 2; ++s) qf[m][s] = *(const bf16x8*)(PROJ + (size_t)(tokb + t) * PROJ_LD + PC_AQ + hd * 64 + m * 32 + 16 * s + 8 * h);
    f32x16 O[2][2]; float mm[2] = {-1e30f, -1e30f}, ll[2] = {0.f, 0.f};
#pragma unroll
    for (int m = 0; m < 2; ++m) { O[m][0] = zero16(); O[m][1] = zero16(); }
    const float c = 0.17677669529663687f * 1.4426950408889634f;
    const int nkt = qs + 1; const unsigned dmask = causal_mask(r, h);
    const bf16_t* kbase = PROJ + (size_t)tokb * PROJ_LD + PC_AK + hd * 64;
    const bf16_t* vrow0 = VT + (size_t)(hd * 64 + r) * NTOK + tokb; const bf16_t* vrow1 = vrow0 + (size_t)32 * NTOK;
    DiffKV ta, tb; diff_load(ta, kbase, vrow0, vrow1, 0, r, h);
    for (int kt = 0; kt < nkt; kt += 2) {
        if (kt + 1 < nkt) diff_load(tb, kbase, vrow0, vrow1, (kt + 1) * 32, r, h);
        diff_step(ta, qf, kt == nkt - 1, dmask, c, mm, ll, O);
        if (kt + 1 < nkt) { if (kt + 2 < nkt) diff_load(ta, kbase, vrow0, vrow1, (kt + 2) * 32, r, h);
            diff_step(tb, qf, kt + 1 == nkt - 1, dmask, c, mm, ll, O); }
    }
    ll[0] += __shfl_xor(ll[0], 32); ll[1] += __shfl_xor(ll[1], 32);
    const float i0 = 1.0f / ll[0], i1 = lam / ll[1]; float ss = 0.f;
#pragma unroll
    for (int et = 0; et < 2; ++et)
#pragma unroll
        for (int i = 0; i < 16; ++i) { const float o = O[0][et][i] * i0 - O[1][et][i] * i1; O[0][et][i] = o; ss += o * o; }
    ss += __shfl_xor(ss, 32);
    const float rn = (1.0f - lam_init) / sqrtf(ss * (1.0f / 64.0f) + 1e-6f);
    bf16_t* yrow = Y + (size_t)(tokb + t) * DM + hd * 64;
#pragma unroll
    for (int et = 0; et < 2; ++et)
#pragma unroll
        for (int g = 0; g < 4; ++g) { u32x2 w; w.x = pk2(O[0][et][4 * g] * rn, O[0][et][4 * g + 1] * rn); w.y = pk2(O[0][et][4 * g + 2] * rn, O[0][et][4 * g + 3] * rn);
            *(u32x2*)(yrow + et * 32 + 8 * g + 4 * h) = w; }
}

struct KV64 { bf16x8 kf[4]; bf16x8 vf[2][2]; };
DI void kv64_load(KV64& t, const bf16_t* kbase, int kld, const bf16_t* vrow0, const bf16_t* vrow1, int k0, int r, int h) {
    const bf16_t* kp = kbase + (size_t)(k0 + r) * kld + 8 * h;
#pragma unroll
    for (int s = 0; s < 4; ++s) t.kf[s] = *(const bf16x8*)(kp + 16 * s);
#pragma unroll
    for (int s2 = 0; s2 < 2; ++s2) { t.vf[0][s2] = vt_frag(vrow0, k0, s2, h); t.vf[1][s2] = vt_frag(vrow1, k0, s2, h); }
}
DI void kv64_step(const KV64& t, const bf16x8 (&qf)[4], bool masked, unsigned vmask, const float c, float& mm, float& ll, f32x16 (&O)[2]) {
    f32x16 st = zero16();
#pragma unroll
    for (int s = 0; s < 4; ++s) st = mfma32(t.kf[s], qf[s], st);
    if (masked) apply_mask(st, vmask);
    bf16x8 p0, p1; sm_step(st, c, mm, ll, O[0], O[1], p0, p1);
    O[0] = mfma32(t.vf[0][0], p0, O[0]); O[0] = mfma32(t.vf[0][1], p1, O[0]);
    O[1] = mfma32(t.vf[1][0], p0, O[1]); O[1] = mfma32(t.vf[1][1], p1, O[1]);
}
DI void mem_attn_wave(const Ctx& C, const Params& P, int l) {
    const bf16_t* MQ = (const bf16_t*)(P.ws + WS_R1 + R1_MQ); bf16_t* MO = (bf16_t*)(P.ws + WS_R1 + R1_MO);
    const bf16_t* MK = wsp<bf16_t>(P, WS_MK) + (size_t)l * 1024 * 256; const bf16_t* MVT = wsp<bf16_t>(P, WS_MVT) + (size_t)l * 256 * 1024;
    const int r = C.lane & 31, h = C.lane >> 5;
    for (int wu = C.bid * NWAVES + C.wave; wu < 2048; wu += C.G * NWAVES) {
        const int bh = wu >> 7, qs = wu & 127, b = bh >> 2, hd = bh & 3, t = b * SEQ + qs * 32 + r;
        bf16x8 qf[4];
#pragma unroll
        for (int s = 0; s < 4; ++s) qf[s] = *(const bf16x8*)(MQ + (size_t)t * 256 + hd * 64 + 16 * s + 8 * h);
        f32x16 O[2] = {zero16(), zero16()}; float mm = -1e30f, ll = 0.f;
        const float c = 0.125f * 1.4426950408889634f;
        const bf16_t* kbase = MK + (size_t)(b * 256) * 256 + hd * 64;
        const bf16_t* vrow0 = MVT + (size_t)(hd * 64 + r) * 1024 + b * 256; const bf16_t* vrow1 = vrow0 + (size_t)32 * 1024;
        KV64 ta, tb; kv64_load(ta, kbase, 256, vrow0, vrow1, 0, r, h);
#pragma unroll 1
        for (int kt = 0; kt < 8; kt += 2) {
            kv64_load(tb, kbase, 256, vrow0, vrow1, (kt + 1) * 32, r, h);
            kv64_step(ta, qf, false, 0u, c, mm, ll, O);
            if (kt + 2 < 8) kv64_load(ta, kbase, 256, vrow0, vrow1, (kt + 2) * 32, r, h);
            kv64_step(tb, qf, false, 0u, c, mm, ll, O);
        }
        ll += __shfl_xor(ll, 32);
        const float il = 1.0f / ll; bf16_t* orow = MO + (size_t)t * 256 + hd * 64;
#pragma unroll
        for (int et = 0; et < 2; ++et)
#pragma unroll
            for (int g = 0; g < 4; ++g) { u32x2 w; w.x = pk2(O[et][4 * g] * il, O[et][4 * g + 1] * il); w.y = pk2(O[et][4 * g + 2] * il, O[et][4 * g + 3] * il);
                *(u32x2*)(orow + et * 32 + 8 * g + 4 * h) = w; }
    }
}

DI f32x16 idx_score(const bf16x8 (&ikf)[2], const bf16x8 (&iqf)[4][2], const float (&iw)[4]) {
    f32x16 a[4];
#pragma unroll
    for (int hh = 0; hh < 4; ++hh) a[hh] = mfma32(ikf[0], iqf[hh][0], zero16());
#pragma unroll
    for (int hh = 0; hh < 4; ++hh) a[hh] = mfma32(ikf[1], iqf[hh][1], a[hh]);
    f32x16 sc = zero16();
#pragma unroll
    for (int hh = 0; hh < 4; ++hh) {
#pragma unroll
        for (int i = 0; i < 16; ++i) sc[i] = fmaf(iw[hh], __builtin_amdgcn_fmed3f(a[hh][i], 0.f, __builtin_inff()), sc[i]); }
    return sc;
}
DI unsigned okey_of(float f) { const unsigned u = __float_as_uint(f); return u ^ ((unsigned)((int)u >> 31) | 0x80000000u); }
DI void load_idx_q(const bf16_t* PROJ, size_t tok, int h, bf16x8 (&iqf)[4][2], float (&iw)[4]) {
    const bf16_t* row = PROJ + tok * PROJ_LD;
#pragma unroll
    for (int hh = 0; hh < 4; ++hh) {
#pragma unroll
        for (int s = 0; s < 2; ++s) iqf[hh][s] = *(const bf16x8*)(row + PC_DIQ + hh * 32 + 16 * s + 8 * h);
        iw[hh] = bf2f(row[PC_DIW + hh]) * 0.08838834764831845f; }
}

template <int PASS> DI void d1_digit(unsigned ok, unsigned sinv, unsigned mv, unsigned mb, bool& match, unsigned& dg) {
    if constexpr (PASS == 0) { match = true; dg = ok >> 21; }
    else if constexpr (PASS == 1) { match = (ok >> 21) == mv; dg = (ok >> 10) & 2047u; }
    else if constexpr (PASS == 2) { match = (ok >> 10) == mv; dg = ((ok & 1023u) << 1) | (sinv >> 11); }
    else { match = (ok == mv) && ((sinv >> 11) == mb); dg = sinv & 2047u; }
}
constexpr int D1_HSTRIDE = 1025;
DI unsigned lin_bin(float sc, float lin_a, float lin_b) { return (unsigned)__builtin_amdgcn_fmed3f(fmaf(sc, lin_a, lin_b), 0.f, 2047.f); }
template <int PASS> DI void d1_pass(const Ctx& C, const bf16_t* PROJ, int tokb, int q0, int nkt, const bf16x8 (&iqf)[4][2], const float (&iw)[4], LAS unsigned* hist, volatile LAS unsigned* QS, const float lin_a = 0.f, const float lin_b = 0.f) {
    const int r = C.lane & 31, h = C.lane >> 5;
    const unsigned mv = QS[r * 4 + 0], mb = QS[r * 4 + 1];
    LAS unsigned* hrow = hist + r * D1_HSTRIDE;
    const bf16_t* kp0 = PROJ + (size_t)(tokb + r) * PROJ_LD + PC_DIK + 8 * h;
    bf16x8 ikf[2], ikn[2];
    if (C.wave < nkt) { const bf16_t* kp = kp0 + (size_t)(C.wave * 32) * PROJ_LD; ikf[0] = *(const bf16x8*)kp; ikf[1] = *(const bf16x8*)(kp + 16); }
    for (int kt = C.wave; kt < nkt; kt += NWAVES) {
        const int k0 = kt * 32;
        { const int ktn = (kt + NWAVES < nkt) ? kt + NWAVES : kt;
          const bf16_t* kp = kp0 + (size_t)(ktn * 32) * PROJ_LD; ikn[0] = *(const bf16x8*)kp; ikn[1] = *(const bf16x8*)(kp + 16); }
        const f32x16 sc = idx_score(ikf, iqf, iw);
        const bool diag = (kt == nkt - 1);
        unsigned wadr[16], wval[16]; bool any_m = false;
#pragma unroll
        for (int i = 0; i < 16; ++i) { const unsigned ok = okey_of(sc[i]), sinv = 4095u - (unsigned)(k0 + crow(i, h));
            bool match; unsigned dg;
            if constexpr (PASS == 4) { match = true; dg = lin_bin(sc[i], lin_a, lin_b); } else d1_digit<PASS>(ok, sinv, mv, mb, match, dg);
            if (diag) match = match && (crow(i, h) <= r);
            wadr[i] = match ? (dg >> 1) : 1024u;
            wval[i] = match ? (1u << ((dg & 1u) * 16u)) : 0u; any_m = any_m || match; }
        if (PASS == 0 || PASS == 4 || __any(any_m)) {
#pragma unroll
            for (int i = 0; i < 16; ++i) __hip_atomic_fetch_add(hrow + wadr[i], wval[i], __ATOMIC_RELAXED, __HIP_MEMORY_SCOPE_WORKGROUP);
        }
        ikf[0] = ikn[0]; ikf[1] = ikn[1];
    }
    __syncthreads();
    for (int srep = ((PROBE_DUP & 32768) ? 0 : 1); srep < 2; ++srep)
    for (int qq = 0; qq < 4; ++qq) {
        const int q = C.wave * 4 + qq; const unsigned rk = QS[q * 4 + 2];
        unsigned lsum = 0;
#pragma unroll
        for (int j = 0; j < 16; ++j) { const unsigned wj = hist[q * D1_HSTRIDE + C.lane * 16 + j]; lsum += (wj & 0xffffu) + (wj >> 16); }
        unsigned x = lsum;
#pragma unroll
        for (int o = 1; o < 64; o <<= 1) { const unsigned y = __shfl_down(x, o); if (C.lane + o < 64) x += y; }
        const unsigned above = x - lsum;
        const bool hit = (above < rk) && (rk <= x);
        const unsigned long long bal = __ballot(hit); const int L = bal ? (__ffsll((long long)bal) - 1) : 0;
        const unsigned aboveL = __shfl(above, L);
        const unsigned bk = (C.lane < 32) ? (unsigned)((const LAS unsigned short*)hist)[q * (2 * D1_HSTRIDE) + L * 32 + C.lane] : 0u;
        unsigned y2 = bk;
#pragma unroll
        for (int o = 1; o < 32; o <<= 1) { const unsigned z = __shfl_down(y2, o); if (C.lane + o < 32) y2 += z; }
        const unsigned ab2 = aboveL + y2 - bk;
        const bool hit2 = (C.lane < 32) && (ab2 < rk) && (rk <= ab2 + bk);
        const unsigned long long bal2 = __ballot(hit2); const int K2 = bal2 ? (__ffsll((long long)bal2) - 1) : 0;
        unsigned bin = (unsigned)(L * 32 + K2), rnew = rk - __shfl(ab2, K2);
        if (C.lane == 0 && srep == 1) {
            const unsigned omv = QS[q * 4 + 0];
            if constexpr (PASS == 0 || PASS == 4) { QS[q * 4 + 0] = bin; }
            else if constexpr (PASS == 1) { QS[q * 4 + 0] = (omv << 11) | bin; }
            else if constexpr (PASS == 2) { QS[q * 4 + 0] = (omv << 10) | (bin >> 1); QS[q * 4 + 1] = bin & 1u; }
            else { QS[q * 4 + 3] = bin; }
            QS[q * 4 + 2] = rnew;
        }
    }
    __syncthreads();
    if constexpr (PASS == 1 || PASS == 2) { for (int crep = 0; crep < ((PROBE_DUP & 65536) ? 2 : 1); ++crep) { for (int i = C.tid; i < 32 * D1_HSTRIDE; i += NTHREADS) hist[i] = 0u; __syncthreads(); } }
}
DI void dsa_select_unit(const Ctx& C, const Params& P, int l, int u) {
    const bf16_t* PROJ = (const bf16_t*)(P.ws + WS_R1 + R1_PROJ); unsigned short* MASK = wsp<unsigned short>(P, WS_MASK);
    const int qt = 127 - (u >> 2), b = u & 3, tokb = b * SEQ, q0 = qt * 32;
    unsigned short* mrow = MASK + ((size_t)(b * 128 + qt) * 128) * 64 + C.lane;
    if (q0 + 31 < 256) {
        for (int kt = C.wave; kt <= qt; kt += NWAVES) mrow[(size_t)kt * 64] = (unsigned short)((kt == qt) ? causal_mask(C.lane & 31, C.lane >> 5) : 0xffffu);
        return; }
    LAS unsigned* hist = (LAS unsigned*)C.lds; volatile LAS unsigned* QS = (volatile LAS unsigned*)(C.lds + 32 * D1_HSTRIDE * 4);
    for (int i = C.tid; i < 32 * D1_HSTRIDE; i += NTHREADS) hist[i] = 0u;
    if (C.tid < 32) { QS[C.tid * 4 + 0] = 0u; QS[C.tid * 4 + 1] = 0u; QS[C.tid * 4 + 2] = 256u; QS[C.tid * 4 + 3] = 0u; }
    __syncthreads();
    const int r = C.lane & 31, h = C.lane >> 5;
    bf16x8 iqf[4][2]; float iw[4]; load_idx_q(PROJ, (size_t)(tokb + q0 + r), h, iqf, iw);
    const int nkt = qt + 1;
    float lin_a, lin_b;
    { const float kmax = sqrtf(__uint_as_float(wsp<unsigned>(P, WS_CTL)[CW_KMAX + 8 * l + b]));
      float hi = 0.f, lo = 0.f;
#pragma unroll
      for (int hh = 0; hh < 4; ++hh) { float n2 = 0.f;
#pragma unroll
          for (int s2 = 0; s2 < 2; ++s2) { const u32x4 w = __builtin_bit_cast(u32x4, iqf[hh][s2]);
#pragma unroll
              for (int j = 0; j < 4; ++j) { const float x0 = bflo(w[j]), x1 = bfhi(w[j]); n2 += x0 * x0 + x1 * x1; } }
          n2 += __shfl_xor(n2, 32); const float bnd = 0.5f * kmax * fabsf(iw[hh]) * sqrtf(n2);
          if (iw[hh] > 0.f) hi += bnd; else lo -= bnd; }
      const float span = hi - lo; lin_a = span > 0.f ? 2047.0f / span : 0.f; lin_b = -lo * lin_a; }
    d1_pass<4>(C, PROJ, tokb, q0, nkt, iqf, iw, hist, QS, lin_a, lin_b);
    constexpr int CCAP = 384;
    LAS unsigned long long* CAND = (LAS unsigned long long*)C.lds;
    LAS unsigned short* LM = (LAS unsigned short*)(C.lds + 98304);
    LAS unsigned* ZBM = (LAS unsigned*)(C.lds + 114688);
    LAS unsigned* ccnt = (LAS unsigned*)(C.lds + 32 * D1_HSTRIDE * 4 + 512);
    if (C.tid < 33) ccnt[C.tid] = 0u;
    __syncthreads();
    {
        const unsigned b0 = QS[r * 4 + 0];
        const bf16_t* kp0 = PROJ + (size_t)(tokb + r) * PROJ_LD + PC_DIK + 8 * h;
        bf16x8 ikf[2], ikn[2];
        if (C.wave < nkt) { const bf16_t* kp = kp0 + (size_t)(C.wave * 32) * PROJ_LD; ikf[0] = *(const bf16x8*)kp; ikf[1] = *(const bf16x8*)(kp + 16); }
        for (int kt = C.wave; kt < nkt; kt += NWAVES) {
            const int k0 = kt * 32;
            { const int ktn = (kt + NWAVES < nkt) ? kt + NWAVES : kt;
              const bf16_t* kp = kp0 + (size_t)(ktn * 32) * PROJ_LD; ikn[0] = *(const bf16x8*)kp; ikn[1] = *(const bf16x8*)(kp + 16); }
            const f32x16 sc = idx_score(ikf, iqf, iw);
            const bool diag = (kt == nkt - 1);
            unsigned above = 0, cand = 0, zer = 0;
#pragma unroll
            for (int i = 0; i < 16; ++i) { const unsigned d0 = lin_bin(sc[i], lin_a, lin_b); const bool ok_c = !diag || (crow(i, h) <= r);
                const bool inb = ok_c && d0 == b0, isz = sc[i] == 0.0f;
                above |= (ok_c && d0 > b0) ? (1u << i) : 0u; cand |= (inb && !isz) ? (1u << i) : 0u; zer |= (inb && isz) ? (1u << i) : 0u; }
            LM[kt * 64 + C.lane] = (unsigned short)above;
            { unsigned kw = 0;
#pragma unroll
              for (int g = 0; g < 4; ++g) kw |= ((zer >> (4 * g)) & 0xfu) << (8 * g + 4 * h);
              kw |= __shfl_xor(kw, 32);
              if (h == 0) ZBM[r * 128 + kt] = kw; }
            if (__any(cand != 0u)) {
                const unsigned nc = (unsigned)__popc(cand);
                unsigned pos = nc ? __hip_atomic_fetch_add(ccnt + r, nc, __ATOMIC_RELAXED, __HIP_MEMORY_SCOPE_WORKGROUP) : 0u;
#pragma unroll
                for (int i = 0; i < 16; ++i) { const bool on = (cand >> i) & 1u;
                    if (on && pos < (unsigned)CCAP) CAND[r * CCAP + pos] = ((unsigned long long)okey_of(sc[i]) << 12) | (unsigned long long)(4095 - (k0 + crow(i, h)));
                    pos += on ? 1u : 0u; }
            }
            ikf[0] = ikn[0]; ikf[1] = ikn[1];
        }
    }
    __syncthreads();
    if (C.tid < 32 && ccnt[C.tid] > (unsigned)CCAP) ccnt[32] = 1u;
    __syncthreads();
    if (ccnt[32] == 0u || (PROBE_DUP & 16384)) {
        const unsigned long long ZK = 0x80000000ull << 12;
        for (int qq = 0; qq < 4; ++qq) {
            const int q = C.wave * 4 + qq; const unsigned n = ccnt[q]; unsigned rk = QS[q * 4 + 2];
            unsigned long long cv[6];
#pragma unroll
            for (int j = 0; j < 6; ++j) { const unsigned idx = (unsigned)C.lane + 64u * j; cv[j] = (idx < n) ? CAND[q * CCAP + idx] : 0ull; }
            unsigned z0 = (2 * C.lane < nkt) ? ZBM[q * 128 + 2 * C.lane] : 0u, z1 = (2 * C.lane + 1 < nkt) ? ZBM[q * 128 + 2 * C.lane + 1] : 0u;
            unsigned Pc = 0, Zc;
#pragma unroll
            for (int j = 0; j < 6; ++j) Pc += (unsigned)__popcll(__ballot(cv[j] >= ZK + 4096ull));
            { unsigned zc = (unsigned)(__popc(z0) + __popc(z1)); Zc = zc;
#pragma unroll
              for (int o = 32; o > 0; o >>= 1) Zc += __shfl_xor(Zc, o); }
            unsigned long long thr;
            unsigned mz = 0;
            if (rk <= Pc || rk > Pc + Zc) {
                if (rk > Pc + Zc) { mz = Zc; }
                const bool neg = rk > Pc + Zc; const unsigned rk2 = neg ? rk - Zc : rk;
                unsigned long long cur = 0ull;
                if (n <= 64u) {
                    for (int bit = 43; bit >= 0; --bit) { const unsigned long long T = cur | (1ull << bit); if ((unsigned)__popcll(__ballot(cv[0] != 0ull && cv[0] >= T)) >= rk2) cur = T; }
                } else {
                    for (int bit = 43; bit >= 0; --bit) { const unsigned long long T = cur | (1ull << bit); unsigned cnt = 0;
#pragma unroll
                        for (int j = 0; j < 6; ++j) cnt += (unsigned)__popcll(__ballot(cv[j] != 0ull && cv[j] >= T));
                        if (cnt >= rk2) cur = T; }
                }
                thr = cur;
            } else { thr = ZK + 4096ull; mz = rk - Pc; }
#pragma unroll
            for (int j = 0; j < 6; ++j) {
                if (cv[j] != 0ull && cv[j] >= thr) { const int key = 4095 - (int)(cv[j] & 4095ull), kt = key >> 5, kk = key & 31, hh = (kk >> 2) & 1, ii = (kk & 3) + 4 * (kk >> 3);
                    const int w16 = kt * 64 + q + 32 * hh;
                    __hip_atomic_fetch_or((LAS unsigned*)LM + (w16 >> 1), 1u << (16 * (w16 & 1) + ii), __ATOMIC_RELAXED, __HIP_MEMORY_SCOPE_WORKGROUP); } }
            if (mz > 0u) {
                const unsigned c0 = (unsigned)__popc(z0), c1 = (unsigned)__popc(z1); unsigned incl = c0 + c1;
#pragma unroll
                for (int o = 1; o < 64; o <<= 1) { const unsigned y = __shfl_up(incl, o); if (C.lane >= o) incl += y; }
                unsigned before = incl - (c0 + c1);
                unsigned need0 = (before >= mz) ? 0u : ((mz - before) < c0 ? (mz - before) : c0);
                while ((unsigned)__popc(z0) > need0) z0 &= ~(0x80000000u >> __clz(z0));
                before += c0;
                unsigned need1 = (before >= mz) ? 0u : ((mz - before) < c1 ? (mz - before) : c1);
                while ((unsigned)__popc(z1) > need1) z1 &= ~(0x80000000u >> __clz(z1));
#pragma unroll
                for (int tz = 0; tz < 2; ++tz) { const unsigned zw = tz ? z1 : z0; const int kt = 2 * C.lane + tz;
                    if (zw) {
#pragma unroll
                        for (int hh = 0; hh < 2; ++hh) { unsigned m16 = 0;
#pragma unroll
                            for (int g = 0; g < 4; ++g) m16 |= ((zw >> (8 * g + 4 * hh)) & 0xfu) << (4 * g);
                            const int w16 = kt * 64 + q + 32 * hh;
                            if (m16) __hip_atomic_fetch_or((LAS unsigned*)LM + (w16 >> 1), m16 << (16 * (w16 & 1)), __ATOMIC_RELAXED, __HIP_MEMORY_SCOPE_WORKGROUP); } } }
            }
        }
        __syncthreads();
        { const LAS unsigned* src = (const LAS unsigned*)LM; unsigned* dst = (unsigned*)(MASK + ((size_t)(b * 128 + qt) * 128) * 64);
          for (int i = C.tid; i < nkt * 32; i += NTHREADS) dst[i] = src[i]; }
        __syncthreads();
        return;
    }
    for (int i = C.tid; i < 32 * D1_HSTRIDE; i += NTHREADS) hist[i] = 0u;
    if (C.tid < 32) { QS[C.tid * 4 + 0] = 0u; QS[C.tid * 4 + 1] = 0u; QS[C.tid * 4 + 2] = 256u; QS[C.tid * 4 + 3] = 0u; }
    __syncthreads();
    d1_pass<0>(C, PROJ, tokb, q0, nkt, iqf, iw, hist, QS);
    for (int i = C.tid; i < 32 * D1_HSTRIDE; i += NTHREADS) hist[i] = 0u;
    __syncthreads();
    d1_pass<1>(C, PROJ, tokb, q0, nkt, iqf, iw, hist, QS);
    d1_pass<2>(C, PROJ, tokb, q0, nkt, iqf, iw, hist, QS);
    d1_pass<3>(C, PROJ, tokb, q0, nkt, iqf, iw, hist, QS);
    {
      const unsigned long long theta = ((unsigned long long)QS[r * 4 + 0] << 12) | ((unsigned long long)QS[r * 4 + 1] << 11) | QS[r * 4 + 3];
      for (int rep = 0; rep < ((PROBE_DUP & 4096) ? 2 : 1); ++rep)
      for (int kt = C.wave; kt < nkt; kt += NWAVES) {
          const int k0 = kt * 32; bf16x8 ikf[2];
          const bf16_t* kp = PROJ + (size_t)(tokb + k0 + r) * PROJ_LD + PC_DIK + 8 * h;
          ikf[0] = *(const bf16x8*)kp; ikf[1] = *(const bf16x8*)(kp + 16);
          const f32x16 sc = idx_score(ikf, iqf, iw);
          unsigned vmask = 0;
#pragma unroll
          for (int i = 0; i < 16; ++i) { const int key = k0 + crow(i, h); const unsigned long long comp = ((unsigned long long)okey_of(sc[i]) << 12) | (unsigned long long)(4095 - key);
              vmask |= (key <= q0 + r && comp >= theta) ? (1u << i) : 0u; }
          mrow[(size_t)kt * 64] = (unsigned short)vmask; } }
    __syncthreads();
}

DI void dsa_attn_wave(const Ctx& C, const Params& P) {
    const bf16_t* PROJ = (const bf16_t*)(P.ws + WS_R1 + R1_PROJ); const bf16_t* VT = (const bf16_t*)(P.ws + WS_R1 + R1_VT); bf16_t* Y = wsp<bf16_t>(P, WS_Y);
    const unsigned short* MASK = wsp<unsigned short>(P, WS_MASK);
    int bh, qs; causal_wave_unit(C.bid, C.wave, bh, qs);
    const int b = bh >> 2, hd = bh & 3, r = C.lane & 31, h = C.lane >> 5, tokb = b * SEQ, q0 = qs * 32, t = q0 + r;
    bf16x8 qf[4];
#pragma unroll
    for (int s = 0; s < 4; ++s) qf[s] = *(const bf16x8*)(PROJ + (size_t)(tokb + t) * PROJ_LD + PC_DQ + hd * 64 + 16 * s + 8 * h);
    f32x16 O[2] = {zero16(), zero16()}; float mm = -1e30f, ll = 0.f;
    const float c = 0.125f * 1.4426950408889634f;
    const int nkt = qs + 1;
    const bf16_t* kbase = PROJ + (size_t)tokb * PROJ_LD + PC_DK;
    const bf16_t* vrow0 = VT + (size_t)(256 + r) * NTOK + tokb; const bf16_t* vrow1 = vrow0 + (size_t)32 * NTOK;
    const unsigned short* mrow = MASK + ((size_t)(b * 128 + qs) * 128) * 64 + C.lane;
    KV64 ta, tb; unsigned ma, mb;
    kv64_load(ta, kbase, PROJ_LD, vrow0, vrow1, 0, r, h); ma = mrow[0];
    for (int kt = 0; kt < nkt; kt += 2) {
        if (kt + 1 < nkt) { kv64_load(tb, kbase, PROJ_LD, vrow0, vrow1, (kt + 1) * 32, r, h); mb = mrow[(size_t)(kt + 1) * 64]; }
        kv64_step(ta, qf, true, ma, c, mm, ll, O);
        if (kt + 1 < nkt) { if (kt + 2 < nkt) { kv64_load(ta, kbase, PROJ_LD, vrow0, vrow1, (kt + 2) * 32, r, h); ma = mrow[(size_t)(kt + 2) * 64]; }
            kv64_step(tb, qf, true, mb, c, mm, ll, O); }
    }
    ll += __shfl_xor(ll, 32);
    const float il = 1.0f / ll; bf16_t* yrow = Y + (size_t)(tokb + t) * DM + 768 + hd * 64;
#pragma unroll
    for (int et = 0; et < 2; ++et)
#pragma unroll
        for (int g = 0; g < 4; ++g) { u32x2 w; w.x = pk2(O[et][4 * g] * il, O[et][4 * g + 1] * il); w.y = pk2(O[et][4 * g + 2] * il, O[et][4 * g + 3] * il);
            *(u32x2*)(yrow + et * 32 + 8 * g + 4 * h) = w; }
}

constexpr int CA_KB = 64 * 144, CA_VB = 64 * 136, CA_BUF = CA_KB + CA_VB;
template <bool DIFF>
DI void causal_attn_block(const Ctx& C, const Params& P, int l) {
    const bf16_t* PROJ = (const bf16_t*)(P.ws + WS_R1 + R1_PROJ); const bf16_t* VT = (const bf16_t*)(P.ws + WS_R1 + R1_VT); bf16_t* Y = wsp<bf16_t>(P, WS_Y);
    const unsigned short* MASK = wsp<unsigned short>(P, WS_MASK);
    const int bh = (C.bid >> 4) & 15, g = C.bid & 15, j0 = 4 * g, b = bh >> 2, hd = bh & 3, tokb = b * SEQ;
#if (PROBE_DUP & 262144)
    const int qs = ((C.wave & 1) == 0) ? 127 - (j0 + (C.wave >> 1)) : j0 + (C.wave >> 1);
#else
    const int qs = (C.wave < 4) ? 127 - (j0 + C.wave) : j0 + (C.wave - 4);
#endif
    const int r = C.lane & 31, h = C.lane >> 5, q0 = qs * 32, t = q0 + r;
    const int nsub = qs + 1, NT = (128 - j0 + 1) >> 1;
    const int kcol = DIFF ? PC_AK + hd * 64 : PC_DK, vrb = DIFF ? hd * 64 : 256;
    const int srow = C.tid >> 3, sch = C.tid & 7;
    const bf16_t* kg = PROJ + (size_t)(tokb + srow) * PROJ_LD + kcol + sch * 8;
    const bf16_t* vg = VT + (size_t)(vrb + srow) * NTOK + tokb + sch * 8;
    LAS unsigned char* kdst = C.lds + srow * 144 + sch * 16; LAS unsigned char* vdst = C.lds + CA_KB + srow * 136 + sch * 16;
    bf16x8 qfd[2][2], qf4[4];
    if constexpr (DIFF) {
#pragma unroll
        for (int m = 0; m < 2; ++m)
#pragma unroll
            for (int s = 0; s < 2; ++s) qfd[m][s] = *(const bf16x8*)(PROJ + (size_t)(tokb + t) * PROJ_LD + PC_AQ + hd * 64 + m * 32 + 16 * s + 8 * h);
    } else {
#pragma unroll
        for (int s = 0; s < 4; ++s) qf4[s] = *(const bf16x8*)(PROJ + (size_t)(tokb + t) * PROJ_LD + PC_DQ + hd * 64 + 16 * s + 8 * h);
    }
    f32x16 O[2][2]; float mm[2] = {-1e30f, -1e30f}, ll[2] = {0.f, 0.f};
#pragma unroll
    for (int m = 0; m < 2; ++m) { O[m][0] = zero16(); O[m][1] = zero16(); }
    const float c = (DIFF ? 0.17677669529663687f : 0.125f) * 1.4426950408889634f;
    const unsigned dmask = causal_mask(r, h);
    const unsigned short* mrow = MASK + ((size_t)(b * 128 + qs) * 128) * 64 + C.lane;
    u32x4 kreg = *(const u32x4*)kg, vreg = *(const u32x4*)vg, kr2, vr2;
    unsigned mcur[2] = {0u, 0u}, mnxt[2] = {0u, 0u}, mn2[2] = {0u, 0u};
    if constexpr (!DIFF) { mcur[0] = mrow[0]; if (1 < nsub) mcur[1] = mrow[64]; if (2 < nsub) mnxt[0] = mrow[128]; if (3 < nsub) mnxt[1] = mrow[192]; }
    *(LAS u32x4*)kdst = kreg; *(LAS u32x2*)vdst = (u32x2){vreg.x, vreg.y}; *(LAS u32x2*)(vdst + 8) = (u32x2){vreg.z, vreg.w};
    if (1 < NT) { kreg = *(const u32x4*)(kg + (size_t)64 * PROJ_LD); vreg = *(const u32x4*)(vg + 64); }
    __syncthreads();
    for (int T = 0; T < NT; ++T) {
        const int cur = T & 1;
        if (T + 2 < NT) { kr2 = *(const u32x4*)(kg + (size_t)(T + 2) * 64 * PROJ_LD); vr2 = *(const u32x4*)(vg + (T + 2) * 64);
            if constexpr (!DIFF) { if (2 * T + 4 < nsub) mn2[0] = mrow[(size_t)(2 * T + 4) * 64]; if (2 * T + 5 < nsub) mn2[1] = mrow[(size_t)(2 * T + 5) * 64]; } }
        const LAS unsigned char* KB = C.lds + cur * CA_BUF; const LAS unsigned char* VB = KB + CA_KB;
#pragma unroll
        for (int sub = 0; sub < 2; ++sub) {
            const int st = 2 * T + sub;
            if (st < nsub) {
                const LAS unsigned char* krow = KB + (sub * 32 + r) * 144 + h * 16;
                const LAS unsigned char* v0 = VB + r * 136 + (sub * 32 + 4 * h) * 2; const LAS unsigned char* v1 = v0 + 32 * 136;
                if constexpr (DIFF) {
                    DiffKV tl;
#pragma unroll
                    for (int m = 0; m < 2; ++m)
#pragma unroll
                        for (int s = 0; s < 2; ++s) tl.kf[m][s] = *(const LAS bf16x8*)(krow + m * 64 + s * 32);
#pragma unroll
                    for (int s2 = 0; s2 < 2; ++s2) {
                        { const u32x2 lo = *(const LAS u32x2*)(v0 + s2 * 32), hi = *(const LAS u32x2*)(v0 + s2 * 32 + 16); u32x4 w; w.x = lo.x; w.y = lo.y; w.z = hi.x; w.w = hi.y; tl.vf[0][s2] = __builtin_bit_cast(bf16x8, w); }
                        { const u32x2 lo = *(const LAS u32x2*)(v1 + s2 * 32), hi = *(const LAS u32x2*)(v1 + s2 * 32 + 16); u32x4 w; w.x = lo.x; w.y = lo.y; w.z = hi.x; w.w = hi.y; tl.vf[1][s2] = __builtin_bit_cast(bf16x8, w); } }
                    diff_step(tl, qfd, st == nsub - 1, dmask, c, mm, ll, O);
                } else {
                    KV64 tl; const unsigned vm = mcur[sub];
#pragma unroll
                    for (int s = 0; s < 4; ++s) tl.kf[s] = *(const LAS bf16x8*)(krow + s * 32);
#pragma unroll
                    for (int s2 = 0; s2 < 2; ++s2) {
                        { const u32x2 lo = *(const LAS u32x2*)(v0 + s2 * 32), hi = *(const LAS u32x2*)(v0 + s2 * 32 + 16); u32x4 w; w.x = lo.x; w.y = lo.y; w.z = hi.x; w.w = hi.y; tl.vf[0][s2] = __builtin_bit_cast(bf16x8, w); }
                        { const u32x2 lo = *(const LAS u32x2*)(v1 + s2 * 32), hi = *(const LAS u32x2*)(v1 + s2 * 32 + 16); u32x4 w; w.x = lo.x; w.y = lo.y; w.z = hi.x; w.w = hi.y; tl.vf[1][s2] = __builtin_bit_cast(bf16x8, w); } }
                    kv64_step(tl, qf4, true, vm, c, mm[0], ll[0], O[0]);
                }
            }
        }
        if (T + 1 < NT) { LAS unsigned char* kd = kdst + (cur ^ 1) * CA_BUF; LAS unsigned char* vd = vdst + (cur ^ 1) * CA_BUF;
            *(LAS u32x4*)kd = kreg; *(LAS u32x2*)vd = (u32x2){vreg.x, vreg.y}; *(LAS u32x2*)(vd + 8) = (u32x2){vreg.z, vreg.w}; }
        kreg = kr2; vreg = vr2; mcur[0] = mnxt[0]; mcur[1] = mnxt[1]; mnxt[0] = mn2[0]; mnxt[1] = mn2[1];
        __syncthreads();
    }
    if constexpr (DIFF) {
        const float* lv = P.diff_lambda + l * 128;
        const float d1 = wave_sum(C.lane < 32 ? lv[C.lane] * lv[32 + C.lane] : 0.f), d2 = wave_sum(C.lane < 32 ? lv[64 + C.lane] * lv[96 + C.lane] : 0.f);
        const float lam_init = 0.8f - 0.6f * expf(-0.3f * (float)l), lam = expf(d1) - expf(d2) + lam_init;
        ll[0] += __shfl_xor(ll[0], 32); ll[1] += __shfl_xor(ll[1], 32);
        const float i0 = 1.0f / ll[0], i1 = lam / ll[1]; float ss = 0.f;
#pragma unroll
        for (int et = 0; et < 2; ++et)
#pragma unroll
            for (int i = 0; i < 16; ++i) { const float o = O[0][et][i] * i0 - O[1][et][i] * i1; O[0][et][i] = o; ss += o * o; }
        ss += __shfl_xor(ss, 32);
        const float rn = (1.0f - lam_init) / sqrtf(ss * (1.0f / 64.0f) + 1e-6f);
        bf16_t* yrow = Y + (size_t)(tokb + t) * DM + hd * 64;
#pragma unroll
        for (int et = 0; et < 2; ++et)
#pragma unroll
            for (int gq = 0; gq < 4; ++gq) { u32x2 w; w.x = pk2(O[0][et][4 * gq] * rn, O[0][et][4 * gq + 1] * rn); w.y = pk2(O[0][et][4 * gq + 2] * rn, O[0][et][4 * gq + 3] * rn);
                *(u32x2*)(yrow + et * 32 + 8 * gq + 4 * h) = w; }
    } else {
        ll[0] += __shfl_xor(ll[0], 32);
        const float il = 1.0f / ll[0]; bf16_t* yrow = Y + (size_t)(tokb + t) * DM + 768 + hd * 64;
#pragma unroll
        for (int et = 0; et < 2; ++et)
#pragma unroll
            for (int gq = 0; gq < 4; ++gq) { u32x2 w; w.x = pk2(O[0][et][4 * gq] * il, O[0][et][4 * gq + 1] * il); w.y = pk2(O[0][et][4 * gq + 2] * il, O[0][et][4 * gq + 3] * il);
                *(u32x2*)(yrow + et * 32 + 8 * gq + 4 * h) = w; }
    }
    __syncthreads();
}

constexpr int CB_KB = 128 * 144, CB_VB = 64 * 264, CB_BUF = CB_KB + CB_VB;
template <bool DIFF>
DI void causal_attn_unit2(const Ctx& C, const Params& P, int l, int bh, int G) {
    const bf16_t* PROJ = (const bf16_t*)(P.ws + WS_R1 + R1_PROJ); const bf16_t* VT = (const bf16_t*)(P.ws + WS_R1 + R1_VT); bf16_t* Y = wsp<bf16_t>(P, WS_Y);
    const unsigned short* MASK = wsp<unsigned short>(P, WS_MASK);
    const int b = bh >> 2, hd = bh & 3, tokb = b * SEQ;
    const int qs = 4 * G + (C.wave & 3), par = C.wave >> 2;
    const int r = C.lane & 31, h = C.lane >> 5, q0 = qs * 32, t = q0 + r;
    const int NT = G + 1;
    const int kcol = DIFF ? PC_AK + hd * 64 : PC_DK, vrb = DIFF ? hd * 64 : 256;
    const int srow = C.tid >> 3, sch = C.tid & 7;
    const bf16_t* kg = PROJ + (size_t)(tokb + srow) * PROJ_LD + kcol + sch * 8;
    const bf16_t* vg = VT + (size_t)(vrb + srow) * NTOK + tokb + sch * 8;
    LAS unsigned char* kdst = C.lds + srow * 144 + sch * 16; LAS unsigned char* vdst = C.lds + CB_KB + srow * 264 + sch * 16;
    bf16x8 qfd[2][2], qf4[4];
    if constexpr (DIFF) {
#pragma unroll
        for (int m = 0; m < 2; ++m)
#pragma unroll
            for (int s = 0; s < 2; ++s) qfd[m][s] = *(const bf16x8*)(PROJ + (size_t)(tokb + t) * PROJ_LD + PC_AQ + hd * 64 + m * 32 + 16 * s + 8 * h);
    } else {
#pragma unroll
        for (int s = 0; s < 4; ++s) qf4[s] = *(const bf16x8*)(PROJ + (size_t)(tokb + t) * PROJ_LD + PC_DQ + hd * 64 + 16 * s + 8 * h);
    }
    f32x16 O[2][2]; float mm[2] = {-1e30f, -1e30f}, ll[2] = {0.f, 0.f};
#pragma unroll
    for (int m = 0; m < 2; ++m) { O[m][0] = zero16(); O[m][1] = zero16(); }
    const float c = (DIFF ? 0.17677669529663687f : 0.125f) * 1.4426950408889634f;
    const unsigned dmask = causal_mask(r, h);
    const unsigned short* mrow = MASK + ((size_t)(b * 128 + qs) * 128) * 64 + C.lane;
    u32x4 kr[2], vr[2];
#define CB_GLOAD(T_) do { kr[0] = *(const u32x4*)(kg + (size_t)((T_) * 128) * PROJ_LD); kr[1] = *(const u32x4*)(kg + (size_t)((T_) * 128 + 64) * PROJ_LD); \
        vr[0] = *(const u32x4*)(vg + (T_) * 128); vr[1] = *(const u32x4*)(vg + (T_) * 128 + 64); } while (0)
#define CB_LSTORE(buf_) do { LAS unsigned char* kd_ = kdst + (buf_) * CB_BUF; LAS unsigned char* vd_ = vdst + (buf_) * CB_BUF; \
        *(LAS u32x4*)kd_ = kr[0]; *(LAS u32x4*)(kd_ + 64 * 144) = kr[1]; \
        *(LAS u32x2*)vd_ = (u32x2){vr[0].x, vr[0].y}; *(LAS u32x2*)(vd_ + 8) = (u32x2){vr[0].z, vr[0].w}; \
        *(LAS u32x2*)(vd_ + 128) = (u32x2){vr[1].x, vr[1].y}; *(LAS u32x2*)(vd_ + 136) = (u32x2){vr[1].z, vr[1].w}; } while (0)
    unsigned mcur[2] = {0u, 0u}, mnxt[2] = {0u, 0u};
    if constexpr (!DIFF) { if (par <= qs) mcur[0] = mrow[(size_t)par * 64]; if (par + 2 <= qs) mcur[1] = mrow[(size_t)(par + 2) * 64]; }
    CB_GLOAD(0); CB_LSTORE(0);
    __syncthreads();
    int cur = 0;
    for (int T = 0; T < NT; ++T) {
        const int nxb = (cur == 2) ? 0 : cur + 1;
        if (T + 1 < NT) { CB_GLOAD(T + 1);
            if constexpr (!DIFF) { const int s0 = 4 * (T + 1) + par; if (s0 <= qs) mnxt[0] = mrow[(size_t)s0 * 64]; if (s0 + 2 <= qs) mnxt[1] = mrow[(size_t)(s0 + 2) * 64]; } }
        const LAS unsigned char* KB = C.lds + cur * CB_BUF; const LAS unsigned char* VB = KB + CB_KB;
#pragma unroll
        for (int k2 = 0; k2 < 2; ++k2) {
            if (k2 == 1 && par == 1) { if (T + 1 < NT) CB_LSTORE(nxb); __syncthreads(); }
            const int sub = par + 2 * k2, st = 4 * T + sub;
            if (st <= qs) {
                const LAS unsigned char* krow = KB + (sub * 32 + r) * 144 + h * 16;
                const LAS unsigned char* v0 = VB + r * 264 + (sub * 32 + 4 * h) * 2; const LAS unsigned char* v1 = v0 + 32 * 264;
                if constexpr (DIFF) {
                    DiffKV tl;
#pragma unroll
                    for (int m = 0; m < 2; ++m)
#pragma unroll
                        for (int s = 0; s < 2; ++s) tl.kf[m][s] = *(const LAS bf16x8*)(krow + m * 64 + s * 32);
#pragma unroll
                    for (int s2 = 0; s2 < 2; ++s2) {
                        { const u32x2 lo = *(const LAS u32x2*)(v0 + s2 * 32), hi = *(const LAS u32x2*)(v0 + s2 * 32 + 16); u32x4 w; w.x = lo.x; w.y = lo.y; w.z = hi.x; w.w = hi.y; tl.vf[0][s2] = __builtin_bit_cast(bf16x8, w); }
                        { const u32x2 lo = *(const LAS u32x2*)(v1 + s2 * 32), hi = *(const LAS u32x2*)(v1 + s2 * 32 + 16); u32x4 w; w.x = lo.x; w.y = lo.y; w.z = hi.x; w.w = hi.y; tl.vf[1][s2] = __builtin_bit_cast(bf16x8, w); } }
                    diff_step(tl, qfd, st == qs, dmask, c, mm, ll, O);
                } else {
                    KV64 tl; const unsigned vm = mcur[k2];
#pragma unroll
                    for (int s = 0; s < 4; ++s) tl.kf[s] = *(const LAS bf16x8*)(krow + s * 32);
#pragma unroll
                    for (int s2 = 0; s2 < 2; ++s2) {
                        { const u32x2 lo = *(const LAS u32x2*)(v0 + s2 * 32), hi = *(const LAS u32x2*)(v0 + s2 * 32 + 16); u32x4 w; w.x = lo.x; w.y = lo.y; w.z = hi.x; w.w = hi.y; tl.vf[0][s2] = __builtin_bit_cast(bf16x8, w); }
                        { const u32x2 lo = *(const LAS u32x2*)(v1 + s2 * 32), hi = *(const LAS u32x2*)(v1 + s2 * 32 + 16); u32x4 w; w.x = lo.x; w.y = lo.y; w.z = hi.x; w.w = hi.y; tl.vf[1][s2] = __builtin_bit_cast(bf16x8, w); } }
                    kv64_step(tl, qf4, true, vm, c, mm[0], ll[0], O[0]);
                }
            }
        }
        if (par == 0) { if (T + 1 < NT) CB_LSTORE(nxb); __syncthreads(); }
        mcur[0] = mnxt[0]; mcur[1] = mnxt[1]; cur = nxb;
    }
#undef CB_GLOAD
#undef CB_LSTORE
    constexpr int NM = DIFF ? 2 : 1, NV = NM * 34;
    LAS float* MA = (LAS float*)C.lds + (size_t)(C.wave & 3) * 64 * NV + C.lane;
    __syncthreads();
    if (par == 1) {
#pragma unroll
        for (int m = 0; m < NM; ++m) { MA[(m * 34 + 0) * 64] = mm[m]; MA[(m * 34 + 1) * 64] = ll[m];
#pragma unroll
            for (int et = 0; et < 2; ++et)
#pragma unroll
                for (int i = 0; i < 16; ++i) MA[(m * 34 + 2 + et * 16 + i) * 64] = O[m][et][i]; }
    }
    __syncthreads();
    if (par == 0) {
#pragma unroll
        for (int m = 0; m < NM; ++m) { const float mB = MA[(m * 34 + 0) * 64], lB = MA[(m * 34 + 1) * 64];
            const float mn = fmaxf(mm[m], mB), aA = __builtin_amdgcn_exp2f((mm[m] - mn) * c), aB = __builtin_amdgcn_exp2f((mB - mn) * c);
            ll[m] = ll[m] * aA + lB * aB;
#pragma unroll
            for (int et = 0; et < 2; ++et)
#pragma unroll
                for (int i = 0; i < 16; ++i) O[m][et][i] = O[m][et][i] * aA + MA[(m * 34 + 2 + et * 16 + i) * 64] * aB; }
        if constexpr (DIFF) {
            const float* lv = P.diff_lambda + l * 128;
            const float d1 = wave_sum(C.lane < 32 ? lv[C.lane] * lv[32 + C.lane] : 0.f), d2 = wave_sum(C.lane < 32 ? lv[64 + C.lane] * lv[96 + C.lane] : 0.f);
            const float lam_init = 0.8f - 0.6f * expf(-0.3f * (float)l), lam = expf(d1) - expf(d2) + lam_init;
            ll[0] += __shfl_xor(ll[0], 32); ll[1] += __shfl_xor(ll[1], 32);
            const float i0 = 1.0f / ll[0], i1 = lam / ll[1]; float ss = 0.f;
#pragma unroll
            for (int et = 0; et < 2; ++et)
#pragma unroll
                for (int i = 0; i < 16; ++i) { const float o = O[0][et][i] * i0 - O[1][et][i] * i1; O[0][et][i] = o; ss += o * o; }
            ss += __shfl_xor(ss, 32);
            const float rn = (1.0f - lam_init) / sqrtf(ss * (1.0f / 64.0f) + 1e-6f);
            bf16_t* yrow = Y + (size_t)(tokb + t) * DM + hd * 64;
#pragma unroll
            for (int et = 0; et < 2; ++et)
#pragma unroll
                for (int gq = 0; gq < 4; ++gq) { u32x2 w; w.x = pk2(O[0][et][4 * gq] * rn, O[0][et][4 * gq + 1] * rn); w.y = pk2(O[0][et][4 * gq + 2] * rn, O[0][et][4 * gq + 3] * rn);
                    *(u32x2*)(yrow + et * 32 + 8 * gq + 4 * h) = w; }
        } else {
            ll[0] += __shfl_xor(ll[0], 32);
            const float il = 1.0f / ll[0]; bf16_t* yrow = Y + (size_t)(tokb + t) * DM + 768 + hd * 64;
#pragma unroll
            for (int et = 0; et < 2; ++et)
#pragma unroll
                for (int gq = 0; gq < 4; ++gq) { u32x2 w; w.x = pk2(O[0][et][4 * gq] * il, O[0][et][4 * gq + 1] * il); w.y = pk2(O[0][et][4 * gq + 2] * il, O[0][et][4 * gq + 3] * il);
                    *(u32x2*)(yrow + et * 32 + 8 * gq + 4 * h) = w; }
        }
    }
    __syncthreads();
}
template <bool DIFF>
DI void causal_attn_block2(const Ctx& C, const Params& P, int l) {
    const int bh = (C.bid >> 4) & 15, gi = C.bid & 15;
    causal_attn_unit2<DIFF>(C, P, l, bh, 31 - gi);
    causal_attn_unit2<DIFF>(C, P, l, bh, gi);
}

DI void mem_attn_block(const Ctx& C, const Params& P, int l) {
    const bf16_t* MQ = (const bf16_t*)(P.ws + WS_R1 + R1_MQ); bf16_t* MO = (bf16_t*)(P.ws + WS_R1 + R1_MO);
    const bf16_t* MK = wsp<bf16_t>(P, WS_MK) + (size_t)l * 1024 * 256; const bf16_t* MVT = wsp<bf16_t>(P, WS_MVT) + (size_t)l * 256 * 1024;
    const int bh = (C.bid >> 4) & 15, grp = C.bid & 15, b = bh >> 2, hd = bh & 3, r = C.lane & 31, h = C.lane >> 5;
    const int t = b * SEQ + (grp * 8 + C.wave) * 32 + r;
    bf16x8 qf[4];
#pragma unroll
    for (int s = 0; s < 4; ++s) qf[s] = *(const bf16x8*)(MQ + (size_t)t * 256 + hd * 64 + 16 * s + 8 * h);
    { u32x4 kr[4], vr[4];
#pragma unroll
      for (int j = 0; j < 4; ++j) { const int ci = C.tid + 512 * j;
          kr[j] = *(const u32x4*)(MK + (size_t)(b * 256 + (ci >> 3)) * 256 + hd * 64 + (ci & 7) * 8);
          vr[j] = *(const u32x4*)(MVT + (size_t)(hd * 64 + (ci >> 5)) * 1024 + b * 256 + (ci & 31) * 8); }
#pragma unroll
      for (int j = 0; j < 4; ++j) { const int ci = C.tid + 512 * j;
          *(LAS u32x4*)(C.lds + (ci >> 3) * 144 + (ci & 7) * 16) = kr[j];
          LAS unsigned char* vd = C.lds + 36864 + (ci >> 5) * 520 + (ci & 31) * 16;
          *(LAS u32x2*)vd = (u32x2){vr[j].x, vr[j].y}; *(LAS u32x2*)(vd + 8) = (u32x2){vr[j].z, vr[j].w}; } }
    __syncthreads();
    f32x16 O[2] = {zero16(), zero16()}; float mm = -1e30f, ll = 0.f;
    const float c = 0.125f * 1.4426950408889634f;
#pragma unroll 2
    for (int kt = 0; kt < 8; ++kt) {
        KV64 tl; const LAS unsigned char* krow = C.lds + (kt * 32 + r) * 144 + h * 16;
        const LAS unsigned char* v0 = C.lds + 36864 + r * 520 + (kt * 32 + 4 * h) * 2; const LAS unsigned char* v1 = v0 + 32 * 520;
#pragma unroll
        for (int s = 0; s < 4; ++s) tl.kf[s] = *(const LAS bf16x8*)(krow + s * 32);
#pragma unroll
        for (int s2 = 0; s2 < 2; ++s2) {
            { const u32x2 lo = *(const LAS u32x2*)(v0 + s2 * 32), hi = *(const LAS u32x2*)(v0 + s2 * 32 + 16); u32x4 w; w.x = lo.x; w.y = lo.y; w.z = hi.x; w.w = hi.y; tl.vf[0][s2] = __builtin_bit_cast(bf16x8, w); }
            { const u32x2 lo = *(const LAS u32x2*)(v1 + s2 * 32), hi = *(const LAS u32x2*)(v1 + s2 * 32 + 16); u32x4 w; w.x = lo.x; w.y = lo.y; w.z = hi.x; w.w = hi.y; tl.vf[1][s2] = __builtin_bit_cast(bf16x8, w); } }
        kv64_step(tl, qf, false, 0u, c, mm, ll, O);
    }
    ll += __shfl_xor(ll, 32);
    const float il = 1.0f / ll; bf16_t* orow = MO + (size_t)t * 256 + hd * 64;
#pragma unroll
    for (int et = 0; et < 2; ++et)
#pragma unroll
        for (int g = 0; g < 4; ++g) { u32x2 w; w.x = pk2(O[et][4 * g] * il, O[et][4 * g + 1] * il); w.y = pk2(O[et][4 * g + 2] * il, O[et][4 * g + 3] * il);
            *(u32x2*)(orow + et * 32 + 8 * g + 4 * h) = w; }
    __syncthreads();
}
DI void mma_lds(f32x16& acc, const LAS bf16_t* A, int lda, const LAS bf16_t* Bt, int ldb, int K, int lane) {
    const int r = lane & 31, h = lane >> 5;
    for (int k0 = 0; k0 < K; k0 += 16) {
        const bf16x8 a = *(const LAS bf16x8*)(A + r * lda + k0 + 8 * h);
        const bf16x8 b = *(const LAS bf16x8*)(Bt + r * ldb + k0 + 8 * h);
        acc = mfma32(a, b, acc);
    }
}

constexpr int HG_BC = 0, HG_QT = 32768, HG_KT = 50176, HG_VT = 67584, HG_ST = 86016, HG_AT = 104448;
DI float hgrn_lb(const Params& P, int l, int ch) { if (l == 0) return 0.f; const float z0 = P.hgrn_lb[ch], z1 = P.hgrn_lb[256 + ch]; return 1.0f / (1.0f + expf(z0 - z1)); }
DI void hgrn_cumsum(const Ctx& C, const Params& P, int l, const float (&fpv)[16], int ch0) {
    LAS float* BC = (LAS float*)(C.lds + HG_BC);
    const float lb = hgrn_lb(P, l, ch0 + (C.tid & 127));
#pragma unroll
    for (int j = 0; j < 16; ++j) { const float f = lb + (1.0f - lb) * frcp(1.0f + fexp(fminf(-fpv[j], 80.f))); BC[C.tid + 512 * j] = flog(fmaxf(f, 1e-30f)); }
    __syncthreads();
    if (C.tid < 128) { float cum = 0.f;
#pragma unroll 8
        for (int s = 0; s < 64; ++s) { cum += BC[s * 128 + C.tid]; BC[s * 128 + C.tid] = cum; } }
    __syncthreads();
}
DI void hgrn_local_unit(const Ctx& C, const Params& P, int l, int u) {
    const bf16_t* PROJ = (const bf16_t*)(P.ws + WS_R1 + R1_PROJ); float* HS = wsp<float>(P, WS_HS); float* HD = wsp<float>(P, WS_HD);
    const int hp = u & 1, bc = u >> 1, b = bc >> 6, c = bc & 63, tok0 = b * SEQ + c * 64, ch0 = hp * 128;
    LAS float* BC = (LAS float*)(C.lds + HG_BC); LAS bf16_t* KT = (LAS bf16_t*)(C.lds + HG_QT);   LAS bf16_t* VT = (LAS bf16_t*)(C.lds + HG_VT);
    const int cl = C.tid & 127, ch = ch0 + cl; const float lb = hgrn_lb(P, l, ch);
    float fpv[16]; bf16_t vv[16];
#pragma unroll
    for (int j = 0; j < 16; ++j) { const bf16_t* row = PROJ + (size_t)(tok0 + (C.tid >> 7) + 4 * j) * PROJ_LD; fpv[j] = bf2f(row[PC_BF + ch]); vv[j] = row[PC_BI + ch]; }
    hgrn_cumsum(C, P, l, fpv, ch0);
#pragma unroll
    for (int j = 0; j < 16; ++j) { const int s = (C.tid >> 7) + 4 * j; const float kk = (1.0f - lb) * frcp(1.0f + fexp(fminf(fpv[j], 80.f)));
        KT[cl * 72 + s] = f2bf(kk * fexp(BC[63 * 128 + cl] - BC[s * 128 + cl])); VT[cl * 72 + s] = vv[j]; }
    if (C.tid < 128) HD[(size_t)bc * 256 + ch0 + C.tid] = fexp(BC[63 * 128 + C.tid]);
    __syncthreads();
    { const int h2 = C.wave >> 2, dkt = (C.wave >> 1) & 1, dvt = C.wave & 1, r = C.lane & 31, h = C.lane >> 5;
      f32x16 acc = zero16();
      mma_lds(acc, KT + (h2 * 64 + dkt * 32) * 72, 72, VT + (h2 * 64 + dvt * 32) * 72, 72, 64, C.lane);
      float* dst = HS + ((size_t)(bc * 4 + hp * 2 + h2) * 64) * 64;
#pragma unroll
      for (int i = 0; i < 16; ++i) dst[(dkt * 32 + crow(i, h)) * 64 + dvt * 32 + r] = acc[i]; }
    __syncthreads();
}
DI void hgrn_scan_unit(const Ctx& C, const Params& P, int u) {
    float* HS = wsp<float>(P, WS_HS); const float* HD = wsp<float>(P, WS_HD);
    const int id = u * NTHREADS + C.tid;
    const int bh = id >> 12, e = id & 4095, b = bh >> 2, hh = bh & 3, dk = e >> 6;
    float Lv[64], Dv[64];
#pragma unroll
    for (int c = 0; c < 64; ++c) { const size_t bc = (size_t)b * 64 + c; Lv[c] = HS[((bc * 4 + hh) << 12) + e]; Dv[c] = HD[bc * 256 + hh * 64 + dk]; }
    float S = 0.f;
#pragma unroll
    for (int c = 0; c < 64; ++c) { const size_t bc = (size_t)b * 64 + c; HS[((bc * 4 + hh) << 12) + e] = S; S = Dv[c] * S + Lv[c]; }
}
DI void hgrn_out_unit(const Ctx& C, const Params& P, int l, int u) {
    const bf16_t* PROJ = (const bf16_t*)(P.ws + WS_R1 + R1_PROJ); const float* HS = wsp<float>(P, WS_HS); bf16_t* Y = wsp<bf16_t>(P, WS_Y);
    const int hp = u & 1, bc = u >> 1, b = bc >> 6, c = bc & 63, tok0 = b * SEQ + c * 64, ch0 = hp * 128;
    LAS float* BC = (LAS float*)(C.lds + HG_BC); LAS bf16_t* QT = (LAS bf16_t*)(C.lds + HG_QT); LAS bf16_t* KT = (LAS bf16_t*)(C.lds + HG_KT);
    LAS bf16_t* VT = (LAS bf16_t*)(C.lds + HG_VT); LAS bf16_t* ST = (LAS bf16_t*)(C.lds + HG_ST); LAS bf16_t* AT = (LAS bf16_t*)(C.lds + HG_AT);
    const int cl = C.tid & 127, ch = ch0 + cl; const float lb = hgrn_lb(P, l, ch);
    float fpv[16], qv16[16], sp16[16]; bf16_t vv[16];
#pragma unroll
    for (int j = 0; j < 16; ++j) { const bf16_t* row = PROJ + (size_t)(tok0 + (C.tid >> 7) + 4 * j) * PROJ_LD; fpv[j] = bf2f(row[PC_BF + ch]); qv16[j] = bf2f(row[PC_BQ + ch]); vv[j] = row[PC_BI + ch];
        sp16[j] = HS[(((size_t)bc * 4 + hp * 2) << 12) + C.tid + 512 * j]; }
    hgrn_cumsum(C, P, l, fpv, ch0);
#pragma unroll
    for (int j = 0; j < 16; ++j) { const int s = (C.tid >> 7) + 4 * j; const float kk = (1.0f - lb) * frcp(1.0f + fexp(fminf(fpv[j], 80.f)));
        const float q = qv16[j] * frcp(1.0f + fexp(fminf(-qv16[j], 80.f)));
        const float bs = BC[s * 128 + cl], br = BC[31 * 128 + cl];
        QT[s * 136 + cl] = f2bf(q * fexp(fminf(bs - br, 80.f)));
        KT[s * 136 + cl] = f2bf(kk * fexp(fminf(br - bs, 80.f)));
        VT[cl * 72 + s] = vv[j]; }
#pragma unroll
    for (int j = 0; j < 16; ++j) { const int i = C.tid + 512 * j, h2 = i >> 12, e = i & 4095, dk = e >> 6, dv = e & 63;
        ST[(h2 * 64 + dv) * 72 + dk] = f2bf(sp16[j] * fexp(BC[31 * 128 + h2 * 64 + dk])); }
    __syncthreads();
    {
      const int h2 = C.wave >> 2, tt = (C.wave >> 1) & 1, st = C.wave & 1, r = C.lane & 31, h = C.lane >> 5;
      if (st <= tt) { f32x16 acc = zero16();
          mma_lds(acc, QT + (tt * 32) * 136 + h2 * 64, 136, KT + (st * 32) * 136 + h2 * 64, 136, 64, C.lane);
#pragma unroll
          for (int i = 0; i < 16; ++i) { const int t = tt * 32 + crow(i, h), s = st * 32 + r; AT[(h2 * 64 + t) * 72 + s] = (s <= t) ? f2bf(acc[i]) : (bf16_t)0; } } }
    __syncthreads();
    if (C.wave < 4) {
      const int h2 = C.wave >> 1, tt = C.wave & 1, r = C.lane & 31, h = C.lane >> 5;
      f32x16 o[2] = {zero16(), zero16()};
#pragma unroll
      for (int dvt = 0; dvt < 2; ++dvt) {
          mma_lds(o[dvt], VT + (h2 * 64 + dvt * 32) * 72, 72, AT + (h2 * 64 + tt * 32) * 72, 72, (tt + 1) * 32, C.lane);
          mma_lds(o[dvt], ST + (h2 * 64 + dvt * 32) * 72, 72, QT + (tt * 32) * 136 + h2 * 64, 136, 64, C.lane); }
      float ss = 0.f;
#pragma unroll
      for (int dvt = 0; dvt < 2; ++dvt)
#pragma unroll
          for (int i = 0; i < 16; ++i) ss += o[dvt][i] * o[dvt][i];
      ss += __shfl_xor(ss, 32);
      const float rn = 1.0f / sqrtf(ss * (1.0f / 64.0f) + 1e-6f);
      const int t = tok0 + tt * 32 + r, chb = ch0 + h2 * 64;
      const bf16_t* grow = PROJ + (size_t)t * PROJ_LD + PC_BG + chb; bf16_t* yrow = Y + (size_t)t * DM + 256 + chb;
#pragma unroll
      for (int dvt = 0; dvt < 2; ++dvt)
#pragma unroll
          for (int g = 0; g < 4; ++g) { const int dv = dvt * 32 + 8 * g + 4 * h; const u32x2 gw = *(const u32x2*)(grow + dv);
              const float g0 = siluf_(bflo(gw.x)), g1 = siluf_(bfhi(gw.x)), g2 = siluf_(bflo(gw.y)), g3 = siluf_(bfhi(gw.y));
              u32x2 w; w.x = pk2(o[dvt][4 * g] * rn * g0, o[dvt][4 * g + 1] * rn * g1); w.y = pk2(o[dvt][4 * g + 2] * rn * g2, o[dvt][4 * g + 3] * rn * g3);
              *(u32x2*)(yrow + dv) = w; } }
    __syncthreads();
}

DI void sgu_unit(const Ctx& C, const Params& P, int l, int u) {
    const bf16_t* PROJ = (const bf16_t*)(P.ws + WS_R1 + R1_PROJ); bf16_t* Y = wsp<bf16_t>(P, WS_Y); const bf16_t* SW = wsp<bf16_t>(P, W_SGU);
    const float* sb = P.spatial_b + l * 512;
    LAS bf16_t* VT = (LAS bf16_t*)C.lds; const int tok0 = (u >> 1) * 128, half = u & 1;
    u32x2 wv[16];
#pragma unroll
    for (int j = 0; j < 16; ++j) wv[j] = *(const u32x2*)(PROJ + (size_t)(tok0 + C.wave + NWAVES * j) * PROJ_LD + PC_CV + C.lane * 4);
#pragma unroll
    for (int j = 0; j < 16; ++j) {
        const int s = C.wave + NWAVES * j; const u32x2 w = wv[j];
        float v[4] = {gelu_tanh(bflo(w.x)), gelu_tanh(bfhi(w.x)), gelu_tanh(bflo(w.y)), gelu_tanh(bfhi(w.y))};
        const float mu = wave_sum(v[0] + v[1] + v[2] + v[3]) * (1.0f / 256.0f);
        float q = 0.f;
#pragma unroll
        for (int jj = 0; jj < 4; ++jj) { v[jj] -= mu; q += v[jj] * v[jj]; }
        const float rs = 1.0f / sqrtf(wave_sum(q) * (1.0f / 256.0f) + 1e-6f);
#pragma unroll
        for (int jj = 0; jj < 4; ++jj) VT[(C.lane * 4 + jj) * 136 + s] = f2bf(v[jj] * rs);
    }
    __syncthreads();
    { const int g = C.wave >> 1, dt = C.wave & 1, r = C.lane & 31, h = C.lane >> 5;
      for (int ti = 0; ti < 2; ++ti) { const int tt = half ? (1 + ti) : (ti * 3);
          f32x16 acc = zero16();
          const bf16_t* wrow = SW + ((size_t)g * 128 + tt * 32 + r) * 128 + 8 * h;
          const LAS bf16_t* vrow = VT + (g * 64 + dt * 32 + r) * 136 + 8 * h;
          bf16x8 af[8];
#pragma unroll
          for (int kk = 0; kk < 8; ++kk) af[kk] = *(const bf16x8*)(wrow + (kk < 2 * (tt + 1) ? kk * 16 : 0));
#pragma unroll
          for (int kk = 0; kk < 8; ++kk) if (kk < 2 * (tt + 1)) { const bf16x8 bb = *(const LAS bf16x8*)(vrow + kk * 16); acc = mfma32(af[kk], bb, acc); }
          const int ch = g * 64 + dt * 32 + r;
#pragma unroll
          for (int i = 0; i < 16; ++i) { const int t = tt * 32 + crow(i, h); const size_t tok = (size_t)(tok0 + t);
              const float uu = gelu_tanh(bf2f(PROJ[tok * PROJ_LD + PC_CU + ch]));
              Y[tok * DM + 512 + ch] = f2bf(uu * (acc[i] + sb[g * 128 + t])); } } }
    __syncthreads();
}

DI void phase_router(const Ctx& C, const Params& P, int l, const bool dry = false) {
    float* XR = P.out; bf16_t* H = wsp<bf16_t>(P, WS_H);
    int* TOKE = wsp<int>(P, WS_TOKE); float* TOKW = wsp<float>(P, WS_TOKW); int* RANK = wsp<int>(P, WS_RANK); int* ROWTOK = dry ? wsp<int>(P, WS_DUMMY) : wsp<int>(P, WS_ROWTOK);
    unsigned* CNT = wsp<unsigned>(P, WS_CTL) + CW_CNT + 64 * l + (dry ? 256 : 0);
    const float* gain = P.norm_ffn + l * DM;
    const float* brg = P.b_rg + l * 4; const float* bre = P.b_re + l * 32;
    LAS bf16_t* XHL = (LAS bf16_t*)C.lds; LAS float* PART = (LAS float*)C.lds; LAS float* LOG = (LAS float*)(C.lds + 32768);
    LAS unsigned* lcnt = (LAS unsigned*)(C.lds + LDS_MISC + 1024); LAS unsigned* lbase = lcnt + 32;
    if (C.tid < 32) lcnt[C.tid] = 0u;
    __syncthreads();
    const int per = NTOK / C.G;
    const int r = C.lane & 31, h = C.lane >> 5;
    for (int it = 0; it < per; it += 32) {
        const int tok0 = C.bid * per + it;
        { f32x4 v[4][4];
#pragma unroll
          for (int j = 0; j < 4; ++j) { const float* xr = XR + (size_t)(tok0 + C.wave * 4 + j) * DM;
#pragma unroll
              for (int q = 0; q < 4; ++q) v[j][q] = *(const f32x4*)(xr + q * 256 + C.lane * 4); }
#pragma unroll
          for (int j = 0; j < 4; ++j) { const int tl = C.wave * 4 + j, t = tok0 + tl; float ss = 0.f;
#pragma unroll
              for (int q = 0; q < 4; ++q) ss += v[j][q][0] * v[j][q][0] + v[j][q][1] * v[j][q][1] + v[j][q][2] * v[j][q][2] + v[j][q][3] * v[j][q][3];
              ss = wave_sum(ss); const float rs = 1.0f / sqrtf(ss * (1.0f / DM) + 1e-6f);
#pragma unroll
              for (int q = 0; q < 4; ++q) { const int c = q * 256 + C.lane * 4; const f32x4 g = *(const f32x4*)(gain + c);
                  const f32x4 o = (f32x4){v[j][q][0] * rs * g[0], v[j][q][1] * rs * g[1], v[j][q][2] * rs * g[2], v[j][q][3] * rs * g[3]};
                  u32x2 w; w.x = pk2(o[0], o[1]); w.y = pk2(o[2], o[3]); *(u32x2*)(H + (size_t)t * DM + c) = w;
                  { u32x2 wl; wl.x = pk2(o[0] - bflo(w.x), o[1] - bfhi(w.x)); wl.y = pk2(o[2] - bflo(w.y), o[3] - bfhi(w.y));
                    *(LAS u32x2*)(XHL + tl * 1032 + c) = w; *(LAS u32x2*)(XHL + 33024 + tl * 1032 + c) = wl; } } } }
        __syncthreads();
        f32x16 acc = zero16();
        { const int ct = C.wave & 1, kq = C.wave >> 1;
          const LAS bf16_t* ah = XHL + r * 1032 + kq * 256 + 8 * h; const LAS bf16_t* al = ah + 33024;
          const bf16_t* bh_ = wsp<bf16_t>(P, W_RH) + (size_t)(ct * 32 + r) * 1024 + kq * 256 + 8 * h; const bf16_t* bl_ = bh_ + (size_t)64 * 1024;
#pragma unroll 4
          for (int k0 = 0; k0 < 256; k0 += 16) { const bf16x8 xh = *(const LAS bf16x8*)(ah + k0), xl = *(const LAS bf16x8*)(al + k0);
              const bf16x8 wh = *(const bf16x8*)(bh_ + k0), wl = *(const bf16x8*)(bl_ + k0);
              acc = mfma32(xh, wh, acc); acc = mfma32(xh, wl, acc); acc = mfma32(xl, wh, acc); } }
        __syncthreads();
#pragma unroll
        for (int i = 0; i < 16; ++i) PART[(C.wave * 16 + i) * 64 + C.lane] = acc[i];
        __syncthreads();
        for (int idx = C.tid; idx < 32 * 36; idx += NTHREADS) { const int tok = idx / 36, col = idx % 36, ct = col < 32 ? 0 : 1, cc = col < 32 ? col : col - 32;
            const int hh = (tok >> 2) & 1, reg = (tok & 3) + 4 * (tok >> 3); float s = 0.f;
#pragma unroll
            for (int kq = 0; kq < 4; ++kq) s += PART[((kq * 2 + ct) * 16 + reg) * 64 + cc + 32 * hh];
            LOG[tok * 36 + col] = s; }
        __syncthreads();
        if (C.tid < 32) { const int t = tok0 + C.tid; const LAS float* lg = LOG + C.tid * 36;
            float gl[4]; int gsel = 0;
#pragma unroll
            for (int k = 0; k < 4; ++k) gl[k] = lg[32 + k] + brg[k];
            float gmax = gl[0];
#pragma unroll
            for (int k = 1; k < 4; ++k) if (gl[k] > gmax) { gmax = gl[k]; gsel = k; }
            float gsum = 0.f;
#pragma unroll
            for (int k = 0; k < 4; ++k) gsum += expf(gl[k] - gmax);
            const float pg = 1.0f / gsum;
            float pe[8]; float emax = -1e30f;
#pragma unroll
            for (int k = 0; k < 8; ++k) { pe[k] = lg[gsel * 8 + k] + bre[gsel * 8 + k]; emax = fmaxf(emax, pe[k]); }
#pragma unroll
            for (int k = 0; k < 8; ++k) pe[k] = expf(pe[k] - emax);
            int i1 = 0; float p1 = pe[0];
#pragma unroll
            for (int k = 1; k < 8; ++k) if (pe[k] > p1) { p1 = pe[k]; i1 = k; }
            int i2 = (i1 == 0) ? 1 : 0; float p2 = pe[i2];
#pragma unroll
            for (int k = 0; k < 8; ++k) if (k != i1 && pe[k] > p2) { p2 = pe[k]; i2 = k; }
            const float inv = pg / (p1 + p2);
            const int e1 = gsel * 8 + i1, e2 = gsel * 8 + i2;
            TOKE[t * 2] = e1; TOKE[t * 2 + 1] = e2; TOKW[t * 2] = p1 * inv; TOKW[t * 2 + 1] = p2 * inv;
            RANK[t * 2] = (int)__hip_atomic_fetch_add(lcnt + e1, 1u, __ATOMIC_RELAXED, __HIP_MEMORY_SCOPE_WORKGROUP);
            RANK[t * 2 + 1] = (int)__hip_atomic_fetch_add(lcnt + e2, 1u, __ATOMIC_RELAXED, __HIP_MEMORY_SCOPE_WORKGROUP); }
        __syncthreads();
    }
    if (C.tid < 32) { const unsigned n = lcnt[C.tid]; lbase[C.tid] = n ? __hip_atomic_fetch_add(CNT + C.tid, n, __ATOMIC_RELAXED, __HIP_MEMORY_SCOPE_AGENT) : 0u; }
    __syncthreads();
    asm volatile("s_waitcnt vmcnt(0)" ::: "memory");
    for (int a = C.tid; a < per * 2; a += NTHREADS) { const int ga = C.bid * per * 2 + a; const int e = TOKE[ga]; const unsigned rk = lbase[e] + (unsigned)RANK[ga];
        ROWTOK[(size_t)e * MOE_CAP + rk] = ga; }
    __syncthreads();
}
typedef f32x4 AccT[2][2][4][2];
DI u32x4 pack8(const f32x4& a, const f32x4& b) { u32x4 w; w.x = pk2(a[0], a[1]); w.y = pk2(a[2], a[3]); w.z = pk2(b[0], b[1]); w.w = pk2(b[2], b[3]); return w; }
template <int ACT> struct EpiStore {
    bf16_t* O; int ldc;
    DI void operator()(const AccT& acc, const pg8::Unit& u, int wr, int wc, int fr, int fq) const {
#pragma unroll
        for (int ai = 0; ai < 2; ++ai)
#pragma unroll
            for (int m = 0; m < 4; ++m) { const size_t row = (size_t)(u.pm * 256 + ai * 128 + wr * 64 + m * 16 + fr);
#pragma unroll
                for (int bj = 0; bj < 2; ++bj) { const int col = u.pn * 256 + bj * 128 + wc * 32 + 8 * fq; f32x4 a = acc[ai][bj][m][0], b = acc[ai][bj][m][1];
                    if (ACT == 1) {
#pragma unroll
                        for (int j = 0; j < 4; ++j) { a[j] = sigmoidf_(a[j]); b[j] = sigmoidf_(b[j]); } }
                    *(u32x4*)(O + row * ldc + col) = pack8(a, b); } }
    }
};
struct EpiMerge {
    const bf16_t* GATE; bf16_t* MG;
    DI void operator()(const AccT& acc, const pg8::Unit& u, int wr, int wc, int fr, int fq) const {
#pragma unroll
        for (int ai = 0; ai < 2; ++ai)
#pragma unroll
            for (int m = 0; m < 4; ++m) { const size_t row = (size_t)(u.pm * 256 + ai * 128 + wr * 64 + m * 16 + fr);
#pragma unroll
                for (int bj = 0; bj < 2; ++bj) { const int col = u.pn * 256 + bj * 128 + wc * 32 + 8 * fq;
                    const u32x4 g = *(const u32x4*)(GATE + row * 4096 + u.x * 1024 + col);
                    f32x4 a = acc[ai][bj][m][0], b = acc[ai][bj][m][1];
                    a[0] *= bflo(g.x); a[1] *= bfhi(g.x); a[2] *= bflo(g.y); a[3] *= bfhi(g.y); b[0] *= bflo(g.z); b[1] *= bfhi(g.z); b[2] *= bflo(g.w); b[3] *= bfhi(g.w);
                    bf16_t* dst = MG + row * 1024 + col;
                    if (u.x > 0) { const u32x4 p = *(const u32x4*)dst;
                        a[0] += bflo(p.x); a[1] += bfhi(p.x); a[2] += bflo(p.y); a[3] += bfhi(p.y); b[0] += bflo(p.z); b[1] += bfhi(p.z); b[2] += bflo(p.w); b[3] += bfhi(p.w); }
                    *(u32x4*)dst = pack8(a, b); }
                asm volatile("" ::: "memory"); }
    }
};
struct EpiResid {
    float* XR;
    DI void operator()(const AccT& acc, const pg8::Unit& u, int wr, int wc, int fr, int fq) const {
#pragma unroll
        for (int ai = 0; ai < 2; ++ai)
#pragma unroll
            for (int m = 0; m < 4; ++m) { const size_t row = (size_t)(u.pm * 256 + ai * 128 + wr * 64 + m * 16 + fr);
#pragma unroll
                for (int bj = 0; bj < 2; ++bj) { float* p = XR + row * 1024 + u.pn * 256 + bj * 128 + wc * 32 + 8 * fq;
                    const f32x4 x0 = *(const f32x4*)p, x1 = *(const f32x4*)(p + 4);
                    *(f32x4*)p = x0 + acc[ai][bj][m][0]; *(f32x4*)(p + 4) = x1 + acc[ai][bj][m][1]; }
                if (m == 3) asm volatile("" ::: "memory"); }
    }
};
struct EpiResidNorm {
    float* XR; bf16_t* XB; float* RSS;
    DI void operator()(const AccT& acc, const pg8::Unit& u, int wr, int wc, int fr, int fq) const {
#pragma unroll
        for (int ai = 0; ai < 2; ++ai)
#pragma unroll
            for (int m = 0; m < 4; ++m) { const size_t row = (size_t)(u.pm * 256 + ai * 128 + wr * 64 + m * 16 + fr); float ss = 0.f;
#pragma unroll
                for (int bj = 0; bj < 2; ++bj) { const size_t off = row * 1024 + u.pn * 256 + bj * 128 + wc * 32 + 8 * fq; float* p = XR + off;
                    const f32x4 x0 = *(const f32x4*)p + acc[ai][bj][m][0], x1 = *(const f32x4*)(p + 4) + acc[ai][bj][m][1];
                    *(f32x4*)p = x0; *(f32x4*)(p + 4) = x1; *(u32x4*)(XB + off) = pack8(x0, x1);
                    ss += (x0[0] * x0[0] + x0[1] * x0[1]) + (x0[2] * x0[2] + x0[3] * x0[3]) + (x1[0] * x1[0] + x1[1] * x1[1]) + (x1[2] * x1[2] + x1[3] * x1[3]); }
                ss += __shfl_xor(ss, 16); ss += __shfl_xor(ss, 32);
                if (fq == 0) RSS[row * 16 + u.pn * 4 + wc] = ss;
                if (m == 3) asm volatile("" ::: "memory"); }
    }
};
struct EpiStoreRstd {
    bf16_t* O; int ldc; const float* RSS;
    DI void operator()(const AccT& acc, const pg8::Unit& u, int wr, int wc, int fr, int fq) const {
#pragma unroll
        for (int ai = 0; ai < 2; ++ai)
#pragma unroll
            for (int m = 0; m < 4; ++m) { const size_t row = (size_t)(u.pm * 256 + ai * 128 + wr * 64 + m * 16 + fr);
                const f32x4* rp = (const f32x4*)(RSS + row * 16); const f32x4 r0 = rp[0], r1 = rp[1], r2 = rp[2], r3 = rp[3];
                const float rsum = ((r0[0] + r0[1]) + (r0[2] + r0[3])) + ((r1[0] + r1[1]) + (r1[2] + r1[3])) + ((r2[0] + r2[1]) + (r2[2] + r2[3])) + ((r3[0] + r3[1]) + (r3[2] + r3[3]));
                const float rs = 1.0f / sqrtf(rsum * (1.0f / 1024.0f) + 1e-6f);
#pragma unroll
                for (int bj = 0; bj < 2; ++bj) { const int col = u.pn * 256 + bj * 128 + wc * 32 + 8 * fq;
                    *(u32x4*)(O + row * ldc + col) = pack8(acc[ai][bj][m][0] * rs, acc[ai][bj][m][1] * rs); } }
    }
};
struct EpiGU {
    bf16_t* HID;
    DI void operator()(const AccT& acc, const pg8::Unit& u, int wr, int wc, int fr, int fq) const {
#pragma unroll
        for (int ai = 0; ai < 2; ++ai)
#pragma unroll
            for (int m = 0; m < 4; ++m) { const size_t row = (size_t)(u.pm * 256 + ai * 128 + wr * 64 + m * 16 + fr);
                f32x4 a, b;
#pragma unroll
                for (int j = 0; j < 4; ++j) { a[j] = siluf_(acc[ai][0][m][0][j]) * acc[ai][1][m][0][j]; b[j] = siluf_(acc[ai][0][m][1][j]) * acc[ai][1][m][1][j]; }
                *(u32x4*)(HID + row * 256 + u.pn * 128 + wc * 32 + 8 * fq) = pack8(a, b); }
    }
};
struct EpiDown {
    bf16_t* YB; const int* ROWTOK; const float* TOKW; const LAS int* cnt;
    DI void operator()(const AccT& acc, const pg8::Unit& u, int wr, int wc, int fr, int fq) const {
        const int ce = cnt[u.x];
#pragma unroll
        for (int ai = 0; ai < 2; ++ai)
#pragma unroll
            for (int m = 0; m < 4; ++m) { const int idx = u.y * 256 + ai * 128 + wr * 64 + m * 16 + fr;
                if (idx < ce) { const int a = ROWTOK[(size_t)u.x * MOE_CAP + idx]; const float w = TOKW[a];
#pragma unroll
                    for (int bj = 0; bj < 2; ++bj) { const int col = u.pn * 256 + bj * 128 + wc * 32 + 8 * fq;
                        *(u32x4*)(YB + (size_t)a * 1024 + col) = pack8(acc[ai][bj][m][0] * w, acc[ai][bj][m][1] * w); } } }
    }
};

struct FusedMergeOrder {
    const char* Hb; const char* Yb; const char* Wg; const char* Wb; int G, c;
    DI bool next(int i, pg8::Unit& u) const {
        const int ti = i >> 3, x = i & 7, n = x >> 1; const long L = (long)ti * G + c; if (L >= 256) return false;
        pg8::tile_map((int)L, 64, 4, u.pm, u.pn); u.x = x; u.y = 0;
        if (x & 1) { u.a = Yb + (size_t)u.pm * 256 * 1024 * 2 + (size_t)n * 256 * 2; u.b = Wb + (size_t)u.pn * 256 * 1024 * 2 + (size_t)n * 256 * 2; u.nt = 4; }
        else { u.a = Hb + (size_t)u.pm * 256 * 1024 * 2; u.b = Wg + ((size_t)n * 1024 + (size_t)u.pn * 256) * 1024 * 2; u.nt = 16; }
        return true; }
    DI unsigned row_off(const pg8::Unit&, int) const { return 0u; }
};
struct EpiFusedMerge {
    bf16_t* GS; bf16_t* MG; int tid;
    DI void operator()(const AccT& acc, const pg8::Unit& u, int wr, int wc, int fr, int fq) const {
        u32x4* gs = (u32x4*)GS + tid;
        if ((u.x & 1) == 0) {
#pragma unroll
            for (int ai = 0; ai < 2; ++ai)
#pragma unroll
                for (int m = 0; m < 4; ++m)
#pragma unroll
                    for (int bj = 0; bj < 2; ++bj) { f32x4 a = acc[ai][bj][m][0], b = acc[ai][bj][m][1];
#pragma unroll
                        for (int j = 0; j < 4; ++j) { a[j] = sigmoidf_(a[j]); b[j] = sigmoidf_(b[j]); }
                        gs[((ai * 4 + m) * 2 + bj) * 512] = pack8(a, b); }
        } else {
#pragma unroll
            for (int ai = 0; ai < 2; ++ai)
#pragma unroll
                for (int m = 0; m < 4; ++m) { const size_t row = (size_t)(u.pm * 256 + ai * 128 + wr * 64 + m * 16 + fr);
#pragma unroll
                    for (int bj = 0; bj < 2; ++bj) { const int col = u.pn * 256 + bj * 128 + wc * 32 + 8 * fq;
                        const u32x4 g = gs[((ai * 4 + m) * 2 + bj) * 512];
                        f32x4 a = acc[ai][bj][m][0], b = acc[ai][bj][m][1];
                        a[0] *= bflo(g.x); a[1] *= bfhi(g.x); a[2] *= bflo(g.y); a[3] *= bfhi(g.y); b[0] *= bflo(g.z); b[1] *= bfhi(g.z); b[2] *= bflo(g.w); b[3] *= bfhi(g.w);
                        bf16_t* dst = MG + row * 1024 + col;
                        if (u.x > 1) { const u32x4 p = *(const u32x4*)dst;
                            a[0] += bflo(p.x); a[1] += bfhi(p.x); a[2] += bflo(p.y); a[3] += bfhi(p.y); b[0] += bflo(p.z); b[1] += bfhi(p.z); b[2] += bflo(p.w); b[3] += bfhi(p.w); }
                        *(u32x4*)dst = pack8(a, b); }
                    if (m == 3) asm volatile("" ::: "memory"); }
        }
    }
};
constexpr int MOE_TAB = LDS_MISC + 256;
DI void moe_build_table(const Ctx& C, const unsigned* CNT) {
    volatile LAS int* T = (volatile LAS int*)(C.lds + MOE_TAB);
    if (C.tid == 0) { int acc = 0; for (int e = 0; e < 32; ++e) { const int n = (int)CNT[e]; T[e] = acc; T[40 + e] = n; const int nt = (n + 255) >> 8;
            for (int j = 0; j < nt; ++j) T[80 + acc + j] = (e << 8) | j;
            acc += nt; } T[32] = acc; }
    __syncthreads();
}
template <int NPN, bool GU> struct MoeOrder {
    const LAS int* T; const char* Ab; const char* Wb; const int* ROWTOK; int G, c;
    DI bool next(int i, pg8::Unit& u) const {
        const long L = (long)i * G + c; const int tile = (int)(L / NPN), pn = (int)(L % NPN);
        if (tile >= __builtin_amdgcn_readfirstlane(T[32])) return false;
        const int ej = __builtin_amdgcn_readfirstlane(T[80 + tile]); const int e = ej >> 8;
        u.x = e; u.y = ej & 255; u.pm = tile; u.pn = pn; u.nt = 0;
        if (GU) { u.a = Ab; u.b = Wb + ((size_t)e * 512 + (size_t)pn * 256) * 1024 * 2; }
        else { u.a = Ab + (size_t)tile * 256 * 256 * 2; u.b = Wb + ((size_t)e * 1024 + (size_t)pn * 256) * 256 * 2; }
        return true; }
    DI unsigned row_off(const pg8::Unit& u, int row) const {
        const int idx = u.y * 256 + row; int tok = 0;
        if (idx < T[40 + u.x]) tok = ROWTOK[(size_t)u.x * MOE_CAP + idx] >> 1;
        return (unsigned)tok * 2048u; }
};

constexpr int PH_PER_LAYER = 16, PH_L0 = 1, N_PHASES = PH_L0 + DEPTH * PH_PER_LAYER + 1;
#ifndef ENABLE_MASK
#define ENABLE_MASK 0xFF
#endif
#ifndef PROBE_DUP
#define PROBE_DUP 0
#endif
#define NREP(bit) ((PROBE_DUP & (bit)) ? 2 : 1)
#define ZIGZAG(n, call) do { for (int _rd = 0; _rd * C.G < (n); ++_rd) { const int u = _rd * C.G + ((_rd & 1) ? (C.G - 1 - C.bid) : C.bid); if (u < (n)) { call; } } } while (0)

typedef const Params __attribute__((address_space(4))) KParams;
#if defined(__HIP_DEVICE_COMPILE__)
#define PHASE_LOADP() KParams* _pp = (KParams*)__builtin_amdgcn_kernarg_segment_ptr(); asm volatile("" : "+s"(_pp)); const Params P = *_pp
#else
#define PHASE_LOADP() const Params P = Parg
#endif
#define PHASE_ENV() PHASE_LOADP(); const Ctx C = relaunder(C0); LAS unsigned char* lds = C.lds; bf16_t* H = wsp<bf16_t>(P, WS_H); bf16_t* Y = wsp<bf16_t>(P, WS_Y); unsigned char* R1 = P.ws + WS_R1
#define IN(k) (lo <= (k) && (k) < hi)
#define SEAM(k) do { if (IN(k) && IN((k) + 1)) { xcd_barrier(bar); if (PROBE_DUP & 1048576) xcd_barrier(bar); } } while (0)
template <int l> DI void layer_phases(const Ctx& C0, const Params& Parg, const int lo, const int hi, const XcdBarrier& bar) {
    constexpr int pb = PH_L0 + l * PH_PER_LAYER;
        if (IN(pb + 0)) { PHASE_ENV(); for (int rep = 0; rep < NREP(8); ++rep) phase_convert_layer(C, P, l);
            if (l == 0) phase_rownorm<false, true, false, true>(C, P, P.norm_mix + l * DM); else if (!(ENABLE_MASK & 32)) phase_rownorm<false, true, false>(C, P, P.norm_mix + l * DM); else phase_rownorm<true, true, false>(C, P, P.norm_mix + l * DM); } SEAM(pb + 0);
        if (IN(pb + 1)) for (int rep = 0; rep < NREP(16); ++rep) { PHASE_ENV();
            { pg8::DenseOrder S; S.init(H, wsp<bf16_t>(P, W_IN), NTOK, 2560, 1024, 1024, C.G, C.bid);
              EpiStore<0> E{(bf16_t*)(R1 + R1_PROJ), PROJ_LD}; pg8::gemm_phase<EpiStore<0>, pg8::DenseOrder, false>(C.tid, lds, 1024, 1024, 1024, S, E); }
            { pg8::DenseOrder S; S.init(wsp<bf16_t>(P, W_V), H, 512, NTOK, 1024, 1024, C.G, (C.bid + 128) % C.G);
              EpiStore<0> E{(bf16_t*)(R1 + R1_VT), NTOK}; pg8::gemm_phase<EpiStore<0>, pg8::DenseOrder, false>(C.tid, lds, 1024, 1024, 1024, S, E); }
            if (l == 0) {
        for (int lm = 0; lm < DEPTH; ++lm) {
            const bf16_t* MEMN = wsp<bf16_t>(P, WS_MEMN) + (size_t)lm * 1024 * 1024; const bf16_t* WKV = wsp<bf16_t>(P, W_KV) + (size_t)lm * 512 * 1024;
            { pg8::DenseOrder S; S.init(MEMN, WKV, 1024, 256, 1024, 1024, C.G, (C.bid + 8 * lm) % C.G);
              EpiStore<0> E{wsp<bf16_t>(P, WS_MK) + (size_t)lm * 1024 * 256, 256}; pg8::gemm_phase<EpiStore<0>, pg8::DenseOrder, false>(C.tid, lds, 1024, 1024, 1024, S, E); }
            { pg8::DenseOrder S; S.init(WKV + (size_t)256 * 1024, MEMN, 256, 1024, 1024, 1024, C.G, (C.bid + 8 * lm + 4) % C.G);
              EpiStore<0> E{wsp<bf16_t>(P, WS_MVT) + (size_t)lm * 256 * 1024, 1024}; pg8::gemm_phase<EpiStore<0>, pg8::DenseOrder, false>(C.tid, lds, 1024, 1024, 1024, S, E); }
        }
            }
        } SEAM(pb + 1);
        if (IN(pb + 2)) { PHASE_ENV(); phase_rope(C, P, l); } SEAM(pb + 2);
        if (IN(pb + 3)) { PHASE_ENV();
            for (int rep = 0; rep < NREP(1); ++rep) { if (ENABLE_MASK & 8) ZIGZAG(512, dsa_select_unit(C, P, l, u);); }
            for (int rep = 0; rep < NREP(1024); ++rep) { if (ENABLE_MASK & 2) ZIGZAG(512, hgrn_local_unit(C, P, l, u);); }
            for (int rep = 0; rep < NREP(2048); ++rep) { if (ENABLE_MASK & 4) ZIGZAG(256, sgu_unit(C, P, l, u);); }
        } SEAM(pb + 3);
        if (IN(pb + 4)) { PHASE_ENV();
            for (int rep = 0; rep < NREP(2); ++rep) { if (ENABLE_MASK & 1) causal_attn_block2<true>(C, P, l); }
            if (ENABLE_MASK & 2) { for (int u = C.G - 1 - C.bid; u < 128; u += C.G) hgrn_scan_unit(C, P, u); }
        } SEAM(pb + 4);
        if (IN(pb + 5)) {
            for (int rep = 0; rep < NREP(4); ++rep) { PHASE_ENV();
            for (int r2 = 0; r2 < NREP(2097152); ++r2) { if (ENABLE_MASK & 8) causal_attn_block2<false>(C, P, l); }
            for (int r3 = 0; r3 < NREP(4194304); ++r3) { if (ENABLE_MASK & 2) ZIGZAG(512, hgrn_out_unit(C, P, l, u);); } }
        } SEAM(pb + 5);
        if (IN(pb + 7)) for (int rep = 0; rep < NREP(128); ++rep) { PHASE_ENV();
            FusedMergeOrder S{(const char*)H, (const char*)Y, (const char*)wsp<bf16_t>(P, W_G), (const char*)wsp<bf16_t>(P, W_BR), C.G, C.bid};
            EpiFusedMerge E{(bf16_t*)(R1 + R1_GS) + (size_t)C.bid * 65536, (bf16_t*)(R1 + R1_MG), C.tid};
            pg8::gemm_phase<EpiFusedMerge, FusedMergeOrder, false>(C.tid, lds, 1024, 1024, 1024, S, E);
        } SEAM(pb + 7);
        if (IN(pb + 8)) { PHASE_ENV();
            pg8::DenseOrder S; S.init(R1 + R1_MG, wsp<bf16_t>(P, W_OUT), NTOK, 1024, 1024, 1024, C.G, C.bid);
            EpiResidNorm E{P.out, H, wsp<float>(P, WS_RSS)}; pg8::gemm_phase<EpiResidNorm, pg8::DenseOrder, false>(C.tid, lds, 1024, 1024, 1024, S, E);
        } SEAM(pb + 8);
        if (IN(pb + 10)) for (int rep = 0; rep < NREP(64); ++rep) { PHASE_ENV();
            pg8::DenseOrder S; S.init(H, wsp<bf16_t>(P, W_Q), NTOK, 256, 1024, 1024, C.G, C.bid);
            EpiStoreRstd E{(bf16_t*)(R1 + R1_MQ), 256, wsp<float>(P, WS_RSS)}; pg8::gemm_phase<EpiStoreRstd, pg8::DenseOrder, false>(C.tid, lds, 1024, 1024, 1024, S, E);
        } SEAM(pb + 10);
        if (IN(pb + 11)) for (int rep = 0; rep < NREP(64); ++rep) { PHASE_ENV(); mem_attn_block(C, P, l); } SEAM(pb + 11);
        if (IN(pb + 12)) { PHASE_ENV();
            if (ENABLE_MASK & 16) { pg8::DenseOrder S; S.init(R1 + R1_MO, wsp<bf16_t>(P, W_O), NTOK, 1024, 256, 256, C.G, C.bid);
              EpiResid E{P.out}; pg8::gemm_phase<EpiResid, pg8::DenseOrder, false>(C.tid, lds, 256, 256, 256, S, E); }
        } SEAM(pb + 12);
        if (IN(pb + 13)) { PHASE_ENV(); phase_router(C, P, l); if (PROBE_DUP & 512) { __syncthreads(); phase_router(C, P, l, true); } } SEAM(pb + 13);
        if (IN(pb + 14)) for (int rep = 0; rep < NREP(32); ++rep) { PHASE_ENV();
            moe_build_table(C, wsp<unsigned>(P, WS_CTL) + CW_CNT + 64 * l);
            MoeOrder<2, true> S{(const LAS int*)(lds + MOE_TAB), (const char*)H, (const char*)wsp<bf16_t>(P, W_GU), wsp<int>(P, WS_ROWTOK), C.G, C.bid};
            EpiGU E{(bf16_t*)(R1 + R1_HID)}; pg8::gemm_phase<EpiGU, MoeOrder<2, true>, true>(C.tid, lds, 1024, 1024, 1024, S, E);
        } SEAM(pb + 14);
        if (IN(pb + 15)) for (int rep = 0; rep < NREP(32); ++rep) { PHASE_ENV();
            moe_build_table(C, wsp<unsigned>(P, WS_CTL) + CW_CNT + 64 * l);
            MoeOrder<4, false> S{(const LAS int*)(lds + MOE_TAB), (const char*)(R1 + R1_HID), (const char*)wsp<bf16_t>(P, W_D), wsp<int>(P, WS_ROWTOK), C.G, C.bid};
            EpiDown E{(bf16_t*)(R1 + R1_YB), wsp<int>(P, WS_ROWTOK), wsp<float>(P, WS_TOKW), (const LAS int*)(lds + MOE_TAB) + 40};
            pg8::gemm_phase<EpiDown, MoeOrder<4, false>, false>(C.tid, lds, 256, 256, 256, S, E);
        } SEAM(pb + 15);
    }
__global__ void __launch_bounds__(NTHREADS, 2) mega_fwd(Params Parg) {
    extern __shared__ __attribute__((aligned(16))) unsigned char lds_raw[];
    Ctx C0; C0.lds = (LAS unsigned char*)lds_raw; C0.tid = threadIdx.x; C0.lane = C0.tid & 63; C0.wave = __builtin_amdgcn_readfirstlane((int)threadIdx.x >> 6); C0.G = gridDim.x; C0.bid = blockIdx.x;
    volatile LAS unsigned* misc = (volatile LAS unsigned*)(C0.lds + LDS_MISC);
    if (C0.tid < 4) misc[C0.tid] = 0u;
    __syncthreads();
    const int lo = Parg.ph_lo, hi = Parg.ph_hi;
    const bool use_bar = (hi - lo) > 1;
    XcdBarrier bar; bar.bar = (unsigned*)(Parg.ws + WS_CTL) + CW_BAR; bar.x = 0; bar.st = misc;
    if (use_bar) bar = xcd_barrier_post((unsigned*)(Parg.ws + WS_CTL) + CW_BAR, misc);
#define IN(k) (lo <= (k) && (k) < hi)
#define SEAM(k) do { if (IN(k) && IN((k) + 1)) { xcd_barrier(bar); if (PROBE_DUP & 1048576) xcd_barrier(bar); } } while (0)

    if (IN(0)) { PHASE_ENV(); phase_prologue(C, P); } SEAM(0);
    layer_phases<0>(C0, Parg, lo, hi, bar);
    layer_phases<1>(C0, Parg, lo, hi, bar);
    if (IN(N_PHASES - 1)) { PHASE_ENV(); if (ENABLE_MASK & 32) phase_rownorm<true, false, true>(C, P, P.norm_final); else phase_rownorm<false, false, true>(C, P, P.norm_final); }
#undef IN
#undef SEAM
}

#ifndef N_LAUNCH_MODE
#define N_LAUNCH_MODE 0
#endif
extern "C" void kernel_launch(void* const* d_in, const int* in_sizes, int n_in, void* d_out, int out_size, void* d_ws, size_t ws_size, hipStream_t stream) {
    static int grid = 0;
    if (grid == 0) {
        if (n_in != 25 || out_size != NTOK * DM || ws_size < WS_END) { fprintf(stderr, "kernel_launch: unexpected shapes (n_in %d out %d ws %zu need %zu)\n", n_in, out_size, ws_size, (size_t)WS_END); grid = -1; return; }
        int dev = 0, cus = 0;
        if (hipGetDevice(&dev) != hipSuccess || hipDeviceGetAttribute(&cus, hipDeviceAttributeMultiprocessorCount, dev) != hipSuccess) { grid = -1; return; }
        if (hipFuncSetAttribute((const void*)mega_fwd, hipFuncAttributeMaxDynamicSharedMemorySize, LDS_BYTES) != hipSuccess) { fprintf(stderr, "kernel_launch: hipFuncSetAttribute failed\n"); grid = -1; return; }
        int per_cu = 0;
        if (hipOccupancyMaxActiveBlocksPerMultiprocessor(&per_cu, (const void*)mega_fwd, NTHREADS, LDS_BYTES) != hipSuccess || per_cu < 1) { fprintf(stderr, "kernel_launch: occupancy query says %d\n", per_cu); }
        (void)hipGetLastError();
        if (cus != 256) fprintf(stderr, "kernel_launch: built for 256 CUs (one workgroup per CU); device reports %d\n", cus);
        grid = 256;
    }
    if (grid < 0) return;
    (void)hipMemsetAsync((char*)d_ws + WS_CTL, 0, CTL_BYTES, stream);
    Params p{};
    p.x = (const float*)d_in[0]; p.mem = (const float*)d_in[1]; p.positions = (const int*)d_in[2];
    p.norm_mix = (const float*)d_in[3]; p.w_in = (const float*)d_in[4]; p.diff_lambda = (const float*)d_in[5]; p.hgrn_lb = (const float*)d_in[6];
    p.spatial_w = (const float*)d_in[7]; p.spatial_b = (const float*)d_in[8]; p.w_branch = (const float*)d_in[9]; p.w_out = (const float*)d_in[10];
    p.norm_mem_q = (const float*)d_in[11]; p.norm_mem_kv = (const float*)d_in[12]; p.w_mem_q = (const float*)d_in[13]; p.w_mem_kv = (const float*)d_in[14]; p.w_mem_o = (const float*)d_in[15];
    p.norm_ffn = (const float*)d_in[16]; p.w_rg = (const float*)d_in[17]; p.b_rg = (const float*)d_in[18]; p.w_re = (const float*)d_in[19]; p.b_re = (const float*)d_in[20];
    p.w_eg = (const float*)d_in[21]; p.w_eu = (const float*)d_in[22]; p.w_ed = (const float*)d_in[23]; p.norm_final = (const float*)d_in[24];
    p.out = (float*)d_out; p.ws = (unsigned char*)d_ws;
#if N_LAUNCH_MODE == 0
    p.ph_lo = 0; p.ph_hi = N_PHASES;
    hipLaunchKernelGGL(mega_fwd, dim3(grid), dim3(NTHREADS), LDS_BYTES, stream, p);
#else
    for (int k = 0; k < N_PHASES; ++k) { p.ph_lo = k; p.ph_hi = k + 1; hipLaunchKernelGGL(mega_fwd, dim3(grid), dim3(NTHREADS), LDS_BYTES, stream, p); }
#endif
}
```

```cpp
#include <hip/hip_runtime.h>
#include <stdint.h>
#include <stdio.h>

#ifndef PROBE_DUP
#define PROBE_DUP 0
#endif
#define DI __device__ __forceinline__
#define LAS __attribute__((address_space(3)))
typedef unsigned short bf16_t;
typedef short bf16x8 __attribute__((ext_vector_type(8)));
typedef short s16x4 __attribute__((ext_vector_type(4)));
typedef float f32x2 __attribute__((ext_vector_type(2)));
typedef float f32x4 __attribute__((ext_vector_type(4)));
typedef float f32x16 __attribute__((ext_vector_type(16)));
typedef unsigned u32x2 __attribute__((ext_vector_type(2)));
typedef unsigned u32x4 __attribute__((ext_vector_type(4)));
typedef __bf16 hbf2 __attribute__((ext_vector_type(2)));

constexpr int NB = 4, SEQ = 4096, NTOK = NB * SEQ, DM = 1024, DEPTH = 2, MEMLEN = 256;
constexpr int NTHREADS = 512, NWAVES = 8;
constexpr int LDS_BYTES = 147456;
constexpr int LDS_MISC = 133120;
constexpr int IN_WIDTH = 6948;
constexpr int PROJ_LD = 2560;
constexpr int PC_AQ = 0, PC_AK = 256, PC_BQ = 512, PC_BF = 768, PC_BI = 1024, PC_BG = 1280, PC_CU = 1536, PC_CV = 1792,
              PC_DQ = 2048, PC_DK = 2304, PC_DIQ = 2368, PC_DIK = 2496, PC_DIW = 2528;
constexpr int MOE_CAP = 16384;

constexpr size_t AL(size_t x) { return (x + 255) & ~(size_t)255; }
constexpr size_t WS_CTL = 0, CTL_BYTES = 65536;
constexpr size_t W_IN = AL(WS_CTL + CTL_BYTES);
constexpr size_t W_V = W_IN + (size_t)2560 * 1024 * 2;
constexpr size_t W_G = W_V + (size_t)512 * 1024 * 2;
constexpr size_t W_BR = W_G + (size_t)4096 * 1024 * 2;
constexpr size_t W_OUT = W_BR + (size_t)4 * 1024 * 256 * 2;
constexpr size_t W_Q = W_OUT + (size_t)1024 * 1024 * 2;
constexpr size_t W_O = W_Q + (size_t)256 * 1024 * 2;
constexpr size_t W_GU = W_O + (size_t)1024 * 256 * 2;
constexpr size_t W_D = W_GU + (size_t)32 * 512 * 1024 * 2;
constexpr size_t W_SGU = W_D + (size_t)32 * 1024 * 256 * 2;
constexpr size_t W_RT = W_SGU + (size_t)4 * 128 * 128 * 2;
constexpr size_t W_RH = W_RT + (size_t)36 * 1024 * 4;
constexpr size_t W_KV = W_RH + (size_t)2 * 64 * 1024 * 2;
constexpr size_t WS_H = W_KV + (size_t)DEPTH * 512 * 1024 * 2;
constexpr size_t WS_R1 = WS_H + (size_t)NTOK * 1024 * 2;
constexpr size_t R1_BYTES = (size_t)NTOK * 4096 * 2;
constexpr size_t WS_Y = WS_R1 + R1_BYTES;
constexpr size_t WS_HS = WS_Y + (size_t)NTOK * 1024 * 2;
constexpr size_t WS_HD = WS_HS + (size_t)NB * 64 * 4 * 4096 * 4;
constexpr size_t WS_THETA = WS_HD + (size_t)NB * 64 * 256 * 4;
constexpr size_t WS_MEMN = WS_THETA + (size_t)NTOK * 8;
constexpr size_t WS_MK = WS_MEMN + (size_t)DEPTH * 1024 * 1024 * 2;
constexpr size_t WS_MVT = WS_MK + (size_t)DEPTH * 1024 * 256 * 2;
constexpr size_t WS_TOKE = WS_MVT + (size_t)DEPTH * 256 * 1024 * 2;
constexpr size_t WS_TOKW = WS_TOKE + (size_t)NTOK * 2 * 4;
constexpr size_t WS_RANK = WS_TOKW + (size_t)NTOK * 2 * 4;
constexpr size_t WS_ROWTOK = WS_RANK + (size_t)NTOK * 2 * 4;
constexpr size_t WS_MASK = WS_ROWTOK + (size_t)32 * MOE_CAP * 4;
constexpr size_t WS_RSS = WS_MASK + (size_t)NB * 128 * 128 * 64 * 2;
constexpr size_t WS_DUMMY_BASE = WS_RSS + (size_t)NTOK * 16 * 4;
constexpr size_t WS_DUMMY_OLD = WS_MASK + (size_t)NB * 128 * 128 * 64 * 2;
constexpr size_t WS_DUMMY = WS_DUMMY_BASE;
constexpr size_t WS_END = WS_DUMMY + (size_t)32 * MOE_CAP * 4;
constexpr size_t R1_PROJ = 0, R1_VT = (size_t)NTOK * PROJ_LD * 2;
constexpr size_t R1_GS = 0, R1_MG = (size_t)256 * 65536 * 2;
constexpr size_t R1_MQ = 0, R1_MO = (size_t)NTOK * 256 * 2, R1_HID = 2 * R1_MO, R1_YB = R1_HID + (size_t)40960 * 256 * 2;
constexpr size_t R1_HIDS = R1_YB + (size_t)NTOK * 2 * 1024 * 2;
static_assert(R1_HIDS + (size_t)32 * 64 * 256 * 2 <= R1_BYTES, "R1 map");
static_assert(R1_YB + (size_t)NTOK * 2 * 1024 * 2 <= R1_BYTES, "R1 map");
static_assert(R1_VT + (size_t)512 * NTOK * 2 <= R1_BYTES, "R1 map");
constexpr int CW_BAR = 0;
constexpr int CW_KMAX = 4032;
constexpr int CW_CNT = 4096;

DI bf16_t f2bf(float f) { __bf16 b = (__bf16)f; return __builtin_bit_cast(bf16_t, b); }
DI float bf2f(bf16_t b) { return __uint_as_float(((unsigned)b) << 16); }
DI unsigned pk2(float a, float b) { f32x2 v = {a, b}; hbf2 r = __builtin_convertvector(v, hbf2); return __builtin_bit_cast(unsigned, r); }
DI float bflo(unsigned w) { return __uint_as_float(w << 16); }
DI float bfhi(unsigned w) { return __uint_as_float(w & 0xffff0000u); }
DI float sigmoidf_(float x) { return __builtin_amdgcn_rcpf(1.0f + __builtin_amdgcn_exp2f(-1.4426950408889634f * x)); }
DI float siluf_(float x) { return x * __builtin_amdgcn_rcpf(1.0f + __builtin_amdgcn_exp2f(-1.4426950408889634f * x)); }
DI float fexp(float x) { return __builtin_amdgcn_exp2f(1.4426950408889634f * x); }
DI float frcp(float x) { return __builtin_amdgcn_rcpf(x); }
DI float flog(float x) { return 0.6931471805599453f * __builtin_amdgcn_logf(x); }
DI float gelu_tanh(float x) { const float u = 0.7978845608028654f * (x + 0.044715f * x * x * x); return x * frcp(1.0f + fexp(-2.0f * u)); }
DI float wave_sum(float v) { for (int o = 32; o > 0; o >>= 1) v += __shfl_xor(v, o); return v; }
DI float xhalf_max(float x) { const u32x2 r = __builtin_amdgcn_permlane32_swap(__float_as_uint(x), __float_as_uint(x), false, false); return fmaxf(__uint_as_float(r.x), __uint_as_float(r.y)); }
DI float xhalf_sum(float x) { const u32x2 r = __builtin_amdgcn_permlane32_swap(__float_as_uint(x), __float_as_uint(x), false, false); return __uint_as_float(r.x) + __uint_as_float(r.y); }
DI f32x16 mfma32(bf16x8 a, bf16x8 b, f32x16 c) { return __builtin_amdgcn_mfma_f32_32x32x16_bf16(a, b, c, 0, 0, 0); }
DI int crow(int reg, int h) { return (reg & 3) + 8 * (reg >> 2) + 4 * h; }
DI f32x16 zero16() { f32x16 z; for (int i = 0; i < 16; ++i) z[i] = 0.f; return z; }

#define XB_TMO      128
#define XB_XCNT(j)  (256  + 64 * (j))
#define XB_XSUB(j)  (1280 + 64 * (j))
#define XB_XGEN(j)  (2304 + 64 * (j))
#define XB_TOP      3328
#define XB_TOPGEN   3392
#define XCD_BAR_WORDS 3456
#define XB_SPIN_CAP (1u << 22)

DI unsigned xb_ld(unsigned* p)              { return __hip_atomic_load(p, __ATOMIC_RELAXED, __HIP_MEMORY_SCOPE_AGENT); }
DI unsigned xb_add(unsigned* p, unsigned v) { return __hip_atomic_fetch_add(p, v, __ATOMIC_RELAXED, __HIP_MEMORY_SCOPE_AGENT); }
DI unsigned xb_xcc_id() { return (unsigned)__builtin_amdgcn_s_getreg((3 << 11) | 20) & 0xFu; }
#define XB_SPIN(cond, bar) do { unsigned _sp = 0; while (cond) { __builtin_amdgcn_s_sleep(1); \
    if ((++_sp & 255u) == 0u) { if (xb_ld(&(bar)[XB_TMO])) break; if (_sp > XB_SPIN_CAP) { atomicAdd(&(bar)[XB_TMO], 1u); break; } } } } while (0)

struct XcdBarrier { unsigned* bar; unsigned x; volatile LAS unsigned* st; };

DI XcdBarrier xcd_barrier_post(unsigned* bar, volatile LAS unsigned* st) {
    XcdBarrier b; b.bar = bar; b.x = xb_xcc_id(); b.st = st;
    if (threadIdx.x == 0) (void)xb_add(&bar[XB_XCNT(b.x)], 1u);
    return b;
}
DI void xcd_barrier_complete(unsigned* bar, unsigned x, unsigned& nloc, unsigned& nx) {
    const unsigned G = gridDim.x * gridDim.y * gridDim.z;
    unsigned sum, cnt, mine, sp = 0u;
    for (;;) {
        sum = 0u; cnt = 0u; mine = 0u;
#pragma unroll
        for (unsigned j = 0; j < 16; ++j) { const unsigned c = xb_ld(&bar[XB_XCNT(j)]); sum += c; cnt += (c > 0u) ? 1u : 0u; mine = (j == x) ? c : mine; }
        if (sum == G) break;
        __builtin_amdgcn_s_sleep(1);
        if ((++sp & 255u) == 0u) { if (xb_ld(&bar[XB_TMO])) break; if (sp > XB_SPIN_CAP) { atomicAdd(&bar[XB_TMO], 1u); break; } }
    }
    nloc = mine > 0u ? mine : 1u; nx = cnt > 0u ? cnt : 1u;
}
DI void xcd_barrier(const XcdBarrier& b) {
    asm volatile("s_waitcnt vmcnt(0)" ::: "memory");
    __syncthreads();
    if (threadIdx.x == 0) {
        unsigned* bar = b.bar;
        __builtin_amdgcn_s_waitcnt(0);
        unsigned nloc = b.st[0], nx = b.st[1];
        if (nloc == 0u) { xcd_barrier_complete(bar, b.x, nloc, nx); b.st[0] = nloc; b.st[1] = nx; }
        const unsigned old = xb_add(&bar[XB_XSUB(b.x)], 1u);
        const unsigned gen = old / nloc;
        if (old + 1u == (gen + 1u) * nloc) {
            __builtin_amdgcn_fence(__ATOMIC_RELEASE, "agent");
            asm volatile("s_waitcnt vmcnt(0)" ::: "memory");
            const unsigned og = xb_add(&bar[XB_TOP], 1u);
            const unsigned tg = og / nx;
            if (og + 1u == (tg + 1u) * nx) xb_add(&bar[XB_TOPGEN], 1u);
            else XB_SPIN(xb_ld(&bar[XB_TOPGEN]) == tg, bar);
            __builtin_amdgcn_fence(__ATOMIC_ACQUIRE, "agent");
            xb_add(&bar[XB_XGEN(b.x)], 1u);
            asm volatile("s_waitcnt vmcnt(0)" ::: "memory");
        } else {
            XB_SPIN(xb_ld(&bar[XB_XGEN(b.x)]) == gen, bar);
            __builtin_amdgcn_fence(__ATOMIC_ACQUIRE, "agent");
            asm volatile("s_waitcnt vmcnt(0)" ::: "memory");
        }
    }
    __syncthreads();
}
namespace pg8 {
constexpr int BM = 256, BK = 64, HALF = 128, HTB = HALF * BK * 2, STAGE_BYTES = 8 * HTB, NXCD = 8, WGM = 8;
DI int lds_byte(int r, int c) { const int st = (r >> 4) * 2 + (c >> 5), rr = r & 15, cc = c & 31, ob = rr * 64 + cc * 2; return st * 1024 + (ob ^ (((ob >> 9) & 1) << 5)); }
DI void stage_rc(int b, int& R, int& C) { const int st = b / 1024, sb = b % 1024, swz = sb ^ (((sb >> 9) & 1) << 5); R = (st >> 1) * 16 + swz / 64; C = (st & 1) * 32 + (swz % 64) / 2; }
DI int perm32(int rho) { const int n = rho >> 4, i = rho & 15; return 8 * (i >> 2) + 4 * n + (i & 3); }

struct Unit { const char* a; const char* b; int pm, pn, x, y, nt; };

DI void tile_map(int L, int nM, int nN, int& pm, int& pn) {
    const int nwg = nM * nN; int wgid = L;
    { const int q = nwg / NXCD, r = nwg % NXCD, xcd = wgid % NXCD, off = wgid / NXCD; wgid = (xcd < r ? xcd * (q + 1) : r * (q + 1) + (xcd - r) * q) + off; }
    const int nig = WGM * nN, gid = wgid / nig, fm = gid * WGM, gsz = (nM - fm) < WGM ? (nM - fm) : WGM;
    pm = fm + ((wgid % nig) % gsz); pn = (wgid % nig) / gsz;
}
struct DenseOrder {
    const char* A; const char* B; size_t at, bt; int nM, nN, nwg, G, c;
    DI void init(const void* A_, const void* B_, int M, int N, int lda, int ldb, int G_, int c_) {
        A = (const char*)A_; B = (const char*)B_; at = (size_t)BM * lda * 2; bt = (size_t)BM * ldb * 2; nM = M / BM; nN = N / BM; nwg = nM * nN; G = G_; c = c_; }
    DI bool next(int i, Unit& u) const {
        const long L = (long)i * G + c; if (L >= nwg) return false;
        tile_map((int)L, nM, nN, u.pm, u.pn); u.a = A + (size_t)u.pm * at; u.b = B + (size_t)u.pn * bt; u.x = 0; u.y = 0; u.nt = 0; return true; }
    DI unsigned row_off(const Unit&, int) const { return 0u; }
};

#define PG8_WAIT_V(n) asm volatile("s_waitcnt vmcnt(" #n ")" ::: "memory")
#define PG8_WAIT_L(n) asm volatile("s_waitcnt lgkmcnt(" #n ")" ::: "memory")
#define PG8_BAR __builtin_amdgcn_s_barrier()
#define PG8_SCHED __builtin_amdgcn_sched_barrier(0)

template <class Epi, class Sched, bool GATHER>
DI void gemm_phase(const int tid, LAS unsigned char* lds, const int lda, const int ldb, const int K, const Sched& S, const Epi& E) {
    const int wid = __builtin_amdgcn_readfirstlane(tid >> 6), lane = tid & 63, wr = wid >> 2, wc = wid & 3, fr = lane & 15, fq = lane >> 4;
    const int nt_phase = K / BK;
    unsigned voffA[2], voffB[2]; int RA[2], CA[2];
#pragma unroll
    for (int i = 0; i < 2; ++i) { int R, C; stage_rc(tid * 16 + i * 8192, R, C); const int Rb = (R & ~31) + perm32(R & 31);
        RA[i] = R; CA[i] = C; voffA[i] = (unsigned)(R * lda + C) * 2u; voffB[i] = (unsigned)(Rb * ldb + C) * 2u; }
    const size_t kstep = (size_t)(BK * 2);
    const size_t hstepA = (size_t)HALF * lda * 2, hstepB = (size_t)HALF * ldb * 2;
    const unsigned ldsw = (unsigned)wid * 1024u;
    const int aoff = lds_byte(wr * 64 + fr, fq * 8), boff = lds_byte(wc * 32 + fr, fq * 8);
    unsigned vc[2][2], vn[2][2];
#define PG8_SA(b, h) (((b) * 2 + (h)) * HTB)
#define PG8_SB(b, h) ((4 + (b) * 2 + (h)) * HTB)
#define PG8_GL(bufoff, gptr, vo, _i) __builtin_amdgcn_global_load_lds((const unsigned*)((const char*)(gptr) + (vo)), (LAS unsigned*)(lds + (bufoff) + ldsw + (_i) * 8192), 16, 0, 0)
#define PG8_STAGE_B(bufoff, gbase) do { PG8_GL(bufoff, gbase, voffB[0], 0); PG8_GL(bufoff, gbase, voffB[1], 1); } while (0)
#define PG8_STAGE_A(bufoff, kptr, h, isnext) do { if constexpr (GATHER) { const unsigned _o0 = (isnext) ? vn[h][0] : vc[h][0], _o1 = (isnext) ? vn[h][1] : vc[h][1]; PG8_GL(bufoff, kptr, _o0, 0); PG8_GL(bufoff, kptr, _o1, 1); } \
        else { PG8_GL(bufoff, (kptr) + (h) * hstepA, voffA[0], 0); PG8_GL(bufoff, (kptr) + (h) * hstepA, voffA[1], 1); } } while (0)
#define PG8_LDA(dst, b, h) do { _Pragma("unroll") for (int m = 0; m < 4; ++m) _Pragma("unroll") for (int k = 0; k < 2; ++k) dst[m][k] = *(const LAS bf16x8*)(lds + PG8_SA(b, h) + aoff + m * 2048 + k * 1024); } while (0)
#define PG8_LDB(dst, b, h) do { _Pragma("unroll") for (int n = 0; n < 2; ++n) _Pragma("unroll") for (int k = 0; k < 2; ++k) dst[n][k] = *(const LAS bf16x8*)(lds + PG8_SB(b, h) + boff + n * 2048 + k * 1024); } while (0)
#define PG8_MMA(ai, bj, At, Bt) do { __builtin_amdgcn_s_setprio(1); _Pragma("unroll") for (int m = 0; m < 4; ++m) _Pragma("unroll") for (int n = 0; n < 2; ++n) _Pragma("unroll") for (int k = 0; k < 2; ++k) \
        acc[ai][bj][m][n] = __builtin_amdgcn_mfma_f32_16x16x32_bf16(Bt[n][k], At[m][k], acc[ai][bj][m][n], 0, 0, 0); __builtin_amdgcn_s_setprio(0); } while (0)
    Unit cur, nxt; int ui = 0;
    if (!S.next(0, cur)) return;
    f32x4 acc[2][2][4][2];
#pragma unroll
    for (int a = 0; a < 2; ++a)
#pragma unroll
        for (int b = 0; b < 2; ++b)
#pragma unroll
            for (int m = 0; m < 4; ++m)
#pragma unroll
                for (int n = 0; n < 2; ++n) acc[a][b][m][n] = (f32x4){0.f, 0.f, 0.f, 0.f};
    bf16x8 At[4][2], B0[2][2], B1[2][2];
    const char* cA = cur.a; const char* cB = cur.b;
    if constexpr (GATHER) {
#pragma unroll
        for (int h = 0; h < 2; ++h)
#pragma unroll
            for (int i = 0; i < 2; ++i) { vc[h][i] = S.row_off(cur, RA[i] + h * HALF) + (unsigned)CA[i] * 2u; vn[h][i] = vc[h][i]; }
    }
    PG8_STAGE_B(PG8_SB(0, 0), cB); PG8_STAGE_A(PG8_SA(0, 0), cA, 0, false); PG8_STAGE_B(PG8_SB(0, 1), cB + hstepB); PG8_STAGE_A(PG8_SA(0, 1), cA, 1, false);
    if (wr == 1) PG8_BAR;
    PG8_WAIT_V(4); PG8_BAR;
    PG8_STAGE_B(PG8_SB(1, 0), cB + kstep); PG8_STAGE_A(PG8_SA(1, 0), cA + kstep, 0, false); PG8_STAGE_B(PG8_SB(1, 1), cB + hstepB + kstep);
    PG8_WAIT_V(6); PG8_BAR;
    for (;;) {
        const bool has_next = S.next(ui + 1, nxt);
        const char* nA = has_next ? nxt.a : cA; const char* nB = has_next ? nxt.b : cB;
        if constexpr (GATHER) {
            if (has_next) {
#pragma unroll
                for (int h = 0; h < 2; ++h)
#pragma unroll
                    for (int i = 0; i < 2; ++i) vn[h][i] = S.row_off(nxt, RA[i] + h * HALF) + (unsigned)CA[i] * 2u;
            }
        }
        const int nt = cur.nt ? cur.nt : nt_phase;
        for (int t = 0; t < nt; t += 2) {
            const bool last = (t == nt - 2);
            int tq = t; asm volatile("" : "+s"(tq));
            const char* a1 = cA + (size_t)(tq + 1) * kstep;
            const char* a2 = last ? nA : cA + (size_t)(tq + 2) * kstep; const char* b2 = last ? nB : cB + (size_t)(tq + 2) * kstep;
            const char* a3 = a2 + kstep; const char* b3 = b2 + kstep;
            PG8_LDB(B0, 0, 0); PG8_SCHED; PG8_LDA(At, 0, 0); PG8_STAGE_A(PG8_SA(1, 1), a1, 1, false);
            PG8_WAIT_L(8); PG8_BAR; PG8_WAIT_L(0); PG8_MMA(0, 0, At, B0); PG8_BAR; PG8_SCHED;
            PG8_LDB(B1, 0, 1); PG8_STAGE_B(PG8_SB(0, 0), b2);
            PG8_BAR; PG8_WAIT_L(0); PG8_MMA(0, 1, At, B1); PG8_BAR;
            PG8_LDA(At, 0, 1); PG8_STAGE_A(PG8_SA(0, 0), a2, 0, last);
            PG8_BAR; PG8_WAIT_L(0); PG8_MMA(1, 0, At, B0); PG8_BAR; PG8_SCHED;
            PG8_STAGE_B(PG8_SB(0, 1), b2 + hstepB);
            PG8_WAIT_V(6); PG8_BAR; PG8_MMA(1, 1, At, B1); PG8_BAR;
            PG8_LDB(B0, 1, 0); PG8_SCHED; PG8_LDA(At, 1, 0); PG8_STAGE_A(PG8_SA(0, 1), a2, 1, last);
            PG8_WAIT_L(8); PG8_BAR; PG8_WAIT_L(0); PG8_MMA(0, 0, At, B0); PG8_BAR; PG8_SCHED;
            PG8_LDB(B1, 1, 1); PG8_STAGE_B(PG8_SB(1, 0), b3);
            PG8_BAR; PG8_WAIT_L(0); PG8_MMA(0, 1, At, B1); PG8_BAR;
            PG8_LDA(At, 1, 1); PG8_STAGE_A(PG8_SA(1, 0), a3, 0, last);
            PG8_BAR; PG8_WAIT_L(0); PG8_MMA(1, 0, At, B0); PG8_BAR; PG8_SCHED;
            PG8_STAGE_B(PG8_SB(1, 1), b3 + hstepB);
            PG8_WAIT_V(6); PG8_BAR; PG8_MMA(1, 1, At, B1); PG8_BAR;
        }
        { int ln2 = lane; asm volatile("" : "+v"(ln2)); E(acc, cur, wr, wc, ln2 & 15, ln2 >> 4); }
        if (!has_next) break;
#pragma unroll
        for (int a = 0; a < 2; ++a)
#pragma unroll
            for (int b = 0; b < 2; ++b)
#pragma unroll
                for (int m = 0; m < 4; ++m)
#pragma unroll
                    for (int n = 0; n < 2; ++n) acc[a][b][m][n] = (f32x4){0.f, 0.f, 0.f, 0.f};
        cur = nxt; cA = nA; cB = nB; ++ui;
        if constexpr (GATHER) {
#pragma unroll
            for (int h = 0; h < 2; ++h)
#pragma unroll
                for (int i = 0; i < 2; ++i) vc[h][i] = vn[h][i];
        }
    }
    PG8_WAIT_V(0);
    if (wr == 0) PG8_BAR;
    PG8_BAR;
#undef PG8_SA
#undef PG8_SB
#undef PG8_GL
#undef PG8_STAGE_A
#undef PG8_STAGE_B
#undef PG8_LDA
#undef PG8_LDB
#undef PG8_MMA
}
}
struct Params {
    const float* x; const float* mem; const int* positions;
    const float* norm_mix; const float* w_in; const float* diff_lambda; const float* hgrn_lb; const float* spatial_w; const float* spatial_b;
    const float* w_branch; const float* w_out; const float* norm_mem_q; const float* norm_mem_kv; const float* w_mem_q; const float* w_mem_kv; const float* w_mem_o;
    const float* norm_ffn; const float* w_rg; const float* b_rg; const float* w_re; const float* b_re; const float* w_eg; const float* w_eu; const float* w_ed; const float* norm_final;
    float* out; unsigned char* ws; int ph_lo, ph_hi;
};
struct Ctx {
    LAS unsigned char* lds; int tid, lane, wave, G, bid;
};
DI Ctx relaunder(const Ctx& C) { Ctx D = C; int w = C.wave, g = C.G, bi = C.bid; asm volatile("" : "+s"(w), "+s"(g), "+s"(bi)); D.wave = w; D.G = g; D.bid = bi; int ln; asm volatile("v_mbcnt_lo_u32_b32 %0, -1, 0\n\tv_mbcnt_hi_u32_b32 %0, -1, %0" : "=v"(ln)); D.lane = ln; D.tid = w * 64 + ln; return D; }
template <class T> DI T* wsp(const Params& P, size_t off) { return (T*)(P.ws + off); }

struct CvtJob { const float* src; bf16_t* dst; int ld_src, ncols, K, ld_dst, nb1, nb2; long ss1, ds1, ss2, ds2; const float* kscale; };
DI void cvt_transpose(const Ctx& C, const CvtJob& J) {
    LAS float* T = (LAS float*)C.lds;
    const int tn = (J.ncols + 63) >> 6, tk = J.K >> 6, per = tn * tk, total = per * J.nb1 * J.nb2;
    for (int t = C.bid; t < total; t += C.G) {
        const int bb = t / per, r = t % per, b1 = bb / J.nb2, b2 = bb % J.nb2, in_ = r / tk, ik = r % tk;
        const float* src = J.src + (size_t)b1 * J.ss1 + (size_t)b2 * J.ss2; bf16_t* dst = J.dst + (size_t)b1 * J.ds1 + (size_t)b2 * J.ds2;
        const int n0 = in_ * 64, k0 = ik * 64;
        { const int k = C.tid >> 3, c8 = (C.tid & 7) * 8;
#pragma unroll
          for (int v = 0; v < 2; ++v) { const int n = n0 + c8 + v * 4;
              f32x4 x = (f32x4){0.f, 0.f, 0.f, 0.f};
              if (n < J.ncols) x = *(const f32x4*)(src + (size_t)(k0 + k) * J.ld_src + n);
              if (J.kscale) { const float g = J.kscale[k0 + k]; x[0] *= g; x[1] *= g; x[2] *= g; x[3] *= g; }
#pragma unroll
              for (int j = 0; j < 4; ++j) T[(c8 + v * 4 + j) * 65 + k] = x[j]; } }
        __syncthreads();
        { const int n = C.tid >> 3, k8 = (C.tid & 7) * 8;
          if (n0 + n < J.ncols) { u32x4 w;
#pragma unroll
              for (int j = 0; j < 4; ++j) w[j] = pk2(T[n * 65 + k8 + 2 * j], T[n * 65 + k8 + 2 * j + 1]);
              *(u32x4*)(dst + (size_t)(n0 + n) * J.ld_dst + k0 + k8) = w; } }
        __syncthreads();
    }
}
DI CvtJob mkjob(const float* src, bf16_t* dst, int ld_src, int ncols, int K, int ld_dst, int nb1 = 1, long ss1 = 0, long ds1 = 0, int nb2 = 1, long ss2 = 0, long ds2 = 0) {
    CvtJob J; J.src = src; J.dst = dst; J.ld_src = ld_src; J.ncols = ncols; J.K = K; J.ld_dst = ld_dst; J.nb1 = nb1; J.nb2 = nb2; J.ss1 = ss1; J.ds1 = ds1; J.ss2 = ss2; J.ds2 = ds2; J.kscale = nullptr; return J; }

DI void phase_convert_layer(const Ctx& C, const Params& P, int l) {
    const float* win = P.w_in + (size_t)l * 1024 * IN_WIDTH;
    bf16_t* WIN = wsp<bf16_t>(P, W_IN); bf16_t* WV = wsp<bf16_t>(P, W_V);
    cvt_transpose(C, mkjob(win + 0, WIN, IN_WIDTH, 512, 1024, 1024));
    cvt_transpose(C, mkjob(win + 768, WIN + (size_t)512 * 1024, IN_WIDTH, 1856, 1024, 1024));
    cvt_transpose(C, mkjob(win + 2688, WIN + (size_t)2368 * 1024, IN_WIDTH, 164, 1024, 1024));
    cvt_transpose(C, mkjob(win + 512, WV, IN_WIDTH, 256, 1024, 1024));
    cvt_transpose(C, mkjob(win + 2624, WV + (size_t)256 * 1024, IN_WIDTH, 64, 1024, 1024));
    cvt_transpose(C, mkjob(win + 2852, wsp<bf16_t>(P, W_G), IN_WIDTH, 4096, 1024, 1024));
    cvt_transpose(C, mkjob(P.w_branch + (size_t)l * 4 * 256 * 1024, wsp<bf16_t>(P, W_BR), 1024, 1024, 256, 1024, 4, 256 * 1024, 256));
    cvt_transpose(C, mkjob(P.w_out + (size_t)l * 1024 * 1024, wsp<bf16_t>(P, W_OUT), 1024, 1024, 1024, 1024));
    { CvtJob J = mkjob(P.w_mem_q + (size_t)l * 1024 * 256, wsp<bf16_t>(P, W_Q), 256, 256, 1024, 1024); J.kscale = P.norm_mem_q + l * DM; cvt_transpose(C, J); }
    cvt_transpose(C, mkjob(P.w_mem_o + (size_t)l * 256 * 1024, wsp<bf16_t>(P, W_O), 1024, 1024, 256, 256));
    cvt_transpose(C, mkjob(P.w_eg + (size_t)l * 32 * 1024 * 256, wsp<bf16_t>(P, W_GU), 256, 128, 1024, 1024, 32, 1024 * 256, 512 * 1024, 2, 128, 256 * 1024));
    cvt_transpose(C, mkjob(P.w_eu + (size_t)l * 32 * 1024 * 256, wsp<bf16_t>(P, W_GU) + (size_t)128 * 1024, 256, 128, 1024, 1024, 32, 1024 * 256, 512 * 1024, 2, 128, 256 * 1024));
    cvt_transpose(C, mkjob(P.w_ed + (size_t)l * 32 * 256 * 1024, wsp<bf16_t>(P, W_D), 1024, 1024, 256, 256, 32, 256 * 1024, 1024 * 256));
    { bf16_t* z0 = WIN + (size_t)2532 * 1024; for (int i = C.bid * NTHREADS + C.tid; i < 28 * 1024; i += C.G * NTHREADS) z0[i] = 0;
      bf16_t* z1 = WV + (size_t)320 * 1024; for (int i = C.bid * NTHREADS + C.tid; i < 192 * 1024; i += C.G * NTHREADS) z1[i] = 0; }
    { bf16_t* rh = wsp<bf16_t>(P, W_RH); const float* wre = P.w_re + (size_t)l * 1024 * 32; const float* wrg = P.w_rg + (size_t)l * 1024 * 4;
      for (int i = C.bid * NTHREADS + C.tid; i < 64 * 1024; i += C.G * NTHREADS) { const int j = i >> 10, k = i & 1023;
          const float w = (j < 32) ? wre[k * 32 + j] : (j < 36 ? wrg[k * 4 + (j - 32)] : 0.f);
          const bf16_t hi = f2bf(w); rh[i] = hi; rh[64 * 1024 + i] = f2bf(w - bf2f(hi)); } }
    { const float* sw = P.spatial_w + (size_t)l * 4 * 128 * 128; bf16_t* d = wsp<bf16_t>(P, W_SGU);
      for (int i = C.bid * NTHREADS + C.tid; i < 4 * 128 * 128; i += C.G * NTHREADS) { const int s = i & 127, t = (i >> 7) & 127; d[i] = (s <= t) ? f2bf(sw[i]) : (bf16_t)0; } }
}

DI void phase_prologue(const Ctx& C, const Params& P) {
    for (int r = C.bid * NWAVES + C.wave; r < NB * MEMLEN; r += C.G * NWAVES) {
        const float* src = P.mem + (size_t)r * DM; f32x4 v[4]; float ss = 0.f;
#pragma unroll
        for (int j = 0; j < 4; ++j) { v[j] = *(const f32x4*)(src + j * 256 + C.lane * 4); ss += v[j][0] * v[j][0] + v[j][1] * v[j][1] + v[j][2] * v[j][2] + v[j][3] * v[j][3]; }
        ss = wave_sum(ss); const float rs = 1.0f / sqrtf(ss * (1.0f / DM) + 1e-6f);
        for (int l = 0; l < DEPTH; ++l) { bf16_t* dst = wsp<bf16_t>(P, WS_MEMN) + ((size_t)l * 1024 + r) * DM;
#pragma unroll
            for (int j = 0; j < 4; ++j) { const f32x4 g = *(const f32x4*)(P.norm_mem_kv + l * DM + j * 256 + C.lane * 4);
                u32x2 w; w.x = pk2(v[j][0] * rs * g[0], v[j][1] * rs * g[1]); w.y = pk2(v[j][2] * rs * g[2], v[j][3] * rs * g[3]);
                *(u32x2*)(dst + j * 256 + C.lane * 4) = w; } }
    }
    for (int l = 0; l < DEPTH; ++l)
        cvt_transpose(C, mkjob(P.w_mem_kv + (size_t)l * 1024 * 512, wsp<bf16_t>(P, W_KV) + (size_t)l * 512 * 1024, 512, 512, 1024, 1024));
}

template <bool ADD_YB, bool WRITE_H, bool FINAL, bool FROM_X = false>
DI void phase_rownorm(const Ctx& C, const Params& P, const float* gain) {
    float* XR = P.out; bf16_t* H = wsp<bf16_t>(P, WS_H); const bf16_t* YB = (const bf16_t*)(P.ws + WS_R1 + R1_YB);
    const int stride = C.G * NWAVES; int t = C.bid * NWAVES + C.wave;
    f32x4 v[4], vn[4]; u32x2 ya[4], yb[4], yan[4], ybn[4];
#define RN_LOAD(dst, da, db, tt) do { const float* src_ = (FROM_X ? P.x : (const float*)XR) + (size_t)(tt) * DM; _Pragma("unroll") for (int j = 0; j < 4; ++j) { const int c = j * 256 + C.lane * 4; dst[j] = *(const f32x4*)(src_ + c); \
        if constexpr (ADD_YB) { da[j] = *(const u32x2*)(YB + (size_t)(2 * (tt)) * DM + c); db[j] = *(const u32x2*)(YB + (size_t)(2 * (tt) + 1) * DM + c); } } } while (0)
    if (t < NTOK) RN_LOAD(v, ya, yb, t);
    for (; t < NTOK; t += stride) {
        const int tn = (t + stride < NTOK) ? t + stride : t;
        RN_LOAD(vn, yan, ybn, tn);
        float* xr = XR + (size_t)t * DM; float ss = 0.f;
#pragma unroll
        for (int j = 0; j < 4; ++j) { const int c = j * 256 + C.lane * 4;
            if constexpr (ADD_YB) { const u32x2 a = ya[j], b = yb[j];
                v[j][0] += bflo(a.x) + bflo(b.x); v[j][1] += bfhi(a.x) + bfhi(b.x); v[j][2] += bflo(a.y) + bflo(b.y); v[j][3] += bfhi(a.y) + bfhi(b.y); }
            if constexpr ((ADD_YB && !FINAL) || FROM_X) *(f32x4*)(xr + c) = v[j];
            ss += v[j][0] * v[j][0] + v[j][1] * v[j][1] + v[j][2] * v[j][2] + v[j][3] * v[j][3]; }
        ss = wave_sum(ss); const float rs = 1.0f / sqrtf(ss * (1.0f / DM) + 1e-6f);
#pragma unroll
        for (int j = 0; j < 4; ++j) { const int c = j * 256 + C.lane * 4; const f32x4 g = *(const f32x4*)(gain + c);
            const f32x4 o = (f32x4){v[j][0] * rs * g[0], v[j][1] * rs * g[1], v[j][2] * rs * g[2], v[j][3] * rs * g[3]};
            if constexpr (FINAL) *(f32x4*)(xr + c) = o;
            if constexpr (WRITE_H) { u32x2 w; w.x = pk2(o[0], o[1]); w.y = pk2(o[2], o[3]); *(u32x2*)(H + (size_t)t * DM + c) = w; } }
#pragma unroll
        for (int j = 0; j < 4; ++j) { v[j] = vn[j]; if constexpr (ADD_YB) { ya[j] = yan[j]; yb[j] = ybn[j]; } }
    }
#undef RN_LOAD
}

DI void phase_rope(const Ctx& C, const Params& P, const int l, const bool dry = false) {
    bf16_t* PROJ = (bf16_t*)(P.ws + WS_R1 + R1_PROJ);
    LAS f32x2* tab = (LAS f32x2*)(C.lds) + C.wave * 64;
    float kmx[4] = {0.f, 0.f, 0.f, 0.f};
    for (int t = C.bid * NWAVES + C.wave; t < NTOK; t += C.G * NWAVES) {
        const float pos = (float)P.positions[t];
        if (C.lane < 48) { const int i = C.lane < 16 ? C.lane : C.lane - 16; const float d = C.lane < 16 ? 32.f : 64.f;
            const float inv = powf(10000.0f, -(float)i * (2.0f / d)); const float ang = pos * inv; float s, c; sincosf(ang, &s, &c); tab[C.lane] = (f32x2){c, s}; }
        __builtin_amdgcn_wave_barrier();
        asm volatile("s_waitcnt lgkmcnt(0)" ::: "memory");
        bf16_t* row = PROJ + (size_t)t * PROJ_LD;
        { const float kv = (C.lane < 32) ? bf2f(row[PC_DIK + C.lane]) : 0.f; const float k2 = wave_sum(kv * kv); const int bb = t >> 12;
#pragma unroll
          for (int q = 0; q < 4; ++q) kmx[q] = (bb == q) ? fmaxf(kmx[q], k2) : kmx[q]; }
        for (int p = C.lane; p < 496; p += 64) {
            int col, half, ti;
            if (p < 256) { col = (p >> 4) * 32 + (p & 15); half = 16; ti = p & 15; }
            else if (p < 416) { const int q = p - 256; col = PC_DQ + (q >> 5) * 64 + (q & 31); half = 32; ti = 16 + (q & 31); }
            else { const int q = p - 416; col = PC_DIQ + (q >> 4) * 32 + (q & 15); half = 16; ti = q & 15; }
            const f32x2 cs = tab[ti]; const float x1 = bf2f(row[col]), x2 = bf2f(row[col + half]);
            if (!dry || pos < -1.0f) { row[col] = f2bf(x1 * cs.x - x2 * cs.y); row[col + half] = f2bf(x2 * cs.x + x1 * cs.y); }
        }
        __builtin_amdgcn_wave_barrier();
    }
    { LAS unsigned* km = (LAS unsigned*)(C.lds + 8192);
      __syncthreads();
      if (C.tid < 4) km[C.tid] = 0u;
      __syncthreads();
      if (C.lane < 4) { float v = 0.f;
#pragma unroll
          for (int q = 0; q < 4; ++q) v = (C.lane == q) ? kmx[q] : v;
          __hip_atomic_fetch_max(km + C.lane, __float_as_uint(v), __ATOMIC_RELAXED, __HIP_MEMORY_SCOPE_WORKGROUP); }
      __syncthreads();
      if (C.tid < 4 && !dry) atomicMax(wsp<unsigned>(P, WS_CTL) + CW_KMAX + 8 * l + C.tid, (unsigned)km[C.tid]);
      __syncthreads(); }
}
DI void sm_step(f32x16& st, const float c, float& m, float& l, f32x16& O0, f32x16& O1, bf16x8& p0, bf16x8& p1) {
    float mx = st[0];
#pragma unroll
    for (int i = 1; i < 16; ++i) mx = fmaxf(mx, st[i]);
    mx = fmaxf(mx, __shfl_xor(mx, 32));
    if (__any(mx > m)) { const float mn = fmaxf(m, mx); const float a = __builtin_amdgcn_exp2f((m - mn) * c); l *= a;
#pragma unroll
        for (int i = 0; i < 16; ++i) { O0[i] *= a; O1[i] *= a; }
        m = mn; }
    const float mc = m * c; float rs = 0.f;
#pragma unroll
    for (int i = 0; i < 16; ++i) { const float p = __builtin_amdgcn_exp2f(fmaf(st[i], c, -mc)); st[i] = p; rs += p; }
    l += rs;
    u32x4 a, b;
    a.x = pk2(st[0], st[1]); a.y = pk2(st[2], st[3]); a.z = pk2(st[4], st[5]); a.w = pk2(st[6], st[7]);
    b.x = pk2(st[8], st[9]); b.y = pk2(st[10], st[11]); b.z = pk2(st[12], st[13]); b.w = pk2(st[14], st[15]);
    p0 = __builtin_bit_cast(bf16x8, a); p1 = __builtin_bit_cast(bf16x8, b);
}
DI void apply_mask(f32x16& st, unsigned vmask) {
#pragma unroll
    for (int i = 0; i < 16; ++i) { const unsigned sel = (unsigned)__builtin_amdgcn_sbfe((int)vmask, i, 1);
        st[i] = __uint_as_float((__float_as_uint(st[i]) & sel) | (__float_as_uint(-3.0e38f) & ~sel)); }
}
DI bf16x8 vt_frag(const bf16_t* vt_row, int k0, int s2, int h) {
    const bf16_t* p = vt_row + k0 + 16 * s2 + 4 * h; const u32x2 lo = *(const u32x2*)p, hi = *(const u32x2*)(p + 8);
    u32x4 w; w.x = lo.x; w.y = lo.y; w.z = hi.x; w.w = hi.y; return __builtin_bit_cast(bf16x8, w);
}
DI unsigned causal_mask(int r, int h) { unsigned m = 0;
#pragma unroll
    for (int i = 0; i < 16; ++i) m |= (crow(i, h) <= r) ? (1u << i) : 0u;
    return m; }
DI void causal_wave_unit(int c, int w, int& bh, int& qs) { const int pi = c * 4 + (w & 3); bh = (pi >> 6) & 15; const int j = pi & 63; qs = (w < 4) ? 127 - j : j; }

struct DiffKV { bf16x8 kf[2][2]; bf16x8 vf[2][2]; };
DI void diff_load(DiffKV& t, const bf16_t* kbase, const bf16_t* vrow0, const bf16_t* vrow1, int k0, int r, int h) {
    const bf16_t* kp = kbase + (size_t)(k0 + r) * PROJ_LD + 8 * h;
#pragma unroll
    for (int m = 0; m < 2; ++m)
#pragma unroll
        for (int s = 0; s < 2; ++s) t.kf[m][s] = *(const bf16x8*)(kp + m * 32 + 16 * s);
#pragma unroll
    for (int s2 = 0; s2 < 2; ++s2) { t.vf[0][s2] = vt_frag(vrow0, k0, s2, h); t.vf[1][s2] = vt_frag(vrow1, k0, s2, h); }
}
DI void diff_step(const DiffKV& t, const bf16x8 (&qf)[2][2], bool diag, unsigned dmask, const float c, float (&mm)[2], float (&ll)[2], f32x16 (&O)[2][2]) {
#pragma unroll
    for (int m = 0; m < 2; ++m) {
        f32x16 st = mfma32(t.kf[m][0], qf[m][0], zero16()); st = mfma32(t.kf[m][1], qf[m][1], st);
        if (diag) apply_mask(st, dmask);
        bf16x8 p0, p1; sm_step(st, c, mm[m], ll[m], O[m][0], O[m][1], p0, p1);
        O[m][0] = mfma32(t.vf[0][0], p0, O[m][0]); O[m][0] = mfma32(t.vf[0][1], p1, O[m][0]);
        O[m][1] = mfma32(t.vf[1][0], p0, O[m][1]); O[m][1] = mfma32(t.vf[1][1], p1, O[m][1]);
    }
}
DI void diff_attn_wave(const Ctx& C, const Params& P, int l) {
    const bf16_t* PROJ = (const bf16_t*)(P.ws + WS_R1 + R1_PROJ); const bf16_t* VT = (const bf16_t*)(P.ws + WS_R1 + R1_VT); bf16_t* Y = wsp<bf16_t>(P, WS_Y);
    int bh, qs; causal_wave_unit(C.bid, C.wave, bh, qs);
    const int b = bh >> 2, hd = bh & 3, r = C.lane & 31, h = C.lane >> 5, tokb = b * SEQ, q0 = qs * 32, t = q0 + r;
    const float* lv = P.diff_lambda + l * 128;
    const float d1 = wave_sum(C.lane < 32 ? lv[C.lane] * lv[32 + C.lane] : 0.f), d2 = wave_sum(C.lane < 32 ? lv[64 + C.lane] * lv[96 + C.lane] : 0.f);
    const float lam_init = 0.8f - 0.6f * expf(-0.3f * (float)l), lam = expf(d1) - expf(d2) + lam_init;
    bf16x8 qf[2][2];
#pragma unroll
    for (int m = 0; m < 2; ++m)
#pragma unroll
        for (int s = 0; s < 2; ++s) qf[m][s] = *(const bf16x8*)(PROJ + (size_t)(tokb + t) * PROJ_LD + PC_AQ + hd * 64 + m * 32 + 16 * s + 8 * h);
    f32x16 O[2][2]; float mm[2] = {-1e30f, -1e30f}, ll[2] = {0.f, 0.f};
#pragma unroll
    for (int m = 0; m < 2; ++m) { O[m][0] = zero16(); O[m][1] = zero16(); }
    const float c = 0.17677669529663687f * 1.4426950408889634f;
    const int nkt = qs + 1; const unsigned dmask = causal_mask(r, h);
    const bf16_t* kbase = PROJ + (size_t)tokb * PROJ_LD + PC_AK + hd * 64;
    const bf16_t* vrow0 = VT + (size_t)(hd * 64 + r) * NTOK + tokb; const bf16_t* vrow1 = vrow0 + (size_t)32 * NTOK;
    DiffKV ta, tb; diff_load(ta, kbase, vrow0, vrow1, 0, r, h);
    for (int kt = 0; kt < nkt; kt += 2) {
        if (kt + 1 < nkt) diff_load(tb, kbase, vrow0, vrow1, (kt + 1) * 32, r, h);
        diff_step(ta, qf, kt == nkt - 1, dmask, c, mm, ll, O);
        if (kt + 1 < nkt) { if (kt + 2 < nkt) diff_load(ta, kbase, vrow0, vrow1, (kt + 2) * 32, r, h);
            diff_step(tb, qf, kt + 1 == nkt - 1, dmask, c, mm, ll, O); }
    }
    ll[0] += __shfl_xor(ll[0], 32); ll[1] += __shfl_xor(ll[1], 32);
    const float i0 = 1.0f / ll[0], i1 = lam / ll[1]; float ss = 0.f;
#pragma unroll
    for (int et = 0; et < 2; ++et)
#pragma unroll
        for (int i = 0; i < 16; ++i) { const float o = O[0][et][i] * i0 - O[1][et][i] * i1; O[0][et][i] = o; ss += o * o; }
    ss += __shfl_xor(ss, 32);
    const float rn = (1.0f - lam_init) / sqrtf(ss * (1.0f / 64.0f) + 1e-6f);
    bf16_t* yrow = Y + (size_t)(tokb + t) * DM + hd * 64;
#pragma unroll
    for (int et = 0; et < 2; ++et)
#pragma unroll
        for (int g = 0; g < 4; ++g) { u32x2 w; w.x = pk2(O[0][et][4 * g] * rn, O[0][et][4 * g + 1] * rn); w.y = pk2(O[0][et][4 * g + 2] * rn, O[0][et][4 * g + 3] * rn);
            *(u32x2*)(yrow + et * 32 + 8 * g + 4 * h) = w; }
}

struct KV64 { bf16x8 kf[4]; bf16x8 vf[2][2]; };
DI void kv64_load(KV64& t, const bf16_t* kbase, int kld, const bf16_t* vrow0, const bf16_t* vrow1, int k0, int r, int h) {
    const bf16_t* kp = kbase + (size_t)(k0 + r) * kld + 8 * h;
#pragma unroll
    for (int s = 0; s < 4; ++s) t.kf[s] = *(const bf16x8*)(kp + 16 * s);
#pragma unroll
    for (int s2 = 0; s2 < 2; ++s2) { t.vf[0][s2] = vt_frag(vrow0, k0, s2, h); t.vf[1][s2] = vt_frag(vrow1, k0, s2, h); }
}
DI void kv64_step(const KV64& t, const bf16x8 (&qf)[4], bool masked, unsigned vmask, const float c, float& mm, float& ll, f32x16 (&O)[2]) {
    f32x16 st = zero16();
#pragma unroll
    for (int s = 0; s < 4; ++s) st = mfma32(t.kf[s], qf[s], st);
    if (masked) apply_mask(st, vmask);
    bf16x8 p0, p1; sm_step(st, c, mm, ll, O[0], O[1], p0, p1);
    O[0] = mfma32(t.vf[0][0], p0, O[0]); O[0] = mfma32(t.vf[0][1], p1, O[0]);
    O[1] = mfma32(t.vf[1][0], p0, O[1]); O[1] = mfma32(t.vf[1][1], p1, O[1]);
}
DI void mem_attn_wave(const Ctx& C, const Params& P, int l) {
    const bf16_t* MQ = (const bf16_t*)(P.ws + WS_R1 + R1_MQ); bf16_t* MO = (bf16_t*)(P.ws + WS_R1 + R1_MO);
    const bf16_t* MK = wsp<bf16_t>(P, WS_MK) + (size_t)l * 1024 * 256; const bf16_t* MVT = wsp<bf16_t>(P, WS_MVT) + (size_t)l * 256 * 1024;
    const int r = C.lane & 31, h = C.lane >> 5;
    for (int wu = C.bid * NWAVES + C.wave; wu < 2048; wu += C.G * NWAVES) {
        const int bh = wu >> 7, qs = wu & 127, b = bh >> 2, hd = bh & 3, t = b * SEQ + qs * 32 + r;
        bf16x8 qf[4];
#pragma unroll
        for (int s = 0; s < 4; ++s) qf[s] = *(const bf16x8*)(MQ + (size_t)t * 256 + hd * 64 + 16 * s + 8 * h);
        f32x16 O[2] = {zero16(), zero16()}; float mm = -1e30f, ll = 0.f;
        const float c = 0.125f * 1.4426950408889634f;
        const bf16_t* kbase = MK + (size_t)(b * 256) * 256 + hd * 64;
        const bf16_t* vrow0 = MVT + (size_t)(hd * 64 + r) * 1024 + b * 256; const bf16_t* vrow1 = vrow0 + (size_t)32 * 1024;
        KV64 ta, tb; kv64_load(ta, kbase, 256, vrow0, vrow1, 0, r, h);
#pragma unroll 1
        for (int kt = 0; kt < 8; kt += 2) {
            kv64_load(tb, kbase, 256, vrow0, vrow1, (kt + 1) * 32, r, h);
            kv64_step(ta, qf, false, 0u, c, mm, ll, O);
            if (kt + 2 < 8) kv64_load(ta, kbase, 256, vrow0, vrow1, (kt + 2) * 32, r, h);
            kv64_step(tb, qf, false, 0u, c, mm, ll, O);
        }
        ll += __shfl_xor(ll, 32);
        const float il = 1.0f / ll; bf16_t* orow = MO + (size_t)t * 256 + hd * 64;
#pragma unroll
        for (int et = 0; et < 2; ++et)
#pragma unroll
            for (int g = 0; g < 4; ++g) { u32x2 w; w.x = pk2(O[et][4 * g] * il, O[et][4 * g + 1] * il); w.y = pk2(O[et][4 * g + 2] * il, O[et][4 * g + 3] * il);
                *(u32x2*)(orow + et * 32 + 8 * g + 4 * h) = w; }
    }
}

DI f32x16 idx_score(const bf16x8 (&ikf)[2], const bf16x8 (&iqf)[4][2], const float (&iw)[4]) {
    f32x16 a[4];
#pragma unroll
    for (int hh = 0; hh < 4; ++hh) a[hh] = mfma32(ikf[0], iqf[hh][0], zero16());
#pragma unroll
    for (int hh = 0; hh < 4; ++hh) a[hh] = mfma32(ikf[1], iqf[hh][1], a[hh]);
    f32x16 sc = zero16();
#pragma unroll
    for (int hh = 0; hh < 4; ++hh) {
#pragma unroll
        for (int i = 0; i < 16; ++i) { const int ab = (int)__float_as_uint(a[hh][i]); const float rl = __uint_as_float((unsigned)(ab > 0 ? ab : 0));
            sc[i] = fmaf(iw[hh], rl, sc[i]); } }
    return sc;
}
DI unsigned okey_of(float f) { const unsigned u = __float_as_uint(f); return u ^ ((unsigned)((int)u >> 31) | 0x80000000u); }
DI void load_idx_q(const bf16_t* PROJ, size_t tok, int h, bf16x8 (&iqf)[4][2], float (&iw)[4]) {
    const bf16_t* row = PROJ + tok * PROJ_LD;
#pragma unroll
    for (int hh = 0; hh < 4; ++hh) {
#pragma unroll
        for (int s = 0; s < 2; ++s) iqf[hh][s] = *(const bf16x8*)(row + PC_DIQ + hh * 32 + 16 * s + 8 * h);
        iw[hh] = bf2f(row[PC_DIW + hh]) * 0.08838834764831845f; }
}

template <int PASS> DI void d1_digit(unsigned ok, unsigned sinv, unsigned mv, unsigned mb, bool& match, unsigned& dg) {
    if constexpr (PASS == 0) { match = true; dg = ok >> 21; }
    else if constexpr (PASS == 1) { match = (ok >> 21) == mv; dg = (ok >> 10) & 2047u; }
    else if constexpr (PASS == 2) { match = (ok >> 10) == mv; dg = ((ok & 1023u) << 1) | (sinv >> 11); }
    else { match = (ok == mv) && ((sinv >> 11) == mb); dg = sinv & 2047u; }
}
constexpr int D1_HSTRIDE = 1025;
DI unsigned lin_bin(float sc, float lin_a, float lin_b) { return (unsigned)__builtin_amdgcn_fmed3f(fmaf(sc, lin_a, lin_b), 0.f, 2047.f); }
template <int PASS> DI void d1_pass(const Ctx& C, const bf16_t* PROJ, int tokb, int q0, int nkt, const bf16x8 (&iqf)[4][2], const float (&iw)[4], LAS unsigned* hist, volatile LAS unsigned* QS, const float lin_a = 0.f, const float lin_b = 0.f) {
    const int r = C.lane & 31, h = C.lane >> 5;
    const unsigned mv = QS[r * 4 + 0], mb = QS[r * 4 + 1];
    LAS unsigned* hrow = hist + r * D1_HSTRIDE;
    const bf16_t* kp0 = PROJ + (size_t)(tokb + r) * PROJ_LD + PC_DIK + 8 * h;
    bf16x8 ikf[2], ikn[2];
    if (C.wave < nkt) { const bf16_t* kp = kp0 + (size_t)(C.wave * 32) * PROJ_LD; ikf[0] = *(const bf16x8*)kp; ikf[1] = *(const bf16x8*)(kp + 16); }
    for (int kt = C.wave; kt < nkt; kt += NWAVES) {
        const int k0 = kt * 32;
        { const int ktn = (kt + NWAVES < nkt) ? kt + NWAVES : kt;
          const bf16_t* kp = kp0 + (size_t)(ktn * 32) * PROJ_LD; ikn[0] = *(const bf16x8*)kp; ikn[1] = *(const bf16x8*)(kp + 16); }
        const f32x16 sc = idx_score(ikf, iqf, iw);
        const bool diag = (kt == nkt - 1);
        unsigned wadr[16], wval[16]; bool any_m = false;
#pragma unroll
        for (int i = 0; i < 16; ++i) { const unsigned ok = okey_of(sc[i]), sinv = 4095u - (unsigned)(k0 + crow(i, h));
            bool match; unsigned dg;
            if constexpr (PASS == 4) { match = true; dg = lin_bin(sc[i], lin_a, lin_b); } else d1_digit<PASS>(ok, sinv, mv, mb, match, dg);
            if (diag) match = match && (crow(i, h) <= r);
            wadr[i] = match ? (dg >> 1) : 1024u;
            wval[i] = match ? (1u << ((dg & 1u) * 16u)) : 0u; any_m = any_m || match; }
        if (PASS == 0 || PASS == 4 || __any(any_m)) {
#pragma unroll
            for (int i = 0; i < 16; ++i) __hip_atomic_fetch_add(hrow + wadr[i], wval[i], __ATOMIC_RELAXED, __HIP_MEMORY_SCOPE_WORKGROUP);
        }
        ikf[0] = ikn[0]; ikf[1] = ikn[1];
    }
    __syncthreads();
    for (int srep = ((PROBE_DUP & 32768) ? 0 : 1); srep < 2; ++srep)
    for (int qq = 0; qq < 4; ++qq) {
        const int q = C.wave * 4 + qq; const unsigned rk = QS[q * 4 + 2];
        unsigned lsum = 0;
#pragma unroll
        for (int j = 0; j < 16; ++j) { const unsigned wj = hist[q * D1_HSTRIDE + C.lane * 16 + j]; lsum += (wj & 0xffffu) + (wj >> 16); }
        unsigned x = lsum;
#pragma unroll
        for (int o = 1; o < 64; o <<= 1) { const unsigned y = __shfl_down(x, o); if (C.lane + o < 64) x += y; }
        const unsigned above = x - lsum;
        const bool hit = (above < rk) && (rk <= x);
        const unsigned long long bal = __ballot(hit); const int L = bal ? (__ffsll((long long)bal) - 1) : 0;
        const unsigned aboveL = __shfl(above, L);
        const unsigned bk = (C.lane < 32) ? (unsigned)((const LAS unsigned short*)hist)[q * (2 * D1_HSTRIDE) + L * 32 + C.lane] : 0u;
        unsigned y2 = bk;
#pragma unroll
        for (int o = 1; o < 32; o <<= 1) { const unsigned z = __shfl_down(y2, o); if (C.lane + o < 32) y2 += z; }
        const unsigned ab2 = aboveL + y2 - bk;
        const bool hit2 = (C.lane < 32) && (ab2 < rk) && (rk <= ab2 + bk);
        const unsigned long long bal2 = __ballot(hit2); const int K2 = bal2 ? (__ffsll((long long)bal2) - 1) : 0;
        unsigned bin = (unsigned)(L * 32 + K2), rnew = rk - __shfl(ab2, K2);
        if (C.lane == 0 && srep == 1) {
            const unsigned omv = QS[q * 4 + 0];
            if constexpr (PASS == 0 || PASS == 4) { QS[q * 4 + 0] = bin; }
            else if constexpr (PASS == 1) { QS[q * 4 + 0] = (omv << 11) | bin; }
            else if constexpr (PASS == 2) { QS[q * 4 + 0] = (omv << 10) | (bin >> 1); QS[q * 4 + 1] = bin & 1u; }
            else { QS[q * 4 + 3] = bin; }
            QS[q * 4 + 2] = rnew;
        }
    }
    __syncthreads();
    if constexpr (PASS == 1 || PASS == 2) { for (int crep = 0; crep < ((PROBE_DUP & 65536) ? 2 : 1); ++crep) { for (int i = C.tid; i < 32 * D1_HSTRIDE; i += NTHREADS) hist[i] = 0u; __syncthreads(); } }
}
DI void dsa_select_unit(const Ctx& C, const Params& P, int l, int u) {
    const bf16_t* PROJ = (const bf16_t*)(P.ws + WS_R1 + R1_PROJ); unsigned short* MASK = wsp<unsigned short>(P, WS_MASK);
    const int qt = 127 - (u >> 2), b = u & 3, tokb = b * SEQ, q0 = qt * 32;
    unsigned short* mrow = MASK + ((size_t)(b * 128 + qt) * 128) * 64 + C.lane;
    if (q0 + 31 < 256) {
        for (int kt = C.wave; kt <= qt; kt += NWAVES) mrow[(size_t)kt * 64] = (unsigned short)((kt == qt) ? causal_mask(C.lane & 31, C.lane >> 5) : 0xffffu);
        return; }
    LAS unsigned* hist = (LAS unsigned*)C.lds; volatile LAS unsigned* QS = (volatile LAS unsigned*)(C.lds + 32 * D1_HSTRIDE * 4);
    for (int i = C.tid; i < 32 * D1_HSTRIDE; i += NTHREADS) hist[i] = 0u;
    if (C.tid < 32) { QS[C.tid * 4 + 0] = 0u; QS[C.tid * 4 + 1] = 0u; QS[C.tid * 4 + 2] = 256u; QS[C.tid * 4 + 3] = 0u; }
    __syncthreads();
    const int r = C.lane & 31, h = C.lane >> 5;
    bf16x8 iqf[4][2]; float iw[4]; load_idx_q(PROJ, (size_t)(tokb + q0 + r), h, iqf, iw);
    const int nkt = qt + 1;
    float lin_a, lin_b;
    { const float kmax = sqrtf(__uint_as_float(wsp<unsigned>(P, WS_CTL)[CW_KMAX + 8 * l + b]));
      float hi = 0.f, lo = 0.f;
#pragma unroll
      for (int hh = 0; hh < 4; ++hh) { float n2 = 0.f;
#pragma unroll
          for (int s2 = 0; s2 < 2; ++s2) { const u32x4 w = __builtin_bit_cast(u32x4, iqf[hh][s2]);
#pragma unroll
              for (int j = 0; j < 4; ++j) { const float x0 = bflo(w[j]), x1 = bfhi(w[j]); n2 += x0 * x0 + x1 * x1; } }
          n2 += __shfl_xor(n2, 32); const float bnd = 0.5f * kmax * fabsf(iw[hh]) * sqrtf(n2);
          if (iw[hh] > 0.f) hi += bnd; else lo -= bnd; }
      const float span = hi - lo; lin_a = span > 0.f ? 2047.0f / span : 0.f; lin_b = -lo * lin_a; }
    d1_pass<4>(C, PROJ, tokb, q0, nkt, iqf, iw, hist, QS, lin_a, lin_b);
    constexpr int CCAP = 384;
    LAS unsigned long long* CAND = (LAS unsigned long long*)C.lds;
    LAS unsigned short* LM = (LAS unsigned short*)(C.lds + 98304);
    LAS unsigned* ZBM = (LAS unsigned*)(C.lds + 114688);
    LAS unsigned* ccnt = (LAS unsigned*)(C.lds + 32 * D1_HSTRIDE * 4 + 512);
    if (C.tid < 33) ccnt[C.tid] = 0u;
    __syncthreads();
    {
        const unsigned b0 = QS[r * 4 + 0];
        const bf16_t* kp0 = PROJ + (size_t)(tokb + r) * PROJ_LD + PC_DIK + 8 * h;
        bf16x8 ikf[2], ikn[2];
        if (C.wave < nkt) { const bf16_t* kp = kp0 + (size_t)(C.wave * 32) * PROJ_LD; ikf[0] = *(const bf16x8*)kp; ikf[1] = *(const bf16x8*)(kp + 16); }
        for (int kt = C.wave; kt < nkt; kt += NWAVES) {
            const int k0 = kt * 32;
            { const int ktn = (kt + NWAVES < nkt) ? kt + NWAVES : kt;
              const bf16_t* kp = kp0 + (size_t)(ktn * 32) * PROJ_LD; ikn[0] = *(const bf16x8*)kp; ikn[1] = *(const bf16x8*)(kp + 16); }
            const f32x16 sc = idx_score(ikf, iqf, iw);
            const bool diag = (kt == nkt - 1);
            unsigned above = 0, cand = 0, zer = 0;
#pragma unroll
            for (int i = 0; i < 16; ++i) { const unsigned d0 = lin_bin(sc[i], lin_a, lin_b); const bool ok_c = !diag || (crow(i, h) <= r);
                const bool inb = ok_c && d0 == b0, isz = sc[i] == 0.0f;
                above |= (ok_c && d0 > b0) ? (1u << i) : 0u; cand |= (inb && !isz) ? (1u << i) : 0u; zer |= (inb && isz) ? (1u << i) : 0u; }
            LM[kt * 64 + C.lane] = (unsigned short)above;
            { unsigned kw = 0;
#pragma unroll
              for (int g = 0; g < 4; ++g) kw |= ((zer >> (4 * g)) & 0xfu) << (8 * g + 4 * h);
              kw |= __shfl_xor(kw, 32);
              if (h == 0) ZBM[r * 128 + kt] = kw; }
            if (__any(cand != 0u)) {
                const unsigned nc = (unsigned)__popc(cand);
                unsigned pos = nc ? __hip_atomic_fetch_add(ccnt + r, nc, __ATOMIC_RELAXED, __HIP_MEMORY_SCOPE_WORKGROUP) : 0u;
#pragma unroll
                for (int i = 0; i < 16; ++i) { const bool on = (cand >> i) & 1u;
                    if (on && pos < (unsigned)CCAP) CAND[r * CCAP + pos] = ((unsigned long long)okey_of(sc[i]) << 12) | (unsigned long long)(4095 - (k0 + crow(i, h)));
                    pos += on ? 1u : 0u; }
            }
            ikf[0] = ikn[0]; ikf[1] = ikn[1];
        }
    }
    __syncthreads();
    if (C.tid < 32 && ccnt[C.tid] > (unsigned)CCAP) ccnt[32] = 1u;
    __syncthreads();
    if (ccnt[32] == 0u || (PROBE_DUP & 16384)) {
        const unsigned long long ZK = 0x80000000ull << 12;
        for (int qq = 0; qq < 4; ++qq) {
            const int q = C.wave * 4 + qq; const unsigned n = ccnt[q]; unsigned rk = QS[q * 4 + 2];
            unsigned long long cv[6];
#pragma unroll
            for (int j = 0; j < 6; ++j) { const unsigned idx = (unsigned)C.lane + 64u * j; cv[j] = (idx < n) ? CAND[q * CCAP + idx] : 0ull; }
            unsigned z0 = (2 * C.lane < nkt) ? ZBM[q * 128 + 2 * C.lane] : 0u, z1 = (2 * C.lane + 1 < nkt) ? ZBM[q * 128 + 2 * C.lane + 1] : 0u;
            unsigned Pc = 0, Zc;
#pragma unroll
            for (int j = 0; j < 6; ++j) Pc += (unsigned)__popcll(__ballot(cv[j] >= ZK + 4096ull));
            { unsigned zc = (unsigned)(__popc(z0) + __popc(z1)); Zc = zc;
#pragma unroll
              for (int o = 32; o > 0; o >>= 1) Zc += __shfl_xor(Zc, o); }
            unsigned long long thr;
            unsigned mz = 0;
            if (rk <= Pc || rk > Pc + Zc) {
                if (rk > Pc + Zc) { mz = Zc; }
                const bool neg = rk > Pc + Zc; const unsigned rk2 = neg ? rk - Zc : rk;
                unsigned long long cur = 0ull;
                if (n <= 64u) {
                    for (int bit = 43; bit >= 0; --bit) { const unsigned long long T = cur | (1ull << bit); if ((unsigned)__popcll(__ballot(cv[0] != 0ull && cv[0] >= T)) >= rk2) cur = T; }
                } else {
                    for (int bit = 43; bit >= 0; --bit) { const unsigned long long T = cur | (1ull << bit); unsigned cnt = 0;
#pragma unroll
                        for (int j = 0; j < 6; ++j) cnt += (unsigned)__popcll(__ballot(cv[j] != 0ull && cv[j] >= T));
                        if (cnt >= rk2) cur = T; }
                }
                thr = cur;
            } else { thr = ZK + 4096ull; mz = rk - Pc; }
#pragma unroll
            for (int j = 0; j < 6; ++j) {
                if (cv[j] != 0ull && cv[j] >= thr) { const int key = 4095 - (int)(cv[j] & 4095ull), kt = key >> 5, kk = key & 31, hh = (kk >> 2) & 1, ii = (kk & 3) + 4 * (kk >> 3);
                    const int w16 = kt * 64 + q + 32 * hh;
                    __hip_atomic_fetch_or((LAS unsigned*)LM + (w16 >> 1), 1u << (16 * (w16 & 1) + ii), __ATOMIC_RELAXED, __HIP_MEMORY_SCOPE_WORKGROUP); } }
            if (mz > 0u) {
                const unsigned c0 = (unsigned)__popc(z0), c1 = (unsigned)__popc(z1); unsigned incl = c0 + c1;
#pragma unroll
                for (int o = 1; o < 64; o <<= 1) { const unsigned y = __shfl_up(incl, o); if (C.lane >= o) incl += y; }
                unsigned before = incl - (c0 + c1);
                unsigned need0 = (before >= mz) ? 0u : ((mz - before) < c0 ? (mz - before) : c0);
                while ((unsigned)__popc(z0) > need0) z0 &= ~(0x80000000u >> __clz(z0));
                before += c0;
                unsigned need1 = (before >= mz) ? 0u : ((mz - before) < c1 ? (mz - before) : c1);
                while ((unsigned)__popc(z1) > need1) z1 &= ~(0x80000000u >> __clz(z1));
#pragma unroll
                for (int tz = 0; tz < 2; ++tz) { const unsigned zw = tz ? z1 : z0; const int kt = 2 * C.lane + tz;
                    if (zw) {
#pragma unroll
                        for (int hh = 0; hh < 2; ++hh) { unsigned m16 = 0;
#pragma unroll
                            for (int g = 0; g < 4; ++g) m16 |= ((zw >> (8 * g + 4 * hh)) & 0xfu) << (4 * g);
                            const int w16 = kt * 64 + q + 32 * hh;
                            if (m16) __hip_atomic_fetch_or((LAS unsigned*)LM + (w16 >> 1), m16 << (16 * (w16 & 1)), __ATOMIC_RELAXED, __HIP_MEMORY_SCOPE_WORKGROUP); } } }
            }
        }
        __syncthreads();
        { const LAS unsigned* src = (const LAS unsigned*)LM; unsigned* dst = (unsigned*)(MASK + ((size_t)(b * 128 + qt) * 128) * 64);
          for (int i = C.tid; i < nkt * 32; i += NTHREADS) dst[i] = src[i]; }
        __syncthreads();
        return;
    }
    for (int i = C.tid; i < 32 * D1_HSTRIDE; i += NTHREADS) hist[i] = 0u;
    if (C.tid < 32) { QS[C.tid * 4 + 0] = 0u; QS[C.tid * 4 + 1] = 0u; QS[C.tid * 4 + 2] = 256u; QS[C.tid * 4 + 3] = 0u; }
    __syncthreads();
    d1_pass<0>(C, PROJ, tokb, q0, nkt, iqf, iw, hist, QS);
    for (int i = C.tid; i < 32 * D1_HSTRIDE; i += NTHREADS) hist[i] = 0u;
    __syncthreads();
    d1_pass<1>(C, PROJ, tokb, q0, nkt, iqf, iw, hist, QS);
    d1_pass<2>(C, PROJ, tokb, q0, nkt, iqf, iw, hist, QS);
    d1_pass<3>(C, PROJ, tokb, q0, nkt, iqf, iw, hist, QS);
    {
      const unsigned long long theta = ((unsigned long long)QS[r * 4 + 0] << 12) | ((unsigned long long)QS[r * 4 + 1] << 11) | QS[r * 4 + 3];
      for (int rep = 0; rep < ((PROBE_DUP & 4096) ? 2 : 1); ++rep)
      for (int kt = C.wave; kt < nkt; kt += NWAVES) {
          const int k0 = kt * 32; bf16x8 ikf[2];
          const bf16_t* kp = PROJ + (size_t)(tokb + k0 + r) * PROJ_LD + PC_DIK + 8 * h;
          ikf[0] = *(const bf16x8*)kp; ikf[1] = *(const bf16x8*)(kp + 16);
          const f32x16 sc = idx_score(ikf, iqf, iw);
          unsigned vmask = 0;
#pragma unroll
          for (int i = 0; i < 16; ++i) { const int key = k0 + crow(i, h); const unsigned long long comp = ((unsigned long long)okey_of(sc[i]) << 12) | (unsigned long long)(4095 - key);
              vmask |= (key <= q0 + r && comp >= theta) ? (1u << i) : 0u; }
          mrow[(size_t)kt * 64] = (unsigned short)vmask; } }
    __syncthreads();
}

DI void dsa_attn_wave(const Ctx& C, const Params& P) {
    const bf16_t* PROJ = (const bf16_t*)(P.ws + WS_R1 + R1_PROJ); const bf16_t* VT = (const bf16_t*)(P.ws + WS_R1 + R1_VT); bf16_t* Y = wsp<bf16_t>(P, WS_Y);
    const unsigned short* MASK = wsp<unsigned short>(P, WS_MASK);
    int bh, qs; causal_wave_unit(C.bid, C.wave, bh, qs);
    const int b = bh >> 2, hd = bh & 3, r = C.lane & 31, h = C.lane >> 5, tokb = b * SEQ, q0 = qs * 32, t = q0 + r;
    bf16x8 qf[4];
#pragma unroll
    for (int s = 0; s < 4; ++s) qf[s] = *(const bf16x8*)(PROJ + (size_t)(tokb + t) * PROJ_LD + PC_DQ + hd * 64 + 16 * s + 8 * h);
    f32x16 O[2] = {zero16(), zero16()}; float mm = -1e30f, ll = 0.f;
    const float c = 0.125f * 1.4426950408889634f;
    const int nkt = qs + 1;
    const bf16_t* kbase = PROJ + (size_t)tokb * PROJ_LD + PC_DK;
    const bf16_t* vrow0 = VT + (size_t)(256 + r) * NTOK + tokb; const bf16_t* vrow1 = vrow0 + (size_t)32 * NTOK;
    const unsigned short* mrow = MASK + ((size_t)(b * 128 + qs) * 128) * 64 + C.lane;
    KV64 ta, tb; unsigned ma, mb;
    kv64_load(ta, kbase, PROJ_LD, vrow0, vrow1, 0, r, h); ma = mrow[0];
    for (int kt = 0; kt < nkt; kt += 2) {
        if (kt + 1 < nkt) { kv64_load(tb, kbase, PROJ_LD, vrow0, vrow1, (kt + 1) * 32, r, h); mb = mrow[(size_t)(kt + 1) * 64]; }
        kv64_step(ta, qf, true, ma, c, mm, ll, O);
        if (kt + 1 < nkt) { if (kt + 2 < nkt) { kv64_load(ta, kbase, PROJ_LD, vrow0, vrow1, (kt + 2) * 32, r, h); ma = mrow[(size_t)(kt + 2) * 64]; }
            kv64_step(tb, qf, true, mb, c, mm, ll, O); }
    }
    ll += __shfl_xor(ll, 32);
    const float il = 1.0f / ll; bf16_t* yrow = Y + (size_t)(tokb + t) * DM + 768 + hd * 64;
#pragma unroll
    for (int et = 0; et < 2; ++et)
#pragma unroll
        for (int g = 0; g < 4; ++g) { u32x2 w; w.x = pk2(O[et][4 * g] * il, O[et][4 * g + 1] * il); w.y = pk2(O[et][4 * g + 2] * il, O[et][4 * g + 3] * il);
            *(u32x2*)(yrow + et * 32 + 8 * g + 4 * h) = w; }
}

constexpr int CA_KB = 64 * 144, CA_VB = 64 * 136, CA_BUF = CA_KB + CA_VB;
template <bool DIFF>
DI void causal_attn_block(const Ctx& C, const Params& P, int l) {
    const bf16_t* PROJ = (const bf16_t*)(P.ws + WS_R1 + R1_PROJ); const bf16_t* VT = (const bf16_t*)(P.ws + WS_R1 + R1_VT); bf16_t* Y = wsp<bf16_t>(P, WS_Y);
    const unsigned short* MASK = wsp<unsigned short>(P, WS_MASK);
    const int bh = (C.bid >> 4) & 15, g = C.bid & 15, j0 = 4 * g, b = bh >> 2, hd = bh & 3, tokb = b * SEQ;
#if (PROBE_DUP & 262144)
    const int qs = ((C.wave & 1) == 0) ? 127 - (j0 + (C.wave >> 1)) : j0 + (C.wave >> 1);
#else
    const int qs = (C.wave < 4) ? 127 - (j0 + C.wave) : j0 + (C.wave - 4);
#endif
    const int r = C.lane & 31, h = C.lane >> 5, q0 = qs * 32, t = q0 + r;
    const int nsub = qs + 1, NT = (128 - j0 + 1) >> 1;
    const int kcol = DIFF ? PC_AK + hd * 64 : PC_DK, vrb = DIFF ? hd * 64 : 256;
    const int srow = C.tid >> 3, sch = C.tid & 7;
    const bf16_t* kg = PROJ + (size_t)(tokb + srow) * PROJ_LD + kcol + sch * 8;
    const bf16_t* vg = VT + (size_t)(vrb + srow) * NTOK + tokb + sch * 8;
    LAS unsigned char* kdst = C.lds + srow * 144 + sch * 16; LAS unsigned char* vdst = C.lds + CA_KB + srow * 136 + sch * 16;
    bf16x8 qfd[2][2], qf4[4];
    if constexpr (DIFF) {
#pragma unroll
        for (int m = 0; m < 2; ++m)
#pragma unroll
            for (int s = 0; s < 2; ++s) qfd[m][s] = *(const bf16x8*)(PROJ + (size_t)(tokb + t) * PROJ_LD + PC_AQ + hd * 64 + m * 32 + 16 * s + 8 * h);
    } else {
#pragma unroll
        for (int s = 0; s < 4; ++s) qf4[s] = *(const bf16x8*)(PROJ + (size_t)(tokb + t) * PROJ_LD + PC_DQ + hd * 64 + 16 * s + 8 * h);
    }
    f32x16 O[2][2]; float mm[2] = {-1e30f, -1e30f}, ll[2] = {0.f, 0.f};
#pragma unroll
    for (int m = 0; m < 2; ++m) { O[m][0] = zero16(); O[m][1] = zero16(); }
    const float c = (DIFF ? 0.17677669529663687f : 0.125f) * 1.4426950408889634f;
    const unsigned dmask = causal_mask(r, h);
    const unsigned short* mrow = MASK + ((size_t)(b * 128 + qs) * 128) * 64 + C.lane;
    u32x4 kreg = *(const u32x4*)kg, vreg = *(const u32x4*)vg, kr2, vr2;
    unsigned mcur[2] = {0u, 0u}, mnxt[2] = {0u, 0u}, mn2[2] = {0u, 0u};
    if constexpr (!DIFF) { mcur[0] = mrow[0]; if (1 < nsub) mcur[1] = mrow[64]; if (2 < nsub) mnxt[0] = mrow[128]; if (3 < nsub) mnxt[1] = mrow[192]; }
    *(LAS u32x4*)kdst = kreg; *(LAS u32x2*)vdst = (u32x2){vreg.x, vreg.y}; *(LAS u32x2*)(vdst + 8) = (u32x2){vreg.z, vreg.w};
    if (1 < NT) { kreg = *(const u32x4*)(kg + (size_t)64 * PROJ_LD); vreg = *(const u32x4*)(vg + 64); }
    __syncthreads();
    for (int T = 0; T < NT; ++T) {
        const int cur = T & 1;
        if (T + 2 < NT) { kr2 = *(const u32x4*)(kg + (size_t)(T + 2) * 64 * PROJ_LD); vr2 = *(const u32x4*)(vg + (T + 2) * 64);
            if constexpr (!DIFF) { if (2 * T + 4 < nsub) mn2[0] = mrow[(size_t)(2 * T + 4) * 64]; if (2 * T + 5 < nsub) mn2[1] = mrow[(size_t)(2 * T + 5) * 64]; } }
        const LAS unsigned char* KB = C.lds + cur * CA_BUF; const LAS unsigned char* VB = KB + CA_KB;
#pragma unroll
        for (int sub = 0; sub < 2; ++sub) {
            const int st = 2 * T + sub;
            if (st < nsub) {
                const LAS unsigned char* krow = KB + (sub * 32 + r) * 144 + h * 16;
                const LAS unsigned char* v0 = VB + r * 136 + (sub * 32 + 4 * h) * 2; const LAS unsigned char* v1 = v0 + 32 * 136;
                if constexpr (DIFF) {
                    DiffKV tl;
#pragma unroll
                    for (int m = 0; m < 2; ++m)
#pragma unroll
                        for (int s = 0; s < 2; ++s) tl.kf[m][s] = *(const LAS bf16x8*)(krow + m * 64 + s * 32);
#pragma unroll
                    for (int s2 = 0; s2 < 2; ++s2) {
                        { const u32x2 lo = *(const LAS u32x2*)(v0 + s2 * 32), hi = *(const LAS u32x2*)(v0 + s2 * 32 + 16); u32x4 w; w.x = lo.x; w.y = lo.y; w.z = hi.x; w.w = hi.y; tl.vf[0][s2] = __builtin_bit_cast(bf16x8, w); }
                        { const u32x2 lo = *(const LAS u32x2*)(v1 + s2 * 32), hi = *(const LAS u32x2*)(v1 + s2 * 32 + 16); u32x4 w; w.x = lo.x; w.y = lo.y; w.z = hi.x; w.w = hi.y; tl.vf[1][s2] = __builtin_bit_cast(bf16x8, w); } }
                    diff_step(tl, qfd, st == nsub - 1, dmask, c, mm, ll, O);
                } else {
                    KV64 tl; const unsigned vm = mcur[sub];
#pragma unroll
                    for (int s = 0; s < 4; ++s) tl.kf[s] = *(const LAS bf16x8*)(krow + s * 32);
#pragma unroll
                    for (int s2 = 0; s2 < 2; ++s2) {
                        { const u32x2 lo = *(const LAS u32x2*)(v0 + s2 * 32), hi = *(const LAS u32x2*)(v0 + s2 * 32 + 16); u32x4 w; w.x = lo.x; w.y = lo.y; w.z = hi.x; w.w = hi.y; tl.vf[0][s2] = __builtin_bit_cast(bf16x8, w); }
                        { const u32x2 lo = *(const LAS u32x2*)(v1 + s2 * 32), hi = *(const LAS u32x2*)(v1 + s2 * 32 + 16); u32x4 w; w.x = lo.x; w.y = lo.y; w.z = hi.x; w.w = hi.y; tl.vf[1][s2] = __builtin_bit_cast(bf16x8, w); } }
                    kv64_step(tl, qf4, true, vm, c, mm[0], ll[0], O[0]);
                }
            }
        }
        if (T + 1 < NT) { LAS unsigned char* kd = kdst + (cur ^ 1) * CA_BUF; LAS unsigned char* vd = vdst + (cur ^ 1) * CA_BUF;
            *(LAS u32x4*)kd = kreg; *(LAS u32x2*)vd = (u32x2){vreg.x, vreg.y}; *(LAS u32x2*)(vd + 8) = (u32x2){vreg.z, vreg.w}; }
        kreg = kr2; vreg = vr2; mcur[0] = mnxt[0]; mcur[1] = mnxt[1]; mnxt[0] = mn2[0]; mnxt[1] = mn2[1];
        __syncthreads();
    }
    if constexpr (DIFF) {
        const float* lv = P.diff_lambda + l * 128;
        const float d1 = wave_sum(C.lane < 32 ? lv[C.lane] * lv[32 + C.lane] : 0.f), d2 = wave_sum(C.lane < 32 ? lv[64 + C.lane] * lv[96 + C.lane] : 0.f);
        const float lam_init = 0.8f - 0.6f * expf(-0.3f * (float)l), lam = expf(d1) - expf(d2) + lam_init;
        ll[0] += __shfl_xor(ll[0], 32); ll[1] += __shfl_xor(ll[1], 32);
        const float i0 = 1.0f / ll[0], i1 = lam / ll[1]; float ss = 0.f;
#pragma unroll
        for (int et = 0; et < 2; ++et)
#pragma unroll
            for (int i = 0; i < 16; ++i) { const float o = O[0][et][i] * i0 - O[1][et][i] * i1; O[0][et][i] = o; ss += o * o; }
        ss += __shfl_xor(ss, 32);
        const float rn = (1.0f - lam_init) / sqrtf(ss * (1.0f / 64.0f) + 1e-6f);
        bf16_t* yrow = Y + (size_t)(tokb + t) * DM + hd * 64;
#pragma unroll
        for (int et = 0; et < 2; ++et)
#pragma unroll
            for (int gq = 0; gq < 4; ++gq) { u32x2 w; w.x = pk2(O[0][et][4 * gq] * rn, O[0][et][4 * gq + 1] * rn); w.y = pk2(O[0][et][4 * gq + 2] * rn, O[0][et][4 * gq + 3] * rn);
                *(u32x2*)(yrow + et * 32 + 8 * gq + 4 * h) = w; }
    } else {
        ll[0] += __shfl_xor(ll[0], 32);
        const float il = 1.0f / ll[0]; bf16_t* yrow = Y + (size_t)(tokb + t) * DM + 768 + hd * 64;
#pragma unroll
        for (int et = 0; et < 2; ++et)
#pragma unroll
            for (int gq = 0; gq < 4; ++gq) { u32x2 w; w.x = pk2(O[0][et][4 * gq] * il, O[0][et][4 * gq + 1] * il); w.y = pk2(O[0][et][4 * gq + 2] * il, O[0][et][4 * gq + 3] * il);
                *(u32x2*)(yrow + et * 32 + 8 * gq + 4 * h) = w; }
    }
    __syncthreads();
}

constexpr int CB_KB = 128 * 144, CB_VB = 64 * 264, CB_BUF = CB_KB + CB_VB;
template <bool DIFF>
DI void causal_attn_unit2(const Ctx& C, const Params& P, int l, int bh, int G) {
    const bf16_t* PROJ = (const bf16_t*)(P.ws + WS_R1 + R1_PROJ); const bf16_t* VT = (const bf16_t*)(P.ws + WS_R1 + R1_VT); bf16_t* Y = wsp<bf16_t>(P, WS_Y);
    const unsigned short* MASK = wsp<unsigned short>(P, WS_MASK);
    const int b = bh >> 2, hd = bh & 3, tokb = b * SEQ;
    const int qs = 4 * G + (C.wave & 3), par = C.wave >> 2;
    const int r = C.lane & 31, h = C.lane >> 5, q0 = qs * 32, t = q0 + r;
    const int NT = G + 1;
    const int kcol = DIFF ? PC_AK + hd * 64 : PC_DK, vrb = DIFF ? hd * 64 : 256;
    const int srow = C.tid >> 3, sch = C.tid & 7;
    const bf16_t* kg = PROJ + (size_t)(tokb + srow) * PROJ_LD + kcol + sch * 8;
    const bf16_t* vg = VT + (size_t)(vrb + srow) * NTOK + tokb + sch * 8;
    LAS unsigned char* kdst = C.lds + srow * 144 + sch * 16; LAS unsigned char* vdst = C.lds + CB_KB + srow * 264 + sch * 16;
    bf16x8 qfd[2][2], qf4[4];
    if constexpr (DIFF) {
#pragma unroll
        for (int m = 0; m < 2; ++m)
#pragma unroll
            for (int s = 0; s < 2; ++s) qfd[m][s] = *(const bf16x8*)(PROJ + (size_t)(tokb + t) * PROJ_LD + PC_AQ + hd * 64 + m * 32 + 16 * s + 8 * h);
    } else {
#pragma unroll
        for (int s = 0; s < 4; ++s) qf4[s] = *(const bf16x8*)(PROJ + (size_t)(tokb + t) * PROJ_LD + PC_DQ + hd * 64 + 16 * s + 8 * h);
    }
    f32x16 O[2][2]; float mm[2] = {-1e30f, -1e30f}, ll[2] = {0.f, 0.f};
#pragma unroll
    for (int m = 0; m < 2; ++m) { O[m][0] = zero16(); O[m][1] = zero16(); }
    const float c = (DIFF ? 0.17677669529663687f : 0.125f) * 1.4426950408889634f;
    const unsigned dmask = causal_mask(r, h);
    const unsigned short* mrow = MASK + ((size_t)(b * 128 + qs) * 128) * 64 + C.lane;
    u32x4 kr[2], vr[2];
#define CB_GLOAD(T_) do { kr[0] = *(const u32x4*)(kg + (size_t)((T_) * 128) * PROJ_LD); kr[1] = *(const u32x4*)(kg + (size_t)((T_) * 128 + 64) * PROJ_LD); \
        vr[0] = *(const u32x4*)(vg + (T_) * 128); vr[1] = *(const u32x4*)(vg + (T_) * 128 + 64); } while (0)
#define CB_LSTORE(buf_) do { LAS unsigned char* kd_ = kdst + (buf_) * CB_BUF; LAS unsigned char* vd_ = vdst + (buf_) * CB_BUF; \
        *(LAS u32x4*)kd_ = kr[0]; *(LAS u32x4*)(kd_ + 64 * 144) = kr[1]; \
        *(LAS u32x2*)vd_ = (u32x2){vr[0].x, vr[0].y}; *(LAS u32x2*)(vd_ + 8) = (u32x2){vr[0].z, vr[0].w}; \
        *(LAS u32x2*)(vd_ + 128) = (u32x2){vr[1].x, vr[1].y}; *(LAS u32x2*)(vd_ + 136) = (u32x2){vr[1].z, vr[1].w}; } while (0)
    unsigned mcur[2] = {0u, 0u}, mnxt[2] = {0u, 0u};
    if constexpr (!DIFF) { if (par <= qs) mcur[0] = mrow[(size_t)par * 64]; if (par + 2 <= qs) mcur[1] = mrow[(size_t)(par + 2) * 64]; }
    CB_GLOAD(0); CB_LSTORE(0);
    __syncthreads();
    int cur = 0;
    for (int T = 0; T < NT; ++T) {
        const int nxb = (cur == 2) ? 0 : cur + 1;
        if (T + 1 < NT) { CB_GLOAD(T + 1);
            if constexpr (!DIFF) { const int s0 = 4 * (T + 1) + par; if (s0 <= qs) mnxt[0] = mrow[(size_t)s0 * 64]; if (s0 + 2 <= qs) mnxt[1] = mrow[(size_t)(s0 + 2) * 64]; } }
        const LAS unsigned char* KB = C.lds + cur * CB_BUF; const LAS unsigned char* VB = KB + CB_KB;
#pragma unroll
        for (int k2 = 0; k2 < 2; ++k2) {
            if (k2 == 1 && par == 1) { if (T + 1 < NT) CB_LSTORE(nxb); __syncthreads(); }
            const int sub = par + 2 * k2, st = 4 * T + sub;
            if (st <= qs) {
                const LAS unsigned char* krow = KB + (sub * 32 + r) * 144 + h * 16;
                const LAS unsigned char* v0 = VB + r * 264 + (sub * 32 + 4 * h) * 2; const LAS unsigned char* v1 = v0 + 32 * 264;
                if constexpr (DIFF) {
                    DiffKV tl;
#pragma unroll
                    for (int m = 0; m < 2; ++m)
#pragma unroll
                        for (int s = 0; s < 2; ++s) tl.kf[m][s] = *(const LAS bf16x8*)(krow + m * 64 + s * 32);
#pragma unroll
                    for (int s2 = 0; s2 < 2; ++s2) {
                        { const u32x2 lo = *(const LAS u32x2*)(v0 + s2 * 32), hi = *(const LAS u32x2*)(v0 + s2 * 32 + 16); u32x4 w; w.x = lo.x; w.y = lo.y; w.z = hi.x; w.w = hi.y; tl.vf[0][s2] = __builtin_bit_cast(bf16x8, w); }
                        { const u32x2 lo = *(const LAS u32x2*)(v1 + s2 * 32), hi = *(const LAS u32x2*)(v1 + s2 * 32 + 16); u32x4 w; w.x = lo.x; w.y = lo.y; w.z = hi.x; w.w = hi.y; tl.vf[1][s2] = __builtin_bit_cast(bf16x8, w); } }
                    diff_step(tl, qfd, st == qs, dmask, c, mm, ll, O);
                } else {
                    KV64 tl; const unsigned vm = mcur[k2];
#pragma unroll
                    for (int s = 0; s < 4; ++s) tl.kf[s] = *(const LAS bf16x8*)(krow + s * 32);
#pragma unroll
                    for (int s2 = 0; s2 < 2; ++s2) {
                        { const u32x2 lo = *(const LAS u32x2*)(v0 + s2 * 32), hi = *(const LAS u32x2*)(v0 + s2 * 32 + 16); u32x4 w; w.x = lo.x; w.y = lo.y; w.z = hi.x; w.w = hi.y; tl.vf[0][s2] = __builtin_bit_cast(bf16x8, w); }
                        { const u32x2 lo = *(const LAS u32x2*)(v1 + s2 * 32), hi = *(const LAS u32x2*)(v1 + s2 * 32 + 16); u32x4 w; w.x = lo.x; w.y = lo.y; w.z = hi.x; w.w = hi.y; tl.vf[1][s2] = __builtin_bit_cast(bf16x8, w); } }
                    kv64_step(tl, qf4, true, vm, c, mm[0], ll[0], O[0]);
                }
            }
        }
        if (par == 0) { if (T + 1 < NT) CB_LSTORE(nxb); __syncthreads(); }
        mcur[0] = mnxt[0]; mcur[1] = mnxt[1]; cur = nxb;
    }
#undef CB_GLOAD
#undef CB_LSTORE
    constexpr int NM = DIFF ? 2 : 1, NV = NM * 34;
    LAS float* MA = (LAS float*)C.lds + (size_t)(C.wave & 3) * 64 * NV + C.lane;
    __syncthreads();
    if (par == 1) {
#pragma unroll
        for (int m = 0; m < NM; ++m) { MA[(m * 34 + 0) * 64] = mm[m]; MA[(m * 34 + 1) * 64] = ll[m];
#pragma unroll
            for (int et = 0; et < 2; ++et)
#pragma unroll
                for (int i = 0; i < 16; ++i) MA[(m * 34 + 2 + et * 16 + i) * 64] = O[m][et][i]; }
    }
    __syncthreads();
    if (par == 0) {
#pragma unroll
        for (int m = 0; m < NM; ++m) { const float mB = MA[(m * 34 + 0) * 64], lB = MA[(m * 34 + 1) * 64];
            const float mn = fmaxf(mm[m], mB), aA = __builtin_amdgcn_exp2f((mm[m] - mn) * c), aB = __builtin_amdgcn_exp2f((mB - mn) * c);
            ll[m] = ll[m] * aA + lB * aB;
#pragma unroll
            for (int et = 0; et < 2; ++et)
#pragma unroll
                for (int i = 0; i < 16; ++i) O[m][et][i] = O[m][et][i] * aA + MA[(m * 34 + 2 + et * 16 + i) * 64] * aB; }
        if constexpr (DIFF) {
            const float* lv = P.diff_lambda + l * 128;
            const float d1 = wave_sum(C.lane < 32 ? lv[C.lane] * lv[32 + C.lane] : 0.f), d2 = wave_sum(C.lane < 32 ? lv[64 + C.lane] * lv[96 + C.lane] : 0.f);
            const float lam_init = 0.8f - 0.6f * expf(-0.3f * (float)l), lam = expf(d1) - expf(d2) + lam_init;
            ll[0] += __shfl_xor(ll[0], 32); ll[1] += __shfl_xor(ll[1], 32);
            const float i0 = 1.0f / ll[0], i1 = lam / ll[1]; float ss = 0.f;
#pragma unroll
            for (int et = 0; et < 2; ++et)
#pragma unroll
                for (int i = 0; i < 16; ++i) { const float o = O[0][et][i] * i0 - O[1][et][i] * i1; O[0][et][i] = o; ss += o * o; }
            ss += __shfl_xor(ss, 32);
            const float rn = (1.0f - lam_init) / sqrtf(ss * (1.0f / 64.0f) + 1e-6f);
            bf16_t* yrow = Y + (size_t)(tokb + t) * DM + hd * 64;
#pragma unroll
            for (int et = 0; et < 2; ++et)
#pragma unroll
                for (int gq = 0; gq < 4; ++gq) { u32x2 w; w.x = pk2(O[0][et][4 * gq] * rn, O[0][et][4 * gq + 1] * rn); w.y = pk2(O[0][et][4 * gq + 2] * rn, O[0][et][4 * gq + 3] * rn);
                    *(u32x2*)(yrow + et * 32 + 8 * gq + 4 * h) = w; }
        } else {
            ll[0] += __shfl_xor(ll[0], 32);
            const float il = 1.0f / ll[0]; bf16_t* yrow = Y + (size_t)(tokb + t) * DM + 768 + hd * 64;
#pragma unroll
            for (int et = 0; et < 2; ++et)
#pragma unroll
                for (int gq = 0; gq < 4; ++gq) { u32x2 w; w.x = pk2(O[0][et][4 * gq] * il, O[0][et][4 * gq + 1] * il); w.y = pk2(O[0][et][4 * gq + 2] * il, O[0][et][4 * gq + 3] * il);
                    *(u32x2*)(yrow + et * 32 + 8 * gq + 4 * h) = w; }
        }
    }
    __syncthreads();
}
template <bool DIFF>
DI void causal_attn_block2(const Ctx& C, const Params& P, int l) {
    const int bh = (C.bid >> 4) & 15, gi = C.bid & 15;
    causal_attn_unit2<DIFF>(C, P, l, bh, 31 - gi);
    causal_attn_unit2<DIFF>(C, P, l, bh, gi);
}

DI void mem_attn_block(const Ctx& C, const Params& P, int l) {
    const bf16_t* MQ = (const bf16_t*)(P.ws + WS_R1 + R1_MQ); bf16_t* MO = (bf16_t*)(P.ws + WS_R1 + R1_MO);
    const bf16_t* MK = wsp<bf16_t>(P, WS_MK) + (size_t)l * 1024 * 256; const bf16_t* MVT = wsp<bf16_t>(P, WS_MVT) + (size_t)l * 256 * 1024;
    const int bh = (C.bid >> 4) & 15, grp = C.bid & 15, b = bh >> 2, hd = bh & 3, r = C.lane & 31, h = C.lane >> 5;
    const int t = b * SEQ + (grp * 8 + C.wave) * 32 + r;
    bf16x8 qf[4];
#pragma unroll
    for (int s = 0; s < 4; ++s) qf[s] = *(const bf16x8*)(MQ + (size_t)t * 256 + hd * 64 + 16 * s + 8 * h);
    { u32x4 kr[4], vr[4];
#pragma unroll
      for (int j = 0; j < 4; ++j) { const int ci = C.tid + 512 * j;
          kr[j] = *(const u32x4*)(MK + (size_t)(b * 256 + (ci >> 3)) * 256 + hd * 64 + (ci & 7) * 8);
          vr[j] = *(const u32x4*)(MVT + (size_t)(hd * 64 + (ci >> 5)) * 1024 + b * 256 + (ci & 31) * 8); }
#pragma unroll
      for (int j = 0; j < 4; ++j) { const int ci = C.tid + 512 * j;
          *(LAS u32x4*)(C.lds + (ci >> 3) * 144 + (ci & 7) * 16) = kr[j];
          LAS unsigned char* vd = C.lds + 36864 + (ci >> 5) * 520 + (ci & 31) * 16;
          *(LAS u32x2*)vd = (u32x2){vr[j].x, vr[j].y}; *(LAS u32x2*)(vd + 8) = (u32x2){vr[j].z, vr[j].w}; } }
    __syncthreads();
    f32x16 O[2] = {zero16(), zero16()}; float mm = -1e30f, ll = 0.f;
    const float c = 0.125f * 1.4426950408889634f;
#pragma unroll 2
    for (int kt = 0; kt < 8; ++kt) {
        KV64 tl; const LAS unsigned char* krow = C.lds + (kt * 32 + r) * 144 + h * 16;
        const LAS unsigned char* v0 = C.lds + 36864 + r * 520 + (kt * 32 + 4 * h) * 2; const LAS unsigned char* v1 = v0 + 32 * 520;
#pragma unroll
        for (int s = 0; s < 4; ++s) tl.kf[s] = *(const LAS bf16x8*)(krow + s * 32);
#pragma unroll
        for (int s2 = 0; s2 < 2; ++s2) {
            { const u32x2 lo = *(const LAS u32x2*)(v0 + s2 * 32), hi = *(const LAS u32x2*)(v0 + s2 * 32 + 16); u32x4 w; w.x = lo.x; w.y = lo.y; w.z = hi.x; w.w = hi.y; tl.vf[0][s2] = __builtin_bit_cast(bf16x8, w); }
            { const u32x2 lo = *(const LAS u32x2*)(v1 + s2 * 32), hi = *(const LAS u32x2*)(v1 + s2 * 32 + 16); u32x4 w; w.x = lo.x; w.y = lo.y; w.z = hi.x; w.w = hi.y; tl.vf[1][s2] = __builtin_bit_cast(bf16x8, w); } }
        kv64_step(tl, qf, false, 0u, c, mm, ll, O);
    }
    ll += __shfl_xor(ll, 32);
    const float il = 1.0f / ll; bf16_t* orow = MO + (size_t)t * 256 + hd * 64;
#pragma unroll
    for (int et = 0; et < 2; ++et)
#pragma unroll
        for (int g = 0; g < 4; ++g) { u32x2 w; w.x = pk2(O[et][4 * g] * il, O[et][4 * g + 1] * il); w.y = pk2(O[et][4 * g + 2] * il, O[et][4 * g + 3] * il);
            *(u32x2*)(orow + et * 32 + 8 * g + 4 * h) = w; }
    __syncthreads();
}
DI void mma_lds(f32x16& acc, const LAS bf16_t* A, int lda, const LAS bf16_t* Bt, int ldb, int K, int lane) {
    const int r = lane & 31, h = lane >> 5;
    for (int k0 = 0; k0 < K; k0 += 16) {
        const bf16x8 a = *(const LAS bf16x8*)(A + r * lda + k0 + 8 * h);
        const bf16x8 b = *(const LAS bf16x8*)(Bt + r * ldb + k0 + 8 * h);
        acc = mfma32(a, b, acc);
    }
}

constexpr int HG_BC = 0, HG_QT = 32768, HG_KT = 50176, HG_VT = 67584, HG_ST = 86016, HG_AT = 104448;
DI float hgrn_lb(const Params& P, int l, int ch) { if (l == 0) return 0.f; const float z0 = P.hgrn_lb[ch], z1 = P.hgrn_lb[256 + ch]; return 1.0f / (1.0f + expf(z0 - z1)); }
DI void hgrn_cumsum(const Ctx& C, const Params& P, int l, const float (&fpv)[16], int ch0) {
    LAS float* BC = (LAS float*)(C.lds + HG_BC);
    const float lb = hgrn_lb(P, l, ch0 + (C.tid & 127));
#pragma unroll
    for (int j = 0; j < 16; ++j) { const float f = lb + (1.0f - lb) * frcp(1.0f + fexp(fminf(-fpv[j], 80.f))); BC[C.tid + 512 * j] = flog(fmaxf(f, 1e-30f)); }
    __syncthreads();
    if (C.tid < 128) { float cum = 0.f;
#pragma unroll 8
        for (int s = 0; s < 64; ++s) { cum += BC[s * 128 + C.tid]; BC[s * 128 + C.tid] = cum; } }
    __syncthreads();
}
DI void hgrn_local_unit(const Ctx& C, const Params& P, int l, int u) {
    const bf16_t* PROJ = (const bf16_t*)(P.ws + WS_R1 + R1_PROJ); float* HS = wsp<float>(P, WS_HS); float* HD = wsp<float>(P, WS_HD);
    const int hp = u & 1, bc = u >> 1, b = bc >> 6, c = bc & 63, tok0 = b * SEQ + c * 64, ch0 = hp * 128;
    LAS float* BC = (LAS float*)(C.lds + HG_BC); LAS bf16_t* KT = (LAS bf16_t*)(C.lds + HG_QT);   LAS bf16_t* VT = (LAS bf16_t*)(C.lds + HG_VT);
    const int cl = C.tid & 127, ch = ch0 + cl; const float lb = hgrn_lb(P, l, ch);
    float fpv[16]; bf16_t vv[16];
#pragma unroll
    for (int j = 0; j < 16; ++j) { const bf16_t* row = PROJ + (size_t)(tok0 + (C.tid >> 7) + 4 * j) * PROJ_LD; fpv[j] = bf2f(row[PC_BF + ch]); vv[j] = row[PC_BI + ch]; }
    hgrn_cumsum(C, P, l, fpv, ch0);
#pragma unroll
    for (int j = 0; j < 16; ++j) { const int s = (C.tid >> 7) + 4 * j; const float kk = (1.0f - lb) * frcp(1.0f + fexp(fminf(fpv[j], 80.f)));
        KT[cl * 72 + s] = f2bf(kk * fexp(BC[63 * 128 + cl] - BC[s * 128 + cl])); VT[cl * 72 + s] = vv[j]; }
    if (C.tid < 128) HD[(size_t)bc * 256 + ch0 + C.tid] = fexp(BC[63 * 128 + C.tid]);
    __syncthreads();
    { const int h2 = C.wave >> 2, dkt = (C.wave >> 1) & 1, dvt = C.wave & 1, r = C.lane & 31, h = C.lane >> 5;
      f32x16 acc = zero16();
      mma_lds(acc, KT + (h2 * 64 + dkt * 32) * 72, 72, VT + (h2 * 64 + dvt * 32) * 72, 72, 64, C.lane);
      float* dst = HS + ((size_t)(bc * 4 + hp * 2 + h2) * 64) * 64;
#pragma unroll
      for (int i = 0; i < 16; ++i) dst[(dkt * 32 + crow(i, h)) * 64 + dvt * 32 + r] = acc[i]; }
    __syncthreads();
}
DI void hgrn_scan_unit(const Ctx& C, const Params& P, int u) {
    float* HS = wsp<float>(P, WS_HS); const float* HD = wsp<float>(P, WS_HD);
    const int id = u * NTHREADS + C.tid;
    const int bh = id >> 12, e = id & 4095, b = bh >> 2, hh = bh & 3, dk = e >> 6;
    float Lv[64], Dv[64];
#pragma unroll
    for (int c = 0; c < 64; ++c) { const size_t bc = (size_t)b * 64 + c; Lv[c] = HS[((bc * 4 + hh) << 12) + e]; Dv[c] = HD[bc * 256 + hh * 64 + dk]; }
    float S = 0.f;
#pragma unroll
    for (int c = 0; c < 64; ++c) { const size_t bc = (size_t)b * 64 + c; HS[((bc * 4 + hh) << 12) + e] = S; S = Dv[c] * S + Lv[c]; }
}
DI void hgrn_out_unit(const Ctx& C, const Params& P, int l, int u) {
    const bf16_t* PROJ = (const bf16_t*)(P.ws + WS_R1 + R1_PROJ); const float* HS = wsp<float>(P, WS_HS); bf16_t* Y = wsp<bf16_t>(P, WS_Y);
    const int hp = u & 1, bc = u >> 1, b = bc >> 6, c = bc & 63, tok0 = b * SEQ + c * 64, ch0 = hp * 128;
    LAS float* BC = (LAS float*)(C.lds + HG_BC); LAS bf16_t* QT = (LAS bf16_t*)(C.lds + HG_QT); LAS bf16_t* KT = (LAS bf16_t*)(C.lds + HG_KT);
    LAS bf16_t* VT = (LAS bf16_t*)(C.lds + HG_VT); LAS bf16_t* ST = (LAS bf16_t*)(C.lds + HG_ST); LAS bf16_t* AT = (LAS bf16_t*)(C.lds + HG_AT);
    const int cl = C.tid & 127, ch = ch0 + cl; const float lb = hgrn_lb(P, l, ch);
    float fpv[16], qv16[16], sp16[16]; bf16_t vv[16];
#pragma unroll
    for (int j = 0; j < 16; ++j) { const bf16_t* row = PROJ + (size_t)(tok0 + (C.tid >> 7) + 4 * j) * PROJ_LD; fpv[j] = bf2f(row[PC_BF + ch]); qv16[j] = bf2f(row[PC_BQ + ch]); vv[j] = row[PC_BI + ch];
        sp16[j] = HS[(((size_t)bc * 4 + hp * 2) << 12) + C.tid + 512 * j]; }
    hgrn_cumsum(C, P, l, fpv, ch0);
#pragma unroll
    for (int j = 0; j < 16; ++j) { const int s = (C.tid >> 7) + 4 * j; const float kk = (1.0f - lb) * frcp(1.0f + fexp(fminf(fpv[j], 80.f)));
        const float q = qv16[j] * frcp(1.0f + fexp(fminf(-qv16[j], 80.f)));
        const float bs = BC[s * 128 + cl], br = BC[31 * 128 + cl];
        QT[s * 136 + cl] = f2bf(q * fexp(fminf(bs - br, 80.f)));
        KT[s * 136 + cl] = f2bf(kk * fexp(fminf(br - bs, 80.f)));
        VT[cl * 72 + s] = vv[j]; }
#pragma unroll
    for (int j = 0; j < 16; ++j) { const int i = C.tid + 512 * j, h2 = i >> 12, e = i & 4095, dk = e >> 6, dv = e & 63;
        ST[(h2 * 64 + dv) * 72 + dk] = f2bf(sp16[j] * fexp(BC[31 * 128 + h2 * 64 + dk])); }
    __syncthreads();
    {
      const int h2 = C.wave >> 2, tt = (C.wave >> 1) & 1, st = C.wave & 1, r = C.lane & 31, h = C.lane >> 5;
      if (st <= tt) { f32x16 acc = zero16();
          mma_lds(acc, QT + (tt * 32) * 136 + h2 * 64, 136, KT + (st * 32) * 136 + h2 * 64, 136, 64, C.lane);
#pragma unroll
          for (int i = 0; i < 16; ++i) { const int t = tt * 32 + crow(i, h), s = st * 32 + r; AT[(h2 * 64 + t) * 72 + s] = (s <= t) ? f2bf(acc[i]) : (bf16_t)0; } } }
    __syncthreads();
    if (C.wave < 4) {
      const int h2 = C.wave >> 1, tt = C.wave & 1, r = C.lane & 31, h = C.lane >> 5;
      f32x16 o[2] = {zero16(), zero16()};
#pragma unroll
      for (int dvt = 0; dvt < 2; ++dvt) {
          mma_lds(o[dvt], VT + (h2 * 64 + dvt * 32) * 72, 72, AT + (h2 * 64 + tt * 32) * 72, 72, (tt + 1) * 32, C.lane);
          mma_lds(o[dvt], ST + (h2 * 64 + dvt * 32) * 72, 72, QT + (tt * 32) * 136 + h2 * 64, 136, 64, C.lane); }
      float ss = 0.f;
#pragma unroll
      for (int dvt = 0; dvt < 2; ++dvt)
#pragma unroll
          for (int i = 0; i < 16; ++i) ss += o[dvt][i] * o[dvt][i];
      ss += __shfl_xor(ss, 32);
      const float rn = 1.0f / sqrtf(ss * (1.0f / 64.0f) + 1e-6f);
      const int t = tok0 + tt * 32 + r, chb = ch0 + h2 * 64;
      const bf16_t* grow = PROJ + (size_t)t * PROJ_LD + PC_BG + chb; bf16_t* yrow = Y + (size_t)t * DM + 256 + chb;
#pragma unroll
      for (int dvt = 0; dvt < 2; ++dvt)
#pragma unroll
          for (int g = 0; g < 4; ++g) { const int dv = dvt * 32 + 8 * g + 4 * h; const u32x2 gw = *(const u32x2*)(grow + dv);
              const float g0 = siluf_(bflo(gw.x)), g1 = siluf_(bfhi(gw.x)), g2 = siluf_(bflo(gw.y)), g3 = siluf_(bfhi(gw.y));
              u32x2 w; w.x = pk2(o[dvt][4 * g] * rn * g0, o[dvt][4 * g + 1] * rn * g1); w.y = pk2(o[dvt][4 * g + 2] * rn * g2, o[dvt][4 * g + 3] * rn * g3);
              *(u32x2*)(yrow + dv) = w; } }
    __syncthreads();
}

DI void sgu_unit(const Ctx& C, const Params& P, int l, int u) {
    const bf16_t* PROJ = (const bf16_t*)(P.ws + WS_R1 + R1_PROJ); bf16_t* Y = wsp<bf16_t>(P, WS_Y); const bf16_t* SW = wsp<bf16_t>(P, W_SGU);
    const float* sb = P.spatial_b + l * 512;
    LAS bf16_t* VT = (LAS bf16_t*)C.lds; const int tok0 = (u >> 1) * 128, half = u & 1;
    u32x2 wv[16];
#pragma unroll
    for (int j = 0; j < 16; ++j) wv[j] = *(const u32x2*)(PROJ + (size_t)(tok0 + C.wave + NWAVES * j) * PROJ_LD + PC_CV + C.lane * 4);
#pragma unroll
    for (int j = 0; j < 16; ++j) {
        const int s = C.wave + NWAVES * j; const u32x2 w = wv[j];
        float v[4] = {gelu_tanh(bflo(w.x)), gelu_tanh(bfhi(w.x)), gelu_tanh(bflo(w.y)), gelu_tanh(bfhi(w.y))};
        const float mu = wave_sum(v[0] + v[1] + v[2] + v[3]) * (1.0f / 256.0f);
        float q = 0.f;
#pragma unroll
        for (int jj = 0; jj < 4; ++jj) { v[jj] -= mu; q += v[jj] * v[jj]; }
        const float rs = 1.0f / sqrtf(wave_sum(q) * (1.0f / 256.0f) + 1e-6f);
#pragma unroll
        for (int jj = 0; jj < 4; ++jj) VT[(C.lane * 4 + jj) * 136 + s] = f2bf(v[jj] * rs);
    }
    __syncthreads();
    { const int g = C.wave >> 1, dt = C.wave & 1, r = C.lane & 31, h = C.lane >> 5;
      for (int ti = 0; ti < 2; ++ti) { const int tt = half ? (1 + ti) : (ti * 3);
          f32x16 acc = zero16();
          const bf16_t* wrow = SW + ((size_t)g * 128 + tt * 32 + r) * 128 + 8 * h;
          const LAS bf16_t* vrow = VT + (g * 64 + dt * 32 + r) * 136 + 8 * h;
          bf16x8 af[8];
#pragma unroll
          for (int kk = 0; kk < 8; ++kk) af[kk] = *(const bf16x8*)(wrow + (kk < 2 * (tt + 1) ? kk * 16 : 0));
#pragma unroll
          for (int kk = 0; kk < 8; ++kk) if (kk < 2 * (tt + 1)) { const bf16x8 bb = *(const LAS bf16x8*)(vrow + kk * 16); acc = mfma32(af[kk], bb, acc); }
          const int ch = g * 64 + dt * 32 + r;
#pragma unroll
          for (int i = 0; i < 16; ++i) { const int t = tt * 32 + crow(i, h); const size_t tok = (size_t)(tok0 + t);
              const float uu = gelu_tanh(bf2f(PROJ[tok * PROJ_LD + PC_CU + ch]));
              Y[tok * DM + 512 + ch] = f2bf(uu * (acc[i] + sb[g * 128 + t])); } } }
    __syncthreads();
}

DI void phase_router(const Ctx& C, const Params& P, int l, const bool dry = false) {
    float* XR = P.out; bf16_t* H = wsp<bf16_t>(P, WS_H);
    int* TOKE = wsp<int>(P, WS_TOKE); float* TOKW = wsp<float>(P, WS_TOKW); int* RANK = wsp<int>(P, WS_RANK); int* ROWTOK = dry ? wsp<int>(P, WS_DUMMY) : wsp<int>(P, WS_ROWTOK);
    unsigned* CNT = wsp<unsigned>(P, WS_CTL) + CW_CNT + 64 * l + (dry ? 256 : 0);
    const float* gain = P.norm_ffn + l * DM;
    const float* brg = P.b_rg + l * 4; const float* bre = P.b_re + l * 32;
    LAS bf16_t* XHL = (LAS bf16_t*)C.lds; LAS float* PART = (LAS float*)C.lds; LAS float* LOG = (LAS float*)(C.lds + 32768);
    LAS unsigned* lcnt = (LAS unsigned*)(C.lds + LDS_MISC + 1024); LAS unsigned* lbase = lcnt + 32;
    if (C.tid < 32) lcnt[C.tid] = 0u;
    __syncthreads();
    const int per = NTOK / C.G;
    const int r = C.lane & 31, h = C.lane >> 5;
    for (int it = 0; it < per; it += 32) {
        const int tok0 = C.bid * per + it;
        { f32x4 v[4][4];
#pragma unroll
          for (int j = 0; j < 4; ++j) { const float* xr = XR + (size_t)(tok0 + C.wave * 4 + j) * DM;
#pragma unroll
              for (int q = 0; q < 4; ++q) v[j][q] = *(const f32x4*)(xr + q * 256 + C.lane * 4); }
#pragma unroll
          for (int j = 0; j < 4; ++j) { const int tl = C.wave * 4 + j, t = tok0 + tl; float ss = 0.f;
#pragma unroll
              for (int q = 0; q < 4; ++q) ss += v[j][q][0] * v[j][q][0] + v[j][q][1] * v[j][q][1] + v[j][q][2] * v[j][q][2] + v[j][q][3] * v[j][q][3];
              ss = wave_sum(ss); const float rs = 1.0f / sqrtf(ss * (1.0f / DM) + 1e-6f);
#pragma unroll
              for (int q = 0; q < 4; ++q) { const int c = q * 256 + C.lane * 4; const f32x4 g = *(const f32x4*)(gain + c);
                  const f32x4 o = (f32x4){v[j][q][0] * rs * g[0], v[j][q][1] * rs * g[1], v[j][q][2] * rs * g[2], v[j][q][3] * rs * g[3]};
                  u32x2 w; w.x = pk2(o[0], o[1]); w.y = pk2(o[2], o[3]); *(u32x2*)(H + (size_t)t * DM + c) = w;
                  { u32x2 wl; wl.x = pk2(o[0] - bflo(w.x), o[1] - bfhi(w.x)); wl.y = pk2(o[2] - bflo(w.y), o[3] - bfhi(w.y));
                    *(LAS u32x2*)(XHL + tl * 1032 + c) = w; *(LAS u32x2*)(XHL + 33024 + tl * 1032 + c) = wl; } } } }
        __syncthreads();
        f32x16 acc = zero16();
        { const int ct = C.wave & 1, kq = C.wave >> 1;
          const LAS bf16_t* ah = XHL + r * 1032 + kq * 256 + 8 * h; const LAS bf16_t* al = ah + 33024;
          const bf16_t* bh_ = wsp<bf16_t>(P, W_RH) + (size_t)(ct * 32 + r) * 1024 + kq * 256 + 8 * h; const bf16_t* bl_ = bh_ + (size_t)64 * 1024;
#pragma unroll 4
          for (int k0 = 0; k0 < 256; k0 += 16) { const bf16x8 xh = *(const LAS bf16x8*)(ah + k0), xl = *(const LAS bf16x8*)(al + k0);
              const bf16x8 wh = *(const bf16x8*)(bh_ + k0), wl = *(const bf16x8*)(bl_ + k0);
              acc = mfma32(xh, wh, acc); acc = mfma32(xh, wl, acc); acc = mfma32(xl, wh, acc); } }
        __syncthreads();
#pragma unroll
        for (int i = 0; i < 16; ++i) PART[(C.wave * 16 + i) * 64 + C.lane] = acc[i];
        __syncthreads();
        for (int idx = C.tid; idx < 32 * 36; idx += NTHREADS) { const int tok = idx / 36, col = idx % 36, ct = col < 32 ? 0 : 1, cc = col < 32 ? col : col - 32;
            const int hh = (tok >> 2) & 1, reg = (tok & 3) + 4 * (tok >> 3); float s = 0.f;
#pragma unroll
            for (int kq = 0; kq < 4; ++kq) s += PART[((kq * 2 + ct) * 16 + reg) * 64 + cc + 32 * hh];
            LOG[tok * 36 + col] = s; }
        __syncthreads();
        if (C.tid < 32) { const int t = tok0 + C.tid; const LAS float* lg = LOG + C.tid * 36;
            float gl[4]; int gsel = 0;
#pragma unroll
            for (int k = 0; k < 4; ++k) gl[k] = lg[32 + k] + brg[k];
            float gmax = gl[0];
#pragma unroll
            for (int k = 1; k < 4; ++k) if (gl[k] > gmax) { gmax = gl[k]; gsel = k; }
            float gsum = 0.f;
#pragma unroll
            for (int k = 0; k < 4; ++k) gsum += expf(gl[k] - gmax);
            const float pg = 1.0f / gsum;
            float pe[8]; float emax = -1e30f;
#pragma unroll
            for (int k = 0; k < 8; ++k) { pe[k] = lg[gsel * 8 + k] + bre[gsel * 8 + k]; emax = fmaxf(emax, pe[k]); }
#pragma unroll
            for (int k = 0; k < 8; ++k) pe[k] = expf(pe[k] - emax);
            int i1 = 0; float p1 = pe[0];
#pragma unroll
            for (int k = 1; k < 8; ++k) if (pe[k] > p1) { p1 = pe[k]; i1 = k; }
            int i2 = (i1 == 0) ? 1 : 0; float p2 = pe[i2];
#pragma unroll
            for (int k = 0; k < 8; ++k) if (k != i1 && pe[k] > p2) { p2 = pe[k]; i2 = k; }
            const float inv = pg / (p1 + p2);
            const int e1 = gsel * 8 + i1, e2 = gsel * 8 + i2;
            TOKE[t * 2] = e1; TOKE[t * 2 + 1] = e2; TOKW[t * 2] = p1 * inv; TOKW[t * 2 + 1] = p2 * inv;
            RANK[t * 2] = (int)__hip_atomic_fetch_add(lcnt + e1, 1u, __ATOMIC_RELAXED, __HIP_MEMORY_SCOPE_WORKGROUP);
            RANK[t * 2 + 1] = (int)__hip_atomic_fetch_add(lcnt + e2, 1u, __ATOMIC_RELAXED, __HIP_MEMORY_SCOPE_WORKGROUP); }
        __syncthreads();
    }
    if (C.tid < 32) { const unsigned n = lcnt[C.tid]; lbase[C.tid] = n ? __hip_atomic_fetch_add(CNT + C.tid, n, __ATOMIC_RELAXED, __HIP_MEMORY_SCOPE_AGENT) : 0u; }
    __syncthreads();
    asm volatile("s_waitcnt vmcnt(0)" ::: "memory");
    for (int a = C.tid; a < per * 2; a += NTHREADS) { const int ga = C.bid * per * 2 + a; const int e = TOKE[ga]; const unsigned rk = lbase[e] + (unsigned)RANK[ga];
        ROWTOK[(size_t)e * MOE_CAP + rk] = ga; }
    __syncthreads();
}
typedef f32x4 AccT[2][2][4][2];
DI u32x4 pack8(const f32x4& a, const f32x4& b) { u32x4 w; w.x = pk2(a[0], a[1]); w.y = pk2(a[2], a[3]); w.z = pk2(b[0], b[1]); w.w = pk2(b[2], b[3]); return w; }
template <int ACT> struct EpiStore {
    bf16_t* O; int ldc;
    DI void operator()(const AccT& acc, const pg8::Unit& u, int wr, int wc, int fr, int fq) const {
#pragma unroll
        for (int ai = 0; ai < 2; ++ai)
#pragma unroll
            for (int m = 0; m < 4; ++m) { const size_t row = (size_t)(u.pm * 256 + ai * 128 + wr * 64 + m * 16 + fr);
#pragma unroll
                for (int bj = 0; bj < 2; ++bj) { const int col = u.pn * 256 + bj * 128 + wc * 32 + 8 * fq; f32x4 a = acc[ai][bj][m][0], b = acc[ai][bj][m][1];
                    if (ACT == 1) {
#pragma unroll
                        for (int j = 0; j < 4; ++j) { a[j] = sigmoidf_(a[j]); b[j] = sigmoidf_(b[j]); } }
                    *(u32x4*)(O + row * ldc + col) = pack8(a, b); } }
    }
};
struct EpiMerge {
    const bf16_t* GATE; bf16_t* MG;
    DI void operator()(const AccT& acc, const pg8::Unit& u, int wr, int wc, int fr, int fq) const {
#pragma unroll
        for (int ai = 0; ai < 2; ++ai)
#pragma unroll
            for (int m = 0; m < 4; ++m) { const size_t row = (size_t)(u.pm * 256 + ai * 128 + wr * 64 + m * 16 + fr);
#pragma unroll
                for (int bj = 0; bj < 2; ++bj) { const int col = u.pn * 256 + bj * 128 + wc * 32 + 8 * fq;
                    const u32x4 g = *(const u32x4*)(GATE + row * 4096 + u.x * 1024 + col);
                    f32x4 a = acc[ai][bj][m][0], b = acc[ai][bj][m][1];
                    a[0] *= bflo(g.x); a[1] *= bfhi(g.x); a[2] *= bflo(g.y); a[3] *= bfhi(g.y); b[0] *= bflo(g.z); b[1] *= bfhi(g.z); b[2] *= bflo(g.w); b[3] *= bfhi(g.w);
                    bf16_t* dst = MG + row * 1024 + col;
                    if (u.x > 0) { const u32x4 p = *(const u32x4*)dst;
                        a[0] += bflo(p.x); a[1] += bfhi(p.x); a[2] += bflo(p.y); a[3] += bfhi(p.y); b[0] += bflo(p.z); b[1] += bfhi(p.z); b[2] += bflo(p.w); b[3] += bfhi(p.w); }
                    *(u32x4*)dst = pack8(a, b); }
                asm volatile("" ::: "memory"); }
    }
};
struct EpiResid {
    float* XR;
    DI void operator()(const AccT& acc, const pg8::Unit& u, int wr, int wc, int fr, int fq) const {
#pragma unroll
        for (int ai = 0; ai < 2; ++ai)
#pragma unroll
            for (int m = 0; m < 4; ++m) { const size_t row = (size_t)(u.pm * 256 + ai * 128 + wr * 64 + m * 16 + fr);
#pragma unroll
                for (int bj = 0; bj < 2; ++bj) { float* p = XR + row * 1024 + u.pn * 256 + bj * 128 + wc * 32 + 8 * fq;
                    const f32x4 x0 = *(const f32x4*)p, x1 = *(const f32x4*)(p + 4);
                    *(f32x4*)p = x0 + acc[ai][bj][m][0]; *(f32x4*)(p + 4) = x1 + acc[ai][bj][m][1]; }
                if (m == 3) asm volatile("" ::: "memory"); }
    }
};
struct EpiResidNorm {
    float* XR; bf16_t* XB; float* RSS;
    DI void operator()(const AccT& acc, const pg8::Unit& u, int wr, int wc, int fr, int fq) const {
#pragma unroll
        for (int ai = 0; ai < 2; ++ai)
#pragma unroll
            for (int m = 0; m < 4; ++m) { const size_t row = (size_t)(u.pm * 256 + ai * 128 + wr * 64 + m * 16 + fr); float ss = 0.f;
#pragma unroll
                for (int bj = 0; bj < 2; ++bj) { const size_t off = row * 1024 + u.pn * 256 + bj * 128 + wc * 32 + 8 * fq; float* p = XR + off;
                    const f32x4 x0 = *(const f32x4*)p + acc[ai][bj][m][0], x1 = *(const f32x4*)(p + 4) + acc[ai][bj][m][1];
                    *(f32x4*)p = x0; *(f32x4*)(p + 4) = x1; *(u32x4*)(XB + off) = pack8(x0, x1);
                    ss += (x0[0] * x0[0] + x0[1] * x0[1]) + (x0[2] * x0[2] + x0[3] * x0[3]) + (x1[0] * x1[0] + x1[1] * x1[1]) + (x1[2] * x1[2] + x1[3] * x1[3]); }
                ss += __shfl_xor(ss, 16); ss += __shfl_xor(ss, 32);
                if (fq == 0) RSS[row * 16 + u.pn * 4 + wc] = ss;
                if (m == 3) asm volatile("" ::: "memory"); }
    }
};
struct EpiStoreRstd {
    bf16_t* O; int ldc; const float* RSS;
    DI void operator()(const AccT& acc, const pg8::Unit& u, int wr, int wc, int fr, int fq) const {
#pragma unroll
        for (int ai = 0; ai < 2; ++ai)
#pragma unroll
            for (int m = 0; m < 4; ++m) { const size_t row = (size_t)(u.pm * 256 + ai * 128 + wr * 64 + m * 16 + fr);
                const f32x4* rp = (const f32x4*)(RSS + row * 16); const f32x4 r0 = rp[0], r1 = rp[1], r2 = rp[2], r3 = rp[3];
                const float rsum = ((r0[0] + r0[1]) + (r0[2] + r0[3])) + ((r1[0] + r1[1]) + (r1[2] + r1[3])) + ((r2[0] + r2[1]) + (r2[2] + r2[3])) + ((r3[0] + r3[1]) + (r3[2] + r3[3]));
                const float rs = 1.0f / sqrtf(rsum * (1.0f / 1024.0f) + 1e-6f);
#pragma unroll
                for (int bj = 0; bj < 2; ++bj) { const int col = u.pn * 256 + bj * 128 + wc * 32 + 8 * fq;
                    *(u32x4*)(O + row * ldc + col) = pack8(acc[ai][bj][m][0] * rs, acc[ai][bj][m][1] * rs); } }
    }
};
struct EpiGU {
    bf16_t* HID;
    DI void operator()(const AccT& acc, const pg8::Unit& u, int wr, int wc, int fr, int fq) const {
#pragma unroll
        for (int ai = 0; ai < 2; ++ai)
#pragma unroll
            for (int m = 0; m < 4; ++m) { const size_t row = (size_t)(u.pm * 256 + ai * 128 + wr * 64 + m * 16 + fr);
                f32x4 a, b;
#pragma unroll
                for (int j = 0; j < 4; ++j) { a[j] = siluf_(acc[ai][0][m][0][j]) * acc[ai][1][m][0][j]; b[j] = siluf_(acc[ai][0][m][1][j]) * acc[ai][1][m][1][j]; }
                *(u32x4*)(HID + row * 256 + u.pn * 128 + wc * 32 + 8 * fq) = pack8(a, b); }
    }
};
struct EpiDown {
    bf16_t* YB; const int* ROWTOK; const float* TOKW; const LAS int* cnt;
    DI void operator()(const AccT& acc, const pg8::Unit& u, int wr, int wc, int fr, int fq) const {
        const int ce = cnt[u.x];
#pragma unroll
        for (int ai = 0; ai < 2; ++ai)
#pragma unroll
            for (int m = 0; m < 4; ++m) { const int idx = u.y * 256 + ai * 128 + wr * 64 + m * 16 + fr;
                if (idx < ce) { const int a = ROWTOK[(size_t)u.x * MOE_CAP + idx]; const float w = TOKW[a];
#pragma unroll
                    for (int bj = 0; bj < 2; ++bj) { const int col = u.pn * 256 + bj * 128 + wc * 32 + 8 * fq;
                        *(u32x4*)(YB + (size_t)a * 1024 + col) = pack8(acc[ai][bj][m][0] * w, acc[ai][bj][m][1] * w); } } }
    }
};

struct FusedMergeOrder {
    const char* Hb; const char* Yb; const char* Wg; const char* Wb; int G, c;
    DI bool next(int i, pg8::Unit& u) const {
        const int ti = i >> 3, x = i & 7, n = x >> 1; const long L = (long)ti * G + c; if (L >= 256) return false;
        pg8::tile_map((int)L, 64, 4, u.pm, u.pn); u.x = x; u.y = 0;
        if (x & 1) { u.a = Yb + (size_t)u.pm * 256 * 1024 * 2 + (size_t)n * 256 * 2; u.b = Wb + (size_t)u.pn * 256 * 1024 * 2 + (size_t)n * 256 * 2; u.nt = 4; }
        else { u.a = Hb + (size_t)u.pm * 256 * 1024 * 2; u.b = Wg + ((size_t)n * 1024 + (size_t)u.pn * 256) * 1024 * 2; u.nt = 16; }
        return true; }
    DI unsigned row_off(const pg8::Unit&, int) const { return 0u; }
};
struct EpiFusedMerge {
    bf16_t* GS; bf16_t* MG; int tid;
    DI void operator()(const AccT& acc, const pg8::Unit& u, int wr, int wc, int fr, int fq) const {
        u32x4* gs = (u32x4*)GS + tid;
        if ((u.x & 1) == 0) {
#pragma unroll
            for (int ai = 0; ai < 2; ++ai)
#pragma unroll
                for (int m = 0; m < 4; ++m)
#pragma unroll
                    for (int bj = 0; bj < 2; ++bj) { f32x4 a = acc[ai][bj][m][0], b = acc[ai][bj][m][1];
#pragma unroll
                        for (int j = 0; j < 4; ++j) { a[j] = sigmoidf_(a[j]); b[j] = sigmoidf_(b[j]); }
                        gs[((ai * 4 + m) * 2 + bj) * 512] = pack8(a, b); }
        } else {
#pragma unroll
            for (int ai = 0; ai < 2; ++ai)
#pragma unroll
                for (int m = 0; m < 4; ++m) { const size_t row = (size_t)(u.pm * 256 + ai * 128 + wr * 64 + m * 16 + fr);
#pragma unroll
                    for (int bj = 0; bj < 2; ++bj) { const int col = u.pn * 256 + bj * 128 + wc * 32 + 8 * fq;
                        const u32x4 g = gs[((ai * 4 + m) * 2 + bj) * 512];
                        f32x4 a = acc[ai][bj][m][0], b = acc[ai][bj][m][1];
                        a[0] *= bflo(g.x); a[1] *= bfhi(g.x); a[2] *= bflo(g.y); a[3] *= bfhi(g.y); b[0] *= bflo(g.z); b[1] *= bfhi(g.z); b[2] *= bflo(g.w); b[3] *= bfhi(g.w);
                        bf16_t* dst = MG + row * 1024 + col;
                        if (u.x > 1) { const u32x4 p = *(const u32x4*)dst;
                            a[0] += bflo(p.x); a[1] += bfhi(p.x); a[2] += bflo(p.y); a[3] += bfhi(p.y); b[0] += bflo(p.z); b[1] += bfhi(p.z); b[2] += bflo(p.w); b[3] += bfhi(p.w); }
                        *(u32x4*)dst = pack8(a, b); }
                    if (m == 3) asm volatile("" ::: "memory"); }
        }
    }
};
constexpr int MOE_TAB = LDS_MISC + 256;
DI void moe_build_table(const Ctx& C, const unsigned* CNT) {
    volatile LAS int* T = (volatile LAS int*)(C.lds + MOE_TAB);
    if (C.tid == 0) { int acc = 0; for (int e = 0; e < 32; ++e) { const int n = (int)CNT[e]; T[e] = acc; T[40 + e] = n; const int nt = (n + 255) >> 8;
            for (int j = 0; j < nt; ++j) T[80 + acc + j] = (e << 8) | j;
            acc += nt; } T[32] = acc; }
    __syncthreads();
}
template <int NPN, bool GU> struct MoeOrder {
    const LAS int* T; const char* Ab; const char* Wb; const int* ROWTOK; int G, c;
    DI bool next(int i, pg8::Unit& u) const {
        const long L = (long)i * G + c; const int tile = (int)(L / NPN), pn = (int)(L % NPN);
        if (tile >= __builtin_amdgcn_readfirstlane(T[32])) return false;
        const int ej = __builtin_amdgcn_readfirstlane(T[80 + tile]); const int e = ej >> 8;
        u.x = e; u.y = ej & 255; u.pm = tile; u.pn = pn; u.nt = 0;
        if (GU) { u.a = Ab; u.b = Wb + ((size_t)e * 512 + (size_t)pn * 256) * 1024 * 2; }
        else { u.a = Ab + (size_t)tile * 256 * 256 * 2; u.b = Wb + ((size_t)e * 1024 + (size_t)pn * 256) * 256 * 2; }
        return true; }
    DI unsigned row_off(const pg8::Unit& u, int row) const {
        const int idx = u.y * 256 + row; int tok = 0;
        if (idx < T[40 + u.x]) tok = ROWTOK[(size_t)u.x * MOE_CAP + idx] >> 1;
        return (unsigned)tok * 2048u; }
};

constexpr int PH_PER_LAYER = 16, PH_L0 = 1, N_PHASES = PH_L0 + DEPTH * PH_PER_LAYER + 1;
#ifndef ENABLE_MASK
#define ENABLE_MASK 0xFF
#endif
#ifndef PROBE_DUP
#define PROBE_DUP 0
#endif
#define NREP(bit) ((PROBE_DUP & (bit)) ? 2 : 1)
#define ZIGZAG(n, call) do { for (int _rd = 0; _rd * C.G < (n); ++_rd) { const int u = _rd * C.G + ((_rd & 1) ? (C.G - 1 - C.bid) : C.bid); if (u < (n)) { call; } } } while (0)

typedef const Params __attribute__((address_space(4))) KParams;
#if defined(__HIP_DEVICE_COMPILE__)
#define PHASE_LOADP() KParams* _pp = (KParams*)__builtin_amdgcn_kernarg_segment_ptr(); asm volatile("" : "+s"(_pp)); const Params P = *_pp
#else
#define PHASE_LOADP() const Params P = Parg
#endif
#define PHASE_ENV() PHASE_LOADP(); const Ctx C = relaunder(C0); LAS unsigned char* lds = C.lds; bf16_t* H = wsp<bf16_t>(P, WS_H); bf16_t* Y = wsp<bf16_t>(P, WS_Y); unsigned char* R1 = P.ws + WS_R1
#define IN(k) (lo <= (k) && (k) < hi)
#define SEAM(k) do { if (IN(k) && IN((k) + 1)) { xcd_barrier(bar); if (PROBE_DUP & 1048576) xcd_barrier(bar); } } while (0)
template <int l> DI void layer_phases(const Ctx& C0, const Params& Parg, const int lo, const int hi, const XcdBarrier& bar) {
    constexpr int pb = PH_L0 + l * PH_PER_LAYER;
        if (IN(pb + 0)) { PHASE_ENV(); for (int rep = 0; rep < NREP(8); ++rep) phase_convert_layer(C, P, l);
            if (l == 0) phase_rownorm<false, true, false, true>(C, P, P.norm_mix + l * DM); else if (!(ENABLE_MASK & 32)) phase_rownorm<false, true, false>(C, P, P.norm_mix + l * DM); else phase_rownorm<true, true, false>(C, P, P.norm_mix + l * DM); } SEAM(pb + 0);
        if (IN(pb + 1)) for (int rep = 0; rep < NREP(16); ++rep) { PHASE_ENV();
            { pg8::DenseOrder S; S.init(H, wsp<bf16_t>(P, W_IN), NTOK, 2560, 1024, 1024, C.G, C.bid);
              EpiStore<0> E{(bf16_t*)(R1 + R1_PROJ), PROJ_LD}; pg8::gemm_phase<EpiStore<0>, pg8::DenseOrder, false>(C.tid, lds, 1024, 1024, 1024, S, E); }
            { pg8::DenseOrder S; S.init(wsp<bf16_t>(P, W_V), H, 512, NTOK, 1024, 1024, C.G, (C.bid + 128) % C.G);
              EpiStore<0> E{(bf16_t*)(R1 + R1_VT), NTOK}; pg8::gemm_phase<EpiStore<0>, pg8::DenseOrder, false>(C.tid, lds, 1024, 1024, 1024, S, E); }
            if (l == 0) {
        for (int lm = 0; lm < DEPTH; ++lm) {
            const bf16_t* MEMN = wsp<bf16_t>(P, WS_MEMN) + (size_t)lm * 1024 * 1024; const bf16_t* WKV = wsp<bf16_t>(P, W_KV) + (size_t)lm * 512 * 1024;
            { pg8::DenseOrder S; S.init(MEMN, WKV, 1024, 256, 1024, 1024, C.G, (C.bid + 8 * lm) % C.G);
              EpiStore<0> E{wsp<bf16_t>(P, WS_MK) + (size_t)lm * 1024 * 256, 256}; pg8::gemm_phase<EpiStore<0>, pg8::DenseOrder, false>(C.tid, lds, 1024, 1024, 1024, S, E); }
            { pg8::DenseOrder S; S.init(WKV + (size_t)256 * 1024, MEMN, 256, 1024, 1024, 1024, C.G, (C.bid + 8 * lm + 4) % C.G);
              EpiStore<0> E{wsp<bf16_t>(P, WS_MVT) + (size_t)lm * 256 * 1024, 1024}; pg8::gemm_phase<EpiStore<0>, pg8::DenseOrder, false>(C.tid, lds, 1024, 1024, 1024, S, E); }
        }
            }
        } SEAM(pb + 1);
        if (IN(pb + 2)) { PHASE_ENV(); phase_rope(C, P, l); } SEAM(pb + 2);
        if (IN(pb + 3)) { PHASE_ENV();
            for (int rep = 0; rep < NREP(1); ++rep) { if (ENABLE_MASK & 8) ZIGZAG(512, dsa_select_unit(C, P, l, u);); }
            for (int rep = 0; rep < NREP(1024); ++rep) { if (ENABLE_MASK & 2) ZIGZAG(512, hgrn_local_unit(C, P, l, u);); }
            for (int rep = 0; rep < NREP(2048); ++rep) { if (ENABLE_MASK & 4) ZIGZAG(256, sgu_unit(C, P, l, u);); }
        } SEAM(pb + 3);
        if (IN(pb + 4)) { PHASE_ENV();
            for (int rep = 0; rep < NREP(2); ++rep) { if (ENABLE_MASK & 1) causal_attn_block2<true>(C, P, l); }
            if (ENABLE_MASK & 2) { for (int u = C.G - 1 - C.bid; u < 128; u += C.G) hgrn_scan_unit(C, P, u); }
        } SEAM(pb + 4);
        if (IN(pb + 5)) {
            for (int rep = 0; rep < NREP(4); ++rep) { PHASE_ENV();
            for (int r2 = 0; r2 < NREP(2097152); ++r2) { if (ENABLE_MASK & 8) causal_attn_block2<false>(C, P, l); }
            for (int r3 = 0; r3 < NREP(4194304); ++r3) { if (ENABLE_MASK & 2) ZIGZAG(512, hgrn_out_unit(C, P, l, u);); } }
        } SEAM(pb + 5);
        if (IN(pb + 7)) for (int rep = 0; rep < NREP(128); ++rep) { PHASE_ENV();
            FusedMergeOrder S{(const char*)H, (const char*)Y, (const char*)wsp<bf16_t>(P, W_G), (const char*)wsp<bf16_t>(P, W_BR), C.G, C.bid};
            EpiFusedMerge E{(bf16_t*)(R1 + R1_GS) + (size_t)C.bid * 65536, (bf16_t*)(R1 + R1_MG), C.tid};
            pg8::gemm_phase<EpiFusedMerge, FusedMergeOrder, false>(C.tid, lds, 1024, 1024, 1024, S, E);
        } SEAM(pb + 7);
        if (IN(pb + 8)) { PHASE_ENV();
            pg8::DenseOrder S; S.init(R1 + R1_MG, wsp<bf16_t>(P, W_OUT), NTOK, 1024, 1024, 1024, C.G, C.bid);
            EpiResidNorm E{P.out, H, wsp<float>(P, WS_RSS)}; pg8::gemm_phase<EpiResidNorm, pg8::DenseOrder, false>(C.tid, lds, 1024, 1024, 1024, S, E);
        } SEAM(pb + 8);
        if (IN(pb + 10)) for (int rep = 0; rep < NREP(64); ++rep) { PHASE_ENV();
            pg8::DenseOrder S; S.init(H, wsp<bf16_t>(P, W_Q), NTOK, 256, 1024, 1024, C.G, C.bid);
            EpiStoreRstd E{(bf16_t*)(R1 + R1_MQ), 256, wsp<float>(P, WS_RSS)}; pg8::gemm_phase<EpiStoreRstd, pg8::DenseOrder, false>(C.tid, lds, 1024, 1024, 1024, S, E);
        } SEAM(pb + 10);
        if (IN(pb + 11)) for (int rep = 0; rep < NREP(64); ++rep) { PHASE_ENV(); mem_attn_block(C, P, l); } SEAM(pb + 11);
        if (IN(pb + 12)) { PHASE_ENV();
            if (ENABLE_MASK & 16) { pg8::DenseOrder S; S.init(R1 + R1_MO, wsp<bf16_t>(P, W_O), NTOK, 1024, 256, 256, C.G, C.bid);
              EpiResid E{P.out}; pg8::gemm_phase<EpiResid, pg8::DenseOrder, false>(C.tid, lds, 256, 256, 256, S, E); }
        } SEAM(pb + 12);
        if (IN(pb + 13)) { PHASE_ENV(); phase_router(C, P, l); if (PROBE_DUP & 512) { __syncthreads(); phase_router(C, P, l, true); } } SEAM(pb + 13);
        if (IN(pb + 14)) for (int rep = 0; rep < NREP(32); ++rep) { PHASE_ENV();
            moe_build_table(C, wsp<unsigned>(P, WS_CTL) + CW_CNT + 64 * l);
            MoeOrder<2, true> S{(const LAS int*)(lds + MOE_TAB), (const char*)H, (const char*)wsp<bf16_t>(P, W_GU), wsp<int>(P, WS_ROWTOK), C.G, C.bid};
            EpiGU E{(bf16_t*)(R1 + R1_HID)}; pg8::gemm_phase<EpiGU, MoeOrder<2, true>, true>(C.tid, lds, 1024, 1024, 1024, S, E);
        } SEAM(pb + 14);
        if (IN(pb + 15)) for (int rep = 0; rep < NREP(32); ++rep) { PHASE_ENV();
            moe_build_table(C, wsp<unsigned>(P, WS_CTL) + CW_CNT + 64 * l);
            MoeOrder<4, false> S{(const LAS int*)(lds + MOE_TAB), (const char*)(R1 + R1_HID), (const char*)wsp<bf16_t>(P, W_D), wsp<int>(P, WS_ROWTOK), C.G, C.bid};
            EpiDown E{(bf16_t*)(R1 + R1_YB), wsp<int>(P, WS_ROWTOK), wsp<float>(P, WS_TOKW), (const LAS int*)(lds + MOE_TAB) + 40};
            pg8::gemm_phase<EpiDown, MoeOrder<4, false>, false>(C.tid, lds, 256, 256, 256, S, E);
        } SEAM(pb + 15);
    }
__global__ void __launch_bounds__(NTHREADS, 2) mega_fwd(Params Parg) {
    extern __shared__ __attribute__((aligned(16))) unsigned char lds_raw[];
    Ctx C0; C0.lds = (LAS unsigned char*)lds_raw; C0.tid = threadIdx.x; C0.lane = C0.tid & 63; C0.wave = __builtin_amdgcn_readfirstlane((int)threadIdx.x >> 6); C0.G = gridDim.x; C0.bid = blockIdx.x;
    volatile LAS unsigned* misc = (volatile LAS unsigned*)(C0.lds + LDS_MISC);
    if (C0.tid < 4) misc[C0.tid] = 0u;
    __syncthreads();
    const int lo = Parg.ph_lo, hi = Parg.ph_hi;
    const bool use_bar = (hi - lo) > 1;
    XcdBarrier bar; bar.bar = (unsigned*)(Parg.ws + WS_CTL) + CW_BAR; bar.x = 0; bar.st = misc;
    if (use_bar) bar = xcd_barrier_post((unsigned*)(Parg.ws + WS_CTL) + CW_BAR, misc);
#define IN(k) (lo <= (k) && (k) < hi)
#define SEAM(k) do { if (IN(k) && IN((k) + 1)) { xcd_barrier(bar); if (PROBE_DUP & 1048576) xcd_barrier(bar); } } while (0)

    if (IN(0)) { PHASE_ENV(); phase_prologue(C, P); } SEAM(0);
    layer_phases<0>(C0, Parg, lo, hi, bar);
    layer_phases<1>(C0, Parg, lo, hi, bar);
    if (IN(N_PHASES - 1)) { PHASE_ENV(); if (ENABLE_MASK & 32) phase_rownorm<true, false, true>(C, P, P.norm_final); else phase_rownorm<false, false, true>(C, P, P.norm_final); }
#undef IN
#undef SEAM
}

#ifndef N_LAUNCH_MODE
#define N_LAUNCH_MODE 0
#endif
extern "C" void kernel_launch(void* const* d_in, const int* in_sizes, int n_in, void* d_out, int out_size, void* d_ws, size_t ws_size, hipStream_t stream) {
    static int grid = 0;
    if (grid == 0) {
        if (n_in != 25 || out_size != NTOK * DM || ws_size < WS_END) { fprintf(stderr, "kernel_launch: unexpected shapes (n_in %d out %d ws %zu need %zu)\n", n_in, out_size, ws_size, (size_t)WS_END); grid = -1; return; }
        int dev = 0, cus = 0;
        if (hipGetDevice(&dev) != hipSuccess || hipDeviceGetAttribute(&cus, hipDeviceAttributeMultiprocessorCount, dev) != hipSuccess) { grid = -1; return; }
        if (hipFuncSetAttribute((const void*)mega_fwd, hipFuncAttributeMaxDynamicSharedMemorySize, LDS_BYTES) != hipSuccess) { fprintf(stderr, "kernel_launch: hipFuncSetAttribute failed\n"); grid = -1; return; }
        int per_cu = 0;
        if (hipOccupancyMaxActiveBlocksPerMultiprocessor(&per_cu, (const void*)mega_fwd, NTHREADS, LDS_BYTES) != hipSuccess || per_cu < 1) { fprintf(stderr, "kernel_launch: occupancy query says %d\n", per_cu); }
        (void)hipGetLastError();
        if (cus != 256) fprintf(stderr, "kernel_launch: built for 256 CUs (one workgroup per CU); device reports %d\n", cus);
        grid = 256;
    }
    if (grid < 0) return;
    (void)hipMemsetAsync((char*)d_ws + WS_CTL, 0, CTL_BYTES, stream);
    Params p{};
    p.x = (const float*)d_in[0]; p.mem = (const float*)d_in[1]; p.positions = (const int*)d_in[2];
    p.norm_mix = (const float*)d_in[3]; p.w_in = (const float*)d_in[4]; p.diff_lambda = (const float*)d_in[5]; p.hgrn_lb = (const float*)d_in[6];
    p.spatial_w = (const float*)d_in[7]; p.spatial_b = (const float*)d_in[8]; p.w_branch = (const float*)d_in[9]; p.w_out = (const float*)d_in[10];
    p.norm_mem_q = (const float*)d_in[11]; p.norm_mem_kv = (const float*)d_in[12]; p.w_mem_q = (const float*)d_in[13]; p.w_mem_kv = (const float*)d_in[14]; p.w_mem_o = (const float*)d_in[15];
    p.norm_ffn = (const float*)d_in[16]; p.w_rg = (const float*)d_in[17]; p.b_rg = (const float*)d_in[18]; p.w_re = (const float*)d_in[19]; p.b_re = (const float*)d_in[20];
    p.w_eg = (const float*)d_in[21]; p.w_eu = (const float*)d_in[22]; p.w_ed = (const float*)d_in[23]; p.norm_final = (const float*)d_in[24];
    p.out = (float*)d_out; p.ws = (unsigned char*)d_ws;
#if N_LAUNCH_MODE == 0
    p.ph_lo = 0; p.ph_hi = N_PHASES;
    hipLaunchKernelGGL(mega_fwd, dim3(grid), dim3(NTHREADS), LDS_BYTES, stream, p);
#else
    for (int k = 0; k < N_PHASES; ++k) { p.ph_lo = k; p.ph_hi = k + 1; hipLaunchKernelGGL(mega_fwd, dim3(grid), dim3(NTHREADS), LDS_BYTES, stream, p); }
#endif
}
```

```cpp
#include <hip/hip_runtime.h>
#include <stdint.h>
#include <stdio.h>

#ifndef PROBE_DUP
#define PROBE_DUP 0
#endif
#define DI __device__ __forceinline__
#define LAS __attribute__((address_space(3)))
typedef unsigned short bf16_t;
typedef short bf16x8 __attribute__((ext_vector_type(8)));
typedef short s16x4 __attribute__((ext_vector_type(4)));
typedef float f32x2 __attribute__((ext_vector_type(2)));
typedef float f32x4 __attribute__((ext_vector_type(4)));
typedef float f32x16 __attribute__((ext_vector_type(16)));
typedef unsigned u32x2 __attribute__((ext_vector_type(2)));
typedef unsigned u32x4 __attribute__((ext_vector_type(4)));
typedef __bf16 hbf2 __attribute__((ext_vector_type(2)));

constexpr int NB = 4, SEQ = 4096, NTOK = NB * SEQ, DM = 1024, DEPTH = 2, MEMLEN = 256;
constexpr int NTHREADS = 512, NWAVES = 8;
constexpr int LDS_BYTES = 147456;
constexpr int LDS_MISC = 133120;
constexpr int IN_WIDTH = 6948;
constexpr int PROJ_LD = 2560;
constexpr int PC_AQ = 0, PC_AK = 256, PC_BQ = 512, PC_BF = 768, PC_BI = 1024, PC_BG = 1280, PC_CU = 1536, PC_CV = 1792,
              PC_DQ = 2048, PC_DK = 2304, PC_DIQ = 2368, PC_DIK = 2496, PC_DIW = 2528;
constexpr int MOE_CAP = 16384;

constexpr size_t AL(size_t x) { return (x + 255) & ~(size_t)255; }
constexpr size_t WS_CTL = 0, CTL_BYTES = 65536;
constexpr size_t W_IN = AL(WS_CTL + CTL_BYTES);
constexpr size_t W_V = W_IN + (size_t)2560 * 1024 * 2;
constexpr size_t W_G = W_V + (size_t)512 * 1024 * 2;
constexpr size_t W_BR = W_G + (size_t)4096 * 1024 * 2;
constexpr size_t W_OUT = W_BR + (size_t)4 * 1024 * 256 * 2;
constexpr size_t W_Q = W_OUT + (size_t)1024 * 1024 * 2;
constexpr size_t W_O = W_Q + (size_t)256 * 1024 * 2;
constexpr size_t W_GU = W_O + (size_t)1024 * 256 * 2;
constexpr size_t W_D = W_GU + (size_t)32 * 512 * 1024 * 2;
constexpr size_t W_SGU = W_D + (size_t)32 * 1024 * 256 * 2;
constexpr size_t W_RT = W_SGU + (size_t)4 * 128 * 128 * 2;
constexpr size_t W_RH = W_RT + (size_t)36 * 1024 * 4;
constexpr size_t W_KV = W_RH + (size_t)2 * 64 * 1024 * 2;
constexpr size_t WS_H = W_KV + (size_t)DEPTH * 512 * 1024 * 2;
constexpr size_t WS_R1 = WS_H + (size_t)NTOK * 1024 * 2;
constexpr size_t R1_BYTES = (size_t)NTOK * 4096 * 2;
constexpr size_t WS_Y = WS_R1 + R1_BYTES;
constexpr size_t WS_HS = WS_Y + (size_t)NTOK * 1024 * 2;
constexpr size_t WS_HD = WS_HS + (size_t)NB * 64 * 4 * 4096 * 4;
constexpr size_t WS_THETA = WS_HD + (size_t)NB * 64 * 256 * 4;
constexpr size_t WS_MEMN = WS_THETA + (size_t)NTOK * 8;
constexpr size_t WS_MK = WS_MEMN + (size_t)DEPTH * 1024 * 1024 * 2;
constexpr size_t WS_MVT = WS_MK + (size_t)DEPTH * 1024 * 256 * 2;
constexpr size_t WS_TOKE = WS_MVT + (size_t)DEPTH * 256 * 1024 * 2;
constexpr size_t WS_TOKW = WS_TOKE + (size_t)NTOK * 2 * 4;
constexpr size_t WS_RANK = WS_TOKW + (size_t)NTOK * 2 * 4;
constexpr size_t WS_ROWTOK = WS_RANK + (size_t)NTOK * 2 * 4;
constexpr size_t WS_MASK = WS_ROWTOK + (size_t)32 * MOE_CAP * 4;
constexpr size_t WS_RSS = WS_MASK + (size_t)NB * 128 * 128 * 64 * 2;
constexpr size_t WS_DUMMY_BASE = WS_RSS + (size_t)NTOK * 16 * 4;
constexpr size_t WS_DUMMY_OLD = WS_MASK + (size_t)NB * 128 * 128 * 64 * 2;
constexpr size_t WS_DUMMY = WS_DUMMY_BASE;
constexpr size_t WS_END = WS_DUMMY + (size_t)32 * MOE_CAP * 4;
constexpr size_t R1_PROJ = 0, R1_VT = (size_t)NTOK * PROJ_LD * 2;
constexpr size_t R1_GS = 0, R1_MG = (size_t)256 * 65536 * 2;
constexpr size_t R1_MQ = 0, R1_MO = (size_t)NTOK * 256 * 2, R1_HID = 2 * R1_MO, R1_YB = R1_HID + (size_t)40960 * 256 * 2;
constexpr size_t R1_HIDS = R1_YB + (size_t)NTOK * 2 * 1024 * 2;
static_assert(R1_HIDS + (size_t)32 * 64 * 256 * 2 <= R1_BYTES, "R1 map");
static_assert(R1_YB + (size_t)NTOK * 2 * 1024 * 2 <= R1_BYTES, "R1 map");
static_assert(R1_VT + (size_t)512 * NTOK * 2 <= R1_BYTES, "R1 map");
constexpr int CW_BAR = 0;
constexpr int CW_KMAX = 4032;
constexpr int CW_CNT = 4096;

DI bf16_t f2bf(float f) { __bf16 b = (__bf16)f; return __builtin_bit_cast(bf16_t, b); }
DI float bf2f(bf16_t b) { return __uint_as_float(((unsigned)b) << 16); }
DI unsigned pk2(float a, float b) { f32x2 v = {a, b}; hbf2 r = __builtin_convertvector(v, hbf2); return __builtin_bit_cast(unsigned, r); }
DI float bflo(unsigned w) { return __uint_as_float(w << 16); }
DI float bfhi(unsigned w) { return __uint_as_float(w & 0xffff0000u); }
DI float sigmoidf_(float x) { return __builtin_amdgcn_rcpf(1.0f + __builtin_amdgcn_exp2f(-1.4426950408889634f * x)); }
DI float siluf_(float x) { return x * __builtin_amdgcn_rcpf(1.0f + __builtin_amdgcn_exp2f(-1.4426950408889634f * x)); }
DI float fexp(float x) { return __builtin_amdgcn_exp2f(1.4426950408889634f * x); }
DI float frcp(float x) { return __builtin_amdgcn_rcpf(x); }
DI float flog(float x) { return 0.6931471805599453f * __builtin_amdgcn_logf(x); }
DI float gelu_tanh(float x) { const float u = 0.7978845608028654f * (x + 0.044715f * x * x * x); return x * frcp(1.0f + fexp(-2.0f * u)); }
DI float wave_sum(float v) { for (int o = 32; o > 0; o >>= 1) v += __shfl_xor(v, o); return v; }
DI float xhalf_max(float x) { const u32x2 r = __builtin_amdgcn_permlane32_swap(__float_as_uint(x), __float_as_uint(x), false, false); return fmaxf(__uint_as_float(r.x), __uint_as_float(r.y)); }
DI float xhalf_sum(float x) { const u32x2 r = __builtin_amdgcn_permlane32_swap(__float_as_uint(x), __float_as_uint(x), false, false); return __uint_as_float(r.x) + __uint_as_float(r.y); }
DI f32x16 mfma32(bf16x8 a, bf16x8 b, f32x16 c) { return __builtin_amdgcn_mfma_f32_32x32x16_bf16(a, b, c, 0, 0, 0); }
DI int crow(int reg, int h) { return (reg & 3) + 8 * (reg >> 2) + 4 * h; }
DI f32x16 zero16() { f32x16 z; for (int i = 0; i < 16; ++i) z[i] = 0.f; return z; }

#define XB_TMO      128
#define XB_XCNT(j)  (256  + 64 * (j))
#define XB_XSUB(j)  (1280 + 64 * (j))
#define XB_XGEN(j)  (2304 + 64 * (j))
#define XB_TOP      3328
#define XB_TOPGEN   3392
#define XCD_BAR_WORDS 3456
#define XB_SPIN_CAP (1u << 22)

DI unsigned xb_ld(unsigned* p)              { return __hip_atomic_load(p, __ATOMIC_RELAXED, __HIP_MEMORY_SCOPE_AGENT); }
DI unsigned xb_add(unsigned* p, unsigned v) { return __hip_atomic_fetch_add(p, v, __ATOMIC_RELAXED, __HIP_MEMORY_SCOPE_AGENT); }
DI unsigned xb_xcc_id() { return (unsigned)__builtin_amdgcn_s_getreg((3 << 11) | 20) & 0xFu; }
#define XB_SPIN(cond, bar) do { unsigned _sp = 0; while (cond) { __builtin_amdgcn_s_sleep(1); \
    if ((++_sp & 255u) == 0u) { if (xb_ld(&(bar)[XB_TMO])) break; if (_sp > XB_SPIN_CAP) { atomicAdd(&(bar)[XB_TMO], 1u); break; } } } } while (0)

struct XcdBarrier { unsigned* bar; unsigned x; volatile LAS unsigned* st; };

DI XcdBarrier xcd_barrier_post(unsigned* bar, volatile LAS unsigned* st) {
    XcdBarrier b; b.bar = bar; b.x = xb_xcc_id(); b.st = st;
    if (threadIdx.x == 0) (void)xb_add(&bar[XB_XCNT(b.x)], 1u);
    return b;
}
DI void xcd_barrier_complete(unsigned* bar, unsigned x, unsigned& nloc, unsigned& nx) {
    const unsigned G = gridDim.x * gridDim.y * gridDim.z;
    unsigned sum, cnt, mine, sp = 0u;
    for (;;) {
        sum = 0u; cnt = 0u; mine = 0u;
#pragma unroll
        for (unsigned j = 0; j < 16; ++j) { const unsigned c = xb_ld(&bar[XB_XCNT(j)]); sum += c; cnt += (c > 0u) ? 1u : 0u; mine = (j == x) ? c : mine; }
        if (sum == G) break;
        __builtin_amdgcn_s_sleep(1);
        if ((++sp & 255u) == 0u) { if (xb_ld(&bar[XB_TMO])) break; if (sp > XB_SPIN_CAP) { atomicAdd(&bar[XB_TMO], 1u); break; } }
    }
    nloc = mine > 0u ? mine : 1u; nx = cnt > 0u ? cnt : 1u;
}
DI void xcd_barrier(const XcdBarrier& b) {
    asm volatile("s_waitcnt vmcnt(0)" ::: "memory");
    __syncthreads();
    if (threadIdx.x == 0) {
        unsigned* bar = b.bar;
        __builtin_amdgcn_s_waitcnt(0);
        unsigned nloc = b.st[0], nx = b.st[1];
        if (nloc == 0u) { xcd_barrier_complete(bar, b.x, nloc, nx); b.st[0] = nloc; b.st[1] = nx; }
        const unsigned old = xb_add(&bar[XB_XSUB(b.x)], 1u);
        const unsigned gen = old / nloc;
        if (old + 1u == (gen + 1u) * nloc) {
            __builtin_amdgcn_fence(__ATOMIC_RELEASE, "agent");
            asm volatile("s_waitcnt vmcnt(0)" ::: "memory");
            const unsigned og = xb_add(&bar[XB_TOP], 1u);
            const unsigned tg = og / nx;
            if (og + 1u == (tg + 1u) * nx) xb_add(&bar[XB_TOPGEN], 1u);
            else XB_SPIN(xb_ld(&bar[XB_TOPGEN]) == tg, bar);
            __builtin_amdgcn_fence(__ATOMIC_ACQUIRE, "agent");
            xb_add(&bar[XB_XGEN(b.x)], 1u);
            asm volatile("s_waitcnt vmcnt(0)" ::: "memory");
        } else {
            XB_SPIN(xb_ld(&bar[XB_XGEN(b.x)]) == gen, bar);
            __builtin_amdgcn_fence(__ATOMIC_ACQUIRE, "agent");
            asm volatile("s_waitcnt vmcnt(0)" ::: "memory");
        }
    }
    __syncthreads();
}
namespace pg8 {
constexpr int BM = 256, BK = 64, HALF = 128, HTB = HALF * BK * 2, STAGE_BYTES = 8 * HTB, NXCD = 8, WGM = 8;
DI int lds_byte(int r, int c) { const int st = (r >> 4) * 2 + (c >> 5), rr = r & 15, cc = c & 31, ob = rr * 64 + cc * 2; return st * 1024 + (ob ^ (((ob >> 9) & 1) << 5)); }
DI void stage_rc(int b, int& R, int& C) { const int st = b / 1024, sb = b % 1024, swz = sb ^ (((sb >> 9) & 1) << 5); R = (st >> 1) * 16 + swz / 64; C = (st & 1) * 32 + (swz % 64) / 2; }
DI int perm32(int rho) { const int n = rho >> 4, i = rho & 15; return 8 * (i >> 2) + 4 * n + (i & 3); }

struct Unit { const char* a; const char* b; int pm, pn, x, y, nt; };

DI void tile_map(int L, int nM, int nN, int& pm, int& pn) {
    const int nwg = nM * nN; int wgid = L;
    { const int q = nwg / NXCD, r = nwg % NXCD, xcd = wgid % NXCD, off = wgid / NXCD; wgid = (xcd < r ? xcd * (q + 1) : r * (q + 1) + (xcd - r) * q) + off; }
    const int nig = WGM * nN, gid = wgid / nig, fm = gid * WGM, gsz = (nM - fm) < WGM ? (nM - fm) : WGM;
    pm = fm + ((wgid % nig) % gsz); pn = (wgid % nig) / gsz;
}
struct DenseOrder {
    const char* A; const char* B; size_t at, bt; int nM, nN, nwg, G, c;
    DI void init(const void* A_, const void* B_, int M, int N, int lda, int ldb, int G_, int c_) {
        A = (const char*)A_; B = (const char*)B_; at = (size_t)BM * lda * 2; bt = (size_t)BM * ldb * 2; nM = M / BM; nN = N / BM; nwg = nM * nN; G = G_; c = c_; }
    DI bool next(int i, Unit& u) const {
        const long L = (long)i * G + c; if (L >= nwg) return false;
        tile_map((int)L, nM, nN, u.pm, u.pn); u.a = A + (size_t)u.pm * at; u.b = B + (size_t)u.pn * bt; u.x = 0; u.y = 0; u.nt = 0; return true; }
    DI unsigned row_off(const Unit&, int) const { return 0u; }
};

#define PG8_WAIT_V(n) asm volatile("s_waitcnt vmcnt(" #n ")" ::: "memory")
#define PG8_WAIT_L(n) asm volatile("s_waitcnt lgkmcnt(" #n ")" ::: "memory")
#define PG8_BAR __builtin_amdgcn_s_barrier()
#define PG8_SCHED __builtin_amdgcn_sched_barrier(0)

template <class Epi, class Sched, bool GATHER>
DI void gemm_phase(const int tid, LAS unsigned char* lds, const int lda, const int ldb, const int K, const Sched& S, const Epi& E) {
    const int wid = __builtin_amdgcn_readfirstlane(tid >> 6), lane = tid & 63, wr = wid >> 2, wc = wid & 3, fr = lane & 15, fq = lane >> 4;
    const int nt_phase = K / BK;
    unsigned voffA[2], voffB[2]; int RA[2], CA[2];
#pragma unroll
    for (int i = 0; i < 2; ++i) { int R, C; stage_rc(tid * 16 + i * 8192, R, C); const int Rb = (R & ~31) + perm32(R & 31);
        RA[i] = R; CA[i] = C; voffA[i] = (unsigned)(R * lda + C) * 2u; voffB[i] = (unsigned)(Rb * ldb + C) * 2u; }
    const size_t kstep = (size_t)(BK * 2);
    const size_t hstepA = (size_t)HALF * lda * 2, hstepB = (size_t)HALF * ldb * 2;
    const unsigned ldsw = (unsigned)wid * 1024u;
    const int aoff = lds_byte(wr * 64 + fr, fq * 8), boff = lds_byte(wc * 32 + fr, fq * 8);
    unsigned vc[2][2], vn[2][2];
#define PG8_SA(b, h) (((b) * 2 + (h)) * HTB)
#define PG8_SB(b, h) ((4 + (b) * 2 + (h)) * HTB)
#define PG8_GL(bufoff, gptr, vo, _i) __builtin_amdgcn_global_load_lds((const unsigned*)((const char*)(gptr) + (vo)), (LAS unsigned*)(lds + (bufoff) + ldsw + (_i) * 8192), 16, 0, 0)
#define PG8_STAGE_B(bufoff, gbase) do { PG8_GL(bufoff, gbase, voffB[0], 0); PG8_GL(bufoff, gbase, voffB[1], 1); } while (0)
#define PG8_STAGE_A(bufoff, kptr, h, isnext) do { if constexpr (GATHER) { const unsigned _o0 = (isnext) ? vn[h][0] : vc[h][0], _o1 = (isnext) ? vn[h][1] : vc[h][1]; PG8_GL(bufoff, kptr, _o0, 0); PG8_GL(bufoff, kptr, _o1, 1); } \
        else { PG8_GL(bufoff, (kptr) + (h) * hstepA, voffA[0], 0); PG8_GL(bufoff, (kptr) + (h) * hstepA, voffA[1], 1); } } while (0)
#define PG8_LDA(dst, b, h) do { _Pragma("unroll") for (int m = 0; m < 4; ++m) _Pragma("unroll") for (int k = 0; k < 2; ++k) dst[m][k] = *(const LAS bf16x8*)(lds + PG8_SA(b, h) + aoff + m * 2048 + k * 1024); } while (0)
#define PG8_LDB(dst, b, h) do { _Pragma("unroll") for (int n = 0; n < 2; ++n) _Pragma("unroll") for (int k = 0; k < 2; ++k) dst[n][k] = *(const LAS bf16x8*)(lds + PG8_SB(b, h) + boff + n * 2048 + k * 1024); } while (0)
#define PG8_MMA(ai, bj, At, Bt) do { __builtin_amdgcn_s_setprio(1); _Pragma("unroll") for (int m = 0; m < 4; ++m) _Pragma("unroll") for (int n = 0; n < 2; ++n) _Pragma("unroll") for (int k = 0; k < 2; ++k) \
        acc[ai][bj][m][n] = __builtin_amdgcn_mfma_f32_16x16x32_bf16(Bt[n][k], At[m][k], acc[ai][bj][m][n], 0, 0, 0); __builtin_amdgcn_s_setprio(0); } while (0)
    Unit cur, nxt; int ui = 0;
    if (!S.next(0, cur)) return;
    f32x4 acc[2][2][4][2];
#pragma unroll
    for (int a = 0; a < 2; ++a)
#pragma unroll
        for (int b = 0; b < 2; ++b)
#pragma unroll
            for (int m = 0; m < 4; ++m)
#pragma unroll
                for (int n = 0; n < 2; ++n) acc[a][b][m][n] = (f32x4){0.f, 0.f, 0.f, 0.f};
    bf16x8 At[4][2], B0[2][2], B1[2][2];
    const char* cA = cur.a; const char* cB = cur.b;
    if constexpr (GATHER) {
#pragma unroll
        for (int h = 0; h < 2; ++h)
#pragma unroll
            for (int i = 0; i < 2; ++i) { vc[h][i] = S.row_off(cur, RA[i] + h * HALF) + (unsigned)CA[i] * 2u; vn[h][i] = vc[h][i]; }
    }
    PG8_STAGE_B(PG8_SB(0, 0), cB); PG8_STAGE_A(PG8_SA(0, 0), cA, 0, false); PG8_STAGE_B(PG8_SB(0, 1), cB + hstepB); PG8_STAGE_A(PG8_SA(0, 1), cA, 1, false);
    if (wr == 1) PG8_BAR;
    PG8_WAIT_V(4); PG8_BAR;
    PG8_STAGE_B(PG8_SB(1, 0), cB + kstep); PG8_STAGE_A(PG8_SA(1, 0), cA + kstep, 0, false); PG8_STAGE_B(PG8_SB(1, 1), cB + hstepB + kstep);
    PG8_WAIT_V(6); PG8_BAR;
    for (;;) {
        const bool has_next = S.next(ui + 1, nxt);
        const char* nA = has_next ? nxt.a : cA; const char* nB = has_next ? nxt.b : cB;
        if constexpr (GATHER) {
            if (has_next) {
#pragma unroll
                for (int h = 0; h < 2; ++h)
#pragma unroll
                    for (int i = 0; i < 2; ++i) vn[h][i] = S.row_off(nxt, RA[i] + h * HALF) + (unsigned)CA[i] * 2u;
            }
        }
        const int nt = cur.nt ? cur.nt : nt_phase;
        for (int t = 0; t < nt; t += 2) {
            const bool last = (t == nt - 2);
            int tq = t; asm volatile("" : "+s"(tq));
            const char* a1 = cA + (size_t)(tq + 1) * kstep;
            const char* a2 = last ? nA : cA + (size_t)(tq + 2) * kstep; const char* b2 = last ? nB : cB + (size_t)(tq + 2) * kstep;
            const char* a3 = a2 + kstep; const char* b3 = b2 + kstep;
            PG8_LDB(B0, 0, 0); PG8_SCHED; PG8_LDA(At, 0, 0); PG8_STAGE_A(PG8_SA(1, 1), a1, 1, false);
            PG8_WAIT_L(8); PG8_BAR; PG8_WAIT_L(0); PG8_MMA(0, 0, At, B0); PG8_BAR; PG8_SCHED;
            PG8_LDB(B1, 0, 1); PG8_STAGE_B(PG8_SB(0, 0), b2);
            PG8_BAR; PG8_WAIT_L(0); PG8_MMA(0, 1, At, B1); PG8_BAR;
            PG8_LDA(At, 0, 1); PG8_STAGE_A(PG8_SA(0, 0), a2, 0, last);
            PG8_BAR; PG8_WAIT_L(0); PG8_MMA(1, 0, At, B0); PG8_BAR; PG8_SCHED;
            PG8_STAGE_B(PG8_SB(0, 1), b2 + hstepB);
            PG8_WAIT_V(6); PG8_BAR; PG8_MMA(1, 1, At, B1); PG8_BAR;
            PG8_LDB(B0, 1, 0); PG8_SCHED; PG8_LDA(At, 1, 0); PG8_STAGE_A(PG8_SA(0, 1), a2, 1, last);
            PG8_WAIT_L(8); PG8_BAR; PG8_WAIT_L(0); PG8_MMA(0, 0, At, B0); PG8_BAR; PG8_SCHED;
            PG8_LDB(B1, 1, 1); PG8_STAGE_B(PG8_SB(1, 0), b3);
            PG8_BAR; PG8_WAIT_L(0); PG8_MMA(0, 1, At, B1); PG8_BAR;
            PG8_LDA(At, 1, 1); PG8_STAGE_A(PG8_SA(1, 0), a3, 0, last);
            PG8_BAR; PG8_WAIT_L(0); PG8_MMA(1, 0, At, B0); PG8_BAR; PG8_SCHED;
            PG8_STAGE_B(PG8_SB(1, 1), b3 + hstepB);
            PG8_WAIT_V(6); PG8_BAR; PG8_MMA(1, 1, At, B1); PG8_BAR;
        }
        { int ln2 = lane; asm volatile("" : "+v"(ln2)); E(acc, cur, wr, wc, ln2 & 15, ln2 >> 4); }
        if (!has_next) break;
#pragma unroll
        for (int a = 0; a < 2; ++a)
#pragma unroll
            for (int b = 0; b < 2; ++b)
#pragma unroll
                for (int m = 0; m < 4; ++m)
#pragma unroll
                    for (int n = 0; n < 2; ++n) acc[a][b][m][n] = (f32x4){0.f, 0.f, 0.f, 0.f};
        cur = nxt; cA = nA; cB = nB; ++ui;
        if constexpr (GATHER) {
#pragma unroll
            for (int h = 0; h < 2; ++h)
#pragma unroll
                for (int i = 0; i < 2; ++i) vc[h][i] = vn[h][i];
        }
    }
    PG8_WAIT_V(0);
    if (wr == 0) PG8_BAR;
    PG8_BAR;
#undef PG8_SA
#undef PG8_SB
#undef PG8_GL
#undef PG8_STAGE_A
#undef PG8_STAGE_B
#undef PG8_LDA
#undef PG8_LDB
#undef PG8_MMA
}
}
struct Params {
    const float* x; const float* mem; const int* positions;
    const float* norm_mix; const float* w_in; const float* diff_lambda; const float* hgrn_lb; const float* spatial_w; const float* spatial_b;
    const float* w_branch; const float* w_out; const float* norm_mem_q; const float* norm_mem_kv; const float* w_mem_q; const float* w_mem_kv; const float* w_mem_o;
    const float* norm_ffn; const float* w_rg; const float* b_rg; const float* w_re; const float* b_re; const float* w_eg; const float* w_eu; const float* w_ed; const float* norm_final;
    float* out; unsigned char* ws; int ph_lo, ph_hi;
};
struct Ctx {
    LAS unsigned char* lds; int tid, lane, wave, G, bid;
};
DI Ctx relaunder(const Ctx& C) { Ctx D = C; int w = C.wave, g = C.G, bi = C.bid; asm volatile("" : "+s"(w), "+s"(g), "+s"(bi)); D.wave = w; D.G = g; D.bid = bi; int ln; asm volatile("v_mbcnt_lo_u32_b32 %0, -1, 0\n\tv_mbcnt_hi_u32_b32 %0, -1, %0" : "=v"(ln)); D.lane = ln; D.tid = w * 64 + ln; return D; }
template <class T> DI T* wsp(const Params& P, size_t off) { return (T*)(P.ws + off); }

struct CvtJob { const float* src; bf16_t* dst; int ld_src, ncols, K, ld_dst, nb1, nb2; long ss1, ds1, ss2, ds2; const float* kscale; };
DI void cvt_transpose(const Ctx& C, const CvtJob& J) {
    LAS float* T = (LAS float*)C.lds;
    const int tn = (J.ncols + 63) >> 6, tk = J.K >> 6, per = tn * tk, total = per * J.nb1 * J.nb2;
    for (int t = C.bid; t < total; t += C.G) {
        const int bb = t / per, r = t % per, b1 = bb / J.nb2, b2 = bb % J.nb2, in_ = r / tk, ik = r % tk;
        const float* src = J.src + (size_t)b1 * J.ss1 + (size_t)b2 * J.ss2; bf16_t* dst = J.dst + (size_t)b1 * J.ds1 + (size_t)b2 * J.ds2;
        const int n0 = in_ * 64, k0 = ik * 64;
        { const int k = C.tid >> 3, c8 = (C.tid & 7) * 8;
#pragma unroll
          for (int v = 0; v < 2; ++v) { const int n = n0 + c8 + v * 4;
              f32x4 x = (f32x4){0.f, 0.f, 0.f, 0.f};
              if (n < J.ncols) x = *(const f32x4*)(src + (size_t)(k0 + k) * J.ld_src + n);
              if (J.kscale) { const float g = J.kscale[k0 + k]; x[0] *= g; x[1] *= g; x[2] *= g; x[3] *= g; }
#pragma unroll
              for (int j = 0; j < 4; ++j) T[(c8 + v * 4 + j) * 65 + k] = x[j]; } }
        __syncthreads();
        { const int n = C.tid >> 3, k8 = (C.tid & 7) * 8;
          if (n0 + n < J.ncols) { u32x4 w;
#pragma unroll
              for (int j = 0; j < 4; ++j) w[j] = pk2(T[n * 65 + k8 + 2 * j], T[n * 65 + k8 + 2 * j + 1]);
              *(u32x4*)(dst + (size_t)(n0 + n) * J.ld_dst + k0 + k8) = w; } }
        __syncthreads();
    }
}
DI CvtJob mkjob(const float* src, bf16_t* dst, int ld_src, int ncols, int K, int ld_dst, int nb1 = 1, long ss1 = 0, long ds1 = 0, int nb2 = 1, long ss2 = 0, long ds2 = 0) {
    CvtJob J; J.src = src; J.dst = dst; J.ld_src = ld_src; J.ncols = ncols; J.K = K; J.ld_dst = ld_dst; J.nb1 = nb1; J.nb2 = nb2; J.ss1 = ss1; J.ds1 = ds1; J.ss2 = ss2; J.ds2 = ds2; J.kscale = nullptr; return J; }

DI void phase_convert_layer(const Ctx& C, const Params& P, int l) {
    const float* win = P.w_in + (size_t)l * 1024 * IN_WIDTH;
    bf16_t* WIN = wsp<bf16_t>(P, W_IN); bf16_t* WV = wsp<bf16_t>(P, W_V);
    cvt_transpose(C, mkjob(win + 0, WIN, IN_WIDTH, 512, 1024, 1024));
    cvt_transpose(C, mkjob(win + 768, WIN + (size_t)512 * 1024, IN_WIDTH, 1856, 1024, 1024));
    cvt_transpose(C, mkjob(win + 2688, WIN + (size_t)2368 * 1024, IN_WIDTH, 164, 1024, 1024));
    cvt_transpose(C, mkjob(win + 512, WV, IN_WIDTH, 256, 1024, 1024));
    cvt_transpose(C, mkjob(win + 2624, WV + (size_t)256 * 1024, IN_WIDTH, 64, 1024, 1024));
    cvt_transpose(C, mkjob(win + 2852, wsp<bf16_t>(P, W_G), IN_WIDTH, 4096, 1024, 1024));
    cvt_transpose(C, mkjob(P.w_branch + (size_t)l * 4 * 256 * 1024, wsp<bf16_t>(P, W_BR), 1024, 1024, 256, 1024, 4, 256 * 1024, 256));
    cvt_transpose(C, mkjob(P.w_out + (size_t)l * 1024 * 1024, wsp<bf16_t>(P, W_OUT), 1024, 1024, 1024, 1024));
    { CvtJob J = mkjob(P.w_mem_q + (size_t)l * 1024 * 256, wsp<bf16_t>(P, W_Q), 256, 256, 1024, 1024); J.kscale = P.norm_mem_q + l * DM; cvt_transpose(C, J); }
    cvt_transpose(C, mkjob(P.w_mem_o + (size_t)l * 256 * 1024, wsp<bf16_t>(P, W_O), 1024, 1024, 256, 256));
    cvt_transpose(C, mkjob(P.w_eg + (size_t)l * 32 * 1024 * 256, wsp<bf16_t>(P, W_GU), 256, 128, 1024, 1024, 32, 1024 * 256, 512 * 1024, 2, 128, 256 * 1024));
    cvt_transpose(C, mkjob(P.w_eu + (size_t)l * 32 * 1024 * 256, wsp<bf16_t>(P, W_GU) + (size_t)128 * 1024, 256, 128, 1024, 1024, 32, 1024 * 256, 512 * 1024, 2, 128, 256 * 1024));
    cvt_transpose(C, mkjob(P.w_ed + (size_t)l * 32 * 256 * 1024, wsp<bf16_t>(P, W_D), 1024, 1024, 256, 256, 32, 256 * 1024, 1024 * 256));
    { bf16_t* z0 = WIN + (size_t)2532 * 1024; for (int i = C.bid * NTHREADS + C.tid; i < 28 * 1024; i += C.G * NTHREADS) z0[i] = 0;
      bf16_t* z1 = WV + (size_t)320 * 1024; for (int i = C.bid * NTHREADS + C.tid; i < 192 * 1024; i += C.G * NTHREADS) z1[i] = 0; }
    { bf16_t* rh = wsp<bf16_t>(P, W_RH); const float* wre = P.w_re + (size_t)l * 1024 * 32; const float* wrg = P.w_rg + (size_t)l * 1024 * 4;
      for (int i = C.bid * NTHREADS + C.tid; i < 64 * 1024; i += C.G * NTHREADS) { const int j = i >> 10, k = i & 1023;
          const float w = (j < 32) ? wre[k * 32 + j] : (j < 36 ? wrg[k * 4 + (j - 32)] : 0.f);
          const bf16_t hi = f2bf(w); rh[i] = hi; rh[64 * 1024 + i] = f2bf(w - bf2f(hi)); } }
    { const float* sw = P.spatial_w + (size_t)l * 4 * 128 * 128; bf16_t* d = wsp<bf16_t>(P, W_SGU);
      for (int i = C.bid * NTHREADS + C.tid; i < 4 * 128 * 128; i += C.G * NTHREADS) { const int s = i & 127, t = (i >> 7) & 127; d[i] = (s <= t) ? f2bf(sw[i]) : (bf16_t)0; } }
}

DI void phase_prologue(const Ctx& C, const Params& P) {
    for (int r = C.bid * NWAVES + C.wave; r < NB * MEMLEN; r += C.G * NWAVES) {
        const float* src = P.mem + (size_t)r * DM; f32x4 v[4]; float ss = 0.f;
#pragma unroll
        for (int j = 0; j < 4; ++j) { v[j] = *(const f32x4*)(src + j * 256 + C.lane * 4); ss += v[j][0] * v[j][0] + v[j][1] * v[j][1] + v[j][2] * v[j][2] + v[j][3] * v[j][3]; }
        ss = wave_sum(ss); const float rs = 1.0f / sqrtf(ss * (1.0f / DM) + 1e-6f);
        for (int l = 0; l < DEPTH; ++l) { bf16_t* dst = wsp<bf16_t>(P, WS_MEMN) + ((size_t)l * 1024 + r) * DM;
#pragma unroll
            for (int j = 0; j < 4; ++j) { const f32x4 g = *(const f32x4*)(P.norm_mem_kv + l * DM + j * 256 + C.lane * 4);
                u32x2 w; w.x = pk2(v[j][0] * rs * g[0], v[j][1] * rs * g[1]); w.y = pk2(v[j][2] * rs * g[2], v[j][3] * rs * g[3]);
                *(u32x2*)(dst + j * 256 + C.lane * 4) = w; } }
    }
    for (int l = 0; l < DEPTH; ++l)
        cvt_transpose(C, mkjob(P.w_mem_kv + (size_t)l * 1024 * 512, wsp<bf16_t>(P, W_KV) + (size_t)l * 512 * 1024, 512, 512, 1024, 1024));
}

template <bool ADD_YB, bool WRITE_H, bool FINAL, bool FROM_X = false>
DI void phase_rownorm(const Ctx& C, const Params& P, const float* gain) {
    float* XR = P.out; bf16_t* H = wsp<bf16_t>(P, WS_H); const bf16_t* YB = (const bf16_t*)(P.ws + WS_R1 + R1_YB);
    const int stride = C.G * NWAVES; int t = C.bid * NWAVES + C.wave;
    f32x4 v[4], vn[4]; u32x2 ya[4], yb[4], yan[4], ybn[4];
#define RN_LOAD(dst, da, db, tt) do { const float* src_ = (FROM_X ? P.x : (const float*)XR) + (size_t)(tt) * DM; _Pragma("unroll") for (int j = 0; j < 4; ++j) { const int c = j * 256 + C.lane * 4; dst[j] = *(const f32x4*)(src_ + c); \
        if constexpr (ADD_YB) { da[j] = *(const u32x2*)(YB + (size_t)(2 * (tt)) * DM + c); db[j] = *(const u32x2*)(YB + (size_t)(2 * (tt) + 1) * DM + c); } } } while (0)
    if (t < NTOK) RN_LOAD(v, ya, yb, t);
    for (; t < NTOK; t += stride) {
        const int tn = (t + stride < NTOK) ? t + stride : t;
        RN_LOAD(vn, yan, ybn, tn);
        float* xr = XR + (size_t)t * DM; float ss = 0.f;
#pragma unroll
        for (int j = 0; j < 4; ++j) { const int c = j * 256 + C.lane * 4;
            if constexpr (ADD_YB) { const u32x2 a = ya[j], b = yb[j];
                v[j][0] += bflo(a.x) + bflo(b.x); v[j][1] += bfhi(a.x) + bfhi(b.x); v[j][2] += bflo(a.y) + bflo(b.y); v[j][3] += bfhi(a.y) + bfhi(b.y); }
            if constexpr ((ADD_YB && !FINAL) || FROM_X) *(f32x4*)(xr + c) = v[j];
            ss += v[j][0] * v[j][0] + v[j][1] * v[j][1] + v[j][2] * v[j][2] + v[j][3] * v[j][3]; }
        ss = wave_sum(ss); const float rs = 1.0f / sqrtf(ss * (1.0f / DM) + 1e-6f);
#pragma unroll
        for (int j = 0; j < 4; ++j) { const int c = j * 256 + C.lane * 4; const f32x4 g = *(const f32x4*)(gain + c);
            const f32x4 o = (f32x4){v[j][0] * rs * g[0], v[j][1] * rs * g[1], v[j][2] * rs * g[2], v[j][3] * rs * g[3]};
            if constexpr (FINAL) *(f32x4*)(xr + c) = o;
            if constexpr (WRITE_H) { u32x2 w; w.x = pk2(o[0], o[1]); w.y = pk2(o[2], o[3]); *(u32x2*)(H + (size_t)t * DM + c) = w; } }
#pragma unroll
        for (int j = 0; j < 4; ++j) { v[j] = vn[j]; if constexpr (ADD_YB) { ya[j] = yan[j]; yb[j] = ybn[j]; } }
    }
#undef RN_LOAD
}

DI void phase_rope(const Ctx& C, const Params& P, const int l, const bool dry = false) {
    bf16_t* PROJ = (bf16_t*)(P.ws + WS_R1 + R1_PROJ);
    LAS f32x2* tab = (LAS f32x2*)(C.lds) + C.wave * 64;
    float kmx[4] = {0.f, 0.f, 0.f, 0.f};
    for (int t = C.bid * NWAVES + C.wave; t < NTOK; t += C.G * NWAVES) {
        const float pos = (float)P.positions[t];
        if (C.lane < 48) { const int i = C.lane < 16 ? C.lane : C.lane - 16; const float d = C.lane < 16 ? 32.f : 64.f;
            const float inv = powf(10000.0f, -(float)i * (2.0f / d)); const float ang = pos * inv; float s, c; sincosf(ang, &s, &c); tab[C.lane] = (f32x2){c, s}; }
        __builtin_amdgcn_wave_barrier();
        asm volatile("s_waitcnt lgkmcnt(0)" ::: "memory");
        bf16_t* row = PROJ + (size_t)t * PROJ_LD;
        { const float kv = (C.lane < 32) ? bf2f(row[PC_DIK + C.lane]) : 0.f; const float k2 = wave_sum(kv * kv); const int bb = t >> 12;
#pragma unroll
          for (int q = 0; q < 4; ++q) kmx[q] = (bb == q) ? fmaxf(kmx[q], k2) : kmx[q]; }
        for (int p = C.lane; p < 496; p += 64) {
            int col, half, ti;
            if (p < 256) { col = (p >> 4) * 32 + (p & 15); half = 16; ti = p & 15; }
            else if (p < 416) { const int q = p - 256; col = PC_DQ + (q >> 5) * 64 + (q & 31); half = 32; ti = 16 + (q & 31); }
            else { const int q = p - 416; col = PC_DIQ + (q >> 4) * 32 + (q & 15); half = 16; ti = q & 15; }
            const f32x2 cs = tab[ti]; const float x1 = bf2f(row[col]), x2 = bf2f(row[col + half]);
            if (!dry || pos < -1.0f) { row[col] = f2bf(x1 * cs.x - x2 * cs.y); row[col + half] = f2bf(x2 * cs.x + x1 * cs.y); }
        }
        __builtin_amdgcn_wave_barrier();
    }
    { LAS unsigned* km = (LAS unsigned*)(C.lds + 8192);
      __syncthreads();
      if (C.tid < 4) km[C.tid] = 0u;
      __syncthreads();
      if (C.lane < 4) { float v = 0.f;
#pragma unroll
          for (int q = 0; q < 4; ++q) v = (C.lane == q) ? kmx[q] : v;
          __hip_atomic_fetch_max(km + C.lane, __float_as_uint(v), __ATOMIC_RELAXED, __HIP_MEMORY_SCOPE_WORKGROUP); }
      __syncthreads();
      if (C.tid < 4 && !dry) atomicMax(wsp<unsigned>(P, WS_CTL) + CW_KMAX + 8 * l + C.tid, (unsigned)km[C.tid]);
      __syncthreads(); }
}
DI void sm_step(f32x16& st, const float c, float& m, float& l, f32x16& O0, f32x16& O1, bf16x8& p0, bf16x8& p1) {
    float mx = st[0];
#pragma unroll
    for (int i = 1; i < 16; ++i) mx = fmaxf(mx, st[i]);
    mx = fmaxf(mx, __shfl_xor(mx, 32));
    if (__any(mx > m)) { const float mn = fmaxf(m, mx); const float a = __builtin_amdgcn_exp2f((m - mn) * c); l *= a;
#pragma unroll
        for (int i = 0; i < 16; ++i) { O0[i] *= a; O1[i] *= a; }
        m = mn; }
    const float mc = m * c; float rs = 0.f;
#pragma unroll
    for (int i = 0; i < 16; ++i) { const float p = __builtin_amdgcn_exp2f(fmaf(st[i], c, -mc)); st[i] = p; rs += p; }
    l += rs;
    u32x4 a, b;
    a.x = pk2(st[0], st[1]); a.y = pk2(st[2], st[3]); a.z = pk2(st[4], st[5]); a.w = pk2(st[6], st[7]);
    b.x = pk2(st[8], st[9]); b.y = pk2(st[10], st[11]); b.z = pk2(st[12], st[13]); b.w = pk2(st[14], st[15]);
    p0 = __builtin_bit_cast(bf16x8, a); p1 = __builtin_bit_cast(bf16x8, b);
}
DI void apply_mask(f32x16& st, unsigned vmask) {
#pragma unroll
    for (int i = 0; i < 16; ++i) { const unsigned sel = (unsigned)__builtin_amdgcn_sbfe((int)vmask, i, 1);
        st[i] = __uint_as_float((__float_as_uint(st[i]) & sel) | (__float_as_uint(-3.0e38f) & ~sel)); }
}
DI bf16x8 vt_frag(const bf16_t* vt_row, int k0, int s2, int h) {
    const bf16_t* p = vt_row + k0 + 16 * s2 + 4 * h; const u32x2 lo = *(const u32x2*)p, hi = *(const u32x2*)(p + 8);
    u32x4 w; w.x = lo.x; w.y = lo.y; w.z = hi.x; w.w = hi.y; return __builtin_bit_cast(bf16x8, w);
}
DI unsigned causal_mask(int r, int h) { unsigned m = 0;
#pragma unroll
    for (int i = 0; i < 16; ++i) m |= (crow(i, h) <= r) ? (1u << i) : 0u;
    return m; }
DI void causal_wave_unit(int c, int w, int& bh, int& qs) { const int pi = c * 4 + (w & 3); bh = (pi >> 6) & 15; const int j = pi & 63; qs = (w < 4) ? 127 - j : j; }

struct DiffKV { bf16x8 kf[2][2]; bf16x8 vf[2][2]; };
DI void diff_load(DiffKV& t, const bf16_t* kbase, const bf16_t* vrow0, const bf16_t* vrow1, int k0, int r, int h) {
    const bf16_t* kp = kbase + (size_t)(k0 + r) * PROJ_LD + 8 * h;
#pragma unroll
    for (int m = 0; m < 2; ++m)
#pragma unroll
        for (int s = 0; s < 2; ++s) t.kf[m][s] = *(const bf16x8*)(kp + m * 32 + 16 * s);
#pragma unroll
    for (int s2 = 0; s2 < 2; ++s2) { t.vf[0][s2] = vt_frag(vrow0, k0, s2, h); t.vf[1][s2] = vt_frag(vrow1, k0, s2, h); }
}
DI void diff_step(const DiffKV& t, const bf16x8 (&qf)[2][2], bool diag, unsigned dmask, const float c, float (&mm)[2], float (&ll)[2], f32x16 (&O)[2][2]) {
#pragma unroll
    for (int m = 0; m < 2; ++m) {
        f32x16 st = mfma32(t.kf[m][0], qf[m][0], zero16()); st = mfma32(t.kf[m][1], qf[m][1], st);
        if (diag) apply_mask(st, dmask);
        bf16x8 p0, p1; sm_step(st, c, mm[m], ll[m], O[m][0], O[m][1], p0, p1);
        O[m][0] = mfma32(t.vf[0][0], p0, O[m][0]); O[m][0] = mfma32(t.vf[0][1], p1, O[m][0]);
        O[m][1] = mfma32(t.vf[1][0], p0, O[m][1]); O[m][1] = mfma32(t.vf[1][1], p1, O[m][1]);
    }
}
DI void diff_attn_wave(const Ctx& C, const Params& P, int l) {
    const bf16_t* PROJ = (const bf16_t*)(P.ws + WS_R1 + R1_PROJ); const bf16_t* VT = (const bf16_t*)(P.ws + WS_R1 + R1_VT); bf16_t* Y = wsp<bf16_t>(P, WS_Y);
    int bh, qs; causal_wave_unit(C.bid, C.wave, bh, qs);
    const int b = bh >> 2, hd = bh & 3, r = C.lane & 31, h = C.lane >> 5, tokb = b * SEQ, q0 = qs * 32, t = q0 + r;
    const float* lv = P.diff_lambda + l * 128;
    const float d1 = wave_sum(C.lane < 32 ? lv[C.lane] * lv[32 + C.lane] : 0.f), d2 = wave_sum(C.lane < 32 ? lv[64 + C.lane] * lv[96 + C.lane] : 0.f);
    const float lam_init = 0.8f - 0.6f * expf(-0.3f * (float)l), lam = expf(d1) - expf(d2) + lam_init;
    bf16x8 qf[2][2];
#pragma unroll
    for (int m = 0; m < 2; ++m)
#pragma unroll
        for (int s = 0; s < 2; ++s) qf[m][s] = *(const bf16x8*)(PROJ + (size_t)(tokb + t) * PROJ_LD + PC_AQ + hd * 64 + m * 32 + 16 * s + 8 * h);
    f32x16 O[2][2]; float mm[2] = {-1e30f, -1e30f}, ll[2] = {0.f, 0.f};
#pragma unroll
    for (int m = 0; m < 2; ++m) { O[m][0] = zero16(); O[m][1] = zero16(); }
    const float c = 0.17677669529663687f * 1.4426950408889634f;
    const int nkt = qs + 1; const unsigned dmask = causal_mask(r, h);
    const bf16_t* kbase = PROJ + (size_t)tokb * PROJ_LD + PC_AK + hd * 64;
    const bf16_t* vrow0 = VT + (size_t)(hd * 64 + r) * NTOK + tokb; const bf16_t* vrow1 = vrow0 + (size_t)32 * NTOK;
    DiffKV ta, tb; diff_load(ta, kbase, vrow0, vrow1, 0, r, h);
    for (int kt = 0; kt < nkt; kt += 2) {
        if (kt + 1 < nkt) diff_load(tb, kbase, vrow0, vrow1, (kt + 1) * 32, r, h);
        diff_step(ta, qf, kt == nkt - 1, dmask, c, mm, ll, O);
        if (kt + 1 < nkt) { if (kt + 2 < nkt) diff_load(ta, kbase, vrow0, vrow1, (kt + 2) * 32, r, h);
            diff_step(tb, qf, kt + 1 == nkt - 1, dmask, c, mm, ll, O); }
    }
    ll[0] += __shfl_xor(ll[0], 32); ll[1] += __shfl_xor(ll[1], 32);
    const float i0 = 1.0f / ll[0], i1 = lam / ll[1]; float ss = 0.f;
#pragma unroll
    for (int et = 0; et < 2; ++et)
#pragma unroll
        for (int i = 0; i < 16; ++i) { const float o = O[0][et][i] * i0 - O[1][et][i] * i1; O[0][et][i] = o; ss += o * o; }
    ss += __shfl_xor(ss, 32);
    const float rn = (1.0f - lam_init) / sqrtf(ss * (1.0f / 64.0f) + 1e-6f);
    bf16_t* yrow = Y + (size_t)(tokb + t) * DM + hd * 64;
#pragma unroll
    for (int et = 0; et < 2; ++et)
#pragma unroll
        for (int g = 0; g < 4; ++g) { u32x2 w; w.x = pk2(O[0][et][4 * g] * rn, O[0][et][4 * g + 1] * rn); w.y = pk2(O[0][et][4 * g + 2] * rn, O[0][et][4 * g + 3] * rn);
            *(u32x2*)(yrow + et * 32 + 8 * g + 4 * h) = w; }
}

struct KV64 { bf16x8 kf[4]; bf16x8 vf[2][2]; };
DI void kv64_load(KV64& t, const bf16_t* kbase, int kld, const bf16_t* vrow0, const bf16_t* vrow1, int k0, int r, int h) {
    const bf16_t* kp = kbase + (size_t)(k0 + r) * kld + 8 * h;
#pragma unroll
    for (int s = 0; s < 4; ++s) t.kf[s] = *(const bf16x8*)(kp + 16 * s);
#pragma unroll
    for (int s2 = 0; s2 < 2; ++s2) { t.vf[0][s2] = vt_frag(vrow0, k0, s2, h); t.vf[1][s2] = vt_frag(vrow1, k0, s2, h); }
}
DI void kv64_step(const KV64& t, const bf16x8 (&qf)[4], bool masked, unsigned vmask, const float c, float& mm, float& ll, f32x16 (&O)[2]) {
    f32x16 st = zero16();
#pragma unroll
    for (int s = 0; s < 4; ++s) st = mfma32(t.kf[s], qf[s], st);
    if (masked) apply_mask(st, vmask);
    bf16x8 p0, p1; sm_step(st, c, mm, ll, O[0], O[1], p0, p1);
    O[0] = mfma32(t.vf[0][0], p0, O[0]); O[0] = mfma32(t.vf[0][1], p1, O[0]);
    O[1] = mfma32(t.vf[1][0], p0, O[1]); O[1] = mfma32(t.vf[1][1], p1, O[1]);
}
DI void mem_attn_wave(const Ctx& C, const Params& P, int l) {
    const bf16_t* MQ = (const bf16_t*)(P.ws + WS_R1 + R1_MQ); bf16_t* MO = (bf16_t*)(P.ws + WS_R1 + R1_MO);
    const bf16_t* MK = wsp<bf16_t>(P, WS_MK) + (size_t)l * 1024 * 256; const bf16_t* MVT = wsp<bf16_t>(P, WS_MVT) + (size_t)l * 256 * 1024;
    const int r = C.lane & 31, h = C.lane >> 5;
    for (int wu = C.bid * NWAVES + C.wave; wu < 2048; wu += C.G * NWAVES) {
        const int bh = wu >> 7, qs = wu & 127, b = bh >> 2, hd = bh & 3, t = b * SEQ + qs * 32 + r;
        bf16x8 qf[4];
#pragma unroll
        for (int s = 0; s < 4; ++s) qf[s] = *(const bf16x8*)(MQ + (size_t)t * 256 + hd * 64 + 16 * s + 8 * h);
        f32x16 O[2] = {zero16(), zero16()}; float mm = -1e30f, ll = 0.f;
        const float c = 0.125f * 1.4426950408889634f;
        const bf16_t* kbase = MK + (size_t)(b * 256) * 256 + hd * 64;
        const bf16_t* vrow0 = MVT + (size_t)(hd * 64 + r) * 1024 + b * 256; const bf16_t* vrow1 = vrow0 + (size_t)32 * 1024;
        KV64 ta, tb; kv64_load(ta, kbase, 256, vrow0, vrow1, 0, r, h);
#pragma unroll 1
        for (int kt = 0; kt < 8; kt += 2) {
            kv64_load(tb, kbase, 256, vrow0, vrow1, (kt + 1) * 32, r, h);
            kv64_step(ta, qf, false, 0u, c, mm, ll, O);
            if (kt + 2 < 8) kv64_load(ta, kbase, 256, vrow0, vrow1, (kt + 2) * 32, r, h);
            kv64_step(tb, qf, false, 0u, c, mm, ll, O);
        }
        ll += __shfl_xor(ll, 32);
        const float il = 1.0f / ll; bf16_t* orow = MO + (size_t)t * 256 + hd * 64;
#pragma unroll
        for (int et = 0; et < 2; ++et)
#pragma unroll
            for (int g = 0; g < 4; ++g) { u32x2 w; w.x = pk2(O[et][4 * g] * il, O[et][4 * g + 1] * il); w.y = pk2(O[et][4 * g + 2] * il, O[et][4 * g + 3] * il);
                *(u32x2*)(orow + et * 32 + 8 * g + 4 * h) = w; }
    }
}

DI f32x16 idx_score(const bf16x8 (&ikf)[2], const bf16x8 (&iqf)[4][2], const float (&iw)[4]) {
    f32x16 a[4];
#pragma unroll
    for (int hh = 0; hh < 4; ++hh) a[hh] = mfma32(ikf[0], iqf[hh][0], zero16());
#pragma unroll
    for (int hh = 0; hh < 4; ++hh) a[hh] = mfma32(ikf[1], iqf[hh][1], a[hh]);
    f32x16 sc = zero16();
#pragma unroll
    for (int hh = 0; hh < 4; ++hh) {
#pragma unroll
        for (int i = 0; i < 16; ++i) { const int ab = (int)__float_as_uint(a[hh][i]); const float rl = __uint_as_float((unsigned)(ab > 0 ? ab : 0));
            sc[i] = fmaf(iw[hh], rl, sc[i]); } }
    return sc;
}
DI unsigned okey_of(float f) { const unsigned u = __float_as_uint(f); return u ^ ((unsigned)((int)u >> 31) | 0x80000000u); }
DI void load_idx_q(const bf16_t* PROJ, size_t tok, int h, bf16x8 (&iqf)[4][2], float (&iw)[4]) {
    const bf16_t* row = PROJ + tok * PROJ_LD;
#pragma unroll
    for (int hh = 0; hh < 4; ++hh) {
#pragma unroll
        for (int s = 0; s < 2; ++s) iqf[hh][s] = *(const bf16x8*)(row + PC_DIQ + hh * 32 + 16 * s + 8 * h);
        iw[hh] = bf2f(row[PC_DIW + hh]) * 0.08838834764831845f; }
}

template <int PASS> DI void d1_digit(unsigned ok, unsigned sinv, unsigned mv, unsigned mb, bool& match, unsigned& dg) {
    if constexpr (PASS == 0) { match = true; dg = ok >> 21; }
    else if constexpr (PASS == 1) { match = (ok >> 21) == mv; dg = (ok >> 10) & 2047u; }
    else if constexpr (PASS == 2) { match = (ok >> 10) == mv; dg = ((ok & 1023u) << 1) | (sinv >> 11); }
    else { match = (ok == mv) && ((sinv >> 11) == mb); dg = sinv & 2047u; }
}
constexpr int D1_HSTRIDE = 1025;
DI unsigned lin_bin(float sc, float lin_a, float lin_b) { return (unsigned)__builtin_amdgcn_fmed3f(fmaf(sc, lin_a, lin_b), 0.f, 2047.f); }
template <int PASS> DI void d1_pass(const Ctx& C, const bf16_t* PROJ, int tokb, int q0, int nkt, const bf16x8 (&iqf)[4][2], const float (&iw)[4], LAS unsigned* hist, volatile LAS unsigned* QS, const float lin_a = 0.f, const float lin_b = 0.f) {
    const int r = C.lane & 31, h = C.lane >> 5;
    const unsigned mv = QS[r * 4 + 0], mb = QS[r * 4 + 1];
    LAS unsigned* hrow = hist + r * D1_HSTRIDE;
    const bf16_t* kp0 = PROJ + (size_t)(tokb + r) * PROJ_LD + PC_DIK + 8 * h;
    bf16x8 ikf[2], ikn[2];
    if (C.wave < nkt) { const bf16_t* kp = kp0 + (size_t)(C.wave * 32) * PROJ_LD; ikf[0] = *(const bf16x8*)kp; ikf[1] = *(const bf16x8*)(kp + 16); }
    for (int kt = C.wave; kt < nkt; kt += NWAVES) {
        const int k0 = kt * 32;
        { const int ktn = (kt + NWAVES < nkt) ? kt + NWAVES : kt;
          const bf16_t* kp = kp0 + (size_t)(ktn * 32) * PROJ_LD; ikn[0] = *(const bf16x8*)kp; ikn[1] = *(const bf16x8*)(kp + 16); }
        const f32x16 sc = idx_score(ikf, iqf, iw);
        const bool diag = (kt == nkt - 1);
        unsigned wadr[16], wval[16]; bool any_m = false;
#pragma unroll
        for (int i = 0; i < 16; ++i) { const unsigned ok = okey_of(sc[i]), sinv = 4095u - (unsigned)(k0 + crow(i, h));
            bool match; unsigned dg;
            if constexpr (PASS == 4) { match = true; dg = lin_bin(sc[i], lin_a, lin_b); } else d1_digit<PASS>(ok, sinv, mv, mb, match, dg);
            if (diag) match = match && (crow(i, h) <= r);
            wadr[i] = match ? (dg >> 1) : 1024u;
            wval[i] = match ? (1u << ((dg & 1u) * 16u)) : 0u; any_m = any_m || match; }
        if (PASS == 0 || PASS == 4 || __any(any_m)) {
#pragma unroll
            for (int i = 0; i < 16; ++i) __hip_atomic_fetch_add(hrow + wadr[i], wval[i], __ATOMIC_RELAXED, __HIP_MEMORY_SCOPE_WORKGROUP);
        }
        ikf[0] = ikn[0]; ikf[1] = ikn[1];
    }
    __syncthreads();
    for (int srep = ((PROBE_DUP & 32768) ? 0 : 1); srep < 2; ++srep)
    for (int qq = 0; qq < 4; ++qq) {
        const int q = C.wave * 4 + qq; const unsigned rk = QS[q * 4 + 2];
        unsigned lsum = 0;
#pragma unroll
        for (int j = 0; j < 16; ++j) { const unsigned wj = hist[q * D1_HSTRIDE + C.lane * 16 + j]; lsum += (wj & 0xffffu) + (wj >> 16); }
        unsigned x = lsum;
#pragma unroll
        for (int o = 1; o < 64; o <<= 1) { const unsigned y = __shfl_down(x, o); if (C.lane + o < 64) x += y; }
        const unsigned above = x - lsum;
        const bool hit = (above < rk) && (rk <= x);
        const unsigned long long bal = __ballot(hit); const int L = bal ? (__ffsll((long long)bal) - 1) : 0;
        const unsigned aboveL = __shfl(above, L);
        const unsigned bk = (C.lane < 32) ? (unsigned)((const LAS unsigned short*)hist)[q * (2 * D1_HSTRIDE) + L * 32 + C.lane] : 0u;
        unsigned y2 = bk;
#pragma unroll
        for (int o = 1; o < 32; o <<= 1) { const unsigned z = __shfl_down(y2, o); if (C.lane + o < 32) y2 += z; }
        const unsigned ab2 = aboveL + y2 - bk;
        const bool hit2 = (C.lane < 32) && (ab2 < rk) && (rk <= ab2 + bk);
        const unsigned long long bal2 = __ballot(hit2); const int K2 = bal2 ? (__ffsll((long long)bal2) - 1) : 0;
        unsigned bin = (unsigned)(L * 32 + K2), rnew = rk - __shfl(ab2, K2);
        if (C.lane == 0 && srep == 1) {
            const unsigned omv = QS[q * 4 + 0];
            if constexpr (PASS == 0 || PASS == 4) { QS[q * 4 + 0] = bin; }
            else if constexpr (PASS == 1) { QS[q * 4 + 0] = (omv << 11) | bin; }
            else if constexpr (PASS == 2) { QS[q * 4 + 0] = (omv << 10) | (bin >> 1); QS[q * 4 + 1] = bin & 1u; }
            else { QS[q * 4 + 3] = bin; }
            QS[q * 4 + 2] = rnew;
        }
    }
    __syncthreads();
    if constexpr (PASS == 1 || PASS == 2) { for (int crep = 0; crep < ((PROBE_DUP & 65536) ? 2 : 1); ++crep) { for (int i = C.tid; i < 32 * D1_HSTRIDE; i += NTHREADS) hist[i] = 0u; __syncthreads(); } }
}
DI void dsa_select_unit(const Ctx& C, const Params& P, int l, int u) {
    const bf16_t* PROJ = (const bf16_t*)(P.ws + WS_R1 + R1_PROJ); unsigned short* MASK = wsp<unsigned short>(P, WS_MASK);
    const int qt = 127 - (u >> 2), b = u & 3, tokb = b * SEQ, q0 = qt * 32;
    unsigned short* mrow = MASK + ((size_t)(b * 128 + qt) * 128) * 64 + C.lane;
    if (q0 + 31 < 256) {
        for (int kt = C.wave; kt <= qt; kt += NWAVES) mrow[(size_t)kt * 64] = (unsigned short)((kt == qt) ? causal_mask(C.lane & 31, C.lane >> 5) : 0xffffu);
        return; }
    LAS unsigned* hist = (LAS unsigned*)C.lds; volatile LAS unsigned* QS = (volatile LAS unsigned*)(C.lds + 32 * D1_HSTRIDE * 4);
    for (int i = C.tid; i < 32 * D1_HSTRIDE; i += NTHREADS) hist[i] = 0u;
    if (C.tid < 32) { QS[C.tid * 4 + 0] = 0u; QS[C.tid * 4 + 1] = 0u; QS[C.tid * 4 + 2] = 256u; QS[C.tid * 4 + 3] = 0u; }
    __syncthreads();
    const int r = C.lane & 31, h = C.lane >> 5;
    bf16x8 iqf[4][2]; float iw[4]; load_idx_q(PROJ, (size_t)(tokb + q0 + r), h, iqf, iw);
    const int nkt = qt + 1;
    float lin_a, lin_b;
    { const float kmax = sqrtf(__uint_as_float(wsp<unsigned>(P, WS_CTL)[CW_KMAX + 8 * l + b]));
      float hi = 0.f, lo = 0.f;
#pragma unroll
      for (int hh = 0; hh < 4; ++hh) { float n2 = 0.f;
#pragma unroll
          for (int s2 = 0; s2 < 2; ++s2) { const u32x4 w = __builtin_bit_cast(u32x4, iqf[hh][s2]);
#pragma unroll
              for (int j = 0; j < 4; ++j) { const float x0 = bflo(w[j]), x1 = bfhi(w[j]); n2 += x0 * x0 + x1 * x1; } }
          n2 += __shfl_xor(n2, 32); const float bnd = 0.5f * kmax * fabsf(iw[hh]) * sqrtf(n2);
          if (iw[hh] > 0.f) hi += bnd; else lo -= bnd; }
      const float span = hi - lo; lin_a = span > 0.f ? 2047.0f / span : 0.f; lin_b = -lo * lin_a; }
    d1_pass<4>(C, PROJ, tokb, q0, nkt, iqf, iw, hist, QS, lin_a, lin_b);
    constexpr int CCAP = 384;
    LAS unsigned long long* CAND = (LAS unsigned long long*)C.lds;
    LAS unsigned short* LM = (LAS unsigned short*)(C.lds + 98304);
    LAS unsigned* ZBM = (LAS unsigned*)(C.lds + 114688);
    LAS unsigned* ccnt = (LAS unsigned*)(C.lds + 32 * D1_HSTRIDE * 4 + 512);
    if (C.tid < 33) ccnt[C.tid] = 0u;
    __syncthreads();
    {
        const unsigned b0 = QS[r * 4 + 0];
        const bf16_t* kp0 = PROJ + (size_t)(tokb + r) * PROJ_LD + PC_DIK + 8 * h;
        bf16x8 ikf[2], ikn[2];
        if (C.wave < nkt) { const bf16_t* kp = kp0 + (size_t)(C.wave * 32) * PROJ_LD; ikf[0] = *(const bf16x8*)kp; ikf[1] = *(const bf16x8*)(kp + 16); }
        for (int kt = C.wave; kt < nkt; kt += NWAVES) {
            const int k0 = kt * 32;
            { const int ktn = (kt + NWAVES < nkt) ? kt + NWAVES : kt;
              const bf16_t* kp = kp0 + (size_t)(ktn * 32) * PROJ_LD; ikn[0] = *(const bf16x8*)kp; ikn[1] = *(const bf16x8*)(kp + 16); }
            const f32x16 sc = idx_score(ikf, iqf, iw);
            const bool diag = (kt == nkt - 1);
            unsigned above = 0, cand = 0, zer = 0;
#pragma unroll
            for (int i = 0; i < 16; ++i) { const unsigned d0 = lin_bin(sc[i], lin_a, lin_b); const bool ok_c = !diag || (crow(i, h) <= r);
                const bool inb = ok_c && d0 == b0, isz = sc[i] == 0.0f;
                above |= (ok_c && d0 > b0) ? (1u << i) : 0u; cand |= (inb && !isz) ? (1u << i) : 0u; zer |= (inb && isz) ? (1u << i) : 0u; }
            LM[kt * 64 + C.lane] = (unsigned short)above;
            { unsigned kw = 0;
#pragma unroll
              for (int g = 0; g < 4; ++g) kw |= ((zer >> (4 * g)) & 0xfu) << (8 * g + 4 * h);
              kw |= __shfl_xor(kw, 32);
              if (h == 0) ZBM[r * 128 + kt] = kw; }
            if (__any(cand != 0u)) {
                const unsigned nc = (unsigned)__popc(cand);
                unsigned pos = nc ? __hip_atomic_fetch_add(ccnt + r, nc, __ATOMIC_RELAXED, __HIP_MEMORY_SCOPE_WORKGROUP) : 0u;
#pragma unroll
                for (int i = 0; i < 16; ++i) { const bool on = (cand >> i) & 1u;
                    if (on && pos < (unsigned)CCAP) CAND[r * CCAP + pos] = ((unsigned long long)okey_of(sc[i]) << 12) | (unsigned long long)(4095 - (k0 + crow(i, h)));
                    pos += on ? 1u : 0u; }
            }
            ikf[0] = ikn[0]; ikf[1] = ikn[1];
        }
    }
    __syncthreads();
    if (C.tid < 32 && ccnt[C.tid] > (unsigned)CCAP) ccnt[32] = 1u;
    __syncthreads();
    if (ccnt[32] == 0u || (PROBE_DUP & 16384)) {
        const unsigned long long ZK = 0x80000000ull << 12;
        for (int qq = 0; qq < 4; ++qq) {
            const int q = C.wave * 4 + qq; const unsigned n = ccnt[q]; unsigned rk = QS[q * 4 + 2];
            unsigned long long cv[6];
#pragma unroll
            for (int j = 0; j < 6; ++j) { const unsigned idx = (unsigned)C.lane + 64u * j; cv[j] = (idx < n) ? CAND[q * CCAP + idx] : 0ull; }
            unsigned z0 = (2 * C.lane < nkt) ? ZBM[q * 128 + 2 * C.lane] : 0u, z1 = (2 * C.lane + 1 < nkt) ? ZBM[q * 128 + 2 * C.lane + 1] : 0u;
            unsigned Pc = 0, Zc;
#pragma unroll
            for (int j = 0; j < 6; ++j) Pc += (unsigned)__popcll(__ballot(cv[j] >= ZK + 4096ull));
            { unsigned zc = (unsigned)(__popc(z0) + __popc(z1)); Zc = zc;
#pragma unroll
              for (int o = 32; o > 0; o >>= 1) Zc += __shfl_xor(Zc, o); }
            unsigned long long thr;
            unsigned mz = 0;
            if (rk <= Pc || rk > Pc + Zc) {
                if (rk > Pc + Zc) { mz = Zc; }
                const bool neg = rk > Pc + Zc; const unsigned rk2 = neg ? rk - Zc : rk;
                unsigned long long cur = 0ull;
                if (n <= 64u) {
                    for (int bit = 43; bit >= 0; --bit) { const unsigned long long T = cur | (1ull << bit); if ((unsigned)__popcll(__ballot(cv[0] != 0ull && cv[0] >= T)) >= rk2) cur = T; }
                } else {
                    for (int bit = 43; bit >= 0; --bit) { const unsigned long long T = cur | (1ull << bit); unsigned cnt = 0;
#pragma unroll
                        for (int j = 0; j < 6; ++j) cnt += (unsigned)__popcll(__ballot(cv[j] != 0ull && cv[j] >= T));
                        if (cnt >= rk2) cur = T; }
                }
                thr = cur;
            } else { thr = ZK + 4096ull; mz = rk - Pc; }
#pragma unroll
            for (int j = 0; j < 6; ++j) {
                if (cv[j] != 0ull && cv[j] >= thr) { const int key = 4095 - (int)(cv[j] & 4095ull), kt = key >> 5, kk = key & 31, hh = (kk >> 2) & 1, ii = (kk & 3) + 4 * (kk >> 3);
                    const int w16 = kt * 64 + q + 32 * hh;
                    __hip_atomic_fetch_or((LAS unsigned*)LM + (w16 >> 1), 1u << (16 * (w16 & 1) + ii), __ATOMIC_RELAXED, __HIP_MEMORY_SCOPE_WORKGROUP); } }
            if (mz > 0u) {
                const unsigned c0 = (unsigned)__popc(z0), c1 = (unsigned)__popc(z1); unsigned incl = c0 + c1;
#pragma unroll
                for (int o = 1; o < 64; o <<= 1) { const unsigned y = __shfl_up(incl, o); if (C.lane >= o) incl += y; }
                unsigned before = incl - (c0 + c1);
                unsigned need0 = (before >= mz) ? 0u : ((mz - before) < c0 ? (mz - before) : c0);
                while ((unsigned)__popc(z0) > need0) z0 &= ~(0x80000000u >> __clz(z0));
                before += c0;
                unsigned need1 = (before >= mz) ? 0u : ((mz - before) < c1 ? (mz - before) : c1);
                while ((unsigned)__popc(z1) > need1) z1 &= ~(0x80000000u >> __clz(z1));
#pragma unroll
                for (int tz = 0; tz < 2; ++tz) { const unsigned zw = tz ? z1 : z0; const int kt = 2 * C.lane + tz;
                    if (zw) {
#pragma unroll
                        for (int hh = 0; hh < 2; ++hh) { unsigned m16 = 0;
#pragma unroll
                            for (int g = 0; g < 4; ++g) m16 |= ((zw >> (8 * g + 4 * hh)) & 0xfu) << (4 * g);
                            const int w16 = kt * 64 + q + 32 * hh;
                            if (m16) __hip_atomic_fetch_or((LAS unsigned*)LM + (w16 >> 1), m16 << (16 * (w16 & 1)), __ATOMIC_RELAXED, __HIP_MEMORY_SCOPE_WORKGROUP); } } }
            }
        }
        __syncthreads();
        { const LAS unsigned* src = (const LAS unsigned*)LM; unsigned* dst = (unsigned*)(MASK + ((size_t)(b * 128 + qt) * 128) * 64);
          for (int i = C.tid; i < nkt * 32; i += NTHREADS) dst[i] = src[i]; }
        __syncthreads();
        return;
    }
    for (int i = C.tid; i < 32 * D1_HSTRIDE; i += NTHREADS) hist[i] = 0u;
    if (C.tid < 32) { QS[C.tid * 4 + 0] = 0u; QS[C.tid * 4 + 1] = 0u; QS[C.tid * 4 + 2] = 256u; QS[C.tid * 4 + 3] = 0u; }
    __syncthreads();
    d1_pass<0>(C, PROJ, tokb, q0, nkt, iqf, iw, hist, QS);
    for (int i = C.tid; i < 32 * D1_HSTRIDE; i += NTHREADS) hist[i] = 0u;
    __syncthreads();
    d1_pass<1>(C, PROJ, tokb, q0, nkt, iqf, iw, hist, QS);
    d1_pass<2>(C, PROJ, tokb, q0, nkt, iqf, iw, hist, QS);
    d1_pass<3>(C, PROJ, tokb, q0, nkt, iqf, iw, hist, QS);
    {
      const unsigned long long theta = ((unsigned long long)QS[r * 4 + 0] << 12) | ((unsigned long long)QS[r * 4 + 1] << 11) | QS[r * 4 + 3];
      for (int rep = 0; rep < ((PROBE_DUP & 4096) ? 2 : 1); ++rep)
      for (int kt = C.wave; kt < nkt; kt += NWAVES) {
          const int k0 = kt * 32; bf16x8 ikf[2];
          const bf16_t* kp = PROJ + (size_t)(tokb + k0 + r) * PROJ_LD + PC_DIK + 8 * h;
          ikf[0] = *(const bf16x8*)kp; ikf[1] = *(const bf16x8*)(kp + 16);
          const f32x16 sc = idx_score(ikf, iqf, iw);
          unsigned vmask = 0;
#pragma unroll
          for (int i = 0; i < 16; ++i) { const int key = k0 + crow(i, h); const unsigned long long comp = ((unsigned long long)okey_of(sc[i]) << 12) | (unsigned long long)(4095 - key);
              vmask |= (key <= q0 + r && comp >= theta) ? (1u << i) : 0u; }
          mrow[(size_t)kt * 64] = (unsigned short)vmask; } }
    __syncthreads();
}

DI void dsa_attn_wave(const Ctx& C, const Params& P) {
    const bf16_t* PROJ = (const bf16_t*)(P.ws + WS_R1 + R1_PROJ); const bf16_t* VT = (const bf16_t*)(P.ws + WS_R1 + R1_VT); bf16_t* Y = wsp<bf16_t>(P, WS_Y);
    const unsigned short* MASK = wsp<unsigned short>(P, WS_MASK);
    int bh, qs; causal_wave_unit(C.bid, C.wave, bh, qs);
    const int b = bh >> 2, hd = bh & 3, r = C.lane & 31, h = C.lane >> 5, tokb = b * SEQ, q0 = qs * 32, t = q0 + r;
    bf16x8 qf[4];
#pragma unroll
    for (int s = 0; s < 4; ++s) qf[s] = *(const bf16x8*)(PROJ + (size_t)(tokb + t) * PROJ_LD + PC_DQ + hd * 64 + 16 * s + 8 * h);
    f32x16 O[2] = {zero16(), zero16()}; float mm = -1e30f, ll = 0.f;
    const float c = 0.125f * 1.4426950408889634f;
    const int nkt = qs + 1;
    const bf16_t* kbase = PROJ + (size_t)tokb * PROJ_LD + PC_DK;
    const bf16_t* vrow0 = VT + (size_t)(256 + r) * NTOK + tokb; const bf16_t* vrow1 = vrow0 + (size_t)32 * NTOK;
    const unsigned short* mrow = MASK + ((size_t)(b * 128 + qs) * 128) * 64 + C.lane;
    KV64 ta, tb; unsigned ma, mb;
    kv64_load(ta, kbase, PROJ_LD, vrow0, vrow1, 0, r, h); ma = mrow[0];
    for (int kt = 0; kt < nkt; kt += 2) {
        if (kt + 1 < nkt) { kv64_load(tb, kbase, PROJ_LD, vrow0, vrow1, (kt + 1) * 32, r, h); mb = mrow[(size_t)(kt + 1) * 64]; }
        kv64_step(ta, qf, true, ma, c, mm, ll, O);
        if (kt + 1 < nkt) { if (kt + 2 < nkt) { kv64_load(ta, kbase, PROJ_LD, vrow0, vrow1, (kt + 2) * 32, r, h); ma = mrow[(size_t)(kt + 2) * 64]; }
            kv64_step(tb, qf, true, mb, c, mm, ll, O); }
    }
    ll += __shfl_xor(ll, 32);
    const float il = 1.0f / ll; bf16_t* yrow = Y + (size_t)(tokb + t) * DM + 768 + hd * 64;
#pragma unroll
    for (int et = 0; et < 2; ++et)
#pragma unroll
        for (int g = 0; g < 4; ++g) { u32x2 w; w.x = pk2(O[et][4 * g] * il, O[et][4 * g + 1] * il); w.y = pk2(O[et][4 * g + 2] * il, O[et][4 * g + 3] * il);
            *(u32x2*)(yrow + et * 32 + 8 * g + 4 * h) = w; }
}

constexpr int CA_KB = 64 * 144, CA_VB = 64 * 136, CA_BUF = CA_KB + CA_VB;
template <bool DIFF>
DI void causal_attn_block(const Ctx& C, const Params& P, int l) {
    const bf16_t* PROJ = (const bf16_t*)(P.ws + WS_R1 + R1_PROJ); const bf16_t* VT = (const bf16_t*)(P.ws + WS_R1 + R1_VT); bf16_t* Y = wsp<bf16_t>(P, WS_Y);
    const unsigned short* MASK = wsp<unsigned short>(P, WS_MASK);
    const int bh = (C.bid >> 4) & 15, g = C.bid & 15, j0 = 4 * g, b = bh >> 2, hd = bh & 3, tokb = b * SEQ;
#if (PROBE_DUP & 262144)
    const int qs = ((C.wave & 1) == 0) ? 127 - (j0 + (C.wave >> 1)) : j0 + (C.wave >> 1);
#else
    const int qs = (C.wave < 4) ? 127 - (j0 + C.wave) : j0 + (C.wave - 4);
#endif
    const int r = C.lane & 31, h = C.lane >> 5, q0 = qs * 32, t = q0 + r;
    const int nsub = qs + 1, NT = (128 - j0 + 1) >> 1;
    const int kcol = DIFF ? PC_AK + hd * 64 : PC_DK, vrb = DIFF ? hd * 64 : 256;
    const int srow = C.tid >> 3, sch = C.tid & 7;
    const bf16_t* kg = PROJ + (size_t)(tokb + srow) * PROJ_LD + kcol + sch * 8;
    const bf16_t* vg = VT + (size_t)(vrb + srow) * NTOK + tokb + sch * 8;
    LAS unsigned char* kdst = C.lds + srow * 144 + sch * 16; LAS unsigned char* vdst = C.lds + CA_KB + srow * 136 + sch * 16;
    bf16x8 qfd[2][2], qf4[4];
    if constexpr (DIFF) {
#pragma unroll
        for (int m = 0; m < 2; ++m)
#pragma unroll
            for (int s = 0; s < 2; ++s) qfd[m][s] = *(const bf16x8*)(PROJ + (size_t)(tokb + t) * PROJ_LD + PC_AQ + hd * 64 + m * 32 + 16 * s + 8 * h);
    } else {
#pragma unroll
        for (int s = 0; s < 4; ++s) qf4[s] = *(const bf16x8*)(PROJ + (size_t)(tokb + t) * PROJ_LD + PC_DQ + hd * 64 + 16 * s + 8 * h);
    }
    f32x16 O[2][2]; float mm[2] = {-1e30f, -1e30f}, ll[2] = {0.f, 0.f};
#pragma unroll
    for (int m = 0; m < 2; ++m) { O[m][0] = zero16(); O[m][1] = zero16(); }
    const float c = (DIFF ? 0.17677669529663687f : 0.125f) * 1.4426950408889634f;
    const unsigned dmask = causal_mask(r, h);
    const unsigned short* mrow = MASK + ((size_t)(b * 128 + qs) * 128) * 64 + C.lane;
    u32x4 kreg = *(const u32x4*)kg, vreg = *(const u32x4*)vg, kr2, vr2;
    unsigned mcur[2] = {0u, 0u}, mnxt[2] = {0u, 0u}, mn2[2] = {0u, 0u};
    if constexpr (!DIFF) { mcur[0] = mrow[0]; if (1 < nsub) mcur[1] = mrow[64]; if (2 < nsub) mnxt[0] = mrow[128]; if (3 < nsub) mnxt[1] = mrow[192]; }
    *(LAS u32x4*)kdst = kreg; *(LAS u32x2*)vdst = (u32x2){vreg.x, vreg.y}; *(LAS u32x2*)(vdst + 8) = (u32x2){vreg.z, vreg.w};
    if (1 < NT) { kreg = *(const u32x4*)(kg + (size_t)64 * PROJ_LD); vreg = *(const u32x4*)(vg + 64); }
    __syncthreads();
    for (int T = 0; T < NT; ++T) {
        const int cur = T & 1;
        if (T + 2 < NT) { kr2 = *(const u32x4*)(kg + (size_t)(T + 2) * 64 * PROJ_LD); vr2 = *(const u32x4*)(vg + (T + 2) * 64);
            if constexpr (!DIFF) { if (2 * T + 4 < nsub) mn2[0] = mrow[(size_t)(2 * T + 4) * 64]; if (2 * T + 5 < nsub) mn2[1] = mrow[(size_t)(2 * T + 5) * 64]; } }
        const LAS unsigned char* KB = C.lds + cur * CA_BUF; const LAS unsigned char* VB = KB + CA_KB;
#pragma unroll
        for (int sub = 0; sub < 2; ++sub) {
            const int st = 2 * T + sub;
            if (st < nsub) {
                const LAS unsigned char* krow = KB + (sub * 32 + r) * 144 + h * 16;
                const LAS unsigned char* v0 = VB + r * 136 + (sub * 32 + 4 * h) * 2; const LAS unsigned char* v1 = v0 + 32 * 136;
                if constexpr (DIFF) {
                    DiffKV tl;
#pragma unroll
                    for (int m = 0; m < 2; ++m)
#pragma unroll
                        for (int s = 0; s < 2; ++s) tl.kf[m][s] = *(const LAS bf16x8*)(krow + m * 64 + s * 32);
#pragma unroll
                    for (int s2 = 0; s2 < 2; ++s2) {
                        { const u32x2 lo = *(const LAS u32x2*)(v0 + s2 * 32), hi = *(const LAS u32x2*)(v0 + s2 * 32 + 16); u32x4 w; w.x = lo.x; w.y = lo.y; w.z = hi.x; w.w = hi.y; tl.vf[0][s2] = __builtin_bit_cast(bf16x8, w); }
                        { const u32x2 lo = *(const LAS u32x2*)(v1 + s2 * 32), hi = *(const LAS u32x2*)(v1 + s2 * 32 + 16); u32x4 w; w.x = lo.x; w.y = lo.y; w.z = hi.x; w.w = hi.y; tl.vf[1][s2] = __builtin_bit_cast(bf16x8, w); } }
                    diff_step(tl, qfd, st == nsub - 1, dmask, c, mm, ll, O);
                } else {
                    KV64 tl; const unsigned vm = mcur[sub];
#pragma unroll
                    for (int s = 0; s < 4; ++s) tl.kf[s] = *(const LAS bf16x8*)(krow + s * 32);
#pragma unroll
                    for (int s2 = 0; s2 < 2; ++s2) {
                        { const u32x2 lo = *(const LAS u32x2*)(v0 + s2 * 32), hi = *(const LAS u32x2*)(v0 + s2 * 32 + 16); u32x4 w; w.x = lo.x; w.y = lo.y; w.z = hi.x; w.w = hi.y; tl.vf[0][s2] = __builtin_bit_cast(bf16x8, w); }
                        { const u32x2 lo = *(const LAS u32x2*)(v1 + s2 * 32), hi = *(const LAS u32x2*)(v1 + s2 * 32 + 16); u32x4 w; w.x = lo.x; w.y = lo.y; w.z = hi.x; w.w = hi.y; tl.vf[1][s2] = __builtin_bit_cast(bf16x8, w); } }
                    kv64_step(tl, qf4, true, vm, c, mm[0], ll[0], O[0]);
                }
            }
        }
        if (T + 1 < NT) { LAS unsigned char* kd = kdst + (cur ^ 1) * CA_BUF; LAS unsigned char* vd = vdst + (cur ^ 1) * CA_BUF;
            *(LAS u32x4*)kd = kreg; *(LAS u32x2*)vd = (u32x2){vreg.x, vreg.y}; *(LAS u32x2*)(vd + 8) = (u32x2){vreg.z, vreg.w}; }
        kreg = kr2; vreg = vr2; mcur[0] = mnxt[0]; mcur[1] = mnxt[1]; mnxt[0] = mn2[0]; mnxt[1] = mn2[1];
        __syncthreads();
    }
    if constexpr (DIFF) {
        const float* lv = P.diff_lambda + l * 128;
        const float d1 = wave_sum(C.lane < 32 ? lv[C.lane] * lv[32 + C.lane] : 0.f), d2 = wave_sum(C.lane < 32 ? lv[64 + C.lane] * lv[96 + C.lane] : 0.f);
        const float lam_init = 0.8f - 0.6f * expf(-0.3f * (float)l), lam = expf(d1) - expf(d2) + lam_init;
        ll[0] += __shfl_xor(ll[0], 32); ll[1] += __shfl_xor(ll[1], 32);
        const float i0 = 1.0f / ll[0], i1 = lam / ll[1]; float ss = 0.f;
#pragma unroll
        for (int et = 0; et < 2; ++et)
#pragma unroll
            for (int i = 0; i < 16; ++i) { const float o = O[0][et][i] * i0 - O[1][et][i] * i1; O[0][et][i] = o; ss += o * o; }
        ss += __shfl_xor(ss, 32);
        const float rn = (1.0f - lam_init) / sqrtf(ss * (1.0f / 64.0f) + 1e-6f);
        bf16_t* yrow = Y + (size_t)(tokb + t) * DM + hd * 64;
#pragma unroll
        for (int et = 0; et < 2; ++et)
#pragma unroll
            for (int gq = 0; gq < 4; ++gq) { u32x2 w; w.x = pk2(O[0][et][4 * gq] * rn, O[0][et][4 * gq + 1] * rn); w.y = pk2(O[0][et][4 * gq + 2] * rn, O[0][et][4 * gq + 3] * rn);
                *(u32x2*)(yrow + et * 32 + 8 * gq + 4 * h) = w; }
    } else {
        ll[0] += __shfl_xor(ll[0], 32);
        const float il = 1.0f / ll[0]; bf16_t* yrow = Y + (size_t)(tokb + t) * DM + 768 + hd * 64;
#pragma unroll
        for (int et = 0; et < 2; ++et)
#pragma unroll
            for (int gq = 0; gq < 4; ++gq) { u32x2 w; w.x = pk2(O[0][et][4 * gq] * il, O[0][et][4 * gq + 1] * il); w.y = pk2(O[0][et][4 * gq + 2] * il, O[0][et][4 * gq + 3] * il);
                *(u32x2*)(yrow + et * 32 + 8 * gq + 4 * h) = w; }
    }
    __syncthreads();
}

constexpr int CB_KB = 128 * 144, CB_VB = 64 * 264, CB_BUF = CB_KB + CB_VB;
template <bool DIFF>
DI void causal_attn_unit2(const Ctx& C, const Params& P, int l, int bh, int G) {
    const bf16_t* PROJ = (const bf16_t*)(P.ws + WS_R1 + R1_PROJ); const bf16_t* VT = (const bf16_t*)(P.ws + WS_R1 + R1_VT); bf16_t* Y = wsp<bf16_t>(P, WS_Y);
    const unsigned short* MASK = wsp<unsigned short>(P, WS_MASK);
    const int b = bh >> 2, hd = bh & 3, tokb = b * SEQ;
    const int qs = 4 * G + (C.wave & 3), par = C.wave >> 2;
    const int r = C.lane & 31, h = C.lane >> 5, q0 = qs * 32, t = q0 + r;
    const int NT = G + 1;
    const int kcol = DIFF ? PC_AK + hd * 64 : PC_DK, vrb = DIFF ? hd * 64 : 256;
    const int srow = C.tid >> 3, sch = C.tid & 7;
    const bf16_t* kg = PROJ + (size_t)(tokb + srow) * PROJ_LD + kcol + sch * 8;
    const bf16_t* vg = VT + (size_t)(vrb + srow) * NTOK + tokb + sch * 8;
    LAS unsigned char* kdst = C.lds + srow * 144 + sch * 16; LAS unsigned char* vdst = C.lds + CB_KB + srow * 264 + sch * 16;
    bf16x8 qfd[2][2], qf4[4];
    if constexpr (DIFF) {
#pragma unroll
        for (int m = 0; m < 2; ++m)
#pragma unroll
            for (int s = 0; s < 2; ++s) qfd[m][s] = *(const bf16x8*)(PROJ + (size_t)(tokb + t) * PROJ_LD + PC_AQ + hd * 64 + m * 32 + 16 * s + 8 * h);
    } else {
#pragma unroll
        for (int s = 0; s < 4; ++s) qf4[s] = *(const bf16x8*)(PROJ + (size_t)(tokb + t) * PROJ_LD + PC_DQ + hd * 64 + 16 * s + 8 * h);
    }
    f32x16 O[2][2]; float mm[2] = {-1e30f, -1e30f}, ll[2] = {0.f, 0.f};
#pragma unroll
    for (int m = 0; m < 2; ++m) { O[m][0] = zero16(); O[m][1] = zero16(); }
    const float c = (DIFF ? 0.17677669529663687f : 0.125f) * 1.4426950408889634f;
    const unsigned dmask = causal_mask(r, h);
    const unsigned short* mrow = MASK + ((size_t)(b * 128 + qs) * 128) * 64 + C.lane;
    u32x4 kr[2], vr[2];
#define CB_GLOAD(T_) do { kr[0] = *(const u32x4*)(kg + (size_t)((T_) * 128) * PROJ_LD); kr[1] = *(const u32x4*)(kg + (size_t)((T_) * 128 + 64) * PROJ_LD); \
        vr[0] = *(const u32x4*)(vg + (T_) * 128); vr[1] = *(const u32x4*)(vg + (T_) * 128 + 64); } while (0)
#define CB_LSTORE(buf_) do { LAS unsigned char* kd_ = kdst + (buf_) * CB_BUF; LAS unsigned char* vd_ = vdst + (buf_) * CB_BUF; \
        *(LAS u32x4*)kd_ = kr[0]; *(LAS u32x4*)(kd_ + 64 * 144) = kr[1]; \
        *(LAS u32x2*)vd_ = (u32x2){vr[0].x, vr[0].y}; *(LAS u32x2*)(vd_ + 8) = (u32x2){vr[0].z, vr[0].w}; \
        *(LAS u32x2*)(vd_ + 128) = (u32x2){vr[1].x, vr[1].y}; *(LAS u32x2*)(vd_ + 136) = (u32x2){vr[1].z, vr[1].w}; } while (0)
    unsigned mcur[2] = {0u, 0u}, mnxt[2] = {0u, 0u};
    if constexpr (!DIFF) { if (par <= qs) mcur[0] = mrow[(size_t)par * 64]; if (par + 2 <= qs) mcur[1] = mrow[(size_t)(par + 2) * 64]; }
    CB_GLOAD(0); CB_LSTORE(0);
    __syncthreads();
    int cur = 0;
    for (int T = 0; T < NT; ++T) {
        const int nxb = (cur == 2) ? 0 : cur + 1;
        if (T + 1 < NT) { CB_GLOAD(T + 1);
            if constexpr (!DIFF) { const int s0 = 4 * (T + 1) + par; if (s0 <= qs) mnxt[0] = mrow[(size_t)s0 * 64]; if (s0 + 2 <= qs) mnxt[1] = mrow[(size_t)(s0 + 2) * 64]; } }
        const LAS unsigned char* KB = C.lds + cur * CB_BUF; const LAS unsigned char* VB = KB + CB_KB;
#pragma unroll
        for (int k2 = 0; k2 < 2; ++k2) {
            if (k2 == 1 && par == 1) { if (T + 1 < NT) CB_LSTORE(nxb); __syncthreads(); }
            const int sub = par + 2 * k2, st = 4 * T + sub;
            if (st <= qs) {
                const LAS unsigned char* krow = KB + (sub * 32 + r) * 144 + h * 16;
                const LAS unsigned char* v0 = VB + r * 264 + (sub * 32 + 4 * h) * 2; const LAS unsigned char* v1 = v0 + 32 * 264;
                if constexpr (DIFF) {
                    DiffKV tl;
#pragma unroll
                    for (int m = 0; m < 2; ++m)
#pragma unroll
                        for (int s = 0; s < 2; ++s) tl.kf[m][s] = *(const LAS bf16x8*)(krow + m * 64 + s * 32);
#pragma unroll
                    for (int s2 = 0; s2 < 2; ++s2) {
                        { const u32x2 lo = *(const LAS u32x2*)(v0 + s2 * 32), hi = *(const LAS u32x2*)(v0 + s2 * 32 + 16); u32x4 w; w.x = lo.x; w.y = lo.y; w.z = hi.x; w.w = hi.y; tl.vf[0][s2] = __builtin_bit_cast(bf16x8, w); }
                        { const u32x2 lo = *(const LAS u32x2*)(v1 + s2 * 32), hi = *(const LAS u32x2*)(v1 + s2 * 32 + 16); u32x4 w; w.x = lo.x; w.y = lo.y; w.z = hi.x; w.w = hi.y; tl.vf[1][s2] = __builtin_bit_cast(bf16x8, w); } }
                    diff_step(tl, qfd, st == qs, dmask, c, mm, ll, O);
                } else {
                    KV64 tl; const unsigned vm = mcur[k2];
#pragma unroll
                    for (int s = 0; s < 4; ++s) tl.kf[s] = *(const LAS bf16x8*)(krow + s * 32);
#pragma unroll
                    for (int s2 = 0; s2 < 2; ++s2) {
                        { const u32x2 lo = *(const LAS u32x2*)(v0 + s2 * 32), hi = *(const LAS u32x2*)(v0 + s2 * 32 + 16); u32x4 w; w.x = lo.x; w.y = lo.y; w.z = hi.x; w.w = hi.y; tl.vf[0][s2] = __builtin_bit_cast(bf16x8, w); }
                        { const u32x2 lo = *(const LAS u32x2*)(v1 + s2 * 32), hi = *(const LAS u32x2*)(v1 + s2 * 32 + 16); u32x4 w; w.x = lo.x; w.y = lo.y; w.z = hi.x; w.w = hi.y; tl.vf[1][s2] = __builtin_bit_cast(bf16x8, w); } }
                    kv64_step(tl, qf4, true, vm, c, mm[0], ll[0], O[0]);
                }
            }
        }
        if (par == 0) { if (T + 1 < NT) CB_LSTORE(nxb); __syncthreads(); }
        mcur[0] = mnxt[0]; mcur[1] = mnxt[1]; cur = nxb;
    }
#undef CB_GLOAD
#undef CB_LSTORE
    constexpr int NM = DIFF ? 2 : 1, NV = NM * 34;
    LAS float* MA = (LAS float*)C.lds + (size_t)(C.wave & 3) * 64 * NV + C.lane;
    __syncthreads();
    if (par == 1) {
#pragma unroll
        for (int m = 0; m < NM; ++m) { MA[(m * 34 + 0) * 64] = mm[m]; MA[(m * 34 + 1) * 64] = ll[m];
#pragma unroll
            for (int et = 0; et < 2; ++et)
#pragma unroll
                for (int i = 0; i < 16; ++i) MA[(m * 34 + 2 + et * 16 + i) * 64] = O[m][et][i]; }
    }
    __syncthreads();
    if (par == 0) {
#pragma unroll
        for (int m = 0; m < NM; ++m) { const float mB = MA[(m * 34 + 0) * 64], lB = MA[(m * 34 + 1) * 64];
            const float mn = fmaxf(mm[m], mB), aA = __builtin_amdgcn_exp2f((mm[m] - mn) * c), aB = __builtin_amdgcn_exp2f((mB - mn) * c);
            ll[m] = ll[m] * aA + lB * aB;
#pragma unroll
            for (int et = 0; et < 2; ++et)
#pragma unroll
                for (int i = 0; i < 16; ++i) O[m][et][i] = O[m][et][i] * aA + MA[(m * 34 + 2 + et * 16 + i) * 64] * aB; }
        if constexpr (DIFF) {
            const float* lv = P.diff_lambda + l * 128;
            const float d1 = wave_sum(C.lane < 32 ? lv[C.lane] * lv[32 + C.lane] : 0.f), d2 = wave_sum(C.lane < 32 ? lv[64 + C.lane] * lv[96 + C.lane] : 0.f);
            const float lam_init = 0.8f - 0.6f * expf(-0.3f * (float)l), lam = expf(d1) - expf(d2) + lam_init;
            ll[0] += __shfl_xor(ll[0], 32); ll[1] += __shfl_xor(ll[1], 32);
            const float i0 = 1.0f / ll[0], i1 = lam / ll[1]; float ss = 0.f;
#pragma unroll
            for (int et = 0; et < 2; ++et)
#pragma unroll
                for (int i = 0; i < 16; ++i) { const float o = O[0][et][i] * i0 - O[1][et][i] * i1; O[0][et][i] = o; ss += o * o; }
            ss += __shfl_xor(ss, 32);
            const float rn = (1.0f - lam_init) / sqrtf(ss * (1.0f / 64.0f) + 1e-6f);
            bf16_t* yrow = Y + (size_t)(tokb + t) * DM + hd * 64;
#pragma unroll
            for (int et = 0; et < 2; ++et)
#pragma unroll
                for (int gq = 0; gq < 4; ++gq) { u32x2 w; w.x = pk2(O[0][et][4 * gq] * rn, O[0][et][4 * gq + 1] * rn); w.y = pk2(O[0][et][4 * gq + 2] * rn, O[0][et][4 * gq + 3] * rn);
                    *(u32x2*)(yrow + et * 32 + 8 * gq + 4 * h) = w; }
        } else {
            ll[0] += __shfl_xor(ll[0], 32);
            const float il = 1.0f / ll[0]; bf16_t* yrow = Y + (size_t)(tokb + t) * DM + 768 + hd * 64;
#pragma unroll
            for (int et = 0; et < 2; ++et)
#pragma unroll
                for (int gq = 0; gq < 4; ++gq) { u32x2 w; w.x = pk2(O[0][et][4 * gq] * il, O[0][et][4 * gq + 1] * il); w.y = pk2(O[0][et][4 * gq + 2] * il, O[0][et][4 * gq + 3] * il);
                    *(u32x2*)(yrow + et * 32 + 8 * gq + 4 * h) = w; }
        }
    }
    __syncthreads();
}
template <bool DIFF>
DI void causal_attn_block2(const Ctx& C, const Params& P, int l) {
    const int xj = C.bid >> 3, bh = ((C.bid & 7) * 2 + (xj >> 4)) & 15, gi = xj & 15;
    causal_attn_unit2<DIFF>(C, P, l, bh, 31 - gi);
    causal_attn_unit2<DIFF>(C, P, l, bh, gi);
}

DI void mem_attn_block(const Ctx& C, const Params& P, int l) {
    const bf16_t* MQ = (const bf16_t*)(P.ws + WS_R1 + R1_MQ); bf16_t* MO = (bf16_t*)(P.ws + WS_R1 + R1_MO);
    const bf16_t* MK = wsp<bf16_t>(P, WS_MK) + (size_t)l * 1024 * 256; const bf16_t* MVT = wsp<bf16_t>(P, WS_MVT) + (size_t)l * 256 * 1024;
    const int xj = C.bid >> 3, bh = ((C.bid & 7) * 2 + (xj >> 4)) & 15, grp = xj & 15, b = bh >> 2, hd = bh & 3, r = C.lane & 31, h = C.lane >> 5;
    const int t = b * SEQ + (grp * 8 + C.wave) * 32 + r;
    bf16x8 qf[4];
#pragma unroll
    for (int s = 0; s < 4; ++s) qf[s] = *(const bf16x8*)(MQ + (size_t)t * 256 + hd * 64 + 16 * s + 8 * h);
    { u32x4 kr[4], vr[4];
#pragma unroll
      for (int j = 0; j < 4; ++j) { const int ci = C.tid + 512 * j;
          kr[j] = *(const u32x4*)(MK + (size_t)(b * 256 + (ci >> 3)) * 256 + hd * 64 + (ci & 7) * 8);
          vr[j] = *(const u32x4*)(MVT + (size_t)(hd * 64 + (ci >> 5)) * 1024 + b * 256 + (ci & 31) * 8); }
#pragma unroll
      for (int j = 0; j < 4; ++j) { const int ci = C.tid + 512 * j;
          *(LAS u32x4*)(C.lds + (ci >> 3) * 144 + (ci & 7) * 16) = kr[j];
          LAS unsigned char* vd = C.lds + 36864 + (ci >> 5) * 520 + (ci & 31) * 16;
          *(LAS u32x2*)vd = (u32x2){vr[j].x, vr[j].y}; *(LAS u32x2*)(vd + 8) = (u32x2){vr[j].z, vr[j].w}; } }
    __syncthreads();
    f32x16 O[2] = {zero16(), zero16()}; float mm = -1e30f, ll = 0.f;
    const float c = 0.125f * 1.4426950408889634f;
#pragma unroll 2
    for (int kt = 0; kt < 8; ++kt) {
        KV64 tl; const LAS unsigned char* krow = C.lds + (kt * 32 + r) * 144 + h * 16;
        const LAS unsigned char* v0 = C.lds + 36864 + r * 520 + (kt * 32 + 4 * h) * 2; const LAS unsigned char* v1 = v0 + 32 * 520;
#pragma unroll
        for (int s = 0; s < 4; ++s) tl.kf[s] = *(const LAS bf16x8*)(krow + s * 32);
#pragma unroll
        for (int s2 = 0; s2 < 2; ++s2) {
            { const u32x2 lo = *(const LAS u32x2*)(v0 + s2 * 32), hi = *(const LAS u32x2*)(v0 + s2 * 32 + 16); u32x4 w; w.x = lo.x; w.y = lo.y; w.z = hi.x; w.w = hi.y; tl.vf[0][s2] = __builtin_bit_cast(bf16x8, w); }
            { const u32x2 lo = *(const LAS u32x2*)(v1 + s2 * 32), hi = *(const LAS u32x2*)(v1 + s2 * 32 + 16); u32x4 w; w.x = lo.x; w.y = lo.y; w.z = hi.x; w.w = hi.y; tl.vf[1][s2] = __builtin_bit_cast(bf16x8, w); } }
        kv64_step(tl, qf, false, 0u, c, mm, ll, O);
    }
    ll += __shfl_xor(ll, 32);
    const float il = 1.0f / ll; bf16_t* orow = MO + (size_t)t * 256 + hd * 64;
#pragma unroll
    for (int et = 0; et < 2; ++et)
#pragma unroll
        for (int g = 0; g < 4; ++g) { u32x2 w; w.x = pk2(O[et][4 * g] * il, O[et][4 * g + 1] * il); w.y = pk2(O[et][4 * g + 2] * il, O[et][4 * g + 3] * il);
            *(u32x2*)(orow + et * 32 + 8 * g + 4 * h) = w; }
    __syncthreads();
}
DI void mma_lds(f32x16& acc, const LAS bf16_t* A, int lda, const LAS bf16_t* Bt, int ldb, int K, int lane) {
    const int r = lane & 31, h = lane >> 5;
    for (int k0 = 0; k0 < K; k0 += 16) {
        const bf16x8 a = *(const LAS bf16x8*)(A + r * lda + k0 + 8 * h);
        const bf16x8 b = *(const LAS bf16x8*)(Bt + r * ldb + k0 + 8 * h);
        acc = mfma32(a, b, acc);
    }
}

constexpr int HG_BC = 0, HG_QT = 32768, HG_KT = 50176, HG_VT = 67584, HG_ST = 86016, HG_AT = 104448;
DI float hgrn_lb(const Params& P, int l, int ch) { if (l == 0) return 0.f; const float z0 = P.hgrn_lb[ch], z1 = P.hgrn_lb[256 + ch]; return 1.0f / (1.0f + expf(z0 - z1)); }
DI void hgrn_cumsum(const Ctx& C, const Params& P, int l, const float (&fpv)[16], int ch0) {
    LAS float* BC = (LAS float*)(C.lds + HG_BC);
    const float lb = hgrn_lb(P, l, ch0 + (C.tid & 127));
#pragma unroll
    for (int j = 0; j < 16; ++j) { const float f = lb + (1.0f - lb) * frcp(1.0f + fexp(fminf(-fpv[j], 80.f))); BC[C.tid + 512 * j] = flog(fmaxf(f, 1e-30f)); }
    __syncthreads();
    if (C.tid < 128) { float cum = 0.f;
#pragma unroll 8
        for (int s = 0; s < 64; ++s) { cum += BC[s * 128 + C.tid]; BC[s * 128 + C.tid] = cum; } }
    __syncthreads();
}
DI void hgrn_local_unit(const Ctx& C, const Params& P, int l, int u) {
    const bf16_t* PROJ = (const bf16_t*)(P.ws + WS_R1 + R1_PROJ); float* HS = wsp<float>(P, WS_HS); float* HD = wsp<float>(P, WS_HD);
    const int hp = u & 1, bc = u >> 1, b = bc >> 6, c = bc & 63, tok0 = b * SEQ + c * 64, ch0 = hp * 128;
    LAS float* BC = (LAS float*)(C.lds + HG_BC); LAS bf16_t* KT = (LAS bf16_t*)(C.lds + HG_QT);   LAS bf16_t* VT = (LAS bf16_t*)(C.lds + HG_VT);
    const int cl = C.tid & 127, ch = ch0 + cl; const float lb = hgrn_lb(P, l, ch);
    float fpv[16]; bf16_t vv[16];
#pragma unroll
    for (int j = 0; j < 16; ++j) { const bf16_t* row = PROJ + (size_t)(tok0 + (C.tid >> 7) + 4 * j) * PROJ_LD; fpv[j] = bf2f(row[PC_BF + ch]); vv[j] = row[PC_BI + ch]; }
    hgrn_cumsum(C, P, l, fpv, ch0);
#pragma unroll
    for (int j = 0; j < 16; ++j) { const int s = (C.tid >> 7) + 4 * j; const float kk = (1.0f - lb) * frcp(1.0f + fexp(fminf(fpv[j], 80.f)));
        KT[cl * 72 + s] = f2bf(kk * fexp(BC[63 * 128 + cl] - BC[s * 128 + cl])); VT[cl * 72 + s] = vv[j]; }
    if (C.tid < 128) HD[(size_t)bc * 256 + ch0 + C.tid] = fexp(BC[63 * 128 + C.tid]);
    __syncthreads();
    { const int h2 = C.wave >> 2, dkt = (C.wave >> 1) & 1, dvt = C.wave & 1, r = C.lane & 31, h = C.lane >> 5;
      f32x16 acc = zero16();
      mma_lds(acc, KT + (h2 * 64 + dkt * 32) * 72, 72, VT + (h2 * 64 + dvt * 32) * 72, 72, 64, C.lane);
      float* dst = HS + ((size_t)(bc * 4 + hp * 2 + h2) * 64) * 64;
#pragma unroll
      for (int i = 0; i < 16; ++i) dst[(dkt * 32 + crow(i, h)) * 64 + dvt * 32 + r] = acc[i]; }
    __syncthreads();
}
DI void hgrn_scan_unit(const Ctx& C, const Params& P, int u) {
    float* HS = wsp<float>(P, WS_HS); const float* HD = wsp<float>(P, WS_HD);
    const int id = u * NTHREADS + C.tid;
    const int bh = id >> 12, e = id & 4095, b = bh >> 2, hh = bh & 3, dk = e >> 6;
    float Lv[64], Dv[64];
#pragma unroll
    for (int c = 0; c < 64; ++c) { const size_t bc = (size_t)b * 64 + c; Lv[c] = HS[((bc * 4 + hh) << 12) + e]; Dv[c] = HD[bc * 256 + hh * 64 + dk]; }
    float S = 0.f;
#pragma unroll
    for (int c = 0; c < 64; ++c) { const size_t bc = (size_t)b * 64 + c; HS[((bc * 4 + hh) << 12) + e] = S; S = Dv[c] * S + Lv[c]; }
}
DI void hgrn_out_unit(const Ctx& C, const Params& P, int l, int u) {
    const bf16_t* PROJ = (const bf16_t*)(P.ws + WS_R1 + R1_PROJ); const float* HS = wsp<float>(P, WS_HS); bf16_t* Y = wsp<bf16_t>(P, WS_Y);
    const int hp = u & 1, bc = u >> 1, b = bc >> 6, c = bc & 63, tok0 = b * SEQ + c * 64, ch0 = hp * 128;
    LAS float* BC = (LAS float*)(C.lds + HG_BC); LAS bf16_t* QT = (LAS bf16_t*)(C.lds + HG_QT); LAS bf16_t* KT = (LAS bf16_t*)(C.lds + HG_KT);
    LAS bf16_t* VT = (LAS bf16_t*)(C.lds + HG_VT); LAS bf16_t* ST = (LAS bf16_t*)(C.lds + HG_ST); LAS bf16_t* AT = (LAS bf16_t*)(C.lds + HG_AT);
    const int cl = C.tid & 127, ch = ch0 + cl; const float lb = hgrn_lb(P, l, ch);
    float fpv[16], qv16[16], sp16[16]; bf16_t vv[16];
#pragma unroll
    for (int j = 0; j < 16; ++j) { const bf16_t* row = PROJ + (size_t)(tok0 + (C.tid >> 7) + 4 * j) * PROJ_LD; fpv[j] = bf2f(row[PC_BF + ch]); qv16[j] = bf2f(row[PC_BQ + ch]); vv[j] = row[PC_BI + ch];
        sp16[j] = HS[(((size_t)bc * 4 + hp * 2) << 12) + C.tid + 512 * j]; }
    hgrn_cumsum(C, P, l, fpv, ch0);
#pragma unroll
    for (int j = 0; j < 16; ++j) { const int s = (C.tid >> 7) + 4 * j; const float kk = (1.0f - lb) * frcp(1.0f + fexp(fminf(fpv[j], 80.f)));
        const float q = qv16[j] * frcp(1.0f + fexp(fminf(-qv16[j], 80.f)));
        const float bs = BC[s * 128 + cl], br = BC[31 * 128 + cl];
        QT[s * 136 + cl] = f2bf(q * fexp(fminf(bs - br, 80.f)));
        KT[s * 136 + cl] = f2bf(kk * fexp(fminf(br - bs, 80.f)));
        VT[cl * 72 + s] = vv[j]; }
#pragma unroll
    for (int j = 0; j < 16; ++j) { const int i = C.tid + 512 * j, h2 = i >> 12, e = i & 4095, dk = e >> 6, dv = e & 63;
        ST[(h2 * 64 + dv) * 72 + dk] = f2bf(sp16[j] * fexp(BC[31 * 128 + h2 * 64 + dk])); }
    __syncthreads();
    {
      const int h2 = C.wave >> 2, tt = (C.wave >> 1) & 1, st = C.wave & 1, r = C.lane & 31, h = C.lane >> 5;
      if (st <= tt) { f32x16 acc = zero16();
          mma_lds(acc, QT + (tt * 32) * 136 + h2 * 64, 136, KT + (st * 32) * 136 + h2 * 64, 136, 64, C.lane);
#pragma unroll
          for (int i = 0; i < 16; ++i) { const int t = tt * 32 + crow(i, h), s = st * 32 + r; AT[(h2 * 64 + t) * 72 + s] = (s <= t) ? f2bf(acc[i]) : (bf16_t)0; } } }
    __syncthreads();
    if (C.wave < 4) {
      const int h2 = C.wave >> 1, tt = C.wave & 1, r = C.lane & 31, h = C.lane >> 5;
      f32x16 o[2] = {zero16(), zero16()};
#pragma unroll
      for (int dvt = 0; dvt < 2; ++dvt) {
          mma_lds(o[dvt], VT + (h2 * 64 + dvt * 32) * 72, 72, AT + (h2 * 64 + tt * 32) * 72, 72, (tt + 1) * 32, C.lane);
          mma_lds(o[dvt], ST + (h2 * 64 + dvt * 32) * 72, 72, QT + (tt * 32) * 136 + h2 * 64, 136, 64, C.lane); }
      float ss = 0.f;
#pragma unroll
      for (int dvt = 0; dvt < 2; ++dvt)
#pragma unroll
          for (int i = 0; i < 16; ++i) ss += o[dvt][i] * o[dvt][i];
      ss += __shfl_xor(ss, 32);
      const float rn = 1.0f / sqrtf(ss * (1.0f / 64.0f) + 1e-6f);
      const int t = tok0 + tt * 32 + r, chb = ch0 + h2 * 64;
      const bf16_t* grow = PROJ + (size_t)t * PROJ_LD + PC_BG + chb; bf16_t* yrow = Y + (size_t)t * DM + 256 + chb;
#pragma unroll
      for (int dvt = 0; dvt < 2; ++dvt)
#pragma unroll
          for (int g = 0; g < 4; ++g) { const int dv = dvt * 32 + 8 * g + 4 * h; const u32x2 gw = *(const u32x2*)(grow + dv);
              const float g0 = siluf_(bflo(gw.x)), g1 = siluf_(bfhi(gw.x)), g2 = siluf_(bflo(gw.y)), g3 = siluf_(bfhi(gw.y));
              u32x2 w; w.x = pk2(o[dvt][4 * g] * rn * g0, o[dvt][4 * g + 1] * rn * g1); w.y = pk2(o[dvt][4 * g + 2] * rn * g2, o[dvt][4 * g + 3] * rn * g3);
              *(u32x2*)(yrow + dv) = w; } }
    __syncthreads();
}

DI void sgu_unit(const Ctx& C, const Params& P, int l, int u) {
    const bf16_t* PROJ = (const bf16_t*)(P.ws + WS_R1 + R1_PROJ); bf16_t* Y = wsp<bf16_t>(P, WS_Y); const bf16_t* SW = wsp<bf16_t>(P, W_SGU);
    const float* sb = P.spatial_b + l * 512;
    LAS bf16_t* VT = (LAS bf16_t*)C.lds; const int tok0 = (u >> 1) * 128, half = u & 1;
    u32x2 wv[16];
#pragma unroll
    for (int j = 0; j < 16; ++j) wv[j] = *(const u32x2*)(PROJ + (size_t)(tok0 + C.wave + NWAVES * j) * PROJ_LD + PC_CV + C.lane * 4);
#pragma unroll
    for (int j = 0; j < 16; ++j) {
        const int s = C.wave + NWAVES * j; const u32x2 w = wv[j];
        float v[4] = {gelu_tanh(bflo(w.x)), gelu_tanh(bfhi(w.x)), gelu_tanh(bflo(w.y)), gelu_tanh(bfhi(w.y))};
        const float mu = wave_sum(v[0] + v[1] + v[2] + v[3]) * (1.0f / 256.0f);
        float q = 0.f;
#pragma unroll
        for (int jj = 0; jj < 4; ++jj) { v[jj] -= mu; q += v[jj] * v[jj]; }
        const float rs = 1.0f / sqrtf(wave_sum(q) * (1.0f / 256.0f) + 1e-6f);
#pragma unroll
        for (int jj = 0; jj < 4; ++jj) VT[(C.lane * 4 + jj) * 136 + s] = f2bf(v[jj] * rs);
    }
    __syncthreads();
    { const int g = C.wave >> 1, dt = C.wave & 1, r = C.lane & 31, h = C.lane >> 5;
      for (int ti = 0; ti < 2; ++ti) { const int tt = half ? (1 + ti) : (ti * 3);
          f32x16 acc = zero16();
          const bf16_t* wrow = SW + ((size_t)g * 128 + tt * 32 + r) * 128 + 8 * h;
          const LAS bf16_t* vrow = VT + (g * 64 + dt * 32 + r) * 136 + 8 * h;
          bf16x8 af[8];
#pragma unroll
          for (int kk = 0; kk < 8; ++kk) af[kk] = *(const bf16x8*)(wrow + (kk < 2 * (tt + 1) ? kk * 16 : 0));
#pragma unroll
          for (int kk = 0; kk < 8; ++kk) if (kk < 2 * (tt + 1)) { const bf16x8 bb = *(const LAS bf16x8*)(vrow + kk * 16); acc = mfma32(af[kk], bb, acc); }
          const int ch = g * 64 + dt * 32 + r;
#pragma unroll
          for (int i = 0; i < 16; ++i) { const int t = tt * 32 + crow(i, h); const size_t tok = (size_t)(tok0 + t);
              const float uu = gelu_tanh(bf2f(PROJ[tok * PROJ_LD + PC_CU + ch]));
              Y[tok * DM + 512 + ch] = f2bf(uu * (acc[i] + sb[g * 128 + t])); } } }
    __syncthreads();
}

DI void phase_router(const Ctx& C, const Params& P, int l, const bool dry = false) {
    float* XR = P.out; bf16_t* H = wsp<bf16_t>(P, WS_H);
    int* TOKE = wsp<int>(P, WS_TOKE); float* TOKW = wsp<float>(P, WS_TOKW); int* RANK = wsp<int>(P, WS_RANK); int* ROWTOK = dry ? wsp<int>(P, WS_DUMMY) : wsp<int>(P, WS_ROWTOK);
    unsigned* CNT = wsp<unsigned>(P, WS_CTL) + CW_CNT + 64 * l + (dry ? 256 : 0);
    const float* gain = P.norm_ffn + l * DM;
    const float* brg = P.b_rg + l * 4; const float* bre = P.b_re + l * 32;
    LAS bf16_t* XHL = (LAS bf16_t*)C.lds; LAS float* PART = (LAS float*)C.lds; LAS float* LOG = (LAS float*)(C.lds + 32768);
    LAS unsigned* lcnt = (LAS unsigned*)(C.lds + LDS_MISC + 1024); LAS unsigned* lbase = lcnt + 32;
    if (C.tid < 32) lcnt[C.tid] = 0u;
    __syncthreads();
    const int per = NTOK / C.G;
    const int r = C.lane & 31, h = C.lane >> 5;
    for (int it = 0; it < per; it += 32) {
        const int tok0 = C.bid * per + it;
        { f32x4 v[4][4];
#pragma unroll
          for (int j = 0; j < 4; ++j) { const float* xr = XR + (size_t)(tok0 + C.wave * 4 + j) * DM;
#pragma unroll
              for (int q = 0; q < 4; ++q) v[j][q] = *(const f32x4*)(xr + q * 256 + C.lane * 4); }
#pragma unroll
          for (int j = 0; j < 4; ++j) { const int tl = C.wave * 4 + j, t = tok0 + tl; float ss = 0.f;
#pragma unroll
              for (int q = 0; q < 4; ++q) ss += v[j][q][0] * v[j][q][0] + v[j][q][1] * v[j][q][1] + v[j][q][2] * v[j][q][2] + v[j][q][3] * v[j][q][3];
              ss = wave_sum(ss); const float rs = 1.0f / sqrtf(ss * (1.0f / DM) + 1e-6f);
#pragma unroll
              for (int q = 0; q < 4; ++q) { const int c = q * 256 + C.lane * 4; const f32x4 g = *(const f32x4*)(gain + c);
                  const f32x4 o = (f32x4){v[j][q][0] * rs * g[0], v[j][q][1] * rs * g[1], v[j][q][2] * rs * g[2], v[j][q][3] * rs * g[3]};
                  u32x2 w; w.x = pk2(o[0], o[1]); w.y = pk2(o[2], o[3]); *(u32x2*)(H + (size_t)t * DM + c) = w;
                  { u32x2 wl; wl.x = pk2(o[0] - bflo(w.x), o[1] - bfhi(w.x)); wl.y = pk2(o[2] - bflo(w.y), o[3] - bfhi(w.y));
                    *(LAS u32x2*)(XHL + tl * 1032 + c) = w; *(LAS u32x2*)(XHL + 33024 + tl * 1032 + c) = wl; } } } }
        __syncthreads();
        f32x16 acc = zero16();
        { const int ct = C.wave & 1, kq = C.wave >> 1;
          const LAS bf16_t* ah = XHL + r * 1032 + kq * 256 + 8 * h; const LAS bf16_t* al = ah + 33024;
          const bf16_t* bh_ = wsp<bf16_t>(P, W_RH) + (size_t)(ct * 32 + r) * 1024 + kq * 256 + 8 * h; const bf16_t* bl_ = bh_ + (size_t)64 * 1024;
#pragma unroll 4
          for (int k0 = 0; k0 < 256; k0 += 16) { const bf16x8 xh = *(const LAS bf16x8*)(ah + k0), xl = *(const LAS bf16x8*)(al + k0);
              const bf16x8 wh = *(const bf16x8*)(bh_ + k0), wl = *(const bf16x8*)(bl_ + k0);
              acc = mfma32(xh, wh, acc); acc = mfma32(xh, wl, acc); acc = mfma32(xl, wh, acc); } }
        __syncthreads();
#pragma unroll
        for (int i = 0; i < 16; ++i) PART[(C.wave * 16 + i) * 64 + C.lane] = acc[i];
        __syncthreads();
        for (int idx = C.tid; idx < 32 * 36; idx += NTHREADS) { const int tok = idx / 36, col = idx % 36, ct = col < 32 ? 0 : 1, cc = col < 32 ? col : col - 32;
            const int hh = (tok >> 2) & 1, reg = (tok & 3) + 4 * (tok >> 3); float s = 0.f;
#pragma unroll
            for (int kq = 0; kq < 4; ++kq) s += PART[((kq * 2 + ct) * 16 + reg) * 64 + cc + 32 * hh];
            LOG[tok * 36 + col] = s; }
        __syncthreads();
        if (C.tid < 32) { const int t = tok0 + C.tid; const LAS float* lg = LOG + C.tid * 36;
            float gl[4]; int gsel = 0;
#pragma unroll
            for (int k = 0; k < 4; ++k) gl[k] = lg[32 + k] + brg[k];
            float gmax = gl[0];
#pragma unroll
            for (int k = 1; k < 4; ++k) if (gl[k] > gmax) { gmax = gl[k]; gsel = k; }
            float gsum = 0.f;
#pragma unroll
            for (int k = 0; k < 4; ++k) gsum += expf(gl[k] - gmax);
            const float pg = 1.0f / gsum;
            float pe[8]; float emax = -1e30f;
#pragma unroll
            for (int k = 0; k < 8; ++k) { pe[k] = lg[gsel * 8 + k] + bre[gsel * 8 + k]; emax = fmaxf(emax, pe[k]); }
#pragma unroll
            for (int k = 0; k < 8; ++k) pe[k] = expf(pe[k] - emax);
            int i1 = 0; float p1 = pe[0];
#pragma unroll
            for (int k = 1; k < 8; ++k) if (pe[k] > p1) { p1 = pe[k]; i1 = k; }
            int i2 = (i1 == 0) ? 1 : 0; float p2 = pe[i2];
#pragma unroll
            for (int k = 0; k < 8; ++k) if (k != i1 && pe[k] > p2) { p2 = pe[k]; i2 = k; }
            const float inv = pg / (p1 + p2);
            const int e1 = gsel * 8 + i1, e2 = gsel * 8 + i2;
            TOKE[t * 2] = e1; TOKE[t * 2 + 1] = e2; TOKW[t * 2] = p1 * inv; TOKW[t * 2 + 1] = p2 * inv;
            RANK[t * 2] = (int)__hip_atomic_fetch_add(lcnt + e1, 1u, __ATOMIC_RELAXED, __HIP_MEMORY_SCOPE_WORKGROUP);
            RANK[t * 2 + 1] = (int)__hip_atomic_fetch_add(lcnt + e2, 1u, __ATOMIC_RELAXED, __HIP_MEMORY_SCOPE_WORKGROUP); }
        __syncthreads();
    }
    if (C.tid < 32) { const unsigned n = lcnt[C.tid]; lbase[C.tid] = n ? __hip_atomic_fetch_add(CNT + C.tid, n, __ATOMIC_RELAXED, __HIP_MEMORY_SCOPE_AGENT) : 0u; }
    __syncthreads();
    asm volatile("s_waitcnt vmcnt(0)" ::: "memory");
    for (int a = C.tid; a < per * 2; a += NTHREADS) { const int ga = C.bid * per * 2 + a; const int e = TOKE[ga]; const unsigned rk = lbase[e] + (unsigned)RANK[ga];
        ROWTOK[(size_t)e * MOE_CAP + rk] = ga; }
    __syncthreads();
}
typedef f32x4 AccT[2][2][4][2];
DI u32x4 pack8(const f32x4& a, const f32x4& b) { u32x4 w; w.x = pk2(a[0], a[1]); w.y = pk2(a[2], a[3]); w.z = pk2(b[0], b[1]); w.w = pk2(b[2], b[3]); return w; }
template <int ACT> struct EpiStore {
    bf16_t* O; int ldc;
    DI void operator()(const AccT& acc, const pg8::Unit& u, int wr, int wc, int fr, int fq) const {
#pragma unroll
        for (int ai = 0; ai < 2; ++ai)
#pragma unroll
            for (int m = 0; m < 4; ++m) { const size_t row = (size_t)(u.pm * 256 + ai * 128 + wr * 64 + m * 16 + fr);
#pragma unroll
                for (int bj = 0; bj < 2; ++bj) { const int col = u.pn * 256 + bj * 128 + wc * 32 + 8 * fq; f32x4 a = acc[ai][bj][m][0], b = acc[ai][bj][m][1];
                    if (ACT == 1) {
#pragma unroll
                        for (int j = 0; j < 4; ++j) { a[j] = sigmoidf_(a[j]); b[j] = sigmoidf_(b[j]); } }
                    *(u32x4*)(O + row * ldc + col) = pack8(a, b); } }
    }
};
struct EpiMerge {
    const bf16_t* GATE; bf16_t* MG;
    DI void operator()(const AccT& acc, const pg8::Unit& u, int wr, int wc, int fr, int fq) const {
#pragma unroll
        for (int ai = 0; ai < 2; ++ai)
#pragma unroll
            for (int m = 0; m < 4; ++m) { const size_t row = (size_t)(u.pm * 256 + ai * 128 + wr * 64 + m * 16 + fr);
#pragma unroll
                for (int bj = 0; bj < 2; ++bj) { const int col = u.pn * 256 + bj * 128 + wc * 32 + 8 * fq;
                    const u32x4 g = *(const u32x4*)(GATE + row * 4096 + u.x * 1024 + col);
                    f32x4 a = acc[ai][bj][m][0], b = acc[ai][bj][m][1];
                    a[0] *= bflo(g.x); a[1] *= bfhi(g.x); a[2] *= bflo(g.y); a[3] *= bfhi(g.y); b[0] *= bflo(g.z); b[1] *= bfhi(g.z); b[2] *= bflo(g.w); b[3] *= bfhi(g.w);
                    bf16_t* dst = MG + row * 1024 + col;
                    if (u.x > 0) { const u32x4 p = *(const u32x4*)dst;
                        a[0] += bflo(p.x); a[1] += bfhi(p.x); a[2] += bflo(p.y); a[3] += bfhi(p.y); b[0] += bflo(p.z); b[1] += bfhi(p.z); b[2] += bflo(p.w); b[3] += bfhi(p.w); }
                    *(u32x4*)dst = pack8(a, b); }
                asm volatile("" ::: "memory"); }
    }
};
struct EpiResid {
    float* XR;
    DI void operator()(const AccT& acc, const pg8::Unit& u, int wr, int wc, int fr, int fq) const {
#pragma unroll
        for (int ai = 0; ai < 2; ++ai)
#pragma unroll
            for (int m = 0; m < 4; ++m) { const size_t row = (size_t)(u.pm * 256 + ai * 128 + wr * 64 + m * 16 + fr);
#pragma unroll
                for (int bj = 0; bj < 2; ++bj) { float* p = XR + row * 1024 + u.pn * 256 + bj * 128 + wc * 32 + 8 * fq;
                    const f32x4 x0 = *(const f32x4*)p, x1 = *(const f32x4*)(p + 4);
                    *(f32x4*)p = x0 + acc[ai][bj][m][0]; *(f32x4*)(p + 4) = x1 + acc[ai][bj][m][1]; }
                if (m == 3) asm volatile("" ::: "memory"); }
    }
};
struct EpiResidNorm {
    float* XR; bf16_t* XB; float* RSS;
    DI void operator()(const AccT& acc, const pg8::Unit& u, int wr, int wc, int fr, int fq) const {
#pragma unroll
        for (int ai = 0; ai < 2; ++ai)
#pragma unroll
            for (int m = 0; m < 4; ++m) { const size_t row = (size_t)(u.pm * 256 + ai * 128 + wr * 64 + m * 16 + fr); float ss = 0.f;
#pragma unroll
                for (int bj = 0; bj < 2; ++bj) { const size_t off = row * 1024 + u.pn * 256 + bj * 128 + wc * 32 + 8 * fq; float* p = XR + off;
                    const f32x4 x0 = *(const f32x4*)p + acc[ai][bj][m][0], x1 = *(const f32x4*)(p + 4) + acc[ai][bj][m][1];
                    *(f32x4*)p = x0; *(f32x4*)(p + 4) = x1; *(u32x4*)(XB + off) = pack8(x0, x1);
                    ss += (x0[0] * x0[0] + x0[1] * x0[1]) + (x0[2] * x0[2] + x0[3] * x0[3]) + (x1[0] * x1[0] + x1[1] * x1[1]) + (x1[2] * x1[2] + x1[3] * x1[3]); }
                ss += __shfl_xor(ss, 16); ss += __shfl_xor(ss, 32);
                if (fq == 0) RSS[row * 16 + u.pn * 4 + wc] = ss;
                if (m == 3) asm volatile("" ::: "memory"); }
    }
};
struct EpiStoreRstd {
    bf16_t* O; int ldc; const float* RSS;
    DI void operator()(const AccT& acc, const pg8::Unit& u, int wr, int wc, int fr, int fq) const {
#pragma unroll
        for (int ai = 0; ai < 2; ++ai)
#pragma unroll
            for (int m = 0; m < 4; ++m) { const size_t row = (size_t)(u.pm * 256 + ai * 128 + wr * 64 + m * 16 + fr);
                const f32x4* rp = (const f32x4*)(RSS + row * 16); const f32x4 r0 = rp[0], r1 = rp[1], r2 = rp[2], r3 = rp[3];
                const float rsum = ((r0[0] + r0[1]) + (r0[2] + r0[3])) + ((r1[0] + r1[1]) + (r1[2] + r1[3])) + ((r2[0] + r2[1]) + (r2[2] + r2[3])) + ((r3[0] + r3[1]) + (r3[2] + r3[3]));
                const float rs = 1.0f / sqrtf(rsum * (1.0f / 1024.0f) + 1e-6f);
#pragma unroll
                for (int bj = 0; bj < 2; ++bj) { const int col = u.pn * 256 + bj * 128 + wc * 32 + 8 * fq;
                    *(u32x4*)(O + row * ldc + col) = pack8(acc[ai][bj][m][0] * rs, acc[ai][bj][m][1] * rs); } }
    }
};
struct EpiGU {
    bf16_t* HID;
    DI void operator()(const AccT& acc, const pg8::Unit& u, int wr, int wc, int fr, int fq) const {
#pragma unroll
        for (int ai = 0; ai < 2; ++ai)
#pragma unroll
            for (int m = 0; m < 4; ++m) { const size_t row = (size_t)(u.pm * 256 + ai * 128 + wr * 64 + m * 16 + fr);
                f32x4 a, b;
#pragma unroll
                for (int j = 0; j < 4; ++j) { a[j] = siluf_(acc[ai][0][m][0][j]) * acc[ai][1][m][0][j]; b[j] = siluf_(acc[ai][0][m][1][j]) * acc[ai][1][m][1][j]; }
                *(u32x4*)(HID + row * 256 + u.pn * 128 + wc * 32 + 8 * fq) = pack8(a, b); }
    }
};
struct EpiDown {
    bf16_t* YB; const int* ROWTOK; const float* TOKW; const LAS int* cnt;
    DI void operator()(const AccT& acc, const pg8::Unit& u, int wr, int wc, int fr, int fq) const {
        const int ce = cnt[u.x];
#pragma unroll
        for (int ai = 0; ai < 2; ++ai)
#pragma unroll
            for (int m = 0; m < 4; ++m) { const int idx = u.y * 256 + ai * 128 + wr * 64 + m * 16 + fr;
                if (idx < ce) { const int a = ROWTOK[(size_t)u.x * MOE_CAP + idx]; const float w = TOKW[a];
#pragma unroll
                    for (int bj = 0; bj < 2; ++bj) { const int col = u.pn * 256 + bj * 128 + wc * 32 + 8 * fq;
                        *(u32x4*)(YB + (size_t)a * 1024 + col) = pack8(acc[ai][bj][m][0] * w, acc[ai][bj][m][1] * w); } } }
    }
};

struct FusedMergeOrder {
    const char* Hb; const char* Yb; const char* Wg; const char* Wb; int G, c;
    DI bool next(int i, pg8::Unit& u) const {
        const int ti = i >> 3, x = i & 7, n = x >> 1; const long L = (long)ti * G + c; if (L >= 256) return false;
        pg8::tile_map((int)L, 64, 4, u.pm, u.pn); u.x = x; u.y = 0;
        if (x & 1) { u.a = Yb + (size_t)u.pm * 256 * 1024 * 2 + (size_t)n * 256 * 2; u.b = Wb + (size_t)u.pn * 256 * 1024 * 2 + (size_t)n * 256 * 2; u.nt = 4; }
        else { u.a = Hb + (size_t)u.pm * 256 * 1024 * 2; u.b = Wg + ((size_t)n * 1024 + (size_t)u.pn * 256) * 1024 * 2; u.nt = 16; }
        return true; }
    DI unsigned row_off(const pg8::Unit&, int) const { return 0u; }
};
struct EpiFusedMerge {
    bf16_t* GS; bf16_t* MG; int tid;
    DI void operator()(const AccT& acc, const pg8::Unit& u, int wr, int wc, int fr, int fq) const {
        u32x4* gs = (u32x4*)GS + tid;
        if ((u.x & 1) == 0) {
#pragma unroll
            for (int ai = 0; ai < 2; ++ai)
#pragma unroll
                for (int m = 0; m < 4; ++m)
#pragma unroll
                    for (int bj = 0; bj < 2; ++bj) { f32x4 a = acc[ai][bj][m][0], b = acc[ai][bj][m][1];
#pragma unroll
                        for (int j = 0; j < 4; ++j) { a[j] = sigmoidf_(a[j]); b[j] = sigmoidf_(b[j]); }
                        gs[((ai * 4 + m) * 2 + bj) * 512] = pack8(a, b); }
        } else {
#pragma unroll
            for (int ai = 0; ai < 2; ++ai)
#pragma unroll
                for (int m = 0; m < 4; ++m) { const size_t row = (size_t)(u.pm * 256 + ai * 128 + wr * 64 + m * 16 + fr);
#pragma unroll
                    for (int bj = 0; bj < 2; ++bj) { const int col = u.pn * 256 + bj * 128 + wc * 32 + 8 * fq;
                        const u32x4 g = gs[((ai * 4 + m) * 2 + bj) * 512];
                        f32x4 a = acc[ai][bj][m][0], b = acc[ai][bj][m][1];
                        a[0] *= bflo(g.x); a[1] *= bfhi(g.x); a[2] *= bflo(g.y); a[3] *= bfhi(g.y); b[0] *= bflo(g.z); b[1] *= bfhi(g.z); b[2] *= bflo(g.w); b[3] *= bfhi(g.w);
                        bf16_t* dst = MG + row * 1024 + col;
                        if (u.x > 1) { const u32x4 p = *(const u32x4*)dst;
                            a[0] += bflo(p.x); a[1] += bfhi(p.x); a[2] += bflo(p.y); a[3] += bfhi(p.y); b[0] += bflo(p.z); b[1] += bfhi(p.z); b[2] += bflo(p.w); b[3] += bfhi(p.w); }
                        *(u32x4*)dst = pack8(a, b); }
                    if (m == 3) asm volatile("" ::: "memory"); }
        }
    }
};
constexpr int MOE_TAB = LDS_MISC + 256;
DI void moe_build_table(const Ctx& C, const unsigned* CNT) {
    volatile LAS int* T = (volatile LAS int*)(C.lds + MOE_TAB);
    if (C.tid == 0) { int acc = 0; for (int e = 0; e < 32; ++e) { const int n = (int)CNT[e]; T[e] = acc; T[40 + e] = n; const int nt = (n + 255) >> 8;
            for (int j = 0; j < nt; ++j) T[80 + acc + j] = (e << 8) | j;
            acc += nt; } T[32] = acc; }
    __syncthreads();
}
template <int NPN, bool GU> struct MoeOrder {
    const LAS int* T; const char* Ab; const char* Wb; const int* ROWTOK; int G, c;
    DI bool next(int i, pg8::Unit& u) const {
        const long L0 = (long)i * G + c; const int tot = __builtin_amdgcn_readfirstlane(T[32]) * NPN, per = (tot + 7) >> 3, j_ = (int)(L0 >> 3);
        if (j_ >= per) return false;
        const long L = (long)(L0 & 7) * per + j_; if (L >= tot) return false;
        const int tile = (int)(L / NPN), pn = (int)(L % NPN);
        const int ej = __builtin_amdgcn_readfirstlane(T[80 + tile]); const int e = ej >> 8;
        u.x = e; u.y = ej & 255; u.pm = tile; u.pn = pn; u.nt = 0;
        if (GU) { u.a = Ab; u.b = Wb + ((size_t)e * 512 + (size_t)pn * 256) * 1024 * 2; }
        else { u.a = Ab + (size_t)tile * 256 * 256 * 2; u.b = Wb + ((size_t)e * 1024 + (size_t)pn * 256) * 256 * 2; }
        return true; }
    DI unsigned row_off(const pg8::Unit& u, int row) const {
        const int idx = u.y * 256 + row; int tok = 0;
        if (idx < T[40 + u.x]) tok = ROWTOK[(size_t)u.x * MOE_CAP + idx] >> 1;
        return (unsigned)tok * 2048u; }
};

constexpr int PH_PER_LAYER = 16, PH_L0 = 1, N_PHASES = PH_L0 + DEPTH * PH_PER_LAYER + 1;
#ifndef ENABLE_MASK
#define ENABLE_MASK 0xFF
#endif
#ifndef PROBE_DUP
#define PROBE_DUP 0
#endif
#define NREP(bit) ((PROBE_DUP & (bit)) ? 2 : 1)
#define ZIGZAG(n, call) do { for (int _rd = 0; _rd * C.G < (n); ++_rd) { const int u = _rd * C.G + ((_rd & 1) ? (C.G - 1 - C.bid) : C.bid); if (u < (n)) { call; } } } while (0)

typedef const Params __attribute__((address_space(4))) KParams;
#if defined(__HIP_DEVICE_COMPILE__)
#define PHASE_LOADP() KParams* _pp = (KParams*)__builtin_amdgcn_kernarg_segment_ptr(); asm volatile("" : "+s"(_pp)); const Params P = *_pp
#else
#define PHASE_LOADP() const Params P = Parg
#endif
#define PHASE_ENV() PHASE_LOADP(); const Ctx C = relaunder(C0); LAS unsigned char* lds = C.lds; bf16_t* H = wsp<bf16_t>(P, WS_H); bf16_t* Y = wsp<bf16_t>(P, WS_Y); unsigned char* R1 = P.ws + WS_R1
#define IN(k) (lo <= (k) && (k) < hi)
#define SEAM(k) do { if (IN(k) && IN((k) + 1)) { xcd_barrier(bar); if (PROBE_DUP & 1048576) xcd_barrier(bar); } } while (0)
template <int l> DI void layer_phases(const Ctx& C0, const Params& Parg, const int lo, const int hi, const XcdBarrier& bar) {
    constexpr int pb = PH_L0 + l * PH_PER_LAYER;
        if (IN(pb + 0)) { PHASE_ENV(); for (int rep = 0; rep < NREP(8); ++rep) phase_convert_layer(C, P, l);
            if (l == 0) phase_rownorm<false, true, false, true>(C, P, P.norm_mix + l * DM); else if (!(ENABLE_MASK & 32)) phase_rownorm<false, true, false>(C, P, P.norm_mix + l * DM); else phase_rownorm<true, true, false>(C, P, P.norm_mix + l * DM); } SEAM(pb + 0);
        if (IN(pb + 1)) for (int rep = 0; rep < NREP(16); ++rep) { PHASE_ENV();
            { pg8::DenseOrder S; S.init(H, wsp<bf16_t>(P, W_IN), NTOK, 2560, 1024, 1024, C.G, C.bid);
              EpiStore<0> E{(bf16_t*)(R1 + R1_PROJ), PROJ_LD}; pg8::gemm_phase<EpiStore<0>, pg8::DenseOrder, false>(C.tid, lds, 1024, 1024, 1024, S, E); }
            { pg8::DenseOrder S; S.init(wsp<bf16_t>(P, W_V), H, 512, NTOK, 1024, 1024, C.G, (C.bid + 128) % C.G);
              EpiStore<0> E{(bf16_t*)(R1 + R1_VT), NTOK}; pg8::gemm_phase<EpiStore<0>, pg8::DenseOrder, false>(C.tid, lds, 1024, 1024, 1024, S, E); }
            if (l == 0) {
        for (int lm = 0; lm < DEPTH; ++lm) {
            const bf16_t* MEMN = wsp<bf16_t>(P, WS_MEMN) + (size_t)lm * 1024 * 1024; const bf16_t* WKV = wsp<bf16_t>(P, W_KV) + (size_t)lm * 512 * 1024;
            { pg8::DenseOrder S; S.init(MEMN, WKV, 1024, 256, 1024, 1024, C.G, (C.bid + 8 * lm) % C.G);
              EpiStore<0> E{wsp<bf16_t>(P, WS_MK) + (size_t)lm * 1024 * 256, 256}; pg8::gemm_phase<EpiStore<0>, pg8::DenseOrder, false>(C.tid, lds, 1024, 1024, 1024, S, E); }
            { pg8::DenseOrder S; S.init(WKV + (size_t)256 * 1024, MEMN, 256, 1024, 1024, 1024, C.G, (C.bid + 8 * lm + 4) % C.G);
              EpiStore<0> E{wsp<bf16_t>(P, WS_MVT) + (size_t)lm * 256 * 1024, 1024}; pg8::gemm_phase<EpiStore<0>, pg8::DenseOrder, false>(C.tid, lds, 1024, 1024, 1024, S, E); }
        }
            }
        } SEAM(pb + 1);
        if (IN(pb + 2)) { PHASE_ENV(); phase_rope(C, P, l); } SEAM(pb + 2);
        if (IN(pb + 3)) { PHASE_ENV();
            for (int rep = 0; rep < NREP(1); ++rep) { if (ENABLE_MASK & 8) ZIGZAG(512, dsa_select_unit(C, P, l, u);); }
            for (int rep = 0; rep < NREP(1024); ++rep) { if (ENABLE_MASK & 2) ZIGZAG(512, hgrn_local_unit(C, P, l, u);); }
            for (int rep = 0; rep < NREP(2048); ++rep) { if (ENABLE_MASK & 4) ZIGZAG(256, sgu_unit(C, P, l, u);); }
        } SEAM(pb + 3);
        if (IN(pb + 4)) { PHASE_ENV();
            for (int rep = 0; rep < NREP(2); ++rep) { if (ENABLE_MASK & 1) causal_attn_block2<true>(C, P, l); }
            if (ENABLE_MASK & 2) { for (int u = C.G - 1 - C.bid; u < 128; u += C.G) hgrn_scan_unit(C, P, u); }
        } SEAM(pb + 4);
        if (IN(pb + 5)) {
            for (int rep = 0; rep < NREP(4); ++rep) { PHASE_ENV();
            for (int r2 = 0; r2 < NREP(2097152); ++r2) { if (ENABLE_MASK & 8) causal_attn_block2<false>(C, P, l); }
            for (int r3 = 0; r3 < NREP(4194304); ++r3) { if (ENABLE_MASK & 2) ZIGZAG(512, hgrn_out_unit(C, P, l, u);); } }
        } SEAM(pb + 5);
        if (IN(pb + 7)) for (int rep = 0; rep < NREP(128); ++rep) { PHASE_ENV();
            FusedMergeOrder S{(const char*)H, (const char*)Y, (const char*)wsp<bf16_t>(P, W_G), (const char*)wsp<bf16_t>(P, W_BR), C.G, C.bid};
            EpiFusedMerge E{(bf16_t*)(R1 + R1_GS) + (size_t)C.bid * 65536, (bf16_t*)(R1 + R1_MG), C.tid};
            pg8::gemm_phase<EpiFusedMerge, FusedMergeOrder, false>(C.tid, lds, 1024, 1024, 1024, S, E);
        } SEAM(pb + 7);
        if (IN(pb + 8)) { PHASE_ENV();
            pg8::DenseOrder S; S.init(R1 + R1_MG, wsp<bf16_t>(P, W_OUT), NTOK, 1024, 1024, 1024, C.G, C.bid);
            EpiResidNorm E{P.out, H, wsp<float>(P, WS_RSS)}; pg8::gemm_phase<EpiResidNorm, pg8::DenseOrder, false>(C.tid, lds, 1024, 1024, 1024, S, E);
        } SEAM(pb + 8);
        if (IN(pb + 10)) for (int rep = 0; rep < NREP(64); ++rep) { PHASE_ENV();
            pg8::DenseOrder S; S.init(H, wsp<bf16_t>(P, W_Q), NTOK, 256, 1024, 1024, C.G, C.bid);
            EpiStoreRstd E{(bf16_t*)(R1 + R1_MQ), 256, wsp<float>(P, WS_RSS)}; pg8::gemm_phase<EpiStoreRstd, pg8::DenseOrder, false>(C.tid, lds, 1024, 1024, 1024, S, E);
        } SEAM(pb + 10);
        if (IN(pb + 11)) for (int rep = 0; rep < NREP(64); ++rep) { PHASE_ENV(); mem_attn_block(C, P, l); } SEAM(pb + 11);
        if (IN(pb + 12)) { PHASE_ENV();
            if (ENABLE_MASK & 16) { pg8::DenseOrder S; S.init(R1 + R1_MO, wsp<bf16_t>(P, W_O), NTOK, 1024, 256, 256, C.G, C.bid);
              EpiResid E{P.out}; pg8::gemm_phase<EpiResid, pg8::DenseOrder, false>(C.tid, lds, 256, 256, 256, S, E); }
        } SEAM(pb + 12);
        if (IN(pb + 13)) { PHASE_ENV(); phase_router(C, P, l); if (PROBE_DUP & 512) { __syncthreads(); phase_router(C, P, l, true); } } SEAM(pb + 13);
        if (IN(pb + 14)) for (int rep = 0; rep < NREP(32); ++rep) { PHASE_ENV();
            moe_build_table(C, wsp<unsigned>(P, WS_CTL) + CW_CNT + 64 * l);
            MoeOrder<2, true> S{(const LAS int*)(lds + MOE_TAB), (const char*)H, (const char*)wsp<bf16_t>(P, W_GU), wsp<int>(P, WS_ROWTOK), C.G, C.bid};
            EpiGU E{(bf16_t*)(R1 + R1_HID)}; pg8::gemm_phase<EpiGU, MoeOrder<2, true>, true>(C.tid, lds, 1024, 1024, 1024, S, E);
        } SEAM(pb + 14);
        if (IN(pb + 15)) for (int rep = 0; rep < NREP(32); ++rep) { PHASE_ENV();
            moe_build_table(C, wsp<unsigned>(P, WS_CTL) + CW_CNT + 64 * l);
            MoeOrder<4, false> S{(const LAS int*)(lds + MOE_TAB), (const char*)(R1 + R1_HID), (const char*)wsp<bf16_t>(P, W_D), wsp<int>(P, WS_ROWTOK), C.G, C.bid};
            EpiDown E{(bf16_t*)(R1 + R1_YB), wsp<int>(P, WS_ROWTOK), wsp<float>(P, WS_TOKW), (const LAS int*)(lds + MOE_TAB) + 40};
            pg8::gemm_phase<EpiDown, MoeOrder<4, false>, false>(C.tid, lds, 256, 256, 256, S, E);
        } SEAM(pb + 15);
    }
__global__ void __launch_bounds__(NTHREADS, 2) mega_fwd(Params Parg) {
    extern __shared__ __attribute__((aligned(16))) unsigned char lds_raw[];
    Ctx C0; C0.lds = (LAS unsigned char*)lds_raw; C0.tid = threadIdx.x; C0.lane = C0.tid & 63; C0.wave = __builtin_amdgcn_readfirstlane((int)threadIdx.x >> 6); C0.G = gridDim.x; C0.bid = blockIdx.x;
    volatile LAS unsigned* misc = (volatile LAS unsigned*)(C0.lds + LDS_MISC);
    if (C0.tid < 4) misc[C0.tid] = 0u;
    __syncthreads();
    const int lo = Parg.ph_lo, hi = Parg.ph_hi;
    const bool use_bar = (hi - lo) > 1;
    XcdBarrier bar; bar.bar = (unsigned*)(Parg.ws + WS_CTL) + CW_BAR; bar.x = 0; bar.st = misc;
    if (use_bar) bar = xcd_barrier_post((unsigned*)(Parg.ws + WS_CTL) + CW_BAR, misc);
#define IN(k) (lo <= (k) && (k) < hi)
#define SEAM(k) do { if (IN(k) && IN((k) + 1)) { xcd_barrier(bar); if (PROBE_DUP & 1048576) xcd_barrier(bar); } } while (0)

    if (IN(0)) { PHASE_ENV(); phase_prologue(C, P); } SEAM(0);
    layer_phases<0>(C0, Parg, lo, hi, bar);
    layer_phases<1>(C0, Parg, lo, hi, bar);
    if (IN(N_PHASES - 1)) { PHASE_ENV(); if (ENABLE_MASK & 32) phase_rownorm<true, false, true>(C, P, P.norm_final); else phase_rownorm<false, false, true>(C, P, P.norm_final); }
#undef IN
#undef SEAM
}

#ifndef N_LAUNCH_MODE
#define N_LAUNCH_MODE 0
#endif
extern "C" void kernel_launch(void* const* d_in, const int* in_sizes, int n_in, void* d_out, int out_size, void* d_ws, size_t ws_size, hipStream_t stream) {
    static int grid = 0;
    if (grid == 0) {
        if (n_in != 25 || out_size != NTOK * DM || ws_size < WS_END) { fprintf(stderr, "kernel_launch: unexpected shapes (n_in %d out %d ws %zu need %zu)\n", n_in, out_size, ws_size, (size_t)WS_END); grid = -1; return; }
        int dev = 0, cus = 0;
        if (hipGetDevice(&dev) != hipSuccess || hipDeviceGetAttribute(&cus, hipDeviceAttributeMultiprocessorCount, dev) != hipSuccess) { grid = -1; return; }
        if (hipFuncSetAttribute((const void*)mega_fwd, hipFuncAttributeMaxDynamicSharedMemorySize, LDS_BYTES) != hipSuccess) { fprintf(stderr, "kernel_launch: hipFuncSetAttribute failed\n"); grid = -1; return; }
        int per_cu = 0;
        if (hipOccupancyMaxActiveBlocksPerMultiprocessor(&per_cu, (const void*)mega_fwd, NTHREADS, LDS_BYTES) != hipSuccess || per_cu < 1) { fprintf(stderr, "kernel_launch: occupancy query says %d\n", per_cu); }
        (void)hipGetLastError();
        if (cus != 256) fprintf(stderr, "kernel_launch: built for 256 CUs (one workgroup per CU); device reports %d\n", cus);
        grid = 256;
    }
    if (grid < 0) return;
    (void)hipMemsetAsync((char*)d_ws + WS_CTL, 0, CTL_BYTES, stream);
    Params p{};
    p.x = (const float*)d_in[0]; p.mem = (const float*)d_in[1]; p.positions = (const int*)d_in[2];
    p.norm_mix = (const float*)d_in[3]; p.w_in = (const float*)d_in[4]; p.diff_lambda = (const float*)d_in[5]; p.hgrn_lb = (const float*)d_in[6];
    p.spatial_w = (const float*)d_in[7]; p.spatial_b = (const float*)d_in[8]; p.w_branch = (const float*)d_in[9]; p.w_out = (const float*)d_in[10];
    p.norm_mem_q = (const float*)d_in[11]; p.norm_mem_kv = (const float*)d_in[12]; p.w_mem_q = (const float*)d_in[13]; p.w_mem_kv = (const float*)d_in[14]; p.w_mem_o = (const float*)d_in[15];
    p.norm_ffn = (const float*)d_in[16]; p.w_rg = (const float*)d_in[17]; p.b_rg = (const float*)d_in[18]; p.w_re = (const float*)d_in[19]; p.b_re = (const float*)d_in[20];
    p.w_eg = (const float*)d_in[21]; p.w_eu = (const float*)d_in[22]; p.w_ed = (const float*)d_in[23]; p.norm_final = (const float*)d_in[24];
    p.out = (float*)d_out; p.ws = (unsigned char*)d_ws;
#if N_LAUNCH_MODE == 0
    p.ph_lo = 0; p.ph_hi = N_PHASES;
    hipLaunchKernelGGL(mega_fwd, dim3(grid), dim3(NTHREADS), LDS_BYTES, stream, p);
#else
    for (int k = 0; k < N_PHASES; ++k) { p.ph_lo = k; p.ph_hi = k + 1; hipLaunchKernelGGL(mega_fwd, dim3(grid), dim3(NTHREADS), LDS_BYTES, stream, p); }
#endif
}
```

```cpp
#include <hip/hip_runtime.h>
#include <stdint.h>
#include <stdio.h>

#ifndef PROBE_DUP
#define PROBE_DUP 0
#endif
#define DI __device__ __forceinline__
#define LAS __attribute__((address_space(3)))
typedef unsigned short bf16_t;
typedef short bf16x8 __attribute__((ext_vector_type(8)));
typedef short s16x4 __attribute__((ext_vector_type(4)));
typedef float f32x2 __attribute__((ext_vector_type(2)));
typedef float f32x4 __attribute__((ext_vector_type(4)));
typedef float f32x16 __attribute__((ext_vector_type(16)));
typedef unsigned u32x2 __attribute__((ext_vector_type(2)));
typedef unsigned u32x4 __attribute__((ext_vector_type(4)));
typedef __bf16 hbf2 __attribute__((ext_vector_type(2)));

constexpr int NB = 4, SEQ = 4096, NTOK = NB * SEQ, DM = 1024, DEPTH = 2, MEMLEN = 256;
constexpr int NTHREADS = 512, NWAVES = 8;
constexpr int LDS_BYTES = 147456;
constexpr int LDS_MISC = 133120;
constexpr int IN_WIDTH = 6948;
constexpr int PROJ_LD = 2560;
constexpr int PC_AQ = 0, PC_AK = 256, PC_BQ = 512, PC_BF = 768, PC_BI = 1024, PC_BG = 1280, PC_CU = 1536, PC_CV = 1792,
              PC_DQ = 2048, PC_DK = 2304, PC_DIQ = 2368, PC_DIK = 2496, PC_DIW = 2528;
constexpr int MOE_CAP = 16384;

constexpr size_t AL(size_t x) { return (x + 255) & ~(size_t)255; }
constexpr size_t WS_CTL = 0, CTL_BYTES = 65536;
constexpr size_t W_IN = AL(WS_CTL + CTL_BYTES);
constexpr size_t W_V = W_IN + (size_t)2560 * 1024 * 2;
constexpr size_t W_G = W_V + (size_t)512 * 1024 * 2;
constexpr size_t W_BR = W_G + (size_t)4096 * 1024 * 2;
constexpr size_t W_OUT = W_BR + (size_t)4 * 1024 * 256 * 2;
constexpr size_t W_Q = W_OUT + (size_t)1024 * 1024 * 2;
constexpr size_t W_O = W_Q + (size_t)256 * 1024 * 2;
constexpr size_t W_GU = W_O + (size_t)1024 * 256 * 2;
constexpr size_t W_D = W_GU + (size_t)32 * 512 * 1024 * 2;
constexpr size_t W_SGU = W_D + (size_t)32 * 1024 * 256 * 2;
constexpr size_t W_RT = W_SGU + (size_t)4 * 128 * 128 * 2;
constexpr size_t W_RH = W_RT + (size_t)36 * 1024 * 4;
constexpr size_t W_KV = W_RH + (size_t)2 * 64 * 1024 * 2;
constexpr size_t WS_H = W_KV + (size_t)DEPTH * 512 * 1024 * 2;
constexpr size_t WS_R1 = WS_H + (size_t)NTOK * 1024 * 2;
constexpr size_t R1_BYTES = (size_t)NTOK * 4096 * 2;
constexpr size_t WS_Y = WS_R1 + R1_BYTES;
constexpr size_t WS_HS = WS_Y + (size_t)NTOK * 1024 * 2;
constexpr size_t WS_HD = WS_HS + (size_t)NB * 64 * 4 * 4096 * 4;
constexpr size_t WS_THETA = WS_HD + (size_t)NB * 64 * 256 * 4;
constexpr size_t WS_MEMN = WS_THETA + (size_t)NTOK * 8;
constexpr size_t WS_MK = WS_MEMN + (size_t)DEPTH * 1024 * 1024 * 2;
constexpr size_t WS_MVT = WS_MK + (size_t)DEPTH * 1024 * 256 * 2;
constexpr size_t WS_TOKE = WS_MVT + (size_t)DEPTH * 256 * 1024 * 2;
constexpr size_t WS_TOKW = WS_TOKE + (size_t)NTOK * 2 * 4;
constexpr size_t WS_RANK = WS_TOKW + (size_t)NTOK * 2 * 4;
constexpr size_t WS_ROWTOK = WS_RANK + (size_t)NTOK * 2 * 4;
constexpr size_t WS_MASK = WS_ROWTOK + (size_t)32 * MOE_CAP * 4;
constexpr size_t WS_RSS = WS_MASK + (size_t)NB * 128 * 128 * 64 * 2;
constexpr size_t WS_DUMMY_BASE = WS_RSS + (size_t)NTOK * 16 * 4;
constexpr size_t WS_DUMMY_OLD = WS_MASK + (size_t)NB * 128 * 128 * 64 * 2;
constexpr size_t WS_DUMMY = WS_DUMMY_BASE;
constexpr size_t WS_END = WS_DUMMY + (size_t)32 * MOE_CAP * 4;
constexpr size_t R1_PROJ = 0, R1_VT = (size_t)NTOK * PROJ_LD * 2;
constexpr size_t R1_GS = 0, R1_MG = (size_t)256 * 65536 * 2;
constexpr size_t R1_MQ = 0, R1_MO = (size_t)NTOK * 256 * 2, R1_HID = 2 * R1_MO, R1_YB = R1_HID + (size_t)40960 * 256 * 2;
constexpr size_t R1_HIDS = R1_YB + (size_t)NTOK * 2 * 1024 * 2;
static_assert(R1_HIDS + (size_t)32 * 64 * 256 * 2 <= R1_BYTES, "R1 map");
static_assert(R1_YB + (size_t)NTOK * 2 * 1024 * 2 <= R1_BYTES, "R1 map");
static_assert(R1_VT + (size_t)512 * NTOK * 2 <= R1_BYTES, "R1 map");
constexpr int CW_BAR = 0;
constexpr int CW_KMAX = 4032;
constexpr int CW_CNT = 4096;

DI bf16_t f2bf(float f) { __bf16 b = (__bf16)f; return __builtin_bit_cast(bf16_t, b); }
DI float bf2f(bf16_t b) { return __uint_as_float(((unsigned)b) << 16); }
DI unsigned pk2(float a, float b) { f32x2 v = {a, b}; hbf2 r = __builtin_convertvector(v, hbf2); return __builtin_bit_cast(unsigned, r); }
DI float bflo(unsigned w) { return __uint_as_float(w << 16); }
DI float bfhi(unsigned w) { return __uint_as_float(w & 0xffff0000u); }
DI float sigmoidf_(float x) { return __builtin_amdgcn_rcpf(1.0f + __builtin_amdgcn_exp2f(-1.4426950408889634f * x)); }
DI float siluf_(float x) { return x * __builtin_amdgcn_rcpf(1.0f + __builtin_amdgcn_exp2f(-1.4426950408889634f * x)); }
DI float fexp(float x) { return __builtin_amdgcn_exp2f(1.4426950408889634f * x); }
DI float frcp(float x) { return __builtin_amdgcn_rcpf(x); }
DI float flog(float x) { return 0.6931471805599453f * __builtin_amdgcn_logf(x); }
DI float gelu_tanh(float x) { const float u = 0.7978845608028654f * (x + 0.044715f * x * x * x); return x * frcp(1.0f + fexp(-2.0f * u)); }
DI float wave_sum(float v) { for (int o = 32; o > 0; o >>= 1) v += __shfl_xor(v, o); return v; }
DI float xhalf_max(float x) { const u32x2 r = __builtin_amdgcn_permlane32_swap(__float_as_uint(x), __float_as_uint(x), false, false); return fmaxf(__uint_as_float(r.x), __uint_as_float(r.y)); }
DI float xhalf_sum(float x) { const u32x2 r = __builtin_amdgcn_permlane32_swap(__float_as_uint(x), __float_as_uint(x), false, false); return __uint_as_float(r.x) + __uint_as_float(r.y); }
DI f32x16 mfma32(bf16x8 a, bf16x8 b, f32x16 c) { return __builtin_amdgcn_mfma_f32_32x32x16_bf16(a, b, c, 0, 0, 0); }
DI int crow(int reg, int h) { return (reg & 3) + 8 * (reg >> 2) + 4 * h; }
DI f32x16 zero16() { f32x16 z; for (int i = 0; i < 16; ++i) z[i] = 0.f; return z; }

#define XB_TMO      128
#define XB_XCNT(j)  (256  + 64 * (j))
#define XB_XSUB(j)  (1280 + 64 * (j))
#define XB_XGEN(j)  (2304 + 64 * (j))
#define XB_TOP      3328
#define XB_TOPGEN   3392
#define XCD_BAR_WORDS 3456
#define XB_SPIN_CAP (1u << 22)

DI unsigned xb_ld(unsigned* p)              { return __hip_atomic_load(p, __ATOMIC_RELAXED, __HIP_MEMORY_SCOPE_AGENT); }
DI unsigned xb_add(unsigned* p, unsigned v) { return __hip_atomic_fetch_add(p, v, __ATOMIC_RELAXED, __HIP_MEMORY_SCOPE_AGENT); }
DI unsigned xb_xcc_id() { return (unsigned)__builtin_amdgcn_s_getreg((3 << 11) | 20) & 0xFu; }
#define XB_SPIN(cond, bar) do { unsigned _sp = 0; while (cond) { __builtin_amdgcn_s_sleep(1); \
    if ((++_sp & 255u) == 0u) { if (xb_ld(&(bar)[XB_TMO])) break; if (_sp > XB_SPIN_CAP) { atomicAdd(&(bar)[XB_TMO], 1u); break; } } } } while (0)

struct XcdBarrier { unsigned* bar; unsigned x; volatile LAS unsigned* st; };

DI XcdBarrier xcd_barrier_post(unsigned* bar, volatile LAS unsigned* st) {
    XcdBarrier b; b.bar = bar; b.x = xb_xcc_id(); b.st = st;
    if (threadIdx.x == 0) (void)xb_add(&bar[XB_XCNT(b.x)], 1u);
    return b;
}
DI void xcd_barrier_complete(unsigned* bar, unsigned x, unsigned& nloc, unsigned& nx) {
    const unsigned G = gridDim.x * gridDim.y * gridDim.z;
    unsigned sum, cnt, mine, sp = 0u;
    for (;;) {
        sum = 0u; cnt = 0u; mine = 0u;
#pragma unroll
        for (unsigned j = 0; j < 16; ++j) { const unsigned c = xb_ld(&bar[XB_XCNT(j)]); sum += c; cnt += (c > 0u) ? 1u : 0u; mine = (j == x) ? c : mine; }
        if (sum == G) break;
        __builtin_amdgcn_s_sleep(1);
        if ((++sp & 255u) == 0u) { if (xb_ld(&bar[XB_TMO])) break; if (sp > XB_SPIN_CAP) { atomicAdd(&bar[XB_TMO], 1u); break; } }
    }
    nloc = mine > 0u ? mine : 1u; nx = cnt > 0u ? cnt : 1u;
}
DI void xcd_barrier(const XcdBarrier& b) {
    asm volatile("s_waitcnt vmcnt(0)" ::: "memory");
    __syncthreads();
    if (threadIdx.x == 0) {
        unsigned* bar = b.bar;
        __builtin_amdgcn_s_waitcnt(0);
        unsigned nloc = b.st[0], nx = b.st[1];
        if (nloc == 0u) { xcd_barrier_complete(bar, b.x, nloc, nx); b.st[0] = nloc; b.st[1] = nx; }
        const unsigned old = xb_add(&bar[XB_XSUB(b.x)], 1u);
        const unsigned gen = old / nloc;
        if (old + 1u == (gen + 1u) * nloc) {
            __builtin_amdgcn_fence(__ATOMIC_RELEASE, "agent");
            asm volatile("s_waitcnt vmcnt(0)" ::: "memory");
            const unsigned og = xb_add(&bar[XB_TOP], 1u);
            const unsigned tg = og / nx;
            if (og + 1u == (tg + 1u) * nx) xb_add(&bar[XB_TOPGEN], 1u);
            else XB_SPIN(xb_ld(&bar[XB_TOPGEN]) == tg, bar);
            __builtin_amdgcn_fence(__ATOMIC_ACQUIRE, "agent");
            xb_add(&bar[XB_XGEN(b.x)], 1u);
            asm volatile("s_waitcnt vmcnt(0)" ::: "memory");
        } else {
            XB_SPIN(xb_ld(&bar[XB_XGEN(b.x)]) == gen, bar);
            __builtin_amdgcn_fence(__ATOMIC_ACQUIRE, "agent");
            asm volatile("s_waitcnt vmcnt(0)" ::: "memory");
        }
    }
    __syncthreads();
}
namespace pg8 {
constexpr int BM = 256, BK = 64, HALF = 128, HTB = HALF * BK * 2, STAGE_BYTES = 8 * HTB, NXCD = 8, WGM = 8;
DI int lds_byte(int r, int c) { const int st = (r >> 4) * 2 + (c >> 5), rr = r & 15, cc = c & 31, ob = rr * 64 + cc * 2; return st * 1024 + (ob ^ (((ob >> 9) & 1) << 5)); }
DI void stage_rc(int b, int& R, int& C) { const int st = b / 1024, sb = b % 1024, swz = sb ^ (((sb >> 9) & 1) << 5); R = (st >> 1) * 16 + swz / 64; C = (st & 1) * 32 + (swz % 64) / 2; }
DI int perm32(int rho) { const int n = rho >> 4, i = rho & 15; return 8 * (i >> 2) + 4 * n + (i & 3); }

struct Unit { const char* a; const char* b; int pm, pn, x, y, nt; };

DI void tile_map(int L, int nM, int nN, int& pm, int& pn) {
    const int nwg = nM * nN; int wgid = L;
    { const int q = nwg / NXCD, r = nwg % NXCD, xcd = wgid % NXCD, off = wgid / NXCD; wgid = (xcd < r ? xcd * (q + 1) : r * (q + 1) + (xcd - r) * q) + off; }
    const int nig = WGM * nN, gid = wgid / nig, fm = gid * WGM, gsz = (nM - fm) < WGM ? (nM - fm) : WGM;
    pm = fm + ((wgid % nig) % gsz); pn = (wgid % nig) / gsz;
}
struct DenseOrder {
    const char* A; const char* B; size_t at, bt; int nM, nN, nwg, G, c;
    DI void init(const void* A_, const void* B_, int M, int N, int lda, int ldb, int G_, int c_) {
        A = (const char*)A_; B = (const char*)B_; at = (size_t)BM * lda * 2; bt = (size_t)BM * ldb * 2; nM = M / BM; nN = N / BM; nwg = nM * nN; G = G_; c = c_; }
    DI bool next(int i, Unit& u) const {
        const long L = (long)i * G + c; if (L >= nwg) return false;
        tile_map((int)L, nM, nN, u.pm, u.pn); u.a = A + (size_t)u.pm * at; u.b = B + (size_t)u.pn * bt; u.x = 0; u.y = 0; u.nt = 0; return true; }
    DI unsigned row_off(const Unit&, int) const { return 0u; }
};

#define PG8_WAIT_V(n) asm volatile("s_waitcnt vmcnt(" #n ")" ::: "memory")
#define PG8_WAIT_L(n) asm volatile("s_waitcnt lgkmcnt(" #n ")" ::: "memory")
#define PG8_BAR __builtin_amdgcn_s_barrier()
#define PG8_SCHED __builtin_amdgcn_sched_barrier(0)

template <class Epi, class Sched, bool GATHER>
DI void gemm_phase(const int tid, LAS unsigned char* lds, const int lda, const int ldb, const int K, const Sched& S, const Epi& E) {
    const int wid = __builtin_amdgcn_readfirstlane(tid >> 6), lane = tid & 63, wr = wid >> 2, wc = wid & 3, fr = lane & 15, fq = lane >> 4;
    const int nt_phase = K / BK;
    unsigned voffA[2], voffB[2]; int RA[2], CA[2];
#pragma unroll
    for (int i = 0; i < 2; ++i) { int R, C; stage_rc(tid * 16 + i * 8192, R, C); const int Rb = (R & ~31) + perm32(R & 31);
        RA[i] = R; CA[i] = C; voffA[i] = (unsigned)(R * lda + C) * 2u; voffB[i] = (unsigned)(Rb * ldb + C) * 2u; }
    const size_t kstep = (size_t)(BK * 2);
    const size_t hstepA = (size_t)HALF * lda * 2, hstepB = (size_t)HALF * ldb * 2;
    const unsigned ldsw = (unsigned)wid * 1024u;
    const int aoff = lds_byte(wr * 64 + fr, fq * 8), boff = lds_byte(wc * 32 + fr, fq * 8);
    unsigned vc[2][2], vn[2][2];
#define PG8_SA(b, h) (((b) * 2 + (h)) * HTB)
#define PG8_SB(b, h) ((4 + (b) * 2 + (h)) * HTB)
#define PG8_GL(bufoff, gptr, vo, _i) __builtin_amdgcn_global_load_lds((const unsigned*)((const char*)(gptr) + (vo)), (LAS unsigned*)(lds + (bufoff) + ldsw + (_i) * 8192), 16, 0, 0)
#define PG8_STAGE_B(bufoff, gbase) do { PG8_GL(bufoff, gbase, voffB[0], 0); PG8_GL(bufoff, gbase, voffB[1], 1); } while (0)
#define PG8_STAGE_A(bufoff, kptr, h, isnext) do { if constexpr (GATHER) { const unsigned _o0 = (isnext) ? vn[h][0] : vc[h][0], _o1 = (isnext) ? vn[h][1] : vc[h][1]; PG8_GL(bufoff, kptr, _o0, 0); PG8_GL(bufoff, kptr, _o1, 1); } \
        else { PG8_GL(bufoff, (kptr) + (h) * hstepA, voffA[0], 0); PG8_GL(bufoff, (kptr) + (h) * hstepA, voffA[1], 1); } } while (0)
#define PG8_LDA(dst, b, h) do { _Pragma("unroll") for (int m = 0; m < 4; ++m) _Pragma("unroll") for (int k = 0; k < 2; ++k) dst[m][k] = *(const LAS bf16x8*)(lds + PG8_SA(b, h) + aoff + m * 2048 + k * 1024); } while (0)
#define PG8_LDB(dst, b, h) do { _Pragma("unroll") for (int n = 0; n < 2; ++n) _Pragma("unroll") for (int k = 0; k < 2; ++k) dst[n][k] = *(const LAS bf16x8*)(lds + PG8_SB(b, h) + boff + n * 2048 + k * 1024); } while (0)
#define PG8_MMA(ai, bj, At, Bt) do { __builtin_amdgcn_s_setprio(1); _Pragma("unroll") for (int m = 0; m < 4; ++m) _Pragma("unroll") for (int n = 0; n < 2; ++n) _Pragma("unroll") for (int k = 0; k < 2; ++k) \
        acc[ai][bj][m][n] = __builtin_amdgcn_mfma_f32_16x16x32_bf16(Bt[n][k], At[m][k], acc[ai][bj][m][n], 0, 0, 0); __builtin_amdgcn_s_setprio(0); } while (0)
    Unit cur, nxt; int ui = 0;
    if (!S.next(0, cur)) return;
    f32x4 acc[2][2][4][2];
#pragma unroll
    for (int a = 0; a < 2; ++a)
#pragma unroll
        for (int b = 0; b < 2; ++b)
#pragma unroll
            for (int m = 0; m < 4; ++m)
#pragma unroll
                for (int n = 0; n < 2; ++n) acc[a][b][m][n] = (f32x4){0.f, 0.f, 0.f, 0.f};
    bf16x8 At[4][2], B0[2][2], B1[2][2];
    const char* cA = cur.a; const char* cB = cur.b;
    if constexpr (GATHER) {
#pragma unroll
        for (int h = 0; h < 2; ++h)
#pragma unroll
            for (int i = 0; i < 2; ++i) { vc[h][i] = S.row_off(cur, RA[i] + h * HALF) + (unsigned)CA[i] * 2u; vn[h][i] = vc[h][i]; }
    }
    PG8_STAGE_B(PG8_SB(0, 0), cB); PG8_STAGE_A(PG8_SA(0, 0), cA, 0, false); PG8_STAGE_B(PG8_SB(0, 1), cB + hstepB); PG8_STAGE_A(PG8_SA(0, 1), cA, 1, false);
    if (wr == 1) PG8_BAR;
    PG8_WAIT_V(4); PG8_BAR;
    PG8_STAGE_B(PG8_SB(1, 0), cB + kstep); PG8_STAGE_A(PG8_SA(1, 0), cA + kstep, 0, false); PG8_STAGE_B(PG8_SB(1, 1), cB + hstepB + kstep);
    PG8_WAIT_V(6); PG8_BAR;
    for (;;) {
        const bool has_next = S.next(ui + 1, nxt);
        const char* nA = has_next ? nxt.a : cA; const char* nB = has_next ? nxt.b : cB;
        if constexpr (GATHER) {
            if (has_next) {
#pragma unroll
                for (int h = 0; h < 2; ++h)
#pragma unroll
                    for (int i = 0; i < 2; ++i) vn[h][i] = S.row_off(nxt, RA[i] + h * HALF) + (unsigned)CA[i] * 2u;
            }
        }
        const int nt = cur.nt ? cur.nt : nt_phase;
        for (int t = 0; t < nt; t += 2) {
            const bool last = (t == nt - 2);
            int tq = t; asm volatile("" : "+s"(tq));
            const char* a1 = cA + (size_t)(tq + 1) * kstep;
            const char* a2 = last ? nA : cA + (size_t)(tq + 2) * kstep; const char* b2 = last ? nB : cB + (size_t)(tq + 2) * kstep;
            const char* a3 = a2 + kstep; const char* b3 = b2 + kstep;
            PG8_LDB(B0, 0, 0); PG8_SCHED; PG8_LDA(At, 0, 0); PG8_STAGE_A(PG8_SA(1, 1), a1, 1, false);
            PG8_WAIT_L(8); PG8_BAR; PG8_WAIT_L(0); PG8_MMA(0, 0, At, B0); PG8_BAR; PG8_SCHED;
            PG8_LDB(B1, 0, 1); PG8_STAGE_B(PG8_SB(0, 0), b2);
            PG8_BAR; PG8_WAIT_L(0); PG8_MMA(0, 1, At, B1); PG8_BAR;
            PG8_LDA(At, 0, 1); PG8_STAGE_A(PG8_SA(0, 0), a2, 0, last);
            PG8_BAR; PG8_WAIT_L(0); PG8_MMA(1, 0, At, B0); PG8_BAR; PG8_SCHED;
            PG8_STAGE_B(PG8_SB(0, 1), b2 + hstepB);
            PG8_WAIT_V(6); PG8_BAR; PG8_MMA(1, 1, At, B1); PG8_BAR;
            PG8_LDB(B0, 1, 0); PG8_SCHED; PG8_LDA(At, 1, 0); PG8_STAGE_A(PG8_SA(0, 1), a2, 1, last);
            PG8_WAIT_L(8); PG8_BAR; PG8_WAIT_L(0); PG8_MMA(0, 0, At, B0); PG8_BAR; PG8_SCHED;
            PG8_LDB(B1, 1, 1); PG8_STAGE_B(PG8_SB(1, 0), b3);
            PG8_BAR; PG8_WAIT_L(0); PG8_MMA(0, 1, At, B1); PG8_BAR;
            PG8_LDA(At, 1, 1); PG8_STAGE_A(PG8_SA(1, 0), a3, 0, last);
            PG8_BAR; PG8_WAIT_L(0); PG8_MMA(1, 0, At, B0); PG8_BAR; PG8_SCHED;
            PG8_STAGE_B(PG8_SB(1, 1), b3 + hstepB);
            PG8_WAIT_V(6); PG8_BAR; PG8_MMA(1, 1, At, B1); PG8_BAR;
        }
        { int ln2 = lane; asm volatile("" : "+v"(ln2)); E(acc, cur, wr, wc, ln2 & 15, ln2 >> 4); }
        if (!has_next) break;
#pragma unroll
        for (int a = 0; a < 2; ++a)
#pragma unroll
            for (int b = 0; b < 2; ++b)
#pragma unroll
                for (int m = 0; m < 4; ++m)
#pragma unroll
                    for (int n = 0; n < 2; ++n) acc[a][b][m][n] = (f32x4){0.f, 0.f, 0.f, 0.f};
        cur = nxt; cA = nA; cB = nB; ++ui;
        if constexpr (GATHER) {
#pragma unroll
            for (int h = 0; h < 2; ++h)
#pragma unroll
                for (int i = 0; i < 2; ++i) vc[h][i] = vn[h][i];
        }
    }
    PG8_WAIT_V(0);
    if (wr == 0) PG8_BAR;
    PG8_BAR;
#undef PG8_SA
#undef PG8_SB
#undef PG8_GL
#undef PG8_STAGE_A
#undef PG8_STAGE_B
#undef PG8_LDA
#undef PG8_LDB
#undef PG8_MMA
}
}
struct Params {
    const float* x; const float* mem; const int* positions;
    const float* norm_mix; const float* w_in; const float* diff_lambda; const float* hgrn_lb; const float* spatial_w; const float* spatial_b;
    const float* w_branch; const float* w_out; const float* norm_mem_q; const float* norm_mem_kv; const float* w_mem_q; const float* w_mem_kv; const float* w_mem_o;
    const float* norm_ffn; const float* w_rg; const float* b_rg; const float* w_re; const float* b_re; const float* w_eg; const float* w_eu; const float* w_ed; const float* norm_final;
    float* out; unsigned char* ws; int ph_lo, ph_hi;
};
struct Ctx {
    LAS unsigned char* lds; int tid, lane, wave, G, bid;
};
DI Ctx relaunder(const Ctx& C) { Ctx D = C; int w = C.wave, g = C.G, bi = C.bid; asm volatile("" : "+s"(w), "+s"(g), "+s"(bi)); D.wave = w; D.G = g; D.bid = bi; int ln; asm volatile("v_mbcnt_lo_u32_b32 %0, -1, 0\n\tv_mbcnt_hi_u32_b32 %0, -1, %0" : "=v"(ln)); D.lane = ln; D.tid = w * 64 + ln; return D; }
template <class T> DI T* wsp(const Params& P, size_t off) { return (T*)(P.ws + off); }

struct CvtJob { const float* src; bf16_t* dst; int ld_src, ncols, K, ld_dst, nb1, nb2; long ss1, ds1, ss2, ds2; const float* kscale; };
DI void cvt_transpose(const Ctx& C, const CvtJob& J) {
    LAS float* T = (LAS float*)C.lds;
    const int tn = (J.ncols + 63) >> 6, tk = J.K >> 6, per = tn * tk, total = per * J.nb1 * J.nb2;
    for (int t = C.bid; t < total; t += C.G) {
        const int bb = t / per, r = t % per, b1 = bb / J.nb2, b2 = bb % J.nb2, in_ = r / tk, ik = r % tk;
        const float* src = J.src + (size_t)b1 * J.ss1 + (size_t)b2 * J.ss2; bf16_t* dst = J.dst + (size_t)b1 * J.ds1 + (size_t)b2 * J.ds2;
        const int n0 = in_ * 64, k0 = ik * 64;
        { const int k = C.tid >> 3, c8 = (C.tid & 7) * 8;
#pragma unroll
          for (int v = 0; v < 2; ++v) { const int n = n0 + c8 + v * 4;
              f32x4 x = (f32x4){0.f, 0.f, 0.f, 0.f};
              if (n < J.ncols) x = *(const f32x4*)(src + (size_t)(k0 + k) * J.ld_src + n);
              if (J.kscale) { const float g = J.kscale[k0 + k]; x[0] *= g; x[1] *= g; x[2] *= g; x[3] *= g; }
#pragma unroll
              for (int j = 0; j < 4; ++j) T[(c8 + v * 4 + j) * 65 + k] = x[j]; } }
        __syncthreads();
        { const int n = C.tid >> 3, k8 = (C.tid & 7) * 8;
          if (n0 + n < J.ncols) { u32x4 w;
#pragma unroll
              for (int j = 0; j < 4; ++j) w[j] = pk2(T[n * 65 + k8 + 2 * j], T[n * 65 + k8 + 2 * j + 1]);
              *(u32x4*)(dst + (size_t)(n0 + n) * J.ld_dst + k0 + k8) = w; } }
        __syncthreads();
    }
}
DI CvtJob mkjob(const float* src, bf16_t* dst, int ld_src, int ncols, int K, int ld_dst, int nb1 = 1, long ss1 = 0, long ds1 = 0, int nb2 = 1, long ss2 = 0, long ds2 = 0) {
    CvtJob J; J.src = src; J.dst = dst; J.ld_src = ld_src; J.ncols = ncols; J.K = K; J.ld_dst = ld_dst; J.nb1 = nb1; J.nb2 = nb2; J.ss1 = ss1; J.ds1 = ds1; J.ss2 = ss2; J.ds2 = ds2; J.kscale = nullptr; return J; }

DI void phase_convert_layer(const Ctx& C, const Params& P, int l) {
    const float* win = P.w_in + (size_t)l * 1024 * IN_WIDTH;
    bf16_t* WIN = wsp<bf16_t>(P, W_IN); bf16_t* WV = wsp<bf16_t>(P, W_V);
    cvt_transpose(C, mkjob(win + 0, WIN, IN_WIDTH, 512, 1024, 1024));
    cvt_transpose(C, mkjob(win + 768, WIN + (size_t)512 * 1024, IN_WIDTH, 1856, 1024, 1024));
    cvt_transpose(C, mkjob(win + 2688, WIN + (size_t)2368 * 1024, IN_WIDTH, 164, 1024, 1024));
    cvt_transpose(C, mkjob(win + 512, WV, IN_WIDTH, 256, 1024, 1024));
    cvt_transpose(C, mkjob(win + 2624, WV + (size_t)256 * 1024, IN_WIDTH, 64, 1024, 1024));
    cvt_transpose(C, mkjob(win + 2852, wsp<bf16_t>(P, W_G), IN_WIDTH, 4096, 1024, 1024));
    cvt_transpose(C, mkjob(P.w_branch + (size_t)l * 4 * 256 * 1024, wsp<bf16_t>(P, W_BR), 1024, 1024, 256, 1024, 4, 256 * 1024, 256));
    cvt_transpose(C, mkjob(P.w_out + (size_t)l * 1024 * 1024, wsp<bf16_t>(P, W_OUT), 1024, 1024, 1024, 1024));
    { CvtJob J = mkjob(P.w_mem_q + (size_t)l * 1024 * 256, wsp<bf16_t>(P, W_Q), 256, 256, 1024, 1024); J.kscale = P.norm_mem_q + l * DM; cvt_transpose(C, J); }
    cvt_transpose(C, mkjob(P.w_mem_o + (size_t)l * 256 * 1024, wsp<bf16_t>(P, W_O), 1024, 1024, 256, 256));
    cvt_transpose(C, mkjob(P.w_eg + (size_t)l * 32 * 1024 * 256, wsp<bf16_t>(P, W_GU), 256, 128, 1024, 1024, 32, 1024 * 256, 512 * 1024, 2, 128, 256 * 1024));
    cvt_transpose(C, mkjob(P.w_eu + (size_t)l * 32 * 1024 * 256, wsp<bf16_t>(P, W_GU) + (size_t)128 * 1024, 256, 128, 1024, 1024, 32, 1024 * 256, 512 * 1024, 2, 128, 256 * 1024));
    cvt_transpose(C, mkjob(P.w_ed + (size_t)l * 32 * 256 * 1024, wsp<bf16_t>(P, W_D), 1024, 1024, 256, 256, 32, 256 * 1024, 1024 * 256));
    { bf16_t* z0 = WIN + (size_t)2532 * 1024; for (int i = C.bid * NTHREADS + C.tid; i < 28 * 1024; i += C.G * NTHREADS) z0[i] = 0;
      bf16_t* z1 = WV + (size_t)320 * 1024; for (int i = C.bid * NTHREADS + C.tid; i < 192 * 1024; i += C.G * NTHREADS) z1[i] = 0; }
    { bf16_t* rh = wsp<bf16_t>(P, W_RH); const float* wre = P.w_re + (size_t)l * 1024 * 32; const float* wrg = P.w_rg + (size_t)l * 1024 * 4;
      for (int i = C.bid * NTHREADS + C.tid; i < 64 * 1024; i += C.G * NTHREADS) { const int j = i >> 10, k = i & 1023;
          const float w = (j < 32) ? wre[k * 32 + j] : (j < 36 ? wrg[k * 4 + (j - 32)] : 0.f);
          const bf16_t hi = f2bf(w); rh[i] = hi; rh[64 * 1024 + i] = f2bf(w - bf2f(hi)); } }
    { const float* sw = P.spatial_w + (size_t)l * 4 * 128 * 128; bf16_t* d = wsp<bf16_t>(P, W_SGU);
      for (int i = C.bid * NTHREADS + C.tid; i < 4 * 128 * 128; i += C.G * NTHREADS) { const int s = i & 127, t = (i >> 7) & 127; d[i] = (s <= t) ? f2bf(sw[i]) : (bf16_t)0; } }
}

DI void phase_prologue(const Ctx& C, const Params& P) {
    for (int r = C.bid * NWAVES + C.wave; r < NB * MEMLEN; r += C.G * NWAVES) {
        const float* src = P.mem + (size_t)r * DM; f32x4 v[4]; float ss = 0.f;
#pragma unroll
        for (int j = 0; j < 4; ++j) { v[j] = *(const f32x4*)(src + j * 256 + C.lane * 4); ss += v[j][0] * v[j][0] + v[j][1] * v[j][1] + v[j][2] * v[j][2] + v[j][3] * v[j][3]; }
        ss = wave_sum(ss); const float rs = 1.0f / sqrtf(ss * (1.0f / DM) + 1e-6f);
        for (int l = 0; l < DEPTH; ++l) { bf16_t* dst = wsp<bf16_t>(P, WS_MEMN) + ((size_t)l * 1024 + r) * DM;
#pragma unroll
            for (int j = 0; j < 4; ++j) { const f32x4 g = *(const f32x4*)(P.norm_mem_kv + l * DM + j * 256 + C.lane * 4);
                u32x2 w; w.x = pk2(v[j][0] * rs * g[0], v[j][1] * rs * g[1]); w.y = pk2(v[j][2] * rs * g[2], v[j][3] * rs * g[3]);
                *(u32x2*)(dst + j * 256 + C.lane * 4) = w; } }
    }
    for (int l = 0; l < DEPTH; ++l)
        cvt_transpose(C, mkjob(P.w_mem_kv + (size_t)l * 1024 * 512, wsp<bf16_t>(P, W_KV) + (size_t)l * 512 * 1024, 512, 512, 1024, 1024));
}

template <bool ADD_YB, bool WRITE_H, bool FINAL, bool FROM_X = false>
DI void phase_rownorm(const Ctx& C, const Params& P, const float* gain) {
    float* XR = P.out; bf16_t* H = wsp<bf16_t>(P, WS_H); const bf16_t* YB = (const bf16_t*)(P.ws + WS_R1 + R1_YB);
    const int stride = C.G * NWAVES; int t = C.bid * NWAVES + C.wave;
    f32x4 v[4], vn[4]; u32x2 ya[4], yb[4], yan[4], ybn[4];
#define RN_LOAD(dst, da, db, tt) do { const float* src_ = (FROM_X ? P.x : (const float*)XR) + (size_t)(tt) * DM; _Pragma("unroll") for (int j = 0; j < 4; ++j) { const int c = j * 256 + C.lane * 4; dst[j] = *(const f32x4*)(src_ + c); \
        if constexpr (ADD_YB) { da[j] = *(const u32x2*)(YB + (size_t)(2 * (tt)) * DM + c); db[j] = *(const u32x2*)(YB + (size_t)(2 * (tt) + 1) * DM + c); } } } while (0)
    if (t < NTOK) RN_LOAD(v, ya, yb, t);
    for (; t < NTOK; t += stride) {
        const int tn = (t + stride < NTOK) ? t + stride : t;
        RN_LOAD(vn, yan, ybn, tn);
        float* xr = XR + (size_t)t * DM; float ss = 0.f;
#pragma unroll
        for (int j = 0; j < 4; ++j) { const int c = j * 256 + C.lane * 4;
            if constexpr (ADD_YB) { const u32x2 a = ya[j], b = yb[j];
                v[j][0] += bflo(a.x) + bflo(b.x); v[j][1] += bfhi(a.x) + bfhi(b.x); v[j][2] += bflo(a.y) + bflo(b.y); v[j][3] += bfhi(a.y) + bfhi(b.y); }
            if constexpr ((ADD_YB && !FINAL) || FROM_X) *(f32x4*)(xr + c) = v[j];
            ss += v[j][0] * v[j][0] + v[j][1] * v[j][1] + v[j][2] * v[j][2] + v[j][3] * v[j][3]; }
        ss = wave_sum(ss); const float rs = 1.0f / sqrtf(ss * (1.0f / DM) + 1e-6f);
#pragma unroll
        for (int j = 0; j < 4; ++j) { const int c = j * 256 + C.lane * 4; const f32x4 g = *(const f32x4*)(gain + c);
            const f32x4 o = (f32x4){v[j][0] * rs * g[0], v[j][1] * rs * g[1], v[j][2] * rs * g[2], v[j][3] * rs * g[3]};
            if constexpr (FINAL) *(f32x4*)(xr + c) = o;
            if constexpr (WRITE_H) { u32x2 w; w.x = pk2(o[0], o[1]); w.y = pk2(o[2], o[3]); *(u32x2*)(H + (size_t)t * DM + c) = w; } }
#pragma unroll
        for (int j = 0; j < 4; ++j) { v[j] = vn[j]; if constexpr (ADD_YB) { ya[j] = yan[j]; yb[j] = ybn[j]; } }
    }
#undef RN_LOAD
}

DI void phase_rope(const Ctx& C, const Params& P, const int l, const bool dry = false) {
    bf16_t* PROJ = (bf16_t*)(P.ws + WS_R1 + R1_PROJ);
    LAS f32x2* tab = (LAS f32x2*)(C.lds) + C.wave * 64;
    float kmx[4] = {0.f, 0.f, 0.f, 0.f};
    for (int t = C.bid * NWAVES + C.wave; t < NTOK; t += C.G * NWAVES) {
        const float pos = (float)P.positions[t];
        if (C.lane < 48) { const int i = C.lane < 16 ? C.lane : C.lane - 16; const float d = C.lane < 16 ? 32.f : 64.f;
            const float inv = powf(10000.0f, -(float)i * (2.0f / d)); const float ang = pos * inv; float s, c; sincosf(ang, &s, &c); tab[C.lane] = (f32x2){c, s}; }
        __builtin_amdgcn_wave_barrier();
        asm volatile("s_waitcnt lgkmcnt(0)" ::: "memory");
        bf16_t* row = PROJ + (size_t)t * PROJ_LD;
        { const float kv = (C.lane < 32) ? bf2f(row[PC_DIK + C.lane]) : 0.f; const float k2 = wave_sum(kv * kv); const int bb = t >> 12;
#pragma unroll
          for (int q = 0; q < 4; ++q) kmx[q] = (bb == q) ? fmaxf(kmx[q], k2) : kmx[q]; }
        for (int p = C.lane; p < 496; p += 64) {
            int col, half, ti;
            if (p < 256) { col = (p >> 4) * 32 + (p & 15); half = 16; ti = p & 15; }
            else if (p < 416) { const int q = p - 256; col = PC_DQ + (q >> 5) * 64 + (q & 31); half = 32; ti = 16 + (q & 31); }
            else { const int q = p - 416; col = PC_DIQ + (q >> 4) * 32 + (q & 15); half = 16; ti = q & 15; }
            const f32x2 cs = tab[ti]; const float x1 = bf2f(row[col]), x2 = bf2f(row[col + half]);
            if (!dry || pos < -1.0f) { row[col] = f2bf(x1 * cs.x - x2 * cs.y); row[col + half] = f2bf(x2 * cs.x + x1 * cs.y); }
        }
        __builtin_amdgcn_wave_barrier();
    }
    { LAS unsigned* km = (LAS unsigned*)(C.lds + 8192);
      __syncthreads();
      if (C.tid < 4) km[C.tid] = 0u;
      __syncthreads();
      if (C.lane < 4) { float v = 0.f;
#pragma unroll
          for (int q = 0; q < 4; ++q) v = (C.lane == q) ? kmx[q] : v;
          __hip_atomic_fetch_max(km + C.lane, __float_as_uint(v), __ATOMIC_RELAXED, __HIP_MEMORY_SCOPE_WORKGROUP); }
      __syncthreads();
      if (C.tid < 4 && !dry) atomicMax(wsp<unsigned>(P, WS_CTL) + CW_KMAX + 8 * l + C.tid, (unsigned)km[C.tid]);
      __syncthreads(); }
}
DI void sm_step(f32x16& st, const float c, float& m, float& l, f32x16& O0, f32x16& O1, bf16x8& p0, bf16x8& p1) {
    float mx = st[0];
#pragma unroll
    for (int i = 1; i < 16; ++i) mx = fmaxf(mx, st[i]);
    mx = fmaxf(mx, __shfl_xor(mx, 32));
    if (__any(mx > m)) { const float mn = fmaxf(m, mx); const float a = __builtin_amdgcn_exp2f((m - mn) * c); l *= a;
#pragma unroll
        for (int i = 0; i < 16; ++i) { O0[i] *= a; O1[i] *= a; }
        m = mn; }
    const float mc = m * c; float rs = 0.f;
#pragma unroll
    for (int i = 0; i < 16; ++i) { const float p = __builtin_amdgcn_exp2f(fmaf(st[i], c, -mc)); st[i] = p; rs += p; }
    l += rs;
    u32x4 a, b;
    a.x = pk2(st[0], st[1]); a.y = pk2(st[2], st[3]); a.z = pk2(st[4], st[5]); a.w = pk2(st[6], st[7]);
    b.x = pk2(st[8], st[9]); b.y = pk2(st[10], st[11]); b.z = pk2(st[12], st[13]); b.w = pk2(st[14], st[15]);
    p0 = __builtin_bit_cast(bf16x8, a); p1 = __builtin_bit_cast(bf16x8, b);
}
DI void apply_mask(f32x16& st, unsigned vmask) {
#pragma unroll
    for (int i = 0; i < 16; ++i) { const unsigned sel = (unsigned)__builtin_amdgcn_sbfe((int)vmask, i, 1);
        st[i] = __uint_as_float((__float_as_uint(st[i]) & sel) | (__float_as_uint(-3.0e38f) & ~sel)); }
}
DI bf16x8 vt_frag(const bf16_t* vt_row, int k0, int s2, int h) {
    const bf16_t* p = vt_row + k0 + 16 * s2 + 4 * h; const u32x2 lo = *(const u32x2*)p, hi = *(const u32x2*)(p + 8);
    u32x4 w; w.x = lo.x; w.y = lo.y; w.z = hi.x; w.w = hi.y; return __builtin_bit_cast(bf16x8, w);
}
DI unsigned causal_mask(int r, int h) { unsigned m = 0;
#pragma unroll
    for (int i = 0; i < 16; ++i) m |= (crow(i, h) <= r) ? (1u << i) : 0u;
    return m; }
DI void causal_wave_unit(int c, int w, int& bh, int& qs) { const int pi = c * 4 + (w & 3); bh = (pi >> 6) & 15; const int j = pi & 63; qs = (w < 4) ? 127 - j : j; }

struct DiffKV { bf16x8 kf[2][2]; bf16x8 vf[2][2]; };
DI void diff_load(DiffKV& t, const bf16_t* kbase, const bf16_t* vrow0, const bf16_t* vrow1, int k0, int r, int h) {
    const bf16_t* kp = kbase + (size_t)(k0 + r) * PROJ_LD + 8 * h;
#pragma unroll
    for (int m = 0; m < 2; ++m)
#pragma unroll
        for (int s = 0; s < 2; ++s) t.kf[m][s] = *(const bf16x8*)(kp + m * 32 + 16 * s);
#pragma unroll
    for (int s2 = 0; s2 < 2; ++s2) { t.vf[0][s2] = vt_frag(vrow0, k0, s2, h); t.vf[1][s2] = vt_frag(vrow1, k0, s2, h); }
}
DI void diff_step(const DiffKV& t, const bf16x8 (&qf)[2][2], bool diag, unsigned dmask, const float c, float (&mm)[2], float (&ll)[2], f32x16 (&O)[2][2]) {
#pragma unroll
    for (int m = 0; m < 2; ++m) {
        f32x16 st = mfma32(t.kf[m][0], qf[m][0], zero16()); st = mfma32(t.kf[m][1], qf[m][1], st);
        if (diag) apply_mask(st, dmask);
        bf16x8 p0, p1; sm_step(st, c, mm[m], ll[m], O[m][0], O[m][1], p0, p1);
        O[m][0] = mfma32(t.vf[0][0], p0, O[m][0]); O[m][0] = mfma32(t.vf[0][1], p1, O[m][0]);
        O[m][1] = mfma32(t.vf[1][0], p0, O[m][1]); O[m][1] = mfma32(t.vf[1][1], p1, O[m][1]);
    }
}
DI void diff_attn_wave(const Ctx& C, const Params& P, int l) {
    const bf16_t* PROJ = (const bf16_t*)(P.ws + WS_R1 + R1_PROJ); const bf16_t* VT = (const bf16_t*)(P.ws + WS_R1 + R1_VT); bf16_t* Y = wsp<bf16_t>(P, WS_Y);
    int bh, qs; causal_wave_unit(C.bid, C.wave, bh, qs);
    const int b = bh >> 2, hd = bh & 3, r = C.lane & 31, h = C.lane >> 5, tokb = b * SEQ, q0 = qs * 32, t = q0 + r;
    const float* lv = P.diff_lambda + l * 128;
    const float d1 = wave_sum(C.lane < 32 ? lv[C.lane] * lv[32 + C.lane] : 0.f), d2 = wave_sum(C.lane < 32 ? lv[64 + C.lane] * lv[96 + C.lane] : 0.f);
    const float lam_init = 0.8f - 0.6f * expf(-0.3f * (float)l), lam = expf(d1) - expf(d2) + lam_init;
    bf16x8 qf[2][2];
#pragma unroll
    for (int m = 0; m < 2; ++m)
#pragma unroll
        for (int s = 0; s < 2; ++s) qf[m][s] = *(const bf16x8*)(PROJ + (size_t)(tokb + t) * PROJ_LD + PC_AQ + hd * 64 + m * 32 + 16 * s + 8 * h);
    f32x16 O[2][2]; float mm[2] = {-1e30f, -1e30f}, ll[2] = {0.f, 0.f};
#pragma unroll
    for (int m = 0; m < 2; ++m) { O[m][0] = zero16(); O[m][1] = zero16(); }
    const float c = 0.17677669529663687f * 1.4426950408889634f;
    const int nkt = qs + 1; const unsigned dmask = causal_mask(r, h);
    const bf16_t* kbase = PROJ + (size_t)tokb * PROJ_LD + PC_AK + hd * 64;
    const bf16_t* vrow0 = VT + (size_t)(hd * 64 + r) * NTOK + tokb; const bf16_t* vrow1 = vrow0 + (size_t)32 * NTOK;
    DiffKV ta, tb; diff_load(ta, kbase, vrow0, vrow1, 0, r, h);
    for (int kt = 0; kt < nkt; kt += 2) {
        if (kt + 1 < nkt) diff_load(tb, kbase, vrow0, vrow1, (kt + 1) * 32, r, h);
        diff_step(ta, qf, kt == nkt - 1, dmask, c, mm, ll, O);
        if (kt + 1 < nkt) { if (kt + 2 < nkt) diff_load(ta, kbase, vrow0, vrow1, (kt + 2) * 32, r, h);
            diff_step(tb, qf, kt + 1 == nkt - 1, dmask, c, mm, ll, O); }
    }
    ll[0] += __shfl_xor(ll[0], 32); ll[1] += __shfl_xor(ll[1], 32);
    const float i0 = 1.0f / ll[0], i1 = lam / ll[1]; float ss = 0.f;
#pragma unroll
    for (int et = 0; et < 2; ++et)
#pragma unroll
        for (int i = 0; i < 16; ++i) { const float o = O[0][et][i] * i0 - O[1][et][i] * i1; O[0][et][i] = o; ss += o * o; }
    ss += __shfl_xor(ss, 32);
    const float rn = (1.0f - lam_init) / sqrtf(ss * (1.0f / 64.0f) + 1e-6f);
    bf16_t* yrow = Y + (size_t)(tokb + t) * DM + hd * 64;
#pragma unroll
    for (int et = 0; et < 2; ++et)
#pragma unroll
        for (int g = 0; g < 4; ++g) { u32x2 w; w.x = pk2(O[0][et][4 * g] * rn, O[0][et][4 * g + 1] * rn); w.y = pk2(O[0][et][4 * g + 2] * rn, O[0][et][4 * g + 3] * rn);
            *(u32x2*)(yrow + et * 32 + 8 * g + 4 * h) = w; }
}

struct KV64 { bf16x8 kf[4]; bf16x8 vf[2][2]; };
DI void kv64_load(KV64& t, const bf16_t* kbase, int kld, const bf16_t* vrow0, const bf16_t* vrow1, int k0, int r, int h) {
    const bf16_t* kp = kbase + (size_t)(k0 + r) * kld + 8 * h;
#pragma unroll
    for (int s = 0; s < 4; ++s) t.kf[s] = *(const bf16x8*)(kp + 16 * s);
#pragma unroll
    for (int s2 = 0; s2 < 2; ++s2) { t.vf[0][s2] = vt_frag(vrow0, k0, s2, h); t.vf[1][s2] = vt_frag(vrow1, k0, s2, h); }
}
DI void kv64_step(const KV64& t, const bf16x8 (&qf)[4], bool masked, unsigned vmask, const float c, float& mm, float& ll, f32x16 (&O)[2]) {
    f32x16 st = zero16();
#pragma unroll
    for (int s = 0; s < 4; ++s) st = mfma32(t.kf[s], qf[s], st);
    if (masked) apply_mask(st, vmask);
    bf16x8 p0, p1; sm_step(st, c, mm, ll, O[0], O[1], p0, p1);
    O[0] = mfma32(t.vf[0][0], p0, O[0]); O[0] = mfma32(t.vf[0][1], p1, O[0]);
    O[1] = mfma32(t.vf[1][0], p0, O[1]); O[1] = mfma32(t.vf[1][1], p1, O[1]);
}
DI void mem_attn_wave(const Ctx& C, const Params& P, int l) {
    const bf16_t* MQ = (const bf16_t*)(P.ws + WS_R1 + R1_MQ); bf16_t* MO = (bf16_t*)(P.ws + WS_R1 + R1_MO);
    const bf16_t* MK = wsp<bf16_t>(P, WS_MK) + (size_t)l * 1024 * 256; const bf16_t* MVT = wsp<bf16_t>(P, WS_MVT) + (size_t)l * 256 * 1024;
    const int r = C.lane & 31, h = C.lane >> 5;
    for (int wu = C.bid * NWAVES + C.wave; wu < 2048; wu += C.G * NWAVES) {
        const int bh = wu >> 7, qs = wu & 127, b = bh >> 2, hd = bh & 3, t = b * SEQ + qs * 32 + r;
        bf16x8 qf[4];
#pragma unroll
        for (int s = 0; s < 4; ++s) qf[s] = *(const bf16x8*)(MQ + (size_t)t * 256 + hd * 64 + 16 * s + 8 * h);
        f32x16 O[2] = {zero16(), zero16()}; float mm = -1e30f, ll = 0.f;
        const float c = 0.125f * 1.4426950408889634f;
        const bf16_t* kbase = MK + (size_t)(b * 256) * 256 + hd * 64;
        const bf16_t* vrow0 = MVT + (size_t)(hd * 64 + r) * 1024 + b * 256; const bf16_t* vrow1 = vrow0 + (size_t)32 * 1024;
        KV64 ta, tb; kv64_load(ta, kbase, 256, vrow0, vrow1, 0, r, h);
#pragma unroll 1
        for (int kt = 0; kt < 8; kt += 2) {
            kv64_load(tb, kbase, 256, vrow0, vrow1, (kt + 1) * 32, r, h);
            kv64_step(ta, qf, false, 0u, c, mm, ll, O);
            if (kt + 2 < 8) kv64_load(ta, kbase, 256, vrow0, vrow1, (kt + 2) * 32, r, h);
            kv64_step(tb, qf, false, 0u, c, mm, ll, O);
        }
        ll += __shfl_xor(ll, 32);
        const float il = 1.0f / ll; bf16_t* orow = MO + (size_t)t * 256 + hd * 64;
#pragma unroll
        for (int et = 0; et < 2; ++et)
#pragma unroll
            for (int g = 0; g < 4; ++g) { u32x2 w; w.x = pk2(O[et][4 * g] * il, O[et][4 * g + 1] * il); w.y = pk2(O[et][4 * g + 2] * il, O[et][4 * g + 3] * il);
                *(u32x2*)(orow + et * 32 + 8 * g + 4 * h) = w; }
    }
}

DI f32x16 idx_score(const bf16x8 (&ikf)[2], const bf16x8 (&iqf)[4][2], const float (&iw)[4]) {
    f32x16 a[4];
#pragma unroll
    for (int hh = 0; hh < 4; ++hh) a[hh] = mfma32(ikf[0], iqf[hh][0], zero16());
#pragma unroll
    for (int hh = 0; hh < 4; ++hh) a[hh] = mfma32(ikf[1], iqf[hh][1], a[hh]);
    f32x16 sc = zero16();
#pragma unroll
    for (int hh = 0; hh < 4; ++hh) {
#pragma unroll
        for (int i = 0; i < 16; ++i) { const int ab = (int)__float_as_uint(a[hh][i]); const float rl = __uint_as_float((unsigned)(ab > 0 ? ab : 0));
            sc[i] = fmaf(iw[hh], rl, sc[i]); } }
    return sc;
}
DI unsigned okey_of(float f) { const unsigned u = __float_as_uint(f); return u ^ ((unsigned)((int)u >> 31) | 0x80000000u); }
DI void load_idx_q(const bf16_t* PROJ, size_t tok, int h, bf16x8 (&iqf)[4][2], float (&iw)[4]) {
    const bf16_t* row = PROJ + tok * PROJ_LD;
#pragma unroll
    for (int hh = 0; hh < 4; ++hh) {
#pragma unroll
        for (int s = 0; s < 2; ++s) iqf[hh][s] = *(const bf16x8*)(row + PC_DIQ + hh * 32 + 16 * s + 8 * h);
        iw[hh] = bf2f(row[PC_DIW + hh]) * 0.08838834764831845f; }
}

template <int PASS> DI void d1_digit(unsigned ok, unsigned sinv, unsigned mv, unsigned mb, bool& match, unsigned& dg) {
    if constexpr (PASS == 0) { match = true; dg = ok >> 21; }
    else if constexpr (PASS == 1) { match = (ok >> 21) == mv; dg = (ok >> 10) & 2047u; }
    else if constexpr (PASS == 2) { match = (ok >> 10) == mv; dg = ((ok & 1023u) << 1) | (sinv >> 11); }
    else { match = (ok == mv) && ((sinv >> 11) == mb); dg = sinv & 2047u; }
}
constexpr int D1_HSTRIDE = 1025;
DI unsigned lin_bin(float sc, float lin_a, float lin_b) { return (unsigned)__builtin_amdgcn_fmed3f(fmaf(sc, lin_a, lin_b), 0.f, 2047.f); }
template <int PASS> DI void d1_pass(const Ctx& C, const bf16_t* PROJ, int tokb, int q0, int nkt, const bf16x8 (&iqf)[4][2], const float (&iw)[4], LAS unsigned* hist, volatile LAS unsigned* QS, const float lin_a = 0.f, const float lin_b = 0.f) {
    const int r = C.lane & 31, h = C.lane >> 5;
    const unsigned mv = QS[r * 4 + 0], mb = QS[r * 4 + 1];
    LAS unsigned* hrow = hist + r * D1_HSTRIDE;
    const bf16_t* kp0 = PROJ + (size_t)(tokb + r) * PROJ_LD + PC_DIK + 8 * h;
    bf16x8 ikf[2], ikn[2];
    if (C.wave < nkt) { const bf16_t* kp = kp0 + (size_t)(C.wave * 32) * PROJ_LD; ikf[0] = *(const bf16x8*)kp; ikf[1] = *(const bf16x8*)(kp + 16); }
    for (int kt = C.wave; kt < nkt; kt += NWAVES) {
        const int k0 = kt * 32;
        { const int ktn = (kt + NWAVES < nkt) ? kt + NWAVES : kt;
          const bf16_t* kp = kp0 + (size_t)(ktn * 32) * PROJ_LD; ikn[0] = *(const bf16x8*)kp; ikn[1] = *(const bf16x8*)(kp + 16); }
        const f32x16 sc = idx_score(ikf, iqf, iw);
        const bool diag = (kt == nkt - 1);
        unsigned wadr[16], wval[16]; bool any_m = false;
#pragma unroll
        for (int i = 0; i < 16; ++i) { const unsigned ok = okey_of(sc[i]), sinv = 4095u - (unsigned)(k0 + crow(i, h));
            bool match; unsigned dg;
            if constexpr (PASS == 4) { match = true; dg = lin_bin(sc[i], lin_a, lin_b); } else d1_digit<PASS>(ok, sinv, mv, mb, match, dg);
            if (diag) match = match && (crow(i, h) <= r);
            wadr[i] = match ? (dg >> 1) : 1024u;
            wval[i] = match ? (1u << ((dg & 1u) * 16u)) : 0u; any_m = any_m || match; }
        if (PASS == 0 || PASS == 4 || __any(any_m)) {
#pragma unroll
            for (int i = 0; i < 16; ++i) __hip_atomic_fetch_add(hrow + wadr[i], wval[i], __ATOMIC_RELAXED, __HIP_MEMORY_SCOPE_WORKGROUP);
        }
        ikf[0] = ikn[0]; ikf[1] = ikn[1];
    }
    __syncthreads();
    for (int srep = ((PROBE_DUP & 32768) ? 0 : 1); srep < 2; ++srep)
    for (int qq = 0; qq < 4; ++qq) {
        const int q = C.wave * 4 + qq; const unsigned rk = QS[q * 4 + 2];
        unsigned lsum = 0;
#pragma unroll
        for (int j = 0; j < 16; ++j) { const unsigned wj = hist[q * D1_HSTRIDE + C.lane * 16 + j]; lsum += (wj & 0xffffu) + (wj >> 16); }
        unsigned x = lsum;
#pragma unroll
        for (int o = 1; o < 64; o <<= 1) { const unsigned y = __shfl_down(x, o); if (C.lane + o < 64) x += y; }
        const unsigned above = x - lsum;
        const bool hit = (above < rk) && (rk <= x);
        const unsigned long long bal = __ballot(hit); const int L = bal ? (__ffsll((long long)bal) - 1) : 0;
        const unsigned aboveL = __shfl(above, L);
        const unsigned bk = (C.lane < 32) ? (unsigned)((const LAS unsigned short*)hist)[q * (2 * D1_HSTRIDE) + L * 32 + C.lane] : 0u;
        unsigned y2 = bk;
#pragma unroll
        for (int o = 1; o < 32; o <<= 1) { const unsigned z = __shfl_down(y2, o); if (C.lane + o < 32) y2 += z; }
        const unsigned ab2 = aboveL + y2 - bk;
        const bool hit2 = (C.lane < 32) && (ab2 < rk) && (rk <= ab2 + bk);
        const unsigned long long bal2 = __ballot(hit2); const int K2 = bal2 ? (__ffsll((long long)bal2) - 1) : 0;
        unsigned bin = (unsigned)(L * 32 + K2), rnew = rk - __shfl(ab2, K2);
        if (C.lane == 0 && srep == 1) {
            const unsigned omv = QS[q * 4 + 0];
            if constexpr (PASS == 0 || PASS == 4) { QS[q * 4 + 0] = bin; }
            else if constexpr (PASS == 1) { QS[q * 4 + 0] = (omv << 11) | bin; }
            else if constexpr (PASS == 2) { QS[q * 4 + 0] = (omv << 10) | (bin >> 1); QS[q * 4 + 1] = bin & 1u; }
            else { QS[q * 4 + 3] = bin; }
            QS[q * 4 + 2] = rnew;
        }
    }
    __syncthreads();
    if constexpr (PASS == 1 || PASS == 2) { for (int crep = 0; crep < ((PROBE_DUP & 65536) ? 2 : 1); ++crep) { for (int i = C.tid; i < 32 * D1_HSTRIDE; i += NTHREADS) hist[i] = 0u; __syncthreads(); } }
}
DI void dsa_select_unit(const Ctx& C, const Params& P, int l, int b, int qt) {
    const bf16_t* PROJ = (const bf16_t*)(P.ws + WS_R1 + R1_PROJ); unsigned short* MASK = wsp<unsigned short>(P, WS_MASK);
    const int tokb = b * SEQ, q0 = qt * 32;
    unsigned short* mrow = MASK + ((size_t)(b * 128 + qt) * 128) * 64 + C.lane;
    if (q0 + 31 < 256) {
        for (int kt = C.wave; kt <= qt; kt += NWAVES) mrow[(size_t)kt * 64] = (unsigned short)((kt == qt) ? causal_mask(C.lane & 31, C.lane >> 5) : 0xffffu);
        return; }
    LAS unsigned* hist = (LAS unsigned*)C.lds; volatile LAS unsigned* QS = (volatile LAS unsigned*)(C.lds + 32 * D1_HSTRIDE * 4);
    for (int i = C.tid; i < 32 * D1_HSTRIDE; i += NTHREADS) hist[i] = 0u;
    if (C.tid < 32) { QS[C.tid * 4 + 0] = 0u; QS[C.tid * 4 + 1] = 0u; QS[C.tid * 4 + 2] = 256u; QS[C.tid * 4 + 3] = 0u; }
    __syncthreads();
    const int r = C.lane & 31, h = C.lane >> 5;
    bf16x8 iqf[4][2]; float iw[4]; load_idx_q(PROJ, (size_t)(tokb + q0 + r), h, iqf, iw);
    const int nkt = qt + 1;
    float lin_a, lin_b;
    { const float kmax = sqrtf(__uint_as_float(wsp<unsigned>(P, WS_CTL)[CW_KMAX + 8 * l + b]));
      float hi = 0.f, lo = 0.f;
#pragma unroll
      for (int hh = 0; hh < 4; ++hh) { float n2 = 0.f;
#pragma unroll
          for (int s2 = 0; s2 < 2; ++s2) { const u32x4 w = __builtin_bit_cast(u32x4, iqf[hh][s2]);
#pragma unroll
              for (int j = 0; j < 4; ++j) { const float x0 = bflo(w[j]), x1 = bfhi(w[j]); n2 += x0 * x0 + x1 * x1; } }
          n2 += __shfl_xor(n2, 32); const float bnd = 0.5f * kmax * fabsf(iw[hh]) * sqrtf(n2);
          if (iw[hh] > 0.f) hi += bnd; else lo -= bnd; }
      const float span = hi - lo; lin_a = span > 0.f ? 2047.0f / span : 0.f; lin_b = -lo * lin_a; }
    d1_pass<4>(C, PROJ, tokb, q0, nkt, iqf, iw, hist, QS, lin_a, lin_b);
    constexpr int CCAP = 384;
    LAS unsigned long long* CAND = (LAS unsigned long long*)C.lds;
    LAS unsigned short* LM = (LAS unsigned short*)(C.lds + 98304);
    LAS unsigned* ZBM = (LAS unsigned*)(C.lds + 114688);
    LAS unsigned* ccnt = (LAS unsigned*)(C.lds + 32 * D1_HSTRIDE * 4 + 512);
    if (C.tid < 33) ccnt[C.tid] = 0u;
    __syncthreads();
    {
        const unsigned b0 = QS[r * 4 + 0];
        const bf16_t* kp0 = PROJ + (size_t)(tokb + r) * PROJ_LD + PC_DIK + 8 * h;
        bf16x8 ikf[2], ikn[2];
        if (C.wave < nkt) { const bf16_t* kp = kp0 + (size_t)(C.wave * 32) * PROJ_LD; ikf[0] = *(const bf16x8*)kp; ikf[1] = *(const bf16x8*)(kp + 16); }
        for (int kt = C.wave; kt < nkt; kt += NWAVES) {
            const int k0 = kt * 32;
            { const int ktn = (kt + NWAVES < nkt) ? kt + NWAVES : kt;
              const bf16_t* kp = kp0 + (size_t)(ktn * 32) * PROJ_LD; ikn[0] = *(const bf16x8*)kp; ikn[1] = *(const bf16x8*)(kp + 16); }
            const f32x16 sc = idx_score(ikf, iqf, iw);
            const bool diag = (kt == nkt - 1);
            unsigned above = 0, cand = 0, zer = 0;
#pragma unroll
            for (int i = 0; i < 16; ++i) { const unsigned d0 = lin_bin(sc[i], lin_a, lin_b); const bool ok_c = !diag || (crow(i, h) <= r);
                const bool inb = ok_c && d0 == b0, isz = sc[i] == 0.0f;
                above |= (ok_c && d0 > b0) ? (1u << i) : 0u; cand |= (inb && !isz) ? (1u << i) : 0u; zer |= (inb && isz) ? (1u << i) : 0u; }
            LM[kt * 64 + C.lane] = (unsigned short)above;
            { unsigned kw = 0;
#pragma unroll
              for (int g = 0; g < 4; ++g) kw |= ((zer >> (4 * g)) & 0xfu) << (8 * g + 4 * h);
              kw |= __shfl_xor(kw, 32);
              if (h == 0) ZBM[r * 128 + kt] = kw; }
            if (__any(cand != 0u)) {
                const unsigned nc = (unsigned)__popc(cand);
                unsigned pos = nc ? __hip_atomic_fetch_add(ccnt + r, nc, __ATOMIC_RELAXED, __HIP_MEMORY_SCOPE_WORKGROUP) : 0u;
#pragma unroll
                for (int i = 0; i < 16; ++i) { const bool on = (cand >> i) & 1u;
                    if (on && pos < (unsigned)CCAP) CAND[r * CCAP + pos] = ((unsigned long long)okey_of(sc[i]) << 12) | (unsigned long long)(4095 - (k0 + crow(i, h)));
                    pos += on ? 1u : 0u; }
            }
            ikf[0] = ikn[0]; ikf[1] = ikn[1];
        }
    }
    __syncthreads();
    if (C.tid < 32 && ccnt[C.tid] > (unsigned)CCAP) ccnt[32] = 1u;
    __syncthreads();
    if (ccnt[32] == 0u || (PROBE_DUP & 16384)) {
        const unsigned long long ZK = 0x80000000ull << 12;
        for (int qq = 0; qq < 4; ++qq) {
            const int q = C.wave * 4 + qq; const unsigned n = ccnt[q]; unsigned rk = QS[q * 4 + 2];
            unsigned long long cv[6];
#pragma unroll
            for (int j = 0; j < 6; ++j) { const unsigned idx = (unsigned)C.lane + 64u * j; cv[j] = (idx < n) ? CAND[q * CCAP + idx] : 0ull; }
            unsigned z0 = (2 * C.lane < nkt) ? ZBM[q * 128 + 2 * C.lane] : 0u, z1 = (2 * C.lane + 1 < nkt) ? ZBM[q * 128 + 2 * C.lane + 1] : 0u;
            unsigned Pc = 0, Zc;
#pragma unroll
            for (int j = 0; j < 6; ++j) Pc += (unsigned)__popcll(__ballot(cv[j] >= ZK + 4096ull));
            { unsigned zc = (unsigned)(__popc(z0) + __popc(z1)); Zc = zc;
#pragma unroll
              for (int o = 32; o > 0; o >>= 1) Zc += __shfl_xor(Zc, o); }
            unsigned long long thr;
            unsigned mz = 0;
            if (rk <= Pc || rk > Pc + Zc) {
                if (rk > Pc + Zc) { mz = Zc; }
                const bool neg = rk > Pc + Zc; const unsigned rk2 = neg ? rk - Zc : rk;
                unsigned long long cur = 0ull;
                if (n <= 64u) {
                    for (int bit = 43; bit >= 0; --bit) { const unsigned long long T = cur | (1ull << bit); if ((unsigned)__popcll(__ballot(cv[0] != 0ull && cv[0] >= T)) >= rk2) cur = T; }
                } else {
                    for (int bit = 43; bit >= 0; --bit) { const unsigned long long T = cur | (1ull << bit); unsigned cnt = 0;
#pragma unroll
                        for (int j = 0; j < 6; ++j) cnt += (unsigned)__popcll(__ballot(cv[j] != 0ull && cv[j] >= T));
                        if (cnt >= rk2) cur = T; }
                }
                thr = cur;
            } else { thr = ZK + 4096ull; mz = rk - Pc; }
#pragma unroll
            for (int j = 0; j < 6; ++j) {
                if (cv[j] != 0ull && cv[j] >= thr) { const int key = 4095 - (int)(cv[j] & 4095ull), kt = key >> 5, kk = key & 31, hh = (kk >> 2) & 1, ii = (kk & 3) + 4 * (kk >> 3);
                    const int w16 = kt * 64 + q + 32 * hh;
                    __hip_atomic_fetch_or((LAS unsigned*)LM + (w16 >> 1), 1u << (16 * (w16 & 1) + ii), __ATOMIC_RELAXED, __HIP_MEMORY_SCOPE_WORKGROUP); } }
            if (mz > 0u) {
                const unsigned c0 = (unsigned)__popc(z0), c1 = (unsigned)__popc(z1); unsigned incl = c0 + c1;
#pragma unroll
                for (int o = 1; o < 64; o <<= 1) { const unsigned y = __shfl_up(incl, o); if (C.lane >= o) incl += y; }
                unsigned before = incl - (c0 + c1);
                unsigned need0 = (before >= mz) ? 0u : ((mz - before) < c0 ? (mz - before) : c0);
                while ((unsigned)__popc(z0) > need0) z0 &= ~(0x80000000u >> __clz(z0));
                before += c0;
                unsigned need1 = (before >= mz) ? 0u : ((mz - before) < c1 ? (mz - before) : c1);
                while ((unsigned)__popc(z1) > need1) z1 &= ~(0x80000000u >> __clz(z1));
#pragma unroll
                for (int tz = 0; tz < 2; ++tz) { const unsigned zw = tz ? z1 : z0; const int kt = 2 * C.lane + tz;
                    if (zw) {
#pragma unroll
                        for (int hh = 0; hh < 2; ++hh) { unsigned m16 = 0;
#pragma unroll
                            for (int g = 0; g < 4; ++g) m16 |= ((zw >> (8 * g + 4 * hh)) & 0xfu) << (4 * g);
                            const int w16 = kt * 64 + q + 32 * hh;
                            if (m16) __hip_atomic_fetch_or((LAS unsigned*)LM + (w16 >> 1), m16 << (16 * (w16 & 1)), __ATOMIC_RELAXED, __HIP_MEMORY_SCOPE_WORKGROUP); } } }
            }
        }
        __syncthreads();
        { const LAS unsigned* src = (const LAS unsigned*)LM; unsigned* dst = (unsigned*)(MASK + ((size_t)(b * 128 + qt) * 128) * 64);
          for (int i = C.tid; i < nkt * 32; i += NTHREADS) dst[i] = src[i]; }
        __syncthreads();
        return;
    }
    for (int i = C.tid; i < 32 * D1_HSTRIDE; i += NTHREADS) hist[i] = 0u;
    if (C.tid < 32) { QS[C.tid * 4 + 0] = 0u; QS[C.tid * 4 + 1] = 0u; QS[C.tid * 4 + 2] = 256u; QS[C.tid * 4 + 3] = 0u; }
    __syncthreads();
    d1_pass<0>(C, PROJ, tokb, q0, nkt, iqf, iw, hist, QS);
    for (int i = C.tid; i < 32 * D1_HSTRIDE; i += NTHREADS) hist[i] = 0u;
    __syncthreads();
    d1_pass<1>(C, PROJ, tokb, q0, nkt, iqf, iw, hist, QS);
    d1_pass<2>(C, PROJ, tokb, q0, nkt, iqf, iw, hist, QS);
    d1_pass<3>(C, PROJ, tokb, q0, nkt, iqf, iw, hist, QS);
    {
      const unsigned long long theta = ((unsigned long long)QS[r * 4 + 0] << 12) | ((unsigned long long)QS[r * 4 + 1] << 11) | QS[r * 4 + 3];
      for (int rep = 0; rep < ((PROBE_DUP & 4096) ? 2 : 1); ++rep)
      for (int kt = C.wave; kt < nkt; kt += NWAVES) {
          const int k0 = kt * 32; bf16x8 ikf[2];
          const bf16_t* kp = PROJ + (size_t)(tokb + k0 + r) * PROJ_LD + PC_DIK + 8 * h;
          ikf[0] = *(const bf16x8*)kp; ikf[1] = *(const bf16x8*)(kp + 16);
          const f32x16 sc = idx_score(ikf, iqf, iw);
          unsigned vmask = 0;
#pragma unroll
          for (int i = 0; i < 16; ++i) { const int key = k0 + crow(i, h); const unsigned long long comp = ((unsigned long long)okey_of(sc[i]) << 12) | (unsigned long long)(4095 - key);
              vmask |= (key <= q0 + r && comp >= theta) ? (1u << i) : 0u; }
          mrow[(size_t)kt * 64] = (unsigned short)vmask; } }
    __syncthreads();
}

DI void dsa_attn_wave(const Ctx& C, const Params& P) {
    const bf16_t* PROJ = (const bf16_t*)(P.ws + WS_R1 + R1_PROJ); const bf16_t* VT = (const bf16_t*)(P.ws + WS_R1 + R1_VT); bf16_t* Y = wsp<bf16_t>(P, WS_Y);
    const unsigned short* MASK = wsp<unsigned short>(P, WS_MASK);
    int bh, qs; causal_wave_unit(C.bid, C.wave, bh, qs);
    const int b = bh >> 2, hd = bh & 3, r = C.lane & 31, h = C.lane >> 5, tokb = b * SEQ, q0 = qs * 32, t = q0 + r;
    bf16x8 qf[4];
#pragma unroll
    for (int s = 0; s < 4; ++s) qf[s] = *(const bf16x8*)(PROJ + (size_t)(tokb + t) * PROJ_LD + PC_DQ + hd * 64 + 16 * s + 8 * h);
    f32x16 O[2] = {zero16(), zero16()}; float mm = -1e30f, ll = 0.f;
    const float c = 0.125f * 1.4426950408889634f;
    const int nkt = qs + 1;
    const bf16_t* kbase = PROJ + (size_t)tokb * PROJ_LD + PC_DK;
    const bf16_t* vrow0 = VT + (size_t)(256 + r) * NTOK + tokb; const bf16_t* vrow1 = vrow0 + (size_t)32 * NTOK;
    const unsigned short* mrow = MASK + ((size_t)(b * 128 + qs) * 128) * 64 + C.lane;
    KV64 ta, tb; unsigned ma, mb;
    kv64_load(ta, kbase, PROJ_LD, vrow0, vrow1, 0, r, h); ma = mrow[0];
    for (int kt = 0; kt < nkt; kt += 2) {
        if (kt + 1 < nkt) { kv64_load(tb, kbase, PROJ_LD, vrow0, vrow1, (kt + 1) * 32, r, h); mb = mrow[(size_t)(kt + 1) * 64]; }
        kv64_step(ta, qf, true, ma, c, mm, ll, O);
        if (kt + 1 < nkt) { if (kt + 2 < nkt) { kv64_load(ta, kbase, PROJ_LD, vrow0, vrow1, (kt + 2) * 32, r, h); ma = mrow[(size_t)(kt + 2) * 64]; }
            kv64_step(tb, qf, true, mb, c, mm, ll, O); }
    }
    ll += __shfl_xor(ll, 32);
    const float il = 1.0f / ll; bf16_t* yrow = Y + (size_t)(tokb + t) * DM + 768 + hd * 64;
#pragma unroll
    for (int et = 0; et < 2; ++et)
#pragma unroll
        for (int g = 0; g < 4; ++g) { u32x2 w; w.x = pk2(O[et][4 * g] * il, O[et][4 * g + 1] * il); w.y = pk2(O[et][4 * g + 2] * il, O[et][4 * g + 3] * il);
            *(u32x2*)(yrow + et * 32 + 8 * g + 4 * h) = w; }
}

constexpr int CA_KB = 64 * 144, CA_VB = 64 * 136, CA_BUF = CA_KB + CA_VB;
template <bool DIFF>
DI void causal_attn_block(const Ctx& C, const Params& P, int l) {
    const bf16_t* PROJ = (const bf16_t*)(P.ws + WS_R1 + R1_PROJ); const bf16_t* VT = (const bf16_t*)(P.ws + WS_R1 + R1_VT); bf16_t* Y = wsp<bf16_t>(P, WS_Y);
    const unsigned short* MASK = wsp<unsigned short>(P, WS_MASK);
    const int bh = (C.bid >> 4) & 15, g = C.bid & 15, j0 = 4 * g, b = bh >> 2, hd = bh & 3, tokb = b * SEQ;
#if (PROBE_DUP & 262144)
    const int qs = ((C.wave & 1) == 0) ? 127 - (j0 + (C.wave >> 1)) : j0 + (C.wave >> 1);
#else
    const int qs = (C.wave < 4) ? 127 - (j0 + C.wave) : j0 + (C.wave - 4);
#endif
    const int r = C.lane & 31, h = C.lane >> 5, q0 = qs * 32, t = q0 + r;
    const int nsub = qs + 1, NT = (128 - j0 + 1) >> 1;
    const int kcol = DIFF ? PC_AK + hd * 64 : PC_DK, vrb = DIFF ? hd * 64 : 256;
    const int srow = C.tid >> 3, sch = C.tid & 7;
    const bf16_t* kg = PROJ + (size_t)(tokb + srow) * PROJ_LD + kcol + sch * 8;
    const bf16_t* vg = VT + (size_t)(vrb + srow) * NTOK + tokb + sch * 8;
    LAS unsigned char* kdst = C.lds + srow * 144 + sch * 16; LAS unsigned char* vdst = C.lds + CA_KB + srow * 136 + sch * 16;
    bf16x8 qfd[2][2], qf4[4];
    if constexpr (DIFF) {
#pragma unroll
        for (int m = 0; m < 2; ++m)
#pragma unroll
            for (int s = 0; s < 2; ++s) qfd[m][s] = *(const bf16x8*)(PROJ + (size_t)(tokb + t) * PROJ_LD + PC_AQ + hd * 64 + m * 32 + 16 * s + 8 * h);
    } else {
#pragma unroll
        for (int s = 0; s < 4; ++s) qf4[s] = *(const bf16x8*)(PROJ + (size_t)(tokb + t) * PROJ_LD + PC_DQ + hd * 64 + 16 * s + 8 * h);
    }
    f32x16 O[2][2]; float mm[2] = {-1e30f, -1e30f}, ll[2] = {0.f, 0.f};
#pragma unroll
    for (int m = 0; m < 2; ++m) { O[m][0] = zero16(); O[m][1] = zero16(); }
    const float c = (DIFF ? 0.17677669529663687f : 0.125f) * 1.4426950408889634f;
    const unsigned dmask = causal_mask(r, h);
    const unsigned short* mrow = MASK + ((size_t)(b * 128 + qs) * 128) * 64 + C.lane;
    u32x4 kreg = *(const u32x4*)kg, vreg = *(const u32x4*)vg, kr2, vr2;
    unsigned mcur[2] = {0u, 0u}, mnxt[2] = {0u, 0u}, mn2[2] = {0u, 0u};
    if constexpr (!DIFF) { mcur[0] = mrow[0]; if (1 < nsub) mcur[1] = mrow[64]; if (2 < nsub) mnxt[0] = mrow[128]; if (3 < nsub) mnxt[1] = mrow[192]; }
    *(LAS u32x4*)kdst = kreg; *(LAS u32x2*)vdst = (u32x2){vreg.x, vreg.y}; *(LAS u32x2*)(vdst + 8) = (u32x2){vreg.z, vreg.w};
    if (1 < NT) { kreg = *(const u32x4*)(kg + (size_t)64 * PROJ_LD); vreg = *(const u32x4*)(vg + 64); }
    __syncthreads();
    for (int T = 0; T < NT; ++T) {
        const int cur = T & 1;
        if (T + 2 < NT) { kr2 = *(const u32x4*)(kg + (size_t)(T + 2) * 64 * PROJ_LD); vr2 = *(const u32x4*)(vg + (T + 2) * 64);
            if constexpr (!DIFF) { if (2 * T + 4 < nsub) mn2[0] = mrow[(size_t)(2 * T + 4) * 64]; if (2 * T + 5 < nsub) mn2[1] = mrow[(size_t)(2 * T + 5) * 64]; } }
        const LAS unsigned char* KB = C.lds + cur * CA_BUF; const LAS unsigned char* VB = KB + CA_KB;
#pragma unroll
        for (int sub = 0; sub < 2; ++sub) {
            const int st = 2 * T + sub;
            if (st < nsub) {
                const LAS unsigned char* krow = KB + (sub * 32 + r) * 144 + h * 16;
                const LAS unsigned char* v0 = VB + r * 136 + (sub * 32 + 4 * h) * 2; const LAS unsigned char* v1 = v0 + 32 * 136;
                if constexpr (DIFF) {
                    DiffKV tl;
#pragma unroll
                    for (int m = 0; m < 2; ++m)
#pragma unroll
                        for (int s = 0; s < 2; ++s) tl.kf[m][s] = *(const LAS bf16x8*)(krow + m * 64 + s * 32);
#pragma unroll
                    for (int s2 = 0; s2 < 2; ++s2) {
                        { const u32x2 lo = *(const LAS u32x2*)(v0 + s2 * 32), hi = *(const LAS u32x2*)(v0 + s2 * 32 + 16); u32x4 w; w.x = lo.x; w.y = lo.y; w.z = hi.x; w.w = hi.y; tl.vf[0][s2] = __builtin_bit_cast(bf16x8, w); }
                        { const u32x2 lo = *(const LAS u32x2*)(v1 + s2 * 32), hi = *(const LAS u32x2*)(v1 + s2 * 32 + 16); u32x4 w; w.x = lo.x; w.y = lo.y; w.z = hi.x; w.w = hi.y; tl.vf[1][s2] = __builtin_bit_cast(bf16x8, w); } }
                    diff_step(tl, qfd, st == nsub - 1, dmask, c, mm, ll, O);
                } else {
                    KV64 tl; const unsigned vm = mcur[sub];
#pragma unroll
                    for (int s = 0; s < 4; ++s) tl.kf[s] = *(const LAS bf16x8*)(krow + s * 32);
#pragma unroll
                    for (int s2 = 0; s2 < 2; ++s2) {
                        { const u32x2 lo = *(const LAS u32x2*)(v0 + s2 * 32), hi = *(const LAS u32x2*)(v0 + s2 * 32 + 16); u32x4 w; w.x = lo.x; w.y = lo.y; w.z = hi.x; w.w = hi.y; tl.vf[0][s2] = __builtin_bit_cast(bf16x8, w); }
                        { const u32x2 lo = *(const LAS u32x2*)(v1 + s2 * 32), hi = *(const LAS u32x2*)(v1 + s2 * 32 + 16); u32x4 w; w.x = lo.x; w.y = lo.y; w.z = hi.x; w.w = hi.y; tl.vf[1][s2] = __builtin_bit_cast(bf16x8, w); } }
                    kv64_step(tl, qf4, true, vm, c, mm[0], ll[0], O[0]);
                }
            }
        }
        if (T + 1 < NT) { LAS unsigned char* kd = kdst + (cur ^ 1) * CA_BUF; LAS unsigned char* vd = vdst + (cur ^ 1) * CA_BUF;
            *(LAS u32x4*)kd = kreg; *(LAS u32x2*)vd = (u32x2){vreg.x, vreg.y}; *(LAS u32x2*)(vd + 8) = (u32x2){vreg.z, vreg.w}; }
        kreg = kr2; vreg = vr2; mcur[0] = mnxt[0]; mcur[1] = mnxt[1]; mnxt[0] = mn2[0]; mnxt[1] = mn2[1];
        __syncthreads();
    }
    if constexpr (DIFF) {
        const float* lv = P.diff_lambda + l * 128;
        const float d1 = wave_sum(C.lane < 32 ? lv[C.lane] * lv[32 + C.lane] : 0.f), d2 = wave_sum(C.lane < 32 ? lv[64 + C.lane] * lv[96 + C.lane] : 0.f);
        const float lam_init = 0.8f - 0.6f * expf(-0.3f * (float)l), lam = expf(d1) - expf(d2) + lam_init;
        ll[0] += __shfl_xor(ll[0], 32); ll[1] += __shfl_xor(ll[1], 32);
        const float i0 = 1.0f / ll[0], i1 = lam / ll[1]; float ss = 0.f;
#pragma unroll
        for (int et = 0; et < 2; ++et)
#pragma unroll
            for (int i = 0; i < 16; ++i) { const float o = O[0][et][i] * i0 - O[1][et][i] * i1; O[0][et][i] = o; ss += o * o; }
        ss += __shfl_xor(ss, 32);
        const float rn = (1.0f - lam_init) / sqrtf(ss * (1.0f / 64.0f) + 1e-6f);
        bf16_t* yrow = Y + (size_t)(tokb + t) * DM + hd * 64;
#pragma unroll
        for (int et = 0; et < 2; ++et)
#pragma unroll
            for (int gq = 0; gq < 4; ++gq) { u32x2 w; w.x = pk2(O[0][et][4 * gq] * rn, O[0][et][4 * gq + 1] * rn); w.y = pk2(O[0][et][4 * gq + 2] * rn, O[0][et][4 * gq + 3] * rn);
                *(u32x2*)(yrow + et * 32 + 8 * gq + 4 * h) = w; }
    } else {
        ll[0] += __shfl_xor(ll[0], 32);
        const float il = 1.0f / ll[0]; bf16_t* yrow = Y + (size_t)(tokb + t) * DM + 768 + hd * 64;
#pragma unroll
        for (int et = 0; et < 2; ++et)
#pragma unroll
            for (int gq = 0; gq < 4; ++gq) { u32x2 w; w.x = pk2(O[0][et][4 * gq] * il, O[0][et][4 * gq + 1] * il); w.y = pk2(O[0][et][4 * gq + 2] * il, O[0][et][4 * gq + 3] * il);
                *(u32x2*)(yrow + et * 32 + 8 * gq + 4 * h) = w; }
    }
    __syncthreads();
}

constexpr int CB_KB = 128 * 144, CB_VB = 64 * 264, CB_BUF = CB_KB + CB_VB;
template <bool DIFF>
DI void causal_attn_unit2(const Ctx& C, const Params& P, int l, int bh, int G) {
    const bf16_t* PROJ = (const bf16_t*)(P.ws + WS_R1 + R1_PROJ); const bf16_t* VT = (const bf16_t*)(P.ws + WS_R1 + R1_VT); bf16_t* Y = wsp<bf16_t>(P, WS_Y);
    const unsigned short* MASK = wsp<unsigned short>(P, WS_MASK);
    const int b = bh >> 2, hd = bh & 3, tokb = b * SEQ;
    const int qs = 4 * G + (C.wave & 3), par = C.wave >> 2;
    const int r = C.lane & 31, h = C.lane >> 5, q0 = qs * 32, t = q0 + r;
    const int NT = G + 1;
    const int kcol = DIFF ? PC_AK + hd * 64 : PC_DK, vrb = DIFF ? hd * 64 : 256;
    const int srow = C.tid >> 3, sch = C.tid & 7;
    const bf16_t* kg = PROJ + (size_t)(tokb + srow) * PROJ_LD + kcol + sch * 8;
    const bf16_t* vg = VT + (size_t)(vrb + srow) * NTOK + tokb + sch * 8;
    LAS unsigned char* kdst = C.lds + srow * 144 + sch * 16; LAS unsigned char* vdst = C.lds + CB_KB + srow * 264 + sch * 16;
    bf16x8 qfd[2][2], qf4[4];
    if constexpr (DIFF) {
#pragma unroll
        for (int m = 0; m < 2; ++m)
#pragma unroll
            for (int s = 0; s < 2; ++s) qfd[m][s] = *(const bf16x8*)(PROJ + (size_t)(tokb + t) * PROJ_LD + PC_AQ + hd * 64 + m * 32 + 16 * s + 8 * h);
    } else {
#pragma unroll
        for (int s = 0; s < 4; ++s) qf4[s] = *(const bf16x8*)(PROJ + (size_t)(tokb + t) * PROJ_LD + PC_DQ + hd * 64 + 16 * s + 8 * h);
    }
    f32x16 O[2][2]; float mm[2] = {-1e30f, -1e30f}, ll[2] = {0.f, 0.f};
#pragma unroll
    for (int m = 0; m < 2; ++m) { O[m][0] = zero16(); O[m][1] = zero16(); }
    const float c = (DIFF ? 0.17677669529663687f : 0.125f) * 1.4426950408889634f;
    const unsigned dmask = causal_mask(r, h);
    const unsigned short* mrow = MASK + ((size_t)(b * 128 + qs) * 128) * 64 + C.lane;
    u32x4 kr[2], vr[2];
#define CB_GLOAD(T_) do { kr[0] = *(const u32x4*)(kg + (size_t)((T_) * 128) * PROJ_LD); kr[1] = *(const u32x4*)(kg + (size_t)((T_) * 128 + 64) * PROJ_LD); \
        vr[0] = *(const u32x4*)(vg + (T_) * 128); vr[1] = *(const u32x4*)(vg + (T_) * 128 + 64); } while (0)
#define CB_LSTORE(buf_) do { LAS unsigned char* kd_ = kdst + (buf_) * CB_BUF; LAS unsigned char* vd_ = vdst + (buf_) * CB_BUF; \
        *(LAS u32x4*)kd_ = kr[0]; *(LAS u32x4*)(kd_ + 64 * 144) = kr[1]; \
        *(LAS u32x2*)vd_ = (u32x2){vr[0].x, vr[0].y}; *(LAS u32x2*)(vd_ + 8) = (u32x2){vr[0].z, vr[0].w}; \
        *(LAS u32x2*)(vd_ + 128) = (u32x2){vr[1].x, vr[1].y}; *(LAS u32x2*)(vd_ + 136) = (u32x2){vr[1].z, vr[1].w}; } while (0)
    unsigned mcur[2] = {0u, 0u}, mnxt[2] = {0u, 0u};
    if constexpr (!DIFF) { if (par <= qs) mcur[0] = mrow[(size_t)par * 64]; if (par + 2 <= qs) mcur[1] = mrow[(size_t)(par + 2) * 64]; }
    CB_GLOAD(0); CB_LSTORE(0);
    __syncthreads();
    int cur = 0;
    for (int T = 0; T < NT; ++T) {
        const int nxb = (cur == 2) ? 0 : cur + 1;
        if (T + 1 < NT) { CB_GLOAD(T + 1);
            if constexpr (!DIFF) { const int s0 = 4 * (T + 1) + par; if (s0 <= qs) mnxt[0] = mrow[(size_t)s0 * 64]; if (s0 + 2 <= qs) mnxt[1] = mrow[(size_t)(s0 + 2) * 64]; } }
        const LAS unsigned char* KB = C.lds + cur * CB_BUF; const LAS unsigned char* VB = KB + CB_KB;
#pragma unroll
        for (int k2 = 0; k2 < 2; ++k2) {
            if (k2 == 1 && par == 1) { if (T + 1 < NT) CB_LSTORE(nxb); __syncthreads(); }
            const int sub = par + 2 * k2, st = 4 * T + sub;
            if (st <= qs) {
                const LAS unsigned char* krow = KB + (sub * 32 + r) * 144 + h * 16;
                const LAS unsigned char* v0 = VB + r * 264 + (sub * 32 + 4 * h) * 2; const LAS unsigned char* v1 = v0 + 32 * 264;
                if constexpr (DIFF) {
                    DiffKV tl;
#pragma unroll
                    for (int m = 0; m < 2; ++m)
#pragma unroll
                        for (int s = 0; s < 2; ++s) tl.kf[m][s] = *(const LAS bf16x8*)(krow + m * 64 + s * 32);
#pragma unroll
                    for (int s2 = 0; s2 < 2; ++s2) {
                        { const u32x2 lo = *(const LAS u32x2*)(v0 + s2 * 32), hi = *(const LAS u32x2*)(v0 + s2 * 32 + 16); u32x4 w; w.x = lo.x; w.y = lo.y; w.z = hi.x; w.w = hi.y; tl.vf[0][s2] = __builtin_bit_cast(bf16x8, w); }
                        { const u32x2 lo = *(const LAS u32x2*)(v1 + s2 * 32), hi = *(const LAS u32x2*)(v1 + s2 * 32 + 16); u32x4 w; w.x = lo.x; w.y = lo.y; w.z = hi.x; w.w = hi.y; tl.vf[1][s2] = __builtin_bit_cast(bf16x8, w); } }
                    diff_step(tl, qfd, st == qs, dmask, c, mm, ll, O);
                } else {
                    KV64 tl; const unsigned vm = mcur[k2];
#pragma unroll
                    for (int s = 0; s < 4; ++s) tl.kf[s] = *(const LAS bf16x8*)(krow + s * 32);
#pragma unroll
                    for (int s2 = 0; s2 < 2; ++s2) {
                        { const u32x2 lo = *(const LAS u32x2*)(v0 + s2 * 32), hi = *(const LAS u32x2*)(v0 + s2 * 32 + 16); u32x4 w; w.x = lo.x; w.y = lo.y; w.z = hi.x; w.w = hi.y; tl.vf[0][s2] = __builtin_bit_cast(bf16x8, w); }
                        { const u32x2 lo = *(const LAS u32x2*)(v1 + s2 * 32), hi = *(const LAS u32x2*)(v1 + s2 * 32 + 16); u32x4 w; w.x = lo.x; w.y = lo.y; w.z = hi.x; w.w = hi.y; tl.vf[1][s2] = __builtin_bit_cast(bf16x8, w); } }
                    kv64_step(tl, qf4, true, vm, c, mm[0], ll[0], O[0]);
                }
            }
        }
        if (par == 0) { if (T + 1 < NT) CB_LSTORE(nxb); __syncthreads(); }
        mcur[0] = mnxt[0]; mcur[1] = mnxt[1]; cur = nxb;
    }
#undef CB_GLOAD
#undef CB_LSTORE
    constexpr int NM = DIFF ? 2 : 1, NV = NM * 34;
    LAS float* MA = (LAS float*)C.lds + (size_t)(C.wave & 3) * 64 * NV + C.lane;
    __syncthreads();
    if (par == 1) {
#pragma unroll
        for (int m = 0; m < NM; ++m) { MA[(m * 34 + 0) * 64] = mm[m]; MA[(m * 34 + 1) * 64] = ll[m];
#pragma unroll
            for (int et = 0; et < 2; ++et)
#pragma unroll
                for (int i = 0; i < 16; ++i) MA[(m * 34 + 2 + et * 16 + i) * 64] = O[m][et][i]; }
    }
    __syncthreads();
    if (par == 0) {
#pragma unroll
        for (int m = 0; m < NM; ++m) { const float mB = MA[(m * 34 + 0) * 64], lB = MA[(m * 34 + 1) * 64];
            const float mn = fmaxf(mm[m], mB), aA = __builtin_amdgcn_exp2f((mm[m] - mn) * c), aB = __builtin_amdgcn_exp2f((mB - mn) * c);
            ll[m] = ll[m] * aA + lB * aB;
#pragma unroll
            for (int et = 0; et < 2; ++et)
#pragma unroll
                for (int i = 0; i < 16; ++i) O[m][et][i] = O[m][et][i] * aA + MA[(m * 34 + 2 + et * 16 + i) * 64] * aB; }
        if constexpr (DIFF) {
            const float* lv = P.diff_lambda + l * 128;
            const float d1 = wave_sum(C.lane < 32 ? lv[C.lane] * lv[32 + C.lane] : 0.f), d2 = wave_sum(C.lane < 32 ? lv[64 + C.lane] * lv[96 + C.lane] : 0.f);
            const float lam_init = 0.8f - 0.6f * expf(-0.3f * (float)l), lam = expf(d1) - expf(d2) + lam_init;
            ll[0] += __shfl_xor(ll[0], 32); ll[1] += __shfl_xor(ll[1], 32);
            const float i0 = 1.0f / ll[0], i1 = lam / ll[1]; float ss = 0.f;
#pragma unroll
            for (int et = 0; et < 2; ++et)
#pragma unroll
                for (int i = 0; i < 16; ++i) { const float o = O[0][et][i] * i0 - O[1][et][i] * i1; O[0][et][i] = o; ss += o * o; }
            ss += __shfl_xor(ss, 32);
            const float rn = (1.0f - lam_init) / sqrtf(ss * (1.0f / 64.0f) + 1e-6f);
            bf16_t* yrow = Y + (size_t)(tokb + t) * DM + hd * 64;
#pragma unroll
            for (int et = 0; et < 2; ++et)
#pragma unroll
                for (int gq = 0; gq < 4; ++gq) { u32x2 w; w.x = pk2(O[0][et][4 * gq] * rn, O[0][et][4 * gq + 1] * rn); w.y = pk2(O[0][et][4 * gq + 2] * rn, O[0][et][4 * gq + 3] * rn);
                    *(u32x2*)(yrow + et * 32 + 8 * gq + 4 * h) = w; }
        } else {
            ll[0] += __shfl_xor(ll[0], 32);
            const float il = 1.0f / ll[0]; bf16_t* yrow = Y + (size_t)(tokb + t) * DM + 768 + hd * 64;
#pragma unroll
            for (int et = 0; et < 2; ++et)
#pragma unroll
                for (int gq = 0; gq < 4; ++gq) { u32x2 w; w.x = pk2(O[0][et][4 * gq] * il, O[0][et][4 * gq + 1] * il); w.y = pk2(O[0][et][4 * gq + 2] * il, O[0][et][4 * gq + 3] * il);
                    *(u32x2*)(yrow + et * 32 + 8 * gq + 4 * h) = w; }
        }
    }
    __syncthreads();
}
template <bool DIFF>
DI void causal_attn_block2(const Ctx& C, const Params& P, int l) {
    const int xj = C.bid >> 3, bh = ((C.bid & 7) * 2 + (xj >> 4)) & 15, gi = xj & 15;
    causal_attn_unit2<DIFF>(C, P, l, bh, 31 - gi);
    causal_attn_unit2<DIFF>(C, P, l, bh, gi);
}

DI void mem_attn_block(const Ctx& C, const Params& P, int l) {
    const bf16_t* MQ = (const bf16_t*)(P.ws + WS_R1 + R1_MQ); bf16_t* MO = (bf16_t*)(P.ws + WS_R1 + R1_MO);
    const bf16_t* MK = wsp<bf16_t>(P, WS_MK) + (size_t)l * 1024 * 256; const bf16_t* MVT = wsp<bf16_t>(P, WS_MVT) + (size_t)l * 256 * 1024;
    const int xj = C.bid >> 3, bh = ((C.bid & 7) * 2 + (xj >> 4)) & 15, grp = xj & 15, b = bh >> 2, hd = bh & 3, r = C.lane & 31, h = C.lane >> 5;
    const int t = b * SEQ + (grp * 8 + C.wave) * 32 + r;
    bf16x8 qf[4];
#pragma unroll
    for (int s = 0; s < 4; ++s) qf[s] = *(const bf16x8*)(MQ + (size_t)t * 256 + hd * 64 + 16 * s + 8 * h);
    { u32x4 kr[4], vr[4];
#pragma unroll
      for (int j = 0; j < 4; ++j) { const int ci = C.tid + 512 * j;
          kr[j] = *(const u32x4*)(MK + (size_t)(b * 256 + (ci >> 3)) * 256 + hd * 64 + (ci & 7) * 8);
          vr[j] = *(const u32x4*)(MVT + (size_t)(hd * 64 + (ci >> 5)) * 1024 + b * 256 + (ci & 31) * 8); }
#pragma unroll
      for (int j = 0; j < 4; ++j) { const int ci = C.tid + 512 * j;
          *(LAS u32x4*)(C.lds + (ci >> 3) * 144 + (ci & 7) * 16) = kr[j];
          LAS unsigned char* vd = C.lds + 36864 + (ci >> 5) * 520 + (ci & 31) * 16;
          *(LAS u32x2*)vd = (u32x2){vr[j].x, vr[j].y}; *(LAS u32x2*)(vd + 8) = (u32x2){vr[j].z, vr[j].w}; } }
    __syncthreads();
    f32x16 O[2] = {zero16(), zero16()}; float mm = -1e30f, ll = 0.f;
    const float c = 0.125f * 1.4426950408889634f;
#pragma unroll 2
    for (int kt = 0; kt < 8; ++kt) {
        KV64 tl; const LAS unsigned char* krow = C.lds + (kt * 32 + r) * 144 + h * 16;
        const LAS unsigned char* v0 = C.lds + 36864 + r * 520 + (kt * 32 + 4 * h) * 2; const LAS unsigned char* v1 = v0 + 32 * 520;
#pragma unroll
        for (int s = 0; s < 4; ++s) tl.kf[s] = *(const LAS bf16x8*)(krow + s * 32);
#pragma unroll
        for (int s2 = 0; s2 < 2; ++s2) {
            { const u32x2 lo = *(const LAS u32x2*)(v0 + s2 * 32), hi = *(const LAS u32x2*)(v0 + s2 * 32 + 16); u32x4 w; w.x = lo.x; w.y = lo.y; w.z = hi.x; w.w = hi.y; tl.vf[0][s2] = __builtin_bit_cast(bf16x8, w); }
            { const u32x2 lo = *(const LAS u32x2*)(v1 + s2 * 32), hi = *(const LAS u32x2*)(v1 + s2 * 32 + 16); u32x4 w; w.x = lo.x; w.y = lo.y; w.z = hi.x; w.w = hi.y; tl.vf[1][s2] = __builtin_bit_cast(bf16x8, w); } }
        kv64_step(tl, qf, false, 0u, c, mm, ll, O);
    }
    ll += __shfl_xor(ll, 32);
    const float il = 1.0f / ll; bf16_t* orow = MO + (size_t)t * 256 + hd * 64;
#pragma unroll
    for (int et = 0; et < 2; ++et)
#pragma unroll
        for (int g = 0; g < 4; ++g) { u32x2 w; w.x = pk2(O[et][4 * g] * il, O[et][4 * g + 1] * il); w.y = pk2(O[et][4 * g + 2] * il, O[et][4 * g + 3] * il);
            *(u32x2*)(orow + et * 32 + 8 * g + 4 * h) = w; }
    __syncthreads();
}
DI void mma_lds(f32x16& acc, const LAS bf16_t* A, int lda, const LAS bf16_t* Bt, int ldb, int K, int lane) {
    const int r = lane & 31, h = lane >> 5;
    for (int k0 = 0; k0 < K; k0 += 16) {
        const bf16x8 a = *(const LAS bf16x8*)(A + r * lda + k0 + 8 * h);
        const bf16x8 b = *(const LAS bf16x8*)(Bt + r * ldb + k0 + 8 * h);
        acc = mfma32(a, b, acc);
    }
}

constexpr int HG_BC = 0, HG_QT = 32768, HG_KT = 50176, HG_VT = 67584, HG_ST = 86016, HG_AT = 104448;
DI float hgrn_lb(const Params& P, int l, int ch) { if (l == 0) return 0.f; const float z0 = P.hgrn_lb[ch], z1 = P.hgrn_lb[256 + ch]; return 1.0f / (1.0f + expf(z0 - z1)); }
DI void hgrn_cumsum(const Ctx& C, const Params& P, int l, const float (&fpv)[16], int ch0) {
    LAS float* BC = (LAS float*)(C.lds + HG_BC);
    const float lb = hgrn_lb(P, l, ch0 + (C.tid & 127));
#pragma unroll
    for (int j = 0; j < 16; ++j) { const float f = lb + (1.0f - lb) * frcp(1.0f + fexp(fminf(-fpv[j], 80.f))); BC[C.tid + 512 * j] = flog(fmaxf(f, 1e-30f)); }
    __syncthreads();
    if (C.tid < 128) { float cum = 0.f;
#pragma unroll 8
        for (int s = 0; s < 64; ++s) { cum += BC[s * 128 + C.tid]; BC[s * 128 + C.tid] = cum; } }
    __syncthreads();
}
DI void hgrn_local_unit(const Ctx& C, const Params& P, int l, int u) {
    const bf16_t* PROJ = (const bf16_t*)(P.ws + WS_R1 + R1_PROJ); float* HS = wsp<float>(P, WS_HS); float* HD = wsp<float>(P, WS_HD);
    const int hp = u & 1, bc = u >> 1, b = bc >> 6, c = bc & 63, tok0 = b * SEQ + c * 64, ch0 = hp * 128;
    LAS float* BC = (LAS float*)(C.lds + HG_BC); LAS bf16_t* KT = (LAS bf16_t*)(C.lds + HG_QT);   LAS bf16_t* VT = (LAS bf16_t*)(C.lds + HG_VT);
    const int cl = C.tid & 127, ch = ch0 + cl; const float lb = hgrn_lb(P, l, ch);
    float fpv[16]; bf16_t vv[16];
#pragma unroll
    for (int j = 0; j < 16; ++j) { const bf16_t* row = PROJ + (size_t)(tok0 + (C.tid >> 7) + 4 * j) * PROJ_LD; fpv[j] = bf2f(row[PC_BF + ch]); vv[j] = row[PC_BI + ch]; }
    hgrn_cumsum(C, P, l, fpv, ch0);
#pragma unroll
    for (int j = 0; j < 16; ++j) { const int s = (C.tid >> 7) + 4 * j; const float kk = (1.0f - lb) * frcp(1.0f + fexp(fminf(fpv[j], 80.f)));
        KT[cl * 72 + s] = f2bf(kk * fexp(BC[63 * 128 + cl] - BC[s * 128 + cl])); VT[cl * 72 + s] = vv[j]; }
    if (C.tid < 128) HD[(size_t)bc * 256 + ch0 + C.tid] = fexp(BC[63 * 128 + C.tid]);
    __syncthreads();
    { const int h2 = C.wave >> 2, dkt = (C.wave >> 1) & 1, dvt = C.wave & 1, r = C.lane & 31, h = C.lane >> 5;
      f32x16 acc = zero16();
      mma_lds(acc, KT + (h2 * 64 + dkt * 32) * 72, 72, VT + (h2 * 64 + dvt * 32) * 72, 72, 64, C.lane);
      float* dst = HS + ((size_t)(bc * 4 + hp * 2 + h2) * 64) * 64;
#pragma unroll
      for (int i = 0; i < 16; ++i) dst[(dkt * 32 + crow(i, h)) * 64 + dvt * 32 + r] = acc[i]; }
    __syncthreads();
}
DI void hgrn_scan_unit(const Ctx& C, const Params& P, int u) {
    float* HS = wsp<float>(P, WS_HS); const float* HD = wsp<float>(P, WS_HD);
    const int id = u * NTHREADS + C.tid;
    const int bh = id >> 12, e = id & 4095, b = bh >> 2, hh = bh & 3, dk = e >> 6;
    float Lv[64], Dv[64];
#pragma unroll
    for (int c = 0; c < 64; ++c) { const size_t bc = (size_t)b * 64 + c; Lv[c] = HS[((bc * 4 + hh) << 12) + e]; Dv[c] = HD[bc * 256 + hh * 64 + dk]; }
    float S = 0.f;
#pragma unroll
    for (int c = 0; c < 64; ++c) { const size_t bc = (size_t)b * 64 + c; HS[((bc * 4 + hh) << 12) + e] = S; S = Dv[c] * S + Lv[c]; }
}
DI void hgrn_out_unit(const Ctx& C, const Params& P, int l, int u) {
    const bf16_t* PROJ = (const bf16_t*)(P.ws + WS_R1 + R1_PROJ); const float* HS = wsp<float>(P, WS_HS); bf16_t* Y = wsp<bf16_t>(P, WS_Y);
    const int hp = u & 1, bc = u >> 1, b = bc >> 6, c = bc & 63, tok0 = b * SEQ + c * 64, ch0 = hp * 128;
    LAS float* BC = (LAS float*)(C.lds + HG_BC); LAS bf16_t* QT = (LAS bf16_t*)(C.lds + HG_QT); LAS bf16_t* KT = (LAS bf16_t*)(C.lds + HG_KT);
    LAS bf16_t* VT = (LAS bf16_t*)(C.lds + HG_VT); LAS bf16_t* ST = (LAS bf16_t*)(C.lds + HG_ST); LAS bf16_t* AT = (LAS bf16_t*)(C.lds + HG_AT);
    const int cl = C.tid & 127, ch = ch0 + cl; const float lb = hgrn_lb(P, l, ch);
    float fpv[16], qv16[16], sp16[16]; bf16_t vv[16];
#pragma unroll
    for (int j = 0; j < 16; ++j) { const bf16_t* row = PROJ + (size_t)(tok0 + (C.tid >> 7) + 4 * j) * PROJ_LD; fpv[j] = bf2f(row[PC_BF + ch]); qv16[j] = bf2f(row[PC_BQ + ch]); vv[j] = row[PC_BI + ch];
        sp16[j] = HS[(((size_t)bc * 4 + hp * 2) << 12) + C.tid + 512 * j]; }
    hgrn_cumsum(C, P, l, fpv, ch0);
#pragma unroll
    for (int j = 0; j < 16; ++j) { const int s = (C.tid >> 7) + 4 * j; const float kk = (1.0f - lb) * frcp(1.0f + fexp(fminf(fpv[j], 80.f)));
        const float q = qv16[j] * frcp(1.0f + fexp(fminf(-qv16[j], 80.f)));
        const float bs = BC[s * 128 + cl], br = BC[31 * 128 + cl];
        QT[s * 136 + cl] = f2bf(q * fexp(fminf(bs - br, 80.f)));
        KT[s * 136 + cl] = f2bf(kk * fexp(fminf(br - bs, 80.f)));
        VT[cl * 72 + s] = vv[j]; }
#pragma unroll
    for (int j = 0; j < 16; ++j) { const int i = C.tid + 512 * j, h2 = i >> 12, e = i & 4095, dk = e >> 6, dv = e & 63;
        ST[(h2 * 64 + dv) * 72 + dk] = f2bf(sp16[j] * fexp(BC[31 * 128 + h2 * 64 + dk])); }
    __syncthreads();
    {
      const int h2 = C.wave >> 2, tt = (C.wave >> 1) & 1, st = C.wave & 1, r = C.lane & 31, h = C.lane >> 5;
      if (st <= tt) { f32x16 acc = zero16();
          mma_lds(acc, QT + (tt * 32) * 136 + h2 * 64, 136, KT + (st * 32) * 136 + h2 * 64, 136, 64, C.lane);
#pragma unroll
          for (int i = 0; i < 16; ++i) { const int t = tt * 32 + crow(i, h), s = st * 32 + r; AT[(h2 * 64 + t) * 72 + s] = (s <= t) ? f2bf(acc[i]) : (bf16_t)0; } } }
    __syncthreads();
    if (C.wave < 4) {
      const int h2 = C.wave >> 1, tt = C.wave & 1, r = C.lane & 31, h = C.lane >> 5;
      f32x16 o[2] = {zero16(), zero16()};
#pragma unroll
      for (int dvt = 0; dvt < 2; ++dvt) {
          mma_lds(o[dvt], VT + (h2 * 64 + dvt * 32) * 72, 72, AT + (h2 * 64 + tt * 32) * 72, 72, (tt + 1) * 32, C.lane);
          mma_lds(o[dvt], ST + (h2 * 64 + dvt * 32) * 72, 72, QT + (tt * 32) * 136 + h2 * 64, 136, 64, C.lane); }
      float ss = 0.f;
#pragma unroll
      for (int dvt = 0; dvt < 2; ++dvt)
#pragma unroll
          for (int i = 0; i < 16; ++i) ss += o[dvt][i] * o[dvt][i];
      ss += __shfl_xor(ss, 32);
      const float rn = 1.0f / sqrtf(ss * (1.0f / 64.0f) + 1e-6f);
      const int t = tok0 + tt * 32 + r, chb = ch0 + h2 * 64;
      const bf16_t* grow = PROJ + (size_t)t * PROJ_LD + PC_BG + chb; bf16_t* yrow = Y + (size_t)t * DM + 256 + chb;
#pragma unroll
      for (int dvt = 0; dvt < 2; ++dvt)
#pragma unroll
          for (int g = 0; g < 4; ++g) { const int dv = dvt * 32 + 8 * g + 4 * h; const u32x2 gw = *(const u32x2*)(grow + dv);
              const float g0 = siluf_(bflo(gw.x)), g1 = siluf_(bfhi(gw.x)), g2 = siluf_(bflo(gw.y)), g3 = siluf_(bfhi(gw.y));
              u32x2 w; w.x = pk2(o[dvt][4 * g] * rn * g0, o[dvt][4 * g + 1] * rn * g1); w.y = pk2(o[dvt][4 * g + 2] * rn * g2, o[dvt][4 * g + 3] * rn * g3);
              *(u32x2*)(yrow + dv) = w; } }
    __syncthreads();
}

DI void sgu_unit(const Ctx& C, const Params& P, int l, int u) {
    const bf16_t* PROJ = (const bf16_t*)(P.ws + WS_R1 + R1_PROJ); bf16_t* Y = wsp<bf16_t>(P, WS_Y); const bf16_t* SW = wsp<bf16_t>(P, W_SGU);
    const float* sb = P.spatial_b + l * 512;
    LAS bf16_t* VT = (LAS bf16_t*)C.lds; const int tok0 = (u >> 1) * 128, half = u & 1;
    u32x2 wv[16];
#pragma unroll
    for (int j = 0; j < 16; ++j) wv[j] = *(const u32x2*)(PROJ + (size_t)(tok0 + C.wave + NWAVES * j) * PROJ_LD + PC_CV + C.lane * 4);
#pragma unroll
    for (int j = 0; j < 16; ++j) {
        const int s = C.wave + NWAVES * j; const u32x2 w = wv[j];
        float v[4] = {gelu_tanh(bflo(w.x)), gelu_tanh(bfhi(w.x)), gelu_tanh(bflo(w.y)), gelu_tanh(bfhi(w.y))};
        const float mu = wave_sum(v[0] + v[1] + v[2] + v[3]) * (1.0f / 256.0f);
        float q = 0.f;
#pragma unroll
        for (int jj = 0; jj < 4; ++jj) { v[jj] -= mu; q += v[jj] * v[jj]; }
        const float rs = 1.0f / sqrtf(wave_sum(q) * (1.0f / 256.0f) + 1e-6f);
#pragma unroll
        for (int jj = 0; jj < 4; ++jj) VT[(C.lane * 4 + jj) * 136 + s] = f2bf(v[jj] * rs);
    }
    __syncthreads();
    { const int g = C.wave >> 1, dt = C.wave & 1, r = C.lane & 31, h = C.lane >> 5;
      for (int ti = 0; ti < 2; ++ti) { const int tt = half ? (1 + ti) : (ti * 3);
          f32x16 acc = zero16();
          const bf16_t* wrow = SW + ((size_t)g * 128 + tt * 32 + r) * 128 + 8 * h;
          const LAS bf16_t* vrow = VT + (g * 64 + dt * 32 + r) * 136 + 8 * h;
          bf16x8 af[8];
#pragma unroll
          for (int kk = 0; kk < 8; ++kk) af[kk] = *(const bf16x8*)(wrow + (kk < 2 * (tt + 1) ? kk * 16 : 0));
#pragma unroll
          for (int kk = 0; kk < 8; ++kk) if (kk < 2 * (tt + 1)) { const bf16x8 bb = *(const LAS bf16x8*)(vrow + kk * 16); acc = mfma32(af[kk], bb, acc); }
          const int ch = g * 64 + dt * 32 + r;
#pragma unroll
          for (int i = 0; i < 16; ++i) { const int t = tt * 32 + crow(i, h); const size_t tok = (size_t)(tok0 + t);
              const float uu = gelu_tanh(bf2f(PROJ[tok * PROJ_LD + PC_CU + ch]));
              Y[tok * DM + 512 + ch] = f2bf(uu * (acc[i] + sb[g * 128 + t])); } } }
    __syncthreads();
}

DI void phase_router(const Ctx& C, const Params& P, int l, const bool dry = false) {
    float* XR = P.out; bf16_t* H = wsp<bf16_t>(P, WS_H);
    int* TOKE = wsp<int>(P, WS_TOKE); float* TOKW = wsp<float>(P, WS_TOKW); int* RANK = wsp<int>(P, WS_RANK); int* ROWTOK = dry ? wsp<int>(P, WS_DUMMY) : wsp<int>(P, WS_ROWTOK);
    unsigned* CNT = wsp<unsigned>(P, WS_CTL) + CW_CNT + 64 * l + (dry ? 256 : 0);
    const float* gain = P.norm_ffn + l * DM;
    const float* brg = P.b_rg + l * 4; const float* bre = P.b_re + l * 32;
    LAS bf16_t* XHL = (LAS bf16_t*)C.lds; LAS float* PART = (LAS float*)C.lds; LAS float* LOG = (LAS float*)(C.lds + 32768);
    LAS unsigned* lcnt = (LAS unsigned*)(C.lds + LDS_MISC + 1024); LAS unsigned* lbase = lcnt + 32;
    if (C.tid < 32) lcnt[C.tid] = 0u;
    __syncthreads();
    const int per = NTOK / C.G;
    const int r = C.lane & 31, h = C.lane >> 5;
    for (int it = 0; it < per; it += 32) {
        const int tok0 = C.bid * per + it;
        { f32x4 v[4][4];
#pragma unroll
          for (int j = 0; j < 4; ++j) { const float* xr = XR + (size_t)(tok0 + C.wave * 4 + j) * DM;
#pragma unroll
              for (int q = 0; q < 4; ++q) v[j][q] = *(const f32x4*)(xr + q * 256 + C.lane * 4); }
#pragma unroll
          for (int j = 0; j < 4; ++j) { const int tl = C.wave * 4 + j, t = tok0 + tl; float ss = 0.f;
#pragma unroll
              for (int q = 0; q < 4; ++q) ss += v[j][q][0] * v[j][q][0] + v[j][q][1] * v[j][q][1] + v[j][q][2] * v[j][q][2] + v[j][q][3] * v[j][q][3];
              ss = wave_sum(ss); const float rs = 1.0f / sqrtf(ss * (1.0f / DM) + 1e-6f);
#pragma unroll
              for (int q = 0; q < 4; ++q) { const int c = q * 256 + C.lane * 4; const f32x4 g = *(const f32x4*)(gain + c);
                  const f32x4 o = (f32x4){v[j][q][0] * rs * g[0], v[j][q][1] * rs * g[1], v[j][q][2] * rs * g[2], v[j][q][3] * rs * g[3]};
                  u32x2 w; w.x = pk2(o[0], o[1]); w.y = pk2(o[2], o[3]); *(u32x2*)(H + (size_t)t * DM + c) = w;
                  { u32x2 wl; wl.x = pk2(o[0] - bflo(w.x), o[1] - bfhi(w.x)); wl.y = pk2(o[2] - bflo(w.y), o[3] - bfhi(w.y));
                    *(LAS u32x2*)(XHL + tl * 1032 + c) = w; *(LAS u32x2*)(XHL + 33024 + tl * 1032 + c) = wl; } } } }
        __syncthreads();
        f32x16 acc = zero16();
        { const int ct = C.wave & 1, kq = C.wave >> 1;
          const LAS bf16_t* ah = XHL + r * 1032 + kq * 256 + 8 * h; const LAS bf16_t* al = ah + 33024;
          const bf16_t* bh_ = wsp<bf16_t>(P, W_RH) + (size_t)(ct * 32 + r) * 1024 + kq * 256 + 8 * h; const bf16_t* bl_ = bh_ + (size_t)64 * 1024;
#pragma unroll 4
          for (int k0 = 0; k0 < 256; k0 += 16) { const bf16x8 xh = *(const LAS bf16x8*)(ah + k0), xl = *(const LAS bf16x8*)(al + k0);
              const bf16x8 wh = *(const bf16x8*)(bh_ + k0), wl = *(const bf16x8*)(bl_ + k0);
              acc = mfma32(xh, wh, acc); acc = mfma32(xh, wl, acc); acc = mfma32(xl, wh, acc); } }
        __syncthreads();
#pragma unroll
        for (int i = 0; i < 16; ++i) PART[(C.wave * 16 + i) * 64 + C.lane] = acc[i];
        __syncthreads();
        for (int idx = C.tid; idx < 32 * 36; idx += NTHREADS) { const int tok = idx / 36, col = idx % 36, ct = col < 32 ? 0 : 1, cc = col < 32 ? col : col - 32;
            const int hh = (tok >> 2) & 1, reg = (tok & 3) + 4 * (tok >> 3); float s = 0.f;
#pragma unroll
            for (int kq = 0; kq < 4; ++kq) s += PART[((kq * 2 + ct) * 16 + reg) * 64 + cc + 32 * hh];
            LOG[tok * 36 + col] = s; }
        __syncthreads();
        if (C.tid < 32) { const int t = tok0 + C.tid; const LAS float* lg = LOG + C.tid * 36;
            float gl[4]; int gsel = 0;
#pragma unroll
            for (int k = 0; k < 4; ++k) gl[k] = lg[32 + k] + brg[k];
            float gmax = gl[0];
#pragma unroll
            for (int k = 1; k < 4; ++k) if (gl[k] > gmax) { gmax = gl[k]; gsel = k; }
            float gsum = 0.f;
#pragma unroll
            for (int k = 0; k < 4; ++k) gsum += expf(gl[k] - gmax);
            const float pg = 1.0f / gsum;
            float pe[8]; float emax = -1e30f;
#pragma unroll
            for (int k = 0; k < 8; ++k) { pe[k] = lg[gsel * 8 + k] + bre[gsel * 8 + k]; emax = fmaxf(emax, pe[k]); }
#pragma unroll
            for (int k = 0; k < 8; ++k) pe[k] = expf(pe[k] - emax);
            int i1 = 0; float p1 = pe[0];
#pragma unroll
            for (int k = 1; k < 8; ++k) if (pe[k] > p1) { p1 = pe[k]; i1 = k; }
            int i2 = (i1 == 0) ? 1 : 0; float p2 = pe[i2];
#pragma unroll
            for (int k = 0; k < 8; ++k) if (k != i1 && pe[k] > p2) { p2 = pe[k]; i2 = k; }
            const float inv = pg / (p1 + p2);
            const int e1 = gsel * 8 + i1, e2 = gsel * 8 + i2;
            TOKE[t * 2] = e1; TOKE[t * 2 + 1] = e2; TOKW[t * 2] = p1 * inv; TOKW[t * 2 + 1] = p2 * inv;
            RANK[t * 2] = (int)__hip_atomic_fetch_add(lcnt + e1, 1u, __ATOMIC_RELAXED, __HIP_MEMORY_SCOPE_WORKGROUP);
            RANK[t * 2 + 1] = (int)__hip_atomic_fetch_add(lcnt + e2, 1u, __ATOMIC_RELAXED, __HIP_MEMORY_SCOPE_WORKGROUP); }
        __syncthreads();
    }
    if (C.tid < 32) { const unsigned n = lcnt[C.tid]; lbase[C.tid] = n ? __hip_atomic_fetch_add(CNT + C.tid, n, __ATOMIC_RELAXED, __HIP_MEMORY_SCOPE_AGENT) : 0u; }
    __syncthreads();
    asm volatile("s_waitcnt vmcnt(0)" ::: "memory");
    for (int a = C.tid; a < per * 2; a += NTHREADS) { const int ga = C.bid * per * 2 + a; const int e = TOKE[ga]; const unsigned rk = lbase[e] + (unsigned)RANK[ga];
        ROWTOK[(size_t)e * MOE_CAP + rk] = ga; }
    __syncthreads();
}
typedef f32x4 AccT[2][2][4][2];
DI u32x4 pack8(const f32x4& a, const f32x4& b) { u32x4 w; w.x = pk2(a[0], a[1]); w.y = pk2(a[2], a[3]); w.z = pk2(b[0], b[1]); w.w = pk2(b[2], b[3]); return w; }
template <int ACT> struct EpiStore {
    bf16_t* O; int ldc;
    DI void operator()(const AccT& acc, const pg8::Unit& u, int wr, int wc, int fr, int fq) const {
#pragma unroll
        for (int ai = 0; ai < 2; ++ai)
#pragma unroll
            for (int m = 0; m < 4; ++m) { const size_t row = (size_t)(u.pm * 256 + ai * 128 + wr * 64 + m * 16 + fr);
#pragma unroll
                for (int bj = 0; bj < 2; ++bj) { const int col = u.pn * 256 + bj * 128 + wc * 32 + 8 * fq; f32x4 a = acc[ai][bj][m][0], b = acc[ai][bj][m][1];
                    if (ACT == 1) {
#pragma unroll
                        for (int j = 0; j < 4; ++j) { a[j] = sigmoidf_(a[j]); b[j] = sigmoidf_(b[j]); } }
                    *(u32x4*)(O + row * ldc + col) = pack8(a, b); } }
    }
};
struct EpiMerge {
    const bf16_t* GATE; bf16_t* MG;
    DI void operator()(const AccT& acc, const pg8::Unit& u, int wr, int wc, int fr, int fq) const {
#pragma unroll
        for (int ai = 0; ai < 2; ++ai)
#pragma unroll
            for (int m = 0; m < 4; ++m) { const size_t row = (size_t)(u.pm * 256 + ai * 128 + wr * 64 + m * 16 + fr);
#pragma unroll
                for (int bj = 0; bj < 2; ++bj) { const int col = u.pn * 256 + bj * 128 + wc * 32 + 8 * fq;
                    const u32x4 g = *(const u32x4*)(GATE + row * 4096 + u.x * 1024 + col);
                    f32x4 a = acc[ai][bj][m][0], b = acc[ai][bj][m][1];
                    a[0] *= bflo(g.x); a[1] *= bfhi(g.x); a[2] *= bflo(g.y); a[3] *= bfhi(g.y); b[0] *= bflo(g.z); b[1] *= bfhi(g.z); b[2] *= bflo(g.w); b[3] *= bfhi(g.w);
                    bf16_t* dst = MG + row * 1024 + col;
                    if (u.x > 0) { const u32x4 p = *(const u32x4*)dst;
                        a[0] += bflo(p.x); a[1] += bfhi(p.x); a[2] += bflo(p.y); a[3] += bfhi(p.y); b[0] += bflo(p.z); b[1] += bfhi(p.z); b[2] += bflo(p.w); b[3] += bfhi(p.w); }
                    *(u32x4*)dst = pack8(a, b); }
                asm volatile("" ::: "memory"); }
    }
};
struct EpiResid {
    float* XR;
    DI void operator()(const AccT& acc, const pg8::Unit& u, int wr, int wc, int fr, int fq) const {
#pragma unroll
        for (int ai = 0; ai < 2; ++ai)
#pragma unroll
            for (int m = 0; m < 4; ++m) { const size_t row = (size_t)(u.pm * 256 + ai * 128 + wr * 64 + m * 16 + fr);
#pragma unroll
                for (int bj = 0; bj < 2; ++bj) { float* p = XR + row * 1024 + u.pn * 256 + bj * 128 + wc * 32 + 8 * fq;
                    const f32x4 x0 = *(const f32x4*)p, x1 = *(const f32x4*)(p + 4);
                    *(f32x4*)p = x0 + acc[ai][bj][m][0]; *(f32x4*)(p + 4) = x1 + acc[ai][bj][m][1]; }
                if (m == 3) asm volatile("" ::: "memory"); }
    }
};
struct EpiResidNorm {
    float* XR; bf16_t* XB; float* RSS;
    DI void operator()(const AccT& acc, const pg8::Unit& u, int wr, int wc, int fr, int fq) const {
#pragma unroll
        for (int ai = 0; ai < 2; ++ai)
#pragma unroll
            for (int m = 0; m < 4; ++m) { const size_t row = (size_t)(u.pm * 256 + ai * 128 + wr * 64 + m * 16 + fr); float ss = 0.f;
#pragma unroll
                for (int bj = 0; bj < 2; ++bj) { const size_t off = row * 1024 + u.pn * 256 + bj * 128 + wc * 32 + 8 * fq; float* p = XR + off;
                    const f32x4 x0 = *(const f32x4*)p + acc[ai][bj][m][0], x1 = *(const f32x4*)(p + 4) + acc[ai][bj][m][1];
                    *(f32x4*)p = x0; *(f32x4*)(p + 4) = x1; *(u32x4*)(XB + off) = pack8(x0, x1);
                    ss += (x0[0] * x0[0] + x0[1] * x0[1]) + (x0[2] * x0[2] + x0[3] * x0[3]) + (x1[0] * x1[0] + x1[1] * x1[1]) + (x1[2] * x1[2] + x1[3] * x1[3]); }
                ss += __shfl_xor(ss, 16); ss += __shfl_xor(ss, 32);
                if (fq == 0) RSS[row * 16 + u.pn * 4 + wc] = ss;
                if (m == 3) asm volatile("" ::: "memory"); }
    }
};
struct EpiStoreRstd {
    bf16_t* O; int ldc; const float* RSS;
    DI void operator()(const AccT& acc, const pg8::Unit& u, int wr, int wc, int fr, int fq) const {
#pragma unroll
        for (int ai = 0; ai < 2; ++ai)
#pragma unroll
            for (int m = 0; m < 4; ++m) { const size_t row = (size_t)(u.pm * 256 + ai * 128 + wr * 64 + m * 16 + fr);
                const f32x4* rp = (const f32x4*)(RSS + row * 16); const f32x4 r0 = rp[0], r1 = rp[1], r2 = rp[2], r3 = rp[3];
                const float rsum = ((r0[0] + r0[1]) + (r0[2] + r0[3])) + ((r1[0] + r1[1]) + (r1[2] + r1[3])) + ((r2[0] + r2[1]) + (r2[2] + r2[3])) + ((r3[0] + r3[1]) + (r3[2] + r3[3]));
                const float rs = 1.0f / sqrtf(rsum * (1.0f / 1024.0f) + 1e-6f);
#pragma unroll
                for (int bj = 0; bj < 2; ++bj) { const int col = u.pn * 256 + bj * 128 + wc * 32 + 8 * fq;
                    *(u32x4*)(O + row * ldc + col) = pack8(acc[ai][bj][m][0] * rs, acc[ai][bj][m][1] * rs); } }
    }
};
struct EpiGU {
    bf16_t* HID;
    DI void operator()(const AccT& acc, const pg8::Unit& u, int wr, int wc, int fr, int fq) const {
#pragma unroll
        for (int ai = 0; ai < 2; ++ai)
#pragma unroll
            for (int m = 0; m < 4; ++m) { const size_t row = (size_t)(u.pm * 256 + ai * 128 + wr * 64 + m * 16 + fr);
                f32x4 a, b;
#pragma unroll
                for (int j = 0; j < 4; ++j) { a[j] = siluf_(acc[ai][0][m][0][j]) * acc[ai][1][m][0][j]; b[j] = siluf_(acc[ai][0][m][1][j]) * acc[ai][1][m][1][j]; }
                *(u32x4*)(HID + row * 256 + u.pn * 128 + wc * 32 + 8 * fq) = pack8(a, b); }
    }
};
struct EpiDown {
    bf16_t* YB; const int* ROWTOK; const float* TOKW; const LAS int* cnt;
    DI void operator()(const AccT& acc, const pg8::Unit& u, int wr, int wc, int fr, int fq) const {
        const int ce = cnt[u.x];
#pragma unroll
        for (int ai = 0; ai < 2; ++ai)
#pragma unroll
            for (int m = 0; m < 4; ++m) { const int idx = u.y * 256 + ai * 128 + wr * 64 + m * 16 + fr;
                if (idx < ce) { const int a = ROWTOK[(size_t)u.x * MOE_CAP + idx]; const float w = TOKW[a];
#pragma unroll
                    for (int bj = 0; bj < 2; ++bj) { const int col = u.pn * 256 + bj * 128 + wc * 32 + 8 * fq;
                        *(u32x4*)(YB + (size_t)a * 1024 + col) = pack8(acc[ai][bj][m][0] * w, acc[ai][bj][m][1] * w); } } }
    }
};

struct FusedMergeOrder {
    const char* Hb; const char* Yb; const char* Wg; const char* Wb; int G, c;
    DI bool next(int i, pg8::Unit& u) const {
        const int ti = i >> 3, x = i & 7, n = x >> 1; const long L = (long)ti * G + c; if (L >= 256) return false;
        pg8::tile_map((int)L, 64, 4, u.pm, u.pn); u.x = x; u.y = 0;
        if (x & 1) { u.a = Yb + (size_t)u.pm * 256 * 1024 * 2 + (size_t)n * 256 * 2; u.b = Wb + (size_t)u.pn * 256 * 1024 * 2 + (size_t)n * 256 * 2; u.nt = 4; }
        else { u.a = Hb + (size_t)u.pm * 256 * 1024 * 2; u.b = Wg + ((size_t)n * 1024 + (size_t)u.pn * 256) * 1024 * 2; u.nt = 16; }
        return true; }
    DI unsigned row_off(const pg8::Unit&, int) const { return 0u; }
};
struct EpiFusedMerge {
    bf16_t* GS; bf16_t* MG; int tid;
    DI void operator()(const AccT& acc, const pg8::Unit& u, int wr, int wc, int fr, int fq) const {
        u32x4* gs = (u32x4*)GS + tid;
        if ((u.x & 1) == 0) {
#pragma unroll
            for (int ai = 0; ai < 2; ++ai)
#pragma unroll
                for (int m = 0; m < 4; ++m)
#pragma unroll
                    for (int bj = 0; bj < 2; ++bj) { f32x4 a = acc[ai][bj][m][0], b = acc[ai][bj][m][1];
#pragma unroll
                        for (int j = 0; j < 4; ++j) { a[j] = sigmoidf_(a[j]); b[j] = sigmoidf_(b[j]); }
                        gs[((ai * 4 + m) * 2 + bj) * 512] = pack8(a, b); }
        } else {
#pragma unroll
            for (int ai = 0; ai < 2; ++ai)
#pragma unroll
                for (int m = 0; m < 4; ++m) { const size_t row = (size_t)(u.pm * 256 + ai * 128 + wr * 64 + m * 16 + fr);
#pragma unroll
                    for (int bj = 0; bj < 2; ++bj) { const int col = u.pn * 256 + bj * 128 + wc * 32 + 8 * fq;
                        const u32x4 g = gs[((ai * 4 + m) * 2 + bj) * 512];
                        f32x4 a = acc[ai][bj][m][0], b = acc[ai][bj][m][1];
                        a[0] *= bflo(g.x); a[1] *= bfhi(g.x); a[2] *= bflo(g.y); a[3] *= bfhi(g.y); b[0] *= bflo(g.z); b[1] *= bfhi(g.z); b[2] *= bflo(g.w); b[3] *= bfhi(g.w);
                        bf16_t* dst = MG + row * 1024 + col;
                        if (u.x > 1) { const u32x4 p = *(const u32x4*)dst;
                            a[0] += bflo(p.x); a[1] += bfhi(p.x); a[2] += bflo(p.y); a[3] += bfhi(p.y); b[0] += bflo(p.z); b[1] += bfhi(p.z); b[2] += bflo(p.w); b[3] += bfhi(p.w); }
                        *(u32x4*)dst = pack8(a, b); }
                    if (m == 3) asm volatile("" ::: "memory"); }
        }
    }
};
constexpr int MOE_TAB = LDS_MISC + 256;
DI void moe_build_table(const Ctx& C, const unsigned* CNT) {
    volatile LAS int* T = (volatile LAS int*)(C.lds + MOE_TAB);
    if (C.tid == 0) { int acc = 0; for (int e = 0; e < 32; ++e) { const int n = (int)CNT[e]; T[e] = acc; T[40 + e] = n; const int nt = (n + 255) >> 8;
            for (int j = 0; j < nt; ++j) T[80 + acc + j] = (e << 8) | j;
            acc += nt; } T[32] = acc; }
    __syncthreads();
}
template <int NPN, bool GU> struct MoeOrder {
    const LAS int* T; const char* Ab; const char* Wb; const int* ROWTOK; int G, c;
    DI bool next(int i, pg8::Unit& u) const {
        const long L0 = (long)i * G + c; const int tot = __builtin_amdgcn_readfirstlane(T[32]) * NPN, per = (tot + 7) >> 3, j_ = (int)(L0 >> 3);
        if (j_ >= per) return false;
        const long L = (long)(L0 & 7) * per + j_; if (L >= tot) return false;
        const int tile = (int)(L / NPN), pn = (int)(L % NPN);
        const int ej = __builtin_amdgcn_readfirstlane(T[80 + tile]); const int e = ej >> 8;
        u.x = e; u.y = ej & 255; u.pm = tile; u.pn = pn; u.nt = 0;
        if (GU) { u.a = Ab; u.b = Wb + ((size_t)e * 512 + (size_t)pn * 256) * 1024 * 2; }
        else { u.a = Ab + (size_t)tile * 256 * 256 * 2; u.b = Wb + ((size_t)e * 1024 + (size_t)pn * 256) * 256 * 2; }
        return true; }
    DI unsigned row_off(const pg8::Unit& u, int row) const {
        const int idx = u.y * 256 + row; int tok = 0;
        if (idx < T[40 + u.x]) tok = ROWTOK[(size_t)u.x * MOE_CAP + idx] >> 1;
        return (unsigned)tok * 2048u; }
};

constexpr int PH_PER_LAYER = 16, PH_L0 = 1, N_PHASES = PH_L0 + DEPTH * PH_PER_LAYER + 1;
#ifndef ENABLE_MASK
#define ENABLE_MASK 0xFF
#endif
#ifndef PROBE_DUP
#define PROBE_DUP 0
#endif
#define NREP(bit) ((PROBE_DUP & (bit)) ? 2 : 1)
#define ZIGZAG(n, call) do { for (int _rd = 0; _rd * C.G < (n); ++_rd) { const int u = _rd * C.G + ((_rd & 1) ? (C.G - 1 - C.bid) : C.bid); if (u < (n)) { call; } } } while (0)

typedef const Params __attribute__((address_space(4))) KParams;
#if defined(__HIP_DEVICE_COMPILE__)
#define PHASE_LOADP() KParams* _pp = (KParams*)__builtin_amdgcn_kernarg_segment_ptr(); asm volatile("" : "+s"(_pp)); const Params P = *_pp
#else
#define PHASE_LOADP() const Params P = Parg
#endif
#define PHASE_ENV() PHASE_LOADP(); const Ctx C = relaunder(C0); LAS unsigned char* lds = C.lds; bf16_t* H = wsp<bf16_t>(P, WS_H); bf16_t* Y = wsp<bf16_t>(P, WS_Y); unsigned char* R1 = P.ws + WS_R1
#define IN(k) (lo <= (k) && (k) < hi)
#define SEAM(k) do { if (IN(k) && IN((k) + 1)) { xcd_barrier(bar); if (PROBE_DUP & 1048576) xcd_barrier(bar); } } while (0)
template <int l> DI void layer_phases(const Ctx& C0, const Params& Parg, const int lo, const int hi, const XcdBarrier& bar) {
    constexpr int pb = PH_L0 + l * PH_PER_LAYER;
        if (IN(pb + 0)) { PHASE_ENV(); for (int rep = 0; rep < NREP(8); ++rep) phase_convert_layer(C, P, l);
            if (l == 0) phase_rownorm<false, true, false, true>(C, P, P.norm_mix + l * DM); else if (!(ENABLE_MASK & 32)) phase_rownorm<false, true, false>(C, P, P.norm_mix + l * DM); else phase_rownorm<true, true, false>(C, P, P.norm_mix + l * DM); } SEAM(pb + 0);
        if (IN(pb + 1)) for (int rep = 0; rep < NREP(16); ++rep) { PHASE_ENV();
            { pg8::DenseOrder S; S.init(H, wsp<bf16_t>(P, W_IN), NTOK, 2560, 1024, 1024, C.G, C.bid);
              EpiStore<0> E{(bf16_t*)(R1 + R1_PROJ), PROJ_LD}; pg8::gemm_phase<EpiStore<0>, pg8::DenseOrder, false>(C.tid, lds, 1024, 1024, 1024, S, E); }
            { pg8::DenseOrder S; S.init(wsp<bf16_t>(P, W_V), H, 512, NTOK, 1024, 1024, C.G, (C.bid + 128) % C.G);
              EpiStore<0> E{(bf16_t*)(R1 + R1_VT), NTOK}; pg8::gemm_phase<EpiStore<0>, pg8::DenseOrder, false>(C.tid, lds, 1024, 1024, 1024, S, E); }
            if (l == 0) {
        for (int lm = 0; lm < DEPTH; ++lm) {
            const bf16_t* MEMN = wsp<bf16_t>(P, WS_MEMN) + (size_t)lm * 1024 * 1024; const bf16_t* WKV = wsp<bf16_t>(P, W_KV) + (size_t)lm * 512 * 1024;
            { pg8::DenseOrder S; S.init(MEMN, WKV, 1024, 256, 1024, 1024, C.G, (C.bid + 8 * lm) % C.G);
              EpiStore<0> E{wsp<bf16_t>(P, WS_MK) + (size_t)lm * 1024 * 256, 256}; pg8::gemm_phase<EpiStore<0>, pg8::DenseOrder, false>(C.tid, lds, 1024, 1024, 1024, S, E); }
            { pg8::DenseOrder S; S.init(WKV + (size_t)256 * 1024, MEMN, 256, 1024, 1024, 1024, C.G, (C.bid + 8 * lm + 4) % C.G);
              EpiStore<0> E{wsp<bf16_t>(P, WS_MVT) + (size_t)lm * 256 * 1024, 1024}; pg8::gemm_phase<EpiStore<0>, pg8::DenseOrder, false>(C.tid, lds, 1024, 1024, 1024, S, E); }
        }
            }
        } SEAM(pb + 1);
        if (IN(pb + 2)) { PHASE_ENV(); phase_rope(C, P, l); } SEAM(pb + 2);
        if (IN(pb + 3)) { PHASE_ENV();
            for (int rep = 0; rep < NREP(1); ++rep) { if (ENABLE_MASK & 8) { const int xb = (C.bid & 7) >> 1, kq = ((C.bid & 7) & 1) * 32 + ((C.bid >> 3) & 31);
                  dsa_select_unit(C, P, l, xb, 127 - kq); dsa_select_unit(C, P, l, xb, kq); } }
            for (int rep = 0; rep < NREP(1024); ++rep) { if (ENABLE_MASK & 2) ZIGZAG(512, hgrn_local_unit(C, P, l, u);); }
            for (int rep = 0; rep < NREP(2048); ++rep) { if (ENABLE_MASK & 4) ZIGZAG(256, sgu_unit(C, P, l, u);); }
        } SEAM(pb + 3);
        if (IN(pb + 4)) { PHASE_ENV();
            for (int rep = 0; rep < NREP(2); ++rep) { if (ENABLE_MASK & 1) causal_attn_block2<true>(C, P, l); }
            if (ENABLE_MASK & 2) { for (int u = C.G - 1 - C.bid; u < 128; u += C.G) hgrn_scan_unit(C, P, u); }
        } SEAM(pb + 4);
        if (IN(pb + 5)) {
            for (int rep = 0; rep < NREP(4); ++rep) { PHASE_ENV();
            for (int r2 = 0; r2 < NREP(2097152); ++r2) { if (ENABLE_MASK & 8) causal_attn_block2<false>(C, P, l); }
            for (int r3 = 0; r3 < NREP(4194304); ++r3) { if (ENABLE_MASK & 2) ZIGZAG(512, hgrn_out_unit(C, P, l, u);); } }
        } SEAM(pb + 5);
        if (IN(pb + 7)) for (int rep = 0; rep < NREP(128); ++rep) { PHASE_ENV();
            FusedMergeOrder S{(const char*)H, (const char*)Y, (const char*)wsp<bf16_t>(P, W_G), (const char*)wsp<bf16_t>(P, W_BR), C.G, C.bid};
            EpiFusedMerge E{(bf16_t*)(R1 + R1_GS) + (size_t)C.bid * 65536, (bf16_t*)(R1 + R1_MG), C.tid};
            pg8::gemm_phase<EpiFusedMerge, FusedMergeOrder, false>(C.tid, lds, 1024, 1024, 1024, S, E);
        } SEAM(pb + 7);
        if (IN(pb + 8)) { PHASE_ENV();
            pg8::DenseOrder S; S.init(R1 + R1_MG, wsp<bf16_t>(P, W_OUT), NTOK, 1024, 1024, 1024, C.G, C.bid);
            EpiResidNorm E{P.out, H, wsp<float>(P, WS_RSS)}; pg8::gemm_phase<EpiResidNorm, pg8::DenseOrder, false>(C.tid, lds, 1024, 1024, 1024, S, E);
        } SEAM(pb + 8);
        if (IN(pb + 10)) for (int rep = 0; rep < NREP(64); ++rep) { PHASE_ENV();
            pg8::DenseOrder S; S.init(H, wsp<bf16_t>(P, W_Q), NTOK, 256, 1024, 1024, C.G, C.bid);
            EpiStoreRstd E{(bf16_t*)(R1 + R1_MQ), 256, wsp<float>(P, WS_RSS)}; pg8::gemm_phase<EpiStoreRstd, pg8::DenseOrder, false>(C.tid, lds, 1024, 1024, 1024, S, E);
        } SEAM(pb + 10);
        if (IN(pb + 11)) for (int rep = 0; rep < NREP(64); ++rep) { PHASE_ENV(); mem_attn_block(C, P, l); } SEAM(pb + 11);
        if (IN(pb + 12)) { PHASE_ENV();
            if (ENABLE_MASK & 16) { pg8::DenseOrder S; S.init(R1 + R1_MO, wsp<bf16_t>(P, W_O), NTOK, 1024, 256, 256, C.G, C.bid);
              EpiResid E{P.out}; pg8::gemm_phase<EpiResid, pg8::DenseOrder, false>(C.tid, lds, 256, 256, 256, S, E); }
        } SEAM(pb + 12);
        if (IN(pb + 13)) { PHASE_ENV(); phase_router(C, P, l); if (PROBE_DUP & 512) { __syncthreads(); phase_router(C, P, l, true); } } SEAM(pb + 13);
        if (IN(pb + 14)) for (int rep = 0; rep < NREP(32); ++rep) { PHASE_ENV();
            moe_build_table(C, wsp<unsigned>(P, WS_CTL) + CW_CNT + 64 * l);
            MoeOrder<2, true> S{(const LAS int*)(lds + MOE_TAB), (const char*)H, (const char*)wsp<bf16_t>(P, W_GU), wsp<int>(P, WS_ROWTOK), C.G, C.bid};
            EpiGU E{(bf16_t*)(R1 + R1_HID)}; pg8::gemm_phase<EpiGU, MoeOrder<2, true>, true>(C.tid, lds, 1024, 1024, 1024, S, E);
        } SEAM(pb + 14);
        if (IN(pb + 15)) for (int rep = 0; rep < NREP(32); ++rep) { PHASE_ENV();
            moe_build_table(C, wsp<unsigned>(P, WS_CTL) + CW_CNT + 64 * l);
            MoeOrder<4, false> S{(const LAS int*)(lds + MOE_TAB), (const char*)(R1 + R1_HID), (const char*)wsp<bf16_t>(P, W_D), wsp<int>(P, WS_ROWTOK), C.G, C.bid};
            EpiDown E{(bf16_t*)(R1 + R1_YB), wsp<int>(P, WS_ROWTOK), wsp<float>(P, WS_TOKW), (const LAS int*)(lds + MOE_TAB) + 40};
            pg8::gemm_phase<EpiDown, MoeOrder<4, false>, false>(C.tid, lds, 256, 256, 256, S, E);
        } SEAM(pb + 15);
    }
__global__ void __launch_bounds__(NTHREADS, 2) mega_fwd(Params Parg) {
    extern __shared__ __attribute__((aligned(16))) unsigned char lds_raw[];
    Ctx C0; C0.lds = (LAS unsigned char*)lds_raw; C0.tid = threadIdx.x; C0.lane = C0.tid & 63; C0.wave = __builtin_amdgcn_readfirstlane((int)threadIdx.x >> 6); C0.G = gridDim.x; C0.bid = blockIdx.x;
    volatile LAS unsigned* misc = (volatile LAS unsigned*)(C0.lds + LDS_MISC);
    if (C0.tid < 4) misc[C0.tid] = 0u;
    __syncthreads();
    const int lo = Parg.ph_lo, hi = Parg.ph_hi;
    const bool use_bar = (hi - lo) > 1;
    XcdBarrier bar; bar.bar = (unsigned*)(Parg.ws + WS_CTL) + CW_BAR; bar.x = 0; bar.st = misc;
    if (use_bar) bar = xcd_barrier_post((unsigned*)(Parg.ws + WS_CTL) + CW_BAR, misc);
#define IN(k) (lo <= (k) && (k) < hi)
#define SEAM(k) do { if (IN(k) && IN((k) + 1)) { xcd_barrier(bar); if (PROBE_DUP & 1048576) xcd_barrier(bar); } } while (0)

    if (IN(0)) { PHASE_ENV(); phase_prologue(C, P); } SEAM(0);
    layer_phases<0>(C0, Parg, lo, hi, bar);
    layer_phases<1>(C0, Parg, lo, hi, bar);
    if (IN(N_PHASES - 1)) { PHASE_ENV(); if (ENABLE_MASK & 32) phase_rownorm<true, false, true>(C, P, P.norm_final); else phase_rownorm<false, false, true>(C, P, P.norm_final); }
#undef IN
#undef SEAM
}

#ifndef N_LAUNCH_MODE
#define N_LAUNCH_MODE 0
#endif
extern "C" void kernel_launch(void* const* d_in, const int* in_sizes, int n_in, void* d_out, int out_size, void* d_ws, size_t ws_size, hipStream_t stream) {
    static int grid = 0;
    if (grid == 0) {
        if (n_in != 25 || out_size != NTOK * DM || ws_size < WS_END) { fprintf(stderr, "kernel_launch: unexpected shapes (n_in %d out %d ws %zu need %zu)\n", n_in, out_size, ws_size, (size_t)WS_END); grid = -1; return; }
        int dev = 0, cus = 0;
        if (hipGetDevice(&dev) != hipSuccess || hipDeviceGetAttribute(&cus, hipDeviceAttributeMultiprocessorCount, dev) != hipSuccess) { grid = -1; return; }
        if (hipFuncSetAttribute((const void*)mega_fwd, hipFuncAttributeMaxDynamicSharedMemorySize, LDS_BYTES) != hipSuccess) { fprintf(stderr, "kernel_launch: hipFuncSetAttribute failed\n"); grid = -1; return; }
        int per_cu = 0;
        if (hipOccupancyMaxActiveBlocksPerMultiprocessor(&per_cu, (const void*)mega_fwd, NTHREADS, LDS_BYTES) != hipSuccess || per_cu < 1) { fprintf(stderr, "kernel_launch: occupancy query says %d\n", per_cu); }
        (void)hipGetLastError();
        if (cus != 256) fprintf(stderr, "kernel_launch: built for 256 CUs (one workgroup per CU); device reports %d\n", cus);
        grid = 256;
    }
    if (grid < 0) return;
    (void)hipMemsetAsync((char*)d_ws + WS_CTL, 0, CTL_BYTES, stream);
    Params p{};
    p.x = (const float*)d_in[0]; p.mem = (const float*)d_in[1]; p.positions = (const int*)d_in[2];
    p.norm_mix = (const float*)d_in[3]; p.w_in = (const float*)d_in[4]; p.diff_lambda = (const float*)d_in[5]; p.hgrn_lb = (const float*)d_in[6];
    p.spatial_w = (const float*)d_in[7]; p.spatial_b = (const float*)d_in[8]; p.w_branch = (const float*)d_in[9]; p.w_out = (const float*)d_in[10];
    p.norm_mem_q = (const float*)d_in[11]; p.norm_mem_kv = (const float*)d_in[12]; p.w_mem_q = (const float*)d_in[13]; p.w_mem_kv = (const float*)d_in[14]; p.w_mem_o = (const float*)d_in[15];
    p.norm_ffn = (const float*)d_in[16]; p.w_rg = (const float*)d_in[17]; p.b_rg = (const float*)d_in[18]; p.w_re = (const float*)d_in[19]; p.b_re = (const float*)d_in[20];
    p.w_eg = (const float*)d_in[21]; p.w_eu = (const float*)d_in[22]; p.w_ed = (const float*)d_in[23]; p.norm_final = (const float*)d_in[24];
    p.out = (float*)d_out; p.ws = (unsigned char*)d_ws;
#if N_LAUNCH_MODE == 0
    p.ph_lo = 0; p.ph_hi = N_PHASES;
    hipLaunchKernelGGL(mega_fwd, dim3(grid), dim3(NTHREADS), LDS_BYTES, stream, p);
#else
    for (int k = 0; k < N_PHASES; ++k) { p.ph_lo = k; p.ph_hi = k + 1; hipLaunchKernelGGL(mega_fwd, dim3(grid), dim3(NTHREADS), LDS_BYTES, stream, p); }
#endif
}
```

```cpp
#include <hip/hip_runtime.h>
#include <stdint.h>
#include <stdio.h>

#ifndef PROBE_DUP
#define PROBE_DUP 0
#endif
#define DI __device__ __forceinline__
#define LAS __attribute__((address_space(3)))
typedef unsigned short bf16_t;
typedef short bf16x8 __attribute__((ext_vector_type(8)));
typedef short s16x4 __attribute__((ext_vector_type(4)));
typedef float f32x2 __attribute__((ext_vector_type(2)));
typedef float f32x4 __attribute__((ext_vector_type(4)));
typedef float f32x16 __attribute__((ext_vector_type(16)));
typedef unsigned u32x2 __attribute__((ext_vector_type(2)));
typedef unsigned u32x4 __attribute__((ext_vector_type(4)));
typedef __bf16 hbf2 __attribute__((ext_vector_type(2)));

constexpr int NB = 4, SEQ = 4096, NTOK = NB * SEQ, DM = 1024, DEPTH = 2, MEMLEN = 256;
constexpr int NTHREADS = 512, NWAVES = 8;
constexpr int LDS_BYTES = 147456;
constexpr int LDS_MISC = 133120;
constexpr int IN_WIDTH = 6948;
constexpr int PROJ_LD = 2560;
constexpr int PC_AQ = 0, PC_AK = 256, PC_BQ = 512, PC_BF = 768, PC_BI = 1024, PC_BG = 1280, PC_CU = 1536, PC_CV = 1792,
              PC_DQ = 2048, PC_DK = 2304, PC_DIQ = 2368, PC_DIK = 2496, PC_DIW = 2528;
constexpr int MOE_CAP = 16384;

constexpr size_t AL(size_t x) { return (x + 255) & ~(size_t)255; }
constexpr size_t WS_CTL = 0, CTL_BYTES = 65536;
constexpr size_t W_IN = AL(WS_CTL + CTL_BYTES);
constexpr size_t W_V = W_IN + (size_t)2560 * 1024 * 2;
constexpr size_t W_G = W_V + (size_t)512 * 1024 * 2;
constexpr size_t W_BR = W_G + (size_t)4096 * 1024 * 2;
constexpr size_t W_OUT = W_BR + (size_t)4 * 1024 * 256 * 2;
constexpr size_t W_Q = W_OUT + (size_t)1024 * 1024 * 2;
constexpr size_t W_O = W_Q + (size_t)256 * 1024 * 2;
constexpr size_t W_GU = W_O + (size_t)1024 * 256 * 2;
constexpr size_t W_D = W_GU + (size_t)32 * 512 * 1024 * 2;
constexpr size_t W_SGU = W_D + (size_t)32 * 1024 * 256 * 2;
constexpr size_t W_RT = W_SGU + (size_t)4 * 128 * 128 * 2;
constexpr size_t W_RH = W_RT + (size_t)36 * 1024 * 4;
constexpr size_t W_KV = W_RH + (size_t)2 * 64 * 1024 * 2;
constexpr size_t WS_H = W_KV + (size_t)DEPTH * 512 * 1024 * 2;
constexpr size_t WS_R1 = WS_H + (size_t)NTOK * 1024 * 2;
constexpr size_t R1_BYTES = (size_t)NTOK * 4096 * 2;
constexpr size_t WS_Y = WS_R1 + R1_BYTES;
constexpr size_t WS_HS = WS_Y + (size_t)NTOK * 1024 * 2;
constexpr size_t WS_HD = WS_HS + (size_t)NB * 64 * 4 * 4096 * 4;
constexpr size_t WS_THETA = WS_HD + (size_t)NB * 64 * 256 * 4;
constexpr size_t WS_MEMN = WS_THETA + (size_t)NTOK * 8;
constexpr size_t WS_MK = WS_MEMN + (size_t)DEPTH * 1024 * 1024 * 2;
constexpr size_t WS_MVT = WS_MK + (size_t)DEPTH * 1024 * 256 * 2;
constexpr size_t WS_TOKE = WS_MVT + (size_t)DEPTH * 256 * 1024 * 2;
constexpr size_t WS_TOKW = WS_TOKE + (size_t)NTOK * 2 * 4;
constexpr size_t WS_RANK = WS_TOKW + (size_t)NTOK * 2 * 4;
constexpr size_t WS_ROWTOK = WS_RANK + (size_t)NTOK * 2 * 4;
constexpr size_t WS_MASK = WS_ROWTOK + (size_t)32 * MOE_CAP * 4;
constexpr size_t WS_RSS = WS_MASK + (size_t)NB * 128 * 128 * 64 * 2;
constexpr size_t WS_DUMMY_BASE = WS_RSS + (size_t)NTOK * 16 * 4;
constexpr size_t WS_DUMMY_OLD = WS_MASK + (size_t)NB * 128 * 128 * 64 * 2;
constexpr size_t WS_DUMMY = WS_DUMMY_BASE;
constexpr size_t WS_END = WS_DUMMY + (size_t)32 * MOE_CAP * 4;
constexpr size_t R1_PROJ = 0, R1_VT = (size_t)NTOK * PROJ_LD * 2;
constexpr size_t R1_GS = 0, R1_PS = (size_t)256 * 65536 * 2, R1_MG = 2 * R1_PS;
constexpr size_t R1_MQ = 0, R1_MO = (size_t)NTOK * 256 * 2, R1_HID = 2 * R1_MO, R1_YB = R1_HID + (size_t)40960 * 256 * 2;
constexpr size_t R1_HIDS = R1_YB + (size_t)NTOK * 2 * 1024 * 2;
static_assert(R1_HIDS + (size_t)32 * 64 * 256 * 2 <= R1_BYTES, "R1 map");
static_assert(R1_YB + (size_t)NTOK * 2 * 1024 * 2 <= R1_BYTES, "R1 map");
static_assert(R1_VT + (size_t)512 * NTOK * 2 <= R1_BYTES, "R1 map");
constexpr int CW_BAR = 0;
constexpr int CW_KMAX = 4032;
constexpr int CW_CNT = 4096;

DI bf16_t f2bf(float f) { __bf16 b = (__bf16)f; return __builtin_bit_cast(bf16_t, b); }
DI float bf2f(bf16_t b) { return __uint_as_float(((unsigned)b) << 16); }
DI unsigned pk2(float a, float b) { f32x2 v = {a, b}; hbf2 r = __builtin_convertvector(v, hbf2); return __builtin_bit_cast(unsigned, r); }
DI float bflo(unsigned w) { return __uint_as_float(w << 16); }
DI float bfhi(unsigned w) { return __uint_as_float(w & 0xffff0000u); }
DI float sigmoidf_(float x) { return __builtin_amdgcn_rcpf(1.0f + __builtin_amdgcn_exp2f(-1.4426950408889634f * x)); }
DI float siluf_(float x) { return x * __builtin_amdgcn_rcpf(1.0f + __builtin_amdgcn_exp2f(-1.4426950408889634f * x)); }
DI float fexp(float x) { return __builtin_amdgcn_exp2f(1.4426950408889634f * x); }
DI float frcp(float x) { return __builtin_amdgcn_rcpf(x); }
DI float flog(float x) { return 0.6931471805599453f * __builtin_amdgcn_logf(x); }
DI float gelu_tanh(float x) { const float u = 0.7978845608028654f * (x + 0.044715f * x * x * x); return x * frcp(1.0f + fexp(-2.0f * u)); }
DI float wave_sum(float v) { for (int o = 32; o > 0; o >>= 1) v += __shfl_xor(v, o); return v; }
DI float xhalf_max(float x) { const u32x2 r = __builtin_amdgcn_permlane32_swap(__float_as_uint(x), __float_as_uint(x), false, false); return fmaxf(__uint_as_float(r.x), __uint_as_float(r.y)); }
DI float xhalf_sum(float x) { const u32x2 r = __builtin_amdgcn_permlane32_swap(__float_as_uint(x), __float_as_uint(x), false, false); return __uint_as_float(r.x) + __uint_as_float(r.y); }
DI f32x16 mfma32(bf16x8 a, bf16x8 b, f32x16 c) { return __builtin_amdgcn_mfma_f32_32x32x16_bf16(a, b, c, 0, 0, 0); }
DI int crow(int reg, int h) { return (reg & 3) + 8 * (reg >> 2) + 4 * h; }
DI f32x16 zero16() { f32x16 z; for (int i = 0; i < 16; ++i) z[i] = 0.f; return z; }

#define XB_TMO      128
#define XB_XCNT(j)  (256  + 64 * (j))
#define XB_XSUB(j)  (1280 + 64 * (j))
#define XB_XGEN(j)  (2304 + 64 * (j))
#define XB_TOP      3328
#define XB_TOPGEN   3392
#define XCD_BAR_WORDS 3456
#define XB_SPIN_CAP (1u << 22)

DI unsigned xb_ld(unsigned* p)              { return __hip_atomic_load(p, __ATOMIC_RELAXED, __HIP_MEMORY_SCOPE_AGENT); }
DI unsigned xb_add(unsigned* p, unsigned v) { return __hip_atomic_fetch_add(p, v, __ATOMIC_RELAXED, __HIP_MEMORY_SCOPE_AGENT); }
DI unsigned xb_xcc_id() { return (unsigned)__builtin_amdgcn_s_getreg((3 << 11) | 20) & 0xFu; }
#define XB_SPIN(cond, bar) do { unsigned _sp = 0; while (cond) { __builtin_amdgcn_s_sleep(1); \
    if ((++_sp & 255u) == 0u) { if (xb_ld(&(bar)[XB_TMO])) break; if (_sp > XB_SPIN_CAP) { atomicAdd(&(bar)[XB_TMO], 1u); break; } } } } while (0)

struct XcdBarrier { unsigned* bar; unsigned x; volatile LAS unsigned* st; };

DI XcdBarrier xcd_barrier_post(unsigned* bar, volatile LAS unsigned* st) {
    XcdBarrier b; b.bar = bar; b.x = xb_xcc_id(); b.st = st;
    if (threadIdx.x == 0) (void)xb_add(&bar[XB_XCNT(b.x)], 1u);
    return b;
}
DI void xcd_barrier_complete(unsigned* bar, unsigned x, unsigned& nloc, unsigned& nx) {
    const unsigned G = gridDim.x * gridDim.y * gridDim.z;
    unsigned sum, cnt, mine, sp = 0u;
    for (;;) {
        sum = 0u; cnt = 0u; mine = 0u;
#pragma unroll
        for (unsigned j = 0; j < 16; ++j) { const unsigned c = xb_ld(&bar[XB_XCNT(j)]); sum += c; cnt += (c > 0u) ? 1u : 0u; mine = (j == x) ? c : mine; }
        if (sum == G) break;
        __builtin_amdgcn_s_sleep(1);
        if ((++sp & 255u) == 0u) { if (xb_ld(&bar[XB_TMO])) break; if (sp > XB_SPIN_CAP) { atomicAdd(&bar[XB_TMO], 1u); break; } }
    }
    nloc = mine > 0u ? mine : 1u; nx = cnt > 0u ? cnt : 1u;
}
DI void xcd_barrier(const XcdBarrier& b) {
    asm volatile("s_waitcnt vmcnt(0)" ::: "memory");
    __syncthreads();
    if (threadIdx.x == 0) {
        unsigned* bar = b.bar;
        __builtin_amdgcn_s_waitcnt(0);
        unsigned nloc = b.st[0], nx = b.st[1];
        if (nloc == 0u) { xcd_barrier_complete(bar, b.x, nloc, nx); b.st[0] = nloc; b.st[1] = nx; }
        const unsigned old = xb_add(&bar[XB_XSUB(b.x)], 1u);
        const unsigned gen = old / nloc;
        if (old + 1u == (gen + 1u) * nloc) {
            __builtin_amdgcn_fence(__ATOMIC_RELEASE, "agent");
            asm volatile("s_waitcnt vmcnt(0)" ::: "memory");
            const unsigned og = xb_add(&bar[XB_TOP], 1u);
            const unsigned tg = og / nx;
            if (og + 1u == (tg + 1u) * nx) xb_add(&bar[XB_TOPGEN], 1u);
            else XB_SPIN(xb_ld(&bar[XB_TOPGEN]) == tg, bar);
            __builtin_amdgcn_fence(__ATOMIC_ACQUIRE, "agent");
            xb_add(&bar[XB_XGEN(b.x)], 1u);
            asm volatile("s_waitcnt vmcnt(0)" ::: "memory");
        } else {
            XB_SPIN(xb_ld(&bar[XB_XGEN(b.x)]) == gen, bar);
            __builtin_amdgcn_fence(__ATOMIC_ACQUIRE, "agent");
            asm volatile("s_waitcnt vmcnt(0)" ::: "memory");
        }
    }
    __syncthreads();
}
namespace pg8 {
constexpr int BM = 256, BK = 64, HALF = 128, HTB = HALF * BK * 2, STAGE_BYTES = 8 * HTB, NXCD = 8, WGM = 8;
DI int lds_byte(int r, int c) { const int st = (r >> 4) * 2 + (c >> 5), rr = r & 15, cc = c & 31, ob = rr * 64 + cc * 2; return st * 1024 + (ob ^ (((ob >> 9) & 1) << 5)); }
DI void stage_rc(int b, int& R, int& C) { const int st = b / 1024, sb = b % 1024, swz = sb ^ (((sb >> 9) & 1) << 5); R = (st >> 1) * 16 + swz / 64; C = (st & 1) * 32 + (swz % 64) / 2; }
DI int perm32(int rho) { const int n = rho >> 4, i = rho & 15; return 8 * (i >> 2) + 4 * n + (i & 3); }

struct Unit { const char* a; const char* b; int pm, pn, x, y, nt; };

DI void tile_map(int L, int nM, int nN, int& pm, int& pn) {
    const int nwg = nM * nN; int wgid = L;
    { const int q = nwg / NXCD, r = nwg % NXCD, xcd = wgid % NXCD, off = wgid / NXCD; wgid = (xcd < r ? xcd * (q + 1) : r * (q + 1) + (xcd - r) * q) + off; }
    const int nig = WGM * nN, gid = wgid / nig, fm = gid * WGM, gsz = (nM - fm) < WGM ? (nM - fm) : WGM;
    pm = fm + ((wgid % nig) % gsz); pn = (wgid % nig) / gsz;
}
struct DenseOrder {
    const char* A; const char* B; size_t at, bt; int nM, nN, nwg, G, c;
    DI void init(const void* A_, const void* B_, int M, int N, int lda, int ldb, int G_, int c_) {
        A = (const char*)A_; B = (const char*)B_; at = (size_t)BM * lda * 2; bt = (size_t)BM * ldb * 2; nM = M / BM; nN = N / BM; nwg = nM * nN; G = G_; c = c_; }
    DI bool next(int i, Unit& u) const {
        const long L = (long)i * G + c; if (L >= nwg) return false;
        tile_map((int)L, nM, nN, u.pm, u.pn); u.a = A + (size_t)u.pm * at; u.b = B + (size_t)u.pn * bt; u.x = 0; u.y = 0; u.nt = 0; return true; }
    DI unsigned row_off(const Unit&, int) const { return 0u; }
};

#define PG8_WAIT_V(n) asm volatile("s_waitcnt vmcnt(" #n ")" ::: "memory")
#define PG8_WAIT_L(n) asm volatile("s_waitcnt lgkmcnt(" #n ")" ::: "memory")
#define PG8_BAR __builtin_amdgcn_s_barrier()
#define PG8_SCHED __builtin_amdgcn_sched_barrier(0)

template <class Epi, class Sched, bool GATHER>
DI void gemm_phase(const int tid, LAS unsigned char* lds, const int lda, const int ldb, const int K, const Sched& S, const Epi& E) {
    const int wid = __builtin_amdgcn_readfirstlane(tid >> 6), lane = tid & 63, wr = wid >> 2, wc = wid & 3, fr = lane & 15, fq = lane >> 4;
    const int nt_phase = K / BK;
    unsigned voffA[2], voffB[2]; int RA[2], CA[2];
#pragma unroll
    for (int i = 0; i < 2; ++i) { int R, C; stage_rc(tid * 16 + i * 8192, R, C); const int Rb = (R & ~31) + perm32(R & 31);
        RA[i] = R; CA[i] = C; voffA[i] = (unsigned)(R * lda + C) * 2u; voffB[i] = (unsigned)(Rb * ldb + C) * 2u; }
    const size_t kstep = (size_t)(BK * 2);
    const size_t hstepA = (size_t)HALF * lda * 2, hstepB = (size_t)HALF * ldb * 2;
    const unsigned ldsw = (unsigned)wid * 1024u;
    const int aoff = lds_byte(wr * 64 + fr, fq * 8), boff = lds_byte(wc * 32 + fr, fq * 8);
    unsigned vc[2][2], vn[2][2];
#define PG8_SA(b, h) (((b) * 2 + (h)) * HTB)
#define PG8_SB(b, h) ((4 + (b) * 2 + (h)) * HTB)
#define PG8_GL(bufoff, gptr, vo, _i) __builtin_amdgcn_global_load_lds((const unsigned*)((const char*)(gptr) + (vo)), (LAS unsigned*)(lds + (bufoff) + ldsw + (_i) * 8192), 16, 0, 0)
#define PG8_STAGE_B(bufoff, gbase) do { PG8_GL(bufoff, gbase, voffB[0], 0); PG8_GL(bufoff, gbase, voffB[1], 1); } while (0)
#define PG8_STAGE_A(bufoff, kptr, h, isnext) do { if constexpr (GATHER) { const unsigned _o0 = (isnext) ? vn[h][0] : vc[h][0], _o1 = (isnext) ? vn[h][1] : vc[h][1]; PG8_GL(bufoff, kptr, _o0, 0); PG8_GL(bufoff, kptr, _o1, 1); } \
        else { PG8_GL(bufoff, (kptr) + (h) * hstepA, voffA[0], 0); PG8_GL(bufoff, (kptr) + (h) * hstepA, voffA[1], 1); } } while (0)
#define PG8_LDA(dst, b, h) do { _Pragma("unroll") for (int m = 0; m < 4; ++m) _Pragma("unroll") for (int k = 0; k < 2; ++k) dst[m][k] = *(const LAS bf16x8*)(lds + PG8_SA(b, h) + aoff + m * 2048 + k * 1024); } while (0)
#define PG8_LDB(dst, b, h) do { _Pragma("unroll") for (int n = 0; n < 2; ++n) _Pragma("unroll") for (int k = 0; k < 2; ++k) dst[n][k] = *(const LAS bf16x8*)(lds + PG8_SB(b, h) + boff + n * 2048 + k * 1024); } while (0)
#define PG8_MMA(ai, bj, At, Bt) do { __builtin_amdgcn_s_setprio(1); _Pragma("unroll") for (int m = 0; m < 4; ++m) _Pragma("unroll") for (int n = 0; n < 2; ++n) _Pragma("unroll") for (int k = 0; k < 2; ++k) \
        acc[ai][bj][m][n] = __builtin_amdgcn_mfma_f32_16x16x32_bf16(Bt[n][k], At[m][k], acc[ai][bj][m][n], 0, 0, 0); __builtin_amdgcn_s_setprio(0); } while (0)
    Unit cur, nxt; int ui = 0;
    if (!S.next(0, cur)) return;
    f32x4 acc[2][2][4][2];
#pragma unroll
    for (int a = 0; a < 2; ++a)
#pragma unroll
        for (int b = 0; b < 2; ++b)
#pragma unroll
            for (int m = 0; m < 4; ++m)
#pragma unroll
                for (int n = 0; n < 2; ++n) acc[a][b][m][n] = (f32x4){0.f, 0.f, 0.f, 0.f};
    bf16x8 At[4][2], B0[2][2], B1[2][2];
    const char* cA = cur.a; const char* cB = cur.b;
    if constexpr (GATHER) {
#pragma unroll
        for (int h = 0; h < 2; ++h)
#pragma unroll
            for (int i = 0; i < 2; ++i) { vc[h][i] = S.row_off(cur, RA[i] + h * HALF) + (unsigned)CA[i] * 2u; vn[h][i] = vc[h][i]; }
    }
    PG8_STAGE_B(PG8_SB(0, 0), cB); PG8_STAGE_A(PG8_SA(0, 0), cA, 0, false); PG8_STAGE_B(PG8_SB(0, 1), cB + hstepB); PG8_STAGE_A(PG8_SA(0, 1), cA, 1, false);
    if (wr == 1) PG8_BAR;
    PG8_WAIT_V(4); PG8_BAR;
    PG8_STAGE_B(PG8_SB(1, 0), cB + kstep); PG8_STAGE_A(PG8_SA(1, 0), cA + kstep, 0, false); PG8_STAGE_B(PG8_SB(1, 1), cB + hstepB + kstep);
    PG8_WAIT_V(6); PG8_BAR;
    for (;;) {
        const bool has_next = S.next(ui + 1, nxt);
        const char* nA = has_next ? nxt.a : cA; const char* nB = has_next ? nxt.b : cB;
        if constexpr (GATHER) {
            if (has_next) {
#pragma unroll
                for (int h = 0; h < 2; ++h)
#pragma unroll
                    for (int i = 0; i < 2; ++i) vn[h][i] = S.row_off(nxt, RA[i] + h * HALF) + (unsigned)CA[i] * 2u;
            }
        }
        const int nt = cur.nt ? cur.nt : nt_phase;
        for (int t = 0; t < nt; t += 2) {
            const bool last = (t == nt - 2);
            int tq = t; asm volatile("" : "+s"(tq));
            const char* a1 = cA + (size_t)(tq + 1) * kstep;
            const char* a2 = last ? nA : cA + (size_t)(tq + 2) * kstep; const char* b2 = last ? nB : cB + (size_t)(tq + 2) * kstep;
            const char* a3 = a2 + kstep; const char* b3 = b2 + kstep;
            PG8_LDB(B0, 0, 0); PG8_SCHED; PG8_LDA(At, 0, 0); PG8_STAGE_A(PG8_SA(1, 1), a1, 1, false);
            PG8_WAIT_L(8); PG8_BAR; PG8_WAIT_L(0); PG8_MMA(0, 0, At, B0); PG8_BAR; PG8_SCHED;
            PG8_LDB(B1, 0, 1); PG8_STAGE_B(PG8_SB(0, 0), b2);
            PG8_BAR; PG8_WAIT_L(0); PG8_MMA(0, 1, At, B1); PG8_BAR;
            PG8_LDA(At, 0, 1); PG8_STAGE_A(PG8_SA(0, 0), a2, 0, last);
            PG8_BAR; PG8_WAIT_L(0); PG8_MMA(1, 0, At, B0); PG8_BAR; PG8_SCHED;
            PG8_STAGE_B(PG8_SB(0, 1), b2 + hstepB);
            PG8_WAIT_V(6); PG8_BAR; PG8_MMA(1, 1, At, B1); PG8_BAR;
            PG8_LDB(B0, 1, 0); PG8_SCHED; PG8_LDA(At, 1, 0); PG8_STAGE_A(PG8_SA(0, 1), a2, 1, last);
            PG8_WAIT_L(8); PG8_BAR; PG8_WAIT_L(0); PG8_MMA(0, 0, At, B0); PG8_BAR; PG8_SCHED;
            PG8_LDB(B1, 1, 1); PG8_STAGE_B(PG8_SB(1, 0), b3);
            PG8_BAR; PG8_WAIT_L(0); PG8_MMA(0, 1, At, B1); PG8_BAR;
            PG8_LDA(At, 1, 1); PG8_STAGE_A(PG8_SA(1, 0), a3, 0, last);
            PG8_BAR; PG8_WAIT_L(0); PG8_MMA(1, 0, At, B0); PG8_BAR; PG8_SCHED;
            PG8_STAGE_B(PG8_SB(1, 1), b3 + hstepB);
            PG8_WAIT_V(6); PG8_BAR; PG8_MMA(1, 1, At, B1); PG8_BAR;
        }
        { int ln2 = lane; asm volatile("" : "+v"(ln2)); E(acc, cur, wr, wc, ln2 & 15, ln2 >> 4); }
        if (!has_next) break;
#pragma unroll
        for (int a = 0; a < 2; ++a)
#pragma unroll
            for (int b = 0; b < 2; ++b)
#pragma unroll
                for (int m = 0; m < 4; ++m)
#pragma unroll
                    for (int n = 0; n < 2; ++n) acc[a][b][m][n] = (f32x4){0.f, 0.f, 0.f, 0.f};
        cur = nxt; cA = nA; cB = nB; ++ui;
        if constexpr (GATHER) {
#pragma unroll
            for (int h = 0; h < 2; ++h)
#pragma unroll
                for (int i = 0; i < 2; ++i) vc[h][i] = vn[h][i];
        }
    }
    PG8_WAIT_V(0);
    if (wr == 0) PG8_BAR;
    PG8_BAR;
#undef PG8_SA
#undef PG8_SB
#undef PG8_GL
#undef PG8_STAGE_A
#undef PG8_STAGE_B
#undef PG8_LDA
#undef PG8_LDB
#undef PG8_MMA
}
}
struct Params {
    const float* x; const float* mem; const int* positions;
    const float* norm_mix; const float* w_in; const float* diff_lambda; const float* hgrn_lb; const float* spatial_w; const float* spatial_b;
    const float* w_branch; const float* w_out; const float* norm_mem_q; const float* norm_mem_kv; const float* w_mem_q; const float* w_mem_kv; const float* w_mem_o;
    const float* norm_ffn; const float* w_rg; const float* b_rg; const float* w_re; const float* b_re; const float* w_eg; const float* w_eu; const float* w_ed; const float* norm_final;
    float* out; unsigned char* ws; int ph_lo, ph_hi;
};
struct Ctx {
    LAS unsigned char* lds; int tid, lane, wave, G, bid;
};
DI Ctx relaunder(const Ctx& C) { Ctx D = C; int w = C.wave, g = C.G, bi = C.bid; asm volatile("" : "+s"(w), "+s"(g), "+s"(bi)); D.wave = w; D.G = g; D.bid = bi; int ln; asm volatile("v_mbcnt_lo_u32_b32 %0, -1, 0\n\tv_mbcnt_hi_u32_b32 %0, -1, %0" : "=v"(ln)); D.lane = ln; D.tid = w * 64 + ln; return D; }
template <class T> DI T* wsp(const Params& P, size_t off) { return (T*)(P.ws + off); }

struct CvtJob { const float* src; bf16_t* dst; int ld_src, ncols, K, ld_dst, nb1, nb2; long ss1, ds1, ss2, ds2; const float* kscale; };
DI void cvt_transpose(const Ctx& C, const CvtJob& J) {
    LAS float* T = (LAS float*)C.lds;
    const int tn = (J.ncols + 63) >> 6, tk = J.K >> 6, per = tn * tk, total = per * J.nb1 * J.nb2;
    for (int t = C.bid; t < total; t += C.G) {
        const int bb = t / per, r = t % per, b1 = bb / J.nb2, b2 = bb % J.nb2, in_ = r / tk, ik = r % tk;
        const float* src = J.src + (size_t)b1 * J.ss1 + (size_t)b2 * J.ss2; bf16_t* dst = J.dst + (size_t)b1 * J.ds1 + (size_t)b2 * J.ds2;
        const int n0 = in_ * 64, k0 = ik * 64;
        { const int k = C.tid >> 3, c8 = (C.tid & 7) * 8;
#pragma unroll
          for (int v = 0; v < 2; ++v) { const int n = n0 + c8 + v * 4;
              f32x4 x = (f32x4){0.f, 0.f, 0.f, 0.f};
              if (n < J.ncols) x = *(const f32x4*)(src + (size_t)(k0 + k) * J.ld_src + n);
              if (J.kscale) { const float g = J.kscale[k0 + k]; x[0] *= g; x[1] *= g; x[2] *= g; x[3] *= g; }
#pragma unroll
              for (int j = 0; j < 4; ++j) T[(c8 + v * 4 + j) * 65 + k] = x[j]; } }
        __syncthreads();
        { const int n = C.tid >> 3, k8 = (C.tid & 7) * 8;
          if (n0 + n < J.ncols) { u32x4 w;
#pragma unroll
              for (int j = 0; j < 4; ++j) w[j] = pk2(T[n * 65 + k8 + 2 * j], T[n * 65 + k8 + 2 * j + 1]);
              *(u32x4*)(dst + (size_t)(n0 + n) * J.ld_dst + k0 + k8) = w; } }
        __syncthreads();
    }
}
DI CvtJob mkjob(const float* src, bf16_t* dst, int ld_src, int ncols, int K, int ld_dst, int nb1 = 1, long ss1 = 0, long ds1 = 0, int nb2 = 1, long ss2 = 0, long ds2 = 0) {
    CvtJob J; J.src = src; J.dst = dst; J.ld_src = ld_src; J.ncols = ncols; J.K = K; J.ld_dst = ld_dst; J.nb1 = nb1; J.nb2 = nb2; J.ss1 = ss1; J.ds1 = ds1; J.ss2 = ss2; J.ds2 = ds2; J.kscale = nullptr; return J; }

DI void phase_convert_layer(const Ctx& C, const Params& P, int l) {
    const float* win = P.w_in + (size_t)l * 1024 * IN_WIDTH;
    bf16_t* WIN = wsp<bf16_t>(P, W_IN); bf16_t* WV = wsp<bf16_t>(P, W_V);
    cvt_transpose(C, mkjob(win + 0, WIN, IN_WIDTH, 512, 1024, 1024));
    cvt_transpose(C, mkjob(win + 768, WIN + (size_t)512 * 1024, IN_WIDTH, 1856, 1024, 1024));
    cvt_transpose(C, mkjob(win + 2688, WIN + (size_t)2368 * 1024, IN_WIDTH, 164, 1024, 1024));
    cvt_transpose(C, mkjob(win + 512, WV, IN_WIDTH, 256, 1024, 1024));
    cvt_transpose(C, mkjob(win + 2624, WV + (size_t)256 * 1024, IN_WIDTH, 64, 1024, 1024));
    cvt_transpose(C, mkjob(win + 2852, wsp<bf16_t>(P, W_G), IN_WIDTH, 4096, 1024, 1024));
    cvt_transpose(C, mkjob(P.w_branch + (size_t)l * 4 * 256 * 1024, wsp<bf16_t>(P, W_BR), 1024, 1024, 256, 1024, 4, 256 * 1024, 256));
    cvt_transpose(C, mkjob(P.w_out + (size_t)l * 1024 * 1024, wsp<bf16_t>(P, W_OUT), 1024, 1024, 1024, 1024));
    { CvtJob J = mkjob(P.w_mem_q + (size_t)l * 1024 * 256, wsp<bf16_t>(P, W_Q), 256, 256, 1024, 1024); J.kscale = P.norm_mem_q + l * DM; cvt_transpose(C, J); }
    cvt_transpose(C, mkjob(P.w_mem_o + (size_t)l * 256 * 1024, wsp<bf16_t>(P, W_O), 1024, 1024, 256, 256));
    cvt_transpose(C, mkjob(P.w_eg + (size_t)l * 32 * 1024 * 256, wsp<bf16_t>(P, W_GU), 256, 128, 1024, 1024, 32, 1024 * 256, 512 * 1024, 2, 128, 256 * 1024));
    cvt_transpose(C, mkjob(P.w_eu + (size_t)l * 32 * 1024 * 256, wsp<bf16_t>(P, W_GU) + (size_t)128 * 1024, 256, 128, 1024, 1024, 32, 1024 * 256, 512 * 1024, 2, 128, 256 * 1024));
    cvt_transpose(C, mkjob(P.w_ed + (size_t)l * 32 * 256 * 1024, wsp<bf16_t>(P, W_D), 1024, 1024, 256, 256, 32, 256 * 1024, 1024 * 256));
    { bf16_t* z0 = WIN + (size_t)2532 * 1024; for (int i = C.bid * NTHREADS + C.tid; i < 28 * 1024; i += C.G * NTHREADS) z0[i] = 0;
      bf16_t* z1 = WV + (size_t)320 * 1024; for (int i = C.bid * NTHREADS + C.tid; i < 192 * 1024; i += C.G * NTHREADS) z1[i] = 0; }
    { bf16_t* rh = wsp<bf16_t>(P, W_RH); const float* wre = P.w_re + (size_t)l * 1024 * 32; const float* wrg = P.w_rg + (size_t)l * 1024 * 4;
      for (int i = C.bid * NTHREADS + C.tid; i < 64 * 1024; i += C.G * NTHREADS) { const int j = i >> 10, k = i & 1023;
          const float w = (j < 32) ? wre[k * 32 + j] : (j < 36 ? wrg[k * 4 + (j - 32)] : 0.f);
          const bf16_t hi = f2bf(w); rh[i] = hi; rh[64 * 1024 + i] = f2bf(w - bf2f(hi)); } }
    { const float* sw = P.spatial_w + (size_t)l * 4 * 128 * 128; bf16_t* d = wsp<bf16_t>(P, W_SGU);
      for (int i = C.bid * NTHREADS + C.tid; i < 4 * 128 * 128; i += C.G * NTHREADS) { const int s = i & 127, t = (i >> 7) & 127; d[i] = (s <= t) ? f2bf(sw[i]) : (bf16_t)0; } }
}

DI void phase_prologue(const Ctx& C, const Params& P) {
    for (int r = C.bid * NWAVES + C.wave; r < NB * MEMLEN; r += C.G * NWAVES) {
        const float* src = P.mem + (size_t)r * DM; f32x4 v[4]; float ss = 0.f;
#pragma unroll
        for (int j = 0; j < 4; ++j) { v[j] = *(const f32x4*)(src + j * 256 + C.lane * 4); ss += v[j][0] * v[j][0] + v[j][1] * v[j][1] + v[j][2] * v[j][2] + v[j][3] * v[j][3]; }
        ss = wave_sum(ss); const float rs = 1.0f / sqrtf(ss * (1.0f / DM) + 1e-6f);
        for (int l = 0; l < DEPTH; ++l) { bf16_t* dst = wsp<bf16_t>(P, WS_MEMN) + ((size_t)l * 1024 + r) * DM;
#pragma unroll
            for (int j = 0; j < 4; ++j) { const f32x4 g = *(const f32x4*)(P.norm_mem_kv + l * DM + j * 256 + C.lane * 4);
                u32x2 w; w.x = pk2(v[j][0] * rs * g[0], v[j][1] * rs * g[1]); w.y = pk2(v[j][2] * rs * g[2], v[j][3] * rs * g[3]);
                *(u32x2*)(dst + j * 256 + C.lane * 4) = w; } }
    }
    for (int l = 0; l < DEPTH; ++l)
        cvt_transpose(C, mkjob(P.w_mem_kv + (size_t)l * 1024 * 512, wsp<bf16_t>(P, W_KV) + (size_t)l * 512 * 1024, 512, 512, 1024, 1024));
}

template <bool ADD_YB, bool WRITE_H, bool FINAL, bool FROM_X = false>
DI void phase_rownorm(const Ctx& C, const Params& P, const float* gain) {
    float* XR = P.out; bf16_t* H = wsp<bf16_t>(P, WS_H); const bf16_t* YB = (const bf16_t*)(P.ws + WS_R1 + R1_YB);
    const int stride = C.G * NWAVES; int t = C.bid * NWAVES + C.wave;
    f32x4 v[4], vn[4]; u32x2 ya[4], yb[4], yan[4], ybn[4];
#define RN_LOAD(dst, da, db, tt) do { const float* src_ = (FROM_X ? P.x : (const float*)XR) + (size_t)(tt) * DM; _Pragma("unroll") for (int j = 0; j < 4; ++j) { const int c = j * 256 + C.lane * 4; dst[j] = *(const f32x4*)(src_ + c); \
        if constexpr (ADD_YB) { da[j] = *(const u32x2*)(YB + (size_t)(2 * (tt)) * DM + c); db[j] = *(const u32x2*)(YB + (size_t)(2 * (tt) + 1) * DM + c); } } } while (0)
    if (t < NTOK) RN_LOAD(v, ya, yb, t);
    for (; t < NTOK; t += stride) {
        const int tn = (t + stride < NTOK) ? t + stride : t;
        RN_LOAD(vn, yan, ybn, tn);
        float* xr = XR + (size_t)t * DM; float ss = 0.f;
#pragma unroll
        for (int j = 0; j < 4; ++j) { const int c = j * 256 + C.lane * 4;
            if constexpr (ADD_YB) { const u32x2 a = ya[j], b = yb[j];
                v[j][0] += bflo(a.x) + bflo(b.x); v[j][1] += bfhi(a.x) + bfhi(b.x); v[j][2] += bflo(a.y) + bflo(b.y); v[j][3] += bfhi(a.y) + bfhi(b.y); }
            if constexpr ((ADD_YB && !FINAL) || FROM_X) *(f32x4*)(xr + c) = v[j];
            ss += v[j][0] * v[j][0] + v[j][1] * v[j][1] + v[j][2] * v[j][2] + v[j][3] * v[j][3]; }
        ss = wave_sum(ss); const float rs = 1.0f / sqrtf(ss * (1.0f / DM) + 1e-6f);
#pragma unroll
        for (int j = 0; j < 4; ++j) { const int c = j * 256 + C.lane * 4; const f32x4 g = *(const f32x4*)(gain + c);
            const f32x4 o = (f32x4){v[j][0] * rs * g[0], v[j][1] * rs * g[1], v[j][2] * rs * g[2], v[j][3] * rs * g[3]};
            if constexpr (FINAL) *(f32x4*)(xr + c) = o;
            if constexpr (WRITE_H) { u32x2 w; w.x = pk2(o[0], o[1]); w.y = pk2(o[2], o[3]); *(u32x2*)(H + (size_t)t * DM + c) = w; } }
#pragma unroll
        for (int j = 0; j < 4; ++j) { v[j] = vn[j]; if constexpr (ADD_YB) { ya[j] = yan[j]; yb[j] = ybn[j]; } }
    }
#undef RN_LOAD
}

DI void phase_rope(const Ctx& C, const Params& P, const int l, const bool dry = false) {
    bf16_t* PROJ = (bf16_t*)(P.ws + WS_R1 + R1_PROJ);
    LAS f32x2* tab = (LAS f32x2*)(C.lds) + C.wave * 64;
    float kmx[4] = {0.f, 0.f, 0.f, 0.f};
    for (int t = C.bid * NWAVES + C.wave; t < NTOK; t += C.G * NWAVES) {
        const float pos = (float)P.positions[t];
        if (C.lane < 48) { const int i = C.lane < 16 ? C.lane : C.lane - 16; const float d = C.lane < 16 ? 32.f : 64.f;
            const float inv = powf(10000.0f, -(float)i * (2.0f / d)); const float ang = pos * inv; float s, c; sincosf(ang, &s, &c); tab[C.lane] = (f32x2){c, s}; }
        __builtin_amdgcn_wave_barrier();
        asm volatile("s_waitcnt lgkmcnt(0)" ::: "memory");
        bf16_t* row = PROJ + (size_t)t * PROJ_LD;
        { const float kv = (C.lane < 32) ? bf2f(row[PC_DIK + C.lane]) : 0.f; const float k2 = wave_sum(kv * kv); const int bb = t >> 12;
#pragma unroll
          for (int q = 0; q < 4; ++q) kmx[q] = (bb == q) ? fmaxf(kmx[q], k2) : kmx[q]; }
        for (int p = C.lane; p < 496; p += 64) {
            int col, half, ti;
            if (p < 256) { col = (p >> 4) * 32 + (p & 15); half = 16; ti = p & 15; }
            else if (p < 416) { const int q = p - 256; col = PC_DQ + (q >> 5) * 64 + (q & 31); half = 32; ti = 16 + (q & 31); }
            else { const int q = p - 416; col = PC_DIQ + (q >> 4) * 32 + (q & 15); half = 16; ti = q & 15; }
            const f32x2 cs = tab[ti]; const float x1 = bf2f(row[col]), x2 = bf2f(row[col + half]);
            if (!dry || pos < -1.0f) { row[col] = f2bf(x1 * cs.x - x2 * cs.y); row[col + half] = f2bf(x2 * cs.x + x1 * cs.y); }
        }
        __builtin_amdgcn_wave_barrier();
    }
    { LAS unsigned* km = (LAS unsigned*)(C.lds + 8192);
      __syncthreads();
      if (C.tid < 4) km[C.tid] = 0u;
      __syncthreads();
      if (C.lane < 4) { float v = 0.f;
#pragma unroll
          for (int q = 0; q < 4; ++q) v = (C.lane == q) ? kmx[q] : v;
          __hip_atomic_fetch_max(km + C.lane, __float_as_uint(v), __ATOMIC_RELAXED, __HIP_MEMORY_SCOPE_WORKGROUP); }
      __syncthreads();
      if (C.tid < 4 && !dry) atomicMax(wsp<unsigned>(P, WS_CTL) + CW_KMAX + 8 * l + C.tid, (unsigned)km[C.tid]);
      __syncthreads(); }
}
DI void sm_step(f32x16& st, const float c, float& m, float& l, f32x16& O0, f32x16& O1, bf16x8& p0, bf16x8& p1) {
    float mx = st[0];
#pragma unroll
    for (int i = 1; i < 16; ++i) mx = fmaxf(mx, st[i]);
    mx = fmaxf(mx, __shfl_xor(mx, 32));
    if (__any(mx > m)) { const float mn = fmaxf(m, mx); const float a = __builtin_amdgcn_exp2f((m - mn) * c); l *= a;
#pragma unroll
        for (int i = 0; i < 16; ++i) { O0[i] *= a; O1[i] *= a; }
        m = mn; }
    const float mc = m * c; float rs = 0.f;
#pragma unroll
    for (int i = 0; i < 16; ++i) { const float p = __builtin_amdgcn_exp2f(fmaf(st[i], c, -mc)); st[i] = p; rs += p; }
    l += rs;
    u32x4 a, b;
    a.x = pk2(st[0], st[1]); a.y = pk2(st[2], st[3]); a.z = pk2(st[4], st[5]); a.w = pk2(st[6], st[7]);
    b.x = pk2(st[8], st[9]); b.y = pk2(st[10], st[11]); b.z = pk2(st[12], st[13]); b.w = pk2(st[14], st[15]);
    p0 = __builtin_bit_cast(bf16x8, a); p1 = __builtin_bit_cast(bf16x8, b);
}
DI void apply_mask(f32x16& st, unsigned vmask) {
#pragma unroll
    for (int i = 0; i < 16; ++i) { const unsigned sel = (unsigned)__builtin_amdgcn_sbfe((int)vmask, i, 1);
        st[i] = __uint_as_float((__float_as_uint(st[i]) & sel) | (__float_as_uint(-3.0e38f) & ~sel)); }
}
DI bf16x8 vt_frag(const bf16_t* vt_row, int k0, int s2, int h) {
    const bf16_t* p = vt_row + k0 + 16 * s2 + 4 * h; const u32x2 lo = *(const u32x2*)p, hi = *(const u32x2*)(p + 8);
    u32x4 w; w.x = lo.x; w.y = lo.y; w.z = hi.x; w.w = hi.y; return __builtin_bit_cast(bf16x8, w);
}
DI unsigned causal_mask(int r, int h) { unsigned m = 0;
#pragma unroll
    for (int i = 0; i < 16; ++i) m |= (crow(i, h) <= r) ? (1u << i) : 0u;
    return m; }
DI void causal_wave_unit(int c, int w, int& bh, int& qs) { const int pi = c * 4 + (w & 3); bh = (pi >> 6) & 15; const int j = pi & 63; qs = (w < 4) ? 127 - j : j; }

struct DiffKV { bf16x8 kf[2][2]; bf16x8 vf[2][2]; };
DI void diff_load(DiffKV& t, const bf16_t* kbase, const bf16_t* vrow0, const bf16_t* vrow1, int k0, int r, int h) {
    const bf16_t* kp = kbase + (size_t)(k0 + r) * PROJ_LD + 8 * h;
#pragma unroll
    for (int m = 0; m < 2; ++m)
#pragma unroll
        for (int s = 0; s < 2; ++s) t.kf[m][s] = *(const bf16x8*)(kp + m * 32 + 16 * s);
#pragma unroll
    for (int s2 = 0; s2 < 2; ++s2) { t.vf[0][s2] = vt_frag(vrow0, k0, s2, h); t.vf[1][s2] = vt_frag(vrow1, k0, s2, h); }
}
DI void diff_step(const DiffKV& t, const bf16x8 (&qf)[2][2], bool diag, unsigned dmask, const float c, float (&mm)[2], float (&ll)[2], f32x16 (&O)[2][2]) {
#pragma unroll
    for (int m = 0; m < 2; ++m) {
        f32x16 st = mfma32(t.kf[m][0], qf[m][0], zero16()); st = mfma32(t.kf[m][1], qf[m][1], st);
        if (diag) apply_mask(st, dmask);
        bf16x8 p0, p1; sm_step(st, c, mm[m], ll[m], O[m][0], O[m][1], p0, p1);
        O[m][0] = mfma32(t.vf[0][0], p0, O[m][0]); O[m][0] = mfma32(t.vf[0][1], p1, O[m][0]);
        O[m][1] = mfma32(t.vf[1][0], p0, O[m][1]); O[m][1] = mfma32(t.vf[1][1], p1, O[m][1]);
    }
}
DI void diff_attn_wave(const Ctx& C, const Params& P, int l) {
    const bf16_t* PROJ = (const bf16_t*)(P.ws + WS_R1 + R1_PROJ); const bf16_t* VT = (const bf16_t*)(P.ws + WS_R1 + R1_VT); bf16_t* Y = wsp<bf16_t>(P, WS_Y);
    int bh, qs; causal_wave_unit(C.bid, C.wave, bh, qs);
    const int b = bh >> 2, hd = bh & 3, r = C.lane & 31, h = C.lane >> 5, tokb = b * SEQ, q0 = qs * 32, t = q0 + r;
    const float* lv = P.diff_lambda + l * 128;
    const float d1 = wave_sum(C.lane < 32 ? lv[C.lane] * lv[32 + C.lane] : 0.f), d2 = wave_sum(C.lane < 32 ? lv[64 + C.lane] * lv[96 + C.lane] : 0.f);
    const float lam_init = 0.8f - 0.6f * expf(-0.3f * (float)l), lam = expf(d1) - expf(d2) + lam_init;
    bf16x8 qf[2][2];
#pragma unroll
    for (int m = 0; m < 2; ++m)
#pragma unroll
        for (int s = 0; s < 2; ++s) qf[m][s] = *(const bf16x8*)(PROJ + (size_t)(tokb + t) * PROJ_LD + PC_AQ + hd * 64 + m * 32 + 16 * s + 8 * h);
    f32x16 O[2][2]; float mm[2] = {-1e30f, -1e30f}, ll[2] = {0.f, 0.f};
#pragma unroll
    for (int m = 0; m < 2; ++m) { O[m][0] = zero16(); O[m][1] = zero16(); }
    const float c = 0.17677669529663687f * 1.4426950408889634f;
    const int nkt = qs + 1; const unsigned dmask = causal_mask(r, h);
    const bf16_t* kbase = PROJ + (size_t)tokb * PROJ_LD + PC_AK + hd * 64;
    const bf16_t* vrow0 = VT + (size_t)(hd * 64 + r) * NTOK + tokb; const bf16_t* vrow1 = vrow0 + (size_t)32 * NTOK;
    DiffKV ta, tb; diff_load(ta, kbase, vrow0, vrow1, 0, r, h);
    for (int kt = 0; kt < nkt; kt += 2) {
        if (kt + 1 < nkt) diff_load(tb, kbase, vrow0, vrow1, (kt + 1) * 32, r, h);
        diff_step(ta, qf, kt == nkt - 1, dmask, c, mm, ll, O);
        if (kt + 1 < nkt) { if (kt + 2 < nkt) diff_load(ta, kbase, vrow0, vrow1, (kt + 2) * 32, r, h);
            diff_step(tb, qf, kt + 1 == nkt - 1, dmask, c, mm, ll, O); }
    }
    ll[0] += __shfl_xor(ll[0], 32); ll[1] += __shfl_xor(ll[1], 32);
    const float i0 = 1.0f / ll[0], i1 = lam / ll[1]; float ss = 0.f;
#pragma unroll
    for (int et = 0; et < 2; ++et)
#pragma unroll
        for (int i = 0; i < 16; ++i) { const float o = O[0][et][i] * i0 - O[1][et][i] * i1; O[0][et][i] = o; ss += o * o; }
    ss += __shfl_xor(ss, 32);
    const float rn = (1.0f - lam_init) / sqrtf(ss * (1.0f / 64.0f) + 1e-6f);
    bf16_t* yrow = Y + (size_t)(tokb + t) * DM + hd * 64;
#pragma unroll
    for (int et = 0; et < 2; ++et)
#pragma unroll
        for (int g = 0; g < 4; ++g) { u32x2 w; w.x = pk2(O[0][et][4 * g] * rn, O[0][et][4 * g + 1] * rn); w.y = pk2(O[0][et][4 * g + 2] * rn, O[0][et][4 * g + 3] * rn);
            *(u32x2*)(yrow + et * 32 + 8 * g + 4 * h) = w; }
}

struct KV64 { bf16x8 kf[4]; bf16x8 vf[2][2]; };
DI void kv64_load(KV64& t, const bf16_t* kbase, int kld, const bf16_t* vrow0, const bf16_t* vrow1, int k0, int r, int h) {
    const bf16_t* kp = kbase + (size_t)(k0 + r) * kld + 8 * h;
#pragma unroll
    for (int s = 0; s < 4; ++s) t.kf[s] = *(const bf16x8*)(kp + 16 * s);
#pragma unroll
    for (int s2 = 0; s2 < 2; ++s2) { t.vf[0][s2] = vt_frag(vrow0, k0, s2, h); t.vf[1][s2] = vt_frag(vrow1, k0, s2, h); }
}
DI void kv64_step(const KV64& t, const bf16x8 (&qf)[4], bool masked, unsigned vmask, const float c, float& mm, float& ll, f32x16 (&O)[2]) {
    f32x16 st = zero16();
#pragma unroll
    for (int s = 0; s < 4; ++s) st = mfma32(t.kf[s], qf[s], st);
    if (masked) apply_mask(st, vmask);
    bf16x8 p0, p1; sm_step(st, c, mm, ll, O[0], O[1], p0, p1);
    O[0] = mfma32(t.vf[0][0], p0, O[0]); O[0] = mfma32(t.vf[0][1], p1, O[0]);
    O[1] = mfma32(t.vf[1][0], p0, O[1]); O[1] = mfma32(t.vf[1][1], p1, O[1]);
}
DI void mem_attn_wave(const Ctx& C, const Params& P, int l) {
    const bf16_t* MQ = (const bf16_t*)(P.ws + WS_R1 + R1_MQ); bf16_t* MO = (bf16_t*)(P.ws + WS_R1 + R1_MO);
    const bf16_t* MK = wsp<bf16_t>(P, WS_MK) + (size_t)l * 1024 * 256; const bf16_t* MVT = wsp<bf16_t>(P, WS_MVT) + (size_t)l * 256 * 1024;
    const int r = C.lane & 31, h = C.lane >> 5;
    for (int wu = C.bid * NWAVES + C.wave; wu < 2048; wu += C.G * NWAVES) {
        const int bh = wu >> 7, qs = wu & 127, b = bh >> 2, hd = bh & 3, t = b * SEQ + qs * 32 + r;
        bf16x8 qf[4];
#pragma unroll
        for (int s = 0; s < 4; ++s) qf[s] = *(const bf16x8*)(MQ + (size_t)t * 256 + hd * 64 + 16 * s + 8 * h);
        f32x16 O[2] = {zero16(), zero16()}; float mm = -1e30f, ll = 0.f;
        const float c = 0.125f * 1.4426950408889634f;
        const bf16_t* kbase = MK + (size_t)(b * 256) * 256 + hd * 64;
        const bf16_t* vrow0 = MVT + (size_t)(hd * 64 + r) * 1024 + b * 256; const bf16_t* vrow1 = vrow0 + (size_t)32 * 1024;
        KV64 ta, tb; kv64_load(ta, kbase, 256, vrow0, vrow1, 0, r, h);
#pragma unroll 1
        for (int kt = 0; kt < 8; kt += 2) {
            kv64_load(tb, kbase, 256, vrow0, vrow1, (kt + 1) * 32, r, h);
            kv64_step(ta, qf, false, 0u, c, mm, ll, O);
            if (kt + 2 < 8) kv64_load(ta, kbase, 256, vrow0, vrow1, (kt + 2) * 32, r, h);
            kv64_step(tb, qf, false, 0u, c, mm, ll, O);
        }
        ll += __shfl_xor(ll, 32);
        const float il = 1.0f / ll; bf16_t* orow = MO + (size_t)t * 256 + hd * 64;
#pragma unroll
        for (int et = 0; et < 2; ++et)
#pragma unroll
            for (int g = 0; g < 4; ++g) { u32x2 w; w.x = pk2(O[et][4 * g] * il, O[et][4 * g + 1] * il); w.y = pk2(O[et][4 * g + 2] * il, O[et][4 * g + 3] * il);
                *(u32x2*)(orow + et * 32 + 8 * g + 4 * h) = w; }
    }
}

DI f32x16 idx_score(const bf16x8 (&ikf)[2], const bf16x8 (&iqf)[4][2], const float (&iw)[4]) {
    f32x16 a[4];
#pragma unroll
    for (int hh = 0; hh < 4; ++hh) a[hh] = mfma32(ikf[0], iqf[hh][0], zero16());
#pragma unroll
    for (int hh = 0; hh < 4; ++hh) a[hh] = mfma32(ikf[1], iqf[hh][1], a[hh]);
    f32x16 sc = zero16();
#pragma unroll
    for (int hh = 0; hh < 4; ++hh) {
#pragma unroll
        for (int i = 0; i < 16; ++i) { const int ab = (int)__float_as_uint(a[hh][i]); const float rl = __uint_as_float((unsigned)(ab > 0 ? ab : 0));
            sc[i] = fmaf(iw[hh], rl, sc[i]); } }
    return sc;
}
DI unsigned okey_of(float f) { const unsigned u = __float_as_uint(f); return u ^ ((unsigned)((int)u >> 31) | 0x80000000u); }
DI void load_idx_q(const bf16_t* PROJ, size_t tok, int h, bf16x8 (&iqf)[4][2], float (&iw)[4]) {
    const bf16_t* row = PROJ + tok * PROJ_LD;
#pragma unroll
    for (int hh = 0; hh < 4; ++hh) {
#pragma unroll
        for (int s = 0; s < 2; ++s) iqf[hh][s] = *(const bf16x8*)(row + PC_DIQ + hh * 32 + 16 * s + 8 * h);
        iw[hh] = bf2f(row[PC_DIW + hh]) * 0.08838834764831845f; }
}

template <int PASS> DI void d1_digit(unsigned ok, unsigned sinv, unsigned mv, unsigned mb, bool& match, unsigned& dg) {
    if constexpr (PASS == 0) { match = true; dg = ok >> 21; }
    else if constexpr (PASS == 1) { match = (ok >> 21) == mv; dg = (ok >> 10) & 2047u; }
    else if constexpr (PASS == 2) { match = (ok >> 10) == mv; dg = ((ok & 1023u) << 1) | (sinv >> 11); }
    else { match = (ok == mv) && ((sinv >> 11) == mb); dg = sinv & 2047u; }
}
constexpr int D1_HSTRIDE = 1025;
DI unsigned lin_bin(float sc, float lin_a, float lin_b) { return (unsigned)__builtin_amdgcn_fmed3f(fmaf(sc, lin_a, lin_b), 0.f, 2047.f); }
template <int PASS> DI void d1_pass(const Ctx& C, const bf16_t* PROJ, int tokb, int q0, int nkt, const bf16x8 (&iqf)[4][2], const float (&iw)[4], LAS unsigned* hist, volatile LAS unsigned* QS, const float lin_a = 0.f, const float lin_b = 0.f) {
    const int r = C.lane & 31, h = C.lane >> 5;
    const unsigned mv = QS[r * 4 + 0], mb = QS[r * 4 + 1];
    LAS unsigned* hrow = hist + r * D1_HSTRIDE;
    const bf16_t* kp0 = PROJ + (size_t)(tokb + r) * PROJ_LD + PC_DIK + 8 * h;
    bf16x8 ikf[2], ikn[2];
    if (C.wave < nkt) { const bf16_t* kp = kp0 + (size_t)(C.wave * 32) * PROJ_LD; ikf[0] = *(const bf16x8*)kp; ikf[1] = *(const bf16x8*)(kp + 16); }
    for (int kt = C.wave; kt < nkt; kt += NWAVES) {
        const int k0 = kt * 32;
        { const int ktn = (kt + NWAVES < nkt) ? kt + NWAVES : kt;
          const bf16_t* kp = kp0 + (size_t)(ktn * 32) * PROJ_LD; ikn[0] = *(const bf16x8*)kp; ikn[1] = *(const bf16x8*)(kp + 16); }
        const f32x16 sc = idx_score(ikf, iqf, iw);
        const bool diag = (kt == nkt - 1);
        unsigned wadr[16], wval[16]; bool any_m = false;
#pragma unroll
        for (int i = 0; i < 16; ++i) { const unsigned ok = okey_of(sc[i]), sinv = 4095u - (unsigned)(k0 + crow(i, h));
            bool match; unsigned dg;
            if constexpr (PASS == 4) { match = true; dg = lin_bin(sc[i], lin_a, lin_b); } else d1_digit<PASS>(ok, sinv, mv, mb, match, dg);
            if (diag) match = match && (crow(i, h) <= r);
            wadr[i] = match ? (dg >> 1) : 1024u;
            wval[i] = match ? (1u << ((dg & 1u) * 16u)) : 0u; any_m = any_m || match; }
        if (PASS == 0 || PASS == 4 || __any(any_m)) {
#pragma unroll
            for (int i = 0; i < 16; ++i) __hip_atomic_fetch_add(hrow + wadr[i], wval[i], __ATOMIC_RELAXED, __HIP_MEMORY_SCOPE_WORKGROUP);
        }
        ikf[0] = ikn[0]; ikf[1] = ikn[1];
    }
    __syncthreads();
    for (int srep = ((PROBE_DUP & 32768) ? 0 : 1); srep < 2; ++srep)
    for (int qq = 0; qq < 4; ++qq) {
        const int q = C.wave * 4 + qq; const unsigned rk = QS[q * 4 + 2];
        unsigned lsum = 0;
#pragma unroll
        for (int j = 0; j < 16; ++j) { const unsigned wj = hist[q * D1_HSTRIDE + C.lane * 16 + j]; lsum += (wj & 0xffffu) + (wj >> 16); }
        unsigned x = lsum;
#pragma unroll
        for (int o = 1; o < 64; o <<= 1) { const unsigned y = __shfl_down(x, o); if (C.lane + o < 64) x += y; }
        const unsigned above = x - lsum;
        const bool hit = (above < rk) && (rk <= x);
        const unsigned long long bal = __ballot(hit); const int L = bal ? (__ffsll((long long)bal) - 1) : 0;
        const unsigned aboveL = __shfl(above, L);
        const unsigned bk = (C.lane < 32) ? (unsigned)((const LAS unsigned short*)hist)[q * (2 * D1_HSTRIDE) + L * 32 + C.lane] : 0u;
        unsigned y2 = bk;
#pragma unroll
        for (int o = 1; o < 32; o <<= 1) { const unsigned z = __shfl_down(y2, o); if (C.lane + o < 32) y2 += z; }
        const unsigned ab2 = aboveL + y2 - bk;
        const bool hit2 = (C.lane < 32) && (ab2 < rk) && (rk <= ab2 + bk);
        const unsigned long long bal2 = __ballot(hit2); const int K2 = bal2 ? (__ffsll((long long)bal2) - 1) : 0;
        unsigned bin = (unsigned)(L * 32 + K2), rnew = rk - __shfl(ab2, K2);
        if (C.lane == 0 && srep == 1) {
            const unsigned omv = QS[q * 4 + 0];
            if constexpr (PASS == 0 || PASS == 4) { QS[q * 4 + 0] = bin; }
            else if constexpr (PASS == 1) { QS[q * 4 + 0] = (omv << 11) | bin; }
            else if constexpr (PASS == 2) { QS[q * 4 + 0] = (omv << 10) | (bin >> 1); QS[q * 4 + 1] = bin & 1u; }
            else { QS[q * 4 + 3] = bin; }
            QS[q * 4 + 2] = rnew;
        }
    }
    __syncthreads();
    if constexpr (PASS == 1 || PASS == 2) { for (int crep = 0; crep < ((PROBE_DUP & 65536) ? 2 : 1); ++crep) { for (int i = C.tid; i < 32 * D1_HSTRIDE; i += NTHREADS) hist[i] = 0u; __syncthreads(); } }
}
DI void dsa_select_unit(const Ctx& C, const Params& P, int l, int b, int qt) {
    const bf16_t* PROJ = (const bf16_t*)(P.ws + WS_R1 + R1_PROJ); unsigned short* MASK = wsp<unsigned short>(P, WS_MASK);
    const int tokb = b * SEQ, q0 = qt * 32;
    unsigned short* mrow = MASK + ((size_t)(b * 128 + qt) * 128) * 64 + C.lane;
    if (q0 + 31 < 256) {
        for (int kt = C.wave; kt <= qt; kt += NWAVES) mrow[(size_t)kt * 64] = (unsigned short)((kt == qt) ? causal_mask(C.lane & 31, C.lane >> 5) : 0xffffu);
        return; }
    LAS unsigned* hist = (LAS unsigned*)C.lds; volatile LAS unsigned* QS = (volatile LAS unsigned*)(C.lds + 32 * D1_HSTRIDE * 4);
    for (int i = C.tid; i < 32 * D1_HSTRIDE; i += NTHREADS) hist[i] = 0u;
    if (C.tid < 32) { QS[C.tid * 4 + 0] = 0u; QS[C.tid * 4 + 1] = 0u; QS[C.tid * 4 + 2] = 256u; QS[C.tid * 4 + 3] = 0u; }
    __syncthreads();
    const int r = C.lane & 31, h = C.lane >> 5;
    bf16x8 iqf[4][2]; float iw[4]; load_idx_q(PROJ, (size_t)(tokb + q0 + r), h, iqf, iw);
    const int nkt = qt + 1;
    float lin_a, lin_b;
    { const float kmax = sqrtf(__uint_as_float(wsp<unsigned>(P, WS_CTL)[CW_KMAX + 8 * l + b]));
      float hi = 0.f, lo = 0.f;
#pragma unroll
      for (int hh = 0; hh < 4; ++hh) { float n2 = 0.f;
#pragma unroll
          for (int s2 = 0; s2 < 2; ++s2) { const u32x4 w = __builtin_bit_cast(u32x4, iqf[hh][s2]);
#pragma unroll
              for (int j = 0; j < 4; ++j) { const float x0 = bflo(w[j]), x1 = bfhi(w[j]); n2 += x0 * x0 + x1 * x1; } }
          n2 += __shfl_xor(n2, 32); const float bnd = 0.5f * kmax * fabsf(iw[hh]) * sqrtf(n2);
          if (iw[hh] > 0.f) hi += bnd; else lo -= bnd; }
      const float span = hi - lo; lin_a = span > 0.f ? 2047.0f / span : 0.f; lin_b = -lo * lin_a; }
    d1_pass<4>(C, PROJ, tokb, q0, nkt, iqf, iw, hist, QS, lin_a, lin_b);
    constexpr int CCAP = 384;
    LAS unsigned long long* CAND = (LAS unsigned long long*)C.lds;
    LAS unsigned short* LM = (LAS unsigned short*)(C.lds + 98304);
    LAS unsigned* ZBM = (LAS unsigned*)(C.lds + 114688);
    LAS unsigned* ccnt = (LAS unsigned*)(C.lds + 32 * D1_HSTRIDE * 4 + 512);
    if (C.tid < 33) ccnt[C.tid] = 0u;
    __syncthreads();
    {
        const unsigned b0 = QS[r * 4 + 0];
        const bf16_t* kp0 = PROJ + (size_t)(tokb + r) * PROJ_LD + PC_DIK + 8 * h;
        bf16x8 ikf[2], ikn[2];
        if (C.wave < nkt) { const bf16_t* kp = kp0 + (size_t)(C.wave * 32) * PROJ_LD; ikf[0] = *(const bf16x8*)kp; ikf[1] = *(const bf16x8*)(kp + 16); }
        for (int kt = C.wave; kt < nkt; kt += NWAVES) {
            const int k0 = kt * 32;
            { const int ktn = (kt + NWAVES < nkt) ? kt + NWAVES : kt;
              const bf16_t* kp = kp0 + (size_t)(ktn * 32) * PROJ_LD; ikn[0] = *(const bf16x8*)kp; ikn[1] = *(const bf16x8*)(kp + 16); }
            const f32x16 sc = idx_score(ikf, iqf, iw);
            const bool diag = (kt == nkt - 1);
            unsigned above = 0, cand = 0, zer = 0;
#pragma unroll
            for (int i = 0; i < 16; ++i) { const unsigned d0 = lin_bin(sc[i], lin_a, lin_b); const bool ok_c = !diag || (crow(i, h) <= r);
                const bool inb = ok_c && d0 == b0, isz = sc[i] == 0.0f;
                above |= (ok_c && d0 > b0) ? (1u << i) : 0u; cand |= (inb && !isz) ? (1u << i) : 0u; zer |= (inb && isz) ? (1u << i) : 0u; }
            LM[kt * 64 + C.lane] = (unsigned short)above;
            { unsigned kw = 0;
#pragma unroll
              for (int g = 0; g < 4; ++g) kw |= ((zer >> (4 * g)) & 0xfu) << (8 * g + 4 * h);
              kw |= __shfl_xor(kw, 32);
              if (h == 0) ZBM[r * 128 + kt] = kw; }
            if (__any(cand != 0u)) {
                const unsigned nc = (unsigned)__popc(cand);
                unsigned pos = nc ? __hip_atomic_fetch_add(ccnt + r, nc, __ATOMIC_RELAXED, __HIP_MEMORY_SCOPE_WORKGROUP) : 0u;
#pragma unroll
                for (int i = 0; i < 16; ++i) { const bool on = (cand >> i) & 1u;
                    if (on && pos < (unsigned)CCAP) CAND[r * CCAP + pos] = ((unsigned long long)okey_of(sc[i]) << 12) | (unsigned long long)(4095 - (k0 + crow(i, h)));
                    pos += on ? 1u : 0u; }
            }
            ikf[0] = ikn[0]; ikf[1] = ikn[1];
        }
    }
    __syncthreads();
    if (C.tid < 32 && ccnt[C.tid] > (unsigned)CCAP) ccnt[32] = 1u;
    __syncthreads();
    if (ccnt[32] == 0u || (PROBE_DUP & 16384)) {
        const unsigned long long ZK = 0x80000000ull << 12;
        for (int qq = 0; qq < 4; ++qq) {
            const int q = C.wave * 4 + qq; const unsigned n = ccnt[q]; unsigned rk = QS[q * 4 + 2];
            unsigned long long cv[6];
#pragma unroll
            for (int j = 0; j < 6; ++j) { const unsigned idx = (unsigned)C.lane + 64u * j; cv[j] = (idx < n) ? CAND[q * CCAP + idx] : 0ull; }
            unsigned z0 = (2 * C.lane < nkt) ? ZBM[q * 128 + 2 * C.lane] : 0u, z1 = (2 * C.lane + 1 < nkt) ? ZBM[q * 128 + 2 * C.lane + 1] : 0u;
            unsigned Pc = 0, Zc;
#pragma unroll
            for (int j = 0; j < 6; ++j) Pc += (unsigned)__popcll(__ballot(cv[j] >= ZK + 4096ull));
            { unsigned zc = (unsigned)(__popc(z0) + __popc(z1)); Zc = zc;
#pragma unroll
              for (int o = 32; o > 0; o >>= 1) Zc += __shfl_xor(Zc, o); }
            unsigned long long thr;
            unsigned mz = 0;
            if (rk <= Pc || rk > Pc + Zc) {
                if (rk > Pc + Zc) { mz = Zc; }
                const bool neg = rk > Pc + Zc; const unsigned rk2 = neg ? rk - Zc : rk;
                unsigned long long cur = 0ull;
                if (n <= 64u) {
                    for (int bit = 43; bit >= 0; --bit) { const unsigned long long T = cur | (1ull << bit); if ((unsigned)__popcll(__ballot(cv[0] != 0ull && cv[0] >= T)) >= rk2) cur = T; }
                } else {
                    for (int bit = 43; bit >= 0; --bit) { const unsigned long long T = cur | (1ull << bit); unsigned cnt = 0;
#pragma unroll
                        for (int j = 0; j < 6; ++j) cnt += (unsigned)__popcll(__ballot(cv[j] != 0ull && cv[j] >= T));
                        if (cnt >= rk2) cur = T; }
                }
                thr = cur;
            } else { thr = ZK + 4096ull; mz = rk - Pc; }
#pragma unroll
            for (int j = 0; j < 6; ++j) {
                if (cv[j] != 0ull && cv[j] >= thr) { const int key = 4095 - (int)(cv[j] & 4095ull), kt = key >> 5, kk = key & 31, hh = (kk >> 2) & 1, ii = (kk & 3) + 4 * (kk >> 3);
                    const int w16 = kt * 64 + q + 32 * hh;
                    __hip_atomic_fetch_or((LAS unsigned*)LM + (w16 >> 1), 1u << (16 * (w16 & 1) + ii), __ATOMIC_RELAXED, __HIP_MEMORY_SCOPE_WORKGROUP); } }
            if (mz > 0u) {
                const unsigned c0 = (unsigned)__popc(z0), c1 = (unsigned)__popc(z1); unsigned incl = c0 + c1;
#pragma unroll
                for (int o = 1; o < 64; o <<= 1) { const unsigned y = __shfl_up(incl, o); if (C.lane >= o) incl += y; }
                unsigned before = incl - (c0 + c1);
                unsigned need0 = (before >= mz) ? 0u : ((mz - before) < c0 ? (mz - before) : c0);
                while ((unsigned)__popc(z0) > need0) z0 &= ~(0x80000000u >> __clz(z0));
                before += c0;
                unsigned need1 = (before >= mz) ? 0u : ((mz - before) < c1 ? (mz - before) : c1);
                while ((unsigned)__popc(z1) > need1) z1 &= ~(0x80000000u >> __clz(z1));
#pragma unroll
                for (int tz = 0; tz < 2; ++tz) { const unsigned zw = tz ? z1 : z0; const int kt = 2 * C.lane + tz;
                    if (zw) {
#pragma unroll
                        for (int hh = 0; hh < 2; ++hh) { unsigned m16 = 0;
#pragma unroll
                            for (int g = 0; g < 4; ++g) m16 |= ((zw >> (8 * g + 4 * hh)) & 0xfu) << (4 * g);
                            const int w16 = kt * 64 + q + 32 * hh;
                            if (m16) __hip_atomic_fetch_or((LAS unsigned*)LM + (w16 >> 1), m16 << (16 * (w16 & 1)), __ATOMIC_RELAXED, __HIP_MEMORY_SCOPE_WORKGROUP); } } }
            }
        }
        __syncthreads();
        { const LAS unsigned* src = (const LAS unsigned*)LM; unsigned* dst = (unsigned*)(MASK + ((size_t)(b * 128 + qt) * 128) * 64);
          for (int i = C.tid; i < nkt * 32; i += NTHREADS) dst[i] = src[i]; }
        __syncthreads();
        return;
    }
    for (int i = C.tid; i < 32 * D1_HSTRIDE; i += NTHREADS) hist[i] = 0u;
    if (C.tid < 32) { QS[C.tid * 4 + 0] = 0u; QS[C.tid * 4 + 1] = 0u; QS[C.tid * 4 + 2] = 256u; QS[C.tid * 4 + 3] = 0u; }
    __syncthreads();
    d1_pass<0>(C, PROJ, tokb, q0, nkt, iqf, iw, hist, QS);
    for (int i = C.tid; i < 32 * D1_HSTRIDE; i += NTHREADS) hist[i] = 0u;
    __syncthreads();
    d1_pass<1>(C, PROJ, tokb, q0, nkt, iqf, iw, hist, QS);
    d1_pass<2>(C, PROJ, tokb, q0, nkt, iqf, iw, hist, QS);
    d1_pass<3>(C, PROJ, tokb, q0, nkt, iqf, iw, hist, QS);
    {
      const unsigned long long theta = ((unsigned long long)QS[r * 4 + 0] << 12) | ((unsigned long long)QS[r * 4 + 1] << 11) | QS[r * 4 + 3];
      for (int rep = 0; rep < ((PROBE_DUP & 4096) ? 2 : 1); ++rep)
      for (int kt = C.wave; kt < nkt; kt += NWAVES) {
          const int k0 = kt * 32; bf16x8 ikf[2];
          const bf16_t* kp = PROJ + (size_t)(tokb + k0 + r) * PROJ_LD + PC_DIK + 8 * h;
          ikf[0] = *(const bf16x8*)kp; ikf[1] = *(const bf16x8*)(kp + 16);
          const f32x16 sc = idx_score(ikf, iqf, iw);
          unsigned vmask = 0;
#pragma unroll
          for (int i = 0; i < 16; ++i) { const int key = k0 + crow(i, h); const unsigned long long comp = ((unsigned long long)okey_of(sc[i]) << 12) | (unsigned long long)(4095 - key);
              vmask |= (key <= q0 + r && comp >= theta) ? (1u << i) : 0u; }
          mrow[(size_t)kt * 64] = (unsigned short)vmask; } }
    __syncthreads();
}

DI void dsa_attn_wave(const Ctx& C, const Params& P) {
    const bf16_t* PROJ = (const bf16_t*)(P.ws + WS_R1 + R1_PROJ); const bf16_t* VT = (const bf16_t*)(P.ws + WS_R1 + R1_VT); bf16_t* Y = wsp<bf16_t>(P, WS_Y);
    const unsigned short* MASK = wsp<unsigned short>(P, WS_MASK);
    int bh, qs; causal_wave_unit(C.bid, C.wave, bh, qs);
    const int b = bh >> 2, hd = bh & 3, r = C.lane & 31, h = C.lane >> 5, tokb = b * SEQ, q0 = qs * 32, t = q0 + r;
    bf16x8 qf[4];
#pragma unroll
    for (int s = 0; s < 4; ++s) qf[s] = *(const bf16x8*)(PROJ + (size_t)(tokb + t) * PROJ_LD + PC_DQ + hd * 64 + 16 * s + 8 * h);
    f32x16 O[2] = {zero16(), zero16()}; float mm = -1e30f, ll = 0.f;
    const float c = 0.125f * 1.4426950408889634f;
    const int nkt = qs + 1;
    const bf16_t* kbase = PROJ + (size_t)tokb * PROJ_LD + PC_DK;
    const bf16_t* vrow0 = VT + (size_t)(256 + r) * NTOK + tokb; const bf16_t* vrow1 = vrow0 + (size_t)32 * NTOK;
    const unsigned short* mrow = MASK + ((size_t)(b * 128 + qs) * 128) * 64 + C.lane;
    KV64 ta, tb; unsigned ma, mb;
    kv64_load(ta, kbase, PROJ_LD, vrow0, vrow1, 0, r, h); ma = mrow[0];
    for (int kt = 0; kt < nkt; kt += 2) {
        if (kt + 1 < nkt) { kv64_load(tb, kbase, PROJ_LD, vrow0, vrow1, (kt + 1) * 32, r, h); mb = mrow[(size_t)(kt + 1) * 64]; }
        kv64_step(ta, qf, true, ma, c, mm, ll, O);
        if (kt + 1 < nkt) { if (kt + 2 < nkt) { kv64_load(ta, kbase, PROJ_LD, vrow0, vrow1, (kt + 2) * 32, r, h); ma = mrow[(size_t)(kt + 2) * 64]; }
            kv64_step(tb, qf, true, mb, c, mm, ll, O); }
    }
    ll += __shfl_xor(ll, 32);
    const float il = 1.0f / ll; bf16_t* yrow = Y + (size_t)(tokb + t) * DM + 768 + hd * 64;
#pragma unroll
    for (int et = 0; et < 2; ++et)
#pragma unroll
        for (int g = 0; g < 4; ++g) { u32x2 w; w.x = pk2(O[et][4 * g] * il, O[et][4 * g + 1] * il); w.y = pk2(O[et][4 * g + 2] * il, O[et][4 * g + 3] * il);
            *(u32x2*)(yrow + et * 32 + 8 * g + 4 * h) = w; }
}

constexpr int CA_KB = 64 * 144, CA_VB = 64 * 136, CA_BUF = CA_KB + CA_VB;
template <bool DIFF>
DI void causal_attn_block(const Ctx& C, const Params& P, int l) {
    const bf16_t* PROJ = (const bf16_t*)(P.ws + WS_R1 + R1_PROJ); const bf16_t* VT = (const bf16_t*)(P.ws + WS_R1 + R1_VT); bf16_t* Y = wsp<bf16_t>(P, WS_Y);
    const unsigned short* MASK = wsp<unsigned short>(P, WS_MASK);
    const int bh = (C.bid >> 4) & 15, g = C.bid & 15, j0 = 4 * g, b = bh >> 2, hd = bh & 3, tokb = b * SEQ;
#if (PROBE_DUP & 262144)
    const int qs = ((C.wave & 1) == 0) ? 127 - (j0 + (C.wave >> 1)) : j0 + (C.wave >> 1);
#else
    const int qs = (C.wave < 4) ? 127 - (j0 + C.wave) : j0 + (C.wave - 4);
#endif
    const int r = C.lane & 31, h = C.lane >> 5, q0 = qs * 32, t = q0 + r;
    const int nsub = qs + 1, NT = (128 - j0 + 1) >> 1;
    const int kcol = DIFF ? PC_AK + hd * 64 : PC_DK, vrb = DIFF ? hd * 64 : 256;
    const int srow = C.tid >> 3, sch = C.tid & 7;
    const bf16_t* kg = PROJ + (size_t)(tokb + srow) * PROJ_LD + kcol + sch * 8;
    const bf16_t* vg = VT + (size_t)(vrb + srow) * NTOK + tokb + sch * 8;
    LAS unsigned char* kdst = C.lds + srow * 144 + sch * 16; LAS unsigned char* vdst = C.lds + CA_KB + srow * 136 + sch * 16;
    bf16x8 qfd[2][2], qf4[4];
    if constexpr (DIFF) {
#pragma unroll
        for (int m = 0; m < 2; ++m)
#pragma unroll
            for (int s = 0; s < 2; ++s) qfd[m][s] = *(const bf16x8*)(PROJ + (size_t)(tokb + t) * PROJ_LD + PC_AQ + hd * 64 + m * 32 + 16 * s + 8 * h);
    } else {
#pragma unroll
        for (int s = 0; s < 4; ++s) qf4[s] = *(const bf16x8*)(PROJ + (size_t)(tokb + t) * PROJ_LD + PC_DQ + hd * 64 + 16 * s + 8 * h);
    }
    f32x16 O[2][2]; float mm[2] = {-1e30f, -1e30f}, ll[2] = {0.f, 0.f};
#pragma unroll
    for (int m = 0; m < 2; ++m) { O[m][0] = zero16(); O[m][1] = zero16(); }
    const float c = (DIFF ? 0.17677669529663687f : 0.125f) * 1.4426950408889634f;
    const unsigned dmask = causal_mask(r, h);
    const unsigned short* mrow = MASK + ((size_t)(b * 128 + qs) * 128) * 64 + C.lane;
    u32x4 kreg = *(const u32x4*)kg, vreg = *(const u32x4*)vg, kr2, vr2;
    unsigned mcur[2] = {0u, 0u}, mnxt[2] = {0u, 0u}, mn2[2] = {0u, 0u};
    if constexpr (!DIFF) { mcur[0] = mrow[0]; if (1 < nsub) mcur[1] = mrow[64]; if (2 < nsub) mnxt[0] = mrow[128]; if (3 < nsub) mnxt[1] = mrow[192]; }
    *(LAS u32x4*)kdst = kreg; *(LAS u32x2*)vdst = (u32x2){vreg.x, vreg.y}; *(LAS u32x2*)(vdst + 8) = (u32x2){vreg.z, vreg.w};
    if (1 < NT) { kreg = *(const u32x4*)(kg + (size_t)64 * PROJ_LD); vreg = *(const u32x4*)(vg + 64); }
    __syncthreads();
    for (int T = 0; T < NT; ++T) {
        const int cur = T & 1;
        if (T + 2 < NT) { kr2 = *(const u32x4*)(kg + (size_t)(T + 2) * 64 * PROJ_LD); vr2 = *(const u32x4*)(vg + (T + 2) * 64);
            if constexpr (!DIFF) { if (2 * T + 4 < nsub) mn2[0] = mrow[(size_t)(2 * T + 4) * 64]; if (2 * T + 5 < nsub) mn2[1] = mrow[(size_t)(2 * T + 5) * 64]; } }
        const LAS unsigned char* KB = C.lds + cur * CA_BUF; const LAS unsigned char* VB = KB + CA_KB;
#pragma unroll
        for (int sub = 0; sub < 2; ++sub) {
            const int st = 2 * T + sub;
            if (st < nsub) {
                const LAS unsigned char* krow = KB + (sub * 32 + r) * 144 + h * 16;
                const LAS unsigned char* v0 = VB + r * 136 + (sub * 32 + 4 * h) * 2; const LAS unsigned char* v1 = v0 + 32 * 136;
                if constexpr (DIFF) {
                    DiffKV tl;
#pragma unroll
                    for (int m = 0; m < 2; ++m)
#pragma unroll
                        for (int s = 0; s < 2; ++s) tl.kf[m][s] = *(const LAS bf16x8*)(krow + m * 64 + s * 32);
#pragma unroll
                    for (int s2 = 0; s2 < 2; ++s2) {
                        { const u32x2 lo = *(const LAS u32x2*)(v0 + s2 * 32), hi = *(const LAS u32x2*)(v0 + s2 * 32 + 16); u32x4 w; w.x = lo.x; w.y = lo.y; w.z = hi.x; w.w = hi.y; tl.vf[0][s2] = __builtin_bit_cast(bf16x8, w); }
                        { const u32x2 lo = *(const LAS u32x2*)(v1 + s2 * 32), hi = *(const LAS u32x2*)(v1 + s2 * 32 + 16); u32x4 w; w.x = lo.x; w.y = lo.y; w.z = hi.x; w.w = hi.y; tl.vf[1][s2] = __builtin_bit_cast(bf16x8, w); } }
                    diff_step(tl, qfd, st == nsub - 1, dmask, c, mm, ll, O);
                } else {
                    KV64 tl; const unsigned vm = mcur[sub];
#pragma unroll
                    for (int s = 0; s < 4; ++s) tl.kf[s] = *(const LAS bf16x8*)(krow + s * 32);
#pragma unroll
                    for (int s2 = 0; s2 < 2; ++s2) {
                        { const u32x2 lo = *(const LAS u32x2*)(v0 + s2 * 32), hi = *(const LAS u32x2*)(v0 + s2 * 32 + 16); u32x4 w; w.x = lo.x; w.y = lo.y; w.z = hi.x; w.w = hi.y; tl.vf[0][s2] = __builtin_bit_cast(bf16x8, w); }
                        { const u32x2 lo = *(const LAS u32x2*)(v1 + s2 * 32), hi = *(const LAS u32x2*)(v1 + s2 * 32 + 16); u32x4 w; w.x = lo.x; w.y = lo.y; w.z = hi.x; w.w = hi.y; tl.vf[1][s2] = __builtin_bit_cast(bf16x8, w); } }
                    kv64_step(tl, qf4, true, vm, c, mm[0], ll[0], O[0]);
                }
            }
        }
        if (T + 1 < NT) { LAS unsigned char* kd = kdst + (cur ^ 1) * CA_BUF; LAS unsigned char* vd = vdst + (cur ^ 1) * CA_BUF;
            *(LAS u32x4*)kd = kreg; *(LAS u32x2*)vd = (u32x2){vreg.x, vreg.y}; *(LAS u32x2*)(vd + 8) = (u32x2){vreg.z, vreg.w}; }
        kreg = kr2; vreg = vr2; mcur[0] = mnxt[0]; mcur[1] = mnxt[1]; mnxt[0] = mn2[0]; mnxt[1] = mn2[1];
        __syncthreads();
    }
    if constexpr (DIFF) {
        const float* lv = P.diff_lambda + l * 128;
        const float d1 = wave_sum(C.lane < 32 ? lv[C.lane] * lv[32 + C.lane] : 0.f), d2 = wave_sum(C.lane < 32 ? lv[64 + C.lane] * lv[96 + C.lane] : 0.f);
        const float lam_init = 0.8f - 0.6f * expf(-0.3f * (float)l), lam = expf(d1) - expf(d2) + lam_init;
        ll[0] += __shfl_xor(ll[0], 32); ll[1] += __shfl_xor(ll[1], 32);
        const float i0 = 1.0f / ll[0], i1 = lam / ll[1]; float ss = 0.f;
#pragma unroll
        for (int et = 0; et < 2; ++et)
#pragma unroll
            for (int i = 0; i < 16; ++i) { const float o = O[0][et][i] * i0 - O[1][et][i] * i1; O[0][et][i] = o; ss += o * o; }
        ss += __shfl_xor(ss, 32);
        const float rn = (1.0f - lam_init) / sqrtf(ss * (1.0f / 64.0f) + 1e-6f);
        bf16_t* yrow = Y + (size_t)(tokb + t) * DM + hd * 64;
#pragma unroll
        for (int et = 0; et < 2; ++et)
#pragma unroll
            for (int gq = 0; gq < 4; ++gq) { u32x2 w; w.x = pk2(O[0][et][4 * gq] * rn, O[0][et][4 * gq + 1] * rn); w.y = pk2(O[0][et][4 * gq + 2] * rn, O[0][et][4 * gq + 3] * rn);
                *(u32x2*)(yrow + et * 32 + 8 * gq + 4 * h) = w; }
    } else {
        ll[0] += __shfl_xor(ll[0], 32);
        const float il = 1.0f / ll[0]; bf16_t* yrow = Y + (size_t)(tokb + t) * DM + 768 + hd * 64;
#pragma unroll
        for (int et = 0; et < 2; ++et)
#pragma unroll
            for (int gq = 0; gq < 4; ++gq) { u32x2 w; w.x = pk2(O[0][et][4 * gq] * il, O[0][et][4 * gq + 1] * il); w.y = pk2(O[0][et][4 * gq + 2] * il, O[0][et][4 * gq + 3] * il);
                *(u32x2*)(yrow + et * 32 + 8 * gq + 4 * h) = w; }
    }
    __syncthreads();
}

constexpr int CB_KB = 128 * 144, CB_VB = 64 * 264, CB_BUF = CB_KB + CB_VB;
template <bool DIFF>
DI void causal_attn_unit2(const Ctx& C, const Params& P, int l, int bh, int G) {
    const bf16_t* PROJ = (const bf16_t*)(P.ws + WS_R1 + R1_PROJ); const bf16_t* VT = (const bf16_t*)(P.ws + WS_R1 + R1_VT); bf16_t* Y = wsp<bf16_t>(P, WS_Y);
    const unsigned short* MASK = wsp<unsigned short>(P, WS_MASK);
    const int b = bh >> 2, hd = bh & 3, tokb = b * SEQ;
    const int qs = 4 * G + (C.wave & 3), par = C.wave >> 2;
    const int r = C.lane & 31, h = C.lane >> 5, q0 = qs * 32, t = q0 + r;
    const int NT = G + 1;
    const int kcol = DIFF ? PC_AK + hd * 64 : PC_DK, vrb = DIFF ? hd * 64 : 256;
    const int srow = C.tid >> 3, sch = C.tid & 7;
    const bf16_t* kg = PROJ + (size_t)(tokb + srow) * PROJ_LD + kcol + sch * 8;
    const bf16_t* vg = VT + (size_t)(vrb + srow) * NTOK + tokb + sch * 8;
    LAS unsigned char* kdst = C.lds + srow * 144 + sch * 16; LAS unsigned char* vdst = C.lds + CB_KB + srow * 264 + sch * 16;
    bf16x8 qfd[2][2], qf4[4];
    if constexpr (DIFF) {
#pragma unroll
        for (int m = 0; m < 2; ++m)
#pragma unroll
            for (int s = 0; s < 2; ++s) qfd[m][s] = *(const bf16x8*)(PROJ + (size_t)(tokb + t) * PROJ_LD + PC_AQ + hd * 64 + m * 32 + 16 * s + 8 * h);
    } else {
#pragma unroll
        for (int s = 0; s < 4; ++s) qf4[s] = *(const bf16x8*)(PROJ + (size_t)(tokb + t) * PROJ_LD + PC_DQ + hd * 64 + 16 * s + 8 * h);
    }
    f32x16 O[2][2]; float mm[2] = {-1e30f, -1e30f}, ll[2] = {0.f, 0.f};
#pragma unroll
    for (int m = 0; m < 2; ++m) { O[m][0] = zero16(); O[m][1] = zero16(); }
    const float c = (DIFF ? 0.17677669529663687f : 0.125f) * 1.4426950408889634f;
    const unsigned dmask = causal_mask(r, h);
    const unsigned short* mrow = MASK + ((size_t)(b * 128 + qs) * 128) * 64 + C.lane;
    u32x4 kr[2], vr[2];
#define CB_GLOAD(T_) do { kr[0] = *(const u32x4*)(kg + (size_t)((T_) * 128) * PROJ_LD); kr[1] = *(const u32x4*)(kg + (size_t)((T_) * 128 + 64) * PROJ_LD); \
        vr[0] = *(const u32x4*)(vg + (T_) * 128); vr[1] = *(const u32x4*)(vg + (T_) * 128 + 64); } while (0)
#define CB_LSTORE(buf_) do { LAS unsigned char* kd_ = kdst + (buf_) * CB_BUF; LAS unsigned char* vd_ = vdst + (buf_) * CB_BUF; \
        *(LAS u32x4*)kd_ = kr[0]; *(LAS u32x4*)(kd_ + 64 * 144) = kr[1]; \
        *(LAS u32x2*)vd_ = (u32x2){vr[0].x, vr[0].y}; *(LAS u32x2*)(vd_ + 8) = (u32x2){vr[0].z, vr[0].w}; \
        *(LAS u32x2*)(vd_ + 128) = (u32x2){vr[1].x, vr[1].y}; *(LAS u32x2*)(vd_ + 136) = (u32x2){vr[1].z, vr[1].w}; } while (0)
    unsigned mcur[2] = {0u, 0u}, mnxt[2] = {0u, 0u};
    if constexpr (!DIFF) { if (par <= qs) mcur[0] = mrow[(size_t)par * 64]; if (par + 2 <= qs) mcur[1] = mrow[(size_t)(par + 2) * 64]; }
    CB_GLOAD(0); CB_LSTORE(0);
    __syncthreads();
    int cur = 0;
    for (int T = 0; T < NT; ++T) {
        const int nxb = (cur == 2) ? 0 : cur + 1;
        if (T + 1 < NT) { CB_GLOAD(T + 1);
            if constexpr (!DIFF) { const int s0 = 4 * (T + 1) + par; if (s0 <= qs) mnxt[0] = mrow[(size_t)s0 * 64]; if (s0 + 2 <= qs) mnxt[1] = mrow[(size_t)(s0 + 2) * 64]; } }
        const LAS unsigned char* KB = C.lds + cur * CB_BUF; const LAS unsigned char* VB = KB + CB_KB;
#pragma unroll
        for (int k2 = 0; k2 < 2; ++k2) {
            if (k2 == 1 && par == 1) { if (T + 1 < NT) CB_LSTORE(nxb); __syncthreads(); }
            const int sub = par + 2 * k2, st = 4 * T + sub;
            if (st <= qs) {
                const LAS unsigned char* krow = KB + (sub * 32 + r) * 144 + h * 16;
                const LAS unsigned char* v0 = VB + r * 264 + (sub * 32 + 4 * h) * 2; const LAS unsigned char* v1 = v0 + 32 * 264;
                if constexpr (DIFF) {
                    DiffKV tl;
#pragma unroll
                    for (int m = 0; m < 2; ++m)
#pragma unroll
                        for (int s = 0; s < 2; ++s) tl.kf[m][s] = *(const LAS bf16x8*)(krow + m * 64 + s * 32);
#pragma unroll
                    for (int s2 = 0; s2 < 2; ++s2) {
                        { const u32x2 lo = *(const LAS u32x2*)(v0 + s2 * 32), hi = *(const LAS u32x2*)(v0 + s2 * 32 + 16); u32x4 w; w.x = lo.x; w.y = lo.y; w.z = hi.x; w.w = hi.y; tl.vf[0][s2] = __builtin_bit_cast(bf16x8, w); }
                        { const u32x2 lo = *(const LAS u32x2*)(v1 + s2 * 32), hi = *(const LAS u32x2*)(v1 + s2 * 32 + 16); u32x4 w; w.x = lo.x; w.y = lo.y; w.z = hi.x; w.w = hi.y; tl.vf[1][s2] = __builtin_bit_cast(bf16x8, w); } }
                    diff_step(tl, qfd, st == qs, dmask, c, mm, ll, O);
                } else {
                    KV64 tl; const unsigned vm = mcur[k2];
#pragma unroll
                    for (int s = 0; s < 4; ++s) tl.kf[s] = *(const LAS bf16x8*)(krow + s * 32);
#pragma unroll
                    for (int s2 = 0; s2 < 2; ++s2) {
                        { const u32x2 lo = *(const LAS u32x2*)(v0 + s2 * 32), hi = *(const LAS u32x2*)(v0 + s2 * 32 + 16); u32x4 w; w.x = lo.x; w.y = lo.y; w.z = hi.x; w.w = hi.y; tl.vf[0][s2] = __builtin_bit_cast(bf16x8, w); }
                        { const u32x2 lo = *(const LAS u32x2*)(v1 + s2 * 32), hi = *(const LAS u32x2*)(v1 + s2 * 32 + 16); u32x4 w; w.x = lo.x; w.y = lo.y; w.z = hi.x; w.w = hi.y; tl.vf[1][s2] = __builtin_bit_cast(bf16x8, w); } }
                    kv64_step(tl, qf4, true, vm, c, mm[0], ll[0], O[0]);
                }
            }
        }
        if (par == 0) { if (T + 1 < NT) CB_LSTORE(nxb); __syncthreads(); }
        mcur[0] = mnxt[0]; mcur[1] = mnxt[1]; cur = nxb;
    }
#undef CB_GLOAD
#undef CB_LSTORE
    constexpr int NM = DIFF ? 2 : 1, NV = NM * 34;
    LAS float* MA = (LAS float*)C.lds + (size_t)(C.wave & 3) * 64 * NV + C.lane;
    __syncthreads();
    if (par == 1) {
#pragma unroll
        for (int m = 0; m < NM; ++m) { MA[(m * 34 + 0) * 64] = mm[m]; MA[(m * 34 + 1) * 64] = ll[m];
#pragma unroll
            for (int et = 0; et < 2; ++et)
#pragma unroll
                for (int i = 0; i < 16; ++i) MA[(m * 34 + 2 + et * 16 + i) * 64] = O[m][et][i]; }
    }
    __syncthreads();
    if (par == 0) {
#pragma unroll
        for (int m = 0; m < NM; ++m) { const float mB = MA[(m * 34 + 0) * 64], lB = MA[(m * 34 + 1) * 64];
            const float mn = fmaxf(mm[m], mB), aA = __builtin_amdgcn_exp2f((mm[m] - mn) * c), aB = __builtin_amdgcn_exp2f((mB - mn) * c);
            ll[m] = ll[m] * aA + lB * aB;
#pragma unroll
            for (int et = 0; et < 2; ++et)
#pragma unroll
                for (int i = 0; i < 16; ++i) O[m][et][i] = O[m][et][i] * aA + MA[(m * 34 + 2 + et * 16 + i) * 64] * aB; }
        if constexpr (DIFF) {
            const float* lv = P.diff_lambda + l * 128;
            const float d1 = wave_sum(C.lane < 32 ? lv[C.lane] * lv[32 + C.lane] : 0.f), d2 = wave_sum(C.lane < 32 ? lv[64 + C.lane] * lv[96 + C.lane] : 0.f);
            const float lam_init = 0.8f - 0.6f * expf(-0.3f * (float)l), lam = expf(d1) - expf(d2) + lam_init;
            ll[0] += __shfl_xor(ll[0], 32); ll[1] += __shfl_xor(ll[1], 32);
            const float i0 = 1.0f / ll[0], i1 = lam / ll[1]; float ss = 0.f;
#pragma unroll
            for (int et = 0; et < 2; ++et)
#pragma unroll
                for (int i = 0; i < 16; ++i) { const float o = O[0][et][i] * i0 - O[1][et][i] * i1; O[0][et][i] = o; ss += o * o; }
            ss += __shfl_xor(ss, 32);
            const float rn = (1.0f - lam_init) / sqrtf(ss * (1.0f / 64.0f) + 1e-6f);
            bf16_t* yrow = Y + (size_t)(tokb + t) * DM + hd * 64;
#pragma unroll
            for (int et = 0; et < 2; ++et)
#pragma unroll
                for (int gq = 0; gq < 4; ++gq) { u32x2 w; w.x = pk2(O[0][et][4 * gq] * rn, O[0][et][4 * gq + 1] * rn); w.y = pk2(O[0][et][4 * gq + 2] * rn, O[0][et][4 * gq + 3] * rn);
                    *(u32x2*)(yrow + et * 32 + 8 * gq + 4 * h) = w; }
        } else {
            ll[0] += __shfl_xor(ll[0], 32);
            const float il = 1.0f / ll[0]; bf16_t* yrow = Y + (size_t)(tokb + t) * DM + 768 + hd * 64;
#pragma unroll
            for (int et = 0; et < 2; ++et)
#pragma unroll
                for (int gq = 0; gq < 4; ++gq) { u32x2 w; w.x = pk2(O[0][et][4 * gq] * il, O[0][et][4 * gq + 1] * il); w.y = pk2(O[0][et][4 * gq + 2] * il, O[0][et][4 * gq + 3] * il);
                    *(u32x2*)(yrow + et * 32 + 8 * gq + 4 * h) = w; }
        }
    }
    __syncthreads();
}
template <bool DIFF>
DI void causal_attn_block2(const Ctx& C, const Params& P, int l) {
    const int xj = C.bid >> 3, bh = ((C.bid & 7) * 2 + (xj >> 4)) & 15, gi = xj & 15;
    causal_attn_unit2<DIFF>(C, P, l, bh, 31 - gi);
    causal_attn_unit2<DIFF>(C, P, l, bh, gi);
}

DI void mem_attn_block(const Ctx& C, const Params& P, int l) {
    const bf16_t* MQ = (const bf16_t*)(P.ws + WS_R1 + R1_MQ); bf16_t* MO = (bf16_t*)(P.ws + WS_R1 + R1_MO);
    const bf16_t* MK = wsp<bf16_t>(P, WS_MK) + (size_t)l * 1024 * 256; const bf16_t* MVT = wsp<bf16_t>(P, WS_MVT) + (size_t)l * 256 * 1024;
    const int xj = C.bid >> 3, bh = ((C.bid & 7) * 2 + (xj >> 4)) & 15, grp = xj & 15, b = bh >> 2, hd = bh & 3, r = C.lane & 31, h = C.lane >> 5;
    const int t = b * SEQ + (grp * 8 + C.wave) * 32 + r;
    bf16x8 qf[4];
#pragma unroll
    for (int s = 0; s < 4; ++s) qf[s] = *(const bf16x8*)(MQ + (size_t)t * 256 + hd * 64 + 16 * s + 8 * h);
    { u32x4 kr[4], vr[4];
#pragma unroll
      for (int j = 0; j < 4; ++j) { const int ci = C.tid + 512 * j;
          kr[j] = *(const u32x4*)(MK + (size_t)(b * 256 + (ci >> 3)) * 256 + hd * 64 + (ci & 7) * 8);
          vr[j] = *(const u32x4*)(MVT + (size_t)(hd * 64 + (ci >> 5)) * 1024 + b * 256 + (ci & 31) * 8); }
#pragma unroll
      for (int j = 0; j < 4; ++j) { const int ci = C.tid + 512 * j;
          *(LAS u32x4*)(C.lds + (ci >> 3) * 144 + (ci & 7) * 16) = kr[j];
          LAS unsigned char* vd = C.lds + 36864 + (ci >> 5) * 520 + (ci & 31) * 16;
          *(LAS u32x2*)vd = (u32x2){vr[j].x, vr[j].y}; *(LAS u32x2*)(vd + 8) = (u32x2){vr[j].z, vr[j].w}; } }
    __syncthreads();
    f32x16 O[2] = {zero16(), zero16()}; float mm = -1e30f, ll = 0.f;
    const float c = 0.125f * 1.4426950408889634f;
#pragma unroll 2
    for (int kt = 0; kt < 8; ++kt) {
        KV64 tl; const LAS unsigned char* krow = C.lds + (kt * 32 + r) * 144 + h * 16;
        const LAS unsigned char* v0 = C.lds + 36864 + r * 520 + (kt * 32 + 4 * h) * 2; const LAS unsigned char* v1 = v0 + 32 * 520;
#pragma unroll
        for (int s = 0; s < 4; ++s) tl.kf[s] = *(const LAS bf16x8*)(krow + s * 32);
#pragma unroll
        for (int s2 = 0; s2 < 2; ++s2) {
            { const u32x2 lo = *(const LAS u32x2*)(v0 + s2 * 32), hi = *(const LAS u32x2*)(v0 + s2 * 32 + 16); u32x4 w; w.x = lo.x; w.y = lo.y; w.z = hi.x; w.w = hi.y; tl.vf[0][s2] = __builtin_bit_cast(bf16x8, w); }
            { const u32x2 lo = *(const LAS u32x2*)(v1 + s2 * 32), hi = *(const LAS u32x2*)(v1 + s2 * 32 + 16); u32x4 w; w.x = lo.x; w.y = lo.y; w.z = hi.x; w.w = hi.y; tl.vf[1][s2] = __builtin_bit_cast(bf16x8, w); } }
        kv64_step(tl, qf, false, 0u, c, mm, ll, O);
    }
    ll += __shfl_xor(ll, 32);
    const float il = 1.0f / ll; bf16_t* orow = MO + (size_t)t * 256 + hd * 64;
#pragma unroll
    for (int et = 0; et < 2; ++et)
#pragma unroll
        for (int g = 0; g < 4; ++g) { u32x2 w; w.x = pk2(O[et][4 * g] * il, O[et][4 * g + 1] * il); w.y = pk2(O[et][4 * g + 2] * il, O[et][4 * g + 3] * il);
            *(u32x2*)(orow + et * 32 + 8 * g + 4 * h) = w; }
    __syncthreads();
}
DI void mma_lds(f32x16& acc, const LAS bf16_t* A, int lda, const LAS bf16_t* Bt, int ldb, int K, int lane) {
    const int r = lane & 31, h = lane >> 5;
    for (int k0 = 0; k0 < K; k0 += 16) {
        const bf16x8 a = *(const LAS bf16x8*)(A + r * lda + k0 + 8 * h);
        const bf16x8 b = *(const LAS bf16x8*)(Bt + r * ldb + k0 + 8 * h);
        acc = mfma32(a, b, acc);
    }
}

constexpr int HG_BC = 0, HG_QT = 32768, HG_KT = 50176, HG_VT = 67584, HG_ST = 86016, HG_AT = 104448;
DI float hgrn_lb(const Params& P, int l, int ch) { if (l == 0) return 0.f; const float z0 = P.hgrn_lb[ch], z1 = P.hgrn_lb[256 + ch]; return 1.0f / (1.0f + expf(z0 - z1)); }
DI void hgrn_cumsum(const Ctx& C, const Params& P, int l, const float (&fpv)[16], int ch0) {
    LAS float* BC = (LAS float*)(C.lds + HG_BC);
    const float lb = hgrn_lb(P, l, ch0 + (C.tid & 127));
#pragma unroll
    for (int j = 0; j < 16; ++j) { const float f = lb + (1.0f - lb) * frcp(1.0f + fexp(fminf(-fpv[j], 80.f))); BC[C.tid + 512 * j] = flog(fmaxf(f, 1e-30f)); }
    __syncthreads();
    if (C.tid < 128) { float cum = 0.f;
#pragma unroll 8
        for (int s = 0; s < 64; ++s) { cum += BC[s * 128 + C.tid]; BC[s * 128 + C.tid] = cum; } }
    __syncthreads();
}
DI void hgrn_local_unit(const Ctx& C, const Params& P, int l, int u) {
    const bf16_t* PROJ = (const bf16_t*)(P.ws + WS_R1 + R1_PROJ); float* HS = wsp<float>(P, WS_HS); float* HD = wsp<float>(P, WS_HD);
    const int hp = u & 1, bc = u >> 1, b = bc >> 6, c = bc & 63, tok0 = b * SEQ + c * 64, ch0 = hp * 128;
    LAS float* BC = (LAS float*)(C.lds + HG_BC); LAS bf16_t* KT = (LAS bf16_t*)(C.lds + HG_QT);   LAS bf16_t* VT = (LAS bf16_t*)(C.lds + HG_VT);
    const int cl = C.tid & 127, ch = ch0 + cl; const float lb = hgrn_lb(P, l, ch);
    float fpv[16]; bf16_t vv[16];
#pragma unroll
    for (int j = 0; j < 16; ++j) { const bf16_t* row = PROJ + (size_t)(tok0 + (C.tid >> 7) + 4 * j) * PROJ_LD; fpv[j] = bf2f(row[PC_BF + ch]); vv[j] = row[PC_BI + ch]; }
    hgrn_cumsum(C, P, l, fpv, ch0);
#pragma unroll
    for (int j = 0; j < 16; ++j) { const int s = (C.tid >> 7) + 4 * j; const float kk = (1.0f - lb) * frcp(1.0f + fexp(fminf(fpv[j], 80.f)));
        KT[cl * 72 + s] = f2bf(kk * fexp(BC[63 * 128 + cl] - BC[s * 128 + cl])); VT[cl * 72 + s] = vv[j]; }
    if (C.tid < 128) HD[(size_t)bc * 256 + ch0 + C.tid] = fexp(BC[63 * 128 + C.tid]);
    __syncthreads();
    { const int h2 = C.wave >> 2, dkt = (C.wave >> 1) & 1, dvt = C.wave & 1, r = C.lane & 31, h = C.lane >> 5;
      f32x16 acc = zero16();
      mma_lds(acc, KT + (h2 * 64 + dkt * 32) * 72, 72, VT + (h2 * 64 + dvt * 32) * 72, 72, 64, C.lane);
      float* dst = HS + ((size_t)(bc * 4 + hp * 2 + h2) * 64) * 64;
#pragma unroll
      for (int i = 0; i < 16; ++i) dst[(dkt * 32 + crow(i, h)) * 64 + dvt * 32 + r] = acc[i]; }
    __syncthreads();
}
DI void hgrn_scan_unit(const Ctx& C, const Params& P, int u) {
    float* HS = wsp<float>(P, WS_HS); const float* HD = wsp<float>(P, WS_HD);
    const int id = u * NTHREADS + C.tid;
    const int bh = id >> 12, e = id & 4095, b = bh >> 2, hh = bh & 3, dk = e >> 6;
    float Lv[64], Dv[64];
#pragma unroll
    for (int c = 0; c < 64; ++c) { const size_t bc = (size_t)b * 64 + c; Lv[c] = HS[((bc * 4 + hh) << 12) + e]; Dv[c] = HD[bc * 256 + hh * 64 + dk]; }
    float S = 0.f;
#pragma unroll
    for (int c = 0; c < 64; ++c) { const size_t bc = (size_t)b * 64 + c; HS[((bc * 4 + hh) << 12) + e] = S; S = Dv[c] * S + Lv[c]; }
}
DI void hgrn_out_unit(const Ctx& C, const Params& P, int l, int u) {
    const bf16_t* PROJ = (const bf16_t*)(P.ws + WS_R1 + R1_PROJ); const float* HS = wsp<float>(P, WS_HS); bf16_t* Y = wsp<bf16_t>(P, WS_Y);
    const int hp = u & 1, bc = u >> 1, b = bc >> 6, c = bc & 63, tok0 = b * SEQ + c * 64, ch0 = hp * 128;
    LAS float* BC = (LAS float*)(C.lds + HG_BC); LAS bf16_t* QT = (LAS bf16_t*)(C.lds + HG_QT); LAS bf16_t* KT = (LAS bf16_t*)(C.lds + HG_KT);
    LAS bf16_t* VT = (LAS bf16_t*)(C.lds + HG_VT); LAS bf16_t* ST = (LAS bf16_t*)(C.lds + HG_ST); LAS bf16_t* AT = (LAS bf16_t*)(C.lds + HG_AT);
    const int cl = C.tid & 127, ch = ch0 + cl; const float lb = hgrn_lb(P, l, ch);
    float fpv[16], qv16[16], sp16[16]; bf16_t vv[16];
#pragma unroll
    for (int j = 0; j < 16; ++j) { const bf16_t* row = PROJ + (size_t)(tok0 + (C.tid >> 7) + 4 * j) * PROJ_LD; fpv[j] = bf2f(row[PC_BF + ch]); qv16[j] = bf2f(row[PC_BQ + ch]); vv[j] = row[PC_BI + ch];
        sp16[j] = HS[(((size_t)bc * 4 + hp * 2) << 12) + C.tid + 512 * j]; }
    hgrn_cumsum(C, P, l, fpv, ch0);
#pragma unroll
    for (int j = 0; j < 16; ++j) { const int s = (C.tid >> 7) + 4 * j; const float kk = (1.0f - lb) * frcp(1.0f + fexp(fminf(fpv[j], 80.f)));
        const float q = qv16[j] * frcp(1.0f + fexp(fminf(-qv16[j], 80.f)));
        const float bs = BC[s * 128 + cl], br = BC[31 * 128 + cl];
        QT[s * 136 + cl] = f2bf(q * fexp(fminf(bs - br, 80.f)));
        KT[s * 136 + cl] = f2bf(kk * fexp(fminf(br - bs, 80.f)));
        VT[cl * 72 + s] = vv[j]; }
#pragma unroll
    for (int j = 0; j < 16; ++j) { const int i = C.tid + 512 * j, h2 = i >> 12, e = i & 4095, dk = e >> 6, dv = e & 63;
        ST[(h2 * 64 + dv) * 72 + dk] = f2bf(sp16[j] * fexp(BC[31 * 128 + h2 * 64 + dk])); }
    __syncthreads();
    {
      const int h2 = C.wave >> 2, tt = (C.wave >> 1) & 1, st = C.wave & 1, r = C.lane & 31, h = C.lane >> 5;
      if (st <= tt) { f32x16 acc = zero16();
          mma_lds(acc, QT + (tt * 32) * 136 + h2 * 64, 136, KT + (st * 32) * 136 + h2 * 64, 136, 64, C.lane);
#pragma unroll
          for (int i = 0; i < 16; ++i) { const int t = tt * 32 + crow(i, h), s = st * 32 + r; AT[(h2 * 64 + t) * 72 + s] = (s <= t) ? f2bf(acc[i]) : (bf16_t)0; } } }
    __syncthreads();
    if (C.wave < 4) {
      const int h2 = C.wave >> 1, tt = C.wave & 1, r = C.lane & 31, h = C.lane >> 5;
      f32x16 o[2] = {zero16(), zero16()};
#pragma unroll
      for (int dvt = 0; dvt < 2; ++dvt) {
          mma_lds(o[dvt], VT + (h2 * 64 + dvt * 32) * 72, 72, AT + (h2 * 64 + tt * 32) * 72, 72, (tt + 1) * 32, C.lane);
          mma_lds(o[dvt], ST + (h2 * 64 + dvt * 32) * 72, 72, QT + (tt * 32) * 136 + h2 * 64, 136, 64, C.lane); }
      float ss = 0.f;
#pragma unroll
      for (int dvt = 0; dvt < 2; ++dvt)
#pragma unroll
          for (int i = 0; i < 16; ++i) ss += o[dvt][i] * o[dvt][i];
      ss += __shfl_xor(ss, 32);
      const float rn = 1.0f / sqrtf(ss * (1.0f / 64.0f) + 1e-6f);
      const int t = tok0 + tt * 32 + r, chb = ch0 + h2 * 64;
      const bf16_t* grow = PROJ + (size_t)t * PROJ_LD + PC_BG + chb; bf16_t* yrow = Y + (size_t)t * DM + 256 + chb;
#pragma unroll
      for (int dvt = 0; dvt < 2; ++dvt)
#pragma unroll
          for (int g = 0; g < 4; ++g) { const int dv = dvt * 32 + 8 * g + 4 * h; const u32x2 gw = *(const u32x2*)(grow + dv);
              const float g0 = siluf_(bflo(gw.x)), g1 = siluf_(bfhi(gw.x)), g2 = siluf_(bflo(gw.y)), g3 = siluf_(bfhi(gw.y));
              u32x2 w; w.x = pk2(o[dvt][4 * g] * rn * g0, o[dvt][4 * g + 1] * rn * g1); w.y = pk2(o[dvt][4 * g + 2] * rn * g2, o[dvt][4 * g + 3] * rn * g3);
              *(u32x2*)(yrow + dv) = w; } }
    __syncthreads();
}

DI void sgu_unit(const Ctx& C, const Params& P, int l, int u) {
    const bf16_t* PROJ = (const bf16_t*)(P.ws + WS_R1 + R1_PROJ); bf16_t* Y = wsp<bf16_t>(P, WS_Y); const bf16_t* SW = wsp<bf16_t>(P, W_SGU);
    const float* sb = P.spatial_b + l * 512;
    LAS bf16_t* VT = (LAS bf16_t*)C.lds; const int tok0 = (u >> 1) * 128, half = u & 1;
    u32x2 wv[16];
#pragma unroll
    for (int j = 0; j < 16; ++j) wv[j] = *(const u32x2*)(PROJ + (size_t)(tok0 + C.wave + NWAVES * j) * PROJ_LD + PC_CV + C.lane * 4);
#pragma unroll
    for (int j = 0; j < 16; ++j) {
        const int s = C.wave + NWAVES * j; const u32x2 w = wv[j];
        float v[4] = {gelu_tanh(bflo(w.x)), gelu_tanh(bfhi(w.x)), gelu_tanh(bflo(w.y)), gelu_tanh(bfhi(w.y))};
        const float mu = wave_sum(v[0] + v[1] + v[2] + v[3]) * (1.0f / 256.0f);
        float q = 0.f;
#pragma unroll
        for (int jj = 0; jj < 4; ++jj) { v[jj] -= mu; q += v[jj] * v[jj]; }
        const float rs = 1.0f / sqrtf(wave_sum(q) * (1.0f / 256.0f) + 1e-6f);
#pragma unroll
        for (int jj = 0; jj < 4; ++jj) VT[(C.lane * 4 + jj) * 136 + s] = f2bf(v[jj] * rs);
    }
    __syncthreads();
    { const int g = C.wave >> 1, dt = C.wave & 1, r = C.lane & 31, h = C.lane >> 5;
      for (int ti = 0; ti < 2; ++ti) { const int tt = half ? (1 + ti) : (ti * 3);
          f32x16 acc = zero16();
          const bf16_t* wrow = SW + ((size_t)g * 128 + tt * 32 + r) * 128 + 8 * h;
          const LAS bf16_t* vrow = VT + (g * 64 + dt * 32 + r) * 136 + 8 * h;
          bf16x8 af[8];
#pragma unroll
          for (int kk = 0; kk < 8; ++kk) af[kk] = *(const bf16x8*)(wrow + (kk < 2 * (tt + 1) ? kk * 16 : 0));
#pragma unroll
          for (int kk = 0; kk < 8; ++kk) if (kk < 2 * (tt + 1)) { const bf16x8 bb = *(const LAS bf16x8*)(vrow + kk * 16); acc = mfma32(af[kk], bb, acc); }
          const int ch = g * 64 + dt * 32 + r;
#pragma unroll
          for (int i = 0; i < 16; ++i) { const int t = tt * 32 + crow(i, h); const size_t tok = (size_t)(tok0 + t);
              const float uu = gelu_tanh(bf2f(PROJ[tok * PROJ_LD + PC_CU + ch]));
              Y[tok * DM + 512 + ch] = f2bf(uu * (acc[i] + sb[g * 128 + t])); } } }
    __syncthreads();
}

DI void phase_router(const Ctx& C, const Params& P, int l, const bool dry = false) {
    float* XR = P.out; bf16_t* H = wsp<bf16_t>(P, WS_H);
    int* TOKE = wsp<int>(P, WS_TOKE); float* TOKW = wsp<float>(P, WS_TOKW); int* RANK = wsp<int>(P, WS_RANK); int* ROWTOK = dry ? wsp<int>(P, WS_DUMMY) : wsp<int>(P, WS_ROWTOK);
    unsigned* CNT = wsp<unsigned>(P, WS_CTL) + CW_CNT + 64 * l + (dry ? 256 : 0);
    const float* gain = P.norm_ffn + l * DM;
    const float* brg = P.b_rg + l * 4; const float* bre = P.b_re + l * 32;
    LAS bf16_t* XHL = (LAS bf16_t*)C.lds; LAS float* PART = (LAS float*)C.lds; LAS float* LOG = (LAS float*)(C.lds + 32768);
    LAS unsigned* lcnt = (LAS unsigned*)(C.lds + LDS_MISC + 1024); LAS unsigned* lbase = lcnt + 32;
    if (C.tid < 32) lcnt[C.tid] = 0u;
    __syncthreads();
    const int per = NTOK / C.G;
    const int r = C.lane & 31, h = C.lane >> 5;
    for (int it = 0; it < per; it += 32) {
        const int tok0 = C.bid * per + it;
        { f32x4 v[4][4];
#pragma unroll
          for (int j = 0; j < 4; ++j) { const float* xr = XR + (size_t)(tok0 + C.wave * 4 + j) * DM;
#pragma unroll
              for (int q = 0; q < 4; ++q) v[j][q] = *(const f32x4*)(xr + q * 256 + C.lane * 4); }
#pragma unroll
          for (int j = 0; j < 4; ++j) { const int tl = C.wave * 4 + j, t = tok0 + tl; float ss = 0.f;
#pragma unroll
              for (int q = 0; q < 4; ++q) ss += v[j][q][0] * v[j][q][0] + v[j][q][1] * v[j][q][1] + v[j][q][2] * v[j][q][2] + v[j][q][3] * v[j][q][3];
              ss = wave_sum(ss); const float rs = 1.0f / sqrtf(ss * (1.0f / DM) + 1e-6f);
#pragma unroll
              for (int q = 0; q < 4; ++q) { const int c = q * 256 + C.lane * 4; const f32x4 g = *(const f32x4*)(gain + c);
                  const f32x4 o = (f32x4){v[j][q][0] * rs * g[0], v[j][q][1] * rs * g[1], v[j][q][2] * rs * g[2], v[j][q][3] * rs * g[3]};
                  u32x2 w; w.x = pk2(o[0], o[1]); w.y = pk2(o[2], o[3]); *(u32x2*)(H + (size_t)t * DM + c) = w;
                  { u32x2 wl; wl.x = pk2(o[0] - bflo(w.x), o[1] - bfhi(w.x)); wl.y = pk2(o[2] - bflo(w.y), o[3] - bfhi(w.y));
                    *(LAS u32x2*)(XHL + tl * 1032 + c) = w; *(LAS u32x2*)(XHL + 33024 + tl * 1032 + c) = wl; } } } }
        __syncthreads();
        f32x16 acc = zero16();
        { const int ct = C.wave & 1, kq = C.wave >> 1;
          const LAS bf16_t* ah = XHL + r * 1032 + kq * 256 + 8 * h; const LAS bf16_t* al = ah + 33024;
          const bf16_t* bh_ = wsp<bf16_t>(P, W_RH) + (size_t)(ct * 32 + r) * 1024 + kq * 256 + 8 * h; const bf16_t* bl_ = bh_ + (size_t)64 * 1024;
#pragma unroll 4
          for (int k0 = 0; k0 < 256; k0 += 16) { const bf16x8 xh = *(const LAS bf16x8*)(ah + k0), xl = *(const LAS bf16x8*)(al + k0);
              const bf16x8 wh = *(const bf16x8*)(bh_ + k0), wl = *(const bf16x8*)(bl_ + k0);
              acc = mfma32(xh, wh, acc); acc = mfma32(xh, wl, acc); acc = mfma32(xl, wh, acc); } }
        __syncthreads();
#pragma unroll
        for (int i = 0; i < 16; ++i) PART[(C.wave * 16 + i) * 64 + C.lane] = acc[i];
        __syncthreads();
        for (int idx = C.tid; idx < 32 * 36; idx += NTHREADS) { const int tok = idx / 36, col = idx % 36, ct = col < 32 ? 0 : 1, cc = col < 32 ? col : col - 32;
            const int hh = (tok >> 2) & 1, reg = (tok & 3) + 4 * (tok >> 3); float s = 0.f;
#pragma unroll
            for (int kq = 0; kq < 4; ++kq) s += PART[((kq * 2 + ct) * 16 + reg) * 64 + cc + 32 * hh];
            LOG[tok * 36 + col] = s; }
        __syncthreads();
        if (C.tid < 32) { const int t = tok0 + C.tid; const LAS float* lg = LOG + C.tid * 36;
            float gl[4]; int gsel = 0;
#pragma unroll
            for (int k = 0; k < 4; ++k) gl[k] = lg[32 + k] + brg[k];
            float gmax = gl[0];
#pragma unroll
            for (int k = 1; k < 4; ++k) if (gl[k] > gmax) { gmax = gl[k]; gsel = k; }
            float gsum = 0.f;
#pragma unroll
            for (int k = 0; k < 4; ++k) gsum += expf(gl[k] - gmax);
            const float pg = 1.0f / gsum;
            float pe[8]; float emax = -1e30f;
#pragma unroll
            for (int k = 0; k < 8; ++k) { pe[k] = lg[gsel * 8 + k] + bre[gsel * 8 + k]; emax = fmaxf(emax, pe[k]); }
#pragma unroll
            for (int k = 0; k < 8; ++k) pe[k] = expf(pe[k] - emax);
            int i1 = 0; float p1 = pe[0];
#pragma unroll
            for (int k = 1; k < 8; ++k) if (pe[k] > p1) { p1 = pe[k]; i1 = k; }
            int i2 = (i1 == 0) ? 1 : 0; float p2 = pe[i2];
#pragma unroll
            for (int k = 0; k < 8; ++k) if (k != i1 && pe[k] > p2) { p2 = pe[k]; i2 = k; }
            const float inv = pg / (p1 + p2);
            const int e1 = gsel * 8 + i1, e2 = gsel * 8 + i2;
            TOKE[t * 2] = e1; TOKE[t * 2 + 1] = e2; TOKW[t * 2] = p1 * inv; TOKW[t * 2 + 1] = p2 * inv;
            RANK[t * 2] = (int)__hip_atomic_fetch_add(lcnt + e1, 1u, __ATOMIC_RELAXED, __HIP_MEMORY_SCOPE_WORKGROUP);
            RANK[t * 2 + 1] = (int)__hip_atomic_fetch_add(lcnt + e2, 1u, __ATOMIC_RELAXED, __HIP_MEMORY_SCOPE_WORKGROUP); }
        __syncthreads();
    }
    if (C.tid < 32) { const unsigned n = lcnt[C.tid]; lbase[C.tid] = n ? __hip_atomic_fetch_add(CNT + C.tid, n, __ATOMIC_RELAXED, __HIP_MEMORY_SCOPE_AGENT) : 0u; }
    __syncthreads();
    asm volatile("s_waitcnt vmcnt(0)" ::: "memory");
    for (int a = C.tid; a < per * 2; a += NTHREADS) { const int ga = C.bid * per * 2 + a; const int e = TOKE[ga]; const unsigned rk = lbase[e] + (unsigned)RANK[ga];
        ROWTOK[(size_t)e * MOE_CAP + rk] = ga; }
    __syncthreads();
}
typedef f32x4 AccT[2][2][4][2];
DI u32x4 pack8(const f32x4& a, const f32x4& b) { u32x4 w; w.x = pk2(a[0], a[1]); w.y = pk2(a[2], a[3]); w.z = pk2(b[0], b[1]); w.w = pk2(b[2], b[3]); return w; }
template <int ACT> struct EpiStore {
    bf16_t* O; int ldc;
    DI void operator()(const AccT& acc, const pg8::Unit& u, int wr, int wc, int fr, int fq) const {
#pragma unroll
        for (int ai = 0; ai < 2; ++ai)
#pragma unroll
            for (int m = 0; m < 4; ++m) { const size_t row = (size_t)(u.pm * 256 + ai * 128 + wr * 64 + m * 16 + fr);
#pragma unroll
                for (int bj = 0; bj < 2; ++bj) { const int col = u.pn * 256 + bj * 128 + wc * 32 + 8 * fq; f32x4 a = acc[ai][bj][m][0], b = acc[ai][bj][m][1];
                    if (ACT == 1) {
#pragma unroll
                        for (int j = 0; j < 4; ++j) { a[j] = sigmoidf_(a[j]); b[j] = sigmoidf_(b[j]); } }
                    *(u32x4*)(O + row * ldc + col) = pack8(a, b); } }
    }
};
struct EpiMerge {
    const bf16_t* GATE; bf16_t* MG;
    DI void operator()(const AccT& acc, const pg8::Unit& u, int wr, int wc, int fr, int fq) const {
#pragma unroll
        for (int ai = 0; ai < 2; ++ai)
#pragma unroll
            for (int m = 0; m < 4; ++m) { const size_t row = (size_t)(u.pm * 256 + ai * 128 + wr * 64 + m * 16 + fr);
#pragma unroll
                for (int bj = 0; bj < 2; ++bj) { const int col = u.pn * 256 + bj * 128 + wc * 32 + 8 * fq;
                    const u32x4 g = *(const u32x4*)(GATE + row * 4096 + u.x * 1024 + col);
                    f32x4 a = acc[ai][bj][m][0], b = acc[ai][bj][m][1];
                    a[0] *= bflo(g.x); a[1] *= bfhi(g.x); a[2] *= bflo(g.y); a[3] *= bfhi(g.y); b[0] *= bflo(g.z); b[1] *= bfhi(g.z); b[2] *= bflo(g.w); b[3] *= bfhi(g.w);
                    bf16_t* dst = MG + row * 1024 + col;
                    if (u.x > 0) { const u32x4 p = *(const u32x4*)dst;
                        a[0] += bflo(p.x); a[1] += bfhi(p.x); a[2] += bflo(p.y); a[3] += bfhi(p.y); b[0] += bflo(p.z); b[1] += bfhi(p.z); b[2] += bflo(p.w); b[3] += bfhi(p.w); }
                    *(u32x4*)dst = pack8(a, b); }
                asm volatile("" ::: "memory"); }
    }
};
struct EpiResid {
    float* XR;
    DI void operator()(const AccT& acc, const pg8::Unit& u, int wr, int wc, int fr, int fq) const {
#pragma unroll
        for (int ai = 0; ai < 2; ++ai)
#pragma unroll
            for (int m = 0; m < 4; ++m) { const size_t row = (size_t)(u.pm * 256 + ai * 128 + wr * 64 + m * 16 + fr);
#pragma unroll
                for (int bj = 0; bj < 2; ++bj) { float* p = XR + row * 1024 + u.pn * 256 + bj * 128 + wc * 32 + 8 * fq;
                    const f32x4 x0 = *(const f32x4*)p, x1 = *(const f32x4*)(p + 4);
                    *(f32x4*)p = x0 + acc[ai][bj][m][0]; *(f32x4*)(p + 4) = x1 + acc[ai][bj][m][1]; }
                if (m == 3) asm volatile("" ::: "memory"); }
    }
};
struct EpiResidNorm {
    float* XR; bf16_t* XB; float* RSS;
    DI void operator()(const AccT& acc, const pg8::Unit& u, int wr, int wc, int fr, int fq) const {
#pragma unroll
        for (int ai = 0; ai < 2; ++ai)
#pragma unroll
            for (int m = 0; m < 4; ++m) { const size_t row = (size_t)(u.pm * 256 + ai * 128 + wr * 64 + m * 16 + fr); float ss = 0.f;
#pragma unroll
                for (int bj = 0; bj < 2; ++bj) { const size_t off = row * 1024 + u.pn * 256 + bj * 128 + wc * 32 + 8 * fq; float* p = XR + off;
                    const f32x4 x0 = *(const f32x4*)p + acc[ai][bj][m][0], x1 = *(const f32x4*)(p + 4) + acc[ai][bj][m][1];
                    *(f32x4*)p = x0; *(f32x4*)(p + 4) = x1; *(u32x4*)(XB + off) = pack8(x0, x1);
                    ss += (x0[0] * x0[0] + x0[1] * x0[1]) + (x0[2] * x0[2] + x0[3] * x0[3]) + (x1[0] * x1[0] + x1[1] * x1[1]) + (x1[2] * x1[2] + x1[3] * x1[3]); }
                ss += __shfl_xor(ss, 16); ss += __shfl_xor(ss, 32);
                if (fq == 0) RSS[row * 16 + u.pn * 4 + wc] = ss;
                if (m == 3) asm volatile("" ::: "memory"); }
    }
};
struct EpiStoreRstd {
    bf16_t* O; int ldc; const float* RSS;
    DI void operator()(const AccT& acc, const pg8::Unit& u, int wr, int wc, int fr, int fq) const {
#pragma unroll
        for (int ai = 0; ai < 2; ++ai)
#pragma unroll
            for (int m = 0; m < 4; ++m) { const size_t row = (size_t)(u.pm * 256 + ai * 128 + wr * 64 + m * 16 + fr);
                const f32x4* rp = (const f32x4*)(RSS + row * 16); const f32x4 r0 = rp[0], r1 = rp[1], r2 = rp[2], r3 = rp[3];
                const float rsum = ((r0[0] + r0[1]) + (r0[2] + r0[3])) + ((r1[0] + r1[1]) + (r1[2] + r1[3])) + ((r2[0] + r2[1]) + (r2[2] + r2[3])) + ((r3[0] + r3[1]) + (r3[2] + r3[3]));
                const float rs = 1.0f / sqrtf(rsum * (1.0f / 1024.0f) + 1e-6f);
#pragma unroll
                for (int bj = 0; bj < 2; ++bj) { const int col = u.pn * 256 + bj * 128 + wc * 32 + 8 * fq;
                    *(u32x4*)(O + row * ldc + col) = pack8(acc[ai][bj][m][0] * rs, acc[ai][bj][m][1] * rs); } }
    }
};
struct EpiGU {
    bf16_t* HID;
    DI void operator()(const AccT& acc, const pg8::Unit& u, int wr, int wc, int fr, int fq) const {
#pragma unroll
        for (int ai = 0; ai < 2; ++ai)
#pragma unroll
            for (int m = 0; m < 4; ++m) { const size_t row = (size_t)(u.pm * 256 + ai * 128 + wr * 64 + m * 16 + fr);
                f32x4 a, b;
#pragma unroll
                for (int j = 0; j < 4; ++j) { a[j] = siluf_(acc[ai][0][m][0][j]) * acc[ai][1][m][0][j]; b[j] = siluf_(acc[ai][0][m][1][j]) * acc[ai][1][m][1][j]; }
                *(u32x4*)(HID + row * 256 + u.pn * 128 + wc * 32 + 8 * fq) = pack8(a, b); }
    }
};
struct EpiDown {
    bf16_t* YB; const int* ROWTOK; const float* TOKW; const LAS int* cnt;
    DI void operator()(const AccT& acc, const pg8::Unit& u, int wr, int wc, int fr, int fq) const {
        const int ce = cnt[u.x];
#pragma unroll
        for (int ai = 0; ai < 2; ++ai)
#pragma unroll
            for (int m = 0; m < 4; ++m) { const int idx = u.y * 256 + ai * 128 + wr * 64 + m * 16 + fr;
                if (idx < ce) { const int a = ROWTOK[(size_t)u.x * MOE_CAP + idx]; const float w = TOKW[a];
#pragma unroll
                    for (int bj = 0; bj < 2; ++bj) { const int col = u.pn * 256 + bj * 128 + wc * 32 + 8 * fq;
                        *(u32x4*)(YB + (size_t)a * 1024 + col) = pack8(acc[ai][bj][m][0] * w, acc[ai][bj][m][1] * w); } } }
    }
};

struct FusedMergeOrder {
    const char* Hb; const char* Yb; const char* Wg; const char* Wb; int G, c;
    DI bool next(int i, pg8::Unit& u) const {
        const int ti = i >> 3, x = i & 7, n = x >> 1; const long L = (long)ti * G + c; if (L >= 256) return false;
        pg8::tile_map((int)L, 64, 4, u.pm, u.pn); u.x = x; u.y = 0;
        if (x & 1) { u.a = Yb + (size_t)u.pm * 256 * 1024 * 2 + (size_t)n * 256 * 2; u.b = Wb + (size_t)u.pn * 256 * 1024 * 2 + (size_t)n * 256 * 2; u.nt = 4; }
        else { u.a = Hb + (size_t)u.pm * 256 * 1024 * 2; u.b = Wg + ((size_t)n * 1024 + (size_t)u.pn * 256) * 1024 * 2; u.nt = 16; }
        return true; }
    DI unsigned row_off(const pg8::Unit&, int) const { return 0u; }
};
struct EpiFusedMerge {
    bf16_t* GS; bf16_t* MG; int tid;
    DI void operator()(const AccT& acc, const pg8::Unit& u, int wr, int wc, int fr, int fq) const {
        const int tid_ = (wr * 4 + wc) * 64 + fq * 16 + fr;
        u32x4* gs = (u32x4*)GS + tid_; u32x4* ps = gs + (R1_PS - R1_GS) / 16;
        if ((u.x & 1) == 0) {
#pragma unroll
            for (int ai = 0; ai < 2; ++ai)
#pragma unroll
                for (int m = 0; m < 4; ++m)
#pragma unroll
                    for (int bj = 0; bj < 2; ++bj) { f32x4 a = acc[ai][bj][m][0], b = acc[ai][bj][m][1];
#pragma unroll
                        for (int j = 0; j < 4; ++j) { a[j] = sigmoidf_(a[j]); b[j] = sigmoidf_(b[j]); }
                        gs[((ai * 4 + m) * 2 + bj) * 512] = pack8(a, b); }
        } else {
#pragma unroll
            for (int ai = 0; ai < 2; ++ai)
#pragma unroll
                for (int m = 0; m < 4; ++m) { const size_t row = (size_t)(u.pm * 256 + ai * 128 + wr * 64 + m * 16 + fr);
#pragma unroll
                    for (int bj = 0; bj < 2; ++bj) { const int col = u.pn * 256 + bj * 128 + wc * 32 + 8 * fq; const int si = ((ai * 4 + m) * 2 + bj) * 512;
                        const u32x4 g = gs[si];
                        f32x4 a = acc[ai][bj][m][0], b = acc[ai][bj][m][1];
                        a[0] *= bflo(g.x); a[1] *= bfhi(g.x); a[2] *= bflo(g.y); a[3] *= bfhi(g.y); b[0] *= bflo(g.z); b[1] *= bfhi(g.z); b[2] *= bflo(g.w); b[3] *= bfhi(g.w);
                        if (u.x > 1) { const u32x4 p = ps[si];
                            a[0] += bflo(p.x); a[1] += bfhi(p.x); a[2] += bflo(p.y); a[3] += bfhi(p.y); b[0] += bflo(p.z); b[1] += bfhi(p.z); b[2] += bflo(p.w); b[3] += bfhi(p.w); }
                        if (u.x < 7) ps[si] = pack8(a, b); else *(u32x4*)(MG + row * 1024 + col) = pack8(a, b); }
                    if (m & 1) asm volatile("" ::: "memory"); }
        }
    }
};
constexpr int MOE_TAB = LDS_MISC + 256;
DI void moe_build_table(const Ctx& C, const unsigned* CNT) {
    volatile LAS int* T = (volatile LAS int*)(C.lds + MOE_TAB);
    if (C.tid == 0) { int acc = 0; for (int e = 0; e < 32; ++e) { const int n = (int)CNT[e]; T[e] = acc; T[40 + e] = n; const int nt = (n + 255) >> 8;
            for (int j = 0; j < nt; ++j) T[80 + acc + j] = (e << 8) | j;
            acc += nt; } T[32] = acc; }
    __syncthreads();
}
template <int NPN, bool GU> struct MoeOrder {
    const LAS int* T; const char* Ab; const char* Wb; const int* ROWTOK; int G, c;
    DI bool next(int i, pg8::Unit& u) const {
        const long L0 = (long)i * G + c; const int tot = __builtin_amdgcn_readfirstlane(T[32]) * NPN, per = (tot + 7) >> 3, j_ = (int)(L0 >> 3);
        if (j_ >= per) return false;
        const long L = (long)(L0 & 7) * per + j_; if (L >= tot) return false;
        const int tile = (int)(L / NPN), pn = (int)(L % NPN);
        const int ej = __builtin_amdgcn_readfirstlane(T[80 + tile]); const int e = ej >> 8;
        u.x = e; u.y = ej & 255; u.pm = tile; u.pn = pn; u.nt = 0;
        if (GU) { u.a = Ab; u.b = Wb + ((size_t)e * 512 + (size_t)pn * 256) * 1024 * 2; }
        else { u.a = Ab + (size_t)tile * 256 * 256 * 2; u.b = Wb + ((size_t)e * 1024 + (size_t)pn * 256) * 256 * 2; }
        return true; }
    DI unsigned row_off(const pg8::Unit& u, int row) const {
        const int idx = u.y * 256 + row; int tok = 0;
        if (idx < T[40 + u.x]) tok = ROWTOK[(size_t)u.x * MOE_CAP + idx] >> 1;
        return (unsigned)tok * 2048u; }
};

constexpr int PH_PER_LAYER = 16, PH_L0 = 1, N_PHASES = PH_L0 + DEPTH * PH_PER_LAYER + 1;
#ifndef ENABLE_MASK
#define ENABLE_MASK 0xFF
#endif
#ifndef PROBE_DUP
#define PROBE_DUP 0
#endif
#define NREP(bit) ((PROBE_DUP & (bit)) ? 2 : 1)
#define ZIGZAG(n, call) do { for (int _rd = 0; _rd * C.G < (n); ++_rd) { const int u = _rd * C.G + ((_rd & 1) ? (C.G - 1 - C.bid) : C.bid); if (u < (n)) { call; } } } while (0)

typedef const Params __attribute__((address_space(4))) KParams;
#if defined(__HIP_DEVICE_COMPILE__)
#define PHASE_LOADP() KParams* _pp = (KParams*)__builtin_amdgcn_kernarg_segment_ptr(); asm volatile("" : "+s"(_pp)); const Params P = *_pp
#else
#define PHASE_LOADP() const Params P = Parg
#endif
#define PHASE_ENV() PHASE_LOADP(); const Ctx C = relaunder(C0); LAS unsigned char* lds = C.lds; bf16_t* H = wsp<bf16_t>(P, WS_H); bf16_t* Y = wsp<bf16_t>(P, WS_Y); unsigned char* R1 = P.ws + WS_R1
#define IN(k) (lo <= (k) && (k) < hi)
#define SEAM(k) do { if (IN(k) && IN((k) + 1)) { xcd_barrier(bar); if (PROBE_DUP & 1048576) xcd_barrier(bar); } } while (0)
template <int l> DI void layer_phases(const Ctx& C0, const Params& Parg, const int lo, const int hi, const XcdBarrier& bar) {
    constexpr int pb = PH_L0 + l * PH_PER_LAYER;
        if (IN(pb + 0)) { PHASE_ENV(); for (int rep = 0; rep < NREP(8); ++rep) phase_convert_layer(C, P, l);
            if (l == 0) phase_rownorm<false, true, false, true>(C, P, P.norm_mix + l * DM); else if (!(ENABLE_MASK & 32)) phase_rownorm<false, true, false>(C, P, P.norm_mix + l * DM); else phase_rownorm<true, true, false>(C, P, P.norm_mix + l * DM); } SEAM(pb + 0);
        if (IN(pb + 1)) for (int rep = 0; rep < NREP(16); ++rep) { PHASE_ENV();
            { pg8::DenseOrder S; S.init(H, wsp<bf16_t>(P, W_IN), NTOK, 2560, 1024, 1024, C.G, C.bid);
              EpiStore<0> E{(bf16_t*)(R1 + R1_PROJ), PROJ_LD}; pg8::gemm_phase<EpiStore<0>, pg8::DenseOrder, false>(C.tid, lds, 1024, 1024, 1024, S, E); }
            { pg8::DenseOrder S; S.init(wsp<bf16_t>(P, W_V), H, 512, NTOK, 1024, 1024, C.G, (C.bid + 128) % C.G);
              EpiStore<0> E{(bf16_t*)(R1 + R1_VT), NTOK}; pg8::gemm_phase<EpiStore<0>, pg8::DenseOrder, false>(C.tid, lds, 1024, 1024, 1024, S, E); }
            if (l == 0) {
        for (int lm = 0; lm < DEPTH; ++lm) {
            const bf16_t* MEMN = wsp<bf16_t>(P, WS_MEMN) + (size_t)lm * 1024 * 1024; const bf16_t* WKV = wsp<bf16_t>(P, W_KV) + (size_t)lm * 512 * 1024;
            { pg8::DenseOrder S; S.init(MEMN, WKV, 1024, 256, 1024, 1024, C.G, (C.bid + 8 * lm) % C.G);
              EpiStore<0> E{wsp<bf16_t>(P, WS_MK) + (size_t)lm * 1024 * 256, 256}; pg8::gemm_phase<EpiStore<0>, pg8::DenseOrder, false>(C.tid, lds, 1024, 1024, 1024, S, E); }
            { pg8::DenseOrder S; S.init(WKV + (size_t)256 * 1024, MEMN, 256, 1024, 1024, 1024, C.G, (C.bid + 8 * lm + 4) % C.G);
              EpiStore<0> E{wsp<bf16_t>(P, WS_MVT) + (size_t)lm * 256 * 1024, 1024}; pg8::gemm_phase<EpiStore<0>, pg8::DenseOrder, false>(C.tid, lds, 1024, 1024, 1024, S, E); }
        }
            }
        } SEAM(pb + 1);
        if (IN(pb + 2)) { PHASE_ENV(); phase_rope(C, P, l); } SEAM(pb + 2);
        if (IN(pb + 3)) { PHASE_ENV();
            for (int rep = 0; rep < NREP(1); ++rep) { if (ENABLE_MASK & 8) { const int xb = (C.bid & 7) >> 1, kq = ((C.bid & 7) & 1) * 32 + ((C.bid >> 3) & 31);
                  dsa_select_unit(C, P, l, xb, 127 - kq); dsa_select_unit(C, P, l, xb, kq); } }
            for (int rep = 0; rep < NREP(1024); ++rep) { if (ENABLE_MASK & 2) ZIGZAG(512, hgrn_local_unit(C, P, l, u);); }
            for (int rep = 0; rep < NREP(2048); ++rep) { if (ENABLE_MASK & 4) ZIGZAG(256, sgu_unit(C, P, l, u);); }
        } SEAM(pb + 3);
        if (IN(pb + 4)) { PHASE_ENV();
            for (int rep = 0; rep < NREP(2); ++rep) { if (ENABLE_MASK & 1) causal_attn_block2<true>(C, P, l); }
            if (ENABLE_MASK & 2) { for (int u = C.G - 1 - C.bid; u < 128; u += C.G) hgrn_scan_unit(C, P, u); }
        } SEAM(pb + 4);
        if (IN(pb + 5)) {
            for (int rep = 0; rep < NREP(4); ++rep) { PHASE_ENV();
            for (int r2 = 0; r2 < NREP(2097152); ++r2) { if (ENABLE_MASK & 8) causal_attn_block2<false>(C, P, l); }
            for (int r3 = 0; r3 < NREP(4194304); ++r3) { if (ENABLE_MASK & 2) ZIGZAG(512, hgrn_out_unit(C, P, l, u);); } }
        } SEAM(pb + 5);
        if (IN(pb + 7)) for (int rep = 0; rep < NREP(128); ++rep) { PHASE_ENV();
            FusedMergeOrder S{(const char*)H, (const char*)Y, (const char*)wsp<bf16_t>(P, W_G), (const char*)wsp<bf16_t>(P, W_BR), C.G, C.bid};
            EpiFusedMerge E{(bf16_t*)(R1 + R1_GS) + (size_t)C.bid * 65536, (bf16_t*)(R1 + R1_MG), C.tid};
            pg8::gemm_phase<EpiFusedMerge, FusedMergeOrder, false>(C.tid, lds, 1024, 1024, 1024, S, E);
        } SEAM(pb + 7);
        if (IN(pb + 8)) { PHASE_ENV();
            pg8::DenseOrder S; S.init(R1 + R1_MG, wsp<bf16_t>(P, W_OUT), NTOK, 1024, 1024, 1024, C.G, C.bid);
            EpiResidNorm E{P.out, H, wsp<float>(P, WS_RSS)}; pg8::gemm_phase<EpiResidNorm, pg8::DenseOrder, false>(C.tid, lds, 1024, 1024, 1024, S, E);
        } SEAM(pb + 8);
        if (IN(pb + 10)) for (int rep = 0; rep < NREP(64); ++rep) { PHASE_ENV();
            pg8::DenseOrder S; S.init(H, wsp<bf16_t>(P, W_Q), NTOK, 256, 1024, 1024, C.G, C.bid);
            EpiStoreRstd E{(bf16_t*)(R1 + R1_MQ), 256, wsp<float>(P, WS_RSS)}; pg8::gemm_phase<EpiStoreRstd, pg8::DenseOrder, false>(C.tid, lds, 1024, 1024, 1024, S, E);
        } SEAM(pb + 10);
        if (IN(pb + 11)) for (int rep = 0; rep < NREP(64); ++rep) { PHASE_ENV(); mem_attn_block(C, P, l); } SEAM(pb + 11);
        if (IN(pb + 12)) { PHASE_ENV();
            if (ENABLE_MASK & 16) { pg8::DenseOrder S; S.init(R1 + R1_MO, wsp<bf16_t>(P, W_O), NTOK, 1024, 256, 256, C.G, C.bid);
              EpiResid E{P.out}; pg8::gemm_phase<EpiResid, pg8::DenseOrder, false>(C.tid, lds, 256, 256, 256, S, E); }
        } SEAM(pb + 12);
        if (IN(pb + 13)) { PHASE_ENV(); phase_router(C, P, l); if (PROBE_DUP & 512) { __syncthreads(); phase_router(C, P, l, true); } } SEAM(pb + 13);
        if (IN(pb + 14)) for (int rep = 0; rep < NREP(32); ++rep) { PHASE_ENV();
            moe_build_table(C, wsp<unsigned>(P, WS_CTL) + CW_CNT + 64 * l);
            MoeOrder<2, true> S{(const LAS int*)(lds + MOE_TAB), (const char*)H, (const char*)wsp<bf16_t>(P, W_GU), wsp<int>(P, WS_ROWTOK), C.G, C.bid};
            EpiGU E{(bf16_t*)(R1 + R1_HID)}; pg8::gemm_phase<EpiGU, MoeOrder<2, true>, true>(C.tid, lds, 1024, 1024, 1024, S, E);
        } SEAM(pb + 14);
        if (IN(pb + 15)) for (int rep = 0; rep < NREP(32); ++rep) { PHASE_ENV();
            moe_build_table(C, wsp<unsigned>(P, WS_CTL) + CW_CNT + 64 * l);
            MoeOrder<4, false> S{(const LAS int*)(lds + MOE_TAB), (const char*)(R1 + R1_HID), (const char*)wsp<bf16_t>(P, W_D), wsp<int>(P, WS_ROWTOK), C.G, C.bid};
            EpiDown E{(bf16_t*)(R1 + R1_YB), wsp<int>(P, WS_ROWTOK), wsp<float>(P, WS_TOKW), (const LAS int*)(lds + MOE_TAB) + 40};
            pg8::gemm_phase<EpiDown, MoeOrder<4, false>, false>(C.tid, lds, 256, 256, 256, S, E);
        } SEAM(pb + 15);
    }
__global__ void __launch_bounds__(NTHREADS, 2) mega_fwd(Params Parg) {
    extern __shared__ __attribute__((aligned(16))) unsigned char lds_raw[];
    Ctx C0; C0.lds = (LAS unsigned char*)lds_raw; C0.tid = threadIdx.x; C0.lane = C0.tid & 63; C0.wave = __builtin_amdgcn_readfirstlane((int)threadIdx.x >> 6); C0.G = gridDim.x; C0.bid = blockIdx.x;
    volatile LAS unsigned* misc = (volatile LAS unsigned*)(C0.lds + LDS_MISC);
    if (C0.tid < 4) misc[C0.tid] = 0u;
    __syncthreads();
    const int lo = Parg.ph_lo, hi = Parg.ph_hi;
    const bool use_bar = (hi - lo) > 1;
    XcdBarrier bar; bar.bar = (unsigned*)(Parg.ws + WS_CTL) + CW_BAR; bar.x = 0; bar.st = misc;
    if (use_bar) bar = xcd_barrier_post((unsigned*)(Parg.ws + WS_CTL) + CW_BAR, misc);
#define IN(k) (lo <= (k) && (k) < hi)
#define SEAM(k) do { if (IN(k) && IN((k) + 1)) { xcd_barrier(bar); if (PROBE_DUP & 1048576) xcd_barrier(bar); } } while (0)

    if (IN(0)) { PHASE_ENV(); phase_prologue(C, P); } SEAM(0);
    layer_phases<0>(C0, Parg, lo, hi, bar);
    layer_phases<1>(C0, Parg, lo, hi, bar);
    if (IN(N_PHASES - 1)) { PHASE_ENV(); if (ENABLE_MASK & 32) phase_rownorm<true, false, true>(C, P, P.norm_final); else phase_rownorm<false, false, true>(C, P, P.norm_final); }
#undef IN
#undef SEAM
}

#ifndef N_LAUNCH_MODE
#define N_LAUNCH_MODE 0
#endif
extern "C" void kernel_launch(void* const* d_in, const int* in_sizes, int n_in, void* d_out, int out_size, void* d_ws, size_t ws_size, hipStream_t stream) {
    static int grid = 0;
    if (grid == 0) {
        if (n_in != 25 || out_size != NTOK * DM || ws_size < WS_END) { fprintf(stderr, "kernel_launch: unexpected shapes (n_in %d out %d ws %zu need %zu)\n", n_in, out_size, ws_size, (size_t)WS_END); grid = -1; return; }
        int dev = 0, cus = 0;
        if (hipGetDevice(&dev) != hipSuccess || hipDeviceGetAttribute(&cus, hipDeviceAttributeMultiprocessorCount, dev) != hipSuccess) { grid = -1; return; }
        if (hipFuncSetAttribute((const void*)mega_fwd, hipFuncAttributeMaxDynamicSharedMemorySize, LDS_BYTES) != hipSuccess) { fprintf(stderr, "kernel_launch: hipFuncSetAttribute failed\n"); grid = -1; return; }
        int per_cu = 0;
        if (hipOccupancyMaxActiveBlocksPerMultiprocessor(&per_cu, (const void*)mega_fwd, NTHREADS, LDS_BYTES) != hipSuccess || per_cu < 1) { fprintf(stderr, "kernel_launch: occupancy query says %d\n", per_cu); }
        (void)hipGetLastError();
        if (cus != 256) fprintf(stderr, "kernel_launch: built for 256 CUs (one workgroup per CU); device reports %d\n", cus);
        grid = 256;
    }
    if (grid < 0) return;
    (void)hipMemsetAsync((char*)d_ws + WS_CTL, 0, CTL_BYTES, stream);
    Params p{};
    p.x = (const float*)d_in[0]; p.mem = (const float*)d_in[1]; p.positions = (const int*)d_in[2];
    p.norm_mix = (const float*)d_in[3]; p.w_in = (const float*)d_in[4]; p.diff_lambda = (const float*)d_in[5]; p.hgrn_lb = (const float*)d_in[6];
    p.spatial_w = (const float*)d_in[7]; p.spatial_b = (const float*)d_in[8]; p.w_branch = (const float*)d_in[9]; p.w_out = (const float*)d_in[10];
    p.norm_mem_q = (const float*)d_in[11]; p.norm_mem_kv = (const float*)d_in[12]; p.w_mem_q = (const float*)d_in[13]; p.w_mem_kv = (const float*)d_in[14]; p.w_mem_o = (const float*)d_in[15];
    p.norm_ffn = (const float*)d_in[16]; p.w_rg = (const float*)d_in[17]; p.b_rg = (const float*)d_in[18]; p.w_re = (const float*)d_in[19]; p.b_re = (const float*)d_in[20];
    p.w_eg = (const float*)d_in[21]; p.w_eu = (const float*)d_in[22]; p.w_ed = (const float*)d_in[23]; p.norm_final = (const float*)d_in[24];
    p.out = (float*)d_out; p.ws = (unsigned char*)d_ws;
#if N_LAUNCH_MODE == 0
    p.ph_lo = 0; p.ph_hi = N_PHASES;
    hipLaunchKernelGGL(mega_fwd, dim3(grid), dim3(NTHREADS), LDS_BYTES, stream, p);
#else
    for (int k = 0; k < N_PHASES; ++k) { p.ph_lo = k; p.ph_hi = k + 1; hipLaunchKernelGGL(mega_fwd, dim3(grid), dim3(NTHREADS), LDS_BYTES, stream, p); }
#endif
}
```

```cpp
#include <hip/hip_runtime.h>
#include <stdint.h>
#include <stdio.h>

#ifndef PROBE_DUP
#define PROBE_DUP 0
#endif
#define DI __device__ __forceinline__
#define LAS __attribute__((address_space(3)))
typedef unsigned short bf16_t;
typedef short bf16x8 __attribute__((ext_vector_type(8)));
typedef short s16x4 __attribute__((ext_vector_type(4)));
typedef float f32x2 __attribute__((ext_vector_type(2)));
typedef float f32x4 __attribute__((ext_vector_type(4)));
typedef float f32x16 __attribute__((ext_vector_type(16)));
typedef unsigned u32x2 __attribute__((ext_vector_type(2)));
typedef unsigned u32x4 __attribute__((ext_vector_type(4)));
typedef __bf16 hbf2 __attribute__((ext_vector_type(2)));

constexpr int NB = 4, SEQ = 4096, NTOK = NB * SEQ, DM = 1024, DEPTH = 2, MEMLEN = 256;
constexpr int NTHREADS = 512, NWAVES = 8;
constexpr int LDS_BYTES = 147456;
constexpr int LDS_MISC = 133120;
constexpr int IN_WIDTH = 6948;
constexpr int PROJ_LD = 2560;
constexpr int PC_AQ = 0, PC_AK = 256, PC_BQ = 512, PC_BF = 768, PC_BI = 1024, PC_BG = 1280, PC_CU = 1536, PC_CV = 1792,
              PC_DQ = 2048, PC_DK = 2304, PC_DIQ = 2368, PC_DIK = 2496, PC_DIW = 2528;
constexpr int MOE_CAP = 16384;

constexpr size_t AL(size_t x) { return (x + 255) & ~(size_t)255; }
constexpr size_t WS_CTL = 0, CTL_BYTES = 65536;
constexpr size_t W_IN = AL(WS_CTL + CTL_BYTES);
constexpr size_t W_V = W_IN + (size_t)2560 * 1024 * 2;
constexpr size_t W_G = W_V + (size_t)512 * 1024 * 2;
constexpr size_t W_BR = W_G + (size_t)4096 * 1024 * 2;
constexpr size_t W_OUT = W_BR + (size_t)4 * 1024 * 256 * 2;
constexpr size_t W_Q = W_OUT + (size_t)1024 * 1024 * 2;
constexpr size_t W_O = W_Q + (size_t)256 * 1024 * 2;
constexpr size_t W_GU = W_O + (size_t)1024 * 256 * 2;
constexpr size_t W_D = W_GU + (size_t)32 * 512 * 1024 * 2;
constexpr size_t W_SGU = W_D + (size_t)32 * 1024 * 256 * 2;
constexpr size_t W_RT = W_SGU + (size_t)4 * 128 * 128 * 2;
constexpr size_t W_RH = W_RT + (size_t)36 * 1024 * 4;
constexpr size_t W_KV = W_RH + (size_t)2 * 64 * 1024 * 2;
constexpr size_t WS_H = W_KV + (size_t)DEPTH * 512 * 1024 * 2;
constexpr size_t WS_R1 = WS_H + (size_t)NTOK * 1024 * 2;
constexpr size_t R1_BYTES = (size_t)NTOK * 4096 * 2;
constexpr size_t WS_Y = WS_R1 + R1_BYTES;
constexpr size_t WS_HS = WS_Y + (size_t)NTOK * 1024 * 2;
constexpr size_t WS_HD = WS_HS + (size_t)NB * 64 * 4 * 4096 * 4;
constexpr size_t WS_THETA = WS_HD + (size_t)NB * 64 * 256 * 4;
constexpr size_t WS_MEMN = WS_THETA + (size_t)NTOK * 8;
constexpr size_t WS_MK = WS_MEMN + (size_t)DEPTH * 1024 * 1024 * 2;
constexpr size_t WS_MVT = WS_MK + (size_t)DEPTH * 1024 * 256 * 2;
constexpr size_t WS_TOKE = WS_MVT + (size_t)DEPTH * 256 * 1024 * 2;
constexpr size_t WS_TOKW = WS_TOKE + (size_t)NTOK * 2 * 4;
constexpr size_t WS_RANK = WS_TOKW + (size_t)NTOK * 2 * 4;
constexpr size_t WS_ROWTOK = WS_RANK + (size_t)NTOK * 2 * 4;
constexpr size_t WS_MASK = WS_ROWTOK + (size_t)32 * MOE_CAP * 4;
constexpr size_t WS_RSS = WS_MASK + (size_t)NB * 128 * 128 * 64 * 2;
constexpr size_t WS_DUMMY_BASE = WS_RSS + (size_t)NTOK * 16 * 4;
constexpr size_t WS_DUMMY_OLD = WS_MASK + (size_t)NB * 128 * 128 * 64 * 2;
constexpr size_t WS_DUMMY = WS_DUMMY_BASE;
constexpr size_t WS_END = WS_DUMMY + (size_t)32 * MOE_CAP * 4;
constexpr size_t R1_PROJ = 0, R1_VT = (size_t)NTOK * PROJ_LD * 2;
constexpr size_t R1_GS = 0, R1_PS = (size_t)256 * 65536 * 2, R1_MG = 2 * R1_PS;
constexpr size_t R1_MQ = 0, R1_MO = (size_t)NTOK * 256 * 2, R1_HID = 2 * R1_MO, R1_YB = R1_HID + (size_t)40960 * 256 * 2;
constexpr size_t R1_HIDS = R1_YB + (size_t)NTOK * 2 * 1024 * 2;
static_assert(R1_HIDS + (size_t)32 * 64 * 256 * 2 <= R1_BYTES, "R1 map");
static_assert(R1_YB + (size_t)NTOK * 2 * 1024 * 2 <= R1_BYTES, "R1 map");
static_assert(R1_VT + (size_t)512 * NTOK * 2 <= R1_BYTES, "R1 map");
constexpr int CW_BAR = 0;
constexpr int CW_KMAX = 4032;
constexpr int CW_CNT = 4096;

DI bf16_t f2bf(float f) { __bf16 b = (__bf16)f; return __builtin_bit_cast(bf16_t, b); }
DI float bf2f(bf16_t b) { return __uint_as_float(((unsigned)b) << 16); }
DI unsigned pk2(float a, float b) { f32x2 v = {a, b}; hbf2 r = __builtin_convertvector(v, hbf2); return __builtin_bit_cast(unsigned, r); }
DI float bflo(unsigned w) { return __uint_as_float(w << 16); }
DI float bfhi(unsigned w) { return __uint_as_float(w & 0xffff0000u); }
DI float sigmoidf_(float x) { return __builtin_amdgcn_rcpf(1.0f + __builtin_amdgcn_exp2f(-1.4426950408889634f * x)); }
DI float siluf_(float x) { return x * __builtin_amdgcn_rcpf(1.0f + __builtin_amdgcn_exp2f(-1.4426950408889634f * x)); }
DI float fexp(float x) { return __builtin_amdgcn_exp2f(1.4426950408889634f * x); }
DI float frcp(float x) { return __builtin_amdgcn_rcpf(x); }
DI float flog(float x) { return 0.6931471805599453f * __builtin_amdgcn_logf(x); }
DI float gelu_tanh(float x) { const float u = 0.7978845608028654f * (x + 0.044715f * x * x * x); return x * frcp(1.0f + fexp(-2.0f * u)); }
DI float wave_sum(float v) { for (int o = 32; o > 0; o >>= 1) v += __shfl_xor(v, o); return v; }
DI float xhalf_max(float x) { const u32x2 r = __builtin_amdgcn_permlane32_swap(__float_as_uint(x), __float_as_uint(x), false, false); return fmaxf(__uint_as_float(r.x), __uint_as_float(r.y)); }
DI float xhalf_sum(float x) { const u32x2 r = __builtin_amdgcn_permlane32_swap(__float_as_uint(x), __float_as_uint(x), false, false); return __uint_as_float(r.x) + __uint_as_float(r.y); }
DI f32x16 mfma32(bf16x8 a, bf16x8 b, f32x16 c) { return __builtin_amdgcn_mfma_f32_32x32x16_bf16(a, b, c, 0, 0, 0); }
DI int crow(int reg, int h) { return (reg & 3) + 8 * (reg >> 2) + 4 * h; }
DI f32x16 zero16() { f32x16 z; for (int i = 0; i < 16; ++i) z[i] = 0.f; return z; }

#define XB_TMO      128
#define XB_XCNT(j)  (256  + 64 * (j))
#define XB_XSUB(j)  (1280 + 64 * (j))
#define XB_XGEN(j)  (2304 + 64 * (j))
#define XB_TOP      3328
#define XB_TOPGEN   3392
#define XCD_BAR_WORDS 3456
#define XB_SPIN_CAP (1u << 22)

DI unsigned xb_ld(unsigned* p)              { return __hip_atomic_load(p, __ATOMIC_RELAXED, __HIP_MEMORY_SCOPE_AGENT); }
DI unsigned xb_add(unsigned* p, unsigned v) { return __hip_atomic_fetch_add(p, v, __ATOMIC_RELAXED, __HIP_MEMORY_SCOPE_AGENT); }
DI unsigned xb_xcc_id() { return (unsigned)__builtin_amdgcn_s_getreg((3 << 11) | 20) & 0xFu; }
#define XB_SPIN(cond, bar) do { unsigned _sp = 0; while (cond) { __builtin_amdgcn_s_sleep(1); \
    if ((++_sp & 255u) == 0u) { if (xb_ld(&(bar)[XB_TMO])) break; if (_sp > XB_SPIN_CAP) { atomicAdd(&(bar)[XB_TMO], 1u); break; } } } } while (0)

struct XcdBarrier { unsigned* bar; unsigned x; volatile LAS unsigned* st; };

DI XcdBarrier xcd_barrier_post(unsigned* bar, volatile LAS unsigned* st) {
    XcdBarrier b; b.bar = bar; b.x = xb_xcc_id(); b.st = st;
    if (threadIdx.x == 0) (void)xb_add(&bar[XB_XCNT(b.x)], 1u);
    return b;
}
DI void xcd_barrier_complete(unsigned* bar, unsigned x, unsigned& nloc, unsigned& nx) {
    const unsigned G = gridDim.x * gridDim.y * gridDim.z;
    unsigned sum, cnt, mine, sp = 0u;
    for (;;) {
        sum = 0u; cnt = 0u; mine = 0u;
#pragma unroll
        for (unsigned j = 0; j < 16; ++j) { const unsigned c = xb_ld(&bar[XB_XCNT(j)]); sum += c; cnt += (c > 0u) ? 1u : 0u; mine = (j == x) ? c : mine; }
        if (sum == G) break;
        __builtin_amdgcn_s_sleep(1);
        if ((++sp & 255u) == 0u) { if (xb_ld(&bar[XB_TMO])) break; if (sp > XB_SPIN_CAP) { atomicAdd(&bar[XB_TMO], 1u); break; } }
    }
    nloc = mine > 0u ? mine : 1u; nx = cnt > 0u ? cnt : 1u;
}
DI void xcd_barrier(const XcdBarrier& b) {
    asm volatile("s_waitcnt vmcnt(0)" ::: "memory");
    __syncthreads();
    if (threadIdx.x == 0) {
        unsigned* bar = b.bar;
        __builtin_amdgcn_s_waitcnt(0);
        unsigned nloc = b.st[0], nx = b.st[1];
        if (nloc == 0u) { xcd_barrier_complete(bar, b.x, nloc, nx); b.st[0] = nloc; b.st[1] = nx; }
        const unsigned old = xb_add(&bar[XB_XSUB(b.x)], 1u);
        const unsigned gen = old / nloc;
        if (old + 1u == (gen + 1u) * nloc) {
            __builtin_amdgcn_fence(__ATOMIC_RELEASE, "agent");
            asm volatile("s_waitcnt vmcnt(0)" ::: "memory");
            const unsigned og = xb_add(&bar[XB_TOP], 1u);
            const unsigned tg = og / nx;
            if (og + 1u == (tg + 1u) * nx) xb_add(&bar[XB_TOPGEN], 1u);
            else XB_SPIN(xb_ld(&bar[XB_TOPGEN]) == tg, bar);
            __builtin_amdgcn_fence(__ATOMIC_ACQUIRE, "agent");
            xb_add(&bar[XB_XGEN(b.x)], 1u);
            asm volatile("s_waitcnt vmcnt(0)" ::: "memory");
        } else {
            XB_SPIN(xb_ld(&bar[XB_XGEN(b.x)]) == gen, bar);
            __builtin_amdgcn_fence(__ATOMIC_ACQUIRE, "agent");
            asm volatile("s_waitcnt vmcnt(0)" ::: "memory");
        }
    }
    __syncthreads();
}
namespace pg8 {
constexpr int BM = 256, BK = 64, HALF = 128, HTB = HALF * BK * 2, STAGE_BYTES = 8 * HTB, NXCD = 8, WGM = 8;
DI int lds_byte(int r, int c) { const int st = (r >> 4) * 2 + (c >> 5), rr = r & 15, cc = c & 31, ob = rr * 64 + cc * 2; return st * 1024 + (ob ^ (((ob >> 9) & 1) << 5)); }
DI void stage_rc(int b, int& R, int& C) { const int st = b / 1024, sb = b % 1024, swz = sb ^ (((sb >> 9) & 1) << 5); R = (st >> 1) * 16 + swz / 64; C = (st & 1) * 32 + (swz % 64) / 2; }
DI int perm32(int rho) { const int n = rho >> 4, i = rho & 15; return 8 * (i >> 2) + 4 * n + (i & 3); }

struct Unit { const char* a; const char* b; int pm, pn, x, y, nt; };

DI void tile_map(int L, int nM, int nN, int& pm, int& pn) {
    const int nwg = nM * nN; int wgid = L;
    { const int q = nwg / NXCD, r = nwg % NXCD, xcd = wgid % NXCD, off = wgid / NXCD; wgid = (xcd < r ? xcd * (q + 1) : r * (q + 1) + (xcd - r) * q) + off; }
    const int nig = WGM * nN, gid = wgid / nig, fm = gid * WGM, gsz = (nM - fm) < WGM ? (nM - fm) : WGM;
    pm = fm + ((wgid % nig) % gsz); pn = (wgid % nig) / gsz;
}
struct DenseOrder {
    const char* A; const char* B; size_t at, bt; int nM, nN, nwg, G, c;
    DI void init(const void* A_, const void* B_, int M, int N, int lda, int ldb, int G_, int c_) {
        A = (const char*)A_; B = (const char*)B_; at = (size_t)BM * lda * 2; bt = (size_t)BM * ldb * 2; nM = M / BM; nN = N / BM; nwg = nM * nN; G = G_; c = c_; }
    DI bool next(int i, Unit& u) const {
        const long L = (long)i * G + c; if (L >= nwg) return false;
        tile_map((int)L, nM, nN, u.pm, u.pn); u.a = A + (size_t)u.pm * at; u.b = B + (size_t)u.pn * bt; u.x = 0; u.y = 0; u.nt = 0; return true; }
    DI unsigned row_off(const Unit&, int) const { return 0u; }
};

#define PG8_WAIT_V(n) asm volatile("s_waitcnt vmcnt(" #n ")" ::: "memory")
#define PG8_WAIT_L(n) asm volatile("s_waitcnt lgkmcnt(" #n ")" ::: "memory")
#define PG8_BAR __builtin_amdgcn_s_barrier()
#define PG8_SCHED __builtin_amdgcn_sched_barrier(0)

template <class Epi, class Sched, bool GATHER>
DI void gemm_phase(const int tid, LAS unsigned char* lds, const int lda, const int ldb, const int K, const Sched& S, const Epi& E) {
    const int wid = __builtin_amdgcn_readfirstlane(tid >> 6), lane = tid & 63, wr = wid >> 2, wc = wid & 3, fr = lane & 15, fq = lane >> 4;
    const int nt_phase = K / BK;
    unsigned voffA[2], voffB[2]; int RA[2], CA[2];
#pragma unroll
    for (int i = 0; i < 2; ++i) { int R, C; stage_rc(tid * 16 + i * 8192, R, C); const int Rb = (R & ~31) + perm32(R & 31);
        RA[i] = R; CA[i] = C; voffA[i] = (unsigned)(R * lda + C) * 2u; voffB[i] = (unsigned)(Rb * ldb + C) * 2u; }
    const size_t kstep = (size_t)(BK * 2);
    const size_t hstepA = (size_t)HALF * lda * 2, hstepB = (size_t)HALF * ldb * 2;
    const unsigned ldsw = (unsigned)wid * 1024u;
    const int aoff = lds_byte(wr * 64 + fr, fq * 8), boff = lds_byte(wc * 32 + fr, fq * 8);
    unsigned vc[2][2], vn[2][2];
#define PG8_SA(b, h) (((b) * 2 + (h)) * HTB)
#define PG8_SB(b, h) ((4 + (b) * 2 + (h)) * HTB)
#define PG8_GL(bufoff, gptr, vo, _i) __builtin_amdgcn_global_load_lds((const unsigned*)((const char*)(gptr) + (vo)), (LAS unsigned*)(lds + (bufoff) + ldsw + (_i) * 8192), 16, 0, 0)
#define PG8_STAGE_B(bufoff, gbase) do { PG8_GL(bufoff, gbase, voffB[0], 0); PG8_GL(bufoff, gbase, voffB[1], 1); } while (0)
#define PG8_STAGE_A(bufoff, kptr, h, isnext) do { if constexpr (GATHER) { const unsigned _o0 = (isnext) ? vn[h][0] : vc[h][0], _o1 = (isnext) ? vn[h][1] : vc[h][1]; PG8_GL(bufoff, kptr, _o0, 0); PG8_GL(bufoff, kptr, _o1, 1); } \
        else { PG8_GL(bufoff, (kptr) + (h) * hstepA, voffA[0], 0); PG8_GL(bufoff, (kptr) + (h) * hstepA, voffA[1], 1); } } while (0)
#define PG8_LDA(dst, b, h) do { _Pragma("unroll") for (int m = 0; m < 4; ++m) _Pragma("unroll") for (int k = 0; k < 2; ++k) dst[m][k] = *(const LAS bf16x8*)(lds + PG8_SA(b, h) + aoff + m * 2048 + k * 1024); } while (0)
#define PG8_LDB(dst, b, h) do { _Pragma("unroll") for (int n = 0; n < 2; ++n) _Pragma("unroll") for (int k = 0; k < 2; ++k) dst[n][k] = *(const LAS bf16x8*)(lds + PG8_SB(b, h) + boff + n * 2048 + k * 1024); } while (0)
#define PG8_MMA(ai, bj, At, Bt) do { __builtin_amdgcn_s_setprio(1); _Pragma("unroll") for (int m = 0; m < 4; ++m) _Pragma("unroll") for (int n = 0; n < 2; ++n) _Pragma("unroll") for (int k = 0; k < 2; ++k) \
        acc[ai][bj][m][n] = __builtin_amdgcn_mfma_f32_16x16x32_bf16(Bt[n][k], At[m][k], acc[ai][bj][m][n], 0, 0, 0); __builtin_amdgcn_s_setprio(0); } while (0)
    Unit cur, nxt; int ui = 0;
    if (!S.next(0, cur)) return;
    f32x4 acc[2][2][4][2];
#pragma unroll
    for (int a = 0; a < 2; ++a)
#pragma unroll
        for (int b = 0; b < 2; ++b)
#pragma unroll
            for (int m = 0; m < 4; ++m)
#pragma unroll
                for (int n = 0; n < 2; ++n) acc[a][b][m][n] = (f32x4){0.f, 0.f, 0.f, 0.f};
    bf16x8 At[4][2], B0[2][2], B1[2][2];
    const char* cA = cur.a; const char* cB = cur.b;
    if constexpr (GATHER) {
#pragma unroll
        for (int h = 0; h < 2; ++h)
#pragma unroll
            for (int i = 0; i < 2; ++i) { vc[h][i] = S.row_off(cur, RA[i] + h * HALF) + (unsigned)CA[i] * 2u; vn[h][i] = vc[h][i]; }
    }
    PG8_STAGE_B(PG8_SB(0, 0), cB); PG8_STAGE_A(PG8_SA(0, 0), cA, 0, false); PG8_STAGE_B(PG8_SB(0, 1), cB + hstepB); PG8_STAGE_A(PG8_SA(0, 1), cA, 1, false);
    if (wr == 1) PG8_BAR;
    PG8_WAIT_V(4); PG8_BAR;
    PG8_STAGE_B(PG8_SB(1, 0), cB + kstep); PG8_STAGE_A(PG8_SA(1, 0), cA + kstep, 0, false); PG8_STAGE_B(PG8_SB(1, 1), cB + hstepB + kstep);
    PG8_WAIT_V(6); PG8_BAR;
    for (;;) {
        const bool has_next = S.next(ui + 1, nxt);
        const char* nA = has_next ? nxt.a : cA; const char* nB = has_next ? nxt.b : cB;
        if constexpr (GATHER) {
            if (has_next) {
#pragma unroll
                for (int h = 0; h < 2; ++h)
#pragma unroll
                    for (int i = 0; i < 2; ++i) vn[h][i] = S.row_off(nxt, RA[i] + h * HALF) + (unsigned)CA[i] * 2u;
            }
        }
        const int nt = cur.nt ? cur.nt : nt_phase;
        for (int t = 0; t < nt; t += 2) {
            const bool last = (t == nt - 2);
            int tq = t; asm volatile("" : "+s"(tq));
            const char* a1 = cA + (size_t)(tq + 1) * kstep;
            const char* a2 = last ? nA : cA + (size_t)(tq + 2) * kstep; const char* b2 = last ? nB : cB + (size_t)(tq + 2) * kstep;
            const char* a3 = a2 + kstep; const char* b3 = b2 + kstep;
            PG8_LDB(B0, 0, 0); PG8_SCHED; PG8_LDA(At, 0, 0); PG8_STAGE_A(PG8_SA(1, 1), a1, 1, false);
            PG8_WAIT_L(8); PG8_BAR; PG8_WAIT_L(0); PG8_MMA(0, 0, At, B0); PG8_BAR; PG8_SCHED;
            PG8_LDB(B1, 0, 1); PG8_STAGE_B(PG8_SB(0, 0), b2);
            PG8_BAR; PG8_WAIT_L(0); PG8_MMA(0, 1, At, B1); PG8_BAR;
            PG8_LDA(At, 0, 1); PG8_STAGE_A(PG8_SA(0, 0), a2, 0, last);
            PG8_BAR; PG8_WAIT_L(0); PG8_MMA(1, 0, At, B0); PG8_BAR; PG8_SCHED;
            PG8_STAGE_B(PG8_SB(0, 1), b2 + hstepB);
            PG8_WAIT_V(6); PG8_BAR; PG8_MMA(1, 1, At, B1); PG8_BAR;
            PG8_LDB(B0, 1, 0); PG8_SCHED; PG8_LDA(At, 1, 0); PG8_STAGE_A(PG8_SA(0, 1), a2, 1, last);
            PG8_WAIT_L(8); PG8_BAR; PG8_WAIT_L(0); PG8_MMA(0, 0, At, B0); PG8_BAR; PG8_SCHED;
            PG8_LDB(B1, 1, 1); PG8_STAGE_B(PG8_SB(1, 0), b3);
            PG8_BAR; PG8_WAIT_L(0); PG8_MMA(0, 1, At, B1); PG8_BAR;
            PG8_LDA(At, 1, 1); PG8_STAGE_A(PG8_SA(1, 0), a3, 0, last);
            PG8_BAR; PG8_WAIT_L(0); PG8_MMA(1, 0, At, B0); PG8_BAR; PG8_SCHED;
            PG8_STAGE_B(PG8_SB(1, 1), b3 + hstepB);
            PG8_WAIT_V(6); PG8_BAR; PG8_MMA(1, 1, At, B1); PG8_BAR;
        }
        { int ln2 = lane; asm volatile("" : "+v"(ln2)); E(acc, cur, wr, wc, ln2 & 15, ln2 >> 4); }
        if (!has_next) break;
#pragma unroll
        for (int a = 0; a < 2; ++a)
#pragma unroll
            for (int b = 0; b < 2; ++b)
#pragma unroll
                for (int m = 0; m < 4; ++m)
#pragma unroll
                    for (int n = 0; n < 2; ++n) acc[a][b][m][n] = (f32x4){0.f, 0.f, 0.f, 0.f};
        cur = nxt; cA = nA; cB = nB; ++ui;
        if constexpr (GATHER) {
#pragma unroll
            for (int h = 0; h < 2; ++h)
#pragma unroll
                for (int i = 0; i < 2; ++i) vc[h][i] = vn[h][i];
        }
    }
    PG8_WAIT_V(0);
    if (wr == 0) PG8_BAR;
    PG8_BAR;
#undef PG8_SA
#undef PG8_SB
#undef PG8_GL
#undef PG8_STAGE_A
#undef PG8_STAGE_B
#undef PG8_LDA
#undef PG8_LDB
#undef PG8_MMA
}
}
struct Params {
    const float* x; const float* mem; const int* positions;
    const float* norm_mix; const float* w_in; const float* diff_lambda; const float* hgrn_lb; const float* spatial_w; const float* spatial_b;
    const float* w_branch; const float* w_out; const float* norm_mem_q; const float* norm_mem_kv; const float* w_mem_q; const float* w_mem_kv; const float* w_mem_o;
    const float* norm_ffn; const float* w_rg; const float* b_rg; const float* w_re; const float* b_re; const float* w_eg; const float* w_eu; const float* w_ed; const float* norm_final;
    float* out; unsigned char* ws; int ph_lo, ph_hi;
};
struct Ctx {
    LAS unsigned char* lds; int tid, lane, wave, G, bid;
};
DI Ctx relaunder(const Ctx& C) { Ctx D = C; int w = C.wave, g = C.G, bi = C.bid; asm volatile("" : "+s"(w), "+s"(g), "+s"(bi)); D.wave = w; D.G = g; D.bid = bi; int ln; asm volatile("v_mbcnt_lo_u32_b32 %0, -1, 0\n\tv_mbcnt_hi_u32_b32 %0, -1, %0" : "=v"(ln)); D.lane = ln; D.tid = w * 64 + ln; return D; }
template <class T> DI T* wsp(const Params& P, size_t off) { return (T*)(P.ws + off); }

struct CvtJob { const float* src; bf16_t* dst; int ld_src, ncols, K, ld_dst, nb1, nb2; long ss1, ds1, ss2, ds2; const float* kscale; };
DI void cvt_transpose(const Ctx& C, const CvtJob& J) {
    LAS float* T = (LAS float*)C.lds;
    const int tn = (J.ncols + 63) >> 6, tk = J.K >> 6, per = tn * tk, total = per * J.nb1 * J.nb2;
    for (int t = C.bid; t < total; t += C.G) {
        const int bb = t / per, r = t % per, b1 = bb / J.nb2, b2 = bb % J.nb2, in_ = r / tk, ik = r % tk;
        const float* src = J.src + (size_t)b1 * J.ss1 + (size_t)b2 * J.ss2; bf16_t* dst = J.dst + (size_t)b1 * J.ds1 + (size_t)b2 * J.ds2;
        const int n0 = in_ * 64, k0 = ik * 64;
        { const int k = C.tid >> 3, c8 = (C.tid & 7) * 8;
#pragma unroll
          for (int v = 0; v < 2; ++v) { const int n = n0 + c8 + v * 4;
              f32x4 x = (f32x4){0.f, 0.f, 0.f, 0.f};
              if (n < J.ncols) x = *(const f32x4*)(src + (size_t)(k0 + k) * J.ld_src + n);
              if (J.kscale) { const float g = J.kscale[k0 + k]; x[0] *= g; x[1] *= g; x[2] *= g; x[3] *= g; }
#pragma unroll
              for (int j = 0; j < 4; ++j) T[(c8 + v * 4 + j) * 65 + k] = x[j]; } }
        __syncthreads();
        { const int n = C.tid >> 3, k8 = (C.tid & 7) * 8;
          if (n0 + n < J.ncols) { u32x4 w;
#pragma unroll
              for (int j = 0; j < 4; ++j) w[j] = pk2(T[n * 65 + k8 + 2 * j], T[n * 65 + k8 + 2 * j + 1]);
              *(u32x4*)(dst + (size_t)(n0 + n) * J.ld_dst + k0 + k8) = w; } }
        __syncthreads();
    }
}
DI CvtJob mkjob(const float* src, bf16_t* dst, int ld_src, int ncols, int K, int ld_dst, int nb1 = 1, long ss1 = 0, long ds1 = 0, int nb2 = 1, long ss2 = 0, long ds2 = 0) {
    CvtJob J; J.src = src; J.dst = dst; J.ld_src = ld_src; J.ncols = ncols; J.K = K; J.ld_dst = ld_dst; J.nb1 = nb1; J.nb2 = nb2; J.ss1 = ss1; J.ds1 = ds1; J.ss2 = ss2; J.ds2 = ds2; J.kscale = nullptr; return J; }

DI void phase_convert_layer(const Ctx& C, const Params& P, int l) {
    const float* win = P.w_in + (size_t)l * 1024 * IN_WIDTH;
    bf16_t* WIN = wsp<bf16_t>(P, W_IN); bf16_t* WV = wsp<bf16_t>(P, W_V);
    cvt_transpose(C, mkjob(win + 0, WIN, IN_WIDTH, 512, 1024, 1024));
    cvt_transpose(C, mkjob(win + 768, WIN + (size_t)512 * 1024, IN_WIDTH, 1856, 1024, 1024));
    cvt_transpose(C, mkjob(win + 2688, WIN + (size_t)2368 * 1024, IN_WIDTH, 164, 1024, 1024));
    cvt_transpose(C, mkjob(win + 512, WV, IN_WIDTH, 256, 1024, 1024));
    cvt_transpose(C, mkjob(win + 2624, WV + (size_t)256 * 1024, IN_WIDTH, 64, 1024, 1024));
    cvt_transpose(C, mkjob(win + 2852, wsp<bf16_t>(P, W_G), IN_WIDTH, 4096, 1024, 1024));
    cvt_transpose(C, mkjob(P.w_branch + (size_t)l * 4 * 256 * 1024, wsp<bf16_t>(P, W_BR), 1024, 1024, 256, 1024, 4, 256 * 1024, 256));
    cvt_transpose(C, mkjob(P.w_out + (size_t)l * 1024 * 1024, wsp<bf16_t>(P, W_OUT), 1024, 1024, 1024, 1024));
    { CvtJob J = mkjob(P.w_mem_q + (size_t)l * 1024 * 256, wsp<bf16_t>(P, W_Q), 256, 256, 1024, 1024); J.kscale = P.norm_mem_q + l * DM; cvt_transpose(C, J); }
    cvt_transpose(C, mkjob(P.w_mem_o + (size_t)l * 256 * 1024, wsp<bf16_t>(P, W_O), 1024, 1024, 256, 256));
    cvt_transpose(C, mkjob(P.w_eg + (size_t)l * 32 * 1024 * 256, wsp<bf16_t>(P, W_GU), 256, 128, 1024, 1024, 32, 1024 * 256, 512 * 1024, 2, 128, 256 * 1024));
    cvt_transpose(C, mkjob(P.w_eu + (size_t)l * 32 * 1024 * 256, wsp<bf16_t>(P, W_GU) + (size_t)128 * 1024, 256, 128, 1024, 1024, 32, 1024 * 256, 512 * 1024, 2, 128, 256 * 1024));
    cvt_transpose(C, mkjob(P.w_ed + (size_t)l * 32 * 256 * 1024, wsp<bf16_t>(P, W_D), 1024, 1024, 256, 256, 32, 256 * 1024, 1024 * 256));
    { bf16_t* z0 = WIN + (size_t)2532 * 1024; for (int i = C.bid * NTHREADS + C.tid; i < 28 * 1024; i += C.G * NTHREADS) z0[i] = 0;
      bf16_t* z1 = WV + (size_t)320 * 1024; for (int i = C.bid * NTHREADS + C.tid; i < 192 * 1024; i += C.G * NTHREADS) z1[i] = 0; }
    { bf16_t* rh = wsp<bf16_t>(P, W_RH); const float* wre = P.w_re + (size_t)l * 1024 * 32; const float* wrg = P.w_rg + (size_t)l * 1024 * 4;
      for (int i = C.bid * NTHREADS + C.tid; i < 64 * 1024; i += C.G * NTHREADS) { const int j = i >> 10, k = i & 1023;
          const float w = (j < 32) ? wre[k * 32 + j] : (j < 36 ? wrg[k * 4 + (j - 32)] : 0.f);
          const bf16_t hi = f2bf(w); rh[i] = hi; rh[64 * 1024 + i] = f2bf(w - bf2f(hi)); } }
    { const float* sw = P.spatial_w + (size_t)l * 4 * 128 * 128; bf16_t* d = wsp<bf16_t>(P, W_SGU);
      for (int i = C.bid * NTHREADS + C.tid; i < 4 * 128 * 128; i += C.G * NTHREADS) { const int s = i & 127, t = (i >> 7) & 127; d[i] = (s <= t) ? f2bf(sw[i]) : (bf16_t)0; } }
}

DI void phase_prologue(const Ctx& C, const Params& P) {
    for (int r = C.bid * NWAVES + C.wave; r < NB * MEMLEN; r += C.G * NWAVES) {
        const float* src = P.mem + (size_t)r * DM; f32x4 v[4]; float ss = 0.f;
#pragma unroll
        for (int j = 0; j < 4; ++j) { v[j] = *(const f32x4*)(src + j * 256 + C.lane * 4); ss += v[j][0] * v[j][0] + v[j][1] * v[j][1] + v[j][2] * v[j][2] + v[j][3] * v[j][3]; }
        ss = wave_sum(ss); const float rs = 1.0f / sqrtf(ss * (1.0f / DM) + 1e-6f);
        for (int l = 0; l < DEPTH; ++l) { bf16_t* dst = wsp<bf16_t>(P, WS_MEMN) + ((size_t)l * 1024 + r) * DM;
#pragma unroll
            for (int j = 0; j < 4; ++j) { const f32x4 g = *(const f32x4*)(P.norm_mem_kv + l * DM + j * 256 + C.lane * 4);
                u32x2 w; w.x = pk2(v[j][0] * rs * g[0], v[j][1] * rs * g[1]); w.y = pk2(v[j][2] * rs * g[2], v[j][3] * rs * g[3]);
                *(u32x2*)(dst + j * 256 + C.lane * 4) = w; } }
    }
    for (int l = 0; l < DEPTH; ++l)
        cvt_transpose(C, mkjob(P.w_mem_kv + (size_t)l * 1024 * 512, wsp<bf16_t>(P, W_KV) + (size_t)l * 512 * 1024, 512, 512, 1024, 1024));
}

template <bool ADD_YB, bool WRITE_H, bool FINAL, bool FROM_X = false>
DI void phase_rownorm(const Ctx& C, const Params& P, const float* gain) {
    float* XR = P.out; bf16_t* H = wsp<bf16_t>(P, WS_H); const bf16_t* YB = (const bf16_t*)(P.ws + WS_R1 + R1_YB);
    const int stride = C.G * NWAVES; int t = C.bid * NWAVES + C.wave;
    f32x4 v[4], vn[4]; u32x2 ya[4], yb[4], yan[4], ybn[4];
#define RN_LOAD(dst, da, db, tt) do { const float* src_ = (FROM_X ? P.x : (const float*)XR) + (size_t)(tt) * DM; _Pragma("unroll") for (int j = 0; j < 4; ++j) { const int c = j * 256 + C.lane * 4; dst[j] = *(const f32x4*)(src_ + c); \
        if constexpr (ADD_YB) { da[j] = *(const u32x2*)(YB + (size_t)(2 * (tt)) * DM + c); db[j] = *(const u32x2*)(YB + (size_t)(2 * (tt) + 1) * DM + c); } } } while (0)
    if (t < NTOK) RN_LOAD(v, ya, yb, t);
    for (; t < NTOK; t += stride) {
        const int tn = (t + stride < NTOK) ? t + stride : t;
        RN_LOAD(vn, yan, ybn, tn);
        float* xr = XR + (size_t)t * DM; float ss = 0.f;
#pragma unroll
        for (int j = 0; j < 4; ++j) { const int c = j * 256 + C.lane * 4;
            if constexpr (ADD_YB) { const u32x2 a = ya[j], b = yb[j];
                v[j][0] += bflo(a.x) + bflo(b.x); v[j][1] += bfhi(a.x) + bfhi(b.x); v[j][2] += bflo(a.y) + bflo(b.y); v[j][3] += bfhi(a.y) + bfhi(b.y); }
            if constexpr ((ADD_YB && !FINAL) || FROM_X) *(f32x4*)(xr + c) = v[j];
            ss += v[j][0] * v[j][0] + v[j][1] * v[j][1] + v[j][2] * v[j][2] + v[j][3] * v[j][3]; }
        ss = wave_sum(ss); const float rs = 1.0f / sqrtf(ss * (1.0f / DM) + 1e-6f);
#pragma unroll
        for (int j = 0; j < 4; ++j) { const int c = j * 256 + C.lane * 4; const f32x4 g = *(const f32x4*)(gain + c);
            const f32x4 o = (f32x4){v[j][0] * rs * g[0], v[j][1] * rs * g[1], v[j][2] * rs * g[2], v[j][3] * rs * g[3]};
            if constexpr (FINAL) *(f32x4*)(xr + c) = o;
            if constexpr (WRITE_H) { u32x2 w; w.x = pk2(o[0], o[1]); w.y = pk2(o[2], o[3]); *(u32x2*)(H + (size_t)t * DM + c) = w; } }
#pragma unroll
        for (int j = 0; j < 4; ++j) { v[j] = vn[j]; if constexpr (ADD_YB) { ya[j] = yan[j]; yb[j] = ybn[j]; } }
    }
#undef RN_LOAD
}

DI void phase_rope(const Ctx& C, const Params& P, const int l, const bool dry = false) {
    bf16_t* PROJ = (bf16_t*)(P.ws + WS_R1 + R1_PROJ);
    LAS f32x2* tab = (LAS f32x2*)(C.lds) + C.wave * 64;
    float kmx[4] = {0.f, 0.f, 0.f, 0.f};
    for (int t = C.bid * NWAVES + C.wave; t < NTOK; t += C.G * NWAVES) {
        const float pos = (float)P.positions[t];
        if (C.lane < 48) { const int i = C.lane < 16 ? C.lane : C.lane - 16; const float d = C.lane < 16 ? 32.f : 64.f;
            const float inv = powf(10000.0f, -(float)i * (2.0f / d)); const float ang = pos * inv; float s, c; sincosf(ang, &s, &c); tab[C.lane] = (f32x2){c, s}; }
        __builtin_amdgcn_wave_barrier();
        asm volatile("s_waitcnt lgkmcnt(0)" ::: "memory");
        bf16_t* row = PROJ + (size_t)t * PROJ_LD;
        { const float kv = (C.lane < 32) ? bf2f(row[PC_DIK + C.lane]) : 0.f; const float k2 = wave_sum(kv * kv); const int bb = t >> 12;
#pragma unroll
          for (int q = 0; q < 4; ++q) kmx[q] = (bb == q) ? fmaxf(kmx[q], k2) : kmx[q]; }
        for (int p = C.lane; p < 496; p += 64) {
            int col, half, ti;
            if (p < 256) { col = (p >> 4) * 32 + (p & 15); half = 16; ti = p & 15; }
            else if (p < 416) { const int q = p - 256; col = PC_DQ + (q >> 5) * 64 + (q & 31); half = 32; ti = 16 + (q & 31); }
            else { const int q = p - 416; col = PC_DIQ + (q >> 4) * 32 + (q & 15); half = 16; ti = q & 15; }
            const f32x2 cs = tab[ti]; const float x1 = bf2f(row[col]), x2 = bf2f(row[col + half]);
            if (!dry || pos < -1.0f) { row[col] = f2bf(x1 * cs.x - x2 * cs.y); row[col + half] = f2bf(x2 * cs.x + x1 * cs.y); }
        }
        __builtin_amdgcn_wave_barrier();
    }
    { LAS unsigned* km = (LAS unsigned*)(C.lds + 8192);
      __syncthreads();
      if (C.tid < 4) km[C.tid] = 0u;
      __syncthreads();
      if (C.lane < 4) { float v = 0.f;
#pragma unroll
          for (int q = 0; q < 4; ++q) v = (C.lane == q) ? kmx[q] : v;
          __hip_atomic_fetch_max(km + C.lane, __float_as_uint(v), __ATOMIC_RELAXED, __HIP_MEMORY_SCOPE_WORKGROUP); }
      __syncthreads();
      if (C.tid < 4 && !dry) atomicMax(wsp<unsigned>(P, WS_CTL) + CW_KMAX + 8 * l + C.tid, (unsigned)km[C.tid]);
      __syncthreads(); }
}
DI void sm_step(f32x16& st, const float c, float& m, float& l, f32x16& O0, f32x16& O1, bf16x8& p0, bf16x8& p1) {
    float mx = st[0];
#pragma unroll
    for (int i = 1; i < 16; ++i) mx = fmaxf(mx, st[i]);
    mx = fmaxf(mx, __shfl_xor(mx, 32));
    if (__any(mx > m)) { const float mn = fmaxf(m, mx); const float a = __builtin_amdgcn_exp2f((m - mn) * c); l *= a;
#pragma unroll
        for (int i = 0; i < 16; ++i) { O0[i] *= a; O1[i] *= a; }
        m = mn; }
    const float mc = m * c; float rs = 0.f;
#pragma unroll
    for (int i = 0; i < 16; ++i) { const float p = __builtin_amdgcn_exp2f(fmaf(st[i], c, -mc)); st[i] = p; rs += p; }
    l += rs;
    u32x4 a, b;
    a.x = pk2(st[0], st[1]); a.y = pk2(st[2], st[3]); a.z = pk2(st[4], st[5]); a.w = pk2(st[6], st[7]);
    b.x = pk2(st[8], st[9]); b.y = pk2(st[10], st[11]); b.z = pk2(st[12], st[13]); b.w = pk2(st[14], st[15]);
    p0 = __builtin_bit_cast(bf16x8, a); p1 = __builtin_bit_cast(bf16x8, b);
}
DI void apply_mask(f32x16& st, unsigned vmask) {
#pragma unroll
    for (int i = 0; i < 16; ++i) { const unsigned sel = (unsigned)__builtin_amdgcn_sbfe((int)vmask, i, 1);
        st[i] = __uint_as_float((__float_as_uint(st[i]) & sel) | (__float_as_uint(-3.0e38f) & ~sel)); }
}
DI bf16x8 vt_frag(const bf16_t* vt_row, int k0, int s2, int h) {
    const bf16_t* p = vt_row + k0 + 16 * s2 + 4 * h; const u32x2 lo = *(const u32x2*)p, hi = *(const u32x2*)(p + 8);
    u32x4 w; w.x = lo.x; w.y = lo.y; w.z = hi.x; w.w = hi.y; return __builtin_bit_cast(bf16x8, w);
}
DI unsigned causal_mask(int r, int h) { unsigned m = 0;
#pragma unroll
    for (int i = 0; i < 16; ++i) m |= (crow(i, h) <= r) ? (1u << i) : 0u;
    return m; }
DI void causal_wave_unit(int c, int w, int& bh, int& qs) { const int pi = c * 4 + (w & 3); bh = (pi >> 6) & 15; const int j = pi & 63; qs = (w < 4) ? 127 - j : j; }

struct DiffKV { bf16x8 kf[2][2]; bf16x8 vf[2][2]; };
DI void diff_load(DiffKV& t, const bf16_t* kbase, const bf16_t* vrow0, const bf16_t* vrow1, int k0, int r, int h) {
    const bf16_t* kp = kbase + (size_t)(k0 + r) * PROJ_LD + 8 * h;
#pragma unroll
    for (int m = 0; m < 2; ++m)
#pragma unroll
        for (int s = 0; s < 2; ++s) t.kf[m][s] = *(const bf16x8*)(kp + m * 32 + 16 * s);
#pragma unroll
    for (int s2 = 0; s2 < 2; ++s2) { t.vf[0][s2] = vt_frag(vrow0, k0, s2, h); t.vf[1][s2] = vt_frag(vrow1, k0, s2, h); }
}
DI void diff_step(const DiffKV& t, const bf16x8 (&qf)[2][2], bool diag, unsigned dmask, const float c, float (&mm)[2], float (&ll)[2], f32x16 (&O)[2][2]) {
#pragma unroll
    for (int m = 0; m < 2; ++m) {
        f32x16 st = mfma32(t.kf[m][0], qf[m][0], zero16()); st = mfma32(t.kf[m][1], qf[m][1], st);
        if (diag) apply_mask(st, dmask);
        bf16x8 p0, p1; sm_step(st, c, mm[m], ll[m], O[m][0], O[m][1], p0, p1);
        O[m][0] = mfma32(t.vf[0][0], p0, O[m][0]); O[m][0] = mfma32(t.vf[0][1], p1, O[m][0]);
        O[m][1] = mfma32(t.vf[1][0], p0, O[m][1]); O[m][1] = mfma32(t.vf[1][1], p1, O[m][1]);
    }
}
DI void diff_attn_wave(const Ctx& C, const Params& P, int l) {
    const bf16_t* PROJ = (const bf16_t*)(P.ws + WS_R1 + R1_PROJ); const bf16_t* VT = (const bf16_t*)(P.ws + WS_R1 + R1_VT); bf16_t* Y = wsp<bf16_t>(P, WS_Y);
    int bh, qs; causal_wave_unit(C.bid, C.wave, bh, qs);
    const int b = bh >> 2, hd = bh & 3, r = C.lane & 31, h = C.lane >> 5, tokb = b * SEQ, q0 = qs * 32, t = q0 + r;
    const float* lv = P.diff_lambda + l * 128;
    const float d1 = wave_sum(C.lane < 32 ? lv[C.lane] * lv[32 + C.lane] : 0.f), d2 = wave_sum(C.lane < 32 ? lv[64 + C.lane] * lv[96 + C.lane] : 0.f);
    const float lam_init = 0.8f - 0.6f * expf(-0.3f * (float)l), lam = expf(d1) - expf(d2) + lam_init;
    bf16x8 qf[2][2];
#pragma unroll
    for (int m = 0; m < 2; ++m)
#pragma unroll
        for (int s = 0; s < 2; ++s) qf[m][s] = *(const bf16x8*)(PROJ + (size_t)(tokb + t) * PROJ_LD + PC_AQ + hd * 64 + m * 32 + 16 * s + 8 * h);
    f32x16 O[2][2]; float mm[2] = {-1e30f, -1e30f}, ll[2] = {0.f, 0.f};
#pragma unroll
    for (int m = 0; m < 2; ++m) { O[m][0] = zero16(); O[m][1] = zero16(); }
    const float c = 0.17677669529663687f * 1.4426950408889634f;
    const int nkt = qs + 1; const unsigned dmask = causal_mask(r, h);
    const bf16_t* kbase = PROJ + (size_t)tokb * PROJ_LD + PC_AK + hd * 64;
    const bf16_t* vrow0 = VT + (size_t)(hd * 64 + r) * NTOK + tokb; const bf16_t* vrow1 = vrow0 + (size_t)32 * NTOK;
    DiffKV ta, tb; diff_load(ta, kbase, vrow0, vrow1, 0, r, h);
    for (int kt = 0; kt < nkt; kt += 2) {
        if (kt + 1 < nkt) diff_load(tb, kbase, vrow0, vrow1, (kt + 1) * 32, r, h);
        diff_step(ta, qf, kt == nkt - 1, dmask, c, mm, ll, O);
        if (kt + 1 < nkt) { if (kt + 2 < nkt) diff_load(ta, kbase, vrow0, vrow1, (kt + 2) * 32, r, h);
            diff_step(tb, qf, kt + 1 == nkt - 1, dmask, c, mm, ll, O); }
    }
    ll[0] += __shfl_xor(ll[0], 32); ll[1] += __shfl_xor(ll[1], 32);
    const float i0 = 1.0f / ll[0], i1 = lam / ll[1]; float ss = 0.f;
#pragma unroll
    for (int et = 0; et < 2; ++et)
#pragma unroll
        for (int i = 0; i < 16; ++i) { const float o = O[0][et][i] * i0 - O[1][et][i] * i1; O[0][et][i] = o; ss += o * o; }
    ss += __shfl_xor(ss, 32);
    const float rn = (1.0f - lam_init) / sqrtf(ss * (1.0f / 64.0f) + 1e-6f);
    bf16_t* yrow = Y + (size_t)(tokb + t) * DM + hd * 64;
#pragma unroll
    for (int et = 0; et < 2; ++et)
#pragma unroll
        for (int g = 0; g < 4; ++g) { u32x2 w; w.x = pk2(O[0][et][4 * g] * rn, O[0][et][4 * g + 1] * rn); w.y = pk2(O[0][et][4 * g + 2] * rn, O[0][et][4 * g + 3] * rn);
            *(u32x2*)(yrow + et * 32 + 8 * g + 4 * h) = w; }
}

struct KV64 { bf16x8 kf[4]; bf16x8 vf[2][2]; };
DI void kv64_load(KV64& t, const bf16_t* kbase, int kld, const bf16_t* vrow0, const bf16_t* vrow1, int k0, int r, int h) {
    const bf16_t* kp = kbase + (size_t)(k0 + r) * kld + 8 * h;
#pragma unroll
    for (int s = 0; s < 4; ++s) t.kf[s] = *(const bf16x8*)(kp + 16 * s);
#pragma unroll
    for (int s2 = 0; s2 < 2; ++s2) { t.vf[0][s2] = vt_frag(vrow0, k0, s2, h); t.vf[1][s2] = vt_frag(vrow1, k0, s2, h); }
}
DI void kv64_step(const KV64& t, const bf16x8 (&qf)[4], bool masked, unsigned vmask, const float c, float& mm, float& ll, f32x16 (&O)[2]) {
    f32x16 st = zero16();
#pragma unroll
    for (int s = 0; s < 4; ++s) st = mfma32(t.kf[s], qf[s], st);
    if (masked) apply_mask(st, vmask);
    bf16x8 p0, p1; sm_step(st, c, mm, ll, O[0], O[1], p0, p1);
    O[0] = mfma32(t.vf[0][0], p0, O[0]); O[0] = mfma32(t.vf[0][1], p1, O[0]);
    O[1] = mfma32(t.vf[1][0], p0, O[1]); O[1] = mfma32(t.vf[1][1], p1, O[1]);
}
DI void mem_attn_wave(const Ctx& C, const Params& P, int l) {
    const bf16_t* MQ = (const bf16_t*)(P.ws + WS_R1 + R1_MQ); bf16_t* MO = (bf16_t*)(P.ws + WS_R1 + R1_MO);
    const bf16_t* MK = wsp<bf16_t>(P, WS_MK) + (size_t)l * 1024 * 256; const bf16_t* MVT = wsp<bf16_t>(P, WS_MVT) + (size_t)l * 256 * 1024;
    const int r = C.lane & 31, h = C.lane >> 5;
    for (int wu = C.bid * NWAVES + C.wave; wu < 2048; wu += C.G * NWAVES) {
        const int bh = wu >> 7, qs = wu & 127, b = bh >> 2, hd = bh & 3, t = b * SEQ + qs * 32 + r;
        bf16x8 qf[4];
#pragma unroll
        for (int s = 0; s < 4; ++s) qf[s] = *(const bf16x8*)(MQ + (size_t)t * 256 + hd * 64 + 16 * s + 8 * h);
        f32x16 O[2] = {zero16(), zero16()}; float mm = -1e30f, ll = 0.f;
        const float c = 0.125f * 1.4426950408889634f;
        const bf16_t* kbase = MK + (size_t)(b * 256) * 256 + hd * 64;
        const bf16_t* vrow0 = MVT + (size_t)(hd * 64 + r) * 1024 + b * 256; const bf16_t* vrow1 = vrow0 + (size_t)32 * 1024;
        KV64 ta, tb; kv64_load(ta, kbase, 256, vrow0, vrow1, 0, r, h);
#pragma unroll 1
        for (int kt = 0; kt < 8; kt += 2) {
            kv64_load(tb, kbase, 256, vrow0, vrow1, (kt + 1) * 32, r, h);
            kv64_step(ta, qf, false, 0u, c, mm, ll, O);
            if (kt + 2 < 8) kv64_load(ta, kbase, 256, vrow0, vrow1, (kt + 2) * 32, r, h);
            kv64_step(tb, qf, false, 0u, c, mm, ll, O);
        }
        ll += __shfl_xor(ll, 32);
        const float il = 1.0f / ll; bf16_t* orow = MO + (size_t)t * 256 + hd * 64;
#pragma unroll
        for (int et = 0; et < 2; ++et)
#pragma unroll
            for (int g = 0; g < 4; ++g) { u32x2 w; w.x = pk2(O[et][4 * g] * il, O[et][4 * g + 1] * il); w.y = pk2(O[et][4 * g + 2] * il, O[et][4 * g + 3] * il);
                *(u32x2*)(orow + et * 32 + 8 * g + 4 * h) = w; }
    }
}

DI f32x16 idx_score(const bf16x8 (&ikf)[2], const bf16x8 (&iqf)[4][2], const float (&iw)[4]) {
    f32x16 a[4];
#pragma unroll
    for (int hh = 0; hh < 4; ++hh) a[hh] = mfma32(ikf[0], iqf[hh][0], zero16());
#pragma unroll
    for (int hh = 0; hh < 4; ++hh) a[hh] = mfma32(ikf[1], iqf[hh][1], a[hh]);
    f32x16 sc = zero16();
#pragma unroll
    for (int hh = 0; hh < 4; ++hh) {
#pragma unroll
        for (int i = 0; i < 16; ++i) { const int ab = (int)__float_as_uint(a[hh][i]); const float rl = __uint_as_float((unsigned)(ab > 0 ? ab : 0));
            sc[i] = fmaf(iw[hh], rl, sc[i]); } }
    return sc;
}
DI unsigned okey_of(float f) { const unsigned u = __float_as_uint(f); return u ^ ((unsigned)((int)u >> 31) | 0x80000000u); }
DI void load_idx_q(const bf16_t* PROJ, size_t tok, int h, bf16x8 (&iqf)[4][2], float (&iw)[4]) {
    const bf16_t* row = PROJ + tok * PROJ_LD;
#pragma unroll
    for (int hh = 0; hh < 4; ++hh) {
#pragma unroll
        for (int s = 0; s < 2; ++s) iqf[hh][s] = *(const bf16x8*)(row + PC_DIQ + hh * 32 + 16 * s + 8 * h);
        iw[hh] = bf2f(row[PC_DIW + hh]) * 0.08838834764831845f; }
}

template <int PASS> DI void d1_digit(unsigned ok, unsigned sinv, unsigned mv, unsigned mb, bool& match, unsigned& dg) {
    if constexpr (PASS == 0) { match = true; dg = ok >> 21; }
    else if constexpr (PASS == 1) { match = (ok >> 21) == mv; dg = (ok >> 10) & 2047u; }
    else if constexpr (PASS == 2) { match = (ok >> 10) == mv; dg = ((ok & 1023u) << 1) | (sinv >> 11); }
    else { match = (ok == mv) && ((sinv >> 11) == mb); dg = sinv & 2047u; }
}
constexpr int D1_HSTRIDE = 1025;
DI unsigned lin_bin(float sc, float lin_a, float lin_b) { return (unsigned)__builtin_amdgcn_fmed3f(fmaf(sc, lin_a, lin_b), 0.f, 2047.f); }
template <int PASS> DI void d1_pass(const Ctx& C, const bf16_t* PROJ, int tokb, int q0, int nkt, const bf16x8 (&iqf)[4][2], const float (&iw)[4], LAS unsigned* hist, volatile LAS unsigned* QS, const float lin_a = 0.f, const float lin_b = 0.f) {
    const int r = C.lane & 31, h = C.lane >> 5;
    const unsigned mv = QS[r * 4 + 0], mb = QS[r * 4 + 1];
    LAS unsigned* hrow = hist + r * D1_HSTRIDE;
    const bf16_t* kp0 = PROJ + (size_t)(tokb + r) * PROJ_LD + PC_DIK + 8 * h;
    bf16x8 ikf[2], ikn[2];
    if (C.wave < nkt) { const bf16_t* kp = kp0 + (size_t)(C.wave * 32) * PROJ_LD; ikf[0] = *(const bf16x8*)kp; ikf[1] = *(const bf16x8*)(kp + 16); }
    for (int kt = C.wave; kt < nkt; kt += NWAVES) {
        const int k0 = kt * 32;
        { const int ktn = (kt + NWAVES < nkt) ? kt + NWAVES : kt;
          const bf16_t* kp = kp0 + (size_t)(ktn * 32) * PROJ_LD; ikn[0] = *(const bf16x8*)kp; ikn[1] = *(const bf16x8*)(kp + 16); }
        const f32x16 sc = idx_score(ikf, iqf, iw);
        const bool diag = (kt == nkt - 1);
        unsigned wadr[16], wval[16]; bool any_m = false;
#pragma unroll
        for (int i = 0; i < 16; ++i) { const unsigned ok = okey_of(sc[i]), sinv = 4095u - (unsigned)(k0 + crow(i, h));
            bool match; unsigned dg;
            if constexpr (PASS == 4) { match = true; dg = lin_bin(sc[i], lin_a, lin_b); } else d1_digit<PASS>(ok, sinv, mv, mb, match, dg);
            if (diag) match = match && (crow(i, h) <= r);
            wadr[i] = match ? (dg >> 1) : 1024u;
            wval[i] = match ? (1u << ((dg & 1u) * 16u)) : 0u; any_m = any_m || match; }
        if (PASS == 0 || PASS == 4 || __any(any_m)) {
#pragma unroll
            for (int i = 0; i < 16; ++i) __hip_atomic_fetch_add(hrow + wadr[i], wval[i], __ATOMIC_RELAXED, __HIP_MEMORY_SCOPE_WORKGROUP);
        }
        ikf[0] = ikn[0]; ikf[1] = ikn[1];
    }
    __syncthreads();
    for (int srep = ((PROBE_DUP & 32768) ? 0 : 1); srep < 2; ++srep)
    for (int qq = 0; qq < 4; ++qq) {
        const int q = C.wave * 4 + qq; const unsigned rk = QS[q * 4 + 2];
        unsigned lsum = 0;
#pragma unroll
        for (int j = 0; j < 16; ++j) { const unsigned wj = hist[q * D1_HSTRIDE + C.lane * 16 + j]; lsum += (wj & 0xffffu) + (wj >> 16); }
        unsigned x = lsum;
#pragma unroll
        for (int o = 1; o < 64; o <<= 1) { const unsigned y = __shfl_down(x, o); if (C.lane + o < 64) x += y; }
        const unsigned above = x - lsum;
        const bool hit = (above < rk) && (rk <= x);
        const unsigned long long bal = __ballot(hit); const int L = bal ? (__ffsll((long long)bal) - 1) : 0;
        const unsigned aboveL = __shfl(above, L);
        const unsigned bk = (C.lane < 32) ? (unsigned)((const LAS unsigned short*)hist)[q * (2 * D1_HSTRIDE) + L * 32 + C.lane] : 0u;
        unsigned y2 = bk;
#pragma unroll
        for (int o = 1; o < 32; o <<= 1) { const unsigned z = __shfl_down(y2, o); if (C.lane + o < 32) y2 += z; }
        const unsigned ab2 = aboveL + y2 - bk;
        const bool hit2 = (C.lane < 32) && (ab2 < rk) && (rk <= ab2 + bk);
        const unsigned long long bal2 = __ballot(hit2); const int K2 = bal2 ? (__ffsll((long long)bal2) - 1) : 0;
        unsigned bin = (unsigned)(L * 32 + K2), rnew = rk - __shfl(ab2, K2);
        if (C.lane == 0 && srep == 1) {
            const unsigned omv = QS[q * 4 + 0];
            if constexpr (PASS == 0 || PASS == 4) { QS[q * 4 + 0] = bin; }
            else if constexpr (PASS == 1) { QS[q * 4 + 0] = (omv << 11) | bin; }
            else if constexpr (PASS == 2) { QS[q * 4 + 0] = (omv << 10) | (bin >> 1); QS[q * 4 + 1] = bin & 1u; }
            else { QS[q * 4 + 3] = bin; }
            QS[q * 4 + 2] = rnew;
        }
    }
    __syncthreads();
    if constexpr (PASS == 1 || PASS == 2) { for (int crep = 0; crep < ((PROBE_DUP & 65536) ? 2 : 1); ++crep) { for (int i = C.tid; i < 32 * D1_HSTRIDE; i += NTHREADS) hist[i] = 0u; __syncthreads(); } }
}
DI void dsa_select_unit(const Ctx& C, const Params& P, int l, int b, int qt) {
    const bf16_t* PROJ = (const bf16_t*)(P.ws + WS_R1 + R1_PROJ); unsigned short* MASK = wsp<unsigned short>(P, WS_MASK);
    const int tokb = b * SEQ, q0 = qt * 32;
    unsigned short* mrow = MASK + ((size_t)(b * 128 + qt) * 128) * 64 + C.lane;
    if (q0 + 31 < 256) {
        for (int kt = C.wave; kt <= qt; kt += NWAVES) mrow[(size_t)kt * 64] = (unsigned short)((kt == qt) ? causal_mask(C.lane & 31, C.lane >> 5) : 0xffffu);
        return; }
    LAS unsigned* hist = (LAS unsigned*)C.lds; volatile LAS unsigned* QS = (volatile LAS unsigned*)(C.lds + 32 * D1_HSTRIDE * 4);
    for (int i = C.tid; i < 32 * D1_HSTRIDE; i += NTHREADS) hist[i] = 0u;
    if (C.tid < 32) { QS[C.tid * 4 + 0] = 0u; QS[C.tid * 4 + 1] = 0u; QS[C.tid * 4 + 2] = 256u; QS[C.tid * 4 + 3] = 0u; }
    __syncthreads();
    const int r = C.lane & 31, h = C.lane >> 5;
    bf16x8 iqf[4][2]; float iw[4]; load_idx_q(PROJ, (size_t)(tokb + q0 + r), h, iqf, iw);
    const int nkt = qt + 1;
    float lin_a, lin_b;
    { const float kmax = sqrtf(__uint_as_float(wsp<unsigned>(P, WS_CTL)[CW_KMAX + 8 * l + b]));
      float hi = 0.f, lo = 0.f;
#pragma unroll
      for (int hh = 0; hh < 4; ++hh) { float n2 = 0.f;
#pragma unroll
          for (int s2 = 0; s2 < 2; ++s2) { const u32x4 w = __builtin_bit_cast(u32x4, iqf[hh][s2]);
#pragma unroll
              for (int j = 0; j < 4; ++j) { const float x0 = bflo(w[j]), x1 = bfhi(w[j]); n2 += x0 * x0 + x1 * x1; } }
          n2 += __shfl_xor(n2, 32); const float bnd = 0.5f * kmax * fabsf(iw[hh]) * sqrtf(n2);
          if (iw[hh] > 0.f) hi += bnd; else lo -= bnd; }
      const float span = hi - lo; lin_a = span > 0.f ? 2047.0f / span : 0.f; lin_b = -lo * lin_a; }
    d1_pass<4>(C, PROJ, tokb, q0, nkt, iqf, iw, hist, QS, lin_a, lin_b);
    constexpr int CCAP = 384;
    LAS unsigned long long* CAND = (LAS unsigned long long*)C.lds;
    LAS unsigned short* LM = (LAS unsigned short*)(C.lds + 98304);
    LAS unsigned* ZBM = (LAS unsigned*)(C.lds + 114688);
    LAS unsigned* ccnt = (LAS unsigned*)(C.lds + 32 * D1_HSTRIDE * 4 + 512);
    if (C.tid < 33) ccnt[C.tid] = 0u;
    __syncthreads();
    {
        const unsigned b0 = QS[r * 4 + 0];
        const bf16_t* kp0 = PROJ + (size_t)(tokb + r) * PROJ_LD + PC_DIK + 8 * h;
        bf16x8 ikf[2], ikn[2];
        if (C.wave < nkt) { const bf16_t* kp = kp0 + (size_t)(C.wave * 32) * PROJ_LD; ikf[0] = *(const bf16x8*)kp; ikf[1] = *(const bf16x8*)(kp + 16); }
        for (int kt = C.wave; kt < nkt; kt += NWAVES) {
            const int k0 = kt * 32;
            { const int ktn = (kt + NWAVES < nkt) ? kt + NWAVES : kt;
              const bf16_t* kp = kp0 + (size_t)(ktn * 32) * PROJ_LD; ikn[0] = *(const bf16x8*)kp; ikn[1] = *(const bf16x8*)(kp + 16); }
            const f32x16 sc = idx_score(ikf, iqf, iw);
            const bool diag = (kt == nkt - 1);
            unsigned above = 0, cand = 0, zer = 0;
#pragma unroll
            for (int i = 0; i < 16; ++i) { const unsigned d0 = lin_bin(sc[i], lin_a, lin_b); const bool ok_c = !diag || (crow(i, h) <= r);
                const bool inb = ok_c && d0 == b0, isz = sc[i] == 0.0f;
                above |= (ok_c && d0 > b0) ? (1u << i) : 0u; cand |= (inb && !isz) ? (1u << i) : 0u; zer |= (inb && isz) ? (1u << i) : 0u; }
            LM[kt * 64 + C.lane] = (unsigned short)above;
            { unsigned kw = 0;
#pragma unroll
              for (int g = 0; g < 4; ++g) kw |= ((zer >> (4 * g)) & 0xfu) << (8 * g + 4 * h);
              kw |= __shfl_xor(kw, 32);
              if (h == 0) ZBM[r * 128 + kt] = kw; }
            if (__any(cand != 0u)) {
                const unsigned nc = (unsigned)__popc(cand);
                unsigned pos = nc ? __hip_atomic_fetch_add(ccnt + r, nc, __ATOMIC_RELAXED, __HIP_MEMORY_SCOPE_WORKGROUP) : 0u;
#pragma unroll
                for (int i = 0; i < 16; ++i) { const bool on = (cand >> i) & 1u;
                    if (on && pos < (unsigned)CCAP) CAND[r * CCAP + pos] = ((unsigned long long)okey_of(sc[i]) << 12) | (unsigned long long)(4095 - (k0 + crow(i, h)));
                    pos += on ? 1u : 0u; }
            }
            ikf[0] = ikn[0]; ikf[1] = ikn[1];
        }
    }
    __syncthreads();
    if (C.tid < 32 && ccnt[C.tid] > (unsigned)CCAP) ccnt[32] = 1u;
    __syncthreads();
    if (ccnt[32] == 0u || (PROBE_DUP & 16384)) {
        const unsigned long long ZK = 0x80000000ull << 12;
        for (int qq = 0; qq < 4; ++qq) {
            const int q = C.wave * 4 + qq; const unsigned n = ccnt[q]; unsigned rk = QS[q * 4 + 2];
            unsigned long long cv[6];
#pragma unroll
            for (int j = 0; j < 6; ++j) { const unsigned idx = (unsigned)C.lane + 64u * j; cv[j] = (idx < n) ? CAND[q * CCAP + idx] : 0ull; }
            unsigned z0 = (2 * C.lane < nkt) ? ZBM[q * 128 + 2 * C.lane] : 0u, z1 = (2 * C.lane + 1 < nkt) ? ZBM[q * 128 + 2 * C.lane + 1] : 0u;
            unsigned Pc = 0, Zc;
#pragma unroll
            for (int j = 0; j < 6; ++j) Pc += (unsigned)__popcll(__ballot(cv[j] >= ZK + 4096ull));
            { unsigned zc = (unsigned)(__popc(z0) + __popc(z1)); Zc = zc;
#pragma unroll
              for (int o = 32; o > 0; o >>= 1) Zc += __shfl_xor(Zc, o); }
            unsigned long long thr;
            unsigned mz = 0;
            if (rk <= Pc || rk > Pc + Zc) {
                if (rk > Pc + Zc) { mz = Zc; }
                const bool neg = rk > Pc + Zc; const unsigned rk2 = neg ? rk - Zc : rk;
                unsigned long long cur = 0ull;
                if (n <= 64u) {
                    for (int bit = 43; bit >= 0; --bit) { const unsigned long long T = cur | (1ull << bit); if ((unsigned)__popcll(__ballot(cv[0] != 0ull && cv[0] >= T)) >= rk2) cur = T; }
                } else {
                    for (int bit = 43; bit >= 0; --bit) { const unsigned long long T = cur | (1ull << bit); unsigned cnt = 0;
#pragma unroll
                        for (int j = 0; j < 6; ++j) cnt += (unsigned)__popcll(__ballot(cv[j] != 0ull && cv[j] >= T));
                        if (cnt >= rk2) cur = T; }
                }
                thr = cur;
            } else { thr = ZK + 4096ull; mz = rk - Pc; }
#pragma unroll
            for (int j = 0; j < 6; ++j) {
                if (cv[j] != 0ull && cv[j] >= thr) { const int key = 4095 - (int)(cv[j] & 4095ull), kt = key >> 5, kk = key & 31, hh = (kk >> 2) & 1, ii = (kk & 3) + 4 * (kk >> 3);
                    const int w16 = kt * 64 + q + 32 * hh;
                    __hip_atomic_fetch_or((LAS unsigned*)LM + (w16 >> 1), 1u << (16 * (w16 & 1) + ii), __ATOMIC_RELAXED, __HIP_MEMORY_SCOPE_WORKGROUP); } }
            if (mz > 0u) {
                const unsigned c0 = (unsigned)__popc(z0), c1 = (unsigned)__popc(z1); unsigned incl = c0 + c1;
#pragma unroll
                for (int o = 1; o < 64; o <<= 1) { const unsigned y = __shfl_up(incl, o); if (C.lane >= o) incl += y; }
                unsigned before = incl - (c0 + c1);
                unsigned need0 = (before >= mz) ? 0u : ((mz - before) < c0 ? (mz - before) : c0);
                while ((unsigned)__popc(z0) > need0) z0 &= ~(0x80000000u >> __clz(z0));
                before += c0;
                unsigned need1 = (before >= mz) ? 0u : ((mz - before) < c1 ? (mz - before) : c1);
                while ((unsigned)__popc(z1) > need1) z1 &= ~(0x80000000u >> __clz(z1));
#pragma unroll
                for (int tz = 0; tz < 2; ++tz) { const unsigned zw = tz ? z1 : z0; const int kt = 2 * C.lane + tz;
                    if (zw) {
#pragma unroll
                        for (int hh = 0; hh < 2; ++hh) { unsigned m16 = 0;
#pragma unroll
                            for (int g = 0; g < 4; ++g) m16 |= ((zw >> (8 * g + 4 * hh)) & 0xfu) << (4 * g);
                            const int w16 = kt * 64 + q + 32 * hh;
                            if (m16) __hip_atomic_fetch_or((LAS unsigned*)LM + (w16 >> 1), m16 << (16 * (w16 & 1)), __ATOMIC_RELAXED, __HIP_MEMORY_SCOPE_WORKGROUP); } } }
            }
        }
        __syncthreads();
        { const LAS unsigned* src = (const LAS unsigned*)LM; unsigned* dst = (unsigned*)(MASK + ((size_t)(b * 128 + qt) * 128) * 64);
          for (int i = C.tid; i < nkt * 32; i += NTHREADS) dst[i] = src[i]; }
        __syncthreads();
        return;
    }
    for (int i = C.tid; i < 32 * D1_HSTRIDE; i += NTHREADS) hist[i] = 0u;
    if (C.tid < 32) { QS[C.tid * 4 + 0] = 0u; QS[C.tid * 4 + 1] = 0u; QS[C.tid * 4 + 2] = 256u; QS[C.tid * 4 + 3] = 0u; }
    __syncthreads();
    d1_pass<0>(C, PROJ, tokb, q0, nkt, iqf, iw, hist, QS);
    for (int i = C.tid; i < 32 * D1_HSTRIDE; i += NTHREADS) hist[i] = 0u;
    __syncthreads();
    d1_pass<1>(C, PROJ, tokb, q0, nkt, iqf, iw, hist, QS);
    d1_pass<2>(C, PROJ, tokb, q0, nkt, iqf, iw, hist, QS);
    d1_pass<3>(C, PROJ, tokb, q0, nkt, iqf, iw, hist, QS);
    {
      const unsigned long long theta = ((unsigned long long)QS[r * 4 + 0] << 12) | ((unsigned long long)QS[r * 4 + 1] << 11) | QS[r * 4 + 3];
      for (int rep = 0; rep < ((PROBE_DUP & 4096) ? 2 : 1); ++rep)
      for (int kt = C.wave; kt < nkt; kt += NWAVES) {
          const int k0 = kt * 32; bf16x8 ikf[2];
          const bf16_t* kp = PROJ + (size_t)(tokb + k0 + r) * PROJ_LD + PC_DIK + 8 * h;
          ikf[0] = *(const bf16x8*)kp; ikf[1] = *(const bf16x8*)(kp + 16);
          const f32x16 sc = idx_score(ikf, iqf, iw);
          unsigned vmask = 0;
#pragma unroll
          for (int i = 0; i < 16; ++i) { const int key = k0 + crow(i, h); const unsigned long long comp = ((unsigned long long)okey_of(sc[i]) << 12) | (unsigned long long)(4095 - key);
              vmask |= (key <= q0 + r && comp >= theta) ? (1u << i) : 0u; }
          mrow[(size_t)kt * 64] = (unsigned short)vmask; } }
    __syncthreads();
}

DI void dsa_attn_wave(const Ctx& C, const Params& P) {
    const bf16_t* PROJ = (const bf16_t*)(P.ws + WS_R1 + R1_PROJ); const bf16_t* VT = (const bf16_t*)(P.ws + WS_R1 + R1_VT); bf16_t* Y = wsp<bf16_t>(P, WS_Y);
    const unsigned short* MASK = wsp<unsigned short>(P, WS_MASK);
    int bh, qs; causal_wave_unit(C.bid, C.wave, bh, qs);
    const int b = bh >> 2, hd = bh & 3, r = C.lane & 31, h = C.lane >> 5, tokb = b * SEQ, q0 = qs * 32, t = q0 + r;
    bf16x8 qf[4];
#pragma unroll
    for (int s = 0; s < 4; ++s) qf[s] = *(const bf16x8*)(PROJ + (size_t)(tokb + t) * PROJ_LD + PC_DQ + hd * 64 + 16 * s + 8 * h);
    f32x16 O[2] = {zero16(), zero16()}; float mm = -1e30f, ll = 0.f;
    const float c = 0.125f * 1.4426950408889634f;
    const int nkt = qs + 1;
    const bf16_t* kbase = PROJ + (size_t)tokb * PROJ_LD + PC_DK;
    const bf16_t* vrow0 = VT + (size_t)(256 + r) * NTOK + tokb; const bf16_t* vrow1 = vrow0 + (size_t)32 * NTOK;
    const unsigned short* mrow = MASK + ((size_t)(b * 128 + qs) * 128) * 64 + C.lane;
    KV64 ta, tb; unsigned ma, mb;
    kv64_load(ta, kbase, PROJ_LD, vrow0, vrow1, 0, r, h); ma = mrow[0];
    for (int kt = 0; kt < nkt; kt += 2) {
        if (kt + 1 < nkt) { kv64_load(tb, kbase, PROJ_LD, vrow0, vrow1, (kt + 1) * 32, r, h); mb = mrow[(size_t)(kt + 1) * 64]; }
        kv64_step(ta, qf, true, ma, c, mm, ll, O);
        if (kt + 1 < nkt) { if (kt + 2 < nkt) { kv64_load(ta, kbase, PROJ_LD, vrow0, vrow1, (kt + 2) * 32, r, h); ma = mrow[(size_t)(kt + 2) * 64]; }
            kv64_step(tb, qf, true, mb, c, mm, ll, O); }
    }
    ll += __shfl_xor(ll, 32);
    const float il = 1.0f / ll; bf16_t* yrow = Y + (size_t)(tokb + t) * DM + 768 + hd * 64;
#pragma unroll
    for (int et = 0; et < 2; ++et)
#pragma unroll
        for (int g = 0; g < 4; ++g) { u32x2 w; w.x = pk2(O[et][4 * g] * il, O[et][4 * g + 1] * il); w.y = pk2(O[et][4 * g + 2] * il, O[et][4 * g + 3] * il);
            *(u32x2*)(yrow + et * 32 + 8 * g + 4 * h) = w; }
}

constexpr int CA_KB = 64 * 144, CA_VB = 64 * 136, CA_BUF = CA_KB + CA_VB;
template <bool DIFF>
DI void causal_attn_block(const Ctx& C, const Params& P, int l) {
    const bf16_t* PROJ = (const bf16_t*)(P.ws + WS_R1 + R1_PROJ); const bf16_t* VT = (const bf16_t*)(P.ws + WS_R1 + R1_VT); bf16_t* Y = wsp<bf16_t>(P, WS_Y);
    const unsigned short* MASK = wsp<unsigned short>(P, WS_MASK);
    const int bh = (C.bid >> 4) & 15, g = C.bid & 15, j0 = 4 * g, b = bh >> 2, hd = bh & 3, tokb = b * SEQ;
#if (PROBE_DUP & 262144)
    const int qs = ((C.wave & 1) == 0) ? 127 - (j0 + (C.wave >> 1)) : j0 + (C.wave >> 1);
#else
    const int qs = (C.wave < 4) ? 127 - (j0 + C.wave) : j0 + (C.wave - 4);
#endif
    const int r = C.lane & 31, h = C.lane >> 5, q0 = qs * 32, t = q0 + r;
    const int nsub = qs + 1, NT = (128 - j0 + 1) >> 1;
    const int kcol = DIFF ? PC_AK + hd * 64 : PC_DK, vrb = DIFF ? hd * 64 : 256;
    const int srow = C.tid >> 3, sch = C.tid & 7;
    const bf16_t* kg = PROJ + (size_t)(tokb + srow) * PROJ_LD + kcol + sch * 8;
    const bf16_t* vg = VT + (size_t)(vrb + srow) * NTOK + tokb + sch * 8;
    LAS unsigned char* kdst = C.lds + srow * 144 + sch * 16; LAS unsigned char* vdst = C.lds + CA_KB + srow * 136 + sch * 16;
    bf16x8 qfd[2][2], qf4[4];
    if constexpr (DIFF) {
#pragma unroll
        for (int m = 0; m < 2; ++m)
#pragma unroll
            for (int s = 0; s < 2; ++s) qfd[m][s] = *(const bf16x8*)(PROJ + (size_t)(tokb + t) * PROJ_LD + PC_AQ + hd * 64 + m * 32 + 16 * s + 8 * h);
    } else {
#pragma unroll
        for (int s = 0; s < 4; ++s) qf4[s] = *(const bf16x8*)(PROJ + (size_t)(tokb + t) * PROJ_LD + PC_DQ + hd * 64 + 16 * s + 8 * h);
    }
    f32x16 O[2][2]; float mm[2] = {-1e30f, -1e30f}, ll[2] = {0.f, 0.f};
#pragma unroll
    for (int m = 0; m < 2; ++m) { O[m][0] = zero16(); O[m][1] = zero16(); }
    const float c = (DIFF ? 0.17677669529663687f : 0.125f) * 1.4426950408889634f;
    const unsigned dmask = causal_mask(r, h);
    const unsigned short* mrow = MASK + ((size_t)(b * 128 + qs) * 128) * 64 + C.lane;
    u32x4 kreg = *(const u32x4*)kg, vreg = *(const u32x4*)vg, kr2, vr2;
    unsigned mcur[2] = {0u, 0u}, mnxt[2] = {0u, 0u}, mn2[2] = {0u, 0u};
    if constexpr (!DIFF) { mcur[0] = mrow[0]; if (1 < nsub) mcur[1] = mrow[64]; if (2 < nsub) mnxt[0] = mrow[128]; if (3 < nsub) mnxt[1] = mrow[192]; }
    *(LAS u32x4*)kdst = kreg; *(LAS u32x2*)vdst = (u32x2){vreg.x, vreg.y}; *(LAS u32x2*)(vdst + 8) = (u32x2){vreg.z, vreg.w};
    if (1 < NT) { kreg = *(const u32x4*)(kg + (size_t)64 * PROJ_LD); vreg = *(const u32x4*)(vg + 64); }
    __syncthreads();
    for (int T = 0; T < NT; ++T) {
        const int cur = T & 1;
        if (T + 2 < NT) { kr2 = *(const u32x4*)(kg + (size_t)(T + 2) * 64 * PROJ_LD); vr2 = *(const u32x4*)(vg + (T + 2) * 64);
            if constexpr (!DIFF) { if (2 * T + 4 < nsub) mn2[0] = mrow[(size_t)(2 * T + 4) * 64]; if (2 * T + 5 < nsub) mn2[1] = mrow[(size_t)(2 * T + 5) * 64]; } }
        const LAS unsigned char* KB = C.lds + cur * CA_BUF; const LAS unsigned char* VB = KB + CA_KB;
#pragma unroll
        for (int sub = 0; sub < 2; ++sub) {
            const int st = 2 * T + sub;
            if (st < nsub) {
                const LAS unsigned char* krow = KB + (sub * 32 + r) * 144 + h * 16;
                const LAS unsigned char* v0 = VB + r * 136 + (sub * 32 + 4 * h) * 2; const LAS unsigned char* v1 = v0 + 32 * 136;
                if constexpr (DIFF) {
                    DiffKV tl;
#pragma unroll
                    for (int m = 0; m < 2; ++m)
#pragma unroll
                        for (int s = 0; s < 2; ++s) tl.kf[m][s] = *(const LAS bf16x8*)(krow + m * 64 + s * 32);
#pragma unroll
                    for (int s2 = 0; s2 < 2; ++s2) {
                        { const u32x2 lo = *(const LAS u32x2*)(v0 + s2 * 32), hi = *(const LAS u32x2*)(v0 + s2 * 32 + 16); u32x4 w; w.x = lo.x; w.y = lo.y; w.z = hi.x; w.w = hi.y; tl.vf[0][s2] = __builtin_bit_cast(bf16x8, w); }
                        { const u32x2 lo = *(const LAS u32x2*)(v1 + s2 * 32), hi = *(const LAS u32x2*)(v1 + s2 * 32 + 16); u32x4 w; w.x = lo.x; w.y = lo.y; w.z = hi.x; w.w = hi.y; tl.vf[1][s2] = __builtin_bit_cast(bf16x8, w); } }
                    diff_step(tl, qfd, st == nsub - 1, dmask, c, mm, ll, O);
                } else {
                    KV64 tl; const unsigned vm = mcur[sub];
#pragma unroll
                    for (int s = 0; s < 4; ++s) tl.kf[s] = *(const LAS bf16x8*)(krow + s * 32);
#pragma unroll
                    for (int s2 = 0; s2 < 2; ++s2) {
                        { const u32x2 lo = *(const LAS u32x2*)(v0 + s2 * 32), hi = *(const LAS u32x2*)(v0 + s2 * 32 + 16); u32x4 w; w.x = lo.x; w.y = lo.y; w.z = hi.x; w.w = hi.y; tl.vf[0][s2] = __builtin_bit_cast(bf16x8, w); }
                        { const u32x2 lo = *(const LAS u32x2*)(v1 + s2 * 32), hi = *(const LAS u32x2*)(v1 + s2 * 32 + 16); u32x4 w; w.x = lo.x; w.y = lo.y; w.z = hi.x; w.w = hi.y; tl.vf[1][s2] = __builtin_bit_cast(bf16x8, w); } }
                    kv64_step(tl, qf4, true, vm, c, mm[0], ll[0], O[0]);
                }
            }
        }
        if (T + 1 < NT) { LAS unsigned char* kd = kdst + (cur ^ 1) * CA_BUF; LAS unsigned char* vd = vdst + (cur ^ 1) * CA_BUF;
            *(LAS u32x4*)kd = kreg; *(LAS u32x2*)vd = (u32x2){vreg.x, vreg.y}; *(LAS u32x2*)(vd + 8) = (u32x2){vreg.z, vreg.w}; }
        kreg = kr2; vreg = vr2; mcur[0] = mnxt[0]; mcur[1] = mnxt[1]; mnxt[0] = mn2[0]; mnxt[1] = mn2[1];
        __syncthreads();
    }
    if constexpr (DIFF) {
        const float* lv = P.diff_lambda + l * 128;
        const float d1 = wave_sum(C.lane < 32 ? lv[C.lane] * lv[32 + C.lane] : 0.f), d2 = wave_sum(C.lane < 32 ? lv[64 + C.lane] * lv[96 + C.lane] : 0.f);
        const float lam_init = 0.8f - 0.6f * expf(-0.3f * (float)l), lam = expf(d1) - expf(d2) + lam_init;
        ll[0] += __shfl_xor(ll[0], 32); ll[1] += __shfl_xor(ll[1], 32);
        const float i0 = 1.0f / ll[0], i1 = lam / ll[1]; float ss = 0.f;
#pragma unroll
        for (int et = 0; et < 2; ++et)
#pragma unroll
            for (int i = 0; i < 16; ++i) { const float o = O[0][et][i] * i0 - O[1][et][i] * i1; O[0][et][i] = o; ss += o * o; }
        ss += __shfl_xor(ss, 32);
        const float rn = (1.0f - lam_init) / sqrtf(ss * (1.0f / 64.0f) + 1e-6f);
        bf16_t* yrow = Y + (size_t)(tokb + t) * DM + hd * 64;
#pragma unroll
        for (int et = 0; et < 2; ++et)
#pragma unroll
            for (int gq = 0; gq < 4; ++gq) { u32x2 w; w.x = pk2(O[0][et][4 * gq] * rn, O[0][et][4 * gq + 1] * rn); w.y = pk2(O[0][et][4 * gq + 2] * rn, O[0][et][4 * gq + 3] * rn);
                *(u32x2*)(yrow + et * 32 + 8 * gq + 4 * h) = w; }
    } else {
        ll[0] += __shfl_xor(ll[0], 32);
        const float il = 1.0f / ll[0]; bf16_t* yrow = Y + (size_t)(tokb + t) * DM + 768 + hd * 64;
#pragma unroll
        for (int et = 0; et < 2; ++et)
#pragma unroll
            for (int gq = 0; gq < 4; ++gq) { u32x2 w; w.x = pk2(O[0][et][4 * gq] * il, O[0][et][4 * gq + 1] * il); w.y = pk2(O[0][et][4 * gq + 2] * il, O[0][et][4 * gq + 3] * il);
                *(u32x2*)(yrow + et * 32 + 8 * gq + 4 * h) = w; }
    }
    __syncthreads();
}

constexpr int CB_KB = 128 * 144, CB_VB = 64 * 264, CB_BUF = CB_KB + CB_VB;
template <bool DIFF>
DI void causal_attn_unit2(const Ctx& C, const Params& P, int l, int bh, int G) {
    const bf16_t* PROJ = (const bf16_t*)(P.ws + WS_R1 + R1_PROJ); const bf16_t* VT = (const bf16_t*)(P.ws + WS_R1 + R1_VT); bf16_t* Y = wsp<bf16_t>(P, WS_Y);
    const unsigned short* MASK = wsp<unsigned short>(P, WS_MASK);
    const int b = bh >> 2, hd = bh & 3, tokb = b * SEQ;
    const int qs = 4 * G + (C.wave & 3), par = C.wave >> 2;
    const int r = C.lane & 31, h = C.lane >> 5, q0 = qs * 32, t = q0 + r;
    const int NT = G + 1;
    const int kcol = DIFF ? PC_AK + hd * 64 : PC_DK, vrb = DIFF ? hd * 64 : 256;
    const int srow = C.tid >> 3, sch = C.tid & 7;
    const bf16_t* kg = PROJ + (size_t)(tokb + srow) * PROJ_LD + kcol + sch * 8;
    const bf16_t* vg = VT + (size_t)(vrb + srow) * NTOK + tokb + sch * 8;
    LAS unsigned char* kdst = C.lds + srow * 144 + sch * 16; LAS unsigned char* vdst = C.lds + CB_KB + srow * 264 + sch * 16;
    bf16x8 qfd[2][2], qf4[4];
    if constexpr (DIFF) {
#pragma unroll
        for (int m = 0; m < 2; ++m)
#pragma unroll
            for (int s = 0; s < 2; ++s) qfd[m][s] = *(const bf16x8*)(PROJ + (size_t)(tokb + t) * PROJ_LD + PC_AQ + hd * 64 + m * 32 + 16 * s + 8 * h);
    } else {
#pragma unroll
        for (int s = 0; s < 4; ++s) qf4[s] = *(const bf16x8*)(PROJ + (size_t)(tokb + t) * PROJ_LD + PC_DQ + hd * 64 + 16 * s + 8 * h);
    }
    f32x16 O[2][2]; float mm[2] = {-1e30f, -1e30f}, ll[2] = {0.f, 0.f};
#pragma unroll
    for (int m = 0; m < 2; ++m) { O[m][0] = zero16(); O[m][1] = zero16(); }
    const float c = (DIFF ? 0.17677669529663687f : 0.125f) * 1.4426950408889634f;
    const unsigned dmask = causal_mask(r, h);
    const unsigned short* mrow = MASK + ((size_t)(b * 128 + qs) * 128) * 64 + C.lane;
    u32x4 kr[2], vr[2];
#define CB_GLOAD(T_) do { kr[0] = *(const u32x4*)(kg + (size_t)((T_) * 128) * PROJ_LD); kr[1] = *(const u32x4*)(kg + (size_t)((T_) * 128 + 64) * PROJ_LD); \
        vr[0] = *(const u32x4*)(vg + (T_) * 128); vr[1] = *(const u32x4*)(vg + (T_) * 128 + 64); } while (0)
#define CB_LSTORE(buf_) do { LAS unsigned char* kd_ = kdst + (buf_) * CB_BUF; LAS unsigned char* vd_ = vdst + (buf_) * CB_BUF; \
        *(LAS u32x4*)kd_ = kr[0]; *(LAS u32x4*)(kd_ + 64 * 144) = kr[1]; \
        *(LAS u32x2*)vd_ = (u32x2){vr[0].x, vr[0].y}; *(LAS u32x2*)(vd_ + 8) = (u32x2){vr[0].z, vr[0].w}; \
        *(LAS u32x2*)(vd_ + 128) = (u32x2){vr[1].x, vr[1].y}; *(LAS u32x2*)(vd_ + 136) = (u32x2){vr[1].z, vr[1].w}; } while (0)
    unsigned mcur[2] = {0u, 0u}, mnxt[2] = {0u, 0u};
    if constexpr (!DIFF) { if (par <= qs) mcur[0] = mrow[(size_t)par * 64]; if (par + 2 <= qs) mcur[1] = mrow[(size_t)(par + 2) * 64]; }
    CB_GLOAD(0); CB_LSTORE(0);
    __syncthreads();
    int cur = 0;
    for (int T = 0; T < NT; ++T) {
        const int nxb = (cur == 2) ? 0 : cur + 1;
        if (T + 1 < NT) { CB_GLOAD(T + 1);
            if constexpr (!DIFF) { const int s0 = 4 * (T + 1) + par; if (s0 <= qs) mnxt[0] = mrow[(size_t)s0 * 64]; if (s0 + 2 <= qs) mnxt[1] = mrow[(size_t)(s0 + 2) * 64]; } }
        const LAS unsigned char* KB = C.lds + cur * CB_BUF; const LAS unsigned char* VB = KB + CB_KB;
#pragma unroll
        for (int k2 = 0; k2 < 2; ++k2) {
            if (k2 == 1 && par == 1) { if (T + 1 < NT) CB_LSTORE(nxb); __syncthreads(); }
            const int sub = par + 2 * k2, st = 4 * T + sub;
            if (st <= qs) {
                const LAS unsigned char* krow = KB + (sub * 32 + r) * 144 + h * 16;
                const LAS unsigned char* v0 = VB + r * 264 + (sub * 32 + 4 * h) * 2; const LAS unsigned char* v1 = v0 + 32 * 264;
                if constexpr (DIFF) {
                    DiffKV tl;
#pragma unroll
                    for (int m = 0; m < 2; ++m)
#pragma unroll
                        for (int s = 0; s < 2; ++s) tl.kf[m][s] = *(const LAS bf16x8*)(krow + m * 64 + s * 32);
#pragma unroll
                    for (int s2 = 0; s2 < 2; ++s2) {
                        { const u32x2 lo = *(const LAS u32x2*)(v0 + s2 * 32), hi = *(const LAS u32x2*)(v0 + s2 * 32 + 16); u32x4 w; w.x = lo.x; w.y = lo.y; w.z = hi.x; w.w = hi.y; tl.vf[0][s2] = __builtin_bit_cast(bf16x8, w); }
                        { const u32x2 lo = *(const LAS u32x2*)(v1 + s2 * 32), hi = *(const LAS u32x2*)(v1 + s2 * 32 + 16); u32x4 w; w.x = lo.x; w.y = lo.y; w.z = hi.x; w.w = hi.y; tl.vf[1][s2] = __builtin_bit_cast(bf16x8, w); } }
                    diff_step(tl, qfd, st == qs, dmask, c, mm, ll, O);
                } else {
                    KV64 tl; const unsigned vm = mcur[k2];
#pragma unroll
                    for (int s = 0; s < 4; ++s) tl.kf[s] = *(const LAS bf16x8*)(krow + s * 32);
#pragma unroll
                    for (int s2 = 0; s2 < 2; ++s2) {
                        { const u32x2 lo = *(const LAS u32x2*)(v0 + s2 * 32), hi = *(const LAS u32x2*)(v0 + s2 * 32 + 16); u32x4 w; w.x = lo.x; w.y = lo.y; w.z = hi.x; w.w = hi.y; tl.vf[0][s2] = __builtin_bit_cast(bf16x8, w); }
                        { const u32x2 lo = *(const LAS u32x2*)(v1 + s2 * 32), hi = *(const LAS u32x2*)(v1 + s2 * 32 + 16); u32x4 w; w.x = lo.x; w.y = lo.y; w.z = hi.x; w.w = hi.y; tl.vf[1][s2] = __builtin_bit_cast(bf16x8, w); } }
                    kv64_step(tl, qf4, true, vm, c, mm[0], ll[0], O[0]);
                }
            }
        }
        if (par == 0) { if (T + 1 < NT) CB_LSTORE(nxb); __syncthreads(); }
        mcur[0] = mnxt[0]; mcur[1] = mnxt[1]; cur = nxb;
    }
#undef CB_GLOAD
#undef CB_LSTORE
    constexpr int NM = DIFF ? 2 : 1, NV = NM * 34;
    LAS float* MA = (LAS float*)C.lds + (size_t)(C.wave & 3) * 64 * NV + C.lane;
    __syncthreads();
    if (par == 1) {
#pragma unroll
        for (int m = 0; m < NM; ++m) { MA[(m * 34 + 0) * 64] = mm[m]; MA[(m * 34 + 1) * 64] = ll[m];
#pragma unroll
            for (int et = 0; et < 2; ++et)
#pragma unroll
                for (int i = 0; i < 16; ++i) MA[(m * 34 + 2 + et * 16 + i) * 64] = O[m][et][i]; }
    }
    __syncthreads();
    if (par == 0) {
#pragma unroll
        for (int m = 0; m < NM; ++m) { const float mB = MA[(m * 34 + 0) * 64], lB = MA[(m * 34 + 1) * 64];
            const float mn = fmaxf(mm[m], mB), aA = __builtin_amdgcn_exp2f((mm[m] - mn) * c), aB = __builtin_amdgcn_exp2f((mB - mn) * c);
            ll[m] = ll[m] * aA + lB * aB;
#pragma unroll
            for (int et = 0; et < 2; ++et)
#pragma unroll
                for (int i = 0; i < 16; ++i) O[m][et][i] = O[m][et][i] * aA + MA[(m * 34 + 2 + et * 16 + i) * 64] * aB; }
        if constexpr (DIFF) {
            const float* lv = P.diff_lambda + l * 128;
            const float d1 = wave_sum(C.lane < 32 ? lv[C.lane] * lv[32 + C.lane] : 0.f), d2 = wave_sum(C.lane < 32 ? lv[64 + C.lane] * lv[96 + C.lane] : 0.f);
            const float lam_init = 0.8f - 0.6f * expf(-0.3f * (float)l), lam = expf(d1) - expf(d2) + lam_init;
            ll[0] += __shfl_xor(ll[0], 32); ll[1] += __shfl_xor(ll[1], 32);
            const float i0 = 1.0f / ll[0], i1 = lam / ll[1]; float ss = 0.f;
#pragma unroll
            for (int et = 0; et < 2; ++et)
#pragma unroll
                for (int i = 0; i < 16; ++i) { const float o = O[0][et][i] * i0 - O[1][et][i] * i1; O[0][et][i] = o; ss += o * o; }
            ss += __shfl_xor(ss, 32);
            const float rn = (1.0f - lam_init) / sqrtf(ss * (1.0f / 64.0f) + 1e-6f);
            bf16_t* yrow = Y + (size_t)(tokb + t) * DM + hd * 64;
#pragma unroll
            for (int et = 0; et < 2; ++et)
#pragma unroll
                for (int gq = 0; gq < 4; ++gq) { u32x2 w; w.x = pk2(O[0][et][4 * gq] * rn, O[0][et][4 * gq + 1] * rn); w.y = pk2(O[0][et][4 * gq + 2] * rn, O[0][et][4 * gq + 3] * rn);
                    *(u32x2*)(yrow + et * 32 + 8 * gq + 4 * h) = w; }
        } else {
            ll[0] += __shfl_xor(ll[0], 32);
            const float il = 1.0f / ll[0]; bf16_t* yrow = Y + (size_t)(tokb + t) * DM + 768 + hd * 64;
#pragma unroll
            for (int et = 0; et < 2; ++et)
#pragma unroll
                for (int gq = 0; gq < 4; ++gq) { u32x2 w; w.x = pk2(O[0][et][4 * gq] * il, O[0][et][4 * gq + 1] * il); w.y = pk2(O[0][et][4 * gq + 2] * il, O[0][et][4 * gq + 3] * il);
                    *(u32x2*)(yrow + et * 32 + 8 * gq + 4 * h) = w; }
        }
    }
    __syncthreads();
}
template <bool DIFF>
DI void causal_attn_block2(const Ctx& C, const Params& P, int l) {
    const int xj = C.bid >> 3, bh = ((C.bid & 7) * 2 + (xj >> 4)) & 15, gi = xj & 15;
    causal_attn_unit2<DIFF>(C, P, l, bh, 31 - gi);
    causal_attn_unit2<DIFF>(C, P, l, bh, gi);
}

DI void mem_attn_block(const Ctx& C, const Params& P, int l) {
    const bf16_t* MQ = (const bf16_t*)(P.ws + WS_R1 + R1_MQ); bf16_t* MO = (bf16_t*)(P.ws + WS_R1 + R1_MO);
    const bf16_t* MK = wsp<bf16_t>(P, WS_MK) + (size_t)l * 1024 * 256; const bf16_t* MVT = wsp<bf16_t>(P, WS_MVT) + (size_t)l * 256 * 1024;
    const int xj = C.bid >> 3, bh = ((C.bid & 7) * 2 + (xj >> 4)) & 15, grp = xj & 15, b = bh >> 2, hd = bh & 3, r = C.lane & 31, h = C.lane >> 5;
    const int t = b * SEQ + (grp * 8 + C.wave) * 32 + r;
    bf16x8 qf[4];
#pragma unroll
    for (int s = 0; s < 4; ++s) qf[s] = *(const bf16x8*)(MQ + (size_t)t * 256 + hd * 64 + 16 * s + 8 * h);
    { u32x4 kr[4], vr[4];
#pragma unroll
      for (int j = 0; j < 4; ++j) { const int ci = C.tid + 512 * j;
          kr[j] = *(const u32x4*)(MK + (size_t)(b * 256 + (ci >> 3)) * 256 + hd * 64 + (ci & 7) * 8);
          vr[j] = *(const u32x4*)(MVT + (size_t)(hd * 64 + (ci >> 5)) * 1024 + b * 256 + (ci & 31) * 8); }
#pragma unroll
      for (int j = 0; j < 4; ++j) { const int ci = C.tid + 512 * j;
          *(LAS u32x4*)(C.lds + (ci >> 3) * 144 + (ci & 7) * 16) = kr[j];
          LAS unsigned char* vd = C.lds + 36864 + (ci >> 5) * 520 + (ci & 31) * 16;
          *(LAS u32x2*)vd = (u32x2){vr[j].x, vr[j].y}; *(LAS u32x2*)(vd + 8) = (u32x2){vr[j].z, vr[j].w}; } }
    __syncthreads();
    f32x16 O[2] = {zero16(), zero16()}; float mm = -1e30f, ll = 0.f;
    const float c = 0.125f * 1.4426950408889634f;
#pragma unroll 2
    for (int kt = 0; kt < 8; ++kt) {
        KV64 tl; const LAS unsigned char* krow = C.lds + (kt * 32 + r) * 144 + h * 16;
        const LAS unsigned char* v0 = C.lds + 36864 + r * 520 + (kt * 32 + 4 * h) * 2; const LAS unsigned char* v1 = v0 + 32 * 520;
#pragma unroll
        for (int s = 0; s < 4; ++s) tl.kf[s] = *(const LAS bf16x8*)(krow + s * 32);
#pragma unroll
        for (int s2 = 0; s2 < 2; ++s2) {
            { const u32x2 lo = *(const LAS u32x2*)(v0 + s2 * 32), hi = *(const LAS u32x2*)(v0 + s2 * 32 + 16); u32x4 w; w.x = lo.x; w.y = lo.y; w.z = hi.x; w.w = hi.y; tl.vf[0][s2] = __builtin_bit_cast(bf16x8, w); }
            { const u32x2 lo = *(const LAS u32x2*)(v1 + s2 * 32), hi = *(const LAS u32x2*)(v1 + s2 * 32 + 16); u32x4 w; w.x = lo.x; w.y = lo.y; w.z = hi.x; w.w = hi.y; tl.vf[1][s2] = __builtin_bit_cast(bf16x8, w); } }
        kv64_step(tl, qf, false, 0u, c, mm, ll, O);
    }
    ll += __shfl_xor(ll, 32);
    const float il = 1.0f / ll; bf16_t* orow = MO + (size_t)t * 256 + hd * 64;
#pragma unroll
    for (int et = 0; et < 2; ++et)
#pragma unroll
        for (int g = 0; g < 4; ++g) { u32x2 w; w.x = pk2(O[et][4 * g] * il, O[et][4 * g + 1] * il); w.y = pk2(O[et][4 * g + 2] * il, O[et][4 * g + 3] * il);
            *(u32x2*)(orow + et * 32 + 8 * g + 4 * h) = w; }
    __syncthreads();
}
DI void mma_lds(f32x16& acc, const LAS bf16_t* A, int lda, const LAS bf16_t* Bt, int ldb, int K, int lane) {
    const int r = lane & 31, h = lane >> 5;
    for (int k0 = 0; k0 < K; k0 += 16) {
        const bf16x8 a = *(const LAS bf16x8*)(A + r * lda + k0 + 8 * h);
        const bf16x8 b = *(const LAS bf16x8*)(Bt + r * ldb + k0 + 8 * h);
        acc = mfma32(a, b, acc);
    }
}

constexpr int HG_BC = 0, HG_QT = 32768, HG_KT = 50176, HG_VT = 67584, HG_ST = 86016, HG_AT = 104448;
DI float hgrn_lb(const Params& P, int l, int ch) { if (l == 0) return 0.f; const float z0 = P.hgrn_lb[ch], z1 = P.hgrn_lb[256 + ch]; return 1.0f / (1.0f + expf(z0 - z1)); }
DI void hgrn_cumsum(const Ctx& C, const Params& P, int l, const float (&fpv)[16], int ch0) {
    LAS float* BC = (LAS float*)(C.lds + HG_BC);
    const float lb = hgrn_lb(P, l, ch0 + (C.tid & 127));
#pragma unroll
    for (int j = 0; j < 16; ++j) { const float f = lb + (1.0f - lb) * frcp(1.0f + fexp(fminf(-fpv[j], 80.f))); BC[C.tid + 512 * j] = flog(fmaxf(f, 1e-30f)); }
    __syncthreads();
    if (C.tid < 128) { float cum = 0.f;
#pragma unroll 8
        for (int s = 0; s < 64; ++s) { cum += BC[s * 128 + C.tid]; BC[s * 128 + C.tid] = cum; } }
    __syncthreads();
}
DI void hgrn_local_unit(const Ctx& C, const Params& P, int l, int u) {
    const bf16_t* PROJ = (const bf16_t*)(P.ws + WS_R1 + R1_PROJ); float* HS = wsp<float>(P, WS_HS); float* HD = wsp<float>(P, WS_HD);
    const int hp = u & 1, bc = u >> 1, b = bc >> 6, c = bc & 63, tok0 = b * SEQ + c * 64, ch0 = hp * 128;
    LAS float* BC = (LAS float*)(C.lds + HG_BC); LAS bf16_t* KT = (LAS bf16_t*)(C.lds + HG_QT);   LAS bf16_t* VT = (LAS bf16_t*)(C.lds + HG_VT);
    const int cl = C.tid & 127, ch = ch0 + cl; const float lb = hgrn_lb(P, l, ch);
    float fpv[16]; bf16_t vv[16];
#pragma unroll
    for (int j = 0; j < 16; ++j) { const bf16_t* row = PROJ + (size_t)(tok0 + (C.tid >> 7) + 4 * j) * PROJ_LD; fpv[j] = bf2f(row[PC_BF + ch]); vv[j] = row[PC_BI + ch]; }
    hgrn_cumsum(C, P, l, fpv, ch0);
#pragma unroll
    for (int j = 0; j < 16; ++j) { const int s = (C.tid >> 7) + 4 * j; const float kk = (1.0f - lb) * frcp(1.0f + fexp(fminf(fpv[j], 80.f)));
        KT[cl * 72 + s] = f2bf(kk * fexp(BC[63 * 128 + cl] - BC[s * 128 + cl])); VT[cl * 72 + s] = vv[j]; }
    if (C.tid < 128) HD[(size_t)bc * 256 + ch0 + C.tid] = fexp(BC[63 * 128 + C.tid]);
    __syncthreads();
    { const int h2 = C.wave >> 2, dkt = (C.wave >> 1) & 1, dvt = C.wave & 1, r = C.lane & 31, h = C.lane >> 5;
      f32x16 acc = zero16();
      mma_lds(acc, KT + (h2 * 64 + dkt * 32) * 72, 72, VT + (h2 * 64 + dvt * 32) * 72, 72, 64, C.lane);
      float* dst = HS + ((size_t)(bc * 4 + hp * 2 + h2) * 64) * 64;
#pragma unroll
      for (int i = 0; i < 16; ++i) dst[(dkt * 32 + crow(i, h)) * 64 + dvt * 32 + r] = acc[i]; }
    __syncthreads();
}
DI void hgrn_scan_unit(const Ctx& C, const Params& P, int u) {
    float* HS = wsp<float>(P, WS_HS); const float* HD = wsp<float>(P, WS_HD);
    const int id = u * NTHREADS + C.tid;
    const int bh = id >> 12, e = id & 4095, b = bh >> 2, hh = bh & 3, dk = e >> 6;
    float Lv[64], Dv[64];
#pragma unroll
    for (int c = 0; c < 64; ++c) { const size_t bc = (size_t)b * 64 + c; Lv[c] = HS[((bc * 4 + hh) << 12) + e]; Dv[c] = HD[bc * 256 + hh * 64 + dk]; }
    float S = 0.f;
#pragma unroll
    for (int c = 0; c < 64; ++c) { const size_t bc = (size_t)b * 64 + c; HS[((bc * 4 + hh) << 12) + e] = S; S = Dv[c] * S + Lv[c]; }
}
DI void hgrn_out_unit(const Ctx& C, const Params& P, int l, int u) {
    const bf16_t* PROJ = (const bf16_t*)(P.ws + WS_R1 + R1_PROJ); const float* HS = wsp<float>(P, WS_HS); bf16_t* Y = wsp<bf16_t>(P, WS_Y);
    const int hp = u & 1, bc = u >> 1, b = bc >> 6, c = bc & 63, tok0 = b * SEQ + c * 64, ch0 = hp * 128;
    LAS float* BC = (LAS float*)(C.lds + HG_BC); LAS bf16_t* QT = (LAS bf16_t*)(C.lds + HG_QT); LAS bf16_t* KT = (LAS bf16_t*)(C.lds + HG_KT);
    LAS bf16_t* VT = (LAS bf16_t*)(C.lds + HG_VT); LAS bf16_t* ST = (LAS bf16_t*)(C.lds + HG_ST); LAS bf16_t* AT = (LAS bf16_t*)(C.lds + HG_AT);
    const int cl = C.tid & 127, ch = ch0 + cl; const float lb = hgrn_lb(P, l, ch);
    float fpv[16], qv16[16], sp16[16]; bf16_t vv[16];
#pragma unroll
    for (int j = 0; j < 16; ++j) { const bf16_t* row = PROJ + (size_t)(tok0 + (C.tid >> 7) + 4 * j) * PROJ_LD; fpv[j] = bf2f(row[PC_BF + ch]); qv16[j] = bf2f(row[PC_BQ + ch]); vv[j] = row[PC_BI + ch];
        sp16[j] = HS[(((size_t)bc * 4 + hp * 2) << 12) + C.tid + 512 * j]; }
    hgrn_cumsum(C, P, l, fpv, ch0);
#pragma unroll
    for (int j = 0; j < 16; ++j) { const int s = (C.tid >> 7) + 4 * j; const float kk = (1.0f - lb) * frcp(1.0f + fexp(fminf(fpv[j], 80.f)));
        const float q = qv16[j] * frcp(1.0f + fexp(fminf(-qv16[j], 80.f)));
        const float bs = BC[s * 128 + cl], br = BC[31 * 128 + cl];
        QT[s * 136 + cl] = f2bf(q * fexp(fminf(bs - br, 80.f)));
        KT[s * 136 + cl] = f2bf(kk * fexp(fminf(br - bs, 80.f)));
        VT[cl * 72 + s] = vv[j]; }
#pragma unroll
    for (int j = 0; j < 16; ++j) { const int i = C.tid + 512 * j, h2 = i >> 12, e = i & 4095, dk = e >> 6, dv = e & 63;
        ST[(h2 * 64 + dv) * 72 + dk] = f2bf(sp16[j] * fexp(BC[31 * 128 + h2 * 64 + dk])); }
    __syncthreads();
    {
      const int h2 = C.wave >> 2, tt = (C.wave >> 1) & 1, st = C.wave & 1, r = C.lane & 31, h = C.lane >> 5;
      if (st <= tt) { f32x16 acc = zero16();
          mma_lds(acc, QT + (tt * 32) * 136 + h2 * 64, 136, KT + (st * 32) * 136 + h2 * 64, 136, 64, C.lane);
#pragma unroll
          for (int i = 0; i < 16; ++i) { const int t = tt * 32 + crow(i, h), s = st * 32 + r; AT[(h2 * 64 + t) * 72 + s] = (s <= t) ? f2bf(acc[i]) : (bf16_t)0; } } }
    __syncthreads();
    if (C.wave < 4) {
      const int h2 = C.wave >> 1, tt = C.wave & 1, r = C.lane & 31, h = C.lane >> 5;
      f32x16 o[2] = {zero16(), zero16()};
#pragma unroll
      for (int dvt = 0; dvt < 2; ++dvt) {
          mma_lds(o[dvt], VT + (h2 * 64 + dvt * 32) * 72, 72, AT + (h2 * 64 + tt * 32) * 72, 72, (tt + 1) * 32, C.lane);
          mma_lds(o[dvt], ST + (h2 * 64 + dvt * 32) * 72, 72, QT + (tt * 32) * 136 + h2 * 64, 136, 64, C.lane); }
      float ss = 0.f;
#pragma unroll
      for (int dvt = 0; dvt < 2; ++dvt)
#pragma unroll
          for (int i = 0; i < 16; ++i) ss += o[dvt][i] * o[dvt][i];
      ss += __shfl_xor(ss, 32);
      const float rn = 1.0f / sqrtf(ss * (1.0f / 64.0f) + 1e-6f);
      const int t = tok0 + tt * 32 + r, chb = ch0 + h2 * 64;
      const bf16_t* grow = PROJ + (size_t)t * PROJ_LD + PC_BG + chb; bf16_t* yrow = Y + (size_t)t * DM + 256 + chb;
#pragma unroll
      for (int dvt = 0; dvt < 2; ++dvt)
#pragma unroll
          for (int g = 0; g < 4; ++g) { const int dv = dvt * 32 + 8 * g + 4 * h; const u32x2 gw = *(const u32x2*)(grow + dv);
              const float g0 = siluf_(bflo(gw.x)), g1 = siluf_(bfhi(gw.x)), g2 = siluf_(bflo(gw.y)), g3 = siluf_(bfhi(gw.y));
              u32x2 w; w.x = pk2(o[dvt][4 * g] * rn * g0, o[dvt][4 * g + 1] * rn * g1); w.y = pk2(o[dvt][4 * g + 2] * rn * g2, o[dvt][4 * g + 3] * rn * g3);
              *(u32x2*)(yrow + dv) = w; } }
    __syncthreads();
}

DI void sgu_unit(const Ctx& C, const Params& P, int l, int u) {
    const bf16_t* PROJ = (const bf16_t*)(P.ws + WS_R1 + R1_PROJ); bf16_t* Y = wsp<bf16_t>(P, WS_Y); const bf16_t* SW = wsp<bf16_t>(P, W_SGU);
    const float* sb = P.spatial_b + l * 512;
    LAS bf16_t* VT = (LAS bf16_t*)C.lds; const int tok0 = (u >> 1) * 128, half = u & 1;
    {
      const int s = C.wave * 16 + (C.lane >> 2), cq = (C.lane & 3) * 64;
      const bf16_t* src = PROJ + (size_t)(tok0 + s) * PROJ_LD + PC_CV + cq;
      u32x4 w[8];
#pragma unroll
      for (int j = 0; j < 8; ++j) w[j] = *(const u32x4*)(src + 8 * j);
      float v[64]; float sm = 0.f;
#pragma unroll
      for (int j = 0; j < 8; ++j)
#pragma unroll
          for (int e = 0; e < 4; ++e) { const float a = gelu_tanh(bflo(w[j][e])), b2 = gelu_tanh(bfhi(w[j][e])); v[8 * j + 2 * e] = a; v[8 * j + 2 * e + 1] = b2; sm += a + b2; }
      sm += __shfl_xor(sm, 1); sm += __shfl_xor(sm, 2);
      const float mu = sm * (1.0f / 256.0f); float q = 0.f;
#pragma unroll
      for (int i = 0; i < 64; ++i) { v[i] -= mu; q += v[i] * v[i]; }
      q += __shfl_xor(q, 1); q += __shfl_xor(q, 2);
      const float rs = 1.0f / sqrtf(q * (1.0f / 256.0f) + 1e-6f);
#pragma unroll
      for (int i = 0; i < 64; ++i) VT[(cq + i) * 136 + s] = f2bf(v[i] * rs);
    }
    __syncthreads();
    { const int g = C.wave >> 1, dt = C.wave & 1, r = C.lane & 31, h = C.lane >> 5;
      for (int ti = 0; ti < 2; ++ti) { const int tt = half ? (1 + ti) : (ti * 3);
          f32x16 acc = zero16();
          const bf16_t* wrow = SW + ((size_t)g * 128 + tt * 32 + r) * 128 + 8 * h;
          const LAS bf16_t* vrow = VT + (g * 64 + dt * 32 + r) * 136 + 8 * h;
          bf16x8 af[8];
#pragma unroll
          for (int kk = 0; kk < 8; ++kk) af[kk] = *(const bf16x8*)(wrow + (kk < 2 * (tt + 1) ? kk * 16 : 0));
#pragma unroll
          for (int kk = 0; kk < 8; ++kk) if (kk < 2 * (tt + 1)) { const bf16x8 bb = *(const LAS bf16x8*)(vrow + kk * 16); acc = mfma32(af[kk], bb, acc); }
          const int ch = g * 64 + dt * 32 + r;
#pragma unroll
          for (int i = 0; i < 16; ++i) { const int t = tt * 32 + crow(i, h); const size_t tok = (size_t)(tok0 + t);
              const float uu = gelu_tanh(bf2f(PROJ[tok * PROJ_LD + PC_CU + ch]));
              Y[tok * DM + 512 + ch] = f2bf(uu * (acc[i] + sb[g * 128 + t])); } } }
    __syncthreads();
}

DI void phase_router(const Ctx& C, const Params& P, int l, const bool dry = false) {
    float* XR = P.out; bf16_t* H = wsp<bf16_t>(P, WS_H);
    int* TOKE = wsp<int>(P, WS_TOKE); float* TOKW = wsp<float>(P, WS_TOKW); int* RANK = wsp<int>(P, WS_RANK); int* ROWTOK = dry ? wsp<int>(P, WS_DUMMY) : wsp<int>(P, WS_ROWTOK);
    unsigned* CNT = wsp<unsigned>(P, WS_CTL) + CW_CNT + 64 * l + (dry ? 256 : 0);
    const float* gain = P.norm_ffn + l * DM;
    const float* brg = P.b_rg + l * 4; const float* bre = P.b_re + l * 32;
    LAS bf16_t* XHL = (LAS bf16_t*)C.lds; LAS float* PART = (LAS float*)C.lds; LAS float* LOG = (LAS float*)(C.lds + 32768);
    LAS unsigned* lcnt = (LAS unsigned*)(C.lds + LDS_MISC + 1024); LAS unsigned* lbase = lcnt + 32;
    if (C.tid < 32) lcnt[C.tid] = 0u;
    __syncthreads();
    const int per = NTOK / C.G;
    const int r = C.lane & 31, h = C.lane >> 5;
    for (int it = 0; it < per; it += 32) {
        const int tok0 = C.bid * per + it;
        { f32x4 v[4][4];
#pragma unroll
          for (int j = 0; j < 4; ++j) { const float* xr = XR + (size_t)(tok0 + C.wave * 4 + j) * DM;
#pragma unroll
              for (int q = 0; q < 4; ++q) v[j][q] = *(const f32x4*)(xr + q * 256 + C.lane * 4); }
#pragma unroll
          for (int j = 0; j < 4; ++j) { const int tl = C.wave * 4 + j, t = tok0 + tl; float ss = 0.f;
#pragma unroll
              for (int q = 0; q < 4; ++q) ss += v[j][q][0] * v[j][q][0] + v[j][q][1] * v[j][q][1] + v[j][q][2] * v[j][q][2] + v[j][q][3] * v[j][q][3];
              ss = wave_sum(ss); const float rs = 1.0f / sqrtf(ss * (1.0f / DM) + 1e-6f);
#pragma unroll
              for (int q = 0; q < 4; ++q) { const int c = q * 256 + C.lane * 4; const f32x4 g = *(const f32x4*)(gain + c);
                  const f32x4 o = (f32x4){v[j][q][0] * rs * g[0], v[j][q][1] * rs * g[1], v[j][q][2] * rs * g[2], v[j][q][3] * rs * g[3]};
                  u32x2 w; w.x = pk2(o[0], o[1]); w.y = pk2(o[2], o[3]); *(u32x2*)(H + (size_t)t * DM + c) = w;
                  { u32x2 wl; wl.x = pk2(o[0] - bflo(w.x), o[1] - bfhi(w.x)); wl.y = pk2(o[2] - bflo(w.y), o[3] - bfhi(w.y));
                    *(LAS u32x2*)(XHL + tl * 1032 + c) = w; *(LAS u32x2*)(XHL + 33024 + tl * 1032 + c) = wl; } } } }
        __syncthreads();
        f32x16 acc = zero16();
        { const int ct = C.wave & 1, kq = C.wave >> 1;
          const LAS bf16_t* ah = XHL + r * 1032 + kq * 256 + 8 * h; const LAS bf16_t* al = ah + 33024;
          const bf16_t* bh_ = wsp<bf16_t>(P, W_RH) + (size_t)(ct * 32 + r) * 1024 + kq * 256 + 8 * h; const bf16_t* bl_ = bh_ + (size_t)64 * 1024;
#pragma unroll 4
          for (int k0 = 0; k0 < 256; k0 += 16) { const bf16x8 xh = *(const LAS bf16x8*)(ah + k0), xl = *(const LAS bf16x8*)(al + k0);
              const bf16x8 wh = *(const bf16x8*)(bh_ + k0), wl = *(const bf16x8*)(bl_ + k0);
              acc = mfma32(xh, wh, acc); acc = mfma32(xh, wl, acc); acc = mfma32(xl, wh, acc); } }
        __syncthreads();
#pragma unroll
        for (int i = 0; i < 16; ++i) PART[(C.wave * 16 + i) * 64 + C.lane] = acc[i];
        __syncthreads();
        for (int idx = C.tid; idx < 32 * 36; idx += NTHREADS) { const int tok = idx / 36, col = idx % 36, ct = col < 32 ? 0 : 1, cc = col < 32 ? col : col - 32;
            const int hh = (tok >> 2) & 1, reg = (tok & 3) + 4 * (tok >> 3); float s = 0.f;
#pragma unroll
            for (int kq = 0; kq < 4; ++kq) s += PART[((kq * 2 + ct) * 16 + reg) * 64 + cc + 32 * hh];
            LOG[tok * 36 + col] = s; }
        __syncthreads();
        if (C.tid < 32) { const int t = tok0 + C.tid; const LAS float* lg = LOG + C.tid * 36;
            float gl[4]; int gsel = 0;
#pragma unroll
            for (int k = 0; k < 4; ++k) gl[k] = lg[32 + k] + brg[k];
            float gmax = gl[0];
#pragma unroll
            for (int k = 1; k < 4; ++k) if (gl[k] > gmax) { gmax = gl[k]; gsel = k; }
            float gsum = 0.f;
#pragma unroll
            for (int k = 0; k < 4; ++k) gsum += expf(gl[k] - gmax);
            const float pg = 1.0f / gsum;
            float pe[8]; float emax = -1e30f;
#pragma unroll
            for (int k = 0; k < 8; ++k) { pe[k] = lg[gsel * 8 + k] + bre[gsel * 8 + k]; emax = fmaxf(emax, pe[k]); }
#pragma unroll
            for (int k = 0; k < 8; ++k) pe[k] = expf(pe[k] - emax);
            int i1 = 0; float p1 = pe[0];
#pragma unroll
            for (int k = 1; k < 8; ++k) if (pe[k] > p1) { p1 = pe[k]; i1 = k; }
            int i2 = (i1 == 0) ? 1 : 0; float p2 = pe[i2];
#pragma unroll
            for (int k = 0; k < 8; ++k) if (k != i1 && pe[k] > p2) { p2 = pe[k]; i2 = k; }
            const float inv = pg / (p1 + p2);
            const int e1 = gsel * 8 + i1, e2 = gsel * 8 + i2;
            TOKE[t * 2] = e1; TOKE[t * 2 + 1] = e2; TOKW[t * 2] = p1 * inv; TOKW[t * 2 + 1] = p2 * inv;
            RANK[t * 2] = (int)__hip_atomic_fetch_add(lcnt + e1, 1u, __ATOMIC_RELAXED, __HIP_MEMORY_SCOPE_WORKGROUP);
            RANK[t * 2 + 1] = (int)__hip_atomic_fetch_add(lcnt + e2, 1u, __ATOMIC_RELAXED, __HIP_MEMORY_SCOPE_WORKGROUP); }
        __syncthreads();
    }
    if (C.tid < 32) { const unsigned n = lcnt[C.tid]; lbase[C.tid] = n ? __hip_atomic_fetch_add(CNT + C.tid, n, __ATOMIC_RELAXED, __HIP_MEMORY_SCOPE_AGENT) : 0u; }
    __syncthreads();
    asm volatile("s_waitcnt vmcnt(0)" ::: "memory");
    for (int a = C.tid; a < per * 2; a += NTHREADS) { const int ga = C.bid * per * 2 + a; const int e = TOKE[ga]; const unsigned rk = lbase[e] + (unsigned)RANK[ga];
        ROWTOK[(size_t)e * MOE_CAP + rk] = ga; }
    __syncthreads();
}
typedef f32x4 AccT[2][2][4][2];
DI u32x4 pack8(const f32x4& a, const f32x4& b) { u32x4 w; w.x = pk2(a[0], a[1]); w.y = pk2(a[2], a[3]); w.z = pk2(b[0], b[1]); w.w = pk2(b[2], b[3]); return w; }
template <int ACT> struct EpiStore {
    bf16_t* O; int ldc;
    DI void operator()(const AccT& acc, const pg8::Unit& u, int wr, int wc, int fr, int fq) const {
#pragma unroll
        for (int ai = 0; ai < 2; ++ai)
#pragma unroll
            for (int m = 0; m < 4; ++m) { const size_t row = (size_t)(u.pm * 256 + ai * 128 + wr * 64 + m * 16 + fr);
#pragma unroll
                for (int bj = 0; bj < 2; ++bj) { const int col = u.pn * 256 + bj * 128 + wc * 32 + 8 * fq; f32x4 a = acc[ai][bj][m][0], b = acc[ai][bj][m][1];
                    if (ACT == 1) {
#pragma unroll
                        for (int j = 0; j < 4; ++j) { a[j] = sigmoidf_(a[j]); b[j] = sigmoidf_(b[j]); } }
                    *(u32x4*)(O + row * ldc + col) = pack8(a, b); } }
    }
};
struct EpiMerge {
    const bf16_t* GATE; bf16_t* MG;
    DI void operator()(const AccT& acc, const pg8::Unit& u, int wr, int wc, int fr, int fq) const {
#pragma unroll
        for (int ai = 0; ai < 2; ++ai)
#pragma unroll
            for (int m = 0; m < 4; ++m) { const size_t row = (size_t)(u.pm * 256 + ai * 128 + wr * 64 + m * 16 + fr);
#pragma unroll
                for (int bj = 0; bj < 2; ++bj) { const int col = u.pn * 256 + bj * 128 + wc * 32 + 8 * fq;
                    const u32x4 g = *(const u32x4*)(GATE + row * 4096 + u.x * 1024 + col);
                    f32x4 a = acc[ai][bj][m][0], b = acc[ai][bj][m][1];
                    a[0] *= bflo(g.x); a[1] *= bfhi(g.x); a[2] *= bflo(g.y); a[3] *= bfhi(g.y); b[0] *= bflo(g.z); b[1] *= bfhi(g.z); b[2] *= bflo(g.w); b[3] *= bfhi(g.w);
                    bf16_t* dst = MG + row * 1024 + col;
                    if (u.x > 0) { const u32x4 p = *(const u32x4*)dst;
                        a[0] += bflo(p.x); a[1] += bfhi(p.x); a[2] += bflo(p.y); a[3] += bfhi(p.y); b[0] += bflo(p.z); b[1] += bfhi(p.z); b[2] += bflo(p.w); b[3] += bfhi(p.w); }
                    *(u32x4*)dst = pack8(a, b); }
                asm volatile("" ::: "memory"); }
    }
};
struct EpiResid {
    float* XR;
    DI void operator()(const AccT& acc, const pg8::Unit& u, int wr, int wc, int fr, int fq) const {
#pragma unroll
        for (int ai = 0; ai < 2; ++ai)
#pragma unroll
            for (int m = 0; m < 4; ++m) { const size_t row = (size_t)(u.pm * 256 + ai * 128 + wr * 64 + m * 16 + fr);
#pragma unroll
                for (int bj = 0; bj < 2; ++bj) { float* p = XR + row * 1024 + u.pn * 256 + bj * 128 + wc * 32 + 8 * fq;
                    const f32x4 x0 = *(const f32x4*)p, x1 = *(const f32x4*)(p + 4);
                    *(f32x4*)p = x0 + acc[ai][bj][m][0]; *(f32x4*)(p + 4) = x1 + acc[ai][bj][m][1]; }
                if (m == 3) asm volatile("" ::: "memory"); }
    }
};
struct EpiResidNorm {
    float* XR; bf16_t* XB; float* RSS;
    DI void operator()(const AccT& acc, const pg8::Unit& u, int wr, int wc, int fr, int fq) const {
#pragma unroll
        for (int ai = 0; ai < 2; ++ai)
#pragma unroll
            for (int m = 0; m < 4; ++m) { const size_t row = (size_t)(u.pm * 256 + ai * 128 + wr * 64 + m * 16 + fr); float ss = 0.f;
#pragma unroll
                for (int bj = 0; bj < 2; ++bj) { const size_t off = row * 1024 + u.pn * 256 + bj * 128 + wc * 32 + 8 * fq; float* p = XR + off;
                    const f32x4 x0 = *(const f32x4*)p + acc[ai][bj][m][0], x1 = *(const f32x4*)(p + 4) + acc[ai][bj][m][1];
                    *(f32x4*)p = x0; *(f32x4*)(p + 4) = x1; *(u32x4*)(XB + off) = pack8(x0, x1);
                    ss += (x0[0] * x0[0] + x0[1] * x0[1]) + (x0[2] * x0[2] + x0[3] * x0[3]) + (x1[0] * x1[0] + x1[1] * x1[1]) + (x1[2] * x1[2] + x1[3] * x1[3]); }
                ss += __shfl_xor(ss, 16); ss += __shfl_xor(ss, 32);
                if (fq == 0) RSS[row * 16 + u.pn * 4 + wc] = ss;
                if (m == 3) asm volatile("" ::: "memory"); }
    }
};
struct EpiStoreRstd {
    bf16_t* O; int ldc; const float* RSS;
    DI void operator()(const AccT& acc, const pg8::Unit& u, int wr, int wc, int fr, int fq) const {
#pragma unroll
        for (int ai = 0; ai < 2; ++ai)
#pragma unroll
            for (int m = 0; m < 4; ++m) { const size_t row = (size_t)(u.pm * 256 + ai * 128 + wr * 64 + m * 16 + fr);
                const f32x4* rp = (const f32x4*)(RSS + row * 16); const f32x4 r0 = rp[0], r1 = rp[1], r2 = rp[2], r3 = rp[3];
                const float rsum = ((r0[0] + r0[1]) + (r0[2] + r0[3])) + ((r1[0] + r1[1]) + (r1[2] + r1[3])) + ((r2[0] + r2[1]) + (r2[2] + r2[3])) + ((r3[0] + r3[1]) + (r3[2] + r3[3]));
                const float rs = 1.0f / sqrtf(rsum * (1.0f / 1024.0f) + 1e-6f);
#pragma unroll
                for (int bj = 0; bj < 2; ++bj) { const int col = u.pn * 256 + bj * 128 + wc * 32 + 8 * fq;
                    *(u32x4*)(O + row * ldc + col) = pack8(acc[ai][bj][m][0] * rs, acc[ai][bj][m][1] * rs); } }
    }
};
struct EpiGU {
    bf16_t* HID;
    DI void operator()(const AccT& acc, const pg8::Unit& u, int wr, int wc, int fr, int fq) const {
#pragma unroll
        for (int ai = 0; ai < 2; ++ai)
#pragma unroll
            for (int m = 0; m < 4; ++m) { const size_t row = (size_t)(u.pm * 256 + ai * 128 + wr * 64 + m * 16 + fr);
                f32x4 a, b;
#pragma unroll
                for (int j = 0; j < 4; ++j) { a[j] = siluf_(acc[ai][0][m][0][j]) * acc[ai][1][m][0][j]; b[j] = siluf_(acc[ai][0][m][1][j]) * acc[ai][1][m][1][j]; }
                *(u32x4*)(HID + row * 256 + u.pn * 128 + wc * 32 + 8 * fq) = pack8(a, b); }
    }
};
struct EpiDown {
    bf16_t* YB; const int* ROWTOK; const float* TOKW; const LAS int* cnt;
    DI void operator()(const AccT& acc, const pg8::Unit& u, int wr, int wc, int fr, int fq) const {
        const int ce = cnt[u.x];
#pragma unroll
        for (int ai = 0; ai < 2; ++ai)
#pragma unroll
            for (int m = 0; m < 4; ++m) { const int idx = u.y * 256 + ai * 128 + wr * 64 + m * 16 + fr;
                if (idx < ce) { const int a = ROWTOK[(size_t)u.x * MOE_CAP + idx]; const float w = TOKW[a];
#pragma unroll
                    for (int bj = 0; bj < 2; ++bj) { const int col = u.pn * 256 + bj * 128 + wc * 32 + 8 * fq;
                        *(u32x4*)(YB + (size_t)a * 1024 + col) = pack8(acc[ai][bj][m][0] * w, acc[ai][bj][m][1] * w); } } }
    }
};

struct FusedMergeOrder {
    const char* Hb; const char* Yb; const char* Wg; const char* Wb; int G, c;
    DI bool next(int i, pg8::Unit& u) const {
        const int ti = i >> 3, x = i & 7, n = x >> 1; const long L = (long)ti * G + c; if (L >= 256) return false;
        pg8::tile_map((int)L, 64, 4, u.pm, u.pn); u.x = x; u.y = 0;
        if (x & 1) { u.a = Yb + (size_t)u.pm * 256 * 1024 * 2 + (size_t)n * 256 * 2; u.b = Wb + (size_t)u.pn * 256 * 1024 * 2 + (size_t)n * 256 * 2; u.nt = 4; }
        else { u.a = Hb + (size_t)u.pm * 256 * 1024 * 2; u.b = Wg + ((size_t)n * 1024 + (size_t)u.pn * 256) * 1024 * 2; u.nt = 16; }
        return true; }
    DI unsigned row_off(const pg8::Unit&, int) const { return 0u; }
};
struct EpiFusedMerge {
    bf16_t* GS; bf16_t* MG; int tid;
    DI void operator()(const AccT& acc, const pg8::Unit& u, int wr, int wc, int fr, int fq) const {
        const int tid_ = (wr * 4 + wc) * 64 + fq * 16 + fr;
        u32x4* gs = (u32x4*)GS + tid_; u32x4* ps = gs + (R1_PS - R1_GS) / 16;
        if ((u.x & 1) == 0) {
#pragma unroll
            for (int ai = 0; ai < 2; ++ai)
#pragma unroll
                for (int m = 0; m < 4; ++m)
#pragma unroll
                    for (int bj = 0; bj < 2; ++bj) { f32x4 a = acc[ai][bj][m][0], b = acc[ai][bj][m][1];
#pragma unroll
                        for (int j = 0; j < 4; ++j) { a[j] = sigmoidf_(a[j]); b[j] = sigmoidf_(b[j]); }
                        gs[((ai * 4 + m) * 2 + bj) * 512] = pack8(a, b); }
        } else {
#pragma unroll
            for (int ai = 0; ai < 2; ++ai)
#pragma unroll
                for (int m = 0; m < 4; ++m) { const size_t row = (size_t)(u.pm * 256 + ai * 128 + wr * 64 + m * 16 + fr);
#pragma unroll
                    for (int bj = 0; bj < 2; ++bj) { const int col = u.pn * 256 + bj * 128 + wc * 32 + 8 * fq; const int si = ((ai * 4 + m) * 2 + bj) * 512;
                        const u32x4 g = gs[si];
                        f32x4 a = acc[ai][bj][m][0], b = acc[ai][bj][m][1];
                        a[0] *= bflo(g.x); a[1] *= bfhi(g.x); a[2] *= bflo(g.y); a[3] *= bfhi(g.y); b[0] *= bflo(g.z); b[1] *= bfhi(g.z); b[2] *= bflo(g.w); b[3] *= bfhi(g.w);
                        if (u.x > 1) { const u32x4 p = ps[si];
                            a[0] += bflo(p.x); a[1] += bfhi(p.x); a[2] += bflo(p.y); a[3] += bfhi(p.y); b[0] += bflo(p.z); b[1] += bfhi(p.z); b[2] += bflo(p.w); b[3] += bfhi(p.w); }
                        if (u.x < 7) ps[si] = pack8(a, b); else *(u32x4*)(MG + row * 1024 + col) = pack8(a, b); }
                    if (m & 1) asm volatile("" ::: "memory"); }
        }
    }
};
constexpr int MOE_TAB = LDS_MISC + 256;
DI void moe_build_table(const Ctx& C, const unsigned* CNT) {
    volatile LAS int* T = (volatile LAS int*)(C.lds + MOE_TAB);
    if (C.tid == 0) { int acc = 0; for (int e = 0; e < 32; ++e) { const int n = (int)CNT[e]; T[e] = acc; T[40 + e] = n; const int nt = (n + 255) >> 8;
            for (int j = 0; j < nt; ++j) T[80 + acc + j] = (e << 8) | j;
            acc += nt; } T[32] = acc; }
    __syncthreads();
}
template <int NPN, bool GU> struct MoeOrder {
    const LAS int* T; const char* Ab; const char* Wb; const int* ROWTOK; int G, c;
    DI bool next(int i, pg8::Unit& u) const {
        const long L0 = (long)i * G + c; const int tot = __builtin_amdgcn_readfirstlane(T[32]) * NPN, per = (tot + 7) >> 3, j_ = (int)(L0 >> 3);
        if (j_ >= per) return false;
        const long L = (long)(L0 & 7) * per + j_; if (L >= tot) return false;
        const int tile = (int)(L / NPN), pn = (int)(L % NPN);
        const int ej = __builtin_amdgcn_readfirstlane(T[80 + tile]); const int e = ej >> 8;
        u.x = e; u.y = ej & 255; u.pm = tile; u.pn = pn; u.nt = 0;
        if (GU) { u.a = Ab; u.b = Wb + ((size_t)e * 512 + (size_t)pn * 256) * 1024 * 2; }
        else { u.a = Ab + (size_t)tile * 256 * 256 * 2; u.b = Wb + ((size_t)e * 1024 + (size_t)pn * 256) * 256 * 2; }
        return true; }
    DI unsigned row_off(const pg8::Unit& u, int row) const {
        const int idx = u.y * 256 + row; int tok = 0;
        if (idx < T[40 + u.x]) tok = ROWTOK[(size_t)u.x * MOE_CAP + idx] >> 1;
        return (unsigned)tok * 2048u; }
};

constexpr int PH_PER_LAYER = 16, PH_L0 = 1, N_PHASES = PH_L0 + DEPTH * PH_PER_LAYER + 1;
#ifndef ENABLE_MASK
#define ENABLE_MASK 0xFF
#endif
#ifndef PROBE_DUP
#define PROBE_DUP 0
#endif
#define NREP(bit) ((PROBE_DUP & (bit)) ? 2 : 1)
#define ZIGZAG(n, call) do { for (int _rd = 0; _rd * C.G < (n); ++_rd) { const int u = _rd * C.G + ((_rd & 1) ? (C.G - 1 - C.bid) : C.bid); if (u < (n)) { call; } } } while (0)

typedef const Params __attribute__((address_space(4))) KParams;
#if defined(__HIP_DEVICE_COMPILE__)
#define PHASE_LOADP() KParams* _pp = (KParams*)__builtin_amdgcn_kernarg_segment_ptr(); asm volatile("" : "+s"(_pp)); const Params P = *_pp
#else
#define PHASE_LOADP() const Params P = Parg
#endif
#define PHASE_ENV() PHASE_LOADP(); const Ctx C = relaunder(C0); LAS unsigned char* lds = C.lds; bf16_t* H = wsp<bf16_t>(P, WS_H); bf16_t* Y = wsp<bf16_t>(P, WS_Y); unsigned char* R1 = P.ws + WS_R1
#define IN(k) (lo <= (k) && (k) < hi)
#define SEAM(k) do { if (IN(k) && IN((k) + 1)) { xcd_barrier(bar); if (PROBE_DUP & 1048576) xcd_barrier(bar); } } while (0)
template <int l> DI void layer_phases(const Ctx& C0, const Params& Parg, const int lo, const int hi, const XcdBarrier& bar) {
    constexpr int pb = PH_L0 + l * PH_PER_LAYER;
        if (IN(pb + 0)) { PHASE_ENV(); for (int rep = 0; rep < NREP(8); ++rep) phase_convert_layer(C, P, l);
            if (l == 0) phase_rownorm<false, true, false, true>(C, P, P.norm_mix + l * DM); else if (!(ENABLE_MASK & 32)) phase_rownorm<false, true, false>(C, P, P.norm_mix + l * DM); else phase_rownorm<true, true, false>(C, P, P.norm_mix + l * DM); } SEAM(pb + 0);
        if (IN(pb + 1)) for (int rep = 0; rep < NREP(16); ++rep) { PHASE_ENV();
            { pg8::DenseOrder S; S.init(H, wsp<bf16_t>(P, W_IN), NTOK, 2560, 1024, 1024, C.G, C.bid);
              EpiStore<0> E{(bf16_t*)(R1 + R1_PROJ), PROJ_LD}; pg8::gemm_phase<EpiStore<0>, pg8::DenseOrder, false>(C.tid, lds, 1024, 1024, 1024, S, E); }
            { pg8::DenseOrder S; S.init(wsp<bf16_t>(P, W_V), H, 512, NTOK, 1024, 1024, C.G, (C.bid + 128) % C.G);
              EpiStore<0> E{(bf16_t*)(R1 + R1_VT), NTOK}; pg8::gemm_phase<EpiStore<0>, pg8::DenseOrder, false>(C.tid, lds, 1024, 1024, 1024, S, E); }
            if (l == 0) {
        for (int lm = 0; lm < DEPTH; ++lm) {
            const bf16_t* MEMN = wsp<bf16_t>(P, WS_MEMN) + (size_t)lm * 1024 * 1024; const bf16_t* WKV = wsp<bf16_t>(P, W_KV) + (size_t)lm * 512 * 1024;
            { pg8::DenseOrder S; S.init(MEMN, WKV, 1024, 256, 1024, 1024, C.G, (C.bid + 8 * lm) % C.G);
              EpiStore<0> E{wsp<bf16_t>(P, WS_MK) + (size_t)lm * 1024 * 256, 256}; pg8::gemm_phase<EpiStore<0>, pg8::DenseOrder, false>(C.tid, lds, 1024, 1024, 1024, S, E); }
            { pg8::DenseOrder S; S.init(WKV + (size_t)256 * 1024, MEMN, 256, 1024, 1024, 1024, C.G, (C.bid + 8 * lm + 4) % C.G);
              EpiStore<0> E{wsp<bf16_t>(P, WS_MVT) + (size_t)lm * 256 * 1024, 1024}; pg8::gemm_phase<EpiStore<0>, pg8::DenseOrder, false>(C.tid, lds, 1024, 1024, 1024, S, E); }
        }
            }
        } SEAM(pb + 1);
        if (IN(pb + 2)) { PHASE_ENV(); phase_rope(C, P, l); } SEAM(pb + 2);
        if (IN(pb + 3)) { PHASE_ENV();
            for (int rep = 0; rep < NREP(1); ++rep) { if (ENABLE_MASK & 8) { const int xb = (C.bid & 7) >> 1, kq = ((C.bid & 7) & 1) * 32 + ((C.bid >> 3) & 31);
                  dsa_select_unit(C, P, l, xb, 127 - kq); dsa_select_unit(C, P, l, xb, kq); } }
            for (int rep = 0; rep < NREP(1024); ++rep) { if (ENABLE_MASK & 2) ZIGZAG(512, hgrn_local_unit(C, P, l, u);); }
            for (int rep = 0; rep < NREP(2048); ++rep) { if (ENABLE_MASK & 4) ZIGZAG(256, sgu_unit(C, P, l, u);); }
        } SEAM(pb + 3);
        if (IN(pb + 4)) { PHASE_ENV();
            for (int rep = 0; rep < NREP(2); ++rep) { if (ENABLE_MASK & 1) causal_attn_block2<true>(C, P, l); }
            if (ENABLE_MASK & 2) { for (int u = C.G - 1 - C.bid; u < 128; u += C.G) hgrn_scan_unit(C, P, u); }
        } SEAM(pb + 4);
        if (IN(pb + 5)) {
            for (int rep = 0; rep < NREP(4); ++rep) { PHASE_ENV();
            for (int r2 = 0; r2 < NREP(2097152); ++r2) { if (ENABLE_MASK & 8) causal_attn_block2<false>(C, P, l); }
            for (int r3 = 0; r3 < NREP(4194304); ++r3) { if (ENABLE_MASK & 2) ZIGZAG(512, hgrn_out_unit(C, P, l, u);); } }
        } SEAM(pb + 5);
        if (IN(pb + 7)) for (int rep = 0; rep < NREP(128); ++rep) { PHASE_ENV();
            FusedMergeOrder S{(const char*)H, (const char*)Y, (const char*)wsp<bf16_t>(P, W_G), (const char*)wsp<bf16_t>(P, W_BR), C.G, C.bid};
            EpiFusedMerge E{(bf16_t*)(R1 + R1_GS) + (size_t)C.bid * 65536, (bf16_t*)(R1 + R1_MG), C.tid};
            pg8::gemm_phase<EpiFusedMerge, FusedMergeOrder, false>(C.tid, lds, 1024, 1024, 1024, S, E);
        } SEAM(pb + 7);
        if (IN(pb + 8)) { PHASE_ENV();
            pg8::DenseOrder S; S.init(R1 + R1_MG, wsp<bf16_t>(P, W_OUT), NTOK, 1024, 1024, 1024, C.G, C.bid);
            EpiResidNorm E{P.out, H, wsp<float>(P, WS_RSS)}; pg8::gemm_phase<EpiResidNorm, pg8::DenseOrder, false>(C.tid, lds, 1024, 1024, 1024, S, E);
        } SEAM(pb + 8);
        if (IN(pb + 10)) for (int rep = 0; rep < NREP(64); ++rep) { PHASE_ENV();
            pg8::DenseOrder S; S.init(H, wsp<bf16_t>(P, W_Q), NTOK, 256, 1024, 1024, C.G, C.bid);
            EpiStoreRstd E{(bf16_t*)(R1 + R1_MQ), 256, wsp<float>(P, WS_RSS)}; pg8::gemm_phase<EpiStoreRstd, pg8::DenseOrder, false>(C.tid, lds, 1024, 1024, 1024, S, E);
        } SEAM(pb + 10);
        if (IN(pb + 11)) for (int rep = 0; rep < NREP(64); ++rep) { PHASE_ENV(); mem_attn_block(C, P, l); } SEAM(pb + 11);
        if (IN(pb + 12)) { PHASE_ENV();
            if (ENABLE_MASK & 16) { pg8::DenseOrder S; S.init(R1 + R1_MO, wsp<bf16_t>(P, W_O), NTOK, 1024, 256, 256, C.G, C.bid);
              EpiResid E{P.out}; pg8::gemm_phase<EpiResid, pg8::DenseOrder, false>(C.tid, lds, 256, 256, 256, S, E); }
        } SEAM(pb + 12);
        if (IN(pb + 13)) { PHASE_ENV(); phase_router(C, P, l); if (PROBE_DUP & 512) { __syncthreads(); phase_router(C, P, l, true); } } SEAM(pb + 13);
        if (IN(pb + 14)) for (int rep = 0; rep < NREP(32); ++rep) { PHASE_ENV();
            moe_build_table(C, wsp<unsigned>(P, WS_CTL) + CW_CNT + 64 * l);
            MoeOrder<2, true> S{(const LAS int*)(lds + MOE_TAB), (const char*)H, (const char*)wsp<bf16_t>(P, W_GU), wsp<int>(P, WS_ROWTOK), C.G, C.bid};
            EpiGU E{(bf16_t*)(R1 + R1_HID)}; pg8::gemm_phase<EpiGU, MoeOrder<2, true>, true>(C.tid, lds, 1024, 1024, 1024, S, E);
        } SEAM(pb + 14);
        if (IN(pb + 15)) for (int rep = 0; rep < NREP(32); ++rep) { PHASE_ENV();
            moe_build_table(C, wsp<unsigned>(P, WS_CTL) + CW_CNT + 64 * l);
            MoeOrder<4, false> S{(const LAS int*)(lds + MOE_TAB), (const char*)(R1 + R1_HID), (const char*)wsp<bf16_t>(P, W_D), wsp<int>(P, WS_ROWTOK), C.G, C.bid};
            EpiDown E{(bf16_t*)(R1 + R1_YB), wsp<int>(P, WS_ROWTOK), wsp<float>(P, WS_TOKW), (const LAS int*)(lds + MOE_TAB) + 40};
            pg8::gemm_phase<EpiDown, MoeOrder<4, false>, false>(C.tid, lds, 256, 256, 256, S, E);
        } SEAM(pb + 15);
    }
__global__ void __launch_bounds__(NTHREADS, 2) mega_fwd(Params Parg) {
    extern __shared__ __attribute__((aligned(16))) unsigned char lds_raw[];
    Ctx C0; C0.lds = (LAS unsigned char*)lds_raw; C0.tid = threadIdx.x; C0.lane = C0.tid & 63; C0.wave = __builtin_amdgcn_readfirstlane((int)threadIdx.x >> 6); C0.G = gridDim.x; C0.bid = blockIdx.x;
    volatile LAS unsigned* misc = (volatile LAS unsigned*)(C0.lds + LDS_MISC);
    if (C0.tid < 4) misc[C0.tid] = 0u;
    __syncthreads();
    const int lo = Parg.ph_lo, hi = Parg.ph_hi;
    const bool use_bar = (hi - lo) > 1;
    XcdBarrier bar; bar.bar = (unsigned*)(Parg.ws + WS_CTL) + CW_BAR; bar.x = 0; bar.st = misc;
    if (use_bar) bar = xcd_barrier_post((unsigned*)(Parg.ws + WS_CTL) + CW_BAR, misc);
#define IN(k) (lo <= (k) && (k) < hi)
#define SEAM(k) do { if (IN(k) && IN((k) + 1)) { xcd_barrier(bar); if (PROBE_DUP & 1048576) xcd_barrier(bar); } } while (0)

    if (IN(0)) { PHASE_ENV(); phase_prologue(C, P); } SEAM(0);
    layer_phases<0>(C0, Parg, lo, hi, bar);
    layer_phases<1>(C0, Parg, lo, hi, bar);
    if (IN(N_PHASES - 1)) { PHASE_ENV(); if (ENABLE_MASK & 32) phase_rownorm<true, false, true>(C, P, P.norm_final); else phase_rownorm<false, false, true>(C, P, P.norm_final); }
#undef IN
#undef SEAM
}

#ifndef N_LAUNCH_MODE
#define N_LAUNCH_MODE 0
#endif
extern "C" void kernel_launch(void* const* d_in, const int* in_sizes, int n_in, void* d_out, int out_size, void* d_ws, size_t ws_size, hipStream_t stream) {
    static int grid = 0;
    if (grid == 0) {
        if (n_in != 25 || out_size != NTOK * DM || ws_size < WS_END) { fprintf(stderr, "kernel_launch: unexpected shapes (n_in %d out %d ws %zu need %zu)\n", n_in, out_size, ws_size, (size_t)WS_END); grid = -1; return; }
        int dev = 0, cus = 0;
        if (hipGetDevice(&dev) != hipSuccess || hipDeviceGetAttribute(&cus, hipDeviceAttributeMultiprocessorCount, dev) != hipSuccess) { grid = -1; return; }
        if (hipFuncSetAttribute((const void*)mega_fwd, hipFuncAttributeMaxDynamicSharedMemorySize, LDS_BYTES) != hipSuccess) { fprintf(stderr, "kernel_launch: hipFuncSetAttribute failed\n"); grid = -1; return; }
        int per_cu = 0;
        if (hipOccupancyMaxActiveBlocksPerMultiprocessor(&per_cu, (const void*)mega_fwd, NTHREADS, LDS_BYTES) != hipSuccess || per_cu < 1) { fprintf(stderr, "kernel_launch: occupancy query says %d\n", per_cu); }
        (void)hipGetLastError();
        if (cus != 256) fprintf(stderr, "kernel_launch: built for 256 CUs (one workgroup per CU); device reports %d\n", cus);
        grid = 256;
    }
    if (grid < 0) return;
    (void)hipMemsetAsync((char*)d_ws + WS_CTL, 0, CTL_BYTES, stream);
    Params p{};
    p.x = (const float*)d_in[0]; p.mem = (const float*)d_in[1]; p.positions = (const int*)d_in[2];
    p.norm_mix = (const float*)d_in[3]; p.w_in = (const float*)d_in[4]; p.diff_lambda = (const float*)d_in[5]; p.hgrn_lb = (const float*)d_in[6];
    p.spatial_w = (const float*)d_in[7]; p.spatial_b = (const float*)d_in[8]; p.w_branch = (const float*)d_in[9]; p.w_out = (const float*)d_in[10];
    p.norm_mem_q = (const float*)d_in[11]; p.norm_mem_kv = (const float*)d_in[12]; p.w_mem_q = (const float*)d_in[13]; p.w_mem_kv = (const float*)d_in[14]; p.w_mem_o = (const float*)d_in[15];
    p.norm_ffn = (const float*)d_in[16]; p.w_rg = (const float*)d_in[17]; p.b_rg = (const float*)d_in[18]; p.w_re = (const float*)d_in[19]; p.b_re = (const float*)d_in[20];
    p.w_eg = (const float*)d_in[21]; p.w_eu = (const float*)d_in[22]; p.w_ed = (const float*)d_in[23]; p.norm_final = (const float*)d_in[24];
    p.out = (float*)d_out; p.ws = (unsigned char*)d_ws;
#if N_LAUNCH_MODE == 0
    p.ph_lo = 0; p.ph_hi = N_PHASES;
    hipLaunchKernelGGL(mega_fwd, dim3(grid), dim3(NTHREADS), LDS_BYTES, stream, p);
#else
    for (int k = 0; k < N_PHASES; ++k) { p.ph_lo = k; p.ph_hi = k + 1; hipLaunchKernelGGL(mega_fwd, dim3(grid), dim3(NTHREADS), LDS_BYTES, stream, p); }
#endif
}
```
